# Optimizing an MI355X kernel written in HIP

```python
import jax, jax.numpy as jnp
from jax import lax
import numpy as np

D_MODEL = 1024
BATCH = 8
SEQ = 4096
DEPTH = 4

N_META = 16
BLOCK = 128
WINDOW = 128
ROPE_THETA = 10000.0
EPS = 1e-6
NEG = -1e30
SWA_HEADS = 8
SWA_KV_HEADS = 2
SWA_HEAD_DIM = 64
SWA_GROUP = SWA_HEADS // SWA_KV_HEADS
MLA_HEADS = 8
MLA_Q_RANK = 256
MLA_KV_RANK = 128
MLA_NOPE_DIM = 64
MLA_ROPE_DIM = 32
MLA_V_DIM = 64
MLA_QK_DIM = MLA_NOPE_DIM + MLA_ROPE_DIM
SWA_Q_W = SWA_HEADS * SWA_HEAD_DIM
SWA_KV_W = SWA_KV_HEADS * SWA_HEAD_DIM
MLA_OUT_W = MLA_HEADS * MLA_V_DIM
MIX_W = SWA_Q_W + MLA_OUT_W
IN_W = SWA_Q_W + 2 * SWA_KV_W + MLA_Q_RANK + MLA_KV_RANK + MLA_ROPE_DIM
D_FF = -(-8 * D_MODEL // (3 * 256)) * 256

kernel_name = "hymba_swa_sink_mla_hybrid"


def rmsnorm(x, g):
    xf = x.astype(jnp.float32)
    y = xf * lax.rsqrt(jnp.mean(xf * xf, axis=-1, keepdims=True) + EPS)
    return (y * g.astype(jnp.float32)).astype(x.dtype)


def rope(x, pos):
    d = x.shape[-1]
    inv = ROPE_THETA ** (-jnp.arange(0, d, 2, dtype=jnp.float32) / d)
    ang = pos[:, None] * inv[None, :]
    cos = jnp.cos(ang)[:, None, :]
    sin = jnp.sin(ang)[:, None, :]
    xf = x.astype(jnp.float32)
    x1, x2 = xf[..., : d // 2], xf[..., d // 2:]
    return jnp.concatenate([x1 * cos - x2 * sin, x2 * cos + x1 * sin], -1).astype(x.dtype)


def swa_sink_attention(q, k, v, sinks, key_valid):
    B, T, _, D = q.shape
    nb = T // BLOCK
    qb = q.reshape(B, nb, BLOCK, SWA_KV_HEADS, SWA_GROUP, D)
    kb = k.reshape(B, nb, BLOCK, SWA_KV_HEADS, D)
    vb = v.reshape(B, nb, BLOCK, SWA_KV_HEADS, D)
    prev = lambda a: jnp.concatenate([jnp.zeros_like(a[:, :1]), a[:, :-1]], axis=1)
    kw = jnp.concatenate([prev(kb), kb], axis=2)
    vw = jnp.concatenate([prev(vb), vb], axis=2)
    s = jnp.einsum("bnqhgd,bnkhd->bhgnqk", qb, kw,
                   preferred_element_type=jnp.float32) * (D ** -0.5)
    qpos = jnp.arange(T).reshape(nb, BLOCK)
    kpos = jnp.concatenate([qpos - BLOCK, qpos], axis=1)
    kv_ok = key_valid.reshape(nb, BLOCK)
    kv_ok = jnp.concatenate(
        [jnp.concatenate([jnp.zeros((1, BLOCK), bool), kv_ok[:-1]], 0), kv_ok], 1)
    diff = qpos[:, :, None] - kpos[:, None, :]
    mask = (diff >= 0) & (diff < WINDOW) & kv_ok[:, None, :]
    s = jnp.where(mask, s, NEG)
    sink = jnp.broadcast_to(
        sinks.astype(jnp.float32).reshape(SWA_KV_HEADS, SWA_GROUP)[None, :, :, None, None, None],
        s.shape[:-1] + (1,))
    p = jax.nn.softmax(jnp.concatenate([s, sink], axis=-1), axis=-1)[..., :-1]
    o = jnp.einsum("bhgnqk,bnkhd->bnqhgd", p.astype(v.dtype), vw)
    return o.reshape(B, T, SWA_HEADS * D)


def causal_block_attention(q, k, v, key_valid):
    B, T, H, dqk = q.shape
    nb = T // BLOCK
    scale = dqk ** -0.5
    qb = jnp.moveaxis(q.reshape(B, nb, BLOCK, H, dqk), 1, 0)
    kpos = jnp.arange(T)

    def one_block(args):
        qblk, i = args
        s = jnp.einsum("bqhd,bkhd->bhqk", qblk, k,
                       preferred_element_type=jnp.float32) * scale
        qpos = i * BLOCK + jnp.arange(BLOCK)
        mask = (kpos[None, :] <= qpos[:, None]) & key_valid[None, :]
        p = jax.nn.softmax(jnp.where(mask, s, NEG), axis=-1)
        return jnp.einsum("bhqk,bkhd->bqhd", p.astype(v.dtype), v)

    o = lax.map(one_block, (qb, jnp.arange(nb)))
    return jnp.moveaxis(o, 0, 1).reshape(B, T, H * v.shape[-1])


def setup_inputs(seed: int = 0) -> dict:
    key = jax.random.key(seed)
    ks = jax.random.split(key, 20)
    f32 = jnp.float32
    nrm = lambda k, shape, scale: jax.random.normal(k, shape, f32) * scale
    gain = lambda k, shape: 1.0 + 0.02 * jax.random.normal(k, shape, f32)
    return {
        "x": nrm(ks[0], (BATCH, SEQ, D_MODEL), 1.0),
        "meta_tokens": nrm(ks[1], (N_META, D_MODEL), 1.0),
        "attn_norm": gain(ks[2], (DEPTH, D_MODEL)),
        "w_in": nrm(ks[3], (DEPTH, D_MODEL, IN_W), D_MODEL ** -0.5),
        "q_norm": gain(ks[4], (DEPTH, MLA_Q_RANK)),
        "w_q_up": nrm(ks[5], (DEPTH, MLA_Q_RANK, MLA_HEADS * MLA_QK_DIM), MLA_Q_RANK ** -0.5),
        "kv_norm": gain(ks[6], (DEPTH, MLA_KV_RANK)),
        "w_kv_up": nrm(ks[7], (DEPTH, MLA_KV_RANK, MLA_HEADS * (MLA_NOPE_DIM + MLA_V_DIM)),
                        MLA_KV_RANK ** -0.5),
        "sinks": nrm(ks[8], (DEPTH, SWA_HEADS), 1.0),
        "out_norm_swa": gain(ks[9], (DEPTH, SWA_Q_W)),
        "out_norm_mla": gain(ks[10], (DEPTH, MLA_OUT_W)),
        "w_o": nrm(ks[11], (DEPTH, MIX_W, D_MODEL), MIX_W ** -0.5),
        "ffn_norm": gain(ks[12], (DEPTH, D_MODEL)),
        "w_gate": nrm(ks[13], (DEPTH, D_MODEL, D_FF), D_MODEL ** -0.5),
        "w_up": nrm(ks[14], (DEPTH, D_MODEL, D_FF), D_MODEL ** -0.5),
        "w_down": nrm(ks[15], (DEPTH, D_FF, D_MODEL), D_FF ** -0.5),
        "final_norm": gain(ks[16], (D_MODEL,)),
    }


def reference(x, meta_tokens, attn_norm, w_in, q_norm, w_q_up, kv_norm, w_kv_up, sinks,
              out_norm_swa, out_norm_mla, w_o, ffn_norm, w_gate, w_up, w_down, final_norm):
    B, S, D = x.shape
    front = (-N_META) % BLOCK
    back = (-S) % BLOCK
    T = front + N_META + S + back
    h = jnp.concatenate([
        jnp.zeros((B, front, D), x.dtype),
        jnp.broadcast_to(meta_tokens.astype(x.dtype)[None], (B, N_META, D)),
        x,
        jnp.zeros((B, back, D), x.dtype)], axis=1)
    idx = jnp.arange(T)
    key_valid = (idx >= front) & (idx < front + N_META + S)
    pos = (idx - front).astype(jnp.float32)

    o1 = SWA_Q_W
    o2 = o1 + SWA_KV_W
    o3 = o2 + SWA_KV_W
    o4 = o3 + MLA_Q_RANK
    o5 = o4 + MLA_KV_RANK
    for l in range(DEPTH):
        u = rmsnorm(h, attn_norm[l])
        proj = u @ w_in[l]
        q_a = rope(proj[..., :o1].reshape(B, T, SWA_HEADS, SWA_HEAD_DIM), pos)
        k_a = rope(proj[..., o1:o2].reshape(B, T, SWA_KV_HEADS, SWA_HEAD_DIM), pos)
        v_a = proj[..., o2:o3].reshape(B, T, SWA_KV_HEADS, SWA_HEAD_DIM)
        out_a = swa_sink_attention(q_a, k_a, v_a, sinks[l], key_valid)
        q_b = (rmsnorm(proj[..., o3:o4], q_norm[l]) @ w_q_up[l]).reshape(
            B, T, MLA_HEADS, MLA_QK_DIM)
        kv_b = (rmsnorm(proj[..., o4:o5], kv_norm[l]) @ w_kv_up[l]).reshape(
            B, T, MLA_HEADS, MLA_NOPE_DIM + MLA_V_DIM)
        k_rope = rope(proj[..., o5:][:, :, None, :], pos)
        q_full = jnp.concatenate(
            [q_b[..., :MLA_NOPE_DIM], rope(q_b[..., MLA_NOPE_DIM:], pos)], axis=-1)
        k_full = jnp.concatenate(
            [kv_b[..., :MLA_NOPE_DIM],
             jnp.broadcast_to(k_rope, (B, T, MLA_HEADS, MLA_ROPE_DIM))], axis=-1)
        v_b = kv_b[..., MLA_NOPE_DIM:]
        out_b = causal_block_attention(q_full, k_full, v_b, key_valid)
        mix = jnp.concatenate([rmsnorm(out_a, out_norm_swa[l]),
                               rmsnorm(out_b, out_norm_mla[l])], axis=-1)
        h = h + mix @ w_o[l]
        u = rmsnorm(h, ffn_norm[l])
        h = h + (jax.nn.silu(u @ w_gate[l]) * (u @ w_up[l])) @ w_down[l]

    h = rmsnorm(h, final_norm)
    start = front + N_META
    return h[:, start:start + S]
```

```cpp
#include <hip/hip_runtime.h>
#include <hip/hip_cooperative_groups.h>
#include <cstdio>
#include <cstdint>
namespace cg = cooperative_groups;

constexpr int BATCH = 8, SEQ = 4096, DM = 1024, DEPTH = 4, NMETA = 16, FRONT = 112, TT = 4224;
constexpr int MROWS = BATCH * TT;
constexpr int INW = 1184, INP = 1280, DFF = 2816, GUP = 2 * DFF;
constexpr float RMS_EPS = 1e-6f;
constexpr float LOG2E = 1.4426950408889634f;
constexpr float LOG2_THETA = 13.287712379549449f;
constexpr float INV_2PI = 0.15915494309189535f;

namespace pg8 {
#define PG8_LAS __attribute__((address_space(3)))
typedef unsigned short bf16_t;
typedef short bf16x8 __attribute__((ext_vector_type(8)));
typedef float f32x4 __attribute__((ext_vector_type(4)));
typedef unsigned u32x4 __attribute__((ext_vector_type(4)));
constexpr int BM = 256, BK = 64, HALF = 128, HTB = HALF * BK * 2  , STAGE_BYTES = 8 * HTB, NXCD = 8, WGM = 8;

__host__ __device__ __forceinline__ int lds_byte(int r, int c) { const int st = (r >> 4) * 2 + (c >> 5), rr = r & 15, cc = c & 31, ob = rr * 64 + cc * 2; return st * 1024 + (ob ^ (((ob >> 9) & 1) << 5)); }
__host__ __device__ __forceinline__ void stage_rc(int b, int& R, int& C) { const int st = b / 1024, sb = b % 1024, swz = sb ^ (((sb >> 9) & 1) << 5); R = (st >> 1) * 16 + swz / 64; C = (st & 1) * 32 + (swz % 64) / 2; }
__host__ __device__ __forceinline__ int perm32(int rho) { const int n = rho >> 4, i = rho & 15; return 8 * (i >> 2) + 4 * n + (i & 3); }

struct Unit { int pm, pn; };
struct Gemm { const bf16_t* A; const bf16_t* Bt; int M, N, K; };

struct StaticOrder {
    int nM, nN, nwg, G, c;
    __host__ __device__ void init(int M, int N, int G_, int c_) { nM = M / BM; nN = N / BM; nwg = nM * nN; G = G_; c = c_; }
    __host__ __device__ bool next(int i, Unit& u) const {
        const long L = (long)i * G + c; if (L >= nwg) return false;
        int wgid = (int)L; { const int q = nwg / NXCD, r = nwg % NXCD, xcd = wgid % NXCD, off = wgid / NXCD; wgid = (xcd < r ? xcd * (q + 1) : r * (q + 1) + (xcd - r) * q) + off; }
        const int nig = WGM * nN, gid = wgid / nig, fm = gid * WGM, gsz = (nM - fm) < WGM ? (nM - fm) : WGM;
        u.pm = fm + ((wgid % nig) % gsz); u.pn = (wgid % nig) / gsz; return true;
    }
    __device__ __forceinline__ void a_ready(const Unit&) const {}
    __device__ __forceinline__ void done(const Unit&) const {}
};

__device__ __forceinline__ unsigned cvt_pk_bf16(float lo, float hi) { unsigned r; asm volatile("v_cvt_pk_bf16_f32 %0, %1, %2" : "=v"(r) : "v"(lo), "v"(hi)); return r; }
typedef unsigned u32x2 __attribute__((ext_vector_type(2)));
__device__ __forceinline__ void st_bf16x4(bf16_t* p, f32x4 v) { u32x2 w; w.x = cvt_pk_bf16(v[0], v[1]); w.y = cvt_pk_bf16(v[2], v[3]); *(u32x2*)p = w; }
__device__ __forceinline__ float sum16(const float* part, int row) {
    const f32x4* p = (const f32x4*)(part + (size_t)row * 16); const f32x4 a = p[0], b = p[1], c = p[2], d = p[3];
    return (((a.x + a.y) + (a.z + a.w)) + ((b.x + b.y) + (b.z + b.w))) + (((c.x + c.y) + (c.z + c.w)) + ((d.x + d.y) + (d.z + d.w)));
}
__device__ __forceinline__ float sum4(const float* part, int row) { const f32x4 a = *(const f32x4*)(part + (size_t)row * 4); return (a.x + a.y) + (a.z + a.w); }
__device__ __forceinline__ float rsq(float x) { return 1.0f / sqrtf(x); }
__device__ __forceinline__ float sq4(f32x4 v) { return (v[0] * v[0] + v[1] * v[1]) + (v[2] * v[2] + v[3] * v[3]); }
#define EPI_ROWS(ai, m) for (int ai = 0; ai < 2; ++ai) for (int m = 0; m < 4; ++m)
#define EPI_ROW(u, ai, m) ((u).pm * BM + (ai) * HALF + wr * 64 + (m) * 16 + fr)

struct EpiIn {
    static constexpr bool PERM = false, AFTER_DRAIN = false, MIDSCALE = false;
    const float* hss; bf16_t *qa, *ka, *va, *qlat, *kvlat, *kr; float *ssq_q, *ssq_kv;
    __device__ __forceinline__ void mid(f32x4 (&)[2][2][4][2], const Unit&, int, int, int, int) const {}
    __device__ __forceinline__ void operator()(const f32x4 (&acc)[2][2][4][2], const Unit& u, int wr, int wc, int fr, int fq) const {
        const int pn = u.pn;
        if (pn <= 2) {
            const bool is_kr = (pn == 2 && wc == 2);
            if (pn == 2 && (wc == 3)) return;
            float inv[2][4];
#pragma unroll
            for (int n = 0; n < 2; ++n)
#pragma unroll
                for (int e = 0; e < 4; ++e) inv[n][e] = is_kr ? __builtin_amdgcn_exp2f(-(float)(4 * fq + e) * (LOG2_THETA / 16.0f)) : __builtin_amdgcn_exp2f(-(float)(16 * n + 4 * fq + e) * (LOG2_THETA / 32.0f));
#pragma unroll
            for (int ai = 0; ai < 2; ++ai)
#pragma unroll
                for (int m = 0; m < 4; ++m) {
                    asm volatile("" ::: "memory"); const int row = EPI_ROW(u, ai, m); const float rs = rsq(sum16(hss, row) * (1.0f / DM) + RMS_EPS);
                    const float pos = (float)((row % TT) - FRONT);
#pragma unroll
                    for (int n = 0; n < 2; ++n) {
                        if (is_kr && n == 1) continue;
                        const f32x4 x1 = acc[ai][0][m][n] * rs, x2 = acc[ai][1][m][n] * rs; f32x4 o1, o2;
#pragma unroll
                        for (int e = 0; e < 4; ++e) { const float ang = pos * inv[n][e]; float rev = ang * INV_2PI; rev = rev - floorf(rev);
                            const float sn = __builtin_amdgcn_sinf(rev), cs = __builtin_amdgcn_cosf(rev); o1[e] = x1[e] * cs - x2[e] * sn; o2[e] = x2[e] * cs + x1[e] * sn; }
                        bf16_t* d; int half;
                        if (pn < 2) { d = qa + (size_t)row * 512 + (4 * pn + wc) * 64 + 16 * n + 4 * fq; half = 32; }
                        else if (!is_kr) { d = ka + (size_t)row * 128 + wc * 64 + 16 * n + 4 * fq; half = 32; }
                        else { d = kr + (size_t)row * 32 + 4 * fq; half = 16; }
                        st_bf16x4(d, o1); st_bf16x4(d + half, o2);
                    }
                }
        } else if (pn == 3) {
#pragma unroll
            for (int ai = 0; ai < 2; ++ai)
#pragma unroll
                for (int m = 0; m < 4; ++m) {
                    asm volatile("" ::: "memory"); const int row = EPI_ROW(u, ai, m); const float rs = rsq(sum16(hss, row) * (1.0f / DM) + RMS_EPS); float ss = 0.f;
#pragma unroll
                    for (int n = 0; n < 2; ++n) { const int c = 32 * wc + 16 * n + 4 * fq; const f32x4 v = acc[ai][0][m][n] * rs, w = acc[ai][1][m][n] * rs;
                        st_bf16x4(va + (size_t)row * 128 + c, v); st_bf16x4(kvlat + (size_t)row * 128 + c, w); ss += sq4(w); }
                    ss += __shfl_xor(ss, 16); ss += __shfl_xor(ss, 32);
                    if (fq == 0) ssq_kv[(size_t)row * 4 + wc] = ss;
                }
        } else {
#pragma unroll
            for (int ai = 0; ai < 2; ++ai)
#pragma unroll
                for (int m = 0; m < 4; ++m) {
                    asm volatile("" ::: "memory"); const int row = EPI_ROW(u, ai, m); const float rs = rsq(sum16(hss, row) * (1.0f / DM) + RMS_EPS); float ss = 0.f;
#pragma unroll
                    for (int bj = 0; bj < 2; ++bj)
#pragma unroll
                        for (int n = 0; n < 2; ++n) { const int c = 128 * bj + 32 * wc + 16 * n + 4 * fq; const f32x4 v = acc[ai][bj][m][n] * rs; st_bf16x4(qlat + (size_t)row * 256 + c, v); ss += sq4(v); }
                    ss += __shfl_xor(ss, 16); ss += __shfl_xor(ss, 32);
                    if (fq == 0) ssq_q[(size_t)row * 4 + wc] = ss;
                }
        }
    }
};

struct EpiQup {
    static constexpr bool PERM = false, AFTER_DRAIN = false, MIDSCALE = false;
    const float* ssq_q; bf16_t* qm;
    __device__ __forceinline__ void mid(f32x4 (&)[2][2][4][2], const Unit&, int, int, int, int) const {}
    __device__ __forceinline__ void operator()(const f32x4 (&acc)[2][2][4][2], const Unit& u, int wr, int wc, int fr, int fq) const {
        const int pn = u.pn;
        float inv[4];
#pragma unroll
        for (int e = 0; e < 4; ++e) inv[e] = __builtin_amdgcn_exp2f(-(float)(4 * fq + e) * (LOG2_THETA / 16.0f));
#pragma unroll
        for (int ai = 0; ai < 2; ++ai)
#pragma unroll
            for (int m = 0; m < 4; ++m) {
                asm volatile("" ::: "memory"); const int row = EPI_ROW(u, ai, m); const float rs = rsq(sum4(ssq_q, row) * (1.0f / 256.0f) + RMS_EPS);
                bf16_t* qrow = qm + (size_t)row * 768;
                if (pn < 2) {
#pragma unroll
                    for (int bj = 0; bj < 2; ++bj)
#pragma unroll
                        for (int n = 0; n < 2; ++n) { const int head = 4 * pn + 2 * bj + (wc >> 1), d = 32 * (wc & 1) + 16 * n + 4 * fq; st_bf16x4(qrow + head * 96 + d, acc[ai][bj][m][n] * rs); }
                } else {
                    const float pos = (float)((row % TT) - FRONT);
#pragma unroll
                    for (int n = 0; n < 2; ++n) { const int head = 2 * wc + n; const f32x4 x1 = acc[ai][0][m][n] * rs, x2 = acc[ai][1][m][n] * rs; f32x4 o1, o2;
#pragma unroll
                        for (int e = 0; e < 4; ++e) { const float ang = pos * inv[e]; float rev = ang * INV_2PI; rev = rev - floorf(rev);
                            const float sn = __builtin_amdgcn_sinf(rev), cs = __builtin_amdgcn_cosf(rev); o1[e] = x1[e] * cs - x2[e] * sn; o2[e] = x2[e] * cs + x1[e] * sn; }
                        st_bf16x4(qrow + head * 96 + 64 + 4 * fq, o1); st_bf16x4(qrow + head * 96 + 80 + 4 * fq, o2); }
                }
            }
    }
};

struct EpiKvup {
    static constexpr bool PERM = false, AFTER_DRAIN = false, MIDSCALE = false;
    const float* ssq_kv; bf16_t *kn, *vb;
    __device__ __forceinline__ void mid(f32x4 (&)[2][2][4][2], const Unit&, int, int, int, int) const {}
    __device__ __forceinline__ void operator()(const f32x4 (&acc)[2][2][4][2], const Unit& u, int wr, int wc, int fr, int fq) const {
        bf16_t* dst = (u.pn < 2 ? kn : vb) + (u.pn & 1) * 256;
#pragma unroll
        for (int ai = 0; ai < 2; ++ai)
#pragma unroll
            for (int m = 0; m < 4; ++m) {
                asm volatile("" ::: "memory"); const int row = EPI_ROW(u, ai, m); const float rs = rsq(sum4(ssq_kv, row) * (1.0f / 128.0f) + RMS_EPS);
#pragma unroll
                for (int bj = 0; bj < 2; ++bj)
#pragma unroll
                    for (int n = 0; n < 2; ++n) st_bf16x4(dst + (size_t)row * 512 + 128 * bj + 32 * wc + 16 * n + 4 * fq, acc[ai][bj][m][n] * rs);
            }
    }
};

struct EpiResid {
    static constexpr bool PERM = false, AFTER_DRAIN = false;
    float* H; bf16_t* HB; float* hss_out; const float* ssq_o;
    __device__ __forceinline__ void finish(const f32x4 (&acc)[2][2][4][2], const Unit& u, int wr, int wc, int fr, int fq, bool two, PG8_LAS unsigned char* xl = nullptr) const {
#pragma unroll
        for (int ai = 0; ai < 2; ++ai)
#pragma unroll
            for (int m = 0; m < 4; ++m) {
                asm volatile("" ::: "memory"); const int row = EPI_ROW(u, ai, m); float rs = 1.0f;
                if (two) rs = ((const PG8_LAS float*)(xl + (wr * 4 + wc) * 1024))[2 * (ai * 64 + m * 16 + fr) + 1];
                float ss = 0.f;
#pragma unroll
                for (int bj = 0; bj < 2; ++bj)
#pragma unroll
                    for (int n = 0; n < 2; ++n) { const size_t off = (size_t)row * DM + u.pn * BM + 128 * bj + 32 * wc + 16 * n + 4 * fq;
                        const f32x4 hv = *(const f32x4*)(H + off) + acc[ai][bj][m][n] * rs; *(f32x4*)(H + off) = hv; st_bf16x4(HB + off, hv); ss += sq4(hv); }
                ss += __shfl_xor(ss, 16); ss += __shfl_xor(ss, 32);
                if (fq == 0) hss_out[(size_t)row * 16 + 4 * u.pn + wc] = ss;
            }
    }
};
struct EpiOut : EpiResid {
    static constexpr bool MIDSCALE = true;
    PG8_LAS unsigned char* xlds;
    __device__ __forceinline__ void prep(const Unit& u, int wid, int wr, int lane) const {
        PG8_LAS float* tab = (PG8_LAS float*)(xlds + wid * 1024);
#pragma unroll
        for (int j = 0; j < 2; ++j) { const int idx = lane + 64 * j; const int row = u.pm * BM + (idx >> 6) * HALF + wr * 64 + (idx & 63);
            const f32x4* p = (const f32x4*)(ssq_o + (size_t)row * 16); const f32x4 a = p[0], b = p[1], c = p[2], d = p[3];
            const float sa = ((a.x + a.y) + (a.z + a.w)) + ((b.x + b.y) + (b.z + b.w)), sb = ((c.x + c.y) + (c.z + c.w)) + ((d.x + d.y) + (d.z + d.w));
            const float va = sa * (1.0f / 512.0f) + RMS_EPS, vb = sb * (1.0f / 512.0f) + RMS_EPS;
            tab[2 * idx] = sqrtf(vb / va); tab[2 * idx + 1] = rsq(vb); }
    }
    __device__ __forceinline__ void mid(f32x4 (&acc)[2][2][4][2], const Unit& u, int wr, int wc, int fr, int fq) const {
        const int wid = wr * 4 + wc; const PG8_LAS float* tab = (const PG8_LAS float*)(xlds + wid * 1024);
#pragma unroll
        for (int ai = 0; ai < 2; ++ai)
#pragma unroll
            for (int m = 0; m < 4; ++m) {
                const float f = tab[2 * (ai * 64 + m * 16 + fr)];
#pragma unroll
                for (int bj = 0; bj < 2; ++bj)
#pragma unroll
                    for (int n = 0; n < 2; ++n) acc[ai][bj][m][n] *= f;
            }
    }
    __device__ __forceinline__ void operator()(const f32x4 (&acc)[2][2][4][2], const Unit& u, int wr, int wc, int fr, int fq) const { finish(acc, u, wr, wc, fr, fq, true, xlds); }
};
struct EpiDown : EpiResid {
    static constexpr bool MIDSCALE = false;
    __device__ __forceinline__ void mid(f32x4 (&)[2][2][4][2], const Unit&, int, int, int, int) const {}
    __device__ __forceinline__ void operator()(const f32x4 (&acc)[2][2][4][2], const Unit& u, int wr, int wc, int fr, int fq) const { finish(acc, u, wr, wc, fr, fq, false); }
};

struct EpiGU {
    static constexpr bool PERM = false, AFTER_DRAIN = false, MIDSCALE = false;
    const float* hss; bf16_t* act;
    __device__ __forceinline__ void mid(f32x4 (&)[2][2][4][2], const Unit&, int, int, int, int) const {}
    __device__ __forceinline__ void operator()(const f32x4 (&acc)[2][2][4][2], const Unit& u, int wr, int wc, int fr, int fq) const {
#pragma unroll
        for (int ai = 0; ai < 2; ++ai)
#pragma unroll
            for (int m = 0; m < 4; ++m) {
                asm volatile("" ::: "memory"); const int row = EPI_ROW(u, ai, m); const float rs = rsq(sum16(hss, row) * (1.0f / DM) + RMS_EPS);
#pragma unroll
                for (int n = 0; n < 2; ++n) { const f32x4 g = acc[ai][0][m][n] * rs, up = acc[ai][1][m][n] * rs; f32x4 a;
#pragma unroll
                    for (int e = 0; e < 4; ++e) a[e] = g[e] * up[e] * __builtin_amdgcn_rcpf(1.0f + __builtin_amdgcn_exp2f(-g[e] * LOG2E));
                    st_bf16x4(act + (size_t)row * DFF + 128 * u.pn + 32 * wc + 16 * n + 4 * fq, a); }
            }
    }
};
template <class Epi, class Sched, bool ALIGN_EPI = false, bool SP2 = false>
__device__ __forceinline__ void gemm_phase(PG8_LAS unsigned char* lds, const Gemm g, const Sched& S, const Epi& E) {
    int tid_ = threadIdx.x; asm volatile("" : "+v"(tid_));
    const int tid = tid_, wid = __builtin_amdgcn_readfirstlane(tid >> 6), lane = tid & 63, wr = wid >> 2, wc = wid & 3, fr = lane & 15, fq = lane >> 4;
    int K_ = g.K; asm volatile("" : "+s"(K_)); const int K = K_, nt = K / BK;
    unsigned voffA[2], voffB[2];
#pragma unroll
    for (int i = 0; i < 2; ++i) { int R, C; stage_rc(tid * 16 + i * 8192, R, C); const int Rb = Epi::PERM ? ((R & ~31) + perm32(R & 31)) : R;
        voffA[i] = (unsigned)(R * K + C) * 2u; voffB[i] = (unsigned)(Rb * K + C) * 2u; }
    const size_t kstep = (size_t)(BK * 2);
    const size_t hstep = (size_t)HALF * K * 2;
    const size_t tstep = 2 * hstep;
    const unsigned ldsw = (unsigned)wid * 1024u;
    const int aoff = lds_byte(wr * 64 + fr, fq * 8), boff = lds_byte(wc * 32 + fr, fq * 8);
#define PG8_SA(b, h) (((b) * 2 + (h)) * HTB)
#define PG8_SB(b, h) ((4 + (b) * 2 + (h)) * HTB)
#define PG8_STAGE(bufoff, gbase, voff) do { _Pragma("unroll") for (int _i = 0; _i < 2; ++_i) \
        __builtin_amdgcn_global_load_lds((const unsigned*)((const char*)(gbase) + (voff)[_i]), (PG8_LAS unsigned*)(lds + (bufoff) + ldsw + _i * 8192), 16, 0, 0); } while (0)
#define PG8_LDA(dst, b, h) do { _Pragma("unroll") for (int m = 0; m < 4; ++m) _Pragma("unroll") for (int k = 0; k < 2; ++k) dst[m][k] = *(const PG8_LAS bf16x8*)(lds + PG8_SA(b, h) + aoff + m * 2048 + k * 1024); } while (0)
#define PG8_LDB(dst, b, h) do { _Pragma("unroll") for (int n = 0; n < 2; ++n) _Pragma("unroll") for (int k = 0; k < 2; ++k) dst[n][k] = *(const PG8_LAS bf16x8*)(lds + PG8_SB(b, h) + boff + n * 2048 + k * 1024); } while (0)
#define PG8_MMA(ai, bj, At, Bt) do { __builtin_amdgcn_s_setprio(1); _Pragma("unroll") for (int m = 0; m < 4; ++m) _Pragma("unroll") for (int n = 0; n < 2; ++n) _Pragma("unroll") for (int k = 0; k < 2; ++k) \
        acc[ai][bj][m][n] = __builtin_amdgcn_mfma_f32_16x16x32_bf16(Bt[n][k], At[m][k], acc[ai][bj][m][n], 0, 0, 0); __builtin_amdgcn_s_setprio(0); } while (0)
#define PG8_WAIT_V(n) asm volatile("s_waitcnt vmcnt(" #n ")" ::: "memory")
#define PG8_WAIT_L(n) asm volatile("s_waitcnt lgkmcnt(" #n ")" ::: "memory")
#define PG8_BAR __builtin_amdgcn_s_barrier()
#define PG8_SCHED __builtin_amdgcn_sched_barrier(0)
    Unit cur, nxt; int ui = 0;
    if (!S.next(0, cur)) return;
    f32x4 acc[2][2][4][2];
#pragma unroll
    for (int a = 0; a < 2; ++a)
#pragma unroll
        for (int b = 0; b < 2; ++b)
#pragma unroll
            for (int m = 0; m < 4; ++m)
#pragma unroll
                for (int n = 0; n < 2; ++n) acc[a][b][m][n] = (f32x4){0.f, 0.f, 0.f, 0.f};
    bf16x8 At[4][2], B0[2][2], B1[2][2];
    const char* cA = (const char*)g.A + (size_t)cur.pm * tstep; const char* cB = (const char*)g.Bt + (size_t)cur.pn * tstep;
    S.a_ready(cur);
    if constexpr (SP2) {
        PG8_STAGE(PG8_SB(0, 0), cB, voffB); PG8_STAGE(PG8_SB(0, 1), cB + hstep, voffB); PG8_STAGE(PG8_SA(0, 0), cA, voffA); PG8_STAGE(PG8_SA(0, 1), cA + hstep, voffA);
        if (wr == 1) PG8_BAR;
        PG8_WAIT_V(2); PG8_BAR;
        PG8_STAGE(PG8_SB(1, 0), cB + kstep, voffB); PG8_STAGE(PG8_SA(1, 0), cA + kstep, voffA); PG8_STAGE(PG8_SB(1, 1), cB + hstep + kstep, voffB);
        PG8_WAIT_V(6); PG8_BAR;
    } else {
        PG8_STAGE(PG8_SB(0, 0), cB, voffB); PG8_STAGE(PG8_SA(0, 0), cA, voffA); PG8_STAGE(PG8_SB(0, 1), cB + hstep, voffB); PG8_STAGE(PG8_SA(0, 1), cA + hstep, voffA);
        if (wr == 1) PG8_BAR;
        PG8_WAIT_V(4); PG8_BAR;
        PG8_STAGE(PG8_SB(1, 0), cB + kstep, voffB); PG8_STAGE(PG8_SA(1, 0), cA + kstep, voffA); PG8_STAGE(PG8_SB(1, 1), cB + hstep + kstep, voffB);
        PG8_WAIT_V(6); PG8_BAR;
    }
    for (;;) {
        const bool has_next = S.next(ui + 1, nxt);
        if constexpr (Epi::MIDSCALE) E.prep(cur, wid, wr, lane);
        const char* nA = has_next ? (const char*)g.A + (size_t)nxt.pm * tstep : cA; const char* nB = has_next ? (const char*)g.Bt + (size_t)nxt.pn * tstep : cB;
        for (int t = 0; t < nt; t += 2) {
            const bool last = (t == nt - 2);
            if constexpr (Epi::MIDSCALE) { if (t == (nt >> 1)) E.mid(acc, cur, wr, wc, fr, fq); }
            const char* a1 = cA + (size_t)(t + 1) * kstep;
            const char* a2 = last ? nA : cA + (size_t)(t + 2) * kstep; const char* b2 = last ? nB : cB + (size_t)(t + 2) * kstep;
            const char* a3 = a2 + kstep; const char* b3 = b2 + kstep;
            if (last && has_next) S.a_ready(nxt);
            if constexpr (SP2) {
            PG8_LDB(B0, 0, 0); PG8_LDB(B1, 0, 1); PG8_SCHED; PG8_LDA(At, 0, 0); PG8_STAGE(PG8_SA(1, 1), a1 + hstep, voffA);
            PG8_WAIT_V(8); PG8_WAIT_L(0); PG8_BAR; PG8_MMA(0, 0, At, B0); PG8_MMA(0, 1, At, B1); PG8_BAR; PG8_SCHED;
            PG8_LDA(At, 0, 1); PG8_STAGE(PG8_SB(0, 0), b2, voffB); PG8_STAGE(PG8_SB(0, 1), b2 + hstep, voffB); PG8_STAGE(PG8_SA(0, 0), a2, voffA);
            PG8_WAIT_V(8); PG8_WAIT_L(0); PG8_BAR; PG8_MMA(1, 0, At, B0); PG8_MMA(1, 1, At, B1); PG8_BAR; PG8_SCHED;
            PG8_LDB(B0, 1, 0); PG8_LDB(B1, 1, 1); PG8_SCHED; PG8_LDA(At, 1, 0); PG8_STAGE(PG8_SA(0, 1), a2 + hstep, voffA);
            PG8_WAIT_V(8); PG8_WAIT_L(0); PG8_BAR; PG8_MMA(0, 0, At, B0); PG8_MMA(0, 1, At, B1); PG8_BAR; PG8_SCHED;
            PG8_LDA(At, 1, 1); PG8_STAGE(PG8_SB(1, 0), b3, voffB); PG8_STAGE(PG8_SB(1, 1), b3 + hstep, voffB); PG8_STAGE(PG8_SA(1, 0), a3, voffA);
            PG8_WAIT_V(8); PG8_WAIT_L(0); PG8_BAR; PG8_MMA(1, 0, At, B0); PG8_MMA(1, 1, At, B1); PG8_BAR; PG8_SCHED;
            } else {
            PG8_LDB(B0, 0, 0); PG8_SCHED; PG8_LDA(At, 0, 0); PG8_STAGE(PG8_SA(1, 1), a1 + hstep, voffA);
            PG8_WAIT_L(8); PG8_BAR; PG8_WAIT_L(0); PG8_MMA(0, 0, At, B0); PG8_BAR; PG8_SCHED;
            PG8_LDB(B1, 0, 1); PG8_STAGE(PG8_SB(0, 0), b2, voffB);
            PG8_BAR; PG8_WAIT_L(0); PG8_MMA(0, 1, At, B1); PG8_BAR;
            PG8_LDA(At, 0, 1); PG8_STAGE(PG8_SA(0, 0), a2, voffA);
            PG8_BAR; PG8_WAIT_L(0); PG8_MMA(1, 0, At, B0); PG8_BAR; PG8_SCHED;
            PG8_STAGE(PG8_SB(0, 1), b2 + hstep, voffB);
            PG8_WAIT_V(6); PG8_BAR; PG8_MMA(1, 1, At, B1); PG8_BAR;
            PG8_LDB(B0, 1, 0); PG8_SCHED; PG8_LDA(At, 1, 0); PG8_STAGE(PG8_SA(0, 1), a2 + hstep, voffA);
            PG8_WAIT_L(8); PG8_BAR; PG8_WAIT_L(0); PG8_MMA(0, 0, At, B0); PG8_BAR; PG8_SCHED;
            PG8_LDB(B1, 1, 1); PG8_STAGE(PG8_SB(1, 0), b3, voffB);
            PG8_BAR; PG8_WAIT_L(0); PG8_MMA(0, 1, At, B1); PG8_BAR;
            PG8_LDA(At, 1, 1); PG8_STAGE(PG8_SA(1, 0), a3, voffA);
            PG8_BAR; PG8_WAIT_L(0); PG8_MMA(1, 0, At, B0); PG8_BAR; PG8_SCHED;
            PG8_STAGE(PG8_SB(1, 1), b3 + hstep, voffB);
            PG8_WAIT_V(6); PG8_BAR; PG8_MMA(1, 1, At, B1); PG8_BAR;
            }
        }
        if constexpr (ALIGN_EPI) { if (wr == 0) PG8_BAR; }
        if constexpr (!Epi::AFTER_DRAIN) { E(acc, cur, wr, wc, fr, fq); S.done(cur); }
        if (!has_next) break;
#pragma unroll
        for (int a = 0; a < 2; ++a)
#pragma unroll
            for (int b = 0; b < 2; ++b)
#pragma unroll
                for (int m = 0; m < 4; ++m)
#pragma unroll
                    for (int n = 0; n < 2; ++n) acc[a][b][m][n] = (f32x4){0.f, 0.f, 0.f, 0.f};
        cur = nxt; cA = nA; cB = nB; ++ui;
        if constexpr (ALIGN_EPI) { if (wr == 1) PG8_BAR; }
    }
    PG8_WAIT_V(0);
    if constexpr (!ALIGN_EPI) { if (wr == 0) PG8_BAR; }
    PG8_BAR;
    if constexpr (Epi::AFTER_DRAIN) { E.fused(acc, cur, wr, wc, fr, fq, lds, wid, lane); S.done(cur); }
#undef PG8_SA
#undef PG8_SB
#undef PG8_STAGE
#undef PG8_LDA
#undef PG8_LDB
#undef PG8_MMA
#undef PG8_WAIT_V
#undef PG8_WAIT_L
#undef PG8_BAR
#undef PG8_SCHED
}
}
namespace att {
#define ALAS __attribute__((address_space(3)))
typedef unsigned short bf16_t;
typedef short bf16x8 __attribute__((ext_vector_type(8)));
typedef short s16x4 __attribute__((ext_vector_type(4)));
typedef float f32x16 __attribute__((ext_vector_type(16)));
typedef unsigned u32x4 __attribute__((ext_vector_type(4)));
typedef float f32x2_t __attribute__((ext_vector_type(2))); typedef __bf16 bf16x2_t __attribute__((ext_vector_type(2)));
constexpr int KPMAX = 208, VP = 144, KSZ = 64 * KPMAX, VSZ = 64 * VP;
constexpr int OFF_V = 2 * KSZ, OFF_SCR = OFF_V + 2 * VSZ, OFF_Q = OFF_SCR + 8 * 256, LDS_BYTES = OFF_Q + 64;
constexpr float NEGF = -1e30f, THR = 6.0f;
__device__ __forceinline__ int crow(int r, int hi) { return (r & 3) + 8 * (r >> 2) + 4 * hi; }
__device__ __forceinline__ unsigned cvtpk(float lo, float hi) { f32x2_t v = {lo, hi}; bf16x2_t b = __builtin_convertvector(v, bf16x2_t); return __builtin_bit_cast(unsigned, b); }
__device__ __forceinline__ bf16x8 pack8(const f32x16& p, int s) { u32x4 w; w.x = cvtpk(p[8 * s], p[8 * s + 1]); w.y = cvtpk(p[8 * s + 2], p[8 * s + 3]); w.z = cvtpk(p[8 * s + 4], p[8 * s + 5]); w.w = cvtpk(p[8 * s + 6], p[8 * s + 7]); return __builtin_bit_cast(bf16x8, w); }
typedef short v4i16_t __attribute__((ext_vector_type(4)));
__device__ __forceinline__ s16x4 vtr(const ALAS unsigned char* p) { return __builtin_bit_cast(s16x4, __builtin_amdgcn_ds_read_tr16_b64_v4i16((ALAS v4i16_t*)p)); }
__device__ __forceinline__ unsigned short f2bf(float f) { unsigned u = __builtin_bit_cast(unsigned, f); return (unsigned short)((u + 0x7fffu + ((u >> 16) & 1u)) >> 16); }

template <int DQK, bool SWA>
__device__ __forceinline__ void attn_unit(ALAS unsigned char* lds, const bf16_t* Qp, int qpitch, const bf16_t* Kp, int kpitch, const bf16_t* Krp, const bf16_t* Vp, int vpitch,
                                          bf16_t* Op, float* ssq, float sink2, int b, int qb) {
    constexpr int KP = DQK * 2 + 16, NS = DQK / 16;
    int tid_ = threadIdx.x; asm volatile("" : "+v"(tid_));
    const int tid = tid_, lane = tid & 63, wid = __builtin_amdgcn_readfirstlane(tid >> 6), r = lane & 31, h = lane >> 5;
    const size_t rowbase = (size_t)b * TT;
    const int q0 = qb * 256, q0w = q0 + wid * 32;
    const bool wave_valid = q0w < TT;
    const int NT = (q0 + 256) / 64 < TT / 64 ? (q0 + 256) / 64 : TT / 64;
    int t0 = 1; if (SWA) { t0 = (q0 - 128) / 64; if (t0 < 1) t0 = 1; }
    ALAS float* scr = (ALAS float*)(lds + OFF_SCR + wid * 256);
    bf16x8 qf[NS];
    { const int qr = (q0w + r) < TT ? (q0w + r) : TT - 1; const bf16_t* qrow = Qp + (rowbase + qr) * (size_t)qpitch;
#pragma unroll
      for (int s = 0; s < NS; ++s) qf[s] = *(const bf16x8*)(qrow + 16 * s + 8 * h); }
    const int srow = tid >> 3, sch = tid & 7, rrow = (tid >> 2) & 63, rch = tid & 3;
    u32x4 kreg, vreg, rreg = {0u, 0u, 0u, 0u};
#define AT_GLOAD(t) do { const size_t kr_ = rowbase + 64 * (t) + srow; kreg = *(const u32x4*)(Kp + kr_ * (size_t)kpitch + sch * 8); vreg = *(const u32x4*)(Vp + kr_ * (size_t)vpitch + sch * 8); \
        if (DQK == 96) { if (tid < 256) rreg = *(const u32x4*)(Krp + (rowbase + 64 * (t) + rrow) * 32 + rch * 8); } } while (0)
#define AT_LSTORE(buf) do { *(ALAS u32x4*)(lds + (buf) * KSZ + srow * KP + sch * 16) = kreg; *(ALAS u32x4*)(lds + OFF_V + (buf) * VSZ + srow * VP + sch * 16) = vreg; \
        if (DQK == 96) { if (tid < 256) *(ALAS u32x4*)(lds + (buf) * KSZ + rrow * KP + 128 + rch * 16) = rreg; } } while (0)
    AT_GLOAD(t0); AT_LSTORE(0);
    __syncthreads();
    float mrun = SWA ? sink2 : NEGF, lrun = (SWA && h == 0) ? 1.0f : 0.0f;
    f32x16 o0, o1;
#pragma unroll
    for (int i = 0; i < 16; ++i) { o0[i] = 0.f; o1[i] = 0.f; }
    const int q = q0w + r;
    for (int t = t0; t < NT; ++t) {
        const int buf = (t - t0) & 1;
        if (t + 1 < NT) AT_GLOAD(t + 1);
        const int kfirst = 64 * t;
        bool active = wave_valid && (kfirst <= q0w + 31);
        if (SWA) active = active && (kfirst + 63 >= q0w - 127);
        if (active) {
            f32x16 s0, s1;
#pragma unroll
            for (int i = 0; i < 16; ++i) { s0[i] = 0.f; s1[i] = 0.f; }
            const ALAS unsigned char* kb = lds + buf * KSZ + r * KP + h * 16;
#pragma unroll
            for (int s = 0; s < NS; ++s) { const bf16x8 k0 = *(const ALAS bf16x8*)(kb + s * 32), k1 = *(const ALAS bf16x8*)(kb + 32 * KP + s * 32);
                s0 = __builtin_amdgcn_mfma_f32_32x32x16_bf16(k0, qf[s], s0, 0, 0, 0); s1 = __builtin_amdgcn_mfma_f32_32x32x16_bf16(k1, qf[s], s1, 0, 0, 0); }
            const bool need_mask = SWA || (t == 1) || (kfirst + 63 > q0w);
            if (need_mask) {
#pragma unroll
                for (int i = 0; i < 16; ++i) { const int key = kfirst + crow(i, h), key1 = key + 32;
                    bool ok0 = (key <= q) && (key >= FRONT), ok1 = (key1 <= q) && (key1 >= FRONT);
                    if (SWA) { ok0 = ok0 && (q - key < 128); ok1 = ok1 && (q - key1 < 128); }
                    s0[i] = ok0 ? s0[i] : NEGF; s1[i] = ok1 ? s1[i] : NEGF; }
            }
            float rm = fmaxf(s0[0], s1[0]);
#pragma unroll
            for (int i = 1; i < 16; ++i) rm = fmaxf(rm, fmaxf(s0[i], s1[i]));
            rm = fmaxf(rm, __shfl_xor(rm, 32));
            if (__any(rm > mrun + THR)) {
                const float mn = fmaxf(mrun, rm), f = __builtin_amdgcn_exp2f(mrun - mn); mrun = mn; lrun *= f;
                if (h == 0) scr[r] = f;
#pragma unroll
                for (int i = 0; i < 16; ++i) { const float fi = scr[crow(i, h)]; o0[i] *= fi; o1[i] *= fi; }
            }
            float ls = 0.f;
#pragma unroll
            for (int i = 0; i < 16; ++i) { s0[i] = __builtin_amdgcn_exp2f(s0[i] - mrun); s1[i] = __builtin_amdgcn_exp2f(s1[i] - mrun); ls += s0[i] + s1[i]; }
            lrun += ls;
            const bf16x8 p0 = pack8(s0, 0), p1 = pack8(s0, 1), p2 = pack8(s1, 0), p3 = pack8(s1, 1);
            const ALAS unsigned char* vb_ = lds + OFF_V + buf * VSZ + (4 * h + ((lane & 15) >> 2)) * VP + ((lane >> 4) & 1) * 32 + (lane & 3) * 8;
#define AT_PV(P, rowoff) do { \
                { const s16x4 lo = vtr(vb_ + (rowoff) * VP), hi = vtr(vb_ + ((rowoff) + 8) * VP); const bf16x8 vf = __builtin_shufflevector(lo, hi, 0, 1, 2, 3, 4, 5, 6, 7); o0 = __builtin_amdgcn_mfma_f32_32x32x16_bf16(P, vf, o0, 0, 0, 0); } \
                { const s16x4 lo = vtr(vb_ + (rowoff) * VP + 64), hi = vtr(vb_ + ((rowoff) + 8) * VP + 64); const bf16x8 vf = __builtin_shufflevector(lo, hi, 0, 1, 2, 3, 4, 5, 6, 7); o1 = __builtin_amdgcn_mfma_f32_32x32x16_bf16(P, vf, o1, 0, 0, 0); } } while (0)
            AT_PV(p0, 0); AT_PV(p1, 16); AT_PV(p2, 32); AT_PV(p3, 48);
#undef AT_PV
        }
        if (t + 1 < NT) AT_LSTORE(buf ^ 1);
        __syncthreads();
    }
#undef AT_GLOAD
#undef AT_LSTORE
    if (wave_valid) {
        const float lt = lrun + __shfl_xor(lrun, 32);
        if (h == 0) scr[32 + r] = lt;
#pragma unroll
        for (int i = 0; i < 16; ++i) {
            const float li = scr[32 + crow(i, h)], inv = li > 0.f ? 1.0f / li : 0.f;
            const float a = o0[i] * inv, c = o1[i] * inv; const size_t row = rowbase + q0w + crow(i, h);
            Op[row * 1024 + r] = f2bf(a); Op[row * 1024 + 32 + r] = f2bf(c);
            float ss = a * a + c * c;
            ss += __shfl_xor(ss, 1); ss += __shfl_xor(ss, 2); ss += __shfl_xor(ss, 4); ss += __shfl_xor(ss, 8); ss += __shfl_xor(ss, 16);
            if (r == 0) ssq[row * 16] = ss;
        }
    }
    __syncthreads();
}
}
typedef unsigned short bf16;
#define LAS __attribute__((address_space(3)))
constexpr size_t MiB = 1u << 20;
constexpr int NWAVES = 8, NTHREADS = 512;
constexpr int LDS_BYTES = 147456;
static_assert(att::LDS_BYTES <= 131072, "attention LDS");
constexpr size_t WS_CTL = 0, CTL_BYTES = 4096;
constexpr size_t WS_H = 1 * MiB;
constexpr size_t WS_HB = WS_H + (size_t)MROWS * DM * 4;
constexpr size_t WS_W = WS_HB + (size_t)MROWS * DM * 2;
constexpr size_t WL_IN = 0, WL_Q = WL_IN + (size_t)INP * DM * 2, WL_KV = WL_Q + (size_t)768 * 256 * 2, WL_O = WL_KV + (size_t)1024 * 128 * 2,
                 WL_GU = WL_O + (size_t)DM * DM * 2, WL_D = WL_GU + (size_t)GUP * DM * 2, WL_END = WL_D + (size_t)DM * DFF * 2;
constexpr size_t WBUF = 22 * MiB;
static_assert(WL_END <= WBUF, "weight buffer");
constexpr size_t WS_PART = WS_W + 2 * WBUF;
constexpr size_t P_HSSA = 0, P_HSSB = P_HSSA + (size_t)MROWS * 64, P_SSQO = P_HSSB + (size_t)MROWS * 64, P_SSQQ = P_SSQO + (size_t)MROWS * 64, P_SSQKV = P_SSQQ + (size_t)MROWS * 16, P_END = P_SSQKV + (size_t)MROWS * 16;
static_assert(P_END <= 8 * MiB, "partials");
constexpr size_t WS_R = WS_PART + 8 * MiB;
constexpr size_t R_QA = 0, R_KA = R_QA + (size_t)MROWS * 512 * 2, R_VA = R_KA + (size_t)MROWS * 128 * 2, R_QLAT = R_VA + (size_t)MROWS * 128 * 2, R_KVLAT = R_QLAT + (size_t)MROWS * 256 * 2,
                 R_KR = R_KVLAT + (size_t)MROWS * 128 * 2, R_QM = R_KR + (size_t)MROWS * 32 * 2, R_KN = R_QM + (size_t)MROWS * 768 * 2, R_VB = R_KN + (size_t)MROWS * 512 * 2,
                 R_O = R_VB + (size_t)MROWS * 512 * 2, R_END = R_O + (size_t)MROWS * 1024 * 2;
constexpr size_t R_ACT = 0;
static_assert((size_t)MROWS * DFF * 2 <= R_END, "act overlay");
constexpr size_t WS_END = WS_R + R_END;
static_assert(WS_END <= 512 * MiB, "workspace must fit 512 MiB");

struct Args {
    const float *x, *meta, *attn_norm, *w_in, *q_norm, *w_q_up, *kv_norm, *w_kv_up, *sinks, *out_norm_swa, *out_norm_mla, *w_o, *ffn_norm, *w_gate, *w_up, *w_down, *final_norm;
    float* out; unsigned char* ws; int ph_lo, ph_hi;
};

__device__ __forceinline__ unsigned f2bf_u(float f) { unsigned u = __builtin_bit_cast(unsigned, f); return (u + 0x7fffu + ((u >> 16) & 1u)) >> 16; }
__device__ __forceinline__ unsigned pk2(float lo, float hi) { return f2bf_u(lo) | (f2bf_u(hi) << 16); }
__device__ __forceinline__ float wave_sum(float v) {
#pragma unroll
    for (int o = 1; o < 64; o <<= 1) v += __shfl_xor(v, o);
    return v;
}

__device__ __forceinline__ int src_in(int np) { const int pn = np >> 8, bj = (np >> 7) & 1, o = np & 127;
    if (pn < 2) return (4 * pn + (o >> 5)) * 64 + (o & 31) + 32 * bj;
    if (pn == 2) { if (o < 64) return 512 + (o >> 5) * 64 + (o & 31) + 32 * bj; if (o < 80) return 1152 + (o - 64) + 16 * bj; return -1; }
    if (pn == 3) return bj ? 1024 + o : 640 + o;
    return 768 + 128 * bj + o; }
__device__ __forceinline__ int src_qup(int np) { const int pn = np >> 8, op = np & 255;
    if (pn < 2) return (4 * pn + (op >> 6)) * 96 + (op & 63);
    const int bj = op >> 7, o = op & 127; return (o >> 4) * 96 + 64 + (o & 15) + 16 * bj; }
__device__ __forceinline__ int src_kvup(int np) { const int pn = np >> 8, op = np & 255; return (4 * (pn & 1) + (op >> 6)) * 128 + (pn >= 2 ? 64 : 0) + (op & 63); }

template <int MODE>
__device__ __forceinline__ void conv_item(const float* W, const float* W2, const float* gain, const float* gain2, int K, int Nsrc, bf16* WT, LAS float* scr, int item, int nblk, int lane) {
    const int kb = item / nblk, nb = item % nblk, k0 = 64 * kb, n0 = 32 * nb;
    const int np = n0 + (lane & 31);
    int src; float cs = 1.0f; const float* Wp = W;
    if (MODE == 0) { src = src_in(np); if (np < 512) cs = 0.125f * LOG2E; }
    else if (MODE == 1) { src = src_qup(np); cs = 0.10206207261596577f * LOG2E; }
    else if (MODE == 2) src = src_kvup(np);
    else if (MODE == 4) { src = 128 * (np >> 8) + (np & 127); if ((np >> 7) & 1) Wp = W2; }
    else src = np;
#pragma unroll 8
    for (int i = 0; i < 32; ++i) { const int kk = 2 * i + (lane >> 5), k = k0 + kk;
        float g = 1.0f; if (MODE == 3) g = (k < 512) ? gain[k] : gain2[k - 512]; else if (MODE != 5) g = gain[k];
        scr[kk * 33 + (lane & 31)] = (src >= 0) ? Wp[(size_t)k * Nsrc + src] * g * cs : 0.0f; }
    asm volatile("s_waitcnt lgkmcnt(0)" ::: "memory");
    const int c = lane & 7;
#pragma unroll
    for (int j = 0; j < 4; ++j) { const int n = (lane >> 3) + 8 * j; const LAS float* s = scr + (8 * c) * 33 + n;
        pg8::u32x4 o; o.x = pk2(s[0 * 33], s[1 * 33]); o.y = pk2(s[2 * 33], s[3 * 33]); o.z = pk2(s[4 * 33], s[5 * 33]); o.w = pk2(s[6 * 33], s[7 * 33]);
        *(pg8::u32x4*)(WT + (size_t)(n0 + n) * K + k0 + 8 * c) = o; }
    asm volatile("s_waitcnt lgkmcnt(0)" ::: "memory");
}
__device__ __forceinline__ void conv_layer(const Args& a, int l, unsigned char* wbuf, LAS unsigned char* lds) {
    int tid_ = threadIdx.x; asm volatile("" : "+v"(tid_));
    const int lane = tid_ & 63, wave = tid_ >> 6;
    LAS float* scr = (LAS float*)(lds + wave * 16384);
    const int gw = blockIdx.x * NWAVES + wave, NGW = gridDim.x * NWAVES;
    constexpr int I0 = (DM / 64) * (INP / 32), I1 = (256 / 64) * (768 / 32), I2 = (128 / 64) * (1024 / 32), I3 = (DM / 64) * (DM / 32), I4 = (DM / 64) * (GUP / 32), I5 = (DFF / 64) * (DM / 32);
    constexpr int NIT = I0 + I1 + I2 + I3 + I4 + I5;
    for (int it = gw; it < NIT; it += NGW) {
        int r = it;
        if (r < I0) { conv_item<0>(a.w_in + (size_t)l * DM * INW, nullptr, a.attn_norm + l * DM, nullptr, DM, INW, (bf16*)(wbuf + WL_IN), scr, r, INP / 32, lane); continue; } r -= I0;
        if (r < I1) { conv_item<1>(a.w_q_up + (size_t)l * 256 * 768, nullptr, a.q_norm + l * 256, nullptr, 256, 768, (bf16*)(wbuf + WL_Q), scr, r, 768 / 32, lane); continue; } r -= I1;
        if (r < I2) { conv_item<2>(a.w_kv_up + (size_t)l * 128 * 1024, nullptr, a.kv_norm + l * 128, nullptr, 128, 1024, (bf16*)(wbuf + WL_KV), scr, r, 1024 / 32, lane); continue; } r -= I2;
        if (r < I3) { conv_item<3>(a.w_o + (size_t)l * DM * DM, nullptr, a.out_norm_swa + l * 512, a.out_norm_mla + l * 512, DM, DM, (bf16*)(wbuf + WL_O), scr, r, DM / 32, lane); continue; } r -= I3;
        if (r < I4) { conv_item<4>(a.w_gate + (size_t)l * DM * DFF, a.w_up + (size_t)l * DM * DFF, a.ffn_norm + l * DM, nullptr, DM, DFF, (bf16*)(wbuf + WL_GU), scr, r, GUP / 32, lane); continue; } r -= I4;
        conv_item<5>(a.w_down + (size_t)l * DFF * DM, nullptr, nullptr, nullptr, DFF, DM, (bf16*)(wbuf + WL_D), scr, r, DM / 32, lane);
    }
}

__device__ __forceinline__ void init_rows(const Args& a, float* H, bf16* HB, float* hss) {
    const int lane = threadIdx.x & 63, wave = threadIdx.x >> 6; const int gw = blockIdx.x * NWAVES + wave, NGW = gridDim.x * NWAVES;
    for (int row = gw; row < MROWS; row += NGW) {
        const int b = row / TT, t = row % TT;
        pg8::f32x4 v[4]; float s = 0.f;
        const float* src = (t < FRONT) ? nullptr : (t < FRONT + NMETA) ? a.meta + (size_t)(t - FRONT) * DM : a.x + ((size_t)b * SEQ + (t - FRONT - NMETA)) * DM;
#pragma unroll
        for (int j = 0; j < 4; ++j) { v[j] = src ? *((const pg8::f32x4*)src + lane + 64 * j) : (pg8::f32x4){0.f, 0.f, 0.f, 0.f}; s += pg8::sq4(v[j]); }
        s = wave_sum(s);
#pragma unroll
        for (int j = 0; j < 4; ++j) { *((pg8::f32x4*)(H + (size_t)row * DM) + lane + 64 * j) = v[j]; pg8::st_bf16x4(HB + (size_t)row * DM + 4 * (lane + 64 * j), v[j]); }
        if (lane < 16) hss[(size_t)row * 16 + lane] = (lane == 0) ? s : 0.f;
    }
}
__device__ __forceinline__ void final_rows(const Args& a, const float* H, const float* hss) {
    const int lane = threadIdx.x & 63, wave = threadIdx.x >> 6; const int gw = blockIdx.x * NWAVES + wave, NGW = gridDim.x * NWAVES;
    for (int o = gw; o < BATCH * SEQ; o += NGW) {
        const int b = o / SEQ, s = o % SEQ; const int row = b * TT + FRONT + NMETA + s;
        const float rs = pg8::rsq(pg8::sum16(hss, row) * (1.0f / DM) + RMS_EPS);
#pragma unroll
        for (int j = 0; j < 4; ++j) { const pg8::f32x4 v = *((const pg8::f32x4*)(H + (size_t)row * DM) + lane + 64 * j), g = *((const pg8::f32x4*)a.final_norm + lane + 64 * j);
            *((pg8::f32x4*)(a.out + (size_t)o * DM) + lane + 64 * j) = v * rs * g; }
    }
}

constexpr int N_ATT_UNITS = 2 * 17 * 64;
__device__ __forceinline__ void attn_phase(const Args& a, int l, unsigned char* ws, LAS unsigned char* lds) {
    unsigned* ctr = (unsigned*)(ws + WS_CTL) + 64 * l;
    unsigned char* R = ws + WS_R;
    const bf16 *QA = (const bf16*)(R + R_QA), *KA = (const bf16*)(R + R_KA), *VA = (const bf16*)(R + R_VA), *KR = (const bf16*)(R + R_KR), *QM = (const bf16*)(R + R_QM), *KN = (const bf16*)(R + R_KN), *VB = (const bf16*)(R + R_VB);
    bf16* O = (bf16*)(R + R_O); float* ssqO = (float*)(ws + WS_PART + P_SSQO);
    LAS int* qslot = (LAS int*)(lds + att::OFF_Q);
    for (;;) {
        if (threadIdx.x == 0) *qslot = (int)atomicAdd(ctr, 1u);
        __syncthreads();
        const int u = *qslot;
        __syncthreads();
        if (u >= N_ATT_UNITS) break;
        if (u < 17 * 64) {
            const int qb = 16 - u / 64, bh = u % 64, b = bh >> 3, hd = bh & 7;
            att::attn_unit<96, false>(lds, QM + hd * 96, 768, KN + hd * 64, 512, KR, VB + hd * 64, 512, O + 512 + hd * 64, ssqO + 8 + hd, 0.f, b, qb);
        } else {
            const int v = u - 17 * 64; const int qb = 16 - v / 64, bh = v % 64, b = bh >> 3, hq = bh & 7, kv = hq >> 2;
            att::attn_unit<64, true>(lds, QA + hq * 64, 512, KA + kv * 64, 128, nullptr, VA + kv * 64, 128, O + hq * 64, ssqO + hq, a.sinks[l * 8 + hq] * LOG2E, b, qb);
        }
    }
}

#ifndef PHM
#define PHM 255
#endif
__global__ void __launch_bounds__(NTHREADS, 2) fwd_megakernel(Args a) {
    extern __shared__ __attribute__((aligned(16))) unsigned char lds_raw[];
    LAS unsigned char* lds = (LAS unsigned char*)lds_raw;
    cg::grid_group grid = cg::this_grid();
    const int lo = a.ph_lo, hi = a.ph_hi;
#define IN_PH(k) (lo <= (k) && (k) < hi)
#define SEAM(k) do { if (IN_PH(k) && IN_PH((k) + 1)) grid.sync(); } while (0)
#define WSL(w) unsigned char* w = a.ws; asm volatile("" : "+s"(w))
    if (IN_PH(0) && (PHM & 1)) { WSL(ws); init_rows(a, (float*)(ws + WS_H), (bf16*)(ws + WS_HB), (float*)(ws + WS_PART + P_HSSA)); conv_layer(a, 0, ws + WS_W, lds); __syncthreads(); }
    SEAM(0);
#pragma unroll 1
    for (int l = 0; l < DEPTH; ++l) {
        const int p = 1 + 6 * l;
        if (IN_PH(p) && (PHM & 2)) {
            WSL(ws); unsigned char* R = ws + WS_R; unsigned char* wb = ws + WS_W + (size_t)(l & 1) * WBUF;
            pg8::Gemm g{(const bf16*)(ws + WS_HB), (const bf16*)(wb + WL_IN), MROWS, INP, DM}; pg8::StaticOrder S; S.init(MROWS, INP, (int)gridDim.x, (int)blockIdx.x);
            pg8::EpiIn E{(const float*)(ws + WS_PART + P_HSSA), (bf16*)(R + R_QA), (bf16*)(R + R_KA), (bf16*)(R + R_VA), (bf16*)(R + R_QLAT), (bf16*)(R + R_KVLAT), (bf16*)(R + R_KR),
                         (float*)(ws + WS_PART + P_SSQQ), (float*)(ws + WS_PART + P_SSQKV)};
            pg8::gemm_phase<pg8::EpiIn, pg8::StaticOrder, true, true>(lds, g, S, E);
        }
        SEAM(p);
        if (IN_PH(p + 1) && (PHM & 4)) {
            { WSL(ws); unsigned char* R = ws + WS_R; unsigned char* wb = ws + WS_W + (size_t)(l & 1) * WBUF;
              pg8::Gemm g{(const bf16*)(R + R_QLAT), (const bf16*)(wb + WL_Q), MROWS, 768, 256}; pg8::StaticOrder S; S.init(MROWS, 768, (int)gridDim.x, (int)blockIdx.x);
              pg8::EpiQup E{(const float*)(ws + WS_PART + P_SSQQ), (bf16*)(R + R_QM)}; pg8::gemm_phase<pg8::EpiQup, pg8::StaticOrder, true, true>(lds, g, S, E); }
            { WSL(ws); unsigned char* R = ws + WS_R; unsigned char* wb = ws + WS_W + (size_t)(l & 1) * WBUF;
              pg8::Gemm g{(const bf16*)(R + R_KVLAT), (const bf16*)(wb + WL_KV), MROWS, 1024, 128}; pg8::StaticOrder S; S.init(MROWS, 1024, (int)gridDim.x, (int)blockIdx.x);
              pg8::EpiKvup E{(const float*)(ws + WS_PART + P_SSQKV), (bf16*)(R + R_KN), (bf16*)(R + R_VB)}; pg8::gemm_phase<pg8::EpiKvup, pg8::StaticOrder, true, true>(lds, g, S, E); }
        }
        SEAM(p + 1);
        if (IN_PH(p + 2) && (PHM & 8)) { WSL(ws); if (l + 1 < DEPTH) { conv_layer(a, l + 1, ws + WS_W + (size_t)((l + 1) & 1) * WBUF, lds); __syncthreads(); } attn_phase(a, l, ws, lds); }
        SEAM(p + 2);
        if (IN_PH(p + 3) && (PHM & 16)) {
            WSL(ws); unsigned char* R = ws + WS_R; unsigned char* wb = ws + WS_W + (size_t)(l & 1) * WBUF;
            pg8::Gemm g{(const bf16*)(R + R_O), (const bf16*)(wb + WL_O), MROWS, DM, DM}; pg8::StaticOrder S; S.init(MROWS, DM, (int)gridDim.x, (int)blockIdx.x);
            pg8::EpiOut E; E.H = (float*)(ws + WS_H); E.HB = (bf16*)(ws + WS_HB); E.hss_out = (float*)(ws + WS_PART + P_HSSB); E.ssq_o = (const float*)(ws + WS_PART + P_SSQO); E.xlds = lds + pg8::STAGE_BYTES;
            pg8::gemm_phase<pg8::EpiOut, pg8::StaticOrder, true, true>(lds, g, S, E);
        }
        SEAM(p + 3);
        if (IN_PH(p + 4) && (PHM & 32)) {
            WSL(ws); unsigned char* R = ws + WS_R; unsigned char* wb = ws + WS_W + (size_t)(l & 1) * WBUF;
            pg8::Gemm g{(const bf16*)(ws + WS_HB), (const bf16*)(wb + WL_GU), MROWS, GUP, DM}; pg8::StaticOrder S; S.init(MROWS, GUP, (int)gridDim.x, (int)blockIdx.x);
            pg8::EpiGU E{(const float*)(ws + WS_PART + P_HSSB), (bf16*)(R + R_ACT)};
            pg8::gemm_phase<pg8::EpiGU, pg8::StaticOrder, true, true>(lds, g, S, E);
        }
        SEAM(p + 4);
        if (IN_PH(p + 5) && (PHM & 64)) {
            WSL(ws); unsigned char* R = ws + WS_R; unsigned char* wb = ws + WS_W + (size_t)(l & 1) * WBUF;
            pg8::Gemm g{(const bf16*)(R + R_ACT), (const bf16*)(wb + WL_D), MROWS, DM, DFF}; pg8::StaticOrder S; S.init(MROWS, DM, (int)gridDim.x, (int)blockIdx.x);
            pg8::EpiDown E; E.H = (float*)(ws + WS_H); E.HB = (bf16*)(ws + WS_HB); E.hss_out = (float*)(ws + WS_PART + P_HSSA); E.ssq_o = nullptr;
            pg8::gemm_phase<pg8::EpiDown, pg8::StaticOrder, true, true>(lds, g, S, E);
        }
        SEAM(p + 5);
    }
    if (IN_PH(1 + 6 * DEPTH) && (PHM & 128)) { WSL(ws); final_rows(a, (const float*)(ws + WS_H), (const float*)(ws + WS_PART + P_HSSA)); }
#undef IN_PH
#undef SEAM
#undef WSL
}
constexpr int N_PHASES = 2 + 6 * DEPTH;

#ifndef MK_SPLIT
#define MK_SPLIT 0
#endif
extern "C" void kernel_launch(void* const* d_in, const int* in_sizes, int n_in, void* d_out, int out_size, void* d_ws, size_t ws_size, hipStream_t stream) {
    static int grid = 0;
    if (grid == 0) {
        if (n_in != 17 || ws_size < WS_END) { fprintf(stderr, "kernel_launch: need 17 inputs and >= %zu bytes of workspace; got n_in %d, ws %zu\n", (size_t)WS_END, n_in, ws_size); grid = -1; return; }
        int dev = 0, cus = 0, per_cu = 0;
        hipGetDevice(&dev); hipDeviceGetAttribute(&cus, hipDeviceAttributeMultiprocessorCount, dev);
        if (hipFuncSetAttribute((const void*)fwd_megakernel, hipFuncAttributeMaxDynamicSharedMemorySize, LDS_BYTES) != hipSuccess) { fprintf(stderr, "kernel_launch: hipFuncSetAttribute failed\n"); grid = -1; return; }
        if (hipOccupancyMaxActiveBlocksPerMultiprocessor(&per_cu, (const void*)fwd_megakernel, NTHREADS, LDS_BYTES) != hipSuccess || per_cu < 1) { fprintf(stderr, "kernel_launch: occupancy query says %d\n", per_cu); per_cu = 1; }
        (void)hipGetLastError();
        grid = cus * 1;
    }
    if (grid < 0) return;
    hipMemsetAsync((char*)d_ws + WS_CTL, 0, CTL_BYTES, stream);
    Args a{};
    const float** f = (const float**)&a;
    for (int i = 0; i < 17; ++i) f[i] = (const float*)d_in[i];
    a.out = (float*)d_out; a.ws = (unsigned char*)d_ws;
#if MK_SPLIT
    for (int ph = 0; ph < N_PHASES; ++ph) { a.ph_lo = ph; a.ph_hi = ph + 1; hipLaunchKernelGGL(fwd_megakernel, dim3(grid), dim3(NTHREADS), LDS_BYTES, stream, a); }
#else
    a.ph_lo = 0; a.ph_hi = N_PHASES;
    void* args[] = {&a};
    hipError_t e = hipLaunchCooperativeKernel((const void*)fwd_megakernel, dim3(grid), dim3(NTHREADS), args, LDS_BYTES, stream);
    if (e != hipSuccess) fprintf(stderr, "cooperative launch failed: %s (grid %d)\n", hipGetErrorString(e), grid);
#endif
}
```

```cpp
#include <hip/hip_runtime.h>
#include <hip/hip_cooperative_groups.h>
#include <cstdio>
#include <cstdint>
namespace cg = cooperative_groups;

constexpr int BATCH = 8, SEQ = 4096, DM = 1024, DEPTH = 4, NMETA = 16, FRONT = 112, TT = 4224;
constexpr int MROWS = BATCH * TT;
constexpr int INW = 1184, INP = 1280, DFF = 2816, GUP = 2 * DFF;
constexpr float RMS_EPS = 1e-6f;
constexpr float LOG2E = 1.4426950408889634f;
constexpr float LOG2_THETA = 13.287712379549449f;
constexpr float INV_2PI = 0.15915494309189535f;

namespace pg8 {
#define PG8_LAS __attribute__((address_space(3)))
typedef unsigned short bf16_t;
typedef short bf16x8 __attribute__((ext_vector_type(8)));
typedef float f32x4 __attribute__((ext_vector_type(4)));
typedef unsigned u32x4 __attribute__((ext_vector_type(4)));
constexpr int BM = 256, BK = 64, HALF = 128, HTB = HALF * BK * 2  , STAGE_BYTES = 8 * HTB, NXCD = 8, WGM = 8;

__host__ __device__ __forceinline__ int lds_byte(int r, int c) { const int st = (r >> 4) * 2 + (c >> 5), rr = r & 15, cc = c & 31, ob = rr * 64 + cc * 2; return st * 1024 + (ob ^ (((ob >> 9) & 1) << 5)); }
__host__ __device__ __forceinline__ void stage_rc(int b, int& R, int& C) { const int st = b / 1024, sb = b % 1024, swz = sb ^ (((sb >> 9) & 1) << 5); R = (st >> 1) * 16 + swz / 64; C = (st & 1) * 32 + (swz % 64) / 2; }
__host__ __device__ __forceinline__ int perm32(int rho) { const int n = rho >> 4, i = rho & 15; return 8 * (i >> 2) + 4 * n + (i & 3); }

struct Unit { int pm, pn; };
struct Gemm { const bf16_t* A; const bf16_t* Bt; int M, N, K; };

struct StaticOrder {
    int nM, nN, nwg, G, c;
    __host__ __device__ void init(int M, int N, int G_, int c_) { nM = M / BM; nN = N / BM; nwg = nM * nN; G = G_; c = c_; }
    __host__ __device__ bool next(int i, Unit& u) const {
        const long L = (long)i * G + c; if (L >= nwg) return false;
        int wgid = (int)L; { const int q = nwg / NXCD, r = nwg % NXCD, xcd = wgid % NXCD, off = wgid / NXCD; wgid = (xcd < r ? xcd * (q + 1) : r * (q + 1) + (xcd - r) * q) + off; }
        const int nig = WGM * nN, gid = wgid / nig, fm = gid * WGM, gsz = (nM - fm) < WGM ? (nM - fm) : WGM;
        u.pm = fm + ((wgid % nig) % gsz); u.pn = (wgid % nig) / gsz; return true;
    }
    __device__ __forceinline__ void a_ready(const Unit&) const {}
    __device__ __forceinline__ void done(const Unit&) const {}
};

__device__ __forceinline__ unsigned cvt_pk_bf16(float lo, float hi) { unsigned r; asm volatile("v_cvt_pk_bf16_f32 %0, %1, %2" : "=v"(r) : "v"(lo), "v"(hi)); return r; }

template <int NM, int NN> struct OrderCT {
    static_assert(NM % 8 == 0 || NM % 8 == 4, "last M group must be 8 or 4 tiles");
    int G, c;
    __device__ __forceinline__ void init(int G_, int c_) { G = G_; c = c_; }
    __device__ __forceinline__ bool next(int i, Unit& u) const {
        constexpr int nwg = NM * NN, q = nwg / NXCD, r = nwg % NXCD, nig = WGM * NN;
        const int L = i * G + c; if (L >= nwg) return false;
        const int xcd = L & (NXCD - 1), off = L >> 3;
        const int wgid = (xcd < r ? xcd * (q + 1) : r * (q + 1) + (xcd - r) * q) + off;
        const int gid = wgid / nig, rem = wgid - gid * nig, fm = gid * WGM;
        const int sh = (NM - fm) < WGM ? 2 : 3;
        u.pm = fm + (rem & ((1 << sh) - 1)); u.pn = rem >> sh; return true;
    }
    __device__ __forceinline__ void a_ready(const Unit&) const {}
    __device__ __forceinline__ void done(const Unit&) const {}
};
typedef unsigned u32x2 __attribute__((ext_vector_type(2)));
__device__ __forceinline__ void st_bf16x4(bf16_t* p, f32x4 v) { u32x2 w; w.x = cvt_pk_bf16(v[0], v[1]); w.y = cvt_pk_bf16(v[2], v[3]); *(u32x2*)p = w; }
__device__ __forceinline__ float sum16(const float* part, int row) {
    const f32x4* p = (const f32x4*)(part + (size_t)row * 16); const f32x4 a = p[0], b = p[1], c = p[2], d = p[3];
    return (((a.x + a.y) + (a.z + a.w)) + ((b.x + b.y) + (b.z + b.w))) + (((c.x + c.y) + (c.z + c.w)) + ((d.x + d.y) + (d.z + d.w)));
}
__device__ __forceinline__ float sum4(const float* part, int row) { const f32x4 a = *(const f32x4*)(part + (size_t)row * 4); return (a.x + a.y) + (a.z + a.w); }
__device__ __forceinline__ float rsq(float x) { return 1.0f / sqrtf(x); }
__device__ __forceinline__ float sq4(f32x4 v) { return (v[0] * v[0] + v[1] * v[1]) + (v[2] * v[2] + v[3] * v[3]); }
#define EPI_ROWS(ai, m) for (int ai = 0; ai < 2; ++ai) for (int m = 0; m < 4; ++m)
#define EPI_ROW(u, ai, m) ((u).pm * BM + (ai) * HALF + wr * 64 + (m) * 16 + fr)

struct EpiIn {
    static constexpr bool PERM = false, AFTER_DRAIN = false, MIDSCALE = false;
    const float* hss; bf16_t *qa, *ka, *va, *qlat, *kvlat, *kr; float *ssq_q, *ssq_kv;
    __device__ __forceinline__ void mid(f32x4 (&)[2][2][4][2], const Unit&, int, int, int, int) const {}
    __device__ __forceinline__ void operator()(const f32x4 (&acc)[2][2][4][2], const Unit& u, int wr, int wc, int fr, int fq) const {
        const int pn = u.pn;
        if (pn <= 2) {
            const bool is_kr = (pn == 2 && wc == 2);
            if (pn == 2 && (wc == 3)) return;
            float inv[2][4];
#pragma unroll
            for (int n = 0; n < 2; ++n)
#pragma unroll
                for (int e = 0; e < 4; ++e) inv[n][e] = is_kr ? __builtin_amdgcn_exp2f(-(float)(4 * fq + e) * (LOG2_THETA / 16.0f)) : __builtin_amdgcn_exp2f(-(float)(16 * n + 4 * fq + e) * (LOG2_THETA / 32.0f));
#pragma unroll
            for (int ai = 0; ai < 2; ++ai)
#pragma unroll
                for (int m = 0; m < 4; ++m) {
                    asm volatile("" ::: "memory"); const int row = EPI_ROW(u, ai, m); const float rs = rsq(sum16(hss, row) * (1.0f / DM) + RMS_EPS);
                    const float pos = (float)((row % TT) - FRONT);
#pragma unroll
                    for (int n = 0; n < 2; ++n) {
                        if (is_kr && n == 1) continue;
                        const f32x4 x1 = acc[ai][0][m][n] * rs, x2 = acc[ai][1][m][n] * rs; f32x4 o1, o2;
#pragma unroll
                        for (int e = 0; e < 4; ++e) { const float ang = pos * inv[n][e]; float rev = ang * INV_2PI; rev = rev - floorf(rev);
                            const float sn = __builtin_amdgcn_sinf(rev), cs = __builtin_amdgcn_cosf(rev); o1[e] = x1[e] * cs - x2[e] * sn; o2[e] = x2[e] * cs + x1[e] * sn; }
                        bf16_t* d; int half;
                        if (pn < 2) { d = qa + (size_t)row * 512 + (4 * pn + wc) * 64 + 16 * n + 4 * fq; half = 32; }
                        else if (!is_kr) { d = ka + (size_t)row * 128 + wc * 64 + 16 * n + 4 * fq; half = 32; }
                        else { d = kr + (size_t)row * 32 + 4 * fq; half = 16; }
                        st_bf16x4(d, o1); st_bf16x4(d + half, o2);
                    }
                }
        } else if (pn == 3) {
#pragma unroll
            for (int ai = 0; ai < 2; ++ai)
#pragma unroll
                for (int m = 0; m < 4; ++m) {
                    asm volatile("" ::: "memory"); const int row = EPI_ROW(u, ai, m); const float rs = rsq(sum16(hss, row) * (1.0f / DM) + RMS_EPS); float ss = 0.f;
#pragma unroll
                    for (int n = 0; n < 2; ++n) { const int c = 32 * wc + 16 * n + 4 * fq; const f32x4 v = acc[ai][0][m][n] * rs, w = acc[ai][1][m][n] * rs;
                        st_bf16x4(va + (size_t)row * 128 + c, v); st_bf16x4(kvlat + (size_t)row * 128 + c, w); ss += sq4(w); }
                    ss += __shfl_xor(ss, 16); ss += __shfl_xor(ss, 32);
                    if (fq == 0) ssq_kv[(size_t)row * 4 + wc] = ss;
                }
        } else {
#pragma unroll
            for (int ai = 0; ai < 2; ++ai)
#pragma unroll
                for (int m = 0; m < 4; ++m) {
                    asm volatile("" ::: "memory"); const int row = EPI_ROW(u, ai, m); const float rs = rsq(sum16(hss, row) * (1.0f / DM) + RMS_EPS); float ss = 0.f;
#pragma unroll
                    for (int bj = 0; bj < 2; ++bj)
#pragma unroll
                        for (int n = 0; n < 2; ++n) { const int c = 128 * bj + 32 * wc + 16 * n + 4 * fq; const f32x4 v = acc[ai][bj][m][n] * rs; st_bf16x4(qlat + (size_t)row * 256 + c, v); ss += sq4(v); }
                    ss += __shfl_xor(ss, 16); ss += __shfl_xor(ss, 32);
                    if (fq == 0) ssq_q[(size_t)row * 4 + wc] = ss;
                }
        }
    }
};

struct EpiQup {
    static constexpr bool PERM = false, AFTER_DRAIN = false, MIDSCALE = false;
    const float* ssq_q; bf16_t* qm;
    __device__ __forceinline__ void mid(f32x4 (&)[2][2][4][2], const Unit&, int, int, int, int) const {}
    __device__ __forceinline__ void operator()(const f32x4 (&acc)[2][2][4][2], const Unit& u, int wr, int wc, int fr, int fq) const {
        const int pn = u.pn;
        float inv[4];
#pragma unroll
        for (int e = 0; e < 4; ++e) inv[e] = __builtin_amdgcn_exp2f(-(float)(4 * fq + e) * (LOG2_THETA / 16.0f));
#pragma unroll
        for (int ai = 0; ai < 2; ++ai)
#pragma unroll
            for (int m = 0; m < 4; ++m) {
                asm volatile("" ::: "memory"); const int row = EPI_ROW(u, ai, m); const float rs = rsq(sum4(ssq_q, row) * (1.0f / 256.0f) + RMS_EPS);
                bf16_t* qrow = qm + (size_t)row * 768;
                if (pn < 2) {
#pragma unroll
                    for (int bj = 0; bj < 2; ++bj)
#pragma unroll
                        for (int n = 0; n < 2; ++n) { const int head = 4 * pn + 2 * bj + (wc >> 1), d = 32 * (wc & 1) + 16 * n + 4 * fq; st_bf16x4(qrow + head * 96 + d, acc[ai][bj][m][n] * rs); }
                } else {
                    const float pos = (float)((row % TT) - FRONT);
#pragma unroll
                    for (int n = 0; n < 2; ++n) { const int head = 2 * wc + n; const f32x4 x1 = acc[ai][0][m][n] * rs, x2 = acc[ai][1][m][n] * rs; f32x4 o1, o2;
#pragma unroll
                        for (int e = 0; e < 4; ++e) { const float ang = pos * inv[e]; float rev = ang * INV_2PI; rev = rev - floorf(rev);
                            const float sn = __builtin_amdgcn_sinf(rev), cs = __builtin_amdgcn_cosf(rev); o1[e] = x1[e] * cs - x2[e] * sn; o2[e] = x2[e] * cs + x1[e] * sn; }
                        st_bf16x4(qrow + head * 96 + 64 + 4 * fq, o1); st_bf16x4(qrow + head * 96 + 80 + 4 * fq, o2); }
                }
            }
    }
};

struct EpiKvup {
    static constexpr bool PERM = false, AFTER_DRAIN = false, MIDSCALE = false;
    const float* ssq_kv; bf16_t *kn, *vb;
    __device__ __forceinline__ void mid(f32x4 (&)[2][2][4][2], const Unit&, int, int, int, int) const {}
    __device__ __forceinline__ void operator()(const f32x4 (&acc)[2][2][4][2], const Unit& u, int wr, int wc, int fr, int fq) const {
        bf16_t* dst = (u.pn < 2 ? kn : vb) + (u.pn & 1) * 256;
#pragma unroll
        for (int ai = 0; ai < 2; ++ai)
#pragma unroll
            for (int m = 0; m < 4; ++m) {
                asm volatile("" ::: "memory"); const int row = EPI_ROW(u, ai, m); const float rs = rsq(sum4(ssq_kv, row) * (1.0f / 128.0f) + RMS_EPS);
#pragma unroll
                for (int bj = 0; bj < 2; ++bj)
#pragma unroll
                    for (int n = 0; n < 2; ++n) st_bf16x4(dst + (size_t)row * 512 + 128 * bj + 32 * wc + 16 * n + 4 * fq, acc[ai][bj][m][n] * rs);
            }
    }
};

struct EpiResid {
    static constexpr bool PERM = false, AFTER_DRAIN = false;
    float* H; bf16_t* HB; float* hss_out; const float* ssq_o;
    __device__ __forceinline__ void finish(const f32x4 (&acc)[2][2][4][2], const Unit& u, int wr, int wc, int fr, int fq, bool two, PG8_LAS unsigned char* xl = nullptr) const {
#pragma unroll
        for (int ai = 0; ai < 2; ++ai)
#pragma unroll
            for (int m = 0; m < 4; ++m) {
                asm volatile("" ::: "memory"); const int row = EPI_ROW(u, ai, m); float rs = 1.0f;
                if (two) rs = ((const PG8_LAS float*)(xl + (wr * 4 + wc) * 1024))[2 * (ai * 64 + m * 16 + fr) + 1];
                float ss = 0.f;
#pragma unroll
                for (int bj = 0; bj < 2; ++bj)
#pragma unroll
                    for (int n = 0; n < 2; ++n) { const size_t off = (size_t)row * DM + u.pn * BM + 128 * bj + 32 * wc + 16 * n + 4 * fq;
                        const f32x4 hv = *(const f32x4*)(H + off) + acc[ai][bj][m][n] * rs; *(f32x4*)(H + off) = hv; st_bf16x4(HB + off, hv); ss += sq4(hv); }
                ss += __shfl_xor(ss, 16); ss += __shfl_xor(ss, 32);
                if (fq == 0) hss_out[(size_t)row * 16 + 4 * u.pn + wc] = ss;
            }
    }
};
struct EpiOut : EpiResid {
    static constexpr bool MIDSCALE = true;
    PG8_LAS unsigned char* xlds;
    __device__ __forceinline__ void prep(const Unit& u, int wid, int wr, int lane) const {
        PG8_LAS float* tab = (PG8_LAS float*)(xlds + wid * 1024);
#pragma unroll
        for (int j = 0; j < 2; ++j) { const int idx = lane + 64 * j; const int row = u.pm * BM + (idx >> 6) * HALF + wr * 64 + (idx & 63);
            const f32x4* p = (const f32x4*)(ssq_o + (size_t)row * 16); const f32x4 a = p[0], b = p[1], c = p[2], d = p[3];
            const float sa = ((a.x + a.y) + (a.z + a.w)) + ((b.x + b.y) + (b.z + b.w)), sb = ((c.x + c.y) + (c.z + c.w)) + ((d.x + d.y) + (d.z + d.w));
            const float va = sa * (1.0f / 512.0f) + RMS_EPS, vb = sb * (1.0f / 512.0f) + RMS_EPS;
            tab[2 * idx] = sqrtf(vb / va); tab[2 * idx + 1] = rsq(vb); }
    }
    __device__ __forceinline__ void mid(f32x4 (&acc)[2][2][4][2], const Unit& u, int wr, int wc, int fr, int fq) const {
        const int wid = wr * 4 + wc; const PG8_LAS float* tab = (const PG8_LAS float*)(xlds + wid * 1024);
#pragma unroll
        for (int ai = 0; ai < 2; ++ai)
#pragma unroll
            for (int m = 0; m < 4; ++m) {
                const float f = tab[2 * (ai * 64 + m * 16 + fr)];
#pragma unroll
                for (int bj = 0; bj < 2; ++bj)
#pragma unroll
                    for (int n = 0; n < 2; ++n) acc[ai][bj][m][n] *= f;
            }
    }
    __device__ __forceinline__ void operator()(const f32x4 (&acc)[2][2][4][2], const Unit& u, int wr, int wc, int fr, int fq) const { finish(acc, u, wr, wc, fr, fq, true, xlds); }
};
struct EpiDown : EpiResid {
    static constexpr bool MIDSCALE = false;
    __device__ __forceinline__ void mid(f32x4 (&)[2][2][4][2], const Unit&, int, int, int, int) const {}
    __device__ __forceinline__ void operator()(const f32x4 (&acc)[2][2][4][2], const Unit& u, int wr, int wc, int fr, int fq) const { finish(acc, u, wr, wc, fr, fq, false); }
};

struct EpiGU {
    static constexpr bool PERM = false, AFTER_DRAIN = false, MIDSCALE = false;
    const float* hss; bf16_t* act;
    __device__ __forceinline__ void mid(f32x4 (&)[2][2][4][2], const Unit&, int, int, int, int) const {}
    __device__ __forceinline__ void operator()(const f32x4 (&acc)[2][2][4][2], const Unit& u, int wr, int wc, int fr, int fq) const {
#pragma unroll
        for (int ai = 0; ai < 2; ++ai)
#pragma unroll
            for (int m = 0; m < 4; ++m) {
                asm volatile("" ::: "memory"); const int row = EPI_ROW(u, ai, m); const float rs = rsq(sum16(hss, row) * (1.0f / DM) + RMS_EPS);
#pragma unroll
                for (int n = 0; n < 2; ++n) { const f32x4 g = acc[ai][0][m][n] * rs, up = acc[ai][1][m][n] * rs; f32x4 a;
#pragma unroll
                    for (int e = 0; e < 4; ++e) a[e] = g[e] * up[e] * __builtin_amdgcn_rcpf(1.0f + __builtin_amdgcn_exp2f(-g[e] * LOG2E));
                    st_bf16x4(act + (size_t)row * DFF + 128 * u.pn + 32 * wc + 16 * n + 4 * fq, a); }
            }
    }
};
template <class Epi, class Sched, bool ALIGN_EPI = false, bool SP2 = false>
__device__ __forceinline__ void gemm_phase(PG8_LAS unsigned char* lds, const Gemm g, const Sched& S, const Epi& E) {
    int tid_ = threadIdx.x; asm volatile("" : "+v"(tid_));
    const int tid = tid_, wid = __builtin_amdgcn_readfirstlane(tid >> 6), lane = tid & 63, wr = wid >> 2, wc = wid & 3, fr = lane & 15, fq = lane >> 4;
    int K_ = g.K; asm volatile("" : "+s"(K_)); const int K = K_, nt = K / BK;
    unsigned voffA[2], voffB[2];
#pragma unroll
    for (int i = 0; i < 2; ++i) { int R, C; stage_rc(tid * 16 + i * 8192, R, C); const int Rb = Epi::PERM ? ((R & ~31) + perm32(R & 31)) : R;
        voffA[i] = (unsigned)(R * K + C) * 2u; voffB[i] = (unsigned)(Rb * K + C) * 2u; }
    const size_t kstep = (size_t)(BK * 2);
    const size_t hstep = (size_t)HALF * K * 2;
    const size_t tstep = 2 * hstep;
    const unsigned ldsw = (unsigned)wid * 1024u;
    const int aoff = lds_byte(wr * 64 + fr, fq * 8), boff = lds_byte(wc * 32 + fr, fq * 8);
#define PG8_SA(b, h) (((b) * 2 + (h)) * HTB)
#define PG8_SB(b, h) ((4 + (b) * 2 + (h)) * HTB)
#define PG8_STAGE(bufoff, gbase, voff) do { _Pragma("unroll") for (int _i = 0; _i < 2; ++_i) \
        __builtin_amdgcn_global_load_lds((const unsigned*)((const char*)(gbase) + (voff)[_i]), (PG8_LAS unsigned*)(lds + (bufoff) + ldsw + _i * 8192), 16, 0, 0); } while (0)
#define PG8_LDA(dst, b, h) do { _Pragma("unroll") for (int m = 0; m < 4; ++m) _Pragma("unroll") for (int k = 0; k < 2; ++k) dst[m][k] = *(const PG8_LAS bf16x8*)(lds + PG8_SA(b, h) + aoff + m * 2048 + k * 1024); } while (0)
#define PG8_LDB(dst, b, h) do { _Pragma("unroll") for (int n = 0; n < 2; ++n) _Pragma("unroll") for (int k = 0; k < 2; ++k) dst[n][k] = *(const PG8_LAS bf16x8*)(lds + PG8_SB(b, h) + boff + n * 2048 + k * 1024); } while (0)
#define PG8_MMA(ai, bj, At, Bt) do { __builtin_amdgcn_s_setprio(1); _Pragma("unroll") for (int m = 0; m < 4; ++m) _Pragma("unroll") for (int n = 0; n < 2; ++n) _Pragma("unroll") for (int k = 0; k < 2; ++k) \
        acc[ai][bj][m][n] = __builtin_amdgcn_mfma_f32_16x16x32_bf16(Bt[n][k], At[m][k], acc[ai][bj][m][n], 0, 0, 0); __builtin_amdgcn_s_setprio(0); } while (0)
#define PG8_WAIT_V(n) asm volatile("s_waitcnt vmcnt(" #n ")" ::: "memory")
#define PG8_WAIT_L(n) asm volatile("s_waitcnt lgkmcnt(" #n ")" ::: "memory")
#define PG8_BAR __builtin_amdgcn_s_barrier()
#define PG8_SCHED __builtin_amdgcn_sched_barrier(0)
    Unit cur, nxt; int ui = 0;
    if (!S.next(0, cur)) return;
    f32x4 acc[2][2][4][2];
#pragma unroll
    for (int a = 0; a < 2; ++a)
#pragma unroll
        for (int b = 0; b < 2; ++b)
#pragma unroll
            for (int m = 0; m < 4; ++m)
#pragma unroll
                for (int n = 0; n < 2; ++n) acc[a][b][m][n] = (f32x4){0.f, 0.f, 0.f, 0.f};
    bf16x8 At[4][2], B0[2][2], B1[2][2];
    const char* cA = (const char*)g.A + (size_t)cur.pm * tstep; const char* cB = (const char*)g.Bt + (size_t)cur.pn * tstep;
    S.a_ready(cur);
    if constexpr (SP2) {
        PG8_STAGE(PG8_SB(0, 0), cB, voffB); PG8_STAGE(PG8_SB(0, 1), cB + hstep, voffB); PG8_STAGE(PG8_SA(0, 0), cA, voffA); PG8_STAGE(PG8_SA(0, 1), cA + hstep, voffA);
        if (wr == 1) PG8_BAR;
        PG8_WAIT_V(2); PG8_BAR;
        PG8_STAGE(PG8_SB(1, 0), cB + kstep, voffB); PG8_STAGE(PG8_SA(1, 0), cA + kstep, voffA); PG8_STAGE(PG8_SB(1, 1), cB + hstep + kstep, voffB);
        PG8_WAIT_V(6); PG8_BAR;
    } else {
        PG8_STAGE(PG8_SB(0, 0), cB, voffB); PG8_STAGE(PG8_SA(0, 0), cA, voffA); PG8_STAGE(PG8_SB(0, 1), cB + hstep, voffB); PG8_STAGE(PG8_SA(0, 1), cA + hstep, voffA);
        if (wr == 1) PG8_BAR;
        PG8_WAIT_V(4); PG8_BAR;
        PG8_STAGE(PG8_SB(1, 0), cB + kstep, voffB); PG8_STAGE(PG8_SA(1, 0), cA + kstep, voffA); PG8_STAGE(PG8_SB(1, 1), cB + hstep + kstep, voffB);
        PG8_WAIT_V(6); PG8_BAR;
    }
    for (;;) {
        const bool has_next = S.next(ui + 1, nxt);
        if constexpr (Epi::MIDSCALE) E.prep(cur, wid, wr, lane);
        const char* nA = has_next ? (const char*)g.A + (size_t)nxt.pm * tstep : cA; const char* nB = has_next ? (const char*)g.Bt + (size_t)nxt.pn * tstep : cB;
        for (int t = 0; t < nt; t += 2) {
            const bool last = (t == nt - 2);
            if constexpr (Epi::MIDSCALE) { if (t == (nt >> 1)) E.mid(acc, cur, wr, wc, fr, fq); }
            const char* a1 = cA + (size_t)(t + 1) * kstep;
            const char* a2 = last ? nA : cA + (size_t)(t + 2) * kstep; const char* b2 = last ? nB : cB + (size_t)(t + 2) * kstep;
            const char* a3 = a2 + kstep; const char* b3 = b2 + kstep;
            if (last && has_next) S.a_ready(nxt);
            if constexpr (SP2) {
            PG8_LDB(B0, 0, 0); PG8_LDB(B1, 0, 1); PG8_SCHED; PG8_LDA(At, 0, 0); PG8_STAGE(PG8_SA(1, 1), a1 + hstep, voffA);
            PG8_WAIT_V(8); PG8_WAIT_L(0); PG8_BAR; PG8_MMA(0, 0, At, B0); PG8_MMA(0, 1, At, B1); PG8_BAR; PG8_SCHED;
            PG8_LDA(At, 0, 1); PG8_STAGE(PG8_SB(0, 0), b2, voffB); PG8_STAGE(PG8_SB(0, 1), b2 + hstep, voffB); PG8_STAGE(PG8_SA(0, 0), a2, voffA);
            PG8_WAIT_V(8); PG8_WAIT_L(0); PG8_BAR; PG8_MMA(1, 0, At, B0); PG8_MMA(1, 1, At, B1); PG8_BAR; PG8_SCHED;
            PG8_LDB(B0, 1, 0); PG8_LDB(B1, 1, 1); PG8_SCHED; PG8_LDA(At, 1, 0); PG8_STAGE(PG8_SA(0, 1), a2 + hstep, voffA);
            PG8_WAIT_V(8); PG8_WAIT_L(0); PG8_BAR; PG8_MMA(0, 0, At, B0); PG8_MMA(0, 1, At, B1); PG8_BAR; PG8_SCHED;
            PG8_LDA(At, 1, 1); PG8_STAGE(PG8_SB(1, 0), b3, voffB); PG8_STAGE(PG8_SB(1, 1), b3 + hstep, voffB); PG8_STAGE(PG8_SA(1, 0), a3, voffA);
            PG8_WAIT_V(8); PG8_WAIT_L(0); PG8_BAR; PG8_MMA(1, 0, At, B0); PG8_MMA(1, 1, At, B1); PG8_BAR; PG8_SCHED;
            } else {
            PG8_LDB(B0, 0, 0); PG8_SCHED; PG8_LDA(At, 0, 0); PG8_STAGE(PG8_SA(1, 1), a1 + hstep, voffA);
            PG8_WAIT_L(8); PG8_BAR; PG8_WAIT_L(0); PG8_MMA(0, 0, At, B0); PG8_BAR; PG8_SCHED;
            PG8_LDB(B1, 0, 1); PG8_STAGE(PG8_SB(0, 0), b2, voffB);
            PG8_BAR; PG8_WAIT_L(0); PG8_MMA(0, 1, At, B1); PG8_BAR;
            PG8_LDA(At, 0, 1); PG8_STAGE(PG8_SA(0, 0), a2, voffA);
            PG8_BAR; PG8_WAIT_L(0); PG8_MMA(1, 0, At, B0); PG8_BAR; PG8_SCHED;
            PG8_STAGE(PG8_SB(0, 1), b2 + hstep, voffB);
            PG8_WAIT_V(6); PG8_BAR; PG8_MMA(1, 1, At, B1); PG8_BAR;
            PG8_LDB(B0, 1, 0); PG8_SCHED; PG8_LDA(At, 1, 0); PG8_STAGE(PG8_SA(0, 1), a2 + hstep, voffA);
            PG8_WAIT_L(8); PG8_BAR; PG8_WAIT_L(0); PG8_MMA(0, 0, At, B0); PG8_BAR; PG8_SCHED;
            PG8_LDB(B1, 1, 1); PG8_STAGE(PG8_SB(1, 0), b3, voffB);
            PG8_BAR; PG8_WAIT_L(0); PG8_MMA(0, 1, At, B1); PG8_BAR;
            PG8_LDA(At, 1, 1); PG8_STAGE(PG8_SA(1, 0), a3, voffA);
            PG8_BAR; PG8_WAIT_L(0); PG8_MMA(1, 0, At, B0); PG8_BAR; PG8_SCHED;
            PG8_STAGE(PG8_SB(1, 1), b3 + hstep, voffB);
            PG8_WAIT_V(6); PG8_BAR; PG8_MMA(1, 1, At, B1); PG8_BAR;
            }
        }
        if constexpr (ALIGN_EPI) { if (wr == 0) PG8_BAR; }
        if constexpr (!Epi::AFTER_DRAIN) { E(acc, cur, wr, wc, fr, fq); S.done(cur); }
        if (!has_next) break;
#pragma unroll
        for (int a = 0; a < 2; ++a)
#pragma unroll
            for (int b = 0; b < 2; ++b)
#pragma unroll
                for (int m = 0; m < 4; ++m)
#pragma unroll
                    for (int n = 0; n < 2; ++n) acc[a][b][m][n] = (f32x4){0.f, 0.f, 0.f, 0.f};
        cur = nxt; cA = nA; cB = nB; ++ui;
        if constexpr (ALIGN_EPI) { if (wr == 1) PG8_BAR; }
    }
    PG8_WAIT_V(0);
    if constexpr (!ALIGN_EPI) { if (wr == 0) PG8_BAR; }
    PG8_BAR;
    if constexpr (Epi::AFTER_DRAIN) { E.fused(acc, cur, wr, wc, fr, fq, lds, wid, lane); S.done(cur); }
#undef PG8_SA
#undef PG8_SB
#undef PG8_STAGE
#undef PG8_LDA
#undef PG8_LDB
#undef PG8_MMA
#undef PG8_WAIT_V
#undef PG8_WAIT_L
#undef PG8_BAR
#undef PG8_SCHED
}
}
namespace att {
#define ALAS __attribute__((address_space(3)))
typedef unsigned short bf16_t;
typedef short bf16x8 __attribute__((ext_vector_type(8)));
typedef short s16x4 __attribute__((ext_vector_type(4)));
typedef float f32x16 __attribute__((ext_vector_type(16)));
typedef unsigned u32x4 __attribute__((ext_vector_type(4)));
typedef float f32x2_t __attribute__((ext_vector_type(2))); typedef __bf16 bf16x2_t __attribute__((ext_vector_type(2)));
constexpr int KPMAX = 208, VP = 144, KSZ = 64 * KPMAX, VSZ = 64 * VP;
constexpr int OFF_V = 2 * KSZ, OFF_SCR = OFF_V + 2 * VSZ, OFF_Q = OFF_SCR + 8 * 256, LDS_BYTES = OFF_Q + 64;
constexpr float NEGF = -1e30f, THR = 6.0f;
__device__ __forceinline__ int crow(int r, int hi) { return (r & 3) + 8 * (r >> 2) + 4 * hi; }
__device__ __forceinline__ unsigned cvtpk(float lo, float hi) { f32x2_t v = {lo, hi}; bf16x2_t b = __builtin_convertvector(v, bf16x2_t); return __builtin_bit_cast(unsigned, b); }
__device__ __forceinline__ bf16x8 pack8(const f32x16& p, int s) { u32x4 w; w.x = cvtpk(p[8 * s], p[8 * s + 1]); w.y = cvtpk(p[8 * s + 2], p[8 * s + 3]); w.z = cvtpk(p[8 * s + 4], p[8 * s + 5]); w.w = cvtpk(p[8 * s + 6], p[8 * s + 7]); return __builtin_bit_cast(bf16x8, w); }
typedef short v4i16_t __attribute__((ext_vector_type(4)));
__device__ __forceinline__ s16x4 vtr(const ALAS unsigned char* p) { return __builtin_bit_cast(s16x4, __builtin_amdgcn_ds_read_tr16_b64_v4i16((ALAS v4i16_t*)p)); }
__device__ __forceinline__ unsigned short f2bf(float f) { unsigned u = __builtin_bit_cast(unsigned, f); return (unsigned short)((u + 0x7fffu + ((u >> 16) & 1u)) >> 16); }

template <int DQK, bool SWA>
__device__ __forceinline__ void attn_unit(ALAS unsigned char* lds, const bf16_t* Qp, int qpitch, const bf16_t* Kp, int kpitch, const bf16_t* Krp, const bf16_t* Vp, int vpitch,
                                          bf16_t* Op, float* ssq, float sink2, int b, int qb) {
    constexpr int KP = DQK * 2 + 16, NS = DQK / 16;
    int tid_ = threadIdx.x; asm volatile("" : "+v"(tid_));
    const int tid = tid_, lane = tid & 63, wid = __builtin_amdgcn_readfirstlane(tid >> 6), r = lane & 31, h = lane >> 5;
    const size_t rowbase = (size_t)b * TT;
    const int q0 = qb * 256, q0w = q0 + wid * 32;
    const bool wave_valid = q0w < TT;
    const int NT = (q0 + 256) / 64 < TT / 64 ? (q0 + 256) / 64 : TT / 64;
    int t0 = 1; if (SWA) { t0 = (q0 - 128) / 64; if (t0 < 1) t0 = 1; }
    ALAS float* scr = (ALAS float*)(lds + OFF_SCR + wid * 256);
    bf16x8 qf[NS];
    { const int qr = (q0w + r) < TT ? (q0w + r) : TT - 1; const bf16_t* qrow = Qp + (rowbase + qr) * (size_t)qpitch;
#pragma unroll
      for (int s = 0; s < NS; ++s) qf[s] = *(const bf16x8*)(qrow + 16 * s + 8 * h); }
    const int srow = tid >> 3, sch = tid & 7, rrow = (tid >> 2) & 63, rch = tid & 3;
    u32x4 kreg, vreg, rreg = {0u, 0u, 0u, 0u};
#define AT_GLOAD(t) do { const size_t kr_ = rowbase + 64 * (t) + srow; kreg = *(const u32x4*)(Kp + kr_ * (size_t)kpitch + sch * 8); vreg = *(const u32x4*)(Vp + kr_ * (size_t)vpitch + sch * 8); \
        if (DQK == 96) { if (tid < 256) rreg = *(const u32x4*)(Krp + (rowbase + 64 * (t) + rrow) * 32 + rch * 8); } } while (0)
#define AT_LSTORE(buf) do { *(ALAS u32x4*)(lds + (buf) * KSZ + srow * KP + sch * 16) = kreg; *(ALAS u32x4*)(lds + OFF_V + (buf) * VSZ + srow * VP + sch * 16) = vreg; \
        if (DQK == 96) { if (tid < 256) *(ALAS u32x4*)(lds + (buf) * KSZ + rrow * KP + 128 + rch * 16) = rreg; } } while (0)
    AT_GLOAD(t0); AT_LSTORE(0);
    __syncthreads();
    float mrun = SWA ? sink2 : NEGF, lrun = (SWA && h == 0) ? 1.0f : 0.0f;
    f32x16 o0, o1;
#pragma unroll
    for (int i = 0; i < 16; ++i) { o0[i] = 0.f; o1[i] = 0.f; }
    const int q = q0w + r;
    for (int t = t0; t < NT; ++t) {
        const int buf = (t - t0) & 1;
        if (t + 1 < NT) AT_GLOAD(t + 1);
        const int kfirst = 64 * t;
        bool active = wave_valid && (kfirst <= q0w + 31);
        if (SWA) active = active && (kfirst + 63 >= q0w - 127);
        if (active) {
            f32x16 s0, s1;
#pragma unroll
            for (int i = 0; i < 16; ++i) { s0[i] = 0.f; s1[i] = 0.f; }
            const ALAS unsigned char* kb = lds + buf * KSZ + r * KP + h * 16;
#pragma unroll
            for (int s = 0; s < NS; ++s) { const bf16x8 k0 = *(const ALAS bf16x8*)(kb + s * 32), k1 = *(const ALAS bf16x8*)(kb + 32 * KP + s * 32);
                s0 = __builtin_amdgcn_mfma_f32_32x32x16_bf16(k0, qf[s], s0, 0, 0, 0); s1 = __builtin_amdgcn_mfma_f32_32x32x16_bf16(k1, qf[s], s1, 0, 0, 0); }
            const bool need_mask = SWA || (t == 1) || (kfirst + 63 > q0w);
            if (need_mask) {
#pragma unroll
                for (int i = 0; i < 16; ++i) { const int key = kfirst + crow(i, h), key1 = key + 32;
                    bool ok0 = (key <= q) && (key >= FRONT), ok1 = (key1 <= q) && (key1 >= FRONT);
                    if (SWA) { ok0 = ok0 && (q - key < 128); ok1 = ok1 && (q - key1 < 128); }
                    s0[i] = ok0 ? s0[i] : NEGF; s1[i] = ok1 ? s1[i] : NEGF; }
            }
            float rm = fmaxf(s0[0], s1[0]);
#pragma unroll
            for (int i = 1; i < 16; ++i) rm = fmaxf(rm, fmaxf(s0[i], s1[i]));
            rm = fmaxf(rm, __shfl_xor(rm, 32));
            if (__any(rm > mrun + THR)) {
                const float mn = fmaxf(mrun, rm), f = __builtin_amdgcn_exp2f(mrun - mn); mrun = mn; lrun *= f;
                if (h == 0) scr[r] = f;
#pragma unroll
                for (int i = 0; i < 16; ++i) { const float fi = scr[crow(i, h)]; o0[i] *= fi; o1[i] *= fi; }
            }
            float ls = 0.f;
#pragma unroll
            for (int i = 0; i < 16; ++i) { s0[i] = __builtin_amdgcn_exp2f(s0[i] - mrun); s1[i] = __builtin_amdgcn_exp2f(s1[i] - mrun); ls += s0[i] + s1[i]; }
            lrun += ls;
            const bf16x8 p0 = pack8(s0, 0), p1 = pack8(s0, 1), p2 = pack8(s1, 0), p3 = pack8(s1, 1);
            const ALAS unsigned char* vb_ = lds + OFF_V + buf * VSZ + (4 * h + ((lane & 15) >> 2)) * VP + ((lane >> 4) & 1) * 32 + (lane & 3) * 8;
#define AT_PV(P, rowoff) do { \
                { const s16x4 lo = vtr(vb_ + (rowoff) * VP), hi = vtr(vb_ + ((rowoff) + 8) * VP); const bf16x8 vf = __builtin_shufflevector(lo, hi, 0, 1, 2, 3, 4, 5, 6, 7); o0 = __builtin_amdgcn_mfma_f32_32x32x16_bf16(P, vf, o0, 0, 0, 0); } \
                { const s16x4 lo = vtr(vb_ + (rowoff) * VP + 64), hi = vtr(vb_ + ((rowoff) + 8) * VP + 64); const bf16x8 vf = __builtin_shufflevector(lo, hi, 0, 1, 2, 3, 4, 5, 6, 7); o1 = __builtin_amdgcn_mfma_f32_32x32x16_bf16(P, vf, o1, 0, 0, 0); } } while (0)
            AT_PV(p0, 0); AT_PV(p1, 16); AT_PV(p2, 32); AT_PV(p3, 48);
#undef AT_PV
        }
        if (t + 1 < NT) AT_LSTORE(buf ^ 1);
        __syncthreads();
    }
#undef AT_GLOAD
#undef AT_LSTORE
    if (wave_valid) {
        const float lt = lrun + __shfl_xor(lrun, 32);
        if (h == 0) scr[32 + r] = lt;
#pragma unroll
        for (int i = 0; i < 16; ++i) {
            const float li = scr[32 + crow(i, h)], inv = li > 0.f ? 1.0f / li : 0.f;
            const float a = o0[i] * inv, c = o1[i] * inv; const size_t row = rowbase + q0w + crow(i, h);
            Op[row * 1024 + r] = f2bf(a); Op[row * 1024 + 32 + r] = f2bf(c);
            float ss = a * a + c * c;
            ss += __shfl_xor(ss, 1); ss += __shfl_xor(ss, 2); ss += __shfl_xor(ss, 4); ss += __shfl_xor(ss, 8); ss += __shfl_xor(ss, 16);
            if (r == 0) ssq[row * 16] = ss;
        }
    }
    __syncthreads();
}
}
typedef unsigned short bf16;
#define LAS __attribute__((address_space(3)))
constexpr size_t MiB = 1u << 20;
constexpr int NWAVES = 8, NTHREADS = 512;
constexpr int LDS_BYTES = 147456;
static_assert(att::LDS_BYTES <= 131072, "attention LDS");
constexpr size_t WS_CTL = 0, CTL_BYTES = 65536;
constexpr size_t WS_H = 1 * MiB;
constexpr size_t WS_HB = WS_H + (size_t)MROWS * DM * 4;
constexpr size_t WS_W = WS_HB + (size_t)MROWS * DM * 2;
constexpr size_t WL_IN = 0, WL_Q = WL_IN + (size_t)INP * DM * 2, WL_KV = WL_Q + (size_t)768 * 256 * 2, WL_O = WL_KV + (size_t)1024 * 128 * 2,
                 WL_GU = WL_O + (size_t)DM * DM * 2, WL_D = WL_GU + (size_t)GUP * DM * 2, WL_END = WL_D + (size_t)DM * DFF * 2;
constexpr size_t WBUF = 22 * MiB;
static_assert(WL_END <= WBUF, "weight buffer");
constexpr size_t WS_PART = WS_W + 2 * WBUF;
constexpr size_t P_HSSA = 0, P_HSSB = P_HSSA + (size_t)MROWS * 64, P_SSQO = P_HSSB + (size_t)MROWS * 64, P_SSQQ = P_SSQO + (size_t)MROWS * 64, P_SSQKV = P_SSQQ + (size_t)MROWS * 16, P_END = P_SSQKV + (size_t)MROWS * 16;
static_assert(P_END <= 8 * MiB, "partials");
constexpr size_t WS_R = WS_PART + 8 * MiB;
constexpr size_t R_QA = 0, R_KA = R_QA + (size_t)MROWS * 512 * 2, R_VA = R_KA + (size_t)MROWS * 128 * 2, R_QLAT = R_VA + (size_t)MROWS * 128 * 2, R_KVLAT = R_QLAT + (size_t)MROWS * 256 * 2,
                 R_KR = R_KVLAT + (size_t)MROWS * 128 * 2, R_QM = R_KR + (size_t)MROWS * 32 * 2, R_KN = R_QM + (size_t)MROWS * 768 * 2, R_VB = R_KN + (size_t)MROWS * 512 * 2,
                 R_O = R_VB + (size_t)MROWS * 512 * 2, R_END = R_O + (size_t)MROWS * 1024 * 2;
constexpr size_t R_ACT = 0;
static_assert((size_t)MROWS * DFF * 2 <= R_END, "act overlay");
constexpr size_t WS_END = WS_R + R_END;
static_assert(WS_END <= 512 * MiB, "workspace must fit 512 MiB");

struct Args {
    const float *x, *meta, *attn_norm, *w_in, *q_norm, *w_q_up, *kv_norm, *w_kv_up, *sinks, *out_norm_swa, *out_norm_mla, *w_o, *ffn_norm, *w_gate, *w_up, *w_down, *final_norm;
    float* out; unsigned char* ws; int ph_lo, ph_hi;
};

__device__ __forceinline__ unsigned f2bf_u(float f) { unsigned u = __builtin_bit_cast(unsigned, f); return (u + 0x7fffu + ((u >> 16) & 1u)) >> 16; }
__device__ __forceinline__ unsigned pk2(float lo, float hi) { return f2bf_u(lo) | (f2bf_u(hi) << 16); }
__device__ __forceinline__ float wave_sum(float v) {
#pragma unroll
    for (int o = 1; o < 64; o <<= 1) v += __shfl_xor(v, o);
    return v;
}

__device__ __forceinline__ int src_in(int np) { const int pn = np >> 8, bj = (np >> 7) & 1, o = np & 127;
    if (pn < 2) return (4 * pn + (o >> 5)) * 64 + (o & 31) + 32 * bj;
    if (pn == 2) { if (o < 64) return 512 + (o >> 5) * 64 + (o & 31) + 32 * bj; if (o < 80) return 1152 + (o - 64) + 16 * bj; return -1; }
    if (pn == 3) return bj ? 1024 + o : 640 + o;
    return 768 + 128 * bj + o; }
__device__ __forceinline__ int src_qup(int np) { const int pn = np >> 8, op = np & 255;
    if (pn < 2) return (4 * pn + (op >> 6)) * 96 + (op & 63);
    const int bj = op >> 7, o = op & 127; return (o >> 4) * 96 + 64 + (o & 15) + 16 * bj; }
__device__ __forceinline__ int src_kvup(int np) { const int pn = np >> 8, op = np & 255; return (4 * (pn & 1) + (op >> 6)) * 128 + (pn >= 2 ? 64 : 0) + (op & 63); }

template <int MODE>
__device__ __forceinline__ void conv_item(const float* W, const float* W2, const float* gain, const float* gain2, int K, int Nsrc, bf16* WT, LAS float* scr, int item, int nblk, int lane) {
    const int kb = item / nblk, nb = item % nblk, k0 = 64 * kb, n0 = 32 * nb;
    const int np = n0 + (lane & 31);
    int src; float cs = 1.0f; const float* Wp = W;
    if (MODE == 0) { src = src_in(np); if (np < 512) cs = 0.125f * LOG2E; }
    else if (MODE == 1) { src = src_qup(np); cs = 0.10206207261596577f * LOG2E; }
    else if (MODE == 2) src = src_kvup(np);
    else if (MODE == 4) { src = 128 * (np >> 8) + (np & 127); if ((np >> 7) & 1) Wp = W2; }
    else src = np;
#pragma unroll 8
    for (int i = 0; i < 32; ++i) { const int kk = 2 * i + (lane >> 5), k = k0 + kk;
        float g = 1.0f; if (MODE == 3) g = (k < 512) ? gain[k] : gain2[k - 512]; else if (MODE != 5) g = gain[k];
        scr[kk * 33 + (lane & 31)] = (src >= 0) ? Wp[(size_t)k * Nsrc + src] * g * cs : 0.0f; }
    asm volatile("s_waitcnt lgkmcnt(0)" ::: "memory");
    const int c = lane & 7;
#pragma unroll
    for (int j = 0; j < 4; ++j) { const int n = (lane >> 3) + 8 * j; const LAS float* s = scr + (8 * c) * 33 + n;
        pg8::u32x4 o; o.x = pk2(s[0 * 33], s[1 * 33]); o.y = pk2(s[2 * 33], s[3 * 33]); o.z = pk2(s[4 * 33], s[5 * 33]); o.w = pk2(s[6 * 33], s[7 * 33]);
        *(pg8::u32x4*)(WT + (size_t)(n0 + n) * K + k0 + 8 * c) = o; }
    asm volatile("s_waitcnt lgkmcnt(0)" ::: "memory");
}
__device__ __forceinline__ void conv_layer(const Args& a, int l, unsigned char* wbuf, LAS unsigned char* lds) {
    int tid_ = threadIdx.x; asm volatile("" : "+v"(tid_));
    const int lane = tid_ & 63, wave = tid_ >> 6;
    LAS float* scr = (LAS float*)(lds + wave * 16384);
    const int gw = blockIdx.x * NWAVES + wave, NGW = gridDim.x * NWAVES;
    constexpr int I0 = (DM / 64) * (INP / 32), I1 = (256 / 64) * (768 / 32), I2 = (128 / 64) * (1024 / 32), I3 = (DM / 64) * (DM / 32), I4 = (DM / 64) * (GUP / 32), I5 = (DFF / 64) * (DM / 32);
    constexpr int NIT = I0 + I1 + I2 + I3 + I4 + I5;
    for (int it = gw; it < NIT; it += NGW) {
        int r = it;
        if (r < I0) { conv_item<0>(a.w_in + (size_t)l * DM * INW, nullptr, a.attn_norm + l * DM, nullptr, DM, INW, (bf16*)(wbuf + WL_IN), scr, r, INP / 32, lane); continue; } r -= I0;
        if (r < I1) { conv_item<1>(a.w_q_up + (size_t)l * 256 * 768, nullptr, a.q_norm + l * 256, nullptr, 256, 768, (bf16*)(wbuf + WL_Q), scr, r, 768 / 32, lane); continue; } r -= I1;
        if (r < I2) { conv_item<2>(a.w_kv_up + (size_t)l * 128 * 1024, nullptr, a.kv_norm + l * 128, nullptr, 128, 1024, (bf16*)(wbuf + WL_KV), scr, r, 1024 / 32, lane); continue; } r -= I2;
        if (r < I3) { conv_item<3>(a.w_o + (size_t)l * DM * DM, nullptr, a.out_norm_swa + l * 512, a.out_norm_mla + l * 512, DM, DM, (bf16*)(wbuf + WL_O), scr, r, DM / 32, lane); continue; } r -= I3;
        if (r < I4) { conv_item<4>(a.w_gate + (size_t)l * DM * DFF, a.w_up + (size_t)l * DM * DFF, a.ffn_norm + l * DM, nullptr, DM, DFF, (bf16*)(wbuf + WL_GU), scr, r, GUP / 32, lane); continue; } r -= I4;
        conv_item<5>(a.w_down + (size_t)l * DFF * DM, nullptr, nullptr, nullptr, DFF, DM, (bf16*)(wbuf + WL_D), scr, r, DM / 32, lane);
    }
}

__device__ __forceinline__ void init_rows(const Args& a, float* H, bf16* HB, float* hss) {
    const int lane = threadIdx.x & 63, wave = threadIdx.x >> 6; const int gw = blockIdx.x * NWAVES + wave, NGW = gridDim.x * NWAVES;
    for (int row = gw; row < MROWS; row += NGW) {
        const int b = row / TT, t = row % TT;
        pg8::f32x4 v[4]; float s = 0.f;
        const float* src = (t < FRONT) ? nullptr : (t < FRONT + NMETA) ? a.meta + (size_t)(t - FRONT) * DM : a.x + ((size_t)b * SEQ + (t - FRONT - NMETA)) * DM;
#pragma unroll
        for (int j = 0; j < 4; ++j) { v[j] = src ? *((const pg8::f32x4*)src + lane + 64 * j) : (pg8::f32x4){0.f, 0.f, 0.f, 0.f}; s += pg8::sq4(v[j]); }
        s = wave_sum(s);
#pragma unroll
        for (int j = 0; j < 4; ++j) { *((pg8::f32x4*)(H + (size_t)row * DM) + lane + 64 * j) = v[j]; pg8::st_bf16x4(HB + (size_t)row * DM + 4 * (lane + 64 * j), v[j]); }
        if (lane < 16) hss[(size_t)row * 16 + lane] = (lane == 0) ? s : 0.f;
    }
}
__device__ __forceinline__ void final_rows(const Args& a, const float* H, const float* hss) {
    const int lane = threadIdx.x & 63, wave = threadIdx.x >> 6; const int gw = blockIdx.x * NWAVES + wave, NGW = gridDim.x * NWAVES;
    for (int o = gw; o < BATCH * SEQ; o += NGW) {
        const int b = o / SEQ, s = o % SEQ; const int row = b * TT + FRONT + NMETA + s;
        const float rs = pg8::rsq(pg8::sum16(hss, row) * (1.0f / DM) + RMS_EPS);
#pragma unroll
        for (int j = 0; j < 4; ++j) { const pg8::f32x4 v = *((const pg8::f32x4*)(H + (size_t)row * DM) + lane + 64 * j), g = *((const pg8::f32x4*)a.final_norm + lane + 64 * j);
            *((pg8::f32x4*)(a.out + (size_t)o * DM) + lane + 64 * j) = v * rs * g; }
    }
}

constexpr int N_ATT_UNITS = 2 * 17 * 64;
__device__ __forceinline__ void attn_phase(const Args& a, int l, unsigned char* ws, LAS unsigned char* lds) {
    unsigned* ctr = (unsigned*)(ws + WS_CTL) + 64 * l; l &= 3;
    unsigned char* R = ws + WS_R;
    const bf16 *QA = (const bf16*)(R + R_QA), *KA = (const bf16*)(R + R_KA), *VA = (const bf16*)(R + R_VA), *KR = (const bf16*)(R + R_KR), *QM = (const bf16*)(R + R_QM), *KN = (const bf16*)(R + R_KN), *VB = (const bf16*)(R + R_VB);
    bf16* O = (bf16*)(R + R_O); float* ssqO = (float*)(ws + WS_PART + P_SSQO);
    LAS int* qslot = (LAS int*)(lds + att::OFF_Q);
    for (;;) {
        if (threadIdx.x == 0) *qslot = (int)atomicAdd(ctr, 1u);
        __syncthreads();
        const int u = *qslot;
        __syncthreads();
        if (u >= N_ATT_UNITS) break;
        if (u < 17 * 64) {
            const int qb = 16 - u / 64, bh = u % 64, b = bh >> 3, hd = bh & 7;
            att::attn_unit<96, false>(lds, QM + hd * 96, 768, KN + hd * 64, 512, KR, VB + hd * 64, 512, O + 512 + hd * 64, ssqO + 8 + hd, 0.f, b, qb);
        } else {
            const int v = u - 17 * 64; const int qb = 16 - v / 64, bh = v % 64, b = bh >> 3, hq = bh & 7, kv = hq >> 2;
            att::attn_unit<64, true>(lds, QA + hq * 64, 512, KA + kv * 64, 128, nullptr, VA + kv * 64, 128, O + hq * 64, ssqO + hq, a.sinks[l * 8 + hq] * LOG2E, b, qb);
        }
    }
}

#define XB_TMO      128
#define XB_XCNT(j)  (256  + 64 * (j))
#define XB_XSUB(j)  (1280 + 64 * (j))
#define XB_XGEN(j)  (2304 + 64 * (j))
#define XB_TOP      3328
#define XB_TOPGEN   3392
#define XCD_BAR_WORDS 3456
#define XB_SPIN_CAP (1u << 18)

__device__ __forceinline__ unsigned xb_ld(unsigned* p)              { return __hip_atomic_load(p, __ATOMIC_RELAXED, __HIP_MEMORY_SCOPE_AGENT); }
__device__ __forceinline__ unsigned xb_add(unsigned* p, unsigned v) { return __hip_atomic_fetch_add(p, v, __ATOMIC_RELAXED, __HIP_MEMORY_SCOPE_AGENT); }
__device__ __forceinline__ unsigned xb_xcc_id() { return (unsigned)__builtin_amdgcn_s_getreg((3 << 11) | 20) & 0xFu; }
#define XB_SPIN(cond, bar) do { unsigned _sp = 0; while (cond) { __builtin_amdgcn_s_sleep(1); \
    if ((++_sp & 255u) == 0u) { if (xb_ld(&(bar)[XB_TMO])) break; if (_sp > XB_SPIN_CAP) { atomicAdd(&(bar)[XB_TMO], 1u); break; } } } } while (0)

struct XcdBarrier {
    unsigned* bar; unsigned x;
    volatile LAS unsigned* st;
};

__device__ __forceinline__ XcdBarrier xcd_barrier_post(unsigned* bar, volatile LAS unsigned* st) {
    XcdBarrier b; b.bar = bar; b.x = xb_xcc_id(); b.st = st;
    if (threadIdx.x == 0) (void)xb_add(&bar[XB_XCNT(b.x)], 1u);
    return b;
}
__device__ __forceinline__ void xcd_barrier_complete(unsigned* bar, unsigned x, unsigned& nloc, unsigned& nx) {
    const unsigned G = gridDim.x * gridDim.y * gridDim.z;
    unsigned sum, cnt, mine, sp = 0u;
    for (;;) {
        sum = 0u; cnt = 0u; mine = 0u;
#pragma unroll
        for (unsigned j = 0; j < 16; ++j) { const unsigned c = xb_ld(&bar[XB_XCNT(j)]); sum += c; cnt += (c > 0u) ? 1u : 0u; mine = (j == x) ? c : mine; }
        if (sum == G) break;
        __builtin_amdgcn_s_sleep(1);
        if ((++sp & 255u) == 0u) { if (xb_ld(&bar[XB_TMO])) break; if (sp > XB_SPIN_CAP) { atomicAdd(&bar[XB_TMO], 1u); break; } }
    }
    nloc = mine > 0u ? mine : 1u; nx = cnt > 0u ? cnt : 1u;
}

__device__ __forceinline__ void xcd_barrier(const XcdBarrier& b) {
    asm volatile("s_waitcnt vmcnt(0)" ::: "memory");
    __syncthreads();
    if (threadIdx.x == 0) {
        unsigned* bar = b.bar;
        __builtin_amdgcn_s_waitcnt(0);
        unsigned nloc = b.st[0], nx = b.st[1];
        if (nloc == 0u) { xcd_barrier_complete(bar, b.x, nloc, nx); b.st[0] = nloc; b.st[1] = nx; }
        const unsigned old = xb_add(&bar[XB_XSUB(b.x)], 1u);
        const unsigned gen = old / nloc;
        if (old + 1u == (gen + 1u) * nloc) {
            __builtin_amdgcn_fence(__ATOMIC_RELEASE, "agent");
            asm volatile("s_waitcnt vmcnt(0)" ::: "memory");
            const unsigned og = xb_add(&bar[XB_TOP], 1u);
            const unsigned tg = og / nx;
            if (og + 1u == (tg + 1u) * nx) xb_add(&bar[XB_TOPGEN], 1u);
            else XB_SPIN(xb_ld(&bar[XB_TOPGEN]) == tg, bar);
            __builtin_amdgcn_fence(__ATOMIC_ACQUIRE, "agent");
            xb_add(&bar[XB_XGEN(b.x)], 1u);
            asm volatile("s_waitcnt vmcnt(0)" ::: "memory");
        } else {
            XB_SPIN(xb_ld(&bar[XB_XGEN(b.x)]) == gen, bar);
            __builtin_amdgcn_fence(__ATOMIC_ACQUIRE, "agent");
            asm volatile("s_waitcnt vmcnt(0)" ::: "memory");
        }
    }
    __syncthreads();
}

constexpr int CW_BAR = 4096;
constexpr int XB_LDS_OFF = 131072 + 8192;
#ifndef PHM
#define PHM 255
#endif
#ifndef PROBE_DUP
#define PROBE_DUP 0
#endif
#ifndef PROBE_SYNC
#define PROBE_SYNC 0
#endif
__global__ void __launch_bounds__(NTHREADS, 2) fwd_megakernel(Args a) {
    extern __shared__ __attribute__((aligned(16))) unsigned char lds_raw[];
    LAS unsigned char* lds = (LAS unsigned char*)lds_raw;
    cg::grid_group grid = cg::this_grid();
    const int lo = a.ph_lo, hi = a.ph_hi;
    if (threadIdx.x < 2) ((LAS unsigned*)(lds + XB_LDS_OFF))[threadIdx.x] = 0u;
    __syncthreads();
    const XcdBarrier xbar = xcd_barrier_post((unsigned*)(a.ws + WS_CTL) + CW_BAR, (volatile LAS unsigned*)(lds + XB_LDS_OFF));
#define IN_PH(k) (lo <= (k) && (k) < hi)
#define SEAM(k) do { if (IN_PH(k) && IN_PH((k) + 1)) { if ((k) == 0) grid.sync(); else xcd_barrier(xbar); if (PROBE_SYNC) xcd_barrier(xbar); } } while (0)
#define WSL(w) unsigned char* w = a.ws; asm volatile("" : "+s"(w))
    if (IN_PH(0) && (PHM & 1)) { WSL(ws); init_rows(a, (float*)(ws + WS_H), (bf16*)(ws + WS_HB), (float*)(ws + WS_PART + P_HSSA)); conv_layer(a, 0, ws + WS_W, lds); __syncthreads(); }
    SEAM(0);
#pragma unroll 1
    for (int l = 0; l < DEPTH; ++l) {
        const int p = 1 + 6 * l;
        if (IN_PH(p) && (PHM & 2)) {
            WSL(ws); unsigned char* R = ws + WS_R; unsigned char* wb = ws + WS_W + (size_t)(l & 1) * WBUF;
            pg8::Gemm g{(const bf16*)(ws + WS_HB), (const bf16*)(wb + WL_IN), MROWS, INP, DM}; pg8::OrderCT<MROWS / 256, INP / 256> S; S.init((int)gridDim.x, (int)blockIdx.x);
            pg8::EpiIn E{(const float*)(ws + WS_PART + P_HSSA), (bf16*)(R + R_QA), (bf16*)(R + R_KA), (bf16*)(R + R_VA), (bf16*)(R + R_QLAT), (bf16*)(R + R_KVLAT), (bf16*)(R + R_KR),
                         (float*)(ws + WS_PART + P_SSQQ), (float*)(ws + WS_PART + P_SSQKV)};
            pg8::gemm_phase<pg8::EpiIn, pg8::OrderCT<MROWS / 256, INP / 256>, true, true>(lds, g, S, E);
            if (PROBE_DUP & 2) pg8::gemm_phase<pg8::EpiIn, pg8::OrderCT<MROWS / 256, INP / 256>, true, true>(lds, g, S, E);
        }
        SEAM(p);
        if (IN_PH(p + 1) && (PHM & 4)) {
            { WSL(ws); unsigned char* R = ws + WS_R; unsigned char* wb = ws + WS_W + (size_t)(l & 1) * WBUF;
              pg8::Gemm g{(const bf16*)(R + R_QLAT), (const bf16*)(wb + WL_Q), MROWS, 768, 256}; pg8::OrderCT<MROWS / 256, 3> S; S.init((int)gridDim.x, (int)blockIdx.x);
              pg8::EpiQup E{(const float*)(ws + WS_PART + P_SSQQ), (bf16*)(R + R_QM)}; pg8::gemm_phase<pg8::EpiQup, pg8::OrderCT<MROWS / 256, 3>, true, true>(lds, g, S, E); }
            { WSL(ws); unsigned char* R = ws + WS_R; unsigned char* wb = ws + WS_W + (size_t)(l & 1) * WBUF;
              pg8::Gemm g{(const bf16*)(R + R_KVLAT), (const bf16*)(wb + WL_KV), MROWS, 1024, 128}; pg8::OrderCT<MROWS / 256, 4> S; S.init((int)gridDim.x, (int)blockIdx.x);
              pg8::EpiKvup E{(const float*)(ws + WS_PART + P_SSQKV), (bf16*)(R + R_KN), (bf16*)(R + R_VB)}; pg8::gemm_phase<pg8::EpiKvup, pg8::OrderCT<MROWS / 256, 4>, true, true>(lds, g, S, E); }
        }
        SEAM(p + 1);
        if (IN_PH(p + 2) && (PHM & 8)) { WSL(ws); if (l + 1 < DEPTH) { conv_layer(a, l + 1, ws + WS_W + (size_t)((l + 1) & 1) * WBUF, lds); __syncthreads(); } attn_phase(a, l, ws, lds); if (PROBE_DUP & 8) attn_phase(a, l + 4, ws, lds); }
        SEAM(p + 2);
        if (IN_PH(p + 3) && (PHM & 16)) {
            WSL(ws); unsigned char* R = ws + WS_R; unsigned char* wb = ws + WS_W + (size_t)(l & 1) * WBUF;
            pg8::Gemm g{(const bf16*)(R + R_O), (const bf16*)(wb + WL_O), MROWS, DM, DM}; pg8::OrderCT<MROWS / 256, 4> S; S.init((int)gridDim.x, (int)blockIdx.x);
            pg8::EpiOut E; E.H = (float*)(ws + WS_H); E.HB = (bf16*)(ws + WS_HB); E.hss_out = (float*)(ws + WS_PART + P_HSSB); E.ssq_o = (const float*)(ws + WS_PART + P_SSQO); E.xlds = lds + pg8::STAGE_BYTES;
            pg8::gemm_phase<pg8::EpiOut, pg8::OrderCT<MROWS / 256, 4>, true, true>(lds, g, S, E);
        }
        SEAM(p + 3);
        if (IN_PH(p + 4) && (PHM & 32)) {
            WSL(ws); unsigned char* R = ws + WS_R; unsigned char* wb = ws + WS_W + (size_t)(l & 1) * WBUF;
            pg8::Gemm g{(const bf16*)(ws + WS_HB), (const bf16*)(wb + WL_GU), MROWS, GUP, DM}; pg8::OrderCT<MROWS / 256, GUP / 256> S; S.init((int)gridDim.x, (int)blockIdx.x);
            pg8::EpiGU E{(const float*)(ws + WS_PART + P_HSSB), (bf16*)(R + R_ACT)};
            pg8::gemm_phase<pg8::EpiGU, pg8::OrderCT<MROWS / 256, GUP / 256>, true, true>(lds, g, S, E);
            if (PROBE_DUP & 32) pg8::gemm_phase<pg8::EpiGU, pg8::OrderCT<MROWS / 256, GUP / 256>, true, true>(lds, g, S, E);
        }
        SEAM(p + 4);
        if (IN_PH(p + 5) && (PHM & 64)) {
            WSL(ws); unsigned char* R = ws + WS_R; unsigned char* wb = ws + WS_W + (size_t)(l & 1) * WBUF;
            pg8::Gemm g{(const bf16*)(R + R_ACT), (const bf16*)(wb + WL_D), MROWS, DM, DFF}; pg8::OrderCT<MROWS / 256, 4> S; S.init((int)gridDim.x, (int)blockIdx.x);
            pg8::EpiDown E; E.H = (float*)(ws + WS_H); E.HB = (bf16*)(ws + WS_HB); E.hss_out = (float*)(ws + WS_PART + P_HSSA); E.ssq_o = nullptr;
            pg8::gemm_phase<pg8::EpiDown, pg8::OrderCT<MROWS / 256, 4>, true, true>(lds, g, S, E);
        }
        SEAM(p + 5);
    }
    if (IN_PH(1 + 6 * DEPTH) && (PHM & 128)) { WSL(ws); final_rows(a, (const float*)(ws + WS_H), (const float*)(ws + WS_PART + P_HSSA)); }
#undef IN_PH
#undef SEAM
#undef WSL
}
constexpr int N_PHASES = 2 + 6 * DEPTH;

#ifndef MK_SPLIT
#define MK_SPLIT 0
#endif
extern "C" void kernel_launch(void* const* d_in, const int* in_sizes, int n_in, void* d_out, int out_size, void* d_ws, size_t ws_size, hipStream_t stream) {
    static int grid = 0;
    if (grid == 0) {
        if (n_in != 17 || ws_size < WS_END) { fprintf(stderr, "kernel_launch: need 17 inputs and >= %zu bytes of workspace; got n_in %d, ws %zu\n", (size_t)WS_END, n_in, ws_size); grid = -1; return; }
        int dev = 0, cus = 0, per_cu = 0;
        hipGetDevice(&dev); hipDeviceGetAttribute(&cus, hipDeviceAttributeMultiprocessorCount, dev);
        if (hipFuncSetAttribute((const void*)fwd_megakernel, hipFuncAttributeMaxDynamicSharedMemorySize, LDS_BYTES) != hipSuccess) { fprintf(stderr, "kernel_launch: hipFuncSetAttribute failed\n"); grid = -1; return; }
        if (hipOccupancyMaxActiveBlocksPerMultiprocessor(&per_cu, (const void*)fwd_megakernel, NTHREADS, LDS_BYTES) != hipSuccess || per_cu < 1) { fprintf(stderr, "kernel_launch: occupancy query says %d\n", per_cu); per_cu = 1; }
        (void)hipGetLastError();
        grid = cus * 1;
    }
    if (grid < 0) return;
    hipMemsetAsync((char*)d_ws + WS_CTL, 0, CTL_BYTES, stream);
    Args a{};
    const float** f = (const float**)&a;
    for (int i = 0; i < 17; ++i) f[i] = (const float*)d_in[i];
    a.out = (float*)d_out; a.ws = (unsigned char*)d_ws;
#if MK_SPLIT
    for (int ph = 0; ph < N_PHASES; ++ph) { a.ph_lo = ph; a.ph_hi = ph + 1; hipLaunchKernelGGL(fwd_megakernel, dim3(grid), dim3(NTHREADS), LDS_BYTES, stream, a); }
#else
    a.ph_lo = 0; a.ph_hi = N_PHASES;
    void* args[] = {&a};
    hipError_t e = hipLaunchCooperativeKernel((const void*)fwd_megakernel, dim3(grid), dim3(NTHREADS), args, LDS_BYTES, stream);
    if (e != hipSuccess) fprintf(stderr, "cooperative launch failed: %s (grid %d)\n", hipGetErrorString(e), grid);
#endif
}
```

```cpp
#include <hip/hip_runtime.h>
#include <hip/hip_cooperative_groups.h>
#include <cstdio>
#include <cstdint>
namespace cg = cooperative_groups;

constexpr int BATCH = 8, SEQ = 4096, DM = 1024, DEPTH = 4, NMETA = 16, FRONT = 112, TT = 4224;
constexpr int MROWS = BATCH * TT;
constexpr int INW = 1184, INP = 1280, DFF = 2816, GUP = 2 * DFF;
constexpr float RMS_EPS = 1e-6f;
constexpr float LOG2E = 1.4426950408889634f;
constexpr float LOG2_THETA = 13.287712379549449f;
constexpr float INV_2PI = 0.15915494309189535f;

namespace pg8 {
#define PG8_LAS __attribute__((address_space(3)))
typedef unsigned short bf16_t;
typedef short bf16x8 __attribute__((ext_vector_type(8)));
typedef float f32x4 __attribute__((ext_vector_type(4)));
typedef unsigned u32x4 __attribute__((ext_vector_type(4)));
constexpr int BM = 256, BK = 64, HALF = 128, HTB = HALF * BK * 2  , STAGE_BYTES = 8 * HTB, NXCD = 8, WGM = 8;

__host__ __device__ __forceinline__ int lds_byte(int r, int c) { const int st = (r >> 4) * 2 + (c >> 5), rr = r & 15, cc = c & 31, ob = rr * 64 + cc * 2; return st * 1024 + (ob ^ (((ob >> 9) & 1) << 5)); }
__host__ __device__ __forceinline__ void stage_rc(int b, int& R, int& C) { const int st = b / 1024, sb = b % 1024, swz = sb ^ (((sb >> 9) & 1) << 5); R = (st >> 1) * 16 + swz / 64; C = (st & 1) * 32 + (swz % 64) / 2; }
__host__ __device__ __forceinline__ int perm32(int rho) { const int n = rho >> 4, i = rho & 15; return 8 * (i >> 2) + 4 * n + (i & 3); }

struct Unit { int pm, pn; };
struct Gemm { const bf16_t* A; const bf16_t* Bt; int M, N, K; int apad; };

struct StaticOrder {
    int nM, nN, nwg, G, c;
    __host__ __device__ void init(int M, int N, int G_, int c_) { nM = M / BM; nN = N / BM; nwg = nM * nN; G = G_; c = c_; }
    __host__ __device__ bool next(int i, Unit& u) const {
        const long L = (long)i * G + c; if (L >= nwg) return false;
        int wgid = (int)L; { const int q = nwg / NXCD, r = nwg % NXCD, xcd = wgid % NXCD, off = wgid / NXCD; wgid = (xcd < r ? xcd * (q + 1) : r * (q + 1) + (xcd - r) * q) + off; }
        const int nig = WGM * nN, gid = wgid / nig, fm = gid * WGM, gsz = (nM - fm) < WGM ? (nM - fm) : WGM;
        u.pm = fm + ((wgid % nig) % gsz); u.pn = (wgid % nig) / gsz; return true;
    }
    __device__ __forceinline__ void a_ready(const Unit&) const {}
    __device__ __forceinline__ void done(const Unit&) const {}
};

__device__ __forceinline__ unsigned cvt_pk_bf16(float lo, float hi) { unsigned r; asm volatile("v_cvt_pk_bf16_f32 %0, %1, %2" : "=v"(r) : "v"(lo), "v"(hi)); return r; }

template <int NM, int NN> struct OrderCT {
    static_assert(NM % 8 == 0 || NM % 8 == 4, "last M group must be 8 or 4 tiles");
    int G, c;
    __device__ __forceinline__ void init(int G_, int c_) { G = G_; c = c_; }
    __device__ __forceinline__ bool next(int i, Unit& u) const {
        constexpr int nwg = NM * NN, q = nwg / NXCD, r = nwg % NXCD, nig = WGM * NN;
        const int L = i * G + c; if (L >= nwg) return false;
        const int xcd = L & (NXCD - 1), off = L >> 3;
        const int wgid = (xcd < r ? xcd * (q + 1) : r * (q + 1) + (xcd - r) * q) + off;
        const int gid = wgid / nig, rem = wgid - gid * nig, fm = gid * WGM;
        const int sh = (NM - fm) < WGM ? 2 : 3;
        u.pm = fm + (rem & ((1 << sh) - 1)); u.pn = rem >> sh; return true;
    }
    __device__ __forceinline__ void a_ready(const Unit&) const {}
    __device__ __forceinline__ void done(const Unit&) const {}
};
typedef unsigned u32x2 __attribute__((ext_vector_type(2)));
__device__ __forceinline__ void st_bf16x4(bf16_t* p, f32x4 v) { u32x2 w; w.x = cvt_pk_bf16(v[0], v[1]); w.y = cvt_pk_bf16(v[2], v[3]); *(u32x2*)p = w; }
__device__ __forceinline__ float sum16(const float* part, int row) {
    const f32x4* p = (const f32x4*)(part + (size_t)row * 16); const f32x4 a = p[0], b = p[1], c = p[2], d = p[3];
    return (((a.x + a.y) + (a.z + a.w)) + ((b.x + b.y) + (b.z + b.w))) + (((c.x + c.y) + (c.z + c.w)) + ((d.x + d.y) + (d.z + d.w)));
}
__device__ __forceinline__ float sum4(const float* part, int row) { const f32x4 a = *(const f32x4*)(part + (size_t)row * 4); return (a.x + a.y) + (a.z + a.w); }
__device__ __forceinline__ float rsq(float x) { return 1.0f / sqrtf(x); }
__device__ __forceinline__ float sq4(f32x4 v) { return (v[0] * v[0] + v[1] * v[1]) + (v[2] * v[2] + v[3] * v[3]); }
#define EPI_ROWS(ai, m) for (int ai = 0; ai < 2; ++ai) for (int m = 0; m < 4; ++m)
#define EPI_ROW(u, ai, m) ((u).pm * BM + (ai) * HALF + wr * 64 + (m) * 16 + fr)

__device__ __forceinline__ int prow_of(int m) { return m + (m >> 12) * 128 + 128; }
#define EPI_NB (META ? BATCH : 1)
#define EPI_PROW(row, b) (META ? (size_t)((b) * TT + FRONT + (row)) : (size_t)prow_of(row))
#define EPI_MAIN_LOOP(CALL) _Pragma("unroll") for (int ai = 0; ai < 2; ++ai) _Pragma("unroll") for (int m = 0; m < 4; ++m) { asm volatile("" ::: "memory"); const int row = EPI_ROW(u, ai, m); \
        const f32x4 a_[2][2] = {{acc[ai][0][m][0], acc[ai][0][m][1]}, {acc[ai][1][m][0], acc[ai][1][m][1]}}; CALL; }

template <bool META> struct EpiIn {
    static constexpr bool PERM = false, AFTER_DRAIN = false, MIDSCALE = false;
    const float* hss; bf16_t *qa, *ka, *va, *qlat, *kvlat, *kr; float *ssq_q, *ssq_kv;
    __device__ __forceinline__ void mid(f32x4 (&)[2][2][4][2], const Unit&, int, int, int, int) const {}
    __device__ __forceinline__ void row_epi(const f32x4 (&a)[2][2], int row, int pn, int wc, int fr, int fq) const {
        const float rs = rsq(sum16(hss, row) * (1.0f / DM) + RMS_EPS);
        if (pn <= 2) {
            const bool is_kr = (pn == 2 && wc == 2);
            if (pn == 2 && wc == 3) return;
            const float pos = META ? (float)row : (float)((row & 4095) + NMETA);
#pragma unroll
            for (int n = 0; n < 2; ++n) {
                if (is_kr && n == 1) continue;
                const f32x4 x1 = a[0][n] * rs, x2 = a[1][n] * rs; f32x4 o1, o2;
#pragma unroll
                for (int e = 0; e < 4; ++e) { const float inv = is_kr ? __builtin_amdgcn_exp2f(-(float)(4 * fq + e) * (LOG2_THETA / 16.0f)) : __builtin_amdgcn_exp2f(-(float)(16 * n + 4 * fq + e) * (LOG2_THETA / 32.0f));
                    const float ang = pos * inv; float rev = ang * INV_2PI; rev = rev - floorf(rev);
                    const float sn = __builtin_amdgcn_sinf(rev), cs = __builtin_amdgcn_cosf(rev); o1[e] = x1[e] * cs - x2[e] * sn; o2[e] = x2[e] * cs + x1[e] * sn; }
#pragma unroll
                for (int b = 0; b < EPI_NB; ++b) { const size_t pr = EPI_PROW(row, b); bf16_t* d; int half;
                    if (pn < 2) { d = qa + pr * 512 + (4 * pn + wc) * 64 + 16 * n + 4 * fq; half = 32; }
                    else if (!is_kr) { d = ka + pr * 128 + wc * 64 + 16 * n + 4 * fq; half = 32; }
                    else { d = kr + pr * 32 + 4 * fq; half = 16; }
                    st_bf16x4(d, o1); st_bf16x4(d + half, o2); }
            }
        } else if (pn == 3) {
            float ss = 0.f;
#pragma unroll
            for (int n = 0; n < 2; ++n) { const int c = 32 * wc + 16 * n + 4 * fq; const f32x4 v = a[0][n] * rs, w = a[1][n] * rs;
#pragma unroll
                for (int b = 0; b < EPI_NB; ++b) st_bf16x4(va + EPI_PROW(row, b) * 128 + c, v);
                st_bf16x4(kvlat + (size_t)row * 128 + c, w); ss += sq4(w); }
            ss += __shfl_xor(ss, 16); ss += __shfl_xor(ss, 32);
            if (fq == 0) ssq_kv[(size_t)row * 4 + wc] = ss;
        } else {
            float ss = 0.f;
#pragma unroll
            for (int bj = 0; bj < 2; ++bj)
#pragma unroll
                for (int n = 0; n < 2; ++n) { const int c = 128 * bj + 32 * wc + 16 * n + 4 * fq; const f32x4 v = a[bj][n] * rs; st_bf16x4(qlat + (size_t)row * 256 + c, v); ss += sq4(v); }
            ss += __shfl_xor(ss, 16); ss += __shfl_xor(ss, 32);
            if (fq == 0) ssq_q[(size_t)row * 4 + wc] = ss;
        }
    }
    __device__ __forceinline__ void operator()(const f32x4 (&acc)[2][2][4][2], const Unit& u, int wr, int wc, int fr, int fq) const { EPI_MAIN_LOOP(row_epi(a_, row, u.pn, wc, fr, fq)) }
};

template <bool META> struct EpiQup {
    static constexpr bool PERM = false, AFTER_DRAIN = false, MIDSCALE = false;
    const float* ssq_q; bf16_t* qm;
    __device__ __forceinline__ void mid(f32x4 (&)[2][2][4][2], const Unit&, int, int, int, int) const {}
    __device__ __forceinline__ void row_epi(const f32x4 (&a)[2][2], int row, int pn, int wc, int fr, int fq) const {
        const float rs = rsq(sum4(ssq_q, row) * (1.0f / 256.0f) + RMS_EPS);
        if (pn < 2) {
#pragma unroll
            for (int bj = 0; bj < 2; ++bj)
#pragma unroll
                for (int n = 0; n < 2; ++n) { const int head = 4 * pn + 2 * bj + (wc >> 1), d = 32 * (wc & 1) + 16 * n + 4 * fq; const f32x4 v = a[bj][n] * rs;
#pragma unroll
                    for (int b = 0; b < EPI_NB; ++b) st_bf16x4(qm + EPI_PROW(row, b) * 768 + head * 96 + d, v); }
        } else {
            const float pos = META ? (float)row : (float)((row & 4095) + NMETA);
#pragma unroll
            for (int n = 0; n < 2; ++n) { const int head = 2 * wc + n; const f32x4 x1 = a[0][n] * rs, x2 = a[1][n] * rs; f32x4 o1, o2;
#pragma unroll
                for (int e = 0; e < 4; ++e) { const float inv = __builtin_amdgcn_exp2f(-(float)(4 * fq + e) * (LOG2_THETA / 16.0f)); const float ang = pos * inv; float rev = ang * INV_2PI; rev = rev - floorf(rev);
                    const float sn = __builtin_amdgcn_sinf(rev), cs = __builtin_amdgcn_cosf(rev); o1[e] = x1[e] * cs - x2[e] * sn; o2[e] = x2[e] * cs + x1[e] * sn; }
#pragma unroll
                for (int b = 0; b < EPI_NB; ++b) { bf16_t* qrow = qm + EPI_PROW(row, b) * 768; st_bf16x4(qrow + head * 96 + 64 + 4 * fq, o1); st_bf16x4(qrow + head * 96 + 80 + 4 * fq, o2); } }
        }
    }
    __device__ __forceinline__ void operator()(const f32x4 (&acc)[2][2][4][2], const Unit& u, int wr, int wc, int fr, int fq) const { EPI_MAIN_LOOP(row_epi(a_, row, u.pn, wc, fr, fq)) }
};

template <bool META> struct EpiKvup {
    static constexpr bool PERM = false, AFTER_DRAIN = false, MIDSCALE = false;
    const float* ssq_kv; bf16_t *kn, *vb;
    __device__ __forceinline__ void mid(f32x4 (&)[2][2][4][2], const Unit&, int, int, int, int) const {}
    __device__ __forceinline__ void row_epi(const f32x4 (&a)[2][2], int row, int pn, int wc, int fr, int fq) const {
        bf16_t* dst = (pn < 2 ? kn : vb) + (pn & 1) * 256;
        const float rs = rsq(sum4(ssq_kv, row) * (1.0f / 128.0f) + RMS_EPS);
#pragma unroll
        for (int bj = 0; bj < 2; ++bj)
#pragma unroll
            for (int n = 0; n < 2; ++n) { const f32x4 v = a[bj][n] * rs;
#pragma unroll
                for (int b = 0; b < EPI_NB; ++b) st_bf16x4(dst + EPI_PROW(row, b) * 512 + 128 * bj + 32 * wc + 16 * n + 4 * fq, v); }
    }
    __device__ __forceinline__ void operator()(const f32x4 (&acc)[2][2][4][2], const Unit& u, int wr, int wc, int fr, int fq) const { EPI_MAIN_LOOP(row_epi(a_, row, u.pn, wc, fr, fq)) }
};

struct EpiResid {
    static constexpr bool PERM = false, AFTER_DRAIN = false;
    float* H; bf16_t* HB; float* hss_out; const float* ssq_o;
    __device__ __forceinline__ void resid_row(const f32x4 (&a)[2][2], int row, float rs, int pn, int wc, int fr, int fq) const {
        float ss = 0.f;
#pragma unroll
        for (int bj = 0; bj < 2; ++bj)
#pragma unroll
            for (int n = 0; n < 2; ++n) { const size_t off = (size_t)row * DM + pn * BM + 128 * bj + 32 * wc + 16 * n + 4 * fq;
                const f32x4 hv = *(const f32x4*)(H + off) + a[bj][n] * rs; *(f32x4*)(H + off) = hv; st_bf16x4(HB + off, hv); ss += sq4(hv); }
        ss += __shfl_xor(ss, 16); ss += __shfl_xor(ss, 32);
        if (fq == 0) hss_out[(size_t)row * 16 + 4 * pn + wc] = ss;
    }
    __device__ __forceinline__ void two_scales(size_t prow, float& f, float& rb) const {
        const f32x4* p = (const f32x4*)(ssq_o + prow * 16); const f32x4 a = p[0], b = p[1], c = p[2], d = p[3];
        const float sa = ((a.x + a.y) + (a.z + a.w)) + ((b.x + b.y) + (b.z + b.w)), sb = ((c.x + c.y) + (c.z + c.w)) + ((d.x + d.y) + (d.z + d.w));
        const float va = sa * (1.0f / 512.0f) + RMS_EPS, vb = sb * (1.0f / 512.0f) + RMS_EPS; f = sqrtf(vb / va); rb = rsq(vb);
    }
};
template <bool META> struct EpiOut : EpiResid {
    static constexpr bool MIDSCALE = true;
    PG8_LAS unsigned char* xlds;
    __device__ __forceinline__ void prep(const Unit& u, int wid, int wr, int lane) const {
        PG8_LAS float* tab = (PG8_LAS float*)(xlds + wid * 1024);
#pragma unroll
        for (int j = 0; j < 2; ++j) { const int idx = lane + 64 * j; const int row = u.pm * BM + (idx >> 6) * HALF + wr * 64 + (idx & 63);
            float f, rb; two_scales((size_t)prow_of(row), f, rb); tab[2 * idx] = f; tab[2 * idx + 1] = rb; }
    }
    __device__ __forceinline__ void mid(f32x4 (&acc)[2][2][4][2], const Unit& u, int wr, int wc, int fr, int fq) const {
        const int wid = wr * 4 + wc; const PG8_LAS float* tab = (const PG8_LAS float*)(xlds + wid * 1024);
#pragma unroll
        for (int ai = 0; ai < 2; ++ai)
#pragma unroll
            for (int m = 0; m < 4; ++m) {
                const float f = tab[2 * (ai * 64 + m * 16 + fr)];
#pragma unroll
                for (int bj = 0; bj < 2; ++bj)
#pragma unroll
                    for (int n = 0; n < 2; ++n) acc[ai][bj][m][n] *= f;
            }
    }
    __device__ __forceinline__ void operator()(const f32x4 (&acc)[2][2][4][2], const Unit& u, int wr, int wc, int fr, int fq) const {
        const PG8_LAS float* tab = (const PG8_LAS float*)(xlds + (wr * 4 + wc) * 1024);
        EPI_MAIN_LOOP(resid_row(a_, row, tab[2 * (ai * 64 + m * 16 + fr) + 1], u.pn, wc, fr, fq))
    }
    __device__ __forceinline__ void mid_row(f32x4 (&a)[2][2], int row) const { float f, rb; two_scales((size_t)(FRONT + row), f, rb);
#pragma unroll
        for (int bj = 0; bj < 2; ++bj)
#pragma unroll
            for (int n = 0; n < 2; ++n) a[bj][n] *= f; }
    __device__ __forceinline__ void row_epi(const f32x4 (&a)[2][2], int row, int pn, int wc, int fr, int fq) const { float f, rb; two_scales((size_t)(FRONT + row), f, rb); resid_row(a, row, rb, pn, wc, fr, fq); }
};
template <bool META> struct EpiDown : EpiResid {
    static constexpr bool MIDSCALE = false;
    __device__ __forceinline__ void mid(f32x4 (&)[2][2][4][2], const Unit&, int, int, int, int) const {}
    __device__ __forceinline__ void row_epi(const f32x4 (&a)[2][2], int row, int pn, int wc, int fr, int fq) const { resid_row(a, row, 1.0f, pn, wc, fr, fq); }
    __device__ __forceinline__ void operator()(const f32x4 (&acc)[2][2][4][2], const Unit& u, int wr, int wc, int fr, int fq) const { EPI_MAIN_LOOP(resid_row(a_, row, 1.0f, u.pn, wc, fr, fq)) }
};

template <bool META> struct EpiGU {
    static constexpr bool PERM = false, AFTER_DRAIN = false, MIDSCALE = false;
    const float* hss; bf16_t* act;
    __device__ __forceinline__ void mid(f32x4 (&)[2][2][4][2], const Unit&, int, int, int, int) const {}
    __device__ __forceinline__ void row_epi(const f32x4 (&a)[2][2], int row, int pn, int wc, int fr, int fq) const {
        const float rs = rsq(sum16(hss, row) * (1.0f / DM) + RMS_EPS);
#pragma unroll
        for (int n = 0; n < 2; ++n) { const f32x4 g = a[0][n] * rs, up = a[1][n] * rs; f32x4 o;
#pragma unroll
            for (int e = 0; e < 4; ++e) o[e] = g[e] * up[e] * __builtin_amdgcn_rcpf(1.0f + __builtin_amdgcn_exp2f(-g[e] * LOG2E));
            st_bf16x4(act + (size_t)row * DFF + 128 * pn + 32 * wc + 16 * n + 4 * fq, o); }
    }
    __device__ __forceinline__ void operator()(const f32x4 (&acc)[2][2][4][2], const Unit& u, int wr, int wc, int fr, int fq) const { EPI_MAIN_LOOP(row_epi(a_, row, u.pn, wc, fr, fq)) }
};

template <class Epi>
__device__ __forceinline__ void skinny_phase(PG8_LAS unsigned char* lds, const bf16_t* A16, const bf16_t* Bt, int K, int NN, const Epi& E) {
    int tid_ = threadIdx.x; asm volatile("" : "+v"(tid_));
    const int tid = tid_, lane = tid & 63, wid = __builtin_amdgcn_readfirstlane(tid >> 6), fr = lane & 15, fq = lane >> 4;
    const int nk = K / 32;
    for (int task = blockIdx.x; task < 4 * NN; task += gridDim.x) {
        const int pn = task >> 2, wc = task & 3;
        f32x4 a[2][2];
#pragma unroll
        for (int bj = 0; bj < 2; ++bj)
#pragma unroll
            for (int n = 0; n < 2; ++n) a[bj][n] = (f32x4){0.f, 0.f, 0.f, 0.f};
        bool scaled = false;
        for (int it = wid; it < nk; it += 8) {
            const int k0 = 32 * it;
            if constexpr (Epi::MIDSCALE) { if (!scaled && k0 >= (K >> 1)) { E.mid_row(a, fr); scaled = true; } }
            const bf16x8 av = *(const bf16x8*)(A16 + (size_t)fr * K + k0 + 8 * fq);
#pragma unroll
            for (int bj = 0; bj < 2; ++bj)
#pragma unroll
                for (int n = 0; n < 2; ++n) { const bf16x8 bv = *(const bf16x8*)(Bt + (size_t)(256 * pn + 128 * bj + 32 * wc + 16 * n + fr) * K + k0 + 8 * fq);
                    a[bj][n] = __builtin_amdgcn_mfma_f32_16x16x32_bf16(bv, av, a[bj][n], 0, 0, 0); }
        }
        if constexpr (Epi::MIDSCALE) { if (!scaled) E.mid_row(a, fr); }
        PG8_LAS f32x4* red = (PG8_LAS f32x4*)lds;
#pragma unroll
        for (int bj = 0; bj < 2; ++bj)
#pragma unroll
            for (int n = 0; n < 2; ++n) red[(wid * 64 + lane) * 4 + bj * 2 + n] = a[bj][n];
        __syncthreads();
        if (wid == 0) {
#pragma unroll
            for (int w = 1; w < 8; ++w)
#pragma unroll
                for (int bj = 0; bj < 2; ++bj)
#pragma unroll
                    for (int n = 0; n < 2; ++n) a[bj][n] += red[(w * 64 + lane) * 4 + bj * 2 + n];
            E.row_epi(a, fr, pn, wc, fr, fq);
        }
        __syncthreads();
    }
}
template <class Epi, class Sched, bool ALIGN_EPI = false, bool SP2 = false>
__device__ __forceinline__ void gemm_phase(PG8_LAS unsigned char* lds, const Gemm g, const Sched& S, const Epi& E) {
    int tid_ = threadIdx.x; asm volatile("" : "+v"(tid_));
    const int tid = tid_, wid = __builtin_amdgcn_readfirstlane(tid >> 6), lane = tid & 63, wr = wid >> 2, wc = wid & 3, fr = lane & 15, fq = lane >> 4;
    int K_ = g.K; asm volatile("" : "+s"(K_)); const int K = K_, nt = K / BK;
    unsigned voffA[2], voffB[2];
#pragma unroll
    for (int i = 0; i < 2; ++i) { int R, C; stage_rc(tid * 16 + i * 8192, R, C); const int Rb = Epi::PERM ? ((R & ~31) + perm32(R & 31)) : R;
        voffA[i] = (unsigned)(R * K + C) * 2u; voffB[i] = (unsigned)(Rb * K + C) * 2u; }
    const size_t kstep = (size_t)(BK * 2);
    const size_t hstep = (size_t)HALF * K * 2;
    const size_t tstep = 2 * hstep;
    const unsigned ldsw = (unsigned)wid * 1024u;
    const int aoff = lds_byte(wr * 64 + fr, fq * 8), boff = lds_byte(wc * 32 + fr, fq * 8);
#define PG8_SA(b, h) (((b) * 2 + (h)) * HTB)
#define PG8_SB(b, h) ((4 + (b) * 2 + (h)) * HTB)
#define PG8_STAGE(bufoff, gbase, voff) do { _Pragma("unroll") for (int _i = 0; _i < 2; ++_i) \
        __builtin_amdgcn_global_load_lds((const unsigned*)((const char*)(gbase) + (voff)[_i]), (PG8_LAS unsigned*)(lds + (bufoff) + ldsw + _i * 8192), 16, 0, 0); } while (0)
#define PG8_LDA(dst, b, h) do { _Pragma("unroll") for (int m = 0; m < 4; ++m) _Pragma("unroll") for (int k = 0; k < 2; ++k) dst[m][k] = *(const PG8_LAS bf16x8*)(lds + PG8_SA(b, h) + aoff + m * 2048 + k * 1024); } while (0)
#define PG8_LDB(dst, b, h) do { _Pragma("unroll") for (int n = 0; n < 2; ++n) _Pragma("unroll") for (int k = 0; k < 2; ++k) dst[n][k] = *(const PG8_LAS bf16x8*)(lds + PG8_SB(b, h) + boff + n * 2048 + k * 1024); } while (0)
#define PG8_MMA(ai, bj, At, Bt) do { __builtin_amdgcn_s_setprio(1); _Pragma("unroll") for (int m = 0; m < 4; ++m) _Pragma("unroll") for (int n = 0; n < 2; ++n) _Pragma("unroll") for (int k = 0; k < 2; ++k) \
        acc[ai][bj][m][n] = __builtin_amdgcn_mfma_f32_16x16x32_bf16(Bt[n][k], At[m][k], acc[ai][bj][m][n], 0, 0, 0); __builtin_amdgcn_s_setprio(0); } while (0)
#define PG8_WAIT_V(n) asm volatile("s_waitcnt vmcnt(" #n ")" ::: "memory")
#define PG8_WAIT_L(n) asm volatile("s_waitcnt lgkmcnt(" #n ")" ::: "memory")
#define PG8_BAR __builtin_amdgcn_s_barrier()
#define PG8_SCHED __builtin_amdgcn_sched_barrier(0)
    Unit cur, nxt; int ui = 0;
    if (!S.next(0, cur)) return;
    f32x4 acc[2][2][4][2];
#pragma unroll
    for (int a = 0; a < 2; ++a)
#pragma unroll
        for (int b = 0; b < 2; ++b)
#pragma unroll
            for (int m = 0; m < 4; ++m)
#pragma unroll
                for (int n = 0; n < 2; ++n) acc[a][b][m][n] = (f32x4){0.f, 0.f, 0.f, 0.f};
    bf16x8 At[4][2], B0[2][2], B1[2][2];
    const char* cA = (const char*)g.A + (size_t)cur.pm * tstep + (g.apad ? (size_t)((cur.pm >> 4) * 128 + 128) * (size_t)K * 2 : (size_t)0); const char* cB = (const char*)g.Bt + (size_t)cur.pn * tstep;
    S.a_ready(cur);
    if constexpr (SP2) {
        PG8_STAGE(PG8_SB(0, 0), cB, voffB); PG8_STAGE(PG8_SB(0, 1), cB + hstep, voffB); PG8_STAGE(PG8_SA(0, 0), cA, voffA); PG8_STAGE(PG8_SA(0, 1), cA + hstep, voffA);
        if (wr == 1) PG8_BAR;
        PG8_WAIT_V(2); PG8_BAR;
        PG8_STAGE(PG8_SB(1, 0), cB + kstep, voffB); PG8_STAGE(PG8_SA(1, 0), cA + kstep, voffA); PG8_STAGE(PG8_SB(1, 1), cB + hstep + kstep, voffB);
        PG8_WAIT_V(6); PG8_BAR;
    } else {
        PG8_STAGE(PG8_SB(0, 0), cB, voffB); PG8_STAGE(PG8_SA(0, 0), cA, voffA); PG8_STAGE(PG8_SB(0, 1), cB + hstep, voffB); PG8_STAGE(PG8_SA(0, 1), cA + hstep, voffA);
        if (wr == 1) PG8_BAR;
        PG8_WAIT_V(4); PG8_BAR;
        PG8_STAGE(PG8_SB(1, 0), cB + kstep, voffB); PG8_STAGE(PG8_SA(1, 0), cA + kstep, voffA); PG8_STAGE(PG8_SB(1, 1), cB + hstep + kstep, voffB);
        PG8_WAIT_V(6); PG8_BAR;
    }
    for (;;) {
        const bool has_next = S.next(ui + 1, nxt);
        if constexpr (Epi::MIDSCALE) E.prep(cur, wid, wr, lane);
        const char* nA = has_next ? (const char*)g.A + (size_t)nxt.pm * tstep + (g.apad ? (size_t)((nxt.pm >> 4) * 128 + 128) * (size_t)K * 2 : (size_t)0) : cA; const char* nB = has_next ? (const char*)g.Bt + (size_t)nxt.pn * tstep : cB;
        for (int t = 0; t < nt; t += 2) {
            const bool last = (t == nt - 2);
            if constexpr (Epi::MIDSCALE) { if (t == (nt >> 1)) E.mid(acc, cur, wr, wc, fr, fq); }
            const char* a1 = cA + (size_t)(t + 1) * kstep;
            const char* a2 = last ? nA : cA + (size_t)(t + 2) * kstep; const char* b2 = last ? nB : cB + (size_t)(t + 2) * kstep;
            const char* a3 = a2 + kstep; const char* b3 = b2 + kstep;
            if (last && has_next) S.a_ready(nxt);
            if constexpr (SP2) {
            PG8_LDB(B0, 0, 0); PG8_LDB(B1, 0, 1); PG8_SCHED; PG8_LDA(At, 0, 0); PG8_STAGE(PG8_SA(1, 1), a1 + hstep, voffA);
            PG8_WAIT_V(8); PG8_WAIT_L(0); PG8_BAR; PG8_MMA(0, 0, At, B0); PG8_MMA(0, 1, At, B1); PG8_BAR; PG8_SCHED;
            PG8_LDA(At, 0, 1); PG8_STAGE(PG8_SB(0, 0), b2, voffB); PG8_STAGE(PG8_SB(0, 1), b2 + hstep, voffB); PG8_STAGE(PG8_SA(0, 0), a2, voffA);
            PG8_WAIT_V(8); PG8_WAIT_L(0); PG8_BAR; PG8_MMA(1, 0, At, B0); PG8_MMA(1, 1, At, B1); PG8_BAR; PG8_SCHED;
            PG8_LDB(B0, 1, 0); PG8_LDB(B1, 1, 1); PG8_SCHED; PG8_LDA(At, 1, 0); PG8_STAGE(PG8_SA(0, 1), a2 + hstep, voffA);
            PG8_WAIT_V(8); PG8_WAIT_L(0); PG8_BAR; PG8_MMA(0, 0, At, B0); PG8_MMA(0, 1, At, B1); PG8_BAR; PG8_SCHED;
            PG8_LDA(At, 1, 1); PG8_STAGE(PG8_SB(1, 0), b3, voffB); PG8_STAGE(PG8_SB(1, 1), b3 + hstep, voffB); PG8_STAGE(PG8_SA(1, 0), a3, voffA);
            PG8_WAIT_V(8); PG8_WAIT_L(0); PG8_BAR; PG8_MMA(1, 0, At, B0); PG8_MMA(1, 1, At, B1); PG8_BAR; PG8_SCHED;
            } else {
            PG8_LDB(B0, 0, 0); PG8_SCHED; PG8_LDA(At, 0, 0); PG8_STAGE(PG8_SA(1, 1), a1 + hstep, voffA);
            PG8_WAIT_L(8); PG8_BAR; PG8_WAIT_L(0); PG8_MMA(0, 0, At, B0); PG8_BAR; PG8_SCHED;
            PG8_LDB(B1, 0, 1); PG8_STAGE(PG8_SB(0, 0), b2, voffB);
            PG8_BAR; PG8_WAIT_L(0); PG8_MMA(0, 1, At, B1); PG8_BAR;
            PG8_LDA(At, 0, 1); PG8_STAGE(PG8_SA(0, 0), a2, voffA);
            PG8_BAR; PG8_WAIT_L(0); PG8_MMA(1, 0, At, B0); PG8_BAR; PG8_SCHED;
            PG8_STAGE(PG8_SB(0, 1), b2 + hstep, voffB);
            PG8_WAIT_V(6); PG8_BAR; PG8_MMA(1, 1, At, B1); PG8_BAR;
            PG8_LDB(B0, 1, 0); PG8_SCHED; PG8_LDA(At, 1, 0); PG8_STAGE(PG8_SA(0, 1), a2 + hstep, voffA);
            PG8_WAIT_L(8); PG8_BAR; PG8_WAIT_L(0); PG8_MMA(0, 0, At, B0); PG8_BAR; PG8_SCHED;
            PG8_LDB(B1, 1, 1); PG8_STAGE(PG8_SB(1, 0), b3, voffB);
            PG8_BAR; PG8_WAIT_L(0); PG8_MMA(0, 1, At, B1); PG8_BAR;
            PG8_LDA(At, 1, 1); PG8_STAGE(PG8_SA(1, 0), a3, voffA);
            PG8_BAR; PG8_WAIT_L(0); PG8_MMA(1, 0, At, B0); PG8_BAR; PG8_SCHED;
            PG8_STAGE(PG8_SB(1, 1), b3 + hstep, voffB);
            PG8_WAIT_V(6); PG8_BAR; PG8_MMA(1, 1, At, B1); PG8_BAR;
            }
        }
        if constexpr (ALIGN_EPI) { if (wr == 0) PG8_BAR; }
        if constexpr (!Epi::AFTER_DRAIN) { E(acc, cur, wr, wc, fr, fq); S.done(cur); }
        if (!has_next) break;
#pragma unroll
        for (int a = 0; a < 2; ++a)
#pragma unroll
            for (int b = 0; b < 2; ++b)
#pragma unroll
                for (int m = 0; m < 4; ++m)
#pragma unroll
                    for (int n = 0; n < 2; ++n) acc[a][b][m][n] = (f32x4){0.f, 0.f, 0.f, 0.f};
        cur = nxt; cA = nA; cB = nB; ++ui;
        if constexpr (ALIGN_EPI) { if (wr == 1) PG8_BAR; }
    }
    PG8_WAIT_V(0);
    if constexpr (!ALIGN_EPI) { if (wr == 0) PG8_BAR; }
    PG8_BAR;
    if constexpr (Epi::AFTER_DRAIN) { E.fused(acc, cur, wr, wc, fr, fq, lds, wid, lane); S.done(cur); }
#undef PG8_SA
#undef PG8_SB
#undef PG8_STAGE
#undef PG8_LDA
#undef PG8_LDB
#undef PG8_MMA
#undef PG8_WAIT_V
#undef PG8_WAIT_L
#undef PG8_BAR
#undef PG8_SCHED
}
}
namespace att {
#define ALAS __attribute__((address_space(3)))
typedef unsigned short bf16_t;
typedef short bf16x8 __attribute__((ext_vector_type(8)));
typedef short s16x4 __attribute__((ext_vector_type(4)));
typedef float f32x16 __attribute__((ext_vector_type(16)));
typedef unsigned u32x4 __attribute__((ext_vector_type(4)));
typedef float f32x2_t __attribute__((ext_vector_type(2))); typedef __bf16 bf16x2_t __attribute__((ext_vector_type(2)));
constexpr int KPMAX = 208, VP = 144, KSZ = 64 * KPMAX, VSZ = 64 * VP;
constexpr int OFF_V = 2 * KSZ, OFF_SCR = OFF_V + 2 * VSZ, OFF_Q = OFF_SCR + 8 * 256, LDS_BYTES = OFF_Q + 64;
constexpr float NEGF = -1e30f, THR = 6.0f;
__device__ __forceinline__ int crow(int r, int hi) { return (r & 3) + 8 * (r >> 2) + 4 * hi; }
__device__ __forceinline__ unsigned cvtpk(float lo, float hi) { f32x2_t v = {lo, hi}; bf16x2_t b = __builtin_convertvector(v, bf16x2_t); return __builtin_bit_cast(unsigned, b); }
__device__ __forceinline__ bf16x8 pack8(const f32x16& p, int s) { u32x4 w; w.x = cvtpk(p[8 * s], p[8 * s + 1]); w.y = cvtpk(p[8 * s + 2], p[8 * s + 3]); w.z = cvtpk(p[8 * s + 4], p[8 * s + 5]); w.w = cvtpk(p[8 * s + 6], p[8 * s + 7]); return __builtin_bit_cast(bf16x8, w); }
typedef short v4i16_t __attribute__((ext_vector_type(4)));
__device__ __forceinline__ s16x4 vtr(const ALAS unsigned char* p) { return __builtin_bit_cast(s16x4, __builtin_amdgcn_ds_read_tr16_b64_v4i16((ALAS v4i16_t*)p)); }
__device__ __forceinline__ unsigned short f2bf(float f) { unsigned u = __builtin_bit_cast(unsigned, f); return (unsigned short)((u + 0x7fffu + ((u >> 16) & 1u)) >> 16); }

template <int DQK, bool SWA>
__device__ __forceinline__ void attn_unit(ALAS unsigned char* lds, const bf16_t* Qp, int qpitch, const bf16_t* Kp, int kpitch, const bf16_t* Krp, const bf16_t* Vp, int vpitch,
                                          bf16_t* Op, float* ssq, float sink2, int b, int qb) {
    constexpr int KP = DQK * 2 + 16, NS = DQK / 16;
    int tid_ = threadIdx.x; asm volatile("" : "+v"(tid_));
    const int tid = tid_, lane = tid & 63, wid = __builtin_amdgcn_readfirstlane(tid >> 6), r = lane & 31, h = lane >> 5;
    const size_t rowbase = (size_t)b * TT;
    const int q0 = qb * 256, q0w = q0 + wid * 32;
    const bool wave_valid = q0w < TT;
    const int NT = (q0 + 256) / 64 < TT / 64 ? (q0 + 256) / 64 : TT / 64;
    int t0 = 1; if (SWA) { t0 = (q0 - 128) / 64; if (t0 < 1) t0 = 1; }
    ALAS float* scr = (ALAS float*)(lds + OFF_SCR + wid * 256);
    bf16x8 qf[NS];
    { const int qr = (q0w + r) < TT ? (q0w + r) : TT - 1; const bf16_t* qrow = Qp + (rowbase + qr) * (size_t)qpitch;
#pragma unroll
      for (int s = 0; s < NS; ++s) qf[s] = *(const bf16x8*)(qrow + 16 * s + 8 * h); }
    const int srow = tid >> 3, sch = tid & 7, rrow = (tid >> 2) & 63, rch = tid & 3;
    u32x4 kreg, vreg, rreg = {0u, 0u, 0u, 0u};
#define AT_GLOAD(t) do { const size_t kr_ = rowbase + 64 * (t) + srow; kreg = *(const u32x4*)(Kp + kr_ * (size_t)kpitch + sch * 8); vreg = *(const u32x4*)(Vp + kr_ * (size_t)vpitch + sch * 8); \
        if (DQK == 96) { if (tid < 256) rreg = *(const u32x4*)(Krp + (rowbase + 64 * (t) + rrow) * 32 + rch * 8); } } while (0)
#define AT_LSTORE(buf) do { *(ALAS u32x4*)(lds + (buf) * KSZ + srow * KP + sch * 16) = kreg; *(ALAS u32x4*)(lds + OFF_V + (buf) * VSZ + srow * VP + sch * 16) = vreg; \
        if (DQK == 96) { if (tid < 256) *(ALAS u32x4*)(lds + (buf) * KSZ + rrow * KP + 128 + rch * 16) = rreg; } } while (0)
    AT_GLOAD(t0); AT_LSTORE(0);
    __syncthreads();
    float mrun = SWA ? sink2 : NEGF, lrun = (SWA && h == 0) ? 1.0f : 0.0f;
    f32x16 o0, o1;
#pragma unroll
    for (int i = 0; i < 16; ++i) { o0[i] = 0.f; o1[i] = 0.f; }
    const int q = q0w + r;
    for (int t = t0; t < NT; ++t) {
        const int buf = (t - t0) & 1;
        if (t + 1 < NT) AT_GLOAD(t + 1);
        const int kfirst = 64 * t;
        bool active = wave_valid && (kfirst <= q0w + 31);
        if (SWA) active = active && (kfirst + 63 >= q0w - 127);
        if (active) {
            f32x16 s0, s1;
#pragma unroll
            for (int i = 0; i < 16; ++i) { s0[i] = 0.f; s1[i] = 0.f; }
            const ALAS unsigned char* kb = lds + buf * KSZ + r * KP + h * 16;
#pragma unroll
            for (int s = 0; s < NS; ++s) { const bf16x8 k0 = *(const ALAS bf16x8*)(kb + s * 32), k1 = *(const ALAS bf16x8*)(kb + 32 * KP + s * 32);
                s0 = __builtin_amdgcn_mfma_f32_32x32x16_bf16(k0, qf[s], s0, 0, 0, 0); s1 = __builtin_amdgcn_mfma_f32_32x32x16_bf16(k1, qf[s], s1, 0, 0, 0); }
            const bool need_mask = SWA || (t == 1) || (kfirst + 63 > q0w);
            if (need_mask) {
#pragma unroll
                for (int i = 0; i < 16; ++i) { const int key = kfirst + crow(i, h), key1 = key + 32;
                    bool ok0 = (key <= q) && (key >= FRONT), ok1 = (key1 <= q) && (key1 >= FRONT);
                    if (SWA) { ok0 = ok0 && (q - key < 128); ok1 = ok1 && (q - key1 < 128); }
                    s0[i] = ok0 ? s0[i] : NEGF; s1[i] = ok1 ? s1[i] : NEGF; }
            }
            float rm = fmaxf(s0[0], s1[0]);
#pragma unroll
            for (int i = 1; i < 16; ++i) rm = fmaxf(rm, fmaxf(s0[i], s1[i]));
            rm = fmaxf(rm, __shfl_xor(rm, 32));
            if (__any(rm > mrun + THR)) {
                const float mn = fmaxf(mrun, rm), f = __builtin_amdgcn_exp2f(mrun - mn); mrun = mn; lrun *= f;
                if (h == 0) scr[r] = f;
#pragma unroll
                for (int i = 0; i < 16; ++i) { const float fi = scr[crow(i, h)]; o0[i] *= fi; o1[i] *= fi; }
            }
            float ls = 0.f;
#pragma unroll
            for (int i = 0; i < 16; ++i) { s0[i] = __builtin_amdgcn_exp2f(s0[i] - mrun); s1[i] = __builtin_amdgcn_exp2f(s1[i] - mrun); ls += s0[i] + s1[i]; }
            lrun += ls;
            const bf16x8 p0 = pack8(s0, 0), p1 = pack8(s0, 1), p2 = pack8(s1, 0), p3 = pack8(s1, 1);
            const ALAS unsigned char* vb_ = lds + OFF_V + buf * VSZ + (4 * h + ((lane & 15) >> 2)) * VP + ((lane >> 4) & 1) * 32 + (lane & 3) * 8;
#define AT_PV(P, rowoff) do { \
                { const s16x4 lo = vtr(vb_ + (rowoff) * VP), hi = vtr(vb_ + ((rowoff) + 8) * VP); const bf16x8 vf = __builtin_shufflevector(lo, hi, 0, 1, 2, 3, 4, 5, 6, 7); o0 = __builtin_amdgcn_mfma_f32_32x32x16_bf16(P, vf, o0, 0, 0, 0); } \
                { const s16x4 lo = vtr(vb_ + (rowoff) * VP + 64), hi = vtr(vb_ + ((rowoff) + 8) * VP + 64); const bf16x8 vf = __builtin_shufflevector(lo, hi, 0, 1, 2, 3, 4, 5, 6, 7); o1 = __builtin_amdgcn_mfma_f32_32x32x16_bf16(P, vf, o1, 0, 0, 0); } } while (0)
            AT_PV(p0, 0); AT_PV(p1, 16); AT_PV(p2, 32); AT_PV(p3, 48);
#undef AT_PV
        }
        if (t + 1 < NT) AT_LSTORE(buf ^ 1);
        __syncthreads();
    }
#undef AT_GLOAD
#undef AT_LSTORE
    if (wave_valid) {
        const float lt = lrun + __shfl_xor(lrun, 32);
        if (h == 0) scr[32 + r] = lt;
#pragma unroll
        for (int i = 0; i < 16; ++i) {
            const float li = scr[32 + crow(i, h)], inv = li > 0.f ? 1.0f / li : 0.f;
            const float a = o0[i] * inv, c = o1[i] * inv; const size_t row = rowbase + q0w + crow(i, h);
            Op[row * 1024 + r] = f2bf(a); Op[row * 1024 + 32 + r] = f2bf(c);
            float ss = a * a + c * c;
            ss += __shfl_xor(ss, 1); ss += __shfl_xor(ss, 2); ss += __shfl_xor(ss, 4); ss += __shfl_xor(ss, 8); ss += __shfl_xor(ss, 16);
            if (r == 0) ssq[row * 16] = ss;
        }
    }
    __syncthreads();
}
}
typedef unsigned short bf16;
#define LAS __attribute__((address_space(3)))
constexpr size_t MiB = 1u << 20;
constexpr int NWAVES = 8, NTHREADS = 512;
constexpr int LDS_BYTES = 147456;
static_assert(att::LDS_BYTES <= 131072, "attention LDS");
constexpr size_t WS_CTL = 0, CTL_BYTES = 65536;
constexpr size_t WS_H = 1 * MiB;
constexpr size_t WS_HB = WS_H + (size_t)MROWS * DM * 4;
constexpr size_t WS_W = WS_HB + (size_t)MROWS * DM * 2;
constexpr size_t WL_IN = 0, WL_Q = WL_IN + (size_t)INP * DM * 2, WL_KV = WL_Q + (size_t)768 * 256 * 2, WL_O = WL_KV + (size_t)1024 * 128 * 2,
                 WL_GU = WL_O + (size_t)DM * DM * 2, WL_D = WL_GU + (size_t)GUP * DM * 2, WL_END = WL_D + (size_t)DM * DFF * 2;
constexpr size_t WBUF = 22 * MiB;
static_assert(WL_END <= WBUF, "weight buffer");
constexpr size_t WS_PART = WS_W + 2 * WBUF;
constexpr size_t P_HSSA = 0, P_HSSB = P_HSSA + (size_t)MROWS * 64, P_SSQO = P_HSSB + (size_t)MROWS * 64, P_SSQQ = P_SSQO + (size_t)MROWS * 64, P_SSQKV = P_SSQQ + (size_t)MROWS * 16, P_END = P_SSQKV + (size_t)MROWS * 16;
constexpr size_t PM_H = (P_END + 255) & ~(size_t)255, PM_HB = PM_H + 16 * DM * 4, PM_HSSA = PM_HB + 16 * DM * 2, PM_HSSB = PM_HSSA + 1024, PM_SSQQ = PM_HSSB + 1024, PM_SSQKV = PM_SSQQ + 256,
                 PM_QLAT = PM_SSQKV + 256, PM_KVLAT = PM_QLAT + 16 * 256 * 2, PM_ACT = PM_KVLAT + 16 * 128 * 2, PM_END = PM_ACT + 16 * DFF * 2;
static_assert(PM_END <= 8 * MiB, "partials");
constexpr int MC = BATCH * SEQ;
constexpr size_t WS_R = WS_PART + 8 * MiB;
constexpr size_t R_QA = 0, R_KA = R_QA + (size_t)MROWS * 512 * 2, R_VA = R_KA + (size_t)MROWS * 128 * 2, R_QLAT = R_VA + (size_t)MROWS * 128 * 2, R_KVLAT = R_QLAT + (size_t)MROWS * 256 * 2,
                 R_KR = R_KVLAT + (size_t)MROWS * 128 * 2, R_QM = R_KR + (size_t)MROWS * 32 * 2, R_KN = R_QM + (size_t)MROWS * 768 * 2, R_VB = R_KN + (size_t)MROWS * 512 * 2,
                 R_O = R_VB + (size_t)MROWS * 512 * 2, R_END = R_O + (size_t)MROWS * 1024 * 2;
constexpr size_t R_ACT = 0;
static_assert((size_t)MROWS * DFF * 2 <= R_END, "act overlay");
constexpr size_t WS_END = WS_R + R_END;
static_assert(WS_END <= 512 * MiB, "workspace must fit 512 MiB");

struct Args {
    const float *x, *meta, *attn_norm, *w_in, *q_norm, *w_q_up, *kv_norm, *w_kv_up, *sinks, *out_norm_swa, *out_norm_mla, *w_o, *ffn_norm, *w_gate, *w_up, *w_down, *final_norm;
    float* out; unsigned char* ws; int ph_lo, ph_hi;
};

__device__ __forceinline__ unsigned f2bf_u(float f) { unsigned u = __builtin_bit_cast(unsigned, f); return (u + 0x7fffu + ((u >> 16) & 1u)) >> 16; }
__device__ __forceinline__ unsigned pk2(float lo, float hi) { return f2bf_u(lo) | (f2bf_u(hi) << 16); }
__device__ __forceinline__ float wave_sum(float v) {
#pragma unroll
    for (int o = 1; o < 64; o <<= 1) v += __shfl_xor(v, o);
    return v;
}

__device__ __forceinline__ int src_in(int np) { const int pn = np >> 8, bj = (np >> 7) & 1, o = np & 127;
    if (pn < 2) return (4 * pn + (o >> 5)) * 64 + (o & 31) + 32 * bj;
    if (pn == 2) { if (o < 64) return 512 + (o >> 5) * 64 + (o & 31) + 32 * bj; if (o < 80) return 1152 + (o - 64) + 16 * bj; return -1; }
    if (pn == 3) return bj ? 1024 + o : 640 + o;
    return 768 + 128 * bj + o; }
__device__ __forceinline__ int src_qup(int np) { const int pn = np >> 8, op = np & 255;
    if (pn < 2) return (4 * pn + (op >> 6)) * 96 + (op & 63);
    const int bj = op >> 7, o = op & 127; return (o >> 4) * 96 + 64 + (o & 15) + 16 * bj; }
__device__ __forceinline__ int src_kvup(int np) { const int pn = np >> 8, op = np & 255; return (4 * (pn & 1) + (op >> 6)) * 128 + (pn >= 2 ? 64 : 0) + (op & 63); }

template <int MODE>
__device__ __forceinline__ void conv_item(const float* W, const float* W2, const float* gain, const float* gain2, int K, int Nsrc, bf16* WT, LAS float* scr, int item, int nblk, int lane) {
    const int kb = item / nblk, nb = item % nblk, k0 = 64 * kb, n0 = 32 * nb;
    const int np = n0 + (lane & 31);
    int src; float cs = 1.0f; const float* Wp = W;
    if (MODE == 0) { src = src_in(np); if (np < 512) cs = 0.125f * LOG2E; }
    else if (MODE == 1) { src = src_qup(np); cs = 0.10206207261596577f * LOG2E; }
    else if (MODE == 2) src = src_kvup(np);
    else if (MODE == 4) { src = 128 * (np >> 8) + (np & 127); if ((np >> 7) & 1) Wp = W2; }
    else src = np;
#pragma unroll 8
    for (int i = 0; i < 32; ++i) { const int kk = 2 * i + (lane >> 5), k = k0 + kk;
        float g = 1.0f; if (MODE == 3) g = (k < 512) ? gain[k] : gain2[k - 512]; else if (MODE != 5) g = gain[k];
        scr[kk * 33 + (lane & 31)] = (src >= 0) ? Wp[(size_t)k * Nsrc + src] * g * cs : 0.0f; }
    asm volatile("s_waitcnt lgkmcnt(0)" ::: "memory");
    const int c = lane & 7;
#pragma unroll
    for (int j = 0; j < 4; ++j) { const int n = (lane >> 3) + 8 * j; const LAS float* s = scr + (8 * c) * 33 + n;
        pg8::u32x4 o; o.x = pk2(s[0 * 33], s[1 * 33]); o.y = pk2(s[2 * 33], s[3 * 33]); o.z = pk2(s[4 * 33], s[5 * 33]); o.w = pk2(s[6 * 33], s[7 * 33]);
        *(pg8::u32x4*)(WT + (size_t)(n0 + n) * K + k0 + 8 * c) = o; }
    asm volatile("s_waitcnt lgkmcnt(0)" ::: "memory");
}
__device__ __forceinline__ void conv_layer(const Args& a, int l, unsigned char* wbuf, LAS unsigned char* lds) {
    int tid_ = threadIdx.x; asm volatile("" : "+v"(tid_));
    const int lane = tid_ & 63, wave = tid_ >> 6;
    LAS float* scr = (LAS float*)(lds + wave * 16384);
    const int gw = blockIdx.x * NWAVES + wave, NGW = gridDim.x * NWAVES;
    constexpr int I0 = (DM / 64) * (INP / 32), I1 = (256 / 64) * (768 / 32), I2 = (128 / 64) * (1024 / 32), I3 = (DM / 64) * (DM / 32), I4 = (DM / 64) * (GUP / 32), I5 = (DFF / 64) * (DM / 32);
    constexpr int NIT = I0 + I1 + I2 + I3 + I4 + I5;
    for (int it = gw; it < NIT; it += NGW) {
        int r = it;
        if (r < I0) { conv_item<0>(a.w_in + (size_t)l * DM * INW, nullptr, a.attn_norm + l * DM, nullptr, DM, INW, (bf16*)(wbuf + WL_IN), scr, r, INP / 32, lane); continue; } r -= I0;
        if (r < I1) { conv_item<1>(a.w_q_up + (size_t)l * 256 * 768, nullptr, a.q_norm + l * 256, nullptr, 256, 768, (bf16*)(wbuf + WL_Q), scr, r, 768 / 32, lane); continue; } r -= I1;
        if (r < I2) { conv_item<2>(a.w_kv_up + (size_t)l * 128 * 1024, nullptr, a.kv_norm + l * 128, nullptr, 128, 1024, (bf16*)(wbuf + WL_KV), scr, r, 1024 / 32, lane); continue; } r -= I2;
        if (r < I3) { conv_item<3>(a.w_o + (size_t)l * DM * DM, nullptr, a.out_norm_swa + l * 512, a.out_norm_mla + l * 512, DM, DM, (bf16*)(wbuf + WL_O), scr, r, DM / 32, lane); continue; } r -= I3;
        if (r < I4) { conv_item<4>(a.w_gate + (size_t)l * DM * DFF, a.w_up + (size_t)l * DM * DFF, a.ffn_norm + l * DM, nullptr, DM, DFF, (bf16*)(wbuf + WL_GU), scr, r, GUP / 32, lane); continue; } r -= I4;
        conv_item<5>(a.w_down + (size_t)l * DFF * DM, nullptr, nullptr, nullptr, DFF, DM, (bf16*)(wbuf + WL_D), scr, r, DM / 32, lane);
    }
}

__device__ __forceinline__ void init_rows(const Args& a, unsigned char* ws) {
    const int lane = threadIdx.x & 63, wave = threadIdx.x >> 6; const int gw = blockIdx.x * NWAVES + wave, NGW = gridDim.x * NWAVES;
    for (int row = gw; row < MC + NMETA; row += NGW) {
        const bool meta = row >= MC; const int r = meta ? row - MC : row;
        const float* src = meta ? a.meta + (size_t)r * DM : a.x + (size_t)r * DM;
        float* H = (float*)(ws + (meta ? WS_PART + PM_H : WS_H)); bf16* HB = (bf16*)(ws + (meta ? WS_PART + PM_HB : WS_HB)); float* hss = (float*)(ws + WS_PART + (meta ? PM_HSSA : P_HSSA));
        pg8::f32x4 v[4]; float s = 0.f;
#pragma unroll
        for (int j = 0; j < 4; ++j) { v[j] = *((const pg8::f32x4*)src + lane + 64 * j); s += pg8::sq4(v[j]); }
        s = wave_sum(s);
#pragma unroll
        for (int j = 0; j < 4; ++j) { *((pg8::f32x4*)(H + (size_t)r * DM) + lane + 64 * j) = v[j]; pg8::st_bf16x4(HB + (size_t)r * DM + 4 * (lane + 64 * j), v[j]); }
        if (lane < 16) hss[(size_t)r * 16 + lane] = (lane == 0) ? s : 0.f;
    }
}
__device__ __forceinline__ void final_rows(const Args& a, const float* H, const float* hss) {
    const int lane = threadIdx.x & 63, wave = threadIdx.x >> 6; const int gw = blockIdx.x * NWAVES + wave, NGW = gridDim.x * NWAVES;
    for (int o = gw; o < BATCH * SEQ; o += NGW) {
        const int row = o;
        const float rs = pg8::rsq(pg8::sum16(hss, row) * (1.0f / DM) + RMS_EPS);
#pragma unroll
        for (int j = 0; j < 4; ++j) { const pg8::f32x4 v = *((const pg8::f32x4*)(H + (size_t)row * DM) + lane + 64 * j), g = *((const pg8::f32x4*)a.final_norm + lane + 64 * j);
            *((pg8::f32x4*)(a.out + (size_t)o * DM) + lane + 64 * j) = v * rs * g; }
    }
}

constexpr int N_ATT_UNITS = 2 * 17 * 64;
__device__ __forceinline__ void attn_phase(const Args& a, int l, unsigned char* ws, LAS unsigned char* lds) {
    unsigned* ctr = (unsigned*)(ws + WS_CTL) + 64 * l; l &= 3;
    unsigned char* R = ws + WS_R;
    const bf16 *QA = (const bf16*)(R + R_QA), *KA = (const bf16*)(R + R_KA), *VA = (const bf16*)(R + R_VA), *KR = (const bf16*)(R + R_KR), *QM = (const bf16*)(R + R_QM), *KN = (const bf16*)(R + R_KN), *VB = (const bf16*)(R + R_VB);
    bf16* O = (bf16*)(R + R_O); float* ssqO = (float*)(ws + WS_PART + P_SSQO);
    LAS int* qslot = (LAS int*)(lds + att::OFF_Q);
    for (;;) {
        if (threadIdx.x == 0) *qslot = (int)atomicAdd(ctr, 1u);
        __syncthreads();
        const int u = *qslot;
        __syncthreads();
        if (u >= N_ATT_UNITS) break;
        if (u < 17 * 64) {
            const int qb = 16 - u / 64, bh = u % 64, b = bh >> 3, hd = bh & 7;
            att::attn_unit<96, false>(lds, QM + hd * 96, 768, KN + hd * 64, 512, KR, VB + hd * 64, 512, O + 512 + hd * 64, ssqO + 8 + hd, 0.f, b, qb);
        } else {
            const int v = u - 17 * 64; const int qb = 16 - v / 64, bh = v % 64, b = bh >> 3, hq = bh & 7, kv = hq >> 2;
            att::attn_unit<64, true>(lds, QA + hq * 64, 512, KA + kv * 64, 128, nullptr, VA + kv * 64, 128, O + hq * 64, ssqO + hq, a.sinks[l * 8 + hq] * LOG2E, b, qb);
        }
    }
}

#define XB_TMO      128
#define XB_XCNT(j)  (256  + 64 * (j))
#define XB_XSUB(j)  (1280 + 64 * (j))
#define XB_XGEN(j)  (2304 + 64 * (j))
#define XB_TOP      3328
#define XB_TOPGEN   3392
#define XCD_BAR_WORDS 3456
#define XB_SPIN_CAP (1u << 18)

__device__ __forceinline__ unsigned xb_ld(unsigned* p)              { return __hip_atomic_load(p, __ATOMIC_RELAXED, __HIP_MEMORY_SCOPE_AGENT); }
__device__ __forceinline__ unsigned xb_add(unsigned* p, unsigned v) { return __hip_atomic_fetch_add(p, v, __ATOMIC_RELAXED, __HIP_MEMORY_SCOPE_AGENT); }
__device__ __forceinline__ unsigned xb_xcc_id() { return (unsigned)__builtin_amdgcn_s_getreg((3 << 11) | 20) & 0xFu; }
#define XB_SPIN(cond, bar) do { unsigned _sp = 0; while (cond) { __builtin_amdgcn_s_sleep(1); \
    if ((++_sp & 255u) == 0u) { if (xb_ld(&(bar)[XB_TMO])) break; if (_sp > XB_SPIN_CAP) { atomicAdd(&(bar)[XB_TMO], 1u); break; } } } } while (0)

struct XcdBarrier {
    unsigned* bar; unsigned x;
    volatile LAS unsigned* st;
};

__device__ __forceinline__ XcdBarrier xcd_barrier_post(unsigned* bar, volatile LAS unsigned* st) {
    XcdBarrier b; b.bar = bar; b.x = xb_xcc_id(); b.st = st;
    if (threadIdx.x == 0) (void)xb_add(&bar[XB_XCNT(b.x)], 1u);
    return b;
}
__device__ __forceinline__ void xcd_barrier_complete(unsigned* bar, unsigned x, unsigned& nloc, unsigned& nx) {
    const unsigned G = gridDim.x * gridDim.y * gridDim.z;
    unsigned sum, cnt, mine, sp = 0u;
    for (;;) {
        sum = 0u; cnt = 0u; mine = 0u;
#pragma unroll
        for (unsigned j = 0; j < 16; ++j) { const unsigned c = xb_ld(&bar[XB_XCNT(j)]); sum += c; cnt += (c > 0u) ? 1u : 0u; mine = (j == x) ? c : mine; }
        if (sum == G) break;
        __builtin_amdgcn_s_sleep(1);
        if ((++sp & 255u) == 0u) { if (xb_ld(&bar[XB_TMO])) break; if (sp > XB_SPIN_CAP) { atomicAdd(&bar[XB_TMO], 1u); break; } }
    }
    nloc = mine > 0u ? mine : 1u; nx = cnt > 0u ? cnt : 1u;
}

__device__ __forceinline__ void xcd_barrier(const XcdBarrier& b) {
    asm volatile("s_waitcnt vmcnt(0)" ::: "memory");
    __syncthreads();
    if (threadIdx.x == 0) {
        unsigned* bar = b.bar;
        __builtin_amdgcn_s_waitcnt(0);
        unsigned nloc = b.st[0], nx = b.st[1];
        if (nloc == 0u) { xcd_barrier_complete(bar, b.x, nloc, nx); b.st[0] = nloc; b.st[1] = nx; }
        const unsigned old = xb_add(&bar[XB_XSUB(b.x)], 1u);
        const unsigned gen = old / nloc;
        if (old + 1u == (gen + 1u) * nloc) {
            __builtin_amdgcn_fence(__ATOMIC_RELEASE, "agent");
            asm volatile("s_waitcnt vmcnt(0)" ::: "memory");
            const unsigned og = xb_add(&bar[XB_TOP], 1u);
            const unsigned tg = og / nx;
            if (og + 1u == (tg + 1u) * nx) xb_add(&bar[XB_TOPGEN], 1u);
            else XB_SPIN(xb_ld(&bar[XB_TOPGEN]) == tg, bar);
            __builtin_amdgcn_fence(__ATOMIC_ACQUIRE, "agent");
            xb_add(&bar[XB_XGEN(b.x)], 1u);
            asm volatile("s_waitcnt vmcnt(0)" ::: "memory");
        } else {
            XB_SPIN(xb_ld(&bar[XB_XGEN(b.x)]) == gen, bar);
            __builtin_amdgcn_fence(__ATOMIC_ACQUIRE, "agent");
            asm volatile("s_waitcnt vmcnt(0)" ::: "memory");
        }
    }
    __syncthreads();
}

constexpr int CW_BAR = 4096;
constexpr int XB_LDS_OFF = 131072 + 8192;
#ifndef PHM
#define PHM 255
#endif
#ifndef PROBE_DUP
#define PROBE_DUP 0
#endif
#ifndef PROBE_SYNC
#define PROBE_SYNC 0
#endif
__global__ void __launch_bounds__(NTHREADS, 2) fwd_megakernel(Args a) {
    extern __shared__ __attribute__((aligned(16))) unsigned char lds_raw[];
    LAS unsigned char* lds = (LAS unsigned char*)lds_raw;
    cg::grid_group grid = cg::this_grid();
    const int lo = a.ph_lo, hi = a.ph_hi;
    if (threadIdx.x < 2) ((LAS unsigned*)(lds + XB_LDS_OFF))[threadIdx.x] = 0u;
    __syncthreads();
    const XcdBarrier xbar = xcd_barrier_post((unsigned*)(a.ws + WS_CTL) + CW_BAR, (volatile LAS unsigned*)(lds + XB_LDS_OFF));
#define IN_PH(k) (lo <= (k) && (k) < hi)
#define SEAM(k) do { if (IN_PH(k) && IN_PH((k) + 1)) { if ((k) == 0) grid.sync(); else xcd_barrier(xbar); if (PROBE_SYNC) xcd_barrier(xbar); } } while (0)
#define WSL(w) unsigned char* w = a.ws; asm volatile("" : "+s"(w))
    if (IN_PH(0) && (PHM & 1)) { WSL(ws); init_rows(a, ws); conv_layer(a, 0, ws + WS_W, lds); __syncthreads(); }
    SEAM(0);
#pragma unroll 1
    for (int l = 0; l < DEPTH; ++l) {
        const int p = 1 + 6 * l;
        if (IN_PH(p) && (PHM & 2)) {
            { WSL(ws); unsigned char* R = ws + WS_R; unsigned char* wb = ws + WS_W + (size_t)(l & 1) * WBUF; unsigned char* pm_ = ws + WS_PART;
              pg8::EpiIn<true> E{(const float*)(pm_ + PM_HSSA), (bf16*)(R + R_QA), (bf16*)(R + R_KA), (bf16*)(R + R_VA), (bf16*)(pm_ + PM_QLAT), (bf16*)(pm_ + PM_KVLAT), (bf16*)(R + R_KR), (float*)(pm_ + PM_SSQQ), (float*)(pm_ + PM_SSQKV)};
              pg8::skinny_phase(lds, (const bf16*)(pm_ + PM_HB), (const bf16*)(wb + WL_IN), DM, INP / 256, E); }
            WSL(ws); unsigned char* R = ws + WS_R; unsigned char* wb = ws + WS_W + (size_t)(l & 1) * WBUF;
            pg8::Gemm g{(const bf16*)(ws + WS_HB), (const bf16*)(wb + WL_IN), MC, INP, DM, 0}; pg8::OrderCT<MC / 256, INP / 256> S; S.init((int)gridDim.x, (int)blockIdx.x);
            pg8::EpiIn<false> E{(const float*)(ws + WS_PART + P_HSSA), (bf16*)(R + R_QA), (bf16*)(R + R_KA), (bf16*)(R + R_VA), (bf16*)(R + R_QLAT), (bf16*)(R + R_KVLAT), (bf16*)(R + R_KR),
                         (float*)(ws + WS_PART + P_SSQQ), (float*)(ws + WS_PART + P_SSQKV)};
            pg8::gemm_phase<pg8::EpiIn<false>, pg8::OrderCT<MC / 256, INP / 256>, true, true>(lds, g, S, E);
        }
        SEAM(p);
        if (IN_PH(p + 1) && (PHM & 4)) {
            { WSL(ws); unsigned char* R = ws + WS_R; unsigned char* wb = ws + WS_W + (size_t)(l & 1) * WBUF; unsigned char* pm_ = ws + WS_PART;
              pg8::EpiQup<true> E{(const float*)(pm_ + PM_SSQQ), (bf16*)(R + R_QM)}; pg8::skinny_phase(lds, (const bf16*)(pm_ + PM_QLAT), (const bf16*)(wb + WL_Q), 256, 3, E); }
            { WSL(ws); unsigned char* R = ws + WS_R; unsigned char* wb = ws + WS_W + (size_t)(l & 1) * WBUF;
              pg8::Gemm g{(const bf16*)(R + R_QLAT), (const bf16*)(wb + WL_Q), MC, 768, 256, 0}; pg8::OrderCT<MC / 256, 3> S; S.init((int)gridDim.x, (int)blockIdx.x);
              pg8::EpiQup<false> E{(const float*)(ws + WS_PART + P_SSQQ), (bf16*)(R + R_QM)}; pg8::gemm_phase<pg8::EpiQup<false>, pg8::OrderCT<MC / 256, 3>, true, true>(lds, g, S, E); }
            { WSL(ws); unsigned char* R = ws + WS_R; unsigned char* wb = ws + WS_W + (size_t)(l & 1) * WBUF; unsigned char* pm_ = ws + WS_PART;
              pg8::EpiKvup<true> E{(const float*)(pm_ + PM_SSQKV), (bf16*)(R + R_KN), (bf16*)(R + R_VB)}; pg8::skinny_phase(lds, (const bf16*)(pm_ + PM_KVLAT), (const bf16*)(wb + WL_KV), 128, 4, E); }
            { WSL(ws); unsigned char* R = ws + WS_R; unsigned char* wb = ws + WS_W + (size_t)(l & 1) * WBUF;
              pg8::Gemm g{(const bf16*)(R + R_KVLAT), (const bf16*)(wb + WL_KV), MC, 1024, 128, 0}; pg8::OrderCT<MC / 256, 4> S; S.init((int)gridDim.x, (int)blockIdx.x);
              pg8::EpiKvup<false> E{(const float*)(ws + WS_PART + P_SSQKV), (bf16*)(R + R_KN), (bf16*)(R + R_VB)}; pg8::gemm_phase<pg8::EpiKvup<false>, pg8::OrderCT<MC / 256, 4>, true, true>(lds, g, S, E); }
        }
        SEAM(p + 1);
        if (IN_PH(p + 2) && (PHM & 8)) { WSL(ws); if (l + 1 < DEPTH) { conv_layer(a, l + 1, ws + WS_W + (size_t)((l + 1) & 1) * WBUF, lds); __syncthreads(); } attn_phase(a, l, ws, lds); if (PROBE_DUP & 8) attn_phase(a, l + 4, ws, lds); }
        SEAM(p + 2);
        if (IN_PH(p + 3) && (PHM & 16)) {
            { WSL(ws); unsigned char* R = ws + WS_R; unsigned char* wb = ws + WS_W + (size_t)(l & 1) * WBUF; unsigned char* pm_ = ws + WS_PART;
              pg8::EpiOut<true> E; E.H = (float*)(pm_ + PM_H); E.HB = (bf16*)(pm_ + PM_HB); E.hss_out = (float*)(pm_ + PM_HSSB); E.ssq_o = (const float*)(pm_ + P_SSQO); E.xlds = lds;
              pg8::skinny_phase(lds, (const bf16*)(R + R_O) + (size_t)FRONT * 1024, (const bf16*)(wb + WL_O), DM, 4, E); }
            WSL(ws); unsigned char* R = ws + WS_R; unsigned char* wb = ws + WS_W + (size_t)(l & 1) * WBUF;
            pg8::Gemm g{(const bf16*)(R + R_O), (const bf16*)(wb + WL_O), MC, DM, DM, 1}; pg8::OrderCT<MC / 256, 4> S; S.init((int)gridDim.x, (int)blockIdx.x);
            pg8::EpiOut<false> E; E.H = (float*)(ws + WS_H); E.HB = (bf16*)(ws + WS_HB); E.hss_out = (float*)(ws + WS_PART + P_HSSB); E.ssq_o = (const float*)(ws + WS_PART + P_SSQO); E.xlds = lds + pg8::STAGE_BYTES;
            pg8::gemm_phase<pg8::EpiOut<false>, pg8::OrderCT<MC / 256, 4>, true, true>(lds, g, S, E);
        }
        SEAM(p + 3);
        if (IN_PH(p + 4) && (PHM & 32)) {
            { WSL(ws); unsigned char* wb = ws + WS_W + (size_t)(l & 1) * WBUF; unsigned char* pm_ = ws + WS_PART;
              pg8::EpiGU<true> E{(const float*)(pm_ + PM_HSSB), (bf16*)(pm_ + PM_ACT)}; pg8::skinny_phase(lds, (const bf16*)(pm_ + PM_HB), (const bf16*)(wb + WL_GU), DM, GUP / 256, E); }
            WSL(ws); unsigned char* R = ws + WS_R; unsigned char* wb = ws + WS_W + (size_t)(l & 1) * WBUF;
            pg8::Gemm g{(const bf16*)(ws + WS_HB), (const bf16*)(wb + WL_GU), MC, GUP, DM, 0}; pg8::OrderCT<MC / 256, GUP / 256> S; S.init((int)gridDim.x, (int)blockIdx.x);
            pg8::EpiGU<false> E{(const float*)(ws + WS_PART + P_HSSB), (bf16*)(R + R_ACT)};
            pg8::gemm_phase<pg8::EpiGU<false>, pg8::OrderCT<MC / 256, GUP / 256>, true, true>(lds, g, S, E);
        }
        SEAM(p + 4);
        if (IN_PH(p + 5) && (PHM & 64)) {
            { WSL(ws); unsigned char* wb = ws + WS_W + (size_t)(l & 1) * WBUF; unsigned char* pm_ = ws + WS_PART;
              pg8::EpiDown<true> E; E.H = (float*)(pm_ + PM_H); E.HB = (bf16*)(pm_ + PM_HB); E.hss_out = (float*)(pm_ + PM_HSSA); E.ssq_o = nullptr;
              pg8::skinny_phase(lds, (const bf16*)(pm_ + PM_ACT), (const bf16*)(wb + WL_D), DFF, 4, E); }
            WSL(ws); unsigned char* R = ws + WS_R; unsigned char* wb = ws + WS_W + (size_t)(l & 1) * WBUF;
            pg8::Gemm g{(const bf16*)(R + R_ACT), (const bf16*)(wb + WL_D), MC, DM, DFF, 0}; pg8::OrderCT<MC / 256, 4> S; S.init((int)gridDim.x, (int)blockIdx.x);
            pg8::EpiDown<false> E; E.H = (float*)(ws + WS_H); E.HB = (bf16*)(ws + WS_HB); E.hss_out = (float*)(ws + WS_PART + P_HSSA); E.ssq_o = nullptr;
            pg8::gemm_phase<pg8::EpiDown<false>, pg8::OrderCT<MC / 256, 4>, true, true>(lds, g, S, E);
        }
        SEAM(p + 5);
    }
    if (IN_PH(1 + 6 * DEPTH) && (PHM & 128)) { WSL(ws); final_rows(a, (const float*)(ws + WS_H), (const float*)(ws + WS_PART + P_HSSA)); }
#undef IN_PH
#undef SEAM
#undef WSL
}
constexpr int N_PHASES = 2 + 6 * DEPTH;

#ifndef MK_SPLIT
#define MK_SPLIT 0
#endif
extern "C" void kernel_launch(void* const* d_in, const int* in_sizes, int n_in, void* d_out, int out_size, void* d_ws, size_t ws_size, hipStream_t stream) {
    static int grid = 0;
    if (grid == 0) {
        if (n_in != 17 || ws_size < WS_END) { fprintf(stderr, "kernel_launch: need 17 inputs and >= %zu bytes of workspace; got n_in %d, ws %zu\n", (size_t)WS_END, n_in, ws_size); grid = -1; return; }
        int dev = 0, cus = 0, per_cu = 0;
        hipGetDevice(&dev); hipDeviceGetAttribute(&cus, hipDeviceAttributeMultiprocessorCount, dev);
        if (hipFuncSetAttribute((const void*)fwd_megakernel, hipFuncAttributeMaxDynamicSharedMemorySize, LDS_BYTES) != hipSuccess) { fprintf(stderr, "kernel_launch: hipFuncSetAttribute failed\n"); grid = -1; return; }
        if (hipOccupancyMaxActiveBlocksPerMultiprocessor(&per_cu, (const void*)fwd_megakernel, NTHREADS, LDS_BYTES) != hipSuccess || per_cu < 1) { fprintf(stderr, "kernel_launch: occupancy query says %d\n", per_cu); per_cu = 1; }
        (void)hipGetLastError();
        grid = cus * 1;
    }
    if (grid < 0) return;
    hipMemsetAsync((char*)d_ws + WS_CTL, 0, CTL_BYTES, stream);
    Args a{};
    const float** f = (const float**)&a;
    for (int i = 0; i < 17; ++i) f[i] = (const float*)d_in[i];
    a.out = (float*)d_out; a.ws = (unsigned char*)d_ws;
#if MK_SPLIT
    for (int ph = 0; ph < N_PHASES; ++ph) { a.ph_lo = ph; a.ph_hi = ph + 1; hipLaunchKernelGGL(fwd_megakernel, dim3(grid), dim3(NTHREADS), LDS_BYTES, stream, a); }
#else
    a.ph_lo = 0; a.ph_hi = N_PHASES;
    void* args[] = {&a};
    hipError_t e = hipLaunchCooperativeKernel((const void*)fwd_megakernel, dim3(grid), dim3(NTHREADS), args, LDS_BYTES, stream);
    if (e != hipSuccess) fprintf(stderr, "cooperative launch failed: %s (grid %d)\n", hipGetErrorString(e), grid);
#endif
}
```

```cpp
#include <hip/hip_runtime.h>
#include <hip/hip_cooperative_groups.h>
#include <cstdio>
#include <cstdint>
namespace cg = cooperative_groups;

constexpr int BATCH = 8, SEQ = 4096, DM = 1024, DEPTH = 4, NMETA = 16, FRONT = 112, TT = 4224;
constexpr int MROWS = BATCH * TT;
constexpr int INW = 1184, INP = 1280, DFF = 2816, GUP = 2 * DFF;
constexpr float RMS_EPS = 1e-6f;
constexpr float LOG2E = 1.4426950408889634f;
constexpr float LOG2_THETA = 13.287712379549449f;
constexpr float INV_2PI = 0.15915494309189535f;

namespace pg8 {
#define PG8_LAS __attribute__((address_space(3)))
typedef unsigned short bf16_t;
typedef short bf16x8 __attribute__((ext_vector_type(8)));
typedef float f32x4 __attribute__((ext_vector_type(4)));
typedef unsigned u32x4 __attribute__((ext_vector_type(4)));
constexpr int BM = 256, BK = 64, HALF = 128, HTB = HALF * BK * 2  , STAGE_BYTES = 8 * HTB, NXCD = 8, WGM = 8;

__host__ __device__ __forceinline__ int lds_byte(int r, int c) { const int st = (r >> 4) * 2 + (c >> 5), rr = r & 15, cc = c & 31, ob = rr * 64 + cc * 2; return st * 1024 + (ob ^ (((ob >> 9) & 1) << 5)); }
__host__ __device__ __forceinline__ void stage_rc(int b, int& R, int& C) { const int st = b / 1024, sb = b % 1024, swz = sb ^ (((sb >> 9) & 1) << 5); R = (st >> 1) * 16 + swz / 64; C = (st & 1) * 32 + (swz % 64) / 2; }
__host__ __device__ __forceinline__ int perm32(int rho) { const int n = rho >> 4, i = rho & 15; return 8 * (i >> 2) + 4 * n + (i & 3); }

struct Unit { int pm, pn; };
struct Gemm { const bf16_t* A; const bf16_t* Bt; int M, N, K; int apad; };

struct StaticOrder {
    int nM, nN, nwg, G, c;
    __host__ __device__ void init(int M, int N, int G_, int c_) { nM = M / BM; nN = N / BM; nwg = nM * nN; G = G_; c = c_; }
    __host__ __device__ bool next(int i, Unit& u) const {
        const long L = (long)i * G + c; if (L >= nwg) return false;
        int wgid = (int)L; { const int q = nwg / NXCD, r = nwg % NXCD, xcd = wgid % NXCD, off = wgid / NXCD; wgid = (xcd < r ? xcd * (q + 1) : r * (q + 1) + (xcd - r) * q) + off; }
        const int nig = WGM * nN, gid = wgid / nig, fm = gid * WGM, gsz = (nM - fm) < WGM ? (nM - fm) : WGM;
        u.pm = fm + ((wgid % nig) % gsz); u.pn = (wgid % nig) / gsz; return true;
    }
    __device__ __forceinline__ void a_ready(const Unit&) const {}
    __device__ __forceinline__ void done(const Unit&) const {}
};

__device__ __forceinline__ unsigned cvt_pk_bf16(float lo, float hi) { unsigned r; asm volatile("v_cvt_pk_bf16_f32 %0, %1, %2" : "=v"(r) : "v"(lo), "v"(hi)); return r; }

template <int NM, int NN> struct OrderCT {
    static_assert(NM % 8 == 0 || NM % 8 == 4, "last M group must be 8 or 4 tiles");
    int G, c;
    __device__ __forceinline__ void init(int G_, int c_) { G = G_; c = c_; }
    __device__ __forceinline__ bool next(int i, Unit& u) const {
        constexpr int nwg = NM * NN, q = nwg / NXCD, r = nwg % NXCD, nig = WGM * NN;
        const int L = i * G + c; if (L >= nwg) return false;
        const int xcd = L & (NXCD - 1), off = L >> 3;
        const int wgid = (xcd < r ? xcd * (q + 1) : r * (q + 1) + (xcd - r) * q) + off;
        const int gid = wgid / nig, rem = wgid - gid * nig, fm = gid * WGM;
        const int sh = (NM - fm) < WGM ? 2 : 3;
        u.pm = fm + (rem & ((1 << sh) - 1)); u.pn = rem >> sh; return true;
    }
    __device__ __forceinline__ void a_ready(const Unit&) const {}
    __device__ __forceinline__ void done(const Unit&) const {}
};
typedef unsigned u32x2 __attribute__((ext_vector_type(2)));
__device__ __forceinline__ void st_bf16x4(bf16_t* p, f32x4 v) { u32x2 w; w.x = cvt_pk_bf16(v[0], v[1]); w.y = cvt_pk_bf16(v[2], v[3]); *(u32x2*)p = w; }
__device__ __forceinline__ float sum16(const float* part, int row) {
    const f32x4* p = (const f32x4*)(part + (size_t)row * 16); const f32x4 a = p[0], b = p[1], c = p[2], d = p[3];
    return (((a.x + a.y) + (a.z + a.w)) + ((b.x + b.y) + (b.z + b.w))) + (((c.x + c.y) + (c.z + c.w)) + ((d.x + d.y) + (d.z + d.w)));
}
__device__ __forceinline__ float sum4(const float* part, int row) { const f32x4 a = *(const f32x4*)(part + (size_t)row * 4); return (a.x + a.y) + (a.z + a.w); }
__device__ __forceinline__ float rsq(float x) { return 1.0f / sqrtf(x); }
__device__ __forceinline__ float sq4(f32x4 v) { return (v[0] * v[0] + v[1] * v[1]) + (v[2] * v[2] + v[3] * v[3]); }
#define EPI_ROWS(ai, m) for (int ai = 0; ai < 2; ++ai) for (int m = 0; m < 4; ++m)
#define EPI_ROW(u, ai, m) ((u).pm * BM + (ai) * HALF + wr * 64 + (m) * 16 + fr)

__device__ __forceinline__ int prow_of(int m) { return m + (m >> 12) * 128 + 128; }
#define EPI_NB (META ? BATCH : 1)
#define EPI_PROW(row, b) (META ? (size_t)((b) * TT + FRONT + (row)) : (size_t)prow_of(row))
#define EPI_MAIN_LOOP(CALL) _Pragma("unroll") for (int ai = 0; ai < 2; ++ai) _Pragma("unroll") for (int m = 0; m < 4; ++m) { asm volatile("" ::: "memory"); const int row = EPI_ROW(u, ai, m); \
        const f32x4 a_[2][2] = {{acc[ai][0][m][0], acc[ai][0][m][1]}, {acc[ai][1][m][0], acc[ai][1][m][1]}}; CALL; }

template <bool META> struct EpiIn {
    static constexpr bool PERM = false, AFTER_DRAIN = false, MIDSCALE = false;
    const float* hss; bf16_t *qa, *ka, *va, *qlat, *kvlat, *kr; float *ssq_q, *ssq_kv;
    __device__ __forceinline__ void mid(f32x4 (&)[2][2][4][2], const Unit&, int, int, int, int) const {}
    __device__ __forceinline__ void row_epi(const f32x4 (&a)[2][2], int row, int pn, int wc, int fr, int fq) const {
        const float rs = rsq(sum16(hss, row) * (1.0f / DM) + RMS_EPS);
        if (pn <= 2) {
            const bool is_kr = (pn == 2 && wc == 2);
            if (pn == 2 && wc == 3) return;
            const float pos = META ? (float)row : (float)((row & 4095) + NMETA);
#pragma unroll
            for (int n = 0; n < 2; ++n) {
                if (is_kr && n == 1) continue;
                const f32x4 x1 = a[0][n] * rs, x2 = a[1][n] * rs; f32x4 o1, o2;
#pragma unroll
                for (int e = 0; e < 4; ++e) { const float inv = is_kr ? __builtin_amdgcn_exp2f(-(float)(4 * fq + e) * (LOG2_THETA / 16.0f)) : __builtin_amdgcn_exp2f(-(float)(16 * n + 4 * fq + e) * (LOG2_THETA / 32.0f));
                    const float ang = pos * inv; float rev = ang * INV_2PI; rev = rev - floorf(rev);
                    const float sn = __builtin_amdgcn_sinf(rev), cs = __builtin_amdgcn_cosf(rev); o1[e] = x1[e] * cs - x2[e] * sn; o2[e] = x2[e] * cs + x1[e] * sn; }
#pragma unroll
                for (int b = 0; b < EPI_NB; ++b) { const size_t pr = EPI_PROW(row, b); bf16_t* d; int half;
                    if (pn < 2) { d = qa + pr * 512 + (4 * pn + wc) * 64 + 16 * n + 4 * fq; half = 32; }
                    else if (!is_kr) { d = ka + pr * 128 + wc * 64 + 16 * n + 4 * fq; half = 32; }
                    else { d = kr + pr * 32 + 4 * fq; half = 16; }
                    st_bf16x4(d, o1); st_bf16x4(d + half, o2); }
            }
        } else if (pn == 3) {
            float ss = 0.f;
#pragma unroll
            for (int n = 0; n < 2; ++n) { const int c = 32 * wc + 16 * n + 4 * fq; const f32x4 v = a[0][n] * rs, w = a[1][n] * rs;
#pragma unroll
                for (int b = 0; b < EPI_NB; ++b) st_bf16x4(va + EPI_PROW(row, b) * 128 + c, v);
                st_bf16x4(kvlat + (size_t)row * 128 + c, w); ss += sq4(w); }
            ss += __shfl_xor(ss, 16); ss += __shfl_xor(ss, 32);
            if (fq == 0) ssq_kv[(size_t)row * 4 + wc] = ss;
        } else {
            float ss = 0.f;
#pragma unroll
            for (int bj = 0; bj < 2; ++bj)
#pragma unroll
                for (int n = 0; n < 2; ++n) { const int c = 128 * bj + 32 * wc + 16 * n + 4 * fq; const f32x4 v = a[bj][n] * rs; st_bf16x4(qlat + (size_t)row * 256 + c, v); ss += sq4(v); }
            ss += __shfl_xor(ss, 16); ss += __shfl_xor(ss, 32);
            if (fq == 0) ssq_q[(size_t)row * 4 + wc] = ss;
        }
    }
    __device__ __forceinline__ void operator()(const f32x4 (&acc)[2][2][4][2], const Unit& u, int wr, int wc, int fr, int fq) const { EPI_MAIN_LOOP(row_epi(a_, row, u.pn, wc, fr, fq)) }
};

template <bool META> struct EpiQup {
    static constexpr bool PERM = false, AFTER_DRAIN = false, MIDSCALE = false;
    const float* ssq_q; bf16_t* qm;
    __device__ __forceinline__ void mid(f32x4 (&)[2][2][4][2], const Unit&, int, int, int, int) const {}
    __device__ __forceinline__ void row_epi(const f32x4 (&a)[2][2], int row, int pn, int wc, int fr, int fq) const {
        const float rs = rsq(sum4(ssq_q, row) * (1.0f / 256.0f) + RMS_EPS);
        if (pn < 2) {
#pragma unroll
            for (int bj = 0; bj < 2; ++bj)
#pragma unroll
                for (int n = 0; n < 2; ++n) { const int head = 4 * pn + 2 * bj + (wc >> 1), d = 32 * (wc & 1) + 16 * n + 4 * fq; const f32x4 v = a[bj][n] * rs;
#pragma unroll
                    for (int b = 0; b < EPI_NB; ++b) st_bf16x4(qm + EPI_PROW(row, b) * 768 + head * 96 + d, v); }
        } else {
            const float pos = META ? (float)row : (float)((row & 4095) + NMETA);
#pragma unroll
            for (int n = 0; n < 2; ++n) { const int head = 2 * wc + n; const f32x4 x1 = a[0][n] * rs, x2 = a[1][n] * rs; f32x4 o1, o2;
#pragma unroll
                for (int e = 0; e < 4; ++e) { const float inv = __builtin_amdgcn_exp2f(-(float)(4 * fq + e) * (LOG2_THETA / 16.0f)); const float ang = pos * inv; float rev = ang * INV_2PI; rev = rev - floorf(rev);
                    const float sn = __builtin_amdgcn_sinf(rev), cs = __builtin_amdgcn_cosf(rev); o1[e] = x1[e] * cs - x2[e] * sn; o2[e] = x2[e] * cs + x1[e] * sn; }
#pragma unroll
                for (int b = 0; b < EPI_NB; ++b) { bf16_t* qrow = qm + EPI_PROW(row, b) * 768; st_bf16x4(qrow + head * 96 + 64 + 4 * fq, o1); st_bf16x4(qrow + head * 96 + 80 + 4 * fq, o2); } }
        }
    }
    __device__ __forceinline__ void operator()(const f32x4 (&acc)[2][2][4][2], const Unit& u, int wr, int wc, int fr, int fq) const { EPI_MAIN_LOOP(row_epi(a_, row, u.pn, wc, fr, fq)) }
};

template <bool META> struct EpiKvup {
    static constexpr bool PERM = false, AFTER_DRAIN = false, MIDSCALE = false;
    const float* ssq_kv; bf16_t *kn, *vb;
    __device__ __forceinline__ void mid(f32x4 (&)[2][2][4][2], const Unit&, int, int, int, int) const {}
    __device__ __forceinline__ void row_epi(const f32x4 (&a)[2][2], int row, int pn, int wc, int fr, int fq) const {
        bf16_t* dst = (pn < 2 ? kn : vb) + (pn & 1) * 256;
        const float rs = rsq(sum4(ssq_kv, row) * (1.0f / 128.0f) + RMS_EPS);
#pragma unroll
        for (int bj = 0; bj < 2; ++bj)
#pragma unroll
            for (int n = 0; n < 2; ++n) { const f32x4 v = a[bj][n] * rs;
#pragma unroll
                for (int b = 0; b < EPI_NB; ++b) st_bf16x4(dst + EPI_PROW(row, b) * 512 + 128 * bj + 32 * wc + 16 * n + 4 * fq, v); }
    }
    __device__ __forceinline__ void operator()(const f32x4 (&acc)[2][2][4][2], const Unit& u, int wr, int wc, int fr, int fq) const { EPI_MAIN_LOOP(row_epi(a_, row, u.pn, wc, fr, fq)) }
};

struct EpiResid {
    static constexpr bool PERM = false, AFTER_DRAIN = false;
    float* H; bf16_t* HB; float* hss_out; const float* ssq_o;
    __device__ __forceinline__ void resid_row(const f32x4 (&a)[2][2], int row, float rs, int pn, int wc, int fr, int fq) const {
        float ss = 0.f;
#pragma unroll
        for (int bj = 0; bj < 2; ++bj)
#pragma unroll
            for (int n = 0; n < 2; ++n) { const size_t off = (size_t)row * DM + pn * BM + 128 * bj + 32 * wc + 16 * n + 4 * fq;
                const u32x2 hw = *(const u32x2*)(HB + off); f32x4 hv; hv[0] = __builtin_bit_cast(float, hw.x << 16); hv[1] = __builtin_bit_cast(float, hw.x & 0xffff0000u); hv[2] = __builtin_bit_cast(float, hw.y << 16); hv[3] = __builtin_bit_cast(float, hw.y & 0xffff0000u);
                hv = hv + a[bj][n] * rs; st_bf16x4(HB + off, hv); ss += sq4(hv); }
        ss += __shfl_xor(ss, 16); ss += __shfl_xor(ss, 32);
        if (fq == 0) hss_out[(size_t)row * 16 + 4 * pn + wc] = ss;
    }
    __device__ __forceinline__ void two_scales(size_t prow, float& f, float& rb) const {
        const f32x4* p = (const f32x4*)(ssq_o + prow * 16); const f32x4 a = p[0], b = p[1], c = p[2], d = p[3];
        const float sa = ((a.x + a.y) + (a.z + a.w)) + ((b.x + b.y) + (b.z + b.w)), sb = ((c.x + c.y) + (c.z + c.w)) + ((d.x + d.y) + (d.z + d.w));
        const float va = sa * (1.0f / 512.0f) + RMS_EPS, vb = sb * (1.0f / 512.0f) + RMS_EPS; f = sqrtf(vb / va); rb = rsq(vb);
    }
};
template <bool META> struct EpiOut : EpiResid {
    static constexpr bool MIDSCALE = true;
    PG8_LAS unsigned char* xlds;
    __device__ __forceinline__ void prep(const Unit& u, int wid, int wr, int lane) const {
        PG8_LAS float* tab = (PG8_LAS float*)(xlds + wid * 1024);
#pragma unroll
        for (int j = 0; j < 2; ++j) { const int idx = lane + 64 * j; const int row = u.pm * BM + (idx >> 6) * HALF + wr * 64 + (idx & 63);
            float f, rb; two_scales((size_t)prow_of(row), f, rb); tab[2 * idx] = f; tab[2 * idx + 1] = rb; }
    }
    __device__ __forceinline__ void mid(f32x4 (&acc)[2][2][4][2], const Unit& u, int wr, int wc, int fr, int fq) const {
        const int wid = wr * 4 + wc; const PG8_LAS float* tab = (const PG8_LAS float*)(xlds + wid * 1024);
#pragma unroll
        for (int ai = 0; ai < 2; ++ai)
#pragma unroll
            for (int m = 0; m < 4; ++m) {
                const float f = tab[2 * (ai * 64 + m * 16 + fr)];
#pragma unroll
                for (int bj = 0; bj < 2; ++bj)
#pragma unroll
                    for (int n = 0; n < 2; ++n) acc[ai][bj][m][n] *= f;
            }
    }
    __device__ __forceinline__ void operator()(const f32x4 (&acc)[2][2][4][2], const Unit& u, int wr, int wc, int fr, int fq) const {
        const PG8_LAS float* tab = (const PG8_LAS float*)(xlds + (wr * 4 + wc) * 1024);
        EPI_MAIN_LOOP(resid_row(a_, row, tab[2 * (ai * 64 + m * 16 + fr) + 1], u.pn, wc, fr, fq))
    }
    __device__ __forceinline__ void mid_row(f32x4 (&a)[2][2], int row) const { float f, rb; two_scales((size_t)(FRONT + row), f, rb);
#pragma unroll
        for (int bj = 0; bj < 2; ++bj)
#pragma unroll
            for (int n = 0; n < 2; ++n) a[bj][n] *= f; }
    __device__ __forceinline__ void row_epi(const f32x4 (&a)[2][2], int row, int pn, int wc, int fr, int fq) const { float f, rb; two_scales((size_t)(FRONT + row), f, rb); resid_row(a, row, rb, pn, wc, fr, fq); }
};
template <bool META> struct EpiDown : EpiResid {
    static constexpr bool MIDSCALE = false;
    __device__ __forceinline__ void mid(f32x4 (&)[2][2][4][2], const Unit&, int, int, int, int) const {}
    __device__ __forceinline__ void row_epi(const f32x4 (&a)[2][2], int row, int pn, int wc, int fr, int fq) const { resid_row(a, row, 1.0f, pn, wc, fr, fq); }
    __device__ __forceinline__ void operator()(const f32x4 (&acc)[2][2][4][2], const Unit& u, int wr, int wc, int fr, int fq) const { EPI_MAIN_LOOP(resid_row(a_, row, 1.0f, u.pn, wc, fr, fq)) }
};

template <bool META> struct EpiGU {
    static constexpr bool PERM = false, AFTER_DRAIN = false, MIDSCALE = false;
    const float* hss; bf16_t* act;
    __device__ __forceinline__ void mid(f32x4 (&)[2][2][4][2], const Unit&, int, int, int, int) const {}
    __device__ __forceinline__ void row_epi(const f32x4 (&a)[2][2], int row, int pn, int wc, int fr, int fq) const {
        const float rs = rsq(sum16(hss, row) * (1.0f / DM) + RMS_EPS);
#pragma unroll
        for (int n = 0; n < 2; ++n) { const f32x4 g = a[0][n] * rs, up = a[1][n] * rs; f32x4 o;
#pragma unroll
            for (int e = 0; e < 4; ++e) o[e] = g[e] * up[e] * __builtin_amdgcn_rcpf(1.0f + __builtin_amdgcn_exp2f(-g[e] * LOG2E));
            st_bf16x4(act + (size_t)row * DFF + 128 * pn + 32 * wc + 16 * n + 4 * fq, o); }
    }
    __device__ __forceinline__ void operator()(const f32x4 (&acc)[2][2][4][2], const Unit& u, int wr, int wc, int fr, int fq) const { EPI_MAIN_LOOP(row_epi(a_, row, u.pn, wc, fr, fq)) }
};

template <class Epi>
__device__ __forceinline__ void skinny_phase(PG8_LAS unsigned char* lds, const bf16_t* A16, const bf16_t* Bt, int K, int NN, const Epi& E) {
    int tid_ = threadIdx.x; asm volatile("" : "+v"(tid_));
    const int tid = tid_, lane = tid & 63, wid = __builtin_amdgcn_readfirstlane(tid >> 6), fr = lane & 15, fq = lane >> 4;
    const int nk = K / 32;
    for (int task = blockIdx.x; task < 4 * NN; task += gridDim.x) {
        const int pn = task >> 2, wc = task & 3;
        f32x4 a[2][2];
#pragma unroll
        for (int bj = 0; bj < 2; ++bj)
#pragma unroll
            for (int n = 0; n < 2; ++n) a[bj][n] = (f32x4){0.f, 0.f, 0.f, 0.f};
        bool scaled = false;
        for (int it = wid; it < nk; it += 8) {
            const int k0 = 32 * it;
            if constexpr (Epi::MIDSCALE) { if (!scaled && k0 >= (K >> 1)) { E.mid_row(a, fr); scaled = true; } }
            const bf16x8 av = *(const bf16x8*)(A16 + (size_t)fr * K + k0 + 8 * fq);
#pragma unroll
            for (int bj = 0; bj < 2; ++bj)
#pragma unroll
                for (int n = 0; n < 2; ++n) { const bf16x8 bv = *(const bf16x8*)(Bt + (size_t)(256 * pn + 128 * bj + 32 * wc + 16 * n + fr) * K + k0 + 8 * fq);
                    a[bj][n] = __builtin_amdgcn_mfma_f32_16x16x32_bf16(bv, av, a[bj][n], 0, 0, 0); }
        }
        if constexpr (Epi::MIDSCALE) { if (!scaled) E.mid_row(a, fr); }
        PG8_LAS f32x4* red = (PG8_LAS f32x4*)lds;
#pragma unroll
        for (int bj = 0; bj < 2; ++bj)
#pragma unroll
            for (int n = 0; n < 2; ++n) red[(wid * 64 + lane) * 4 + bj * 2 + n] = a[bj][n];
        __syncthreads();
        if (wid == 0) {
#pragma unroll
            for (int w = 1; w < 8; ++w)
#pragma unroll
                for (int bj = 0; bj < 2; ++bj)
#pragma unroll
                    for (int n = 0; n < 2; ++n) a[bj][n] += red[(w * 64 + lane) * 4 + bj * 2 + n];
            E.row_epi(a, fr, pn, wc, fr, fq);
        }
        __syncthreads();
    }
}
template <class Epi, class Sched, bool ALIGN_EPI = false, bool SP2 = false>
__device__ __forceinline__ void gemm_phase(PG8_LAS unsigned char* lds, const Gemm g, const Sched& S, const Epi& E) {
    int tid_ = threadIdx.x; asm volatile("" : "+v"(tid_));
    const int tid = tid_, wid = __builtin_amdgcn_readfirstlane(tid >> 6), lane = tid & 63, wr = wid >> 2, wc = wid & 3, fr = lane & 15, fq = lane >> 4;
    int K_ = g.K; asm volatile("" : "+s"(K_)); const int K = K_, nt = K / BK;
    unsigned voffA[2], voffB[2];
#pragma unroll
    for (int i = 0; i < 2; ++i) { int R, C; stage_rc(tid * 16 + i * 8192, R, C); const int Rb = Epi::PERM ? ((R & ~31) + perm32(R & 31)) : R;
        voffA[i] = (unsigned)(R * K + C) * 2u; voffB[i] = (unsigned)(Rb * K + C) * 2u; }
    const size_t kstep = (size_t)(BK * 2);
    const size_t hstep = (size_t)HALF * K * 2;
    const size_t tstep = 2 * hstep;
    const unsigned ldsw = (unsigned)wid * 1024u;
    const int aoff = lds_byte(wr * 64 + fr, fq * 8), boff = lds_byte(wc * 32 + fr, fq * 8);
#define PG8_SA(b, h) (((b) * 2 + (h)) * HTB)
#define PG8_SB(b, h) ((4 + (b) * 2 + (h)) * HTB)
#define PG8_STAGE(bufoff, gbase, voff) do { _Pragma("unroll") for (int _i = 0; _i < 2; ++_i) \
        __builtin_amdgcn_global_load_lds((const unsigned*)((const char*)(gbase) + (voff)[_i]), (PG8_LAS unsigned*)(lds + (bufoff) + ldsw + _i * 8192), 16, 0, 0); } while (0)
#define PG8_LDA(dst, b, h) do { _Pragma("unroll") for (int m = 0; m < 4; ++m) _Pragma("unroll") for (int k = 0; k < 2; ++k) dst[m][k] = *(const PG8_LAS bf16x8*)(lds + PG8_SA(b, h) + aoff + m * 2048 + k * 1024); } while (0)
#define PG8_LDB(dst, b, h) do { _Pragma("unroll") for (int n = 0; n < 2; ++n) _Pragma("unroll") for (int k = 0; k < 2; ++k) dst[n][k] = *(const PG8_LAS bf16x8*)(lds + PG8_SB(b, h) + boff + n * 2048 + k * 1024); } while (0)
#define PG8_MMA(ai, bj, At, Bt) do { __builtin_amdgcn_s_setprio(1); _Pragma("unroll") for (int m = 0; m < 4; ++m) _Pragma("unroll") for (int n = 0; n < 2; ++n) _Pragma("unroll") for (int k = 0; k < 2; ++k) \
        acc[ai][bj][m][n] = __builtin_amdgcn_mfma_f32_16x16x32_bf16(Bt[n][k], At[m][k], acc[ai][bj][m][n], 0, 0, 0); __builtin_amdgcn_s_setprio(0); } while (0)
#define PG8_WAIT_V(n) asm volatile("s_waitcnt vmcnt(" #n ")" ::: "memory")
#define PG8_WAIT_L(n) asm volatile("s_waitcnt lgkmcnt(" #n ")" ::: "memory")
#define PG8_BAR __builtin_amdgcn_s_barrier()
#define PG8_SCHED __builtin_amdgcn_sched_barrier(0)
    Unit cur, nxt; int ui = 0;
    if (!S.next(0, cur)) return;
    f32x4 acc[2][2][4][2];
#pragma unroll
    for (int a = 0; a < 2; ++a)
#pragma unroll
        for (int b = 0; b < 2; ++b)
#pragma unroll
            for (int m = 0; m < 4; ++m)
#pragma unroll
                for (int n = 0; n < 2; ++n) acc[a][b][m][n] = (f32x4){0.f, 0.f, 0.f, 0.f};
    bf16x8 At[4][2], B0[2][2], B1[2][2];
    const char* cA = (const char*)g.A + (size_t)cur.pm * tstep + (g.apad ? (size_t)((cur.pm >> 4) * 128 + 128) * (size_t)K * 2 : (size_t)0); const char* cB = (const char*)g.Bt + (size_t)cur.pn * tstep;
    S.a_ready(cur);
    if constexpr (SP2) {
        PG8_STAGE(PG8_SB(0, 0), cB, voffB); PG8_STAGE(PG8_SB(0, 1), cB + hstep, voffB); PG8_STAGE(PG8_SA(0, 0), cA, voffA); PG8_STAGE(PG8_SA(0, 1), cA + hstep, voffA);
        if (wr == 1) PG8_BAR;
        PG8_WAIT_V(2); PG8_BAR;
        PG8_STAGE(PG8_SB(1, 0), cB + kstep, voffB); PG8_STAGE(PG8_SA(1, 0), cA + kstep, voffA); PG8_STAGE(PG8_SB(1, 1), cB + hstep + kstep, voffB);
        PG8_WAIT_V(6); PG8_BAR;
    } else {
        PG8_STAGE(PG8_SB(0, 0), cB, voffB); PG8_STAGE(PG8_SA(0, 0), cA, voffA); PG8_STAGE(PG8_SB(0, 1), cB + hstep, voffB); PG8_STAGE(PG8_SA(0, 1), cA + hstep, voffA);
        if (wr == 1) PG8_BAR;
        PG8_WAIT_V(4); PG8_BAR;
        PG8_STAGE(PG8_SB(1, 0), cB + kstep, voffB); PG8_STAGE(PG8_SA(1, 0), cA + kstep, voffA); PG8_STAGE(PG8_SB(1, 1), cB + hstep + kstep, voffB);
        PG8_WAIT_V(6); PG8_BAR;
    }
    for (;;) {
        const bool has_next = S.next(ui + 1, nxt);
        if constexpr (Epi::MIDSCALE) E.prep(cur, wid, wr, lane);
        const char* nA = has_next ? (const char*)g.A + (size_t)nxt.pm * tstep + (g.apad ? (size_t)((nxt.pm >> 4) * 128 + 128) * (size_t)K * 2 : (size_t)0) : cA; const char* nB = has_next ? (const char*)g.Bt + (size_t)nxt.pn * tstep : cB;
        for (int t = 0; t < nt; t += 2) {
            const bool last = (t == nt - 2);
            if constexpr (Epi::MIDSCALE) { if (t == (nt >> 1)) E.mid(acc, cur, wr, wc, fr, fq); }
            const char* a1 = cA + (size_t)(t + 1) * kstep;
            const char* a2 = last ? nA : cA + (size_t)(t + 2) * kstep; const char* b2 = last ? nB : cB + (size_t)(t + 2) * kstep;
            const char* a3 = a2 + kstep; const char* b3 = b2 + kstep;
            if (last && has_next) S.a_ready(nxt);
            if constexpr (SP2) {
            PG8_LDB(B0, 0, 0); PG8_LDB(B1, 0, 1); PG8_SCHED; PG8_LDA(At, 0, 0); PG8_STAGE(PG8_SA(1, 1), a1 + hstep, voffA);
            PG8_WAIT_V(8); PG8_WAIT_L(0); PG8_BAR; PG8_MMA(0, 0, At, B0); PG8_MMA(0, 1, At, B1); PG8_BAR; PG8_SCHED;
            PG8_LDA(At, 0, 1); PG8_STAGE(PG8_SB(0, 0), b2, voffB); PG8_STAGE(PG8_SB(0, 1), b2 + hstep, voffB); PG8_STAGE(PG8_SA(0, 0), a2, voffA);
            PG8_WAIT_V(8); PG8_WAIT_L(0); PG8_BAR; PG8_MMA(1, 0, At, B0); PG8_MMA(1, 1, At, B1); PG8_BAR; PG8_SCHED;
            PG8_LDB(B0, 1, 0); PG8_LDB(B1, 1, 1); PG8_SCHED; PG8_LDA(At, 1, 0); PG8_STAGE(PG8_SA(0, 1), a2 + hstep, voffA);
            PG8_WAIT_V(8); PG8_WAIT_L(0); PG8_BAR; PG8_MMA(0, 0, At, B0); PG8_MMA(0, 1, At, B1); PG8_BAR; PG8_SCHED;
            PG8_LDA(At, 1, 1); PG8_STAGE(PG8_SB(1, 0), b3, voffB); PG8_STAGE(PG8_SB(1, 1), b3 + hstep, voffB); PG8_STAGE(PG8_SA(1, 0), a3, voffA);
            PG8_WAIT_V(8); PG8_WAIT_L(0); PG8_BAR; PG8_MMA(1, 0, At, B0); PG8_MMA(1, 1, At, B1); PG8_BAR; PG8_SCHED;
            } else {
            PG8_LDB(B0, 0, 0); PG8_SCHED; PG8_LDA(At, 0, 0); PG8_STAGE(PG8_SA(1, 1), a1 + hstep, voffA);
            PG8_WAIT_L(8); PG8_BAR; PG8_WAIT_L(0); PG8_MMA(0, 0, At, B0); PG8_BAR; PG8_SCHED;
            PG8_LDB(B1, 0, 1); PG8_STAGE(PG8_SB(0, 0), b2, voffB);
            PG8_BAR; PG8_WAIT_L(0); PG8_MMA(0, 1, At, B1); PG8_BAR;
            PG8_LDA(At, 0, 1); PG8_STAGE(PG8_SA(0, 0), a2, voffA);
            PG8_BAR; PG8_WAIT_L(0); PG8_MMA(1, 0, At, B0); PG8_BAR; PG8_SCHED;
            PG8_STAGE(PG8_SB(0, 1), b2 + hstep, voffB);
            PG8_WAIT_V(6); PG8_BAR; PG8_MMA(1, 1, At, B1); PG8_BAR;
            PG8_LDB(B0, 1, 0); PG8_SCHED; PG8_LDA(At, 1, 0); PG8_STAGE(PG8_SA(0, 1), a2 + hstep, voffA);
            PG8_WAIT_L(8); PG8_BAR; PG8_WAIT_L(0); PG8_MMA(0, 0, At, B0); PG8_BAR; PG8_SCHED;
            PG8_LDB(B1, 1, 1); PG8_STAGE(PG8_SB(1, 0), b3, voffB);
            PG8_BAR; PG8_WAIT_L(0); PG8_MMA(0, 1, At, B1); PG8_BAR;
            PG8_LDA(At, 1, 1); PG8_STAGE(PG8_SA(1, 0), a3, voffA);
            PG8_BAR; PG8_WAIT_L(0); PG8_MMA(1, 0, At, B0); PG8_BAR; PG8_SCHED;
            PG8_STAGE(PG8_SB(1, 1), b3 + hstep, voffB);
            PG8_WAIT_V(6); PG8_BAR; PG8_MMA(1, 1, At, B1); PG8_BAR;
            }
        }
        if constexpr (ALIGN_EPI) { if (wr == 0) PG8_BAR; }
        if constexpr (!Epi::AFTER_DRAIN) { E(acc, cur, wr, wc, fr, fq); S.done(cur); }
        if (!has_next) break;
#pragma unroll
        for (int a = 0; a < 2; ++a)
#pragma unroll
            for (int b = 0; b < 2; ++b)
#pragma unroll
                for (int m = 0; m < 4; ++m)
#pragma unroll
                    for (int n = 0; n < 2; ++n) acc[a][b][m][n] = (f32x4){0.f, 0.f, 0.f, 0.f};
        cur = nxt; cA = nA; cB = nB; ++ui;
        if constexpr (ALIGN_EPI) { if (wr == 1) PG8_BAR; }
    }
    PG8_WAIT_V(0);
    if constexpr (!ALIGN_EPI) { if (wr == 0) PG8_BAR; }
    PG8_BAR;
    if constexpr (Epi::AFTER_DRAIN) { E.fused(acc, cur, wr, wc, fr, fq, lds, wid, lane); S.done(cur); }
#undef PG8_SA
#undef PG8_SB
#undef PG8_STAGE
#undef PG8_LDA
#undef PG8_LDB
#undef PG8_MMA
#undef PG8_WAIT_V
#undef PG8_WAIT_L
#undef PG8_BAR
#undef PG8_SCHED
}
}
namespace att {
#define ALAS __attribute__((address_space(3)))
typedef unsigned short bf16_t;
typedef short bf16x8 __attribute__((ext_vector_type(8)));
typedef short s16x4 __attribute__((ext_vector_type(4)));
typedef float f32x16 __attribute__((ext_vector_type(16)));
typedef unsigned u32x4 __attribute__((ext_vector_type(4)));
typedef float f32x2_t __attribute__((ext_vector_type(2))); typedef __bf16 bf16x2_t __attribute__((ext_vector_type(2)));
constexpr int KPMAX = 208, VP = 144, KSZ = 64 * KPMAX, VSZ = 64 * VP;
constexpr int OFF_V = 2 * KSZ, OFF_SCR = OFF_V + 2 * VSZ, OFF_Q = OFF_SCR + 8 * 256, LDS_BYTES = OFF_Q + 64;
constexpr float NEGF = -1e30f, THR = 6.0f;
__device__ __forceinline__ int crow(int r, int hi) { return (r & 3) + 8 * (r >> 2) + 4 * hi; }
__device__ __forceinline__ unsigned cvtpk(float lo, float hi) { f32x2_t v = {lo, hi}; bf16x2_t b = __builtin_convertvector(v, bf16x2_t); return __builtin_bit_cast(unsigned, b); }
__device__ __forceinline__ bf16x8 pack8(const f32x16& p, int s) { u32x4 w; w.x = cvtpk(p[8 * s], p[8 * s + 1]); w.y = cvtpk(p[8 * s + 2], p[8 * s + 3]); w.z = cvtpk(p[8 * s + 4], p[8 * s + 5]); w.w = cvtpk(p[8 * s + 6], p[8 * s + 7]); return __builtin_bit_cast(bf16x8, w); }
typedef short v4i16_t __attribute__((ext_vector_type(4)));
__device__ __forceinline__ s16x4 vtr(const ALAS unsigned char* p) { return __builtin_bit_cast(s16x4, __builtin_amdgcn_ds_read_tr16_b64_v4i16((ALAS v4i16_t*)p)); }
__device__ __forceinline__ unsigned short f2bf(float f) { unsigned u = __builtin_bit_cast(unsigned, f); return (unsigned short)((u + 0x7fffu + ((u >> 16) & 1u)) >> 16); }

template <int DQK, bool SWA>
__device__ __forceinline__ void attn_unit(ALAS unsigned char* lds, const bf16_t* Qp, int qpitch, const bf16_t* Kp, int kpitch, const bf16_t* Krp, const bf16_t* Vp, int vpitch,
                                          bf16_t* Op, float* ssq, float sink2, int b, int qb) {
    constexpr int KP = DQK * 2 + 16, NS = DQK / 16;
    int tid_ = threadIdx.x; asm volatile("" : "+v"(tid_));
    const int tid = tid_, lane = tid & 63, wid = __builtin_amdgcn_readfirstlane(tid >> 6), r = lane & 31, h = lane >> 5;
    const size_t rowbase = (size_t)b * TT;
    const int q0 = qb * 256, q0w = q0 + wid * 32;
    const bool wave_valid = q0w < TT;
    const int NT = (q0 + 256) / 64 < TT / 64 ? (q0 + 256) / 64 : TT / 64;
    int t0 = 1; if (SWA) { t0 = (q0 - 128) / 64; if (t0 < 1) t0 = 1; }
    ALAS float* scr = (ALAS float*)(lds + OFF_SCR + wid * 256);
    bf16x8 qf[NS];
    { const int qr = (q0w + r) < TT ? (q0w + r) : TT - 1; const bf16_t* qrow = Qp + (rowbase + qr) * (size_t)qpitch;
#pragma unroll
      for (int s = 0; s < NS; ++s) qf[s] = *(const bf16x8*)(qrow + 16 * s + 8 * h); }
    const int srow = tid >> 3, sch = tid & 7, rrow = (tid >> 2) & 63, rch = tid & 3;
    u32x4 kreg, vreg, rreg = {0u, 0u, 0u, 0u};
#define AT_GLOAD(t) do { const size_t kr_ = rowbase + 64 * (t) + srow; kreg = *(const u32x4*)(Kp + kr_ * (size_t)kpitch + sch * 8); vreg = *(const u32x4*)(Vp + kr_ * (size_t)vpitch + sch * 8); \
        if (DQK == 96) { if (tid < 256) rreg = *(const u32x4*)(Krp + (rowbase + 64 * (t) + rrow) * 32 + rch * 8); } } while (0)
#define AT_LSTORE(buf) do { *(ALAS u32x4*)(lds + (buf) * KSZ + srow * KP + sch * 16) = kreg; *(ALAS u32x4*)(lds + OFF_V + (buf) * VSZ + srow * VP + sch * 16) = vreg; \
        if (DQK == 96) { if (tid < 256) *(ALAS u32x4*)(lds + (buf) * KSZ + rrow * KP + 128 + rch * 16) = rreg; } } while (0)
    AT_GLOAD(t0); AT_LSTORE(0);
    __syncthreads();
    float mrun = SWA ? sink2 : NEGF, lrun = (SWA && h == 0) ? 1.0f : 0.0f;
    f32x16 o0, o1;
#pragma unroll
    for (int i = 0; i < 16; ++i) { o0[i] = 0.f; o1[i] = 0.f; }
    const int q = q0w + r;
    for (int t = t0; t < NT; ++t) {
        const int buf = (t - t0) & 1;
        if (t + 1 < NT) AT_GLOAD(t + 1);
        const int kfirst = 64 * t;
        bool active = wave_valid && (kfirst <= q0w + 31);
        if (SWA) active = active && (kfirst + 63 >= q0w - 127);
        if (active) {
            f32x16 s0, s1;
#pragma unroll
            for (int i = 0; i < 16; ++i) { s0[i] = 0.f; s1[i] = 0.f; }
            const ALAS unsigned char* kb = lds + buf * KSZ + r * KP + h * 16;
#pragma unroll
            for (int s = 0; s < NS; ++s) { const bf16x8 k0 = *(const ALAS bf16x8*)(kb + s * 32), k1 = *(const ALAS bf16x8*)(kb + 32 * KP + s * 32);
                s0 = __builtin_amdgcn_mfma_f32_32x32x16_bf16(k0, qf[s], s0, 0, 0, 0); s1 = __builtin_amdgcn_mfma_f32_32x32x16_bf16(k1, qf[s], s1, 0, 0, 0); }
            const bool need_mask = SWA || (t == 1) || (kfirst + 63 > q0w);
            if (need_mask) {
#pragma unroll
                for (int i = 0; i < 16; ++i) { const int key = kfirst + crow(i, h), key1 = key + 32;
                    bool ok0 = (key <= q) && (key >= FRONT), ok1 = (key1 <= q) && (key1 >= FRONT);
                    if (SWA) { ok0 = ok0 && (q - key < 128); ok1 = ok1 && (q - key1 < 128); }
                    s0[i] = ok0 ? s0[i] : NEGF; s1[i] = ok1 ? s1[i] : NEGF; }
            }
            float rm = fmaxf(s0[0], s1[0]);
#pragma unroll
            for (int i = 1; i < 16; ++i) rm = fmaxf(rm, fmaxf(s0[i], s1[i]));
            rm = fmaxf(rm, __shfl_xor(rm, 32));
            if (__any(rm > mrun + THR)) {
                const float mn = fmaxf(mrun, rm), f = __builtin_amdgcn_exp2f(mrun - mn); mrun = mn; lrun *= f;
                if (h == 0) scr[r] = f;
#pragma unroll
                for (int i = 0; i < 16; ++i) { const float fi = scr[crow(i, h)]; o0[i] *= fi; o1[i] *= fi; }
            }
            float ls = 0.f;
#pragma unroll
            for (int i = 0; i < 16; ++i) { s0[i] = __builtin_amdgcn_exp2f(s0[i] - mrun); s1[i] = __builtin_amdgcn_exp2f(s1[i] - mrun); ls += s0[i] + s1[i]; }
            lrun += ls;
            const bf16x8 p0 = pack8(s0, 0), p1 = pack8(s0, 1), p2 = pack8(s1, 0), p3 = pack8(s1, 1);
            const ALAS unsigned char* vb_ = lds + OFF_V + buf * VSZ + (4 * h + ((lane & 15) >> 2)) * VP + ((lane >> 4) & 1) * 32 + (lane & 3) * 8;
#define AT_PV(P, rowoff) do { \
                { const s16x4 lo = vtr(vb_ + (rowoff) * VP), hi = vtr(vb_ + ((rowoff) + 8) * VP); const bf16x8 vf = __builtin_shufflevector(lo, hi, 0, 1, 2, 3, 4, 5, 6, 7); o0 = __builtin_amdgcn_mfma_f32_32x32x16_bf16(P, vf, o0, 0, 0, 0); } \
                { const s16x4 lo = vtr(vb_ + (rowoff) * VP + 64), hi = vtr(vb_ + ((rowoff) + 8) * VP + 64); const bf16x8 vf = __builtin_shufflevector(lo, hi, 0, 1, 2, 3, 4, 5, 6, 7); o1 = __builtin_amdgcn_mfma_f32_32x32x16_bf16(P, vf, o1, 0, 0, 0); } } while (0)
            AT_PV(p0, 0); AT_PV(p1, 16); AT_PV(p2, 32); AT_PV(p3, 48);
#undef AT_PV
        }
        if (t + 1 < NT) AT_LSTORE(buf ^ 1);
        __syncthreads();
    }
#undef AT_GLOAD
#undef AT_LSTORE
    if (wave_valid) {
        const float lt = lrun + __shfl_xor(lrun, 32);
        if (h == 0) scr[32 + r] = lt;
#pragma unroll
        for (int i = 0; i < 16; ++i) {
            const float li = scr[32 + crow(i, h)], inv = li > 0.f ? 1.0f / li : 0.f;
            const float a = o0[i] * inv, c = o1[i] * inv; const size_t row = rowbase + q0w + crow(i, h);
            Op[row * 1024 + r] = f2bf(a); Op[row * 1024 + 32 + r] = f2bf(c);
            float ss = a * a + c * c;
            ss += __shfl_xor(ss, 1); ss += __shfl_xor(ss, 2); ss += __shfl_xor(ss, 4); ss += __shfl_xor(ss, 8); ss += __shfl_xor(ss, 16);
            if (r == 0) ssq[row * 16] = ss;
        }
    }
    __syncthreads();
}
}
typedef unsigned short bf16;
#define LAS __attribute__((address_space(3)))
constexpr size_t MiB = 1u << 20;
constexpr int NWAVES = 8, NTHREADS = 512;
constexpr int LDS_BYTES = 147456;
static_assert(att::LDS_BYTES <= 131072, "attention LDS");
constexpr size_t WS_CTL = 0, CTL_BYTES = 65536;
constexpr size_t WS_H = 1 * MiB;
constexpr size_t WS_HB = WS_H + (size_t)MROWS * DM * 4;
constexpr size_t WS_W = WS_HB + (size_t)MROWS * DM * 2;
constexpr size_t WL_IN = 0, WL_Q = WL_IN + (size_t)INP * DM * 2, WL_KV = WL_Q + (size_t)768 * 256 * 2, WL_O = WL_KV + (size_t)1024 * 128 * 2,
                 WL_GU = WL_O + (size_t)DM * DM * 2, WL_D = WL_GU + (size_t)GUP * DM * 2, WL_END = WL_D + (size_t)DM * DFF * 2;
constexpr size_t WBUF = 22 * MiB;
static_assert(WL_END <= WBUF, "weight buffer");
constexpr size_t WS_PART = WS_W + 2 * WBUF;
constexpr size_t P_HSSA = 0, P_HSSB = P_HSSA + (size_t)MROWS * 64, P_SSQO = P_HSSB + (size_t)MROWS * 64, P_SSQQ = P_SSQO + (size_t)MROWS * 64, P_SSQKV = P_SSQQ + (size_t)MROWS * 16, P_END = P_SSQKV + (size_t)MROWS * 16;
constexpr size_t PM_H = (P_END + 255) & ~(size_t)255, PM_HB = PM_H + 16 * DM * 4, PM_HSSA = PM_HB + 16 * DM * 2, PM_HSSB = PM_HSSA + 1024, PM_SSQQ = PM_HSSB + 1024, PM_SSQKV = PM_SSQQ + 256,
                 PM_QLAT = PM_SSQKV + 256, PM_KVLAT = PM_QLAT + 16 * 256 * 2, PM_ACT = PM_KVLAT + 16 * 128 * 2, PM_END = PM_ACT + 16 * DFF * 2;
static_assert(PM_END <= 8 * MiB, "partials");
constexpr int MC = BATCH * SEQ;
constexpr size_t WS_R = WS_PART + 8 * MiB;
constexpr size_t R_QA = 0, R_KA = R_QA + (size_t)MROWS * 512 * 2, R_VA = R_KA + (size_t)MROWS * 128 * 2, R_QLAT = R_VA + (size_t)MROWS * 128 * 2, R_KVLAT = R_QLAT + (size_t)MROWS * 256 * 2,
                 R_KR = R_KVLAT + (size_t)MROWS * 128 * 2, R_QM = R_KR + (size_t)MROWS * 32 * 2, R_KN = R_QM + (size_t)MROWS * 768 * 2, R_VB = R_KN + (size_t)MROWS * 512 * 2,
                 R_O = R_VB + (size_t)MROWS * 512 * 2, R_END = R_O + (size_t)MROWS * 1024 * 2;
constexpr size_t R_ACT = 0;
static_assert((size_t)MROWS * DFF * 2 <= R_END, "act overlay");
constexpr size_t WS_END = WS_R + R_END;
static_assert(WS_END <= 512 * MiB, "workspace must fit 512 MiB");

struct Args {
    const float *x, *meta, *attn_norm, *w_in, *q_norm, *w_q_up, *kv_norm, *w_kv_up, *sinks, *out_norm_swa, *out_norm_mla, *w_o, *ffn_norm, *w_gate, *w_up, *w_down, *final_norm;
    float* out; unsigned char* ws; int ph_lo, ph_hi;
};

__device__ __forceinline__ unsigned f2bf_u(float f) { unsigned u = __builtin_bit_cast(unsigned, f); return (u + 0x7fffu + ((u >> 16) & 1u)) >> 16; }
__device__ __forceinline__ unsigned pk2(float lo, float hi) { return f2bf_u(lo) | (f2bf_u(hi) << 16); }
__device__ __forceinline__ float wave_sum(float v) {
#pragma unroll
    for (int o = 1; o < 64; o <<= 1) v += __shfl_xor(v, o);
    return v;
}

__device__ __forceinline__ int src_in(int np) { const int pn = np >> 8, bj = (np >> 7) & 1, o = np & 127;
    if (pn < 2) return (4 * pn + (o >> 5)) * 64 + (o & 31) + 32 * bj;
    if (pn == 2) { if (o < 64) return 512 + (o >> 5) * 64 + (o & 31) + 32 * bj; if (o < 80) return 1152 + (o - 64) + 16 * bj; return -1; }
    if (pn == 3) return bj ? 1024 + o : 640 + o;
    return 768 + 128 * bj + o; }
__device__ __forceinline__ int src_qup(int np) { const int pn = np >> 8, op = np & 255;
    if (pn < 2) return (4 * pn + (op >> 6)) * 96 + (op & 63);
    const int bj = op >> 7, o = op & 127; return (o >> 4) * 96 + 64 + (o & 15) + 16 * bj; }
__device__ __forceinline__ int src_kvup(int np) { const int pn = np >> 8, op = np & 255; return (4 * (pn & 1) + (op >> 6)) * 128 + (pn >= 2 ? 64 : 0) + (op & 63); }

template <int MODE>
__device__ __forceinline__ void conv_item(const float* W, const float* W2, const float* gain, const float* gain2, int K, int Nsrc, bf16* WT, LAS float* scr, int item, int nblk, int lane) {
    const int kb = item / nblk, nb = item % nblk, k0 = 64 * kb, n0 = 32 * nb;
    const int np = n0 + (lane & 31);
    int src; float cs = 1.0f; const float* Wp = W;
    if (MODE == 0) { src = src_in(np); if (np < 512) cs = 0.125f * LOG2E; }
    else if (MODE == 1) { src = src_qup(np); cs = 0.10206207261596577f * LOG2E; }
    else if (MODE == 2) src = src_kvup(np);
    else if (MODE == 4) { src = 128 * (np >> 8) + (np & 127); if ((np >> 7) & 1) Wp = W2; }
    else src = np;
#pragma unroll 8
    for (int i = 0; i < 32; ++i) { const int kk = 2 * i + (lane >> 5), k = k0 + kk;
        float g = 1.0f; if (MODE == 3) g = (k < 512) ? gain[k] : gain2[k - 512]; else if (MODE != 5) g = gain[k];
        scr[kk * 33 + (lane & 31)] = (src >= 0) ? Wp[(size_t)k * Nsrc + src] * g * cs : 0.0f; }
    asm volatile("s_waitcnt lgkmcnt(0)" ::: "memory");
    const int c = lane & 7;
#pragma unroll
    for (int j = 0; j < 4; ++j) { const int n = (lane >> 3) + 8 * j; const LAS float* s = scr + (8 * c) * 33 + n;
        pg8::u32x4 o; o.x = pk2(s[0 * 33], s[1 * 33]); o.y = pk2(s[2 * 33], s[3 * 33]); o.z = pk2(s[4 * 33], s[5 * 33]); o.w = pk2(s[6 * 33], s[7 * 33]);
        *(pg8::u32x4*)(WT + (size_t)(n0 + n) * K + k0 + 8 * c) = o; }
    asm volatile("s_waitcnt lgkmcnt(0)" ::: "memory");
}
__device__ __forceinline__ void conv_layer(const Args& a, int l, unsigned char* wbuf, LAS unsigned char* lds) {
    int tid_ = threadIdx.x; asm volatile("" : "+v"(tid_));
    const int lane = tid_ & 63, wave = tid_ >> 6;
    LAS float* scr = (LAS float*)(lds + wave * 16384);
    const int gw = blockIdx.x * NWAVES + wave, NGW = gridDim.x * NWAVES;
    constexpr int I0 = (DM / 64) * (INP / 32), I1 = (256 / 64) * (768 / 32), I2 = (128 / 64) * (1024 / 32), I3 = (DM / 64) * (DM / 32), I4 = (DM / 64) * (GUP / 32), I5 = (DFF / 64) * (DM / 32);
    constexpr int NIT = I0 + I1 + I2 + I3 + I4 + I5;
    for (int it = gw; it < NIT; it += NGW) {
        int r = it;
        if (r < I0) { conv_item<0>(a.w_in + (size_t)l * DM * INW, nullptr, a.attn_norm + l * DM, nullptr, DM, INW, (bf16*)(wbuf + WL_IN), scr, r, INP / 32, lane); continue; } r -= I0;
        if (r < I1) { conv_item<1>(a.w_q_up + (size_t)l * 256 * 768, nullptr, a.q_norm + l * 256, nullptr, 256, 768, (bf16*)(wbuf + WL_Q), scr, r, 768 / 32, lane); continue; } r -= I1;
        if (r < I2) { conv_item<2>(a.w_kv_up + (size_t)l * 128 * 1024, nullptr, a.kv_norm + l * 128, nullptr, 128, 1024, (bf16*)(wbuf + WL_KV), scr, r, 1024 / 32, lane); continue; } r -= I2;
        if (r < I3) { conv_item<3>(a.w_o + (size_t)l * DM * DM, nullptr, a.out_norm_swa + l * 512, a.out_norm_mla + l * 512, DM, DM, (bf16*)(wbuf + WL_O), scr, r, DM / 32, lane); continue; } r -= I3;
        if (r < I4) { conv_item<4>(a.w_gate + (size_t)l * DM * DFF, a.w_up + (size_t)l * DM * DFF, a.ffn_norm + l * DM, nullptr, DM, DFF, (bf16*)(wbuf + WL_GU), scr, r, GUP / 32, lane); continue; } r -= I4;
        conv_item<5>(a.w_down + (size_t)l * DFF * DM, nullptr, nullptr, nullptr, DFF, DM, (bf16*)(wbuf + WL_D), scr, r, DM / 32, lane);
    }
}

__device__ __forceinline__ void init_rows(const Args& a, unsigned char* ws) {
    const int lane = threadIdx.x & 63, wave = threadIdx.x >> 6; const int gw = blockIdx.x * NWAVES + wave, NGW = gridDim.x * NWAVES;
    for (int row = gw; row < MC + NMETA; row += NGW) {
        const bool meta = row >= MC; const int r = meta ? row - MC : row;
        const float* src = meta ? a.meta + (size_t)r * DM : a.x + (size_t)r * DM;
        float* H = (float*)(ws + (meta ? WS_PART + PM_H : WS_H)); bf16* HB = (bf16*)(ws + (meta ? WS_PART + PM_HB : WS_HB)); float* hss = (float*)(ws + WS_PART + (meta ? PM_HSSA : P_HSSA));
        pg8::f32x4 v[4]; float s = 0.f;
#pragma unroll
        for (int j = 0; j < 4; ++j) { v[j] = *((const pg8::f32x4*)src + lane + 64 * j); s += pg8::sq4(v[j]); }
        s = wave_sum(s);
#pragma unroll
        for (int j = 0; j < 4; ++j) { pg8::st_bf16x4(HB + (size_t)r * DM + 4 * (lane + 64 * j), v[j]); }
        if (lane < 16) hss[(size_t)r * 16 + lane] = (lane == 0) ? s : 0.f;
    }
}
__device__ __forceinline__ void final_rows(const Args& a, const bf16* HBf, const float* hss) {
    const int lane = threadIdx.x & 63, wave = threadIdx.x >> 6; const int gw = blockIdx.x * NWAVES + wave, NGW = gridDim.x * NWAVES;
    for (int o = gw; o < BATCH * SEQ; o += NGW) {
        const int row = o;
        const float rs = pg8::rsq(pg8::sum16(hss, row) * (1.0f / DM) + RMS_EPS);
#pragma unroll
        for (int j = 0; j < 4; ++j) { const pg8::u32x2 hw = *((const pg8::u32x2*)(HBf + (size_t)row * DM) + lane + 64 * j); pg8::f32x4 v; v[0] = __builtin_bit_cast(float, hw.x << 16); v[1] = __builtin_bit_cast(float, hw.x & 0xffff0000u); v[2] = __builtin_bit_cast(float, hw.y << 16); v[3] = __builtin_bit_cast(float, hw.y & 0xffff0000u);
            const pg8::f32x4 g = *((const pg8::f32x4*)a.final_norm + lane + 64 * j);
            *((pg8::f32x4*)(a.out + (size_t)o * DM) + lane + 64 * j) = v * rs * g; }
    }
}

constexpr int N_ATT_UNITS = 2 * 17 * 64;
__device__ __forceinline__ void attn_phase(const Args& a, int l, unsigned char* ws, LAS unsigned char* lds) {
    const int lq = l; l &= 3;
    unsigned char* R = ws + WS_R;
    const bf16 *QA = (const bf16*)(R + R_QA), *KA = (const bf16*)(R + R_KA), *VA = (const bf16*)(R + R_VA), *KR = (const bf16*)(R + R_KR), *QM = (const bf16*)(R + R_QM), *KN = (const bf16*)(R + R_KN), *VB = (const bf16*)(R + R_VB);
    bf16* O = (bf16*)(R + R_O); float* ssqO = (float*)(ws + WS_PART + P_SSQO);
    LAS int* qslot = (LAS int*)(lds + att::OFF_Q);
    const unsigned xcc = ((unsigned)__builtin_amdgcn_s_getreg((3 << 11) | 20) & 0xFu) & 7u;
    unsigned* ctr = (unsigned*)(ws + WS_CTL) + 64 * lq + 8 * 64 * (int)xcc;
    constexpr int PER_X = N_ATT_UNITS / 8;
    for (int pass = 0; pass < 8; ++pass) {
        const unsigned x = (xcc + (unsigned)pass) & 7u; unsigned* c = (unsigned*)(ws + WS_CTL) + 64 * lq + 8 * 64 * (int)x;
        for (;;) {
            if (threadIdx.x == 0) *qslot = (int)atomicAdd(c, 1u);
            __syncthreads();
            const int u = *qslot;
            __syncthreads();
            if (u >= PER_X) break;
            if (u < PER_X / 2) {
                const int bh = 8 * (u / 17) + (int)x, qb = 16 - u % 17, b = bh >> 3, hd = bh & 7;
                att::attn_unit<96, false>(lds, QM + hd * 96, 768, KN + hd * 64, 512, KR, VB + hd * 64, 512, O + 512 + hd * 64, ssqO + 8 + hd, 0.f, b, qb);
            } else {
                const int v = u - PER_X / 2; const int bh = 8 * (v / 17) + (int)x, qb = 16 - v % 17, b = bh >> 3, hq = bh & 7, kv = hq >> 2;
                att::attn_unit<64, true>(lds, QA + hq * 64, 512, KA + kv * 64, 128, nullptr, VA + kv * 64, 128, O + hq * 64, ssqO + hq, a.sinks[l * 8 + hq] * LOG2E, b, qb);
            }
        }
    }
    (void)ctr;
}

#define XB_TMO      128
#define XB_XCNT(j)  (256  + 64 * (j))
#define XB_XSUB(j)  (1280 + 64 * (j))
#define XB_XGEN(j)  (2304 + 64 * (j))
#define XB_TOP      3328
#define XB_TOPGEN   3392
#define XCD_BAR_WORDS 3456
#define XB_SPIN_CAP (1u << 18)

__device__ __forceinline__ unsigned xb_ld(unsigned* p)              { return __hip_atomic_load(p, __ATOMIC_RELAXED, __HIP_MEMORY_SCOPE_AGENT); }
__device__ __forceinline__ unsigned xb_add(unsigned* p, unsigned v) { return __hip_atomic_fetch_add(p, v, __ATOMIC_RELAXED, __HIP_MEMORY_SCOPE_AGENT); }
__device__ __forceinline__ unsigned xb_xcc_id() { return (unsigned)__builtin_amdgcn_s_getreg((3 << 11) | 20) & 0xFu; }
#define XB_SPIN(cond, bar) do { unsigned _sp = 0; while (cond) { __builtin_amdgcn_s_sleep(1); \
    if ((++_sp & 255u) == 0u) { if (xb_ld(&(bar)[XB_TMO])) break; if (_sp > XB_SPIN_CAP) { atomicAdd(&(bar)[XB_TMO], 1u); break; } } } } while (0)

struct XcdBarrier {
    unsigned* bar; unsigned x;
    volatile LAS unsigned* st;
};

__device__ __forceinline__ XcdBarrier xcd_barrier_post(unsigned* bar, volatile LAS unsigned* st) {
    XcdBarrier b; b.bar = bar; b.x = xb_xcc_id(); b.st = st;
    if (threadIdx.x == 0) (void)xb_add(&bar[XB_XCNT(b.x)], 1u);
    return b;
}
__device__ __forceinline__ void xcd_barrier_complete(unsigned* bar, unsigned x, unsigned& nloc, unsigned& nx) {
    const unsigned G = gridDim.x * gridDim.y * gridDim.z;
    unsigned sum, cnt, mine, sp = 0u;
    for (;;) {
        sum = 0u; cnt = 0u; mine = 0u;
#pragma unroll
        for (unsigned j = 0; j < 16; ++j) { const unsigned c = xb_ld(&bar[XB_XCNT(j)]); sum += c; cnt += (c > 0u) ? 1u : 0u; mine = (j == x) ? c : mine; }
        if (sum == G) break;
        __builtin_amdgcn_s_sleep(1);
        if ((++sp & 255u) == 0u) { if (xb_ld(&bar[XB_TMO])) break; if (sp > XB_SPIN_CAP) { atomicAdd(&bar[XB_TMO], 1u); break; } }
    }
    nloc = mine > 0u ? mine : 1u; nx = cnt > 0u ? cnt : 1u;
}

__device__ __forceinline__ void xcd_barrier(const XcdBarrier& b) {
    asm volatile("s_waitcnt vmcnt(0)" ::: "memory");
    __syncthreads();
    if (threadIdx.x == 0) {
        unsigned* bar = b.bar;
        __builtin_amdgcn_s_waitcnt(0);
        unsigned nloc = b.st[0], nx = b.st[1];
        if (nloc == 0u) { xcd_barrier_complete(bar, b.x, nloc, nx); b.st[0] = nloc; b.st[1] = nx; }
        const unsigned old = xb_add(&bar[XB_XSUB(b.x)], 1u);
        const unsigned gen = old / nloc;
        if (old + 1u == (gen + 1u) * nloc) {
            __builtin_amdgcn_fence(__ATOMIC_RELEASE, "agent");
            asm volatile("s_waitcnt vmcnt(0)" ::: "memory");
            const unsigned og = xb_add(&bar[XB_TOP], 1u);
            const unsigned tg = og / nx;
            if (og + 1u == (tg + 1u) * nx) xb_add(&bar[XB_TOPGEN], 1u);
            else XB_SPIN(xb_ld(&bar[XB_TOPGEN]) == tg, bar);
            __builtin_amdgcn_fence(__ATOMIC_ACQUIRE, "agent");
            xb_add(&bar[XB_XGEN(b.x)], 1u);
            asm volatile("s_waitcnt vmcnt(0)" ::: "memory");
        } else {
            XB_SPIN(xb_ld(&bar[XB_XGEN(b.x)]) == gen, bar);
            __builtin_amdgcn_fence(__ATOMIC_ACQUIRE, "agent");
            asm volatile("s_waitcnt vmcnt(0)" ::: "memory");
        }
    }
    __syncthreads();
}

constexpr int CW_BAR = 4096;
constexpr int XB_LDS_OFF = 131072 + 8192;
#ifndef PHM
#define PHM 255
#endif
#ifndef PROBE_DUP
#define PROBE_DUP 0
#endif
#ifndef PROBE_SYNC
#define PROBE_SYNC 0
#endif
__global__ void __launch_bounds__(NTHREADS, 2) fwd_megakernel(Args a) {
    extern __shared__ __attribute__((aligned(16))) unsigned char lds_raw[];
    LAS unsigned char* lds = (LAS unsigned char*)lds_raw;
    cg::grid_group grid = cg::this_grid();
    const int lo = a.ph_lo, hi = a.ph_hi;
    if (threadIdx.x < 2) ((LAS unsigned*)(lds + XB_LDS_OFF))[threadIdx.x] = 0u;
    __syncthreads();
    const XcdBarrier xbar = xcd_barrier_post((unsigned*)(a.ws + WS_CTL) + CW_BAR, (volatile LAS unsigned*)(lds + XB_LDS_OFF));
#define IN_PH(k) (lo <= (k) && (k) < hi)
#define SEAM(k) do { if (IN_PH(k) && IN_PH((k) + 1)) { if ((k) == 0) grid.sync(); else xcd_barrier(xbar); if (PROBE_SYNC) xcd_barrier(xbar); } } while (0)
#define WSL(w) unsigned char* w = a.ws; asm volatile("" : "+s"(w))
    if (IN_PH(0) && (PHM & 1)) { WSL(ws); init_rows(a, ws); conv_layer(a, 0, ws + WS_W, lds); __syncthreads(); }
    SEAM(0);
#pragma unroll 1
    for (int l = 0; l < DEPTH; ++l) {
        const int p = 1 + 6 * l;
        if (IN_PH(p) && (PHM & 2)) {
            { WSL(ws); unsigned char* R = ws + WS_R; unsigned char* wb = ws + WS_W + (size_t)(l & 1) * WBUF; unsigned char* pm_ = ws + WS_PART;
              pg8::EpiIn<true> E{(const float*)(pm_ + PM_HSSA), (bf16*)(R + R_QA), (bf16*)(R + R_KA), (bf16*)(R + R_VA), (bf16*)(pm_ + PM_QLAT), (bf16*)(pm_ + PM_KVLAT), (bf16*)(R + R_KR), (float*)(pm_ + PM_SSQQ), (float*)(pm_ + PM_SSQKV)};
              pg8::skinny_phase(lds, (const bf16*)(pm_ + PM_HB), (const bf16*)(wb + WL_IN), DM, INP / 256, E); }
            WSL(ws); unsigned char* R = ws + WS_R; unsigned char* wb = ws + WS_W + (size_t)(l & 1) * WBUF;
            pg8::Gemm g{(const bf16*)(ws + WS_HB), (const bf16*)(wb + WL_IN), MC, INP, DM, 0}; pg8::OrderCT<MC / 256, INP / 256> S; S.init((int)gridDim.x, (int)blockIdx.x);
            pg8::EpiIn<false> E{(const float*)(ws + WS_PART + P_HSSA), (bf16*)(R + R_QA), (bf16*)(R + R_KA), (bf16*)(R + R_VA), (bf16*)(R + R_QLAT), (bf16*)(R + R_KVLAT), (bf16*)(R + R_KR),
                         (float*)(ws + WS_PART + P_SSQQ), (float*)(ws + WS_PART + P_SSQKV)};
            pg8::gemm_phase<pg8::EpiIn<false>, pg8::OrderCT<MC / 256, INP / 256>, true, true>(lds, g, S, E);
        }
        SEAM(p);
        if (IN_PH(p + 1) && (PHM & 4)) {
            { WSL(ws); unsigned char* R = ws + WS_R; unsigned char* wb = ws + WS_W + (size_t)(l & 1) * WBUF; unsigned char* pm_ = ws + WS_PART;
              pg8::EpiQup<true> E{(const float*)(pm_ + PM_SSQQ), (bf16*)(R + R_QM)}; pg8::skinny_phase(lds, (const bf16*)(pm_ + PM_QLAT), (const bf16*)(wb + WL_Q), 256, 3, E); }
            { WSL(ws); unsigned char* R = ws + WS_R; unsigned char* wb = ws + WS_W + (size_t)(l & 1) * WBUF;
              pg8::Gemm g{(const bf16*)(R + R_QLAT), (const bf16*)(wb + WL_Q), MC, 768, 256, 0}; pg8::OrderCT<MC / 256, 3> S; S.init((int)gridDim.x, (int)blockIdx.x);
              pg8::EpiQup<false> E{(const float*)(ws + WS_PART + P_SSQQ), (bf16*)(R + R_QM)}; pg8::gemm_phase<pg8::EpiQup<false>, pg8::OrderCT<MC / 256, 3>, true, true>(lds, g, S, E); }
            { WSL(ws); unsigned char* R = ws + WS_R; unsigned char* wb = ws + WS_W + (size_t)(l & 1) * WBUF; unsigned char* pm_ = ws + WS_PART;
              pg8::EpiKvup<true> E{(const float*)(pm_ + PM_SSQKV), (bf16*)(R + R_KN), (bf16*)(R + R_VB)}; pg8::skinny_phase(lds, (const bf16*)(pm_ + PM_KVLAT), (const bf16*)(wb + WL_KV), 128, 4, E); }
            { WSL(ws); unsigned char* R = ws + WS_R; unsigned char* wb = ws + WS_W + (size_t)(l & 1) * WBUF;
              pg8::Gemm g{(const bf16*)(R + R_KVLAT), (const bf16*)(wb + WL_KV), MC, 1024, 128, 0}; pg8::OrderCT<MC / 256, 4> S; S.init((int)gridDim.x, (int)blockIdx.x);
              pg8::EpiKvup<false> E{(const float*)(ws + WS_PART + P_SSQKV), (bf16*)(R + R_KN), (bf16*)(R + R_VB)}; pg8::gemm_phase<pg8::EpiKvup<false>, pg8::OrderCT<MC / 256, 4>, true, true>(lds, g, S, E); }
        }
        SEAM(p + 1);
        if (IN_PH(p + 2) && (PHM & 8)) { WSL(ws); if (l + 1 < DEPTH) { conv_layer(a, l + 1, ws + WS_W + (size_t)((l + 1) & 1) * WBUF, lds); __syncthreads(); } attn_phase(a, l, ws, lds); if (PROBE_DUP & 8) attn_phase(a, l + 4, ws, lds); }
        SEAM(p + 2);
        if (IN_PH(p + 3) && (PHM & 16)) {
            { WSL(ws); unsigned char* R = ws + WS_R; unsigned char* wb = ws + WS_W + (size_t)(l & 1) * WBUF; unsigned char* pm_ = ws + WS_PART;
              pg8::EpiOut<true> E; E.H = (float*)(pm_ + PM_H); E.HB = (bf16*)(pm_ + PM_HB); E.hss_out = (float*)(pm_ + PM_HSSB); E.ssq_o = (const float*)(pm_ + P_SSQO); E.xlds = lds;
              pg8::skinny_phase(lds, (const bf16*)(R + R_O) + (size_t)FRONT * 1024, (const bf16*)(wb + WL_O), DM, 4, E); }
            WSL(ws); unsigned char* R = ws + WS_R; unsigned char* wb = ws + WS_W + (size_t)(l & 1) * WBUF;
            pg8::Gemm g{(const bf16*)(R + R_O), (const bf16*)(wb + WL_O), MC, DM, DM, 1}; pg8::OrderCT<MC / 256, 4> S; S.init((int)gridDim.x, (int)blockIdx.x);
            pg8::EpiOut<false> E; E.H = (float*)(ws + WS_H); E.HB = (bf16*)(ws + WS_HB); E.hss_out = (float*)(ws + WS_PART + P_HSSB); E.ssq_o = (const float*)(ws + WS_PART + P_SSQO); E.xlds = lds + pg8::STAGE_BYTES;
            pg8::gemm_phase<pg8::EpiOut<false>, pg8::OrderCT<MC / 256, 4>, true, true>(lds, g, S, E);
        }
        SEAM(p + 3);
        if (IN_PH(p + 4) && (PHM & 32)) {
            { WSL(ws); unsigned char* wb = ws + WS_W + (size_t)(l & 1) * WBUF; unsigned char* pm_ = ws + WS_PART;
              pg8::EpiGU<true> E{(const float*)(pm_ + PM_HSSB), (bf16*)(pm_ + PM_ACT)}; pg8::skinny_phase(lds, (const bf16*)(pm_ + PM_HB), (const bf16*)(wb + WL_GU), DM, GUP / 256, E); }
            WSL(ws); unsigned char* R = ws + WS_R; unsigned char* wb = ws + WS_W + (size_t)(l & 1) * WBUF;
            pg8::Gemm g{(const bf16*)(ws + WS_HB), (const bf16*)(wb + WL_GU), MC, GUP, DM, 0}; pg8::OrderCT<MC / 256, GUP / 256> S; S.init((int)gridDim.x, (int)blockIdx.x);
            pg8::EpiGU<false> E{(const float*)(ws + WS_PART + P_HSSB), (bf16*)(R + R_ACT)};
            pg8::gemm_phase<pg8::EpiGU<false>, pg8::OrderCT<MC / 256, GUP / 256>, true, true>(lds, g, S, E);
        }
        SEAM(p + 4);
        if (IN_PH(p + 5) && (PHM & 64)) {
            { WSL(ws); unsigned char* wb = ws + WS_W + (size_t)(l & 1) * WBUF; unsigned char* pm_ = ws + WS_PART;
              pg8::EpiDown<true> E; E.H = (float*)(pm_ + PM_H); E.HB = (bf16*)(pm_ + PM_HB); E.hss_out = (float*)(pm_ + PM_HSSA); E.ssq_o = nullptr;
              pg8::skinny_phase(lds, (const bf16*)(pm_ + PM_ACT), (const bf16*)(wb + WL_D), DFF, 4, E); }
            WSL(ws); unsigned char* R = ws + WS_R; unsigned char* wb = ws + WS_W + (size_t)(l & 1) * WBUF;
            pg8::Gemm g{(const bf16*)(R + R_ACT), (const bf16*)(wb + WL_D), MC, DM, DFF, 0}; pg8::OrderCT<MC / 256, 4> S; S.init((int)gridDim.x, (int)blockIdx.x);
            pg8::EpiDown<false> E; E.H = (float*)(ws + WS_H); E.HB = (bf16*)(ws + WS_HB); E.hss_out = (float*)(ws + WS_PART + P_HSSA); E.ssq_o = nullptr;
            pg8::gemm_phase<pg8::EpiDown<false>, pg8::OrderCT<MC / 256, 4>, true, true>(lds, g, S, E);
        }
        SEAM(p + 5);
    }
    if (IN_PH(1 + 6 * DEPTH) && (PHM & 128)) { WSL(ws); final_rows(a, (const bf16*)(ws + WS_HB), (const float*)(ws + WS_PART + P_HSSA)); }
#undef IN_PH
#undef SEAM
#undef WSL
}
constexpr int N_PHASES = 2 + 6 * DEPTH;

#ifndef MK_SPLIT
#define MK_SPLIT 0
#endif
extern "C" void kernel_launch(void* const* d_in, const int* in_sizes, int n_in, void* d_out, int out_size, void* d_ws, size_t ws_size, hipStream_t stream) {
    static int grid = 0;
    if (grid == 0) {
        if (n_in != 17 || ws_size < WS_END) { fprintf(stderr, "kernel_launch: need 17 inputs and >= %zu bytes of workspace; got n_in %d, ws %zu\n", (size_t)WS_END, n_in, ws_size); grid = -1; return; }
        int dev = 0, cus = 0, per_cu = 0;
        hipGetDevice(&dev); hipDeviceGetAttribute(&cus, hipDeviceAttributeMultiprocessorCount, dev);
        if (hipFuncSetAttribute((const void*)fwd_megakernel, hipFuncAttributeMaxDynamicSharedMemorySize, LDS_BYTES) != hipSuccess) { fprintf(stderr, "kernel_launch: hipFuncSetAttribute failed\n"); grid = -1; return; }
        if (hipOccupancyMaxActiveBlocksPerMultiprocessor(&per_cu, (const void*)fwd_megakernel, NTHREADS, LDS_BYTES) != hipSuccess || per_cu < 1) { fprintf(stderr, "kernel_launch: occupancy query says %d\n", per_cu); per_cu = 1; }
        (void)hipGetLastError();
        grid = cus * 1;
    }
    if (grid < 0) return;
    hipMemsetAsync((char*)d_ws + WS_CTL, 0, CTL_BYTES, stream);
    Args a{};
    const float** f = (const float**)&a;
    for (int i = 0; i < 17; ++i) f[i] = (const float*)d_in[i];
    a.out = (float*)d_out; a.ws = (unsigned char*)d_ws;
#if MK_SPLIT
    for (int ph = 0; ph < N_PHASES; ++ph) { a.ph_lo = ph; a.ph_hi = ph + 1; hipLaunchKernelGGL(fwd_megakernel, dim3(grid), dim3(NTHREADS), LDS_BYTES, stream, a); }
#else
    a.ph_lo = 0; a.ph_hi = N_PHASES;
    void* args[] = {&a};
    hipError_t e = hipLaunchCooperativeKernel((const void*)fwd_megakernel, dim3(grid), dim3(NTHREADS), args, LDS_BYTES, stream);
    if (e != hipSuccess) fprintf(stderr, "cooperative launch failed: %s (grid %d)\n", hipGetErrorString(e), grid);
#endif
}
```

```cpp
#include <hip/hip_runtime.h>
#include <hip/hip_cooperative_groups.h>
#include <cstdio>
#include <cstdint>
namespace cg = cooperative_groups;

constexpr int BATCH = 8, SEQ = 4096, DM = 1024, DEPTH = 4, NMETA = 16, FRONT = 112, TT = 4224;
constexpr int MROWS = BATCH * TT;
constexpr int INW = 1184, INP = 1280, DFF = 2816, GUP = 2 * DFF;
constexpr float RMS_EPS = 1e-6f;
constexpr float LOG2E = 1.4426950408889634f;
constexpr float LOG2_THETA = 13.287712379549449f;
constexpr float INV_2PI = 0.15915494309189535f;

namespace pg8 {
#define PG8_LAS __attribute__((address_space(3)))
typedef unsigned short bf16_t;
typedef short bf16x8 __attribute__((ext_vector_type(8)));
typedef float f32x4 __attribute__((ext_vector_type(4)));
typedef unsigned u32x4 __attribute__((ext_vector_type(4)));
constexpr int BM = 256, BK = 64, HALF = 128, HTB = HALF * BK * 2  , STAGE_BYTES = 8 * HTB, NXCD = 8, WGM = 8;

__host__ __device__ __forceinline__ int lds_byte(int r, int c) { const int st = (r >> 4) * 2 + (c >> 5), rr = r & 15, cc = c & 31, ob = rr * 64 + cc * 2; return st * 1024 + (ob ^ (((ob >> 9) & 1) << 5)); }
__host__ __device__ __forceinline__ void stage_rc(int b, int& R, int& C) { const int st = b / 1024, sb = b % 1024, swz = sb ^ (((sb >> 9) & 1) << 5); R = (st >> 1) * 16 + swz / 64; C = (st & 1) * 32 + (swz % 64) / 2; }
__host__ __device__ __forceinline__ int perm32(int rho) { const int n = rho >> 4, i = rho & 15; return 8 * (i >> 2) + 4 * n + (i & 3); }

struct Unit { int pm, pn; };
struct Gemm { const bf16_t* A; const bf16_t* Bt; int M, N, K; int apad; };

struct StaticOrder {
    int nM, nN, nwg, G, c;
    __host__ __device__ void init(int M, int N, int G_, int c_) { nM = M / BM; nN = N / BM; nwg = nM * nN; G = G_; c = c_; }
    __host__ __device__ bool next(int i, Unit& u) const {
        const long L = (long)i * G + c; if (L >= nwg) return false;
        int wgid = (int)L; { const int q = nwg / NXCD, r = nwg % NXCD, xcd = wgid % NXCD, off = wgid / NXCD; wgid = (xcd < r ? xcd * (q + 1) : r * (q + 1) + (xcd - r) * q) + off; }
        const int nig = WGM * nN, gid = wgid / nig, fm = gid * WGM, gsz = (nM - fm) < WGM ? (nM - fm) : WGM;
        u.pm = fm + ((wgid % nig) % gsz); u.pn = (wgid % nig) / gsz; return true;
    }
    __device__ __forceinline__ void a_ready(const Unit&) const {}
    __device__ __forceinline__ void done(const Unit&) const {}
};

__device__ __forceinline__ unsigned cvt_pk_bf16(float lo, float hi) { unsigned r; asm volatile("v_cvt_pk_bf16_f32 %0, %1, %2" : "=v"(r) : "v"(lo), "v"(hi)); return r; }

template <int NM, int NN> struct OrderCT {
    static_assert(NM % 8 == 0 || NM % 8 == 4, "last M group must be 8 or 4 tiles");
    int G, c;
    __device__ __forceinline__ void init(int G_, int c_) { G = G_; c = c_; }
    __device__ __forceinline__ bool next(int i, Unit& u) const {
        constexpr int nwg = NM * NN, q = nwg / NXCD, r = nwg % NXCD, nig = WGM * NN;
        const int L = i * G + c; if (L >= nwg) return false;
        const int xcd = L & (NXCD - 1), off = L >> 3;
        const int wgid = (xcd < r ? xcd * (q + 1) : r * (q + 1) + (xcd - r) * q) + off;
        const int gid = wgid / nig, rem = wgid - gid * nig, fm = gid * WGM;
        const int sh = (NM - fm) < WGM ? 2 : 3;
        u.pm = fm + (rem & ((1 << sh) - 1)); u.pn = rem >> sh; return true;
    }
    __device__ __forceinline__ void a_ready(const Unit&) const {}
    __device__ __forceinline__ void done(const Unit&) const {}
};
typedef unsigned u32x2 __attribute__((ext_vector_type(2)));
__device__ __forceinline__ void st_bf16x4(bf16_t* p, f32x4 v) { u32x2 w; w.x = cvt_pk_bf16(v[0], v[1]); w.y = cvt_pk_bf16(v[2], v[3]); *(u32x2*)p = w; }
__device__ __forceinline__ float sum16(const float* part, int row) {
    const f32x4* p = (const f32x4*)(part + (size_t)row * 16); const f32x4 a = p[0], b = p[1], c = p[2], d = p[3];
    return (((a.x + a.y) + (a.z + a.w)) + ((b.x + b.y) + (b.z + b.w))) + (((c.x + c.y) + (c.z + c.w)) + ((d.x + d.y) + (d.z + d.w)));
}
__device__ __forceinline__ float sum4(const float* part, int row) { const f32x4 a = *(const f32x4*)(part + (size_t)row * 4); return (a.x + a.y) + (a.z + a.w); }
__device__ __forceinline__ float rsq(float x) { return 1.0f / sqrtf(x); }
__device__ __forceinline__ float sq4(f32x4 v) { return (v[0] * v[0] + v[1] * v[1]) + (v[2] * v[2] + v[3] * v[3]); }
#define EPI_ROWS(ai, m) for (int ai = 0; ai < 2; ++ai) for (int m = 0; m < 4; ++m)
#define EPI_ROW(u, ai, m) ((u).pm * BM + (ai) * HALF + wr * 64 + (m) * 16 + fr)

__device__ __forceinline__ int prow_of(int m) { return m + (m >> 12) * 128 + 128; }
#define EPI_NB (META ? BATCH : 1)
#define EPI_PROW(row, b) (META ? (size_t)((b) * TT + FRONT + (row)) : (size_t)prow_of(row))
#define EPI_MAIN_LOOP(CALL) _Pragma("unroll") for (int ai = 0; ai < 2; ++ai) _Pragma("unroll") for (int m = 0; m < 4; ++m) { asm volatile("" ::: "memory"); const int row = EPI_ROW(u, ai, m); \
        const f32x4 a_[2][2] = {{acc[ai][0][m][0], acc[ai][0][m][1]}, {acc[ai][1][m][0], acc[ai][1][m][1]}}; CALL; }

template <bool META> struct EpiIn {
    static constexpr bool PERM = false, AFTER_DRAIN = false, MIDSCALE = false;
    const float* hss; bf16_t *qa, *ka, *va, *qlat, *kvlat, *kr; float *ssq_q, *ssq_kv;
    __device__ __forceinline__ void mid(f32x4 (&)[2][2][4][2], const Unit&, int, int, int, int) const {}
    __device__ __forceinline__ void row_epi(const f32x4 (&a)[2][2], int row, int pn, int wc, int fr, int fq) const {
        const float rs = rsq(sum16(hss, row) * (1.0f / DM) + RMS_EPS);
        if (pn <= 2) {
            const bool is_kr = (pn == 2 && wc == 2);
            if (pn == 2 && wc == 3) return;
            const float pos = META ? (float)row : (float)((row & 4095) + NMETA);
#pragma unroll
            for (int n = 0; n < 2; ++n) {
                if (is_kr && n == 1) continue;
                const f32x4 x1 = a[0][n] * rs, x2 = a[1][n] * rs; f32x4 o1, o2;
#pragma unroll
                for (int e = 0; e < 4; ++e) { const float inv = is_kr ? __builtin_amdgcn_exp2f(-(float)(4 * fq + e) * (LOG2_THETA / 16.0f)) : __builtin_amdgcn_exp2f(-(float)(16 * n + 4 * fq + e) * (LOG2_THETA / 32.0f));
                    const float ang = pos * inv; float rev = ang * INV_2PI; rev = rev - floorf(rev);
                    const float sn = __builtin_amdgcn_sinf(rev), cs = __builtin_amdgcn_cosf(rev); o1[e] = x1[e] * cs - x2[e] * sn; o2[e] = x2[e] * cs + x1[e] * sn; }
#pragma unroll
                for (int b = 0; b < EPI_NB; ++b) { const size_t pr = EPI_PROW(row, b); bf16_t* d; int half;
                    if (pn < 2) { d = qa + pr * 512 + (4 * pn + wc) * 64 + 16 * n + 4 * fq; half = 32; }
                    else if (!is_kr) { d = ka + pr * 128 + wc * 64 + 16 * n + 4 * fq; half = 32; }
                    else { d = kr + pr * 32 + 4 * fq; half = 16; }
                    st_bf16x4(d, o1); st_bf16x4(d + half, o2); }
            }
        } else if (pn == 3) {
            float ss = 0.f;
#pragma unroll
            for (int n = 0; n < 2; ++n) { const int c = 32 * wc + 16 * n + 4 * fq; const f32x4 v = a[0][n] * rs, w = a[1][n] * rs;
#pragma unroll
                for (int b = 0; b < EPI_NB; ++b) st_bf16x4(va + EPI_PROW(row, b) * 128 + c, v);
                st_bf16x4(kvlat + (size_t)row * 128 + c, w); ss += sq4(w); }
            ss += __shfl_xor(ss, 16); ss += __shfl_xor(ss, 32);
            if (fq == 0) ssq_kv[(size_t)row * 4 + wc] = ss;
        } else {
            float ss = 0.f;
#pragma unroll
            for (int bj = 0; bj < 2; ++bj)
#pragma unroll
                for (int n = 0; n < 2; ++n) { const int c = 128 * bj + 32 * wc + 16 * n + 4 * fq; const f32x4 v = a[bj][n] * rs; st_bf16x4(qlat + (size_t)row * 256 + c, v); ss += sq4(v); }
            ss += __shfl_xor(ss, 16); ss += __shfl_xor(ss, 32);
            if (fq == 0) ssq_q[(size_t)row * 4 + wc] = ss;
        }
    }
    __device__ __forceinline__ void operator()(const f32x4 (&acc)[2][2][4][2], const Unit& u, int wr, int wc, int fr, int fq) const { EPI_MAIN_LOOP(row_epi(a_, row, u.pn, wc, fr, fq)) }
};

template <bool META> struct EpiQup {
    static constexpr bool PERM = false, AFTER_DRAIN = false, MIDSCALE = false;
    const float* ssq_q; bf16_t* qm;
    __device__ __forceinline__ void mid(f32x4 (&)[2][2][4][2], const Unit&, int, int, int, int) const {}
    __device__ __forceinline__ void row_epi(const f32x4 (&a)[2][2], int row, int pn, int wc, int fr, int fq) const {
        const float rs = rsq(sum4(ssq_q, row) * (1.0f / 256.0f) + RMS_EPS);
        if (pn < 2) {
#pragma unroll
            for (int bj = 0; bj < 2; ++bj)
#pragma unroll
                for (int n = 0; n < 2; ++n) { const int head = 4 * pn + 2 * bj + (wc >> 1), d = 32 * (wc & 1) + 16 * n + 4 * fq; const f32x4 v = a[bj][n] * rs;
#pragma unroll
                    for (int b = 0; b < EPI_NB; ++b) st_bf16x4(qm + EPI_PROW(row, b) * 768 + head * 96 + d, v); }
        } else {
            const float pos = META ? (float)row : (float)((row & 4095) + NMETA);
#pragma unroll
            for (int n = 0; n < 2; ++n) { const int head = 2 * wc + n; const f32x4 x1 = a[0][n] * rs, x2 = a[1][n] * rs; f32x4 o1, o2;
#pragma unroll
                for (int e = 0; e < 4; ++e) { const float inv = __builtin_amdgcn_exp2f(-(float)(4 * fq + e) * (LOG2_THETA / 16.0f)); const float ang = pos * inv; float rev = ang * INV_2PI; rev = rev - floorf(rev);
                    const float sn = __builtin_amdgcn_sinf(rev), cs = __builtin_amdgcn_cosf(rev); o1[e] = x1[e] * cs - x2[e] * sn; o2[e] = x2[e] * cs + x1[e] * sn; }
#pragma unroll
                for (int b = 0; b < EPI_NB; ++b) { bf16_t* qrow = qm + EPI_PROW(row, b) * 768; st_bf16x4(qrow + head * 96 + 64 + 4 * fq, o1); st_bf16x4(qrow + head * 96 + 80 + 4 * fq, o2); } }
        }
    }
    __device__ __forceinline__ void operator()(const f32x4 (&acc)[2][2][4][2], const Unit& u, int wr, int wc, int fr, int fq) const { EPI_MAIN_LOOP(row_epi(a_, row, u.pn, wc, fr, fq)) }
};

template <bool META> struct EpiKvup {
    static constexpr bool PERM = false, AFTER_DRAIN = false, MIDSCALE = false;
    const float* ssq_kv; bf16_t *kn, *vb;
    __device__ __forceinline__ void mid(f32x4 (&)[2][2][4][2], const Unit&, int, int, int, int) const {}
    __device__ __forceinline__ void row_epi(const f32x4 (&a)[2][2], int row, int pn, int wc, int fr, int fq) const {
        bf16_t* dst = (pn < 2 ? kn : vb) + (pn & 1) * 256;
        const float rs = rsq(sum4(ssq_kv, row) * (1.0f / 128.0f) + RMS_EPS);
#pragma unroll
        for (int bj = 0; bj < 2; ++bj)
#pragma unroll
            for (int n = 0; n < 2; ++n) { const f32x4 v = a[bj][n] * rs;
#pragma unroll
                for (int b = 0; b < EPI_NB; ++b) st_bf16x4(dst + EPI_PROW(row, b) * 512 + 128 * bj + 32 * wc + 16 * n + 4 * fq, v); }
    }
    __device__ __forceinline__ void operator()(const f32x4 (&acc)[2][2][4][2], const Unit& u, int wr, int wc, int fr, int fq) const { EPI_MAIN_LOOP(row_epi(a_, row, u.pn, wc, fr, fq)) }
};

struct EpiResid {
    static constexpr bool PERM = false, AFTER_DRAIN = false;
    float* H; bf16_t* HB; float* hss_out; const float* ssq_o;
    __device__ __forceinline__ void resid_row(const f32x4 (&a)[2][2], int row, float rs, int pn, int wc, int fr, int fq) const {
        float ss = 0.f;
#pragma unroll
        for (int bj = 0; bj < 2; ++bj)
#pragma unroll
            for (int n = 0; n < 2; ++n) { const size_t off = (size_t)row * DM + pn * BM + 128 * bj + 32 * wc + 16 * n + 4 * fq;
                const u32x2 hw = *(const u32x2*)(HB + off); f32x4 hv; hv[0] = __builtin_bit_cast(float, hw.x << 16); hv[1] = __builtin_bit_cast(float, hw.x & 0xffff0000u); hv[2] = __builtin_bit_cast(float, hw.y << 16); hv[3] = __builtin_bit_cast(float, hw.y & 0xffff0000u);
                hv = hv + a[bj][n] * rs; st_bf16x4(HB + off, hv); ss += sq4(hv); }
        ss += __shfl_xor(ss, 16); ss += __shfl_xor(ss, 32);
        if (fq == 0) hss_out[(size_t)row * 16 + 4 * pn + wc] = ss;
    }
    __device__ __forceinline__ void two_scales(size_t prow, float& f, float& rb) const {
        const f32x4* p = (const f32x4*)(ssq_o + prow * 16); const f32x4 a = p[0], b = p[1], c = p[2], d = p[3];
        const float sa = ((a.x + a.y) + (a.z + a.w)) + ((b.x + b.y) + (b.z + b.w)), sb = ((c.x + c.y) + (c.z + c.w)) + ((d.x + d.y) + (d.z + d.w));
        const float va = sa * (1.0f / 512.0f) + RMS_EPS, vb = sb * (1.0f / 512.0f) + RMS_EPS; f = sqrtf(vb / va); rb = rsq(vb);
    }
};
template <bool META> struct EpiOut : EpiResid {
    static constexpr bool MIDSCALE = true;
    PG8_LAS unsigned char* xlds;
    __device__ __forceinline__ void prep(const Unit& u, int wid, int wr, int lane) const {
        PG8_LAS float* tab = (PG8_LAS float*)(xlds + wid * 1024);
#pragma unroll
        for (int j = 0; j < 2; ++j) { const int idx = lane + 64 * j; const int row = u.pm * BM + (idx >> 6) * HALF + wr * 64 + (idx & 63);
            float f, rb; two_scales((size_t)prow_of(row), f, rb); tab[2 * idx] = f; tab[2 * idx + 1] = rb; }
    }
    __device__ __forceinline__ void mid(f32x4 (&acc)[2][2][4][2], const Unit& u, int wr, int wc, int fr, int fq) const {
        const int wid = wr * 4 + wc; const PG8_LAS float* tab = (const PG8_LAS float*)(xlds + wid * 1024);
#pragma unroll
        for (int ai = 0; ai < 2; ++ai)
#pragma unroll
            for (int m = 0; m < 4; ++m) {
                const float f = tab[2 * (ai * 64 + m * 16 + fr)];
#pragma unroll
                for (int bj = 0; bj < 2; ++bj)
#pragma unroll
                    for (int n = 0; n < 2; ++n) acc[ai][bj][m][n] *= f;
            }
    }
    __device__ __forceinline__ void operator()(const f32x4 (&acc)[2][2][4][2], const Unit& u, int wr, int wc, int fr, int fq) const {
        const PG8_LAS float* tab = (const PG8_LAS float*)(xlds + (wr * 4 + wc) * 1024);
        EPI_MAIN_LOOP(resid_row(a_, row, tab[2 * (ai * 64 + m * 16 + fr) + 1], u.pn, wc, fr, fq))
    }
    __device__ __forceinline__ void mid_row(f32x4 (&a)[2][2], int row) const { float f, rb; two_scales((size_t)(FRONT + row), f, rb);
#pragma unroll
        for (int bj = 0; bj < 2; ++bj)
#pragma unroll
            for (int n = 0; n < 2; ++n) a[bj][n] *= f; }
    __device__ __forceinline__ void row_epi(const f32x4 (&a)[2][2], int row, int pn, int wc, int fr, int fq) const { float f, rb; two_scales((size_t)(FRONT + row), f, rb); resid_row(a, row, rb, pn, wc, fr, fq); }
};
template <bool META> struct EpiDown : EpiResid {
    static constexpr bool MIDSCALE = false;
    __device__ __forceinline__ void mid(f32x4 (&)[2][2][4][2], const Unit&, int, int, int, int) const {}
    __device__ __forceinline__ void row_epi(const f32x4 (&a)[2][2], int row, int pn, int wc, int fr, int fq) const { resid_row(a, row, 1.0f, pn, wc, fr, fq); }
    __device__ __forceinline__ void operator()(const f32x4 (&acc)[2][2][4][2], const Unit& u, int wr, int wc, int fr, int fq) const { EPI_MAIN_LOOP(resid_row(a_, row, 1.0f, u.pn, wc, fr, fq)) }
};

template <bool META> struct EpiGU {
    static constexpr bool PERM = false, AFTER_DRAIN = false, MIDSCALE = false;
    const float* hss; bf16_t* act;
    __device__ __forceinline__ void mid(f32x4 (&)[2][2][4][2], const Unit&, int, int, int, int) const {}
    __device__ __forceinline__ void row_epi(const f32x4 (&a)[2][2], int row, int pn, int wc, int fr, int fq) const {
        const float rs = rsq(sum16(hss, row) * (1.0f / DM) + RMS_EPS);
#pragma unroll
        for (int n = 0; n < 2; ++n) { const f32x4 g = a[0][n] * rs, up = a[1][n] * rs; f32x4 o;
#pragma unroll
            for (int e = 0; e < 4; ++e) o[e] = g[e] * up[e] * __builtin_amdgcn_rcpf(1.0f + __builtin_amdgcn_exp2f(-g[e] * LOG2E));
            st_bf16x4(act + (size_t)row * DFF + 128 * pn + 32 * wc + 16 * n + 4 * fq, o); }
    }
    __device__ __forceinline__ void operator()(const f32x4 (&acc)[2][2][4][2], const Unit& u, int wr, int wc, int fr, int fq) const { EPI_MAIN_LOOP(row_epi(a_, row, u.pn, wc, fr, fq)) }
};

template <class Epi>
__device__ __forceinline__ void skinny_phase(PG8_LAS unsigned char* lds, const bf16_t* A16, const bf16_t* Bt, int K, int NN, const Epi& E) {
    int tid_ = threadIdx.x; asm volatile("" : "+v"(tid_));
    const int tid = tid_, lane = tid & 63, wid = __builtin_amdgcn_readfirstlane(tid >> 6), fr = lane & 15, fq = lane >> 4;
    const int nk = K / 32;
    for (int task = blockIdx.x; task < 4 * NN; task += gridDim.x) {
        const int pn = task >> 2, wc = task & 3;
        f32x4 a[2][2];
#pragma unroll
        for (int bj = 0; bj < 2; ++bj)
#pragma unroll
            for (int n = 0; n < 2; ++n) a[bj][n] = (f32x4){0.f, 0.f, 0.f, 0.f};
        bool scaled = false;
        for (int it = wid; it < nk; it += 8) {
            const int k0 = 32 * it;
            if constexpr (Epi::MIDSCALE) { if (!scaled && k0 >= (K >> 1)) { E.mid_row(a, fr); scaled = true; } }
            const bf16x8 av = *(const bf16x8*)(A16 + (size_t)fr * K + k0 + 8 * fq);
#pragma unroll
            for (int bj = 0; bj < 2; ++bj)
#pragma unroll
                for (int n = 0; n < 2; ++n) { const bf16x8 bv = *(const bf16x8*)(Bt + (size_t)(256 * pn + 128 * bj + 32 * wc + 16 * n + fr) * K + k0 + 8 * fq);
                    a[bj][n] = __builtin_amdgcn_mfma_f32_16x16x32_bf16(bv, av, a[bj][n], 0, 0, 0); }
        }
        if constexpr (Epi::MIDSCALE) { if (!scaled) E.mid_row(a, fr); }
        PG8_LAS f32x4* red = (PG8_LAS f32x4*)lds;
#pragma unroll
        for (int bj = 0; bj < 2; ++bj)
#pragma unroll
            for (int n = 0; n < 2; ++n) red[(wid * 64 + lane) * 4 + bj * 2 + n] = a[bj][n];
        __syncthreads();
        if (wid == 0) {
#pragma unroll
            for (int w = 1; w < 8; ++w)
#pragma unroll
                for (int bj = 0; bj < 2; ++bj)
#pragma unroll
                    for (int n = 0; n < 2; ++n) a[bj][n] += red[(w * 64 + lane) * 4 + bj * 2 + n];
            E.row_epi(a, fr, pn, wc, fr, fq);
        }
        __syncthreads();
    }
}
template <class Epi, class Sched, bool ALIGN_EPI = false, bool SP2 = false>
__device__ __forceinline__ void gemm_phase(PG8_LAS unsigned char* lds, const Gemm g, const Sched& S, const Epi& E) {
    int tid_ = threadIdx.x; asm volatile("" : "+v"(tid_));
    const int tid = tid_, wid = __builtin_amdgcn_readfirstlane(tid >> 6), lane = tid & 63, wr = wid >> 2, wc = wid & 3, fr = lane & 15, fq = lane >> 4;
    int K_ = g.K; asm volatile("" : "+s"(K_)); const int K = K_, nt = K / BK;
    unsigned voffA[2], voffB[2];
#pragma unroll
    for (int i = 0; i < 2; ++i) { int R, C; stage_rc(tid * 16 + i * 8192, R, C); const int Rb = Epi::PERM ? ((R & ~31) + perm32(R & 31)) : R;
        voffA[i] = (unsigned)(R * K + C) * 2u; voffB[i] = (unsigned)(Rb * K + C) * 2u; }
    const size_t kstep = (size_t)(BK * 2);
    const size_t hstep = (size_t)HALF * K * 2;
    const size_t tstep = 2 * hstep;
    const unsigned ldsw = (unsigned)wid * 1024u;
    const int aoff = lds_byte(wr * 64 + fr, fq * 8), boff = lds_byte(wc * 32 + fr, fq * 8);
#define PG8_SA(b, h) (((b) * 2 + (h)) * HTB)
#define PG8_SB(b, h) ((4 + (b) * 2 + (h)) * HTB)
#define PG8_STAGE(bufoff, gbase, voff) do { _Pragma("unroll") for (int _i = 0; _i < 2; ++_i) \
        __builtin_amdgcn_global_load_lds((const unsigned*)((const char*)(gbase) + (voff)[_i]), (PG8_LAS unsigned*)(lds + (bufoff) + ldsw + _i * 8192), 16, 0, 0); } while (0)
#define PG8_LDA(dst, b, h) do { _Pragma("unroll") for (int m = 0; m < 4; ++m) _Pragma("unroll") for (int k = 0; k < 2; ++k) dst[m][k] = *(const PG8_LAS bf16x8*)(lds + PG8_SA(b, h) + aoff + m * 2048 + k * 1024); } while (0)
#define PG8_LDB(dst, b, h) do { _Pragma("unroll") for (int n = 0; n < 2; ++n) _Pragma("unroll") for (int k = 0; k < 2; ++k) dst[n][k] = *(const PG8_LAS bf16x8*)(lds + PG8_SB(b, h) + boff + n * 2048 + k * 1024); } while (0)
#define PG8_MMA(ai, bj, At, Bt) do { __builtin_amdgcn_s_setprio(1); _Pragma("unroll") for (int m = 0; m < 4; ++m) _Pragma("unroll") for (int n = 0; n < 2; ++n) _Pragma("unroll") for (int k = 0; k < 2; ++k) \
        acc[ai][bj][m][n] = __builtin_amdgcn_mfma_f32_16x16x32_bf16(Bt[n][k], At[m][k], acc[ai][bj][m][n], 0, 0, 0); __builtin_amdgcn_s_setprio(0); } while (0)
#define PG8_WAIT_V(n) asm volatile("s_waitcnt vmcnt(" #n ")" ::: "memory")
#define PG8_WAIT_L(n) asm volatile("s_waitcnt lgkmcnt(" #n ")" ::: "memory")
#define PG8_BAR __builtin_amdgcn_s_barrier()
#define PG8_SCHED __builtin_amdgcn_sched_barrier(0)
    Unit cur, nxt; int ui = 0;
    if (!S.next(0, cur)) return;
    f32x4 acc[2][2][4][2];
#pragma unroll
    for (int a = 0; a < 2; ++a)
#pragma unroll
        for (int b = 0; b < 2; ++b)
#pragma unroll
            for (int m = 0; m < 4; ++m)
#pragma unroll
                for (int n = 0; n < 2; ++n) acc[a][b][m][n] = (f32x4){0.f, 0.f, 0.f, 0.f};
    bf16x8 At[4][2], B0[2][2], B1[2][2];
    const char* cA = (const char*)g.A + (size_t)cur.pm * tstep + (g.apad ? (size_t)((cur.pm >> 4) * 128 + 128) * (size_t)K * 2 : (size_t)0); const char* cB = (const char*)g.Bt + (size_t)cur.pn * tstep;
    S.a_ready(cur);
    if constexpr (SP2) {
        PG8_STAGE(PG8_SB(0, 0), cB, voffB); PG8_STAGE(PG8_SB(0, 1), cB + hstep, voffB); PG8_STAGE(PG8_SA(0, 0), cA, voffA); PG8_STAGE(PG8_SA(0, 1), cA + hstep, voffA);
        if (wr == 1) PG8_BAR;
        PG8_WAIT_V(2); PG8_BAR;
        PG8_STAGE(PG8_SB(1, 0), cB + kstep, voffB); PG8_STAGE(PG8_SA(1, 0), cA + kstep, voffA); PG8_STAGE(PG8_SB(1, 1), cB + hstep + kstep, voffB);
        PG8_WAIT_V(6); PG8_BAR;
    } else {
        PG8_STAGE(PG8_SB(0, 0), cB, voffB); PG8_STAGE(PG8_SA(0, 0), cA, voffA); PG8_STAGE(PG8_SB(0, 1), cB + hstep, voffB); PG8_STAGE(PG8_SA(0, 1), cA + hstep, voffA);
        if (wr == 1) PG8_BAR;
        PG8_WAIT_V(4); PG8_BAR;
        PG8_STAGE(PG8_SB(1, 0), cB + kstep, voffB); PG8_STAGE(PG8_SA(1, 0), cA + kstep, voffA); PG8_STAGE(PG8_SB(1, 1), cB + hstep + kstep, voffB);
        PG8_WAIT_V(6); PG8_BAR;
    }
    for (;;) {
        const bool has_next = S.next(ui + 1, nxt);
        if constexpr (Epi::MIDSCALE) E.prep(cur, wid, wr, lane);
        const char* nA = has_next ? (const char*)g.A + (size_t)nxt.pm * tstep + (g.apad ? (size_t)((nxt.pm >> 4) * 128 + 128) * (size_t)K * 2 : (size_t)0) : cA; const char* nB = has_next ? (const char*)g.Bt + (size_t)nxt.pn * tstep : cB;
        for (int t = 0; t < nt; t += 2) {
            const bool last = (t == nt - 2);
            if constexpr (Epi::MIDSCALE) { if (t == (nt >> 1)) E.mid(acc, cur, wr, wc, fr, fq); }
            const char* a1 = cA + (size_t)(t + 1) * kstep;
            const char* a2 = last ? nA : cA + (size_t)(t + 2) * kstep; const char* b2 = last ? nB : cB + (size_t)(t + 2) * kstep;
            const char* a3 = a2 + kstep; const char* b3 = b2 + kstep;
            if (last && has_next) S.a_ready(nxt);
            if constexpr (SP2) {
            PG8_LDB(B0, 0, 0); PG8_LDB(B1, 0, 1); PG8_SCHED; PG8_LDA(At, 0, 0); PG8_STAGE(PG8_SA(1, 1), a1 + hstep, voffA);
            PG8_WAIT_V(8); PG8_WAIT_L(0); PG8_BAR; PG8_MMA(0, 0, At, B0); PG8_MMA(0, 1, At, B1); PG8_BAR; PG8_SCHED;
            PG8_LDA(At, 0, 1); PG8_STAGE(PG8_SB(0, 0), b2, voffB); PG8_STAGE(PG8_SB(0, 1), b2 + hstep, voffB); PG8_STAGE(PG8_SA(0, 0), a2, voffA);
            PG8_WAIT_V(8); PG8_WAIT_L(0); PG8_BAR; PG8_MMA(1, 0, At, B0); PG8_MMA(1, 1, At, B1); PG8_BAR; PG8_SCHED;
            PG8_LDB(B0, 1, 0); PG8_LDB(B1, 1, 1); PG8_SCHED; PG8_LDA(At, 1, 0); PG8_STAGE(PG8_SA(0, 1), a2 + hstep, voffA);
            PG8_WAIT_V(8); PG8_WAIT_L(0); PG8_BAR; PG8_MMA(0, 0, At, B0); PG8_MMA(0, 1, At, B1); PG8_BAR; PG8_SCHED;
            PG8_LDA(At, 1, 1); PG8_STAGE(PG8_SB(1, 0), b3, voffB); PG8_STAGE(PG8_SB(1, 1), b3 + hstep, voffB); PG8_STAGE(PG8_SA(1, 0), a3, voffA);
            PG8_WAIT_V(8); PG8_WAIT_L(0); PG8_BAR; PG8_MMA(1, 0, At, B0); PG8_MMA(1, 1, At, B1); PG8_BAR; PG8_SCHED;
            } else {
            PG8_LDB(B0, 0, 0); PG8_SCHED; PG8_LDA(At, 0, 0); PG8_STAGE(PG8_SA(1, 1), a1 + hstep, voffA);
            PG8_WAIT_L(8); PG8_BAR; PG8_WAIT_L(0); PG8_MMA(0, 0, At, B0); PG8_BAR; PG8_SCHED;
            PG8_LDB(B1, 0, 1); PG8_STAGE(PG8_SB(0, 0), b2, voffB);
            PG8_BAR; PG8_WAIT_L(0); PG8_MMA(0, 1, At, B1); PG8_BAR;
            PG8_LDA(At, 0, 1); PG8_STAGE(PG8_SA(0, 0), a2, voffA);
            PG8_BAR; PG8_WAIT_L(0); PG8_MMA(1, 0, At, B0); PG8_BAR; PG8_SCHED;
            PG8_STAGE(PG8_SB(0, 1), b2 + hstep, voffB);
            PG8_WAIT_V(6); PG8_BAR; PG8_MMA(1, 1, At, B1); PG8_BAR;
            PG8_LDB(B0, 1, 0); PG8_SCHED; PG8_LDA(At, 1, 0); PG8_STAGE(PG8_SA(0, 1), a2 + hstep, voffA);
            PG8_WAIT_L(8); PG8_BAR; PG8_WAIT_L(0); PG8_MMA(0, 0, At, B0); PG8_BAR; PG8_SCHED;
            PG8_LDB(B1, 1, 1); PG8_STAGE(PG8_SB(1, 0), b3, voffB);
            PG8_BAR; PG8_WAIT_L(0); PG8_MMA(0, 1, At, B1); PG8_BAR;
            PG8_LDA(At, 1, 1); PG8_STAGE(PG8_SA(1, 0), a3, voffA);
            PG8_BAR; PG8_WAIT_L(0); PG8_MMA(1, 0, At, B0); PG8_BAR; PG8_SCHED;
            PG8_STAGE(PG8_SB(1, 1), b3 + hstep, voffB);
            PG8_WAIT_V(6); PG8_BAR; PG8_MMA(1, 1, At, B1); PG8_BAR;
            }
        }
        if constexpr (ALIGN_EPI) { if (wr == 0) PG8_BAR; }
        if constexpr (!Epi::AFTER_DRAIN) { E(acc, cur, wr, wc, fr, fq); S.done(cur); }
        if (!has_next) break;
#pragma unroll
        for (int a = 0; a < 2; ++a)
#pragma unroll
            for (int b = 0; b < 2; ++b)
#pragma unroll
                for (int m = 0; m < 4; ++m)
#pragma unroll
                    for (int n = 0; n < 2; ++n) acc[a][b][m][n] = (f32x4){0.f, 0.f, 0.f, 0.f};
        cur = nxt; cA = nA; cB = nB; ++ui;
        if constexpr (ALIGN_EPI) { if (wr == 1) PG8_BAR; }
    }
    PG8_WAIT_V(0);
    if constexpr (!ALIGN_EPI) { if (wr == 0) PG8_BAR; }
    PG8_BAR;
    if constexpr (Epi::AFTER_DRAIN) { E.fused(acc, cur, wr, wc, fr, fq, lds, wid, lane); S.done(cur); }
#undef PG8_SA
#undef PG8_SB
#undef PG8_STAGE
#undef PG8_LDA
#undef PG8_LDB
#undef PG8_MMA
#undef PG8_WAIT_V
#undef PG8_WAIT_L
#undef PG8_BAR
#undef PG8_SCHED
}
}
namespace att {
#define ALAS __attribute__((address_space(3)))
typedef unsigned short bf16_t;
typedef short bf16x8 __attribute__((ext_vector_type(8)));
typedef short s16x4 __attribute__((ext_vector_type(4)));
typedef float f32x16 __attribute__((ext_vector_type(16)));
typedef unsigned u32x4 __attribute__((ext_vector_type(4)));
typedef float f32x2_t __attribute__((ext_vector_type(2))); typedef __bf16 bf16x2_t __attribute__((ext_vector_type(2)));
constexpr int KPMAX = 208, VP = 144, KSZ = 64 * KPMAX, VSZ = 64 * VP;
constexpr int OFF_V = 2 * KSZ, OFF_SCR = OFF_V + 2 * VSZ, OFF_Q = OFF_SCR + 8 * 256, LDS_BYTES = OFF_Q + 64;
constexpr float NEGF = -1e30f, THR = 6.0f;
__device__ __forceinline__ int crow(int r, int hi) { return (r & 3) + 8 * (r >> 2) + 4 * hi; }
__device__ __forceinline__ unsigned cvtpk(float lo, float hi) { f32x2_t v = {lo, hi}; bf16x2_t b = __builtin_convertvector(v, bf16x2_t); return __builtin_bit_cast(unsigned, b); }
__device__ __forceinline__ bf16x8 pack8(const f32x16& p, int s) { u32x4 w; w.x = cvtpk(p[8 * s], p[8 * s + 1]); w.y = cvtpk(p[8 * s + 2], p[8 * s + 3]); w.z = cvtpk(p[8 * s + 4], p[8 * s + 5]); w.w = cvtpk(p[8 * s + 6], p[8 * s + 7]); return __builtin_bit_cast(bf16x8, w); }
typedef short v4i16_t __attribute__((ext_vector_type(4)));
__device__ __forceinline__ s16x4 vtr(const ALAS unsigned char* p) { return __builtin_bit_cast(s16x4, __builtin_amdgcn_ds_read_tr16_b64_v4i16((ALAS v4i16_t*)p)); }
__device__ __forceinline__ unsigned short f2bf(float f) { unsigned u = __builtin_bit_cast(unsigned, f); return (unsigned short)((u + 0x7fffu + ((u >> 16) & 1u)) >> 16); }

template <int DQK, bool SWA>
__device__ __forceinline__ void attn_unit(ALAS unsigned char* lds, const bf16_t* Qp, int qpitch, const bf16_t* Kp, int kpitch, const bf16_t* Krp, const bf16_t* Vp, int vpitch,
                                          bf16_t* Op, float* ssq, float sink2, int b, int qb) {
    constexpr int KP = DQK * 2 + 16, NS = DQK / 16;
    int tid_ = threadIdx.x; asm volatile("" : "+v"(tid_));
    const int tid = tid_, lane = tid & 63, wid = __builtin_amdgcn_readfirstlane(tid >> 6), r = lane & 31, h = lane >> 5;
    const size_t rowbase = (size_t)b * TT;
    const int q0 = qb * 256, q0w = q0 + wid * 32;
    const bool wave_valid = q0w < TT;
    const int NT = (q0 + 256) / 64 < TT / 64 ? (q0 + 256) / 64 : TT / 64;
    int t0 = 1; if (SWA) { t0 = (q0 - 128) / 64; if (t0 < 1) t0 = 1; }
    ALAS float* scr = (ALAS float*)(lds + OFF_SCR + wid * 256);
    bf16x8 qf[NS];
    { const int qr = (q0w + r) < TT ? (q0w + r) : TT - 1; const bf16_t* qrow = Qp + (rowbase + qr) * (size_t)qpitch;
#pragma unroll
      for (int s = 0; s < NS; ++s) qf[s] = *(const bf16x8*)(qrow + 16 * s + 8 * h); }
    const int srow = tid >> 3, sch = tid & 7, rrow = (tid >> 2) & 63, rch = tid & 3;
    u32x4 kregA, vregA, rregA = {0u, 0u, 0u, 0u}, kregB, vregB, rregB = {0u, 0u, 0u, 0u};
#define AT_GLOAD(t, S) do { const size_t kr_ = rowbase + 64 * (t) + srow; kreg##S = *(const u32x4*)(Kp + kr_ * (size_t)kpitch + sch * 8); vreg##S = *(const u32x4*)(Vp + kr_ * (size_t)vpitch + sch * 8); \
        if (DQK == 96) { if (tid < 256) rreg##S = *(const u32x4*)(Krp + (rowbase + 64 * (t) + rrow) * 32 + rch * 8); } } while (0)
#define AT_LSTORE(buf, S) do { *(ALAS u32x4*)(lds + (buf) * KSZ + srow * KP + sch * 16) = kreg##S; *(ALAS u32x4*)(lds + OFF_V + (buf) * VSZ + srow * VP + sch * 16) = vreg##S; \
        if (DQK == 96) { if (tid < 256) *(ALAS u32x4*)(lds + (buf) * KSZ + rrow * KP + 128 + rch * 16) = rreg##S; } } while (0)
    AT_GLOAD(t0, A); AT_LSTORE(0, A);
    if (t0 + 1 < NT) AT_GLOAD(t0 + 1, A);
    __syncthreads();
    float mrun = SWA ? sink2 : NEGF, lrun = (SWA && h == 0) ? 1.0f : 0.0f;
    f32x16 o0, o1;
#pragma unroll
    for (int i = 0; i < 16; ++i) { o0[i] = 0.f; o1[i] = 0.f; }
    const int q = q0w + r;
#define AT_PV(P, rowoff) do { \
                { const s16x4 lo = vtr(vb_ + (rowoff) * VP), hi = vtr(vb_ + ((rowoff) + 8) * VP); const bf16x8 vf = __builtin_shufflevector(lo, hi, 0, 1, 2, 3, 4, 5, 6, 7); o0 = __builtin_amdgcn_mfma_f32_32x32x16_bf16(P, vf, o0, 0, 0, 0); } \
                { const s16x4 lo = vtr(vb_ + (rowoff) * VP + 64), hi = vtr(vb_ + ((rowoff) + 8) * VP + 64); const bf16x8 vf = __builtin_shufflevector(lo, hi, 0, 1, 2, 3, 4, 5, 6, 7); o1 = __builtin_amdgcn_mfma_f32_32x32x16_bf16(P, vf, o1, 0, 0, 0); } } while (0)
#define AT_STEP(t, LS, SS) do { \
        const int buf = (t - t0) & 1; \
        if (t + 2 < NT) AT_GLOAD(t + 2, LS); \
        const int kfirst = 64 * t; \
        bool active = wave_valid && (kfirst <= q0w + 31); \
        if (SWA) active = active && (kfirst + 63 >= q0w - 127); \
        if (active) { \
            f32x16 s0, s1; \
_Pragma("unroll") \
            for (int i = 0; i < 16; ++i) { s0[i] = 0.f; s1[i] = 0.f; } \
            const ALAS unsigned char* kb = lds + buf * KSZ + r * KP + h * 16; \
_Pragma("unroll") \
            for (int s = 0; s < NS; ++s) { const bf16x8 k0 = *(const ALAS bf16x8*)(kb + s * 32), k1 = *(const ALAS bf16x8*)(kb + 32 * KP + s * 32); \
                s0 = __builtin_amdgcn_mfma_f32_32x32x16_bf16(k0, qf[s], s0, 0, 0, 0); s1 = __builtin_amdgcn_mfma_f32_32x32x16_bf16(k1, qf[s], s1, 0, 0, 0); } \
            const bool need_mask = SWA || (t == 1) || (kfirst + 63 > q0w); \
            if (need_mask) { \
_Pragma("unroll") \
                for (int i = 0; i < 16; ++i) { const int key = kfirst + crow(i, h), key1 = key + 32; \
                    bool ok0 = (key <= q) && (key >= FRONT), ok1 = (key1 <= q) && (key1 >= FRONT); \
                    if (SWA) { ok0 = ok0 && (q - key < 128); ok1 = ok1 && (q - key1 < 128); } \
                    s0[i] = ok0 ? s0[i] : NEGF; s1[i] = ok1 ? s1[i] : NEGF; } \
            } \
            float rm = fmaxf(s0[0], s1[0]); \
_Pragma("unroll") \
            for (int i = 1; i < 16; ++i) rm = fmaxf(rm, fmaxf(s0[i], s1[i])); \
            rm = fmaxf(rm, __shfl_xor(rm, 32)); \
            if (__any(rm > mrun + THR)) { \
                const float mn = fmaxf(mrun, rm), f = __builtin_amdgcn_exp2f(mrun - mn); mrun = mn; lrun *= f; \
                if (h == 0) scr[r] = f; \
_Pragma("unroll") \
                for (int i = 0; i < 16; ++i) { const float fi = scr[crow(i, h)]; o0[i] *= fi; o1[i] *= fi; } \
            } \
            float ls = 0.f; \
_Pragma("unroll") \
            for (int i = 0; i < 16; ++i) { s0[i] = __builtin_amdgcn_exp2f(s0[i] - mrun); s1[i] = __builtin_amdgcn_exp2f(s1[i] - mrun); ls += s0[i] + s1[i]; } \
            lrun += ls; \
            const bf16x8 p0 = pack8(s0, 0), p1 = pack8(s0, 1), p2 = pack8(s1, 0), p3 = pack8(s1, 1); \
            const ALAS unsigned char* vb_ = lds + OFF_V + buf * VSZ + (4 * h + ((lane & 15) >> 2)) * VP + ((lane >> 4) & 1) * 32 + (lane & 3) * 8; \
            AT_PV(p0, 0); AT_PV(p1, 16); AT_PV(p2, 32); AT_PV(p3, 48); \
        } \
        if (t + 1 < NT) AT_LSTORE(buf ^ 1, SS); \
        __syncthreads(); \
    } while (0)
    {
        int t = t0;
        for (; t + 1 < NT; t += 2) { AT_STEP(t, B, A); const int t1 = t + 1; AT_STEP(t1, A, B); }
        if (t < NT) AT_STEP(t, B, A);
    }
#undef AT_STEP
#undef AT_PV
#undef AT_GLOAD
#undef AT_LSTORE
    if (wave_valid) {
        const float lt = lrun + __shfl_xor(lrun, 32);
        if (h == 0) scr[32 + r] = lt;
#pragma unroll
        for (int i = 0; i < 16; ++i) {
            const float li = scr[32 + crow(i, h)], inv = li > 0.f ? 1.0f / li : 0.f;
            const float a = o0[i] * inv, c = o1[i] * inv; const size_t row = rowbase + q0w + crow(i, h);
            Op[row * 1024 + r] = f2bf(a); Op[row * 1024 + 32 + r] = f2bf(c);
            float ss = a * a + c * c;
            ss += __shfl_xor(ss, 1); ss += __shfl_xor(ss, 2); ss += __shfl_xor(ss, 4); ss += __shfl_xor(ss, 8); ss += __shfl_xor(ss, 16);
            if (r == 0) ssq[row * 16] = ss;
        }
    }
    __syncthreads();
}
}
typedef unsigned short bf16;
#define LAS __attribute__((address_space(3)))
constexpr size_t MiB = 1u << 20;
constexpr int NWAVES = 8, NTHREADS = 512;
constexpr int LDS_BYTES = 147456;
static_assert(att::LDS_BYTES <= 131072, "attention LDS");
constexpr size_t WS_CTL = 0, CTL_BYTES = 65536;
constexpr size_t WS_H = 1 * MiB;
constexpr size_t WS_HB = WS_H + (size_t)MROWS * DM * 4;
constexpr size_t WS_W = WS_HB + (size_t)MROWS * DM * 2;
constexpr size_t WL_IN = 0, WL_Q = WL_IN + (size_t)INP * DM * 2, WL_KV = WL_Q + (size_t)768 * 256 * 2, WL_O = WL_KV + (size_t)1024 * 128 * 2,
                 WL_GU = WL_O + (size_t)DM * DM * 2, WL_D = WL_GU + (size_t)GUP * DM * 2, WL_END = WL_D + (size_t)DM * DFF * 2;
constexpr size_t WBUF = 22 * MiB;
static_assert(WL_END <= WBUF, "weight buffer");
constexpr size_t WS_PART = WS_W + 2 * WBUF;
constexpr size_t P_HSSA = 0, P_HSSB = P_HSSA + (size_t)MROWS * 64, P_SSQO = P_HSSB + (size_t)MROWS * 64, P_SSQQ = P_SSQO + (size_t)MROWS * 64, P_SSQKV = P_SSQQ + (size_t)MROWS * 16, P_END = P_SSQKV + (size_t)MROWS * 16;
constexpr size_t PM_H = (P_END + 255) & ~(size_t)255, PM_HB = PM_H + 16 * DM * 4, PM_HSSA = PM_HB + 16 * DM * 2, PM_HSSB = PM_HSSA + 1024, PM_SSQQ = PM_HSSB + 1024, PM_SSQKV = PM_SSQQ + 256,
                 PM_QLAT = PM_SSQKV + 256, PM_KVLAT = PM_QLAT + 16 * 256 * 2, PM_ACT = PM_KVLAT + 16 * 128 * 2, PM_END = PM_ACT + 16 * DFF * 2;
static_assert(PM_END <= 8 * MiB, "partials");
constexpr int MC = BATCH * SEQ;
constexpr size_t WS_R = WS_PART + 8 * MiB;
constexpr size_t R_QA = 0, R_KA = R_QA + (size_t)MROWS * 512 * 2, R_VA = R_KA + (size_t)MROWS * 128 * 2, R_QLAT = R_VA + (size_t)MROWS * 128 * 2, R_KVLAT = R_QLAT + (size_t)MROWS * 256 * 2,
                 R_KR = R_KVLAT + (size_t)MROWS * 128 * 2, R_QM = R_KR + (size_t)MROWS * 32 * 2, R_KN = R_QM + (size_t)MROWS * 768 * 2, R_VB = R_KN + (size_t)MROWS * 512 * 2,
                 R_O = R_VB + (size_t)MROWS * 512 * 2, R_END = R_O + (size_t)MROWS * 1024 * 2;
constexpr size_t R_ACT = 0;
static_assert((size_t)MROWS * DFF * 2 <= R_END, "act overlay");
constexpr size_t WS_END = WS_R + R_END;
static_assert(WS_END <= 512 * MiB, "workspace must fit 512 MiB");

struct Args {
    const float *x, *meta, *attn_norm, *w_in, *q_norm, *w_q_up, *kv_norm, *w_kv_up, *sinks, *out_norm_swa, *out_norm_mla, *w_o, *ffn_norm, *w_gate, *w_up, *w_down, *final_norm;
    float* out; unsigned char* ws; int ph_lo, ph_hi;
};

__device__ __forceinline__ unsigned f2bf_u(float f) { unsigned u = __builtin_bit_cast(unsigned, f); return (u + 0x7fffu + ((u >> 16) & 1u)) >> 16; }
__device__ __forceinline__ unsigned pk2(float lo, float hi) { return f2bf_u(lo) | (f2bf_u(hi) << 16); }
__device__ __forceinline__ float wave_sum(float v) {
#pragma unroll
    for (int o = 1; o < 64; o <<= 1) v += __shfl_xor(v, o);
    return v;
}

__device__ __forceinline__ int src_in(int np) { const int pn = np >> 8, bj = (np >> 7) & 1, o = np & 127;
    if (pn < 2) return (4 * pn + (o >> 5)) * 64 + (o & 31) + 32 * bj;
    if (pn == 2) { if (o < 64) return 512 + (o >> 5) * 64 + (o & 31) + 32 * bj; if (o < 80) return 1152 + (o - 64) + 16 * bj; return -1; }
    if (pn == 3) return bj ? 1024 + o : 640 + o;
    return 768 + 128 * bj + o; }
__device__ __forceinline__ int src_qup(int np) { const int pn = np >> 8, op = np & 255;
    if (pn < 2) return (4 * pn + (op >> 6)) * 96 + (op & 63);
    const int bj = op >> 7, o = op & 127; return (o >> 4) * 96 + 64 + (o & 15) + 16 * bj; }
__device__ __forceinline__ int src_kvup(int np) { const int pn = np >> 8, op = np & 255; return (4 * (pn & 1) + (op >> 6)) * 128 + (pn >= 2 ? 64 : 0) + (op & 63); }

template <int MODE>
__device__ __forceinline__ void conv_item(const float* W, const float* W2, const float* gain, const float* gain2, int K, int Nsrc, bf16* WT, LAS float* scr, int item, int nblk, int lane) {
    const int kb = item / nblk, nb = item % nblk, k0 = 64 * kb, n0 = 32 * nb;
    const int np = n0 + (lane & 31);
    int src; float cs = 1.0f; const float* Wp = W;
    if (MODE == 0) { src = src_in(np); if (np < 512) cs = 0.125f * LOG2E; }
    else if (MODE == 1) { src = src_qup(np); cs = 0.10206207261596577f * LOG2E; }
    else if (MODE == 2) src = src_kvup(np);
    else if (MODE == 4) { src = 128 * (np >> 8) + (np & 127); if ((np >> 7) & 1) Wp = W2; }
    else src = np;
#pragma unroll 8
    for (int i = 0; i < 32; ++i) { const int kk = 2 * i + (lane >> 5), k = k0 + kk;
        float g = 1.0f; if (MODE == 3) g = (k < 512) ? gain[k] : gain2[k - 512]; else if (MODE != 5) g = gain[k];
        scr[kk * 33 + (lane & 31)] = (src >= 0) ? Wp[(size_t)k * Nsrc + src] * g * cs : 0.0f; }
    asm volatile("s_waitcnt lgkmcnt(0)" ::: "memory");
    const int c = lane & 7;
#pragma unroll
    for (int j = 0; j < 4; ++j) { const int n = (lane >> 3) + 8 * j; const LAS float* s = scr + (8 * c) * 33 + n;
        pg8::u32x4 o; o.x = pk2(s[0 * 33], s[1 * 33]); o.y = pk2(s[2 * 33], s[3 * 33]); o.z = pk2(s[4 * 33], s[5 * 33]); o.w = pk2(s[6 * 33], s[7 * 33]);
        *(pg8::u32x4*)(WT + (size_t)(n0 + n) * K + k0 + 8 * c) = o; }
    asm volatile("s_waitcnt lgkmcnt(0)" ::: "memory");
}
__device__ __forceinline__ void conv_layer(const Args& a, int l, unsigned char* wbuf, LAS unsigned char* lds) {
    int tid_ = threadIdx.x; asm volatile("" : "+v"(tid_));
    const int lane = tid_ & 63, wave = tid_ >> 6;
    LAS float* scr = (LAS float*)(lds + wave * 16384);
    const int gw = blockIdx.x * NWAVES + wave, NGW = gridDim.x * NWAVES;
    constexpr int I0 = (DM / 64) * (INP / 32), I1 = (256 / 64) * (768 / 32), I2 = (128 / 64) * (1024 / 32), I3 = (DM / 64) * (DM / 32), I4 = (DM / 64) * (GUP / 32), I5 = (DFF / 64) * (DM / 32);
    constexpr int NIT = I0 + I1 + I2 + I3 + I4 + I5;
    for (int it = gw; it < NIT; it += NGW) {
        int r = it;
        if (r < I0) { conv_item<0>(a.w_in + (size_t)l * DM * INW, nullptr, a.attn_norm + l * DM, nullptr, DM, INW, (bf16*)(wbuf + WL_IN), scr, r, INP / 32, lane); continue; } r -= I0;
        if (r < I1) { conv_item<1>(a.w_q_up + (size_t)l * 256 * 768, nullptr, a.q_norm + l * 256, nullptr, 256, 768, (bf16*)(wbuf + WL_Q), scr, r, 768 / 32, lane); continue; } r -= I1;
        if (r < I2) { conv_item<2>(a.w_kv_up + (size_t)l * 128 * 1024, nullptr, a.kv_norm + l * 128, nullptr, 128, 1024, (bf16*)(wbuf + WL_KV), scr, r, 1024 / 32, lane); continue; } r -= I2;
        if (r < I3) { conv_item<3>(a.w_o + (size_t)l * DM * DM, nullptr, a.out_norm_swa + l * 512, a.out_norm_mla + l * 512, DM, DM, (bf16*)(wbuf + WL_O), scr, r, DM / 32, lane); continue; } r -= I3;
        if (r < I4) { conv_item<4>(a.w_gate + (size_t)l * DM * DFF, a.w_up + (size_t)l * DM * DFF, a.ffn_norm + l * DM, nullptr, DM, DFF, (bf16*)(wbuf + WL_GU), scr, r, GUP / 32, lane); continue; } r -= I4;
        conv_item<5>(a.w_down + (size_t)l * DFF * DM, nullptr, nullptr, nullptr, DFF, DM, (bf16*)(wbuf + WL_D), scr, r, DM / 32, lane);
    }
}

__device__ __forceinline__ void init_rows(const Args& a, unsigned char* ws) {
    const int lane = threadIdx.x & 63, wave = threadIdx.x >> 6; const int gw = blockIdx.x * NWAVES + wave, NGW = gridDim.x * NWAVES;
    for (int row = gw; row < MC + NMETA; row += NGW) {
        const bool meta = row >= MC; const int r = meta ? row - MC : row;
        const float* src = meta ? a.meta + (size_t)r * DM : a.x + (size_t)r * DM;
        float* H = (float*)(ws + (meta ? WS_PART + PM_H : WS_H)); bf16* HB = (bf16*)(ws + (meta ? WS_PART + PM_HB : WS_HB)); float* hss = (float*)(ws + WS_PART + (meta ? PM_HSSA : P_HSSA));
        pg8::f32x4 v[4]; float s = 0.f;
#pragma unroll
        for (int j = 0; j < 4; ++j) { v[j] = *((const pg8::f32x4*)src + lane + 64 * j); s += pg8::sq4(v[j]); }
        s = wave_sum(s);
#pragma unroll
        for (int j = 0; j < 4; ++j) { pg8::st_bf16x4(HB + (size_t)r * DM + 4 * (lane + 64 * j), v[j]); }
        if (lane < 16) hss[(size_t)r * 16 + lane] = (lane == 0) ? s : 0.f;
    }
}
__device__ __forceinline__ void final_rows(const Args& a, const bf16* HBf, const float* hss) {
    const int lane = threadIdx.x & 63, wave = threadIdx.x >> 6; const int gw = blockIdx.x * NWAVES + wave, NGW = gridDim.x * NWAVES;
    for (int o = gw; o < BATCH * SEQ; o += NGW) {
        const int row = o;
        const float rs = pg8::rsq(pg8::sum16(hss, row) * (1.0f / DM) + RMS_EPS);
#pragma unroll
        for (int j = 0; j < 4; ++j) { const pg8::u32x2 hw = *((const pg8::u32x2*)(HBf + (size_t)row * DM) + lane + 64 * j); pg8::f32x4 v; v[0] = __builtin_bit_cast(float, hw.x << 16); v[1] = __builtin_bit_cast(float, hw.x & 0xffff0000u); v[2] = __builtin_bit_cast(float, hw.y << 16); v[3] = __builtin_bit_cast(float, hw.y & 0xffff0000u);
            const pg8::f32x4 g = *((const pg8::f32x4*)a.final_norm + lane + 64 * j);
            *((pg8::f32x4*)(a.out + (size_t)o * DM) + lane + 64 * j) = v * rs * g; }
    }
}

constexpr int N_ATT_UNITS = 2 * 17 * 64;
__device__ __forceinline__ void attn_phase(const Args& a, int l, unsigned char* ws, LAS unsigned char* lds) {
    const int lq = l; l &= 3;
    unsigned char* R = ws + WS_R;
    const bf16 *QA = (const bf16*)(R + R_QA), *KA = (const bf16*)(R + R_KA), *VA = (const bf16*)(R + R_VA), *KR = (const bf16*)(R + R_KR), *QM = (const bf16*)(R + R_QM), *KN = (const bf16*)(R + R_KN), *VB = (const bf16*)(R + R_VB);
    bf16* O = (bf16*)(R + R_O); float* ssqO = (float*)(ws + WS_PART + P_SSQO);
    LAS int* qslot = (LAS int*)(lds + att::OFF_Q);
    const unsigned xcc = ((unsigned)__builtin_amdgcn_s_getreg((3 << 11) | 20) & 0xFu) & 7u;
    unsigned* ctr = (unsigned*)(ws + WS_CTL) + 64 * lq + 8 * 64 * (int)xcc;
    constexpr int PER_X = N_ATT_UNITS / 8;
    for (int pass = 0; pass < 8; ++pass) {
        const unsigned x = (xcc + (unsigned)pass) & 7u; unsigned* c = (unsigned*)(ws + WS_CTL) + 64 * lq + 8 * 64 * (int)x;
        for (;;) {
            if (threadIdx.x == 0) *qslot = (int)atomicAdd(c, 1u);
            __syncthreads();
            const int u = *qslot;
            __syncthreads();
            if (u >= PER_X) break;
            if (u < PER_X / 2) {
                const int bh = 8 * (u / 17) + (int)x, qb = 16 - u % 17, b = bh >> 3, hd = bh & 7;
                att::attn_unit<96, false>(lds, QM + hd * 96, 768, KN + hd * 64, 512, KR, VB + hd * 64, 512, O + 512 + hd * 64, ssqO + 8 + hd, 0.f, b, qb);
            } else {
                const int v = u - PER_X / 2; const int bh = 8 * (v / 17) + (int)x, qb = 16 - v % 17, b = bh >> 3, hq = bh & 7, kv = hq >> 2;
                att::attn_unit<64, true>(lds, QA + hq * 64, 512, KA + kv * 64, 128, nullptr, VA + kv * 64, 128, O + hq * 64, ssqO + hq, a.sinks[l * 8 + hq] * LOG2E, b, qb);
            }
        }
    }
    (void)ctr;
}

#define XB_TMO      128
#define XB_XCNT(j)  (256  + 64 * (j))
#define XB_XSUB(j)  (1280 + 64 * (j))
#define XB_XGEN(j)  (2304 + 64 * (j))
#define XB_TOP      3328
#define XB_TOPGEN   3392
#define XCD_BAR_WORDS 3456
#define XB_SPIN_CAP (1u << 18)

__device__ __forceinline__ unsigned xb_ld(unsigned* p)              { return __hip_atomic_load(p, __ATOMIC_RELAXED, __HIP_MEMORY_SCOPE_AGENT); }
__device__ __forceinline__ unsigned xb_add(unsigned* p, unsigned v) { return __hip_atomic_fetch_add(p, v, __ATOMIC_RELAXED, __HIP_MEMORY_SCOPE_AGENT); }
__device__ __forceinline__ unsigned xb_xcc_id() { return (unsigned)__builtin_amdgcn_s_getreg((3 << 11) | 20) & 0xFu; }
#define XB_SPIN(cond, bar) do { unsigned _sp = 0; while (cond) { __builtin_amdgcn_s_sleep(1); \
    if ((++_sp & 255u) == 0u) { if (xb_ld(&(bar)[XB_TMO])) break; if (_sp > XB_SPIN_CAP) { atomicAdd(&(bar)[XB_TMO], 1u); break; } } } } while (0)

struct XcdBarrier {
    unsigned* bar; unsigned x;
    volatile LAS unsigned* st;
};

__device__ __forceinline__ XcdBarrier xcd_barrier_post(unsigned* bar, volatile LAS unsigned* st) {
    XcdBarrier b; b.bar = bar; b.x = xb_xcc_id(); b.st = st;
    if (threadIdx.x == 0) (void)xb_add(&bar[XB_XCNT(b.x)], 1u);
    return b;
}
__device__ __forceinline__ void xcd_barrier_complete(unsigned* bar, unsigned x, unsigned& nloc, unsigned& nx) {
    const unsigned G = gridDim.x * gridDim.y * gridDim.z;
    unsigned sum, cnt, mine, sp = 0u;
    for (;;) {
        sum = 0u; cnt = 0u; mine = 0u;
#pragma unroll
        for (unsigned j = 0; j < 16; ++j) { const unsigned c = xb_ld(&bar[XB_XCNT(j)]); sum += c; cnt += (c > 0u) ? 1u : 0u; mine = (j == x) ? c : mine; }
        if (sum == G) break;
        __builtin_amdgcn_s_sleep(1);
        if ((++sp & 255u) == 0u) { if (xb_ld(&bar[XB_TMO])) break; if (sp > XB_SPIN_CAP) { atomicAdd(&bar[XB_TMO], 1u); break; } }
    }
    nloc = mine > 0u ? mine : 1u; nx = cnt > 0u ? cnt : 1u;
}

__device__ __forceinline__ void xcd_barrier(const XcdBarrier& b) {
    asm volatile("s_waitcnt vmcnt(0)" ::: "memory");
    __syncthreads();
    if (threadIdx.x == 0) {
        unsigned* bar = b.bar;
        __builtin_amdgcn_s_waitcnt(0);
        unsigned nloc = b.st[0], nx = b.st[1];
        if (nloc == 0u) { xcd_barrier_complete(bar, b.x, nloc, nx); b.st[0] = nloc; b.st[1] = nx; }
        const unsigned old = xb_add(&bar[XB_XSUB(b.x)], 1u);
        const unsigned gen = old / nloc;
        if (old + 1u == (gen + 1u) * nloc) {
            __builtin_amdgcn_fence(__ATOMIC_RELEASE, "agent");
            asm volatile("s_waitcnt vmcnt(0)" ::: "memory");
            const unsigned og = xb_add(&bar[XB_TOP], 1u);
            const unsigned tg = og / nx;
            if (og + 1u == (tg + 1u) * nx) xb_add(&bar[XB_TOPGEN], 1u);
            else XB_SPIN(xb_ld(&bar[XB_TOPGEN]) == tg, bar);
            __builtin_amdgcn_fence(__ATOMIC_ACQUIRE, "agent");
            xb_add(&bar[XB_XGEN(b.x)], 1u);
            asm volatile("s_waitcnt vmcnt(0)" ::: "memory");
        } else {
            XB_SPIN(xb_ld(&bar[XB_XGEN(b.x)]) == gen, bar);
            __builtin_amdgcn_fence(__ATOMIC_ACQUIRE, "agent");
            asm volatile("s_waitcnt vmcnt(0)" ::: "memory");
        }
    }
    __syncthreads();
}

constexpr int CW_BAR = 4096;
constexpr int XB_LDS_OFF = 131072 + 8192;
#ifndef PHM
#define PHM 255
#endif
#ifndef PROBE_DUP
#define PROBE_DUP 0
#endif
#ifndef PROBE_SYNC
#define PROBE_SYNC 0
#endif
__global__ void __launch_bounds__(NTHREADS, 2) fwd_megakernel(Args a) {
    extern __shared__ __attribute__((aligned(16))) unsigned char lds_raw[];
    LAS unsigned char* lds = (LAS unsigned char*)lds_raw;
    cg::grid_group grid = cg::this_grid();
    const int lo = a.ph_lo, hi = a.ph_hi;
    if (threadIdx.x < 2) ((LAS unsigned*)(lds + XB_LDS_OFF))[threadIdx.x] = 0u;
    __syncthreads();
    const XcdBarrier xbar = xcd_barrier_post((unsigned*)(a.ws + WS_CTL) + CW_BAR, (volatile LAS unsigned*)(lds + XB_LDS_OFF));
#define IN_PH(k) (lo <= (k) && (k) < hi)
#define SEAM(k) do { if (IN_PH(k) && IN_PH((k) + 1)) { if ((k) == 0) grid.sync(); else xcd_barrier(xbar); if (PROBE_SYNC) xcd_barrier(xbar); } } while (0)
#define WSL(w) unsigned char* w = a.ws; asm volatile("" : "+s"(w))
    if (IN_PH(0) && (PHM & 1)) { WSL(ws); init_rows(a, ws); conv_layer(a, 0, ws + WS_W, lds); __syncthreads(); }
    SEAM(0);
#pragma unroll 1
    for (int l = 0; l < DEPTH; ++l) {
        const int p = 1 + 6 * l;
        if (IN_PH(p) && (PHM & 2)) {
            { WSL(ws); unsigned char* R = ws + WS_R; unsigned char* wb = ws + WS_W + (size_t)(l & 1) * WBUF; unsigned char* pm_ = ws + WS_PART;
              pg8::EpiIn<true> E{(const float*)(pm_ + PM_HSSA), (bf16*)(R + R_QA), (bf16*)(R + R_KA), (bf16*)(R + R_VA), (bf16*)(pm_ + PM_QLAT), (bf16*)(pm_ + PM_KVLAT), (bf16*)(R + R_KR), (float*)(pm_ + PM_SSQQ), (float*)(pm_ + PM_SSQKV)};
              pg8::skinny_phase(lds, (const bf16*)(pm_ + PM_HB), (const bf16*)(wb + WL_IN), DM, INP / 256, E); }
            WSL(ws); unsigned char* R = ws + WS_R; unsigned char* wb = ws + WS_W + (size_t)(l & 1) * WBUF;
            pg8::Gemm g{(const bf16*)(ws + WS_HB), (const bf16*)(wb + WL_IN), MC, INP, DM, 0}; pg8::OrderCT<MC / 256, INP / 256> S; S.init((int)gridDim.x, (int)blockIdx.x);
            pg8::EpiIn<false> E{(const float*)(ws + WS_PART + P_HSSA), (bf16*)(R + R_QA), (bf16*)(R + R_KA), (bf16*)(R + R_VA), (bf16*)(R + R_QLAT), (bf16*)(R + R_KVLAT), (bf16*)(R + R_KR),
                         (float*)(ws + WS_PART + P_SSQQ), (float*)(ws + WS_PART + P_SSQKV)};
            pg8::gemm_phase<pg8::EpiIn<false>, pg8::OrderCT<MC / 256, INP / 256>, true, true>(lds, g, S, E);
        }
        SEAM(p);
        if (IN_PH(p + 1) && (PHM & 4)) {
            { WSL(ws); unsigned char* R = ws + WS_R; unsigned char* wb = ws + WS_W + (size_t)(l & 1) * WBUF; unsigned char* pm_ = ws + WS_PART;
              pg8::EpiQup<true> E{(const float*)(pm_ + PM_SSQQ), (bf16*)(R + R_QM)}; pg8::skinny_phase(lds, (const bf16*)(pm_ + PM_QLAT), (const bf16*)(wb + WL_Q), 256, 3, E); }
            { WSL(ws); unsigned char* R = ws + WS_R; unsigned char* wb = ws + WS_W + (size_t)(l & 1) * WBUF;
              pg8::Gemm g{(const bf16*)(R + R_QLAT), (const bf16*)(wb + WL_Q), MC, 768, 256, 0}; pg8::OrderCT<MC / 256, 3> S; S.init((int)gridDim.x, (int)blockIdx.x);
              pg8::EpiQup<false> E{(const float*)(ws + WS_PART + P_SSQQ), (bf16*)(R + R_QM)}; pg8::gemm_phase<pg8::EpiQup<false>, pg8::OrderCT<MC / 256, 3>, true, true>(lds, g, S, E); }
            { WSL(ws); unsigned char* R = ws + WS_R; unsigned char* wb = ws + WS_W + (size_t)(l & 1) * WBUF; unsigned char* pm_ = ws + WS_PART;
              pg8::EpiKvup<true> E{(const float*)(pm_ + PM_SSQKV), (bf16*)(R + R_KN), (bf16*)(R + R_VB)}; pg8::skinny_phase(lds, (const bf16*)(pm_ + PM_KVLAT), (const bf16*)(wb + WL_KV), 128, 4, E); }
            { WSL(ws); unsigned char* R = ws + WS_R; unsigned char* wb = ws + WS_W + (size_t)(l & 1) * WBUF;
              pg8::Gemm g{(const bf16*)(R + R_KVLAT), (const bf16*)(wb + WL_KV), MC, 1024, 128, 0}; pg8::OrderCT<MC / 256, 4> S; S.init((int)gridDim.x, (int)blockIdx.x);
              pg8::EpiKvup<false> E{(const float*)(ws + WS_PART + P_SSQKV), (bf16*)(R + R_KN), (bf16*)(R + R_VB)}; pg8::gemm_phase<pg8::EpiKvup<false>, pg8::OrderCT<MC / 256, 4>, true, true>(lds, g, S, E); }
        }
        SEAM(p + 1);
        if (IN_PH(p + 2) && (PHM & 8)) { WSL(ws); if (l + 1 < DEPTH) { conv_layer(a, l + 1, ws + WS_W + (size_t)((l + 1) & 1) * WBUF, lds); __syncthreads(); } attn_phase(a, l, ws, lds); if (PROBE_DUP & 8) attn_phase(a, l + 4, ws, lds); }
        SEAM(p + 2);
        if (IN_PH(p + 3) && (PHM & 16)) {
            { WSL(ws); unsigned char* R = ws + WS_R; unsigned char* wb = ws + WS_W + (size_t)(l & 1) * WBUF; unsigned char* pm_ = ws + WS_PART;
              pg8::EpiOut<true> E; E.H = (float*)(pm_ + PM_H); E.HB = (bf16*)(pm_ + PM_HB); E.hss_out = (float*)(pm_ + PM_HSSB); E.ssq_o = (const float*)(pm_ + P_SSQO); E.xlds = lds;
              pg8::skinny_phase(lds, (const bf16*)(R + R_O) + (size_t)FRONT * 1024, (const bf16*)(wb + WL_O), DM, 4, E); }
            WSL(ws); unsigned char* R = ws + WS_R; unsigned char* wb = ws + WS_W + (size_t)(l & 1) * WBUF;
            pg8::Gemm g{(const bf16*)(R + R_O), (const bf16*)(wb + WL_O), MC, DM, DM, 1}; pg8::OrderCT<MC / 256, 4> S; S.init((int)gridDim.x, (int)blockIdx.x);
            pg8::EpiOut<false> E; E.H = (float*)(ws + WS_H); E.HB = (bf16*)(ws + WS_HB); E.hss_out = (float*)(ws + WS_PART + P_HSSB); E.ssq_o = (const float*)(ws + WS_PART + P_SSQO); E.xlds = lds + pg8::STAGE_BYTES;
            pg8::gemm_phase<pg8::EpiOut<false>, pg8::OrderCT<MC / 256, 4>, true, true>(lds, g, S, E);
        }
        SEAM(p + 3);
        if (IN_PH(p + 4) && (PHM & 32)) {
            { WSL(ws); unsigned char* wb = ws + WS_W + (size_t)(l & 1) * WBUF; unsigned char* pm_ = ws + WS_PART;
              pg8::EpiGU<true> E{(const float*)(pm_ + PM_HSSB), (bf16*)(pm_ + PM_ACT)}; pg8::skinny_phase(lds, (const bf16*)(pm_ + PM_HB), (const bf16*)(wb + WL_GU), DM, GUP / 256, E); }
            WSL(ws); unsigned char* R = ws + WS_R; unsigned char* wb = ws + WS_W + (size_t)(l & 1) * WBUF;
            pg8::Gemm g{(const bf16*)(ws + WS_HB), (const bf16*)(wb + WL_GU), MC, GUP, DM, 0}; pg8::OrderCT<MC / 256, GUP / 256> S; S.init((int)gridDim.x, (int)blockIdx.x);
            pg8::EpiGU<false> E{(const float*)(ws + WS_PART + P_HSSB), (bf16*)(R + R_ACT)};
            pg8::gemm_phase<pg8::EpiGU<false>, pg8::OrderCT<MC / 256, GUP / 256>, true, true>(lds, g, S, E);
        }
        SEAM(p + 4);
        if (IN_PH(p + 5) && (PHM & 64)) {
            { WSL(ws); unsigned char* wb = ws + WS_W + (size_t)(l & 1) * WBUF; unsigned char* pm_ = ws + WS_PART;
              pg8::EpiDown<true> E; E.H = (float*)(pm_ + PM_H); E.HB = (bf16*)(pm_ + PM_HB); E.hss_out = (float*)(pm_ + PM_HSSA); E.ssq_o = nullptr;
              pg8::skinny_phase(lds, (const bf16*)(pm_ + PM_ACT), (const bf16*)(wb + WL_D), DFF, 4, E); }
            WSL(ws); unsigned char* R = ws + WS_R; unsigned char* wb = ws + WS_W + (size_t)(l & 1) * WBUF;
            pg8::Gemm g{(const bf16*)(R + R_ACT), (const bf16*)(wb + WL_D), MC, DM, DFF, 0}; pg8::OrderCT<MC / 256, 4> S; S.init((int)gridDim.x, (int)blockIdx.x);
            pg8::EpiDown<false> E; E.H = (float*)(ws + WS_H); E.HB = (bf16*)(ws + WS_HB); E.hss_out = (float*)(ws + WS_PART + P_HSSA); E.ssq_o = nullptr;
            pg8::gemm_phase<pg8::EpiDown<false>, pg8::OrderCT<MC / 256, 4>, true, true>(lds, g, S, E);
        }
        SEAM(p + 5);
    }
    if (IN_PH(1 + 6 * DEPTH) && (PHM & 128)) { WSL(ws); final_rows(a, (const bf16*)(ws + WS_HB), (const float*)(ws + WS_PART + P_HSSA)); }
#undef IN_PH
#undef SEAM
#undef WSL
}
constexpr int N_PHASES = 2 + 6 * DEPTH;

#ifndef MK_SPLIT
#define MK_SPLIT 0
#endif
extern "C" void kernel_launch(void* const* d_in, const int* in_sizes, int n_in, void* d_out, int out_size, void* d_ws, size_t ws_size, hipStream_t stream) {
    static int grid = 0;
    if (grid == 0) {
        if (n_in != 17 || ws_size < WS_END) { fprintf(stderr, "kernel_launch: need 17 inputs and >= %zu bytes of workspace; got n_in %d, ws %zu\n", (size_t)WS_END, n_in, ws_size); grid = -1; return; }
        int dev = 0, cus = 0, per_cu = 0;
        hipGetDevice(&dev); hipDeviceGetAttribute(&cus, hipDeviceAttributeMultiprocessorCount, dev);
        if (hipFuncSetAttribute((const void*)fwd_megakernel, hipFuncAttributeMaxDynamicSharedMemorySize, LDS_BYTES) != hipSuccess) { fprintf(stderr, "kernel_launch: hipFuncSetAttribute failed\n"); grid = -1; return; }
        if (hipOccupancyMaxActiveBlocksPerMultiprocessor(&per_cu, (const void*)fwd_megakernel, NTHREADS, LDS_BYTES) != hipSuccess || per_cu < 1) { fprintf(stderr, "kernel_launch: occupancy query says %d\n", per_cu); per_cu = 1; }
        (void)hipGetLastError();
        grid = cus * 1;
    }
    if (grid < 0) return;
    hipMemsetAsync((char*)d_ws + WS_CTL, 0, CTL_BYTES, stream);
    Args a{};
    const float** f = (const float**)&a;
    for (int i = 0; i < 17; ++i) f[i] = (const float*)d_in[i];
    a.out = (float*)d_out; a.ws = (unsigned char*)d_ws;
#if MK_SPLIT
    for (int ph = 0; ph < N_PHASES; ++ph) { a.ph_lo = ph; a.ph_hi = ph + 1; hipLaunchKernelGGL(fwd_megakernel, dim3(grid), dim3(NTHREADS), LDS_BYTES, stream, a); }
#else
    a.ph_lo = 0; a.ph_hi = N_PHASES;
    void* args[] = {&a};
    hipError_t e = hipLaunchCooperativeKernel((const void*)fwd_megakernel, dim3(grid), dim3(NTHREADS), args, LDS_BYTES, stream);
    if (e != hipSuccess) fprintf(stderr, "cooperative launch failed: %s (grid %d)\n", hipGetErrorString(e), grid);
#endif
}
```

```cpp
#include <hip/hip_runtime.h>
#include <hip/hip_cooperative_groups.h>
#include <cstdio>
#include <cstdint>
namespace cg = cooperative_groups;

constexpr int BATCH = 8, SEQ = 4096, DM = 1024, DEPTH = 4, NMETA = 16, FRONT = 112, TT = 4224;
constexpr int MROWS = BATCH * TT;
constexpr int INW = 1184, INP = 1280, DFF = 2816, GUP = 2 * DFF;
constexpr float RMS_EPS = 1e-6f;
constexpr float LOG2E = 1.4426950408889634f;
constexpr float LOG2_THETA = 13.287712379549449f;
constexpr float INV_2PI = 0.15915494309189535f;

namespace pg8 {
#define PG8_LAS __attribute__((address_space(3)))
typedef unsigned short bf16_t;
typedef short bf16x8 __attribute__((ext_vector_type(8)));
typedef float f32x4 __attribute__((ext_vector_type(4)));
typedef unsigned u32x4 __attribute__((ext_vector_type(4)));
constexpr int BM = 256, BK = 64, HALF = 128, HTB = HALF * BK * 2  , STAGE_BYTES = 8 * HTB, NXCD = 8, WGM = 8;

__host__ __device__ __forceinline__ int lds_byte(int r, int c) { const int st = (r >> 4) * 2 + (c >> 5), rr = r & 15, cc = c & 31, ob = rr * 64 + cc * 2; return st * 1024 + (ob ^ (((ob >> 9) & 1) << 5)); }
__host__ __device__ __forceinline__ void stage_rc(int b, int& R, int& C) { const int st = b / 1024, sb = b % 1024, swz = sb ^ (((sb >> 9) & 1) << 5); R = (st >> 1) * 16 + swz / 64; C = (st & 1) * 32 + (swz % 64) / 2; }
__host__ __device__ __forceinline__ int perm32(int rho) { const int n = rho >> 4, i = rho & 15; return 8 * (i >> 2) + 4 * n + (i & 3); }

struct Unit { int pm, pn; };
struct Gemm { const bf16_t* A; const bf16_t* Bt; int M, N, K; int apad; };

struct StaticOrder {
    int nM, nN, nwg, G, c;
    __host__ __device__ void init(int M, int N, int G_, int c_) { nM = M / BM; nN = N / BM; nwg = nM * nN; G = G_; c = c_; }
    __host__ __device__ bool next(int i, Unit& u) const {
        const long L = (long)i * G + c; if (L >= nwg) return false;
        int wgid = (int)L; { const int q = nwg / NXCD, r = nwg % NXCD, xcd = wgid % NXCD, off = wgid / NXCD; wgid = (xcd < r ? xcd * (q + 1) : r * (q + 1) + (xcd - r) * q) + off; }
        const int nig = WGM * nN, gid = wgid / nig, fm = gid * WGM, gsz = (nM - fm) < WGM ? (nM - fm) : WGM;
        u.pm = fm + ((wgid % nig) % gsz); u.pn = (wgid % nig) / gsz; return true;
    }
    __device__ __forceinline__ void a_ready(const Unit&) const {}
    __device__ __forceinline__ void done(const Unit&) const {}
};

__device__ __forceinline__ unsigned cvt_pk_bf16(float lo, float hi) { unsigned r; asm volatile("v_cvt_pk_bf16_f32 %0, %1, %2" : "=v"(r) : "v"(lo), "v"(hi)); return r; }

template <int NM, int NN> struct OrderCT {
    static_assert(NM % 8 == 0 || NM % 8 == 4, "last M group must be 8 or 4 tiles");
    int G, c;
    __device__ __forceinline__ void init(int G_, int c_) { G = G_; c = c_; }
    __device__ __forceinline__ bool next(int i, Unit& u) const {
        constexpr int nwg = NM * NN, q = nwg / NXCD, r = nwg % NXCD, nig = WGM * NN;
        const int L = i * G + c; if (L >= nwg) return false;
        const int xcd = L & (NXCD - 1), off = L >> 3;
        const int wgid = (xcd < r ? xcd * (q + 1) : r * (q + 1) + (xcd - r) * q) + off;
        const int gid = wgid / nig, rem = wgid - gid * nig, fm = gid * WGM;
        const int sh = (NM - fm) < WGM ? 2 : 3;
        u.pm = fm + (rem & ((1 << sh) - 1)); u.pn = rem >> sh; return true;
    }
    __device__ __forceinline__ void a_ready(const Unit&) const {}
    __device__ __forceinline__ void done(const Unit&) const {}
};
typedef unsigned u32x2 __attribute__((ext_vector_type(2)));
__device__ __forceinline__ void st_bf16x4(bf16_t* p, f32x4 v) { u32x2 w; w.x = cvt_pk_bf16(v[0], v[1]); w.y = cvt_pk_bf16(v[2], v[3]); *(u32x2*)p = w; }
__device__ __forceinline__ float sum16(const float* part, int row) {
    const f32x4* p = (const f32x4*)(part + (size_t)row * 16); const f32x4 a = p[0], b = p[1], c = p[2], d = p[3];
    return (((a.x + a.y) + (a.z + a.w)) + ((b.x + b.y) + (b.z + b.w))) + (((c.x + c.y) + (c.z + c.w)) + ((d.x + d.y) + (d.z + d.w)));
}
__device__ __forceinline__ float sum4(const float* part, int row) { const f32x4 a = *(const f32x4*)(part + (size_t)row * 4); return (a.x + a.y) + (a.z + a.w); }
__device__ __forceinline__ float rsq(float x) { return 1.0f / sqrtf(x); }
__device__ __forceinline__ float sq4(f32x4 v) { return (v[0] * v[0] + v[1] * v[1]) + (v[2] * v[2] + v[3] * v[3]); }
#define EPI_ROWS(ai, m) for (int ai = 0; ai < 2; ++ai) for (int m = 0; m < 4; ++m)
#define EPI_ROW(u, ai, m) ((u).pm * BM + (ai) * HALF + wr * 64 + (m) * 16 + fr)

__device__ __forceinline__ int prow_of(int m) { return m + (m >> 12) * 128 + 128; }
#define EPI_NB (META ? BATCH : 1)
#define EPI_PROW(row, b) (META ? (size_t)((b) * TT + FRONT + (row)) : (size_t)prow_of(row))
#define EPI_MAIN_LOOP(CALL) _Pragma("unroll") for (int ai = 0; ai < 2; ++ai) _Pragma("unroll") for (int m = 0; m < 4; ++m) { asm volatile("" ::: "memory"); const int row = EPI_ROW(u, ai, m); \
        const f32x4 a_[2][2] = {{acc[ai][0][m][0], acc[ai][0][m][1]}, {acc[ai][1][m][0], acc[ai][1][m][1]}}; CALL; }

template <bool META> struct EpiIn {
    static constexpr bool PERM = false, AFTER_DRAIN = false, MIDSCALE = false;
    const float* hss; bf16_t *qa, *ka, *va, *qlat, *kvlat, *kr; float *ssq_q, *ssq_kv;
    __device__ __forceinline__ void mid(f32x4 (&)[2][2][4][2], const Unit&, int, int, int, int) const {}
    __device__ __forceinline__ void row_epi(const f32x4 (&a)[2][2], int row, int pn, int wc, int fr, int fq) const {
        const float rs = rsq(sum16(hss, row) * (1.0f / DM) + RMS_EPS);
        if (pn <= 2) {
            const bool is_kr = (pn == 2 && wc == 2);
            if (pn == 2 && wc == 3) return;
            const float pos = META ? (float)row : (float)((row & 4095) + NMETA);
#pragma unroll
            for (int n = 0; n < 2; ++n) {
                if (is_kr && n == 1) continue;
                const f32x4 x1 = a[0][n] * rs, x2 = a[1][n] * rs; f32x4 o1, o2;
#pragma unroll
                for (int e = 0; e < 4; ++e) { const float inv = is_kr ? __builtin_amdgcn_exp2f(-(float)(4 * fq + e) * (LOG2_THETA / 16.0f)) : __builtin_amdgcn_exp2f(-(float)(16 * n + 4 * fq + e) * (LOG2_THETA / 32.0f));
                    const float ang = pos * inv; float rev = ang * INV_2PI; rev = rev - floorf(rev);
                    const float sn = __builtin_amdgcn_sinf(rev), cs = __builtin_amdgcn_cosf(rev); o1[e] = x1[e] * cs - x2[e] * sn; o2[e] = x2[e] * cs + x1[e] * sn; }
#pragma unroll
                for (int b = 0; b < EPI_NB; ++b) { const size_t pr = EPI_PROW(row, b); bf16_t* d; int half;
                    if (pn < 2) { d = qa + pr * 512 + (4 * pn + wc) * 64 + 16 * n + 4 * fq; half = 32; }
                    else if (!is_kr) { d = ka + pr * 128 + wc * 64 + 16 * n + 4 * fq; half = 32; }
                    else { d = kr + pr * 32 + 4 * fq; half = 16; }
                    st_bf16x4(d, o1); st_bf16x4(d + half, o2); }
            }
        } else if (pn == 3) {
            float ss = 0.f;
#pragma unroll
            for (int n = 0; n < 2; ++n) { const int c = 32 * wc + 16 * n + 4 * fq; const f32x4 v = a[0][n] * rs, w = a[1][n] * rs;
#pragma unroll
                for (int b = 0; b < EPI_NB; ++b) st_bf16x4(va + EPI_PROW(row, b) * 128 + c, v);
                st_bf16x4(kvlat + (size_t)row * 128 + c, w); ss += sq4(w); }
            ss += __shfl_xor(ss, 16); ss += __shfl_xor(ss, 32);
            if (fq == 0) ssq_kv[(size_t)row * 4 + wc] = ss;
        } else {
            float ss = 0.f;
#pragma unroll
            for (int bj = 0; bj < 2; ++bj)
#pragma unroll
                for (int n = 0; n < 2; ++n) { const int c = 128 * bj + 32 * wc + 16 * n + 4 * fq; const f32x4 v = a[bj][n] * rs; st_bf16x4(qlat + (size_t)row * 256 + c, v); ss += sq4(v); }
            ss += __shfl_xor(ss, 16); ss += __shfl_xor(ss, 32);
            if (fq == 0) ssq_q[(size_t)row * 4 + wc] = ss;
        }
    }
    __device__ __forceinline__ void operator()(const f32x4 (&acc)[2][2][4][2], const Unit& u, int wr, int wc, int fr, int fq) const { EPI_MAIN_LOOP(row_epi(a_, row, u.pn, wc, fr, fq)) }
};

template <bool META> struct EpiQup {
    static constexpr bool PERM = false, AFTER_DRAIN = false, MIDSCALE = false;
    const float* ssq_q; bf16_t* qm;
    __device__ __forceinline__ void mid(f32x4 (&)[2][2][4][2], const Unit&, int, int, int, int) const {}
    __device__ __forceinline__ void row_epi(const f32x4 (&a)[2][2], int row, int pn, int wc, int fr, int fq) const {
        const float rs = rsq(sum4(ssq_q, row) * (1.0f / 256.0f) + RMS_EPS);
        if (pn < 2) {
#pragma unroll
            for (int bj = 0; bj < 2; ++bj)
#pragma unroll
                for (int n = 0; n < 2; ++n) { const int head = 4 * pn + 2 * bj + (wc >> 1), d = 32 * (wc & 1) + 16 * n + 4 * fq; const f32x4 v = a[bj][n] * rs;
#pragma unroll
                    for (int b = 0; b < EPI_NB; ++b) st_bf16x4(qm + EPI_PROW(row, b) * 768 + head * 96 + d, v); }
        } else {
            const float pos = META ? (float)row : (float)((row & 4095) + NMETA);
#pragma unroll
            for (int n = 0; n < 2; ++n) { const int head = 2 * wc + n; const f32x4 x1 = a[0][n] * rs, x2 = a[1][n] * rs; f32x4 o1, o2;
#pragma unroll
                for (int e = 0; e < 4; ++e) { const float inv = __builtin_amdgcn_exp2f(-(float)(4 * fq + e) * (LOG2_THETA / 16.0f)); const float ang = pos * inv; float rev = ang * INV_2PI; rev = rev - floorf(rev);
                    const float sn = __builtin_amdgcn_sinf(rev), cs = __builtin_amdgcn_cosf(rev); o1[e] = x1[e] * cs - x2[e] * sn; o2[e] = x2[e] * cs + x1[e] * sn; }
#pragma unroll
                for (int b = 0; b < EPI_NB; ++b) { bf16_t* qrow = qm + EPI_PROW(row, b) * 768; st_bf16x4(qrow + head * 96 + 64 + 4 * fq, o1); st_bf16x4(qrow + head * 96 + 80 + 4 * fq, o2); } }
        }
    }
    __device__ __forceinline__ void operator()(const f32x4 (&acc)[2][2][4][2], const Unit& u, int wr, int wc, int fr, int fq) const { EPI_MAIN_LOOP(row_epi(a_, row, u.pn, wc, fr, fq)) }
};

template <bool META> struct EpiKvup {
    static constexpr bool PERM = false, AFTER_DRAIN = false, MIDSCALE = false;
    const float* ssq_kv; bf16_t *kn, *vb;
    __device__ __forceinline__ void mid(f32x4 (&)[2][2][4][2], const Unit&, int, int, int, int) const {}
    __device__ __forceinline__ void row_epi(const f32x4 (&a)[2][2], int row, int pn, int wc, int fr, int fq) const {
        bf16_t* dst = (pn < 2 ? kn : vb) + (pn & 1) * 256;
        const float rs = rsq(sum4(ssq_kv, row) * (1.0f / 128.0f) + RMS_EPS);
#pragma unroll
        for (int bj = 0; bj < 2; ++bj)
#pragma unroll
            for (int n = 0; n < 2; ++n) { const f32x4 v = a[bj][n] * rs;
#pragma unroll
                for (int b = 0; b < EPI_NB; ++b) st_bf16x4(dst + EPI_PROW(row, b) * 512 + 128 * bj + 32 * wc + 16 * n + 4 * fq, v); }
    }
    __device__ __forceinline__ void operator()(const f32x4 (&acc)[2][2][4][2], const Unit& u, int wr, int wc, int fr, int fq) const { EPI_MAIN_LOOP(row_epi(a_, row, u.pn, wc, fr, fq)) }
};

struct EpiResid {
    static constexpr bool PERM = false, AFTER_DRAIN = false;
    float* H; bf16_t* HB; float* hss_out; const float* ssq_o;
    __device__ __forceinline__ void resid_row(const f32x4 (&a)[2][2], int row, float rs, int pn, int wc, int fr, int fq) const {
        float ss = 0.f;
#pragma unroll
        for (int bj = 0; bj < 2; ++bj)
#pragma unroll
            for (int n = 0; n < 2; ++n) { const size_t off = (size_t)row * DM + pn * BM + 128 * bj + 32 * wc + 16 * n + 4 * fq;
                const u32x2 hw = *(const u32x2*)(HB + off); f32x4 hv; hv[0] = __builtin_bit_cast(float, hw.x << 16); hv[1] = __builtin_bit_cast(float, hw.x & 0xffff0000u); hv[2] = __builtin_bit_cast(float, hw.y << 16); hv[3] = __builtin_bit_cast(float, hw.y & 0xffff0000u);
                hv = hv + a[bj][n] * rs; st_bf16x4(HB + off, hv); ss += sq4(hv); }
        ss += __shfl_xor(ss, 16); ss += __shfl_xor(ss, 32);
        if (fq == 0) hss_out[(size_t)row * 16 + 4 * pn + wc] = ss;
    }
    __device__ __forceinline__ void two_scales(size_t prow, float& f, float& rb) const {
        const f32x4* p = (const f32x4*)(ssq_o + prow * 16); const f32x4 a = p[0], b = p[1], c = p[2], d = p[3];
        const float sa = ((a.x + a.y) + (a.z + a.w)) + ((b.x + b.y) + (b.z + b.w)), sb = ((c.x + c.y) + (c.z + c.w)) + ((d.x + d.y) + (d.z + d.w));
        const float va = sa * (1.0f / 512.0f) + RMS_EPS, vb = sb * (1.0f / 512.0f) + RMS_EPS; f = sqrtf(vb / va); rb = rsq(vb);
    }
};
template <bool META> struct EpiOut : EpiResid {
    static constexpr bool MIDSCALE = true;
    PG8_LAS unsigned char* xlds;
    __device__ __forceinline__ void prep(const Unit& u, int wid, int wr, int lane) const {
        PG8_LAS float* tab = (PG8_LAS float*)(xlds + wid * 1024);
#pragma unroll
        for (int j = 0; j < 2; ++j) { const int idx = lane + 64 * j; const int row = u.pm * BM + (idx >> 6) * HALF + wr * 64 + (idx & 63);
            float f, rb; two_scales((size_t)prow_of(row), f, rb); tab[2 * idx] = f; tab[2 * idx + 1] = rb; }
    }
    __device__ __forceinline__ void mid(f32x4 (&acc)[2][2][4][2], const Unit& u, int wr, int wc, int fr, int fq) const {
        const int wid = wr * 4 + wc; const PG8_LAS float* tab = (const PG8_LAS float*)(xlds + wid * 1024);
#pragma unroll
        for (int ai = 0; ai < 2; ++ai)
#pragma unroll
            for (int m = 0; m < 4; ++m) {
                const float f = tab[2 * (ai * 64 + m * 16 + fr)];
#pragma unroll
                for (int bj = 0; bj < 2; ++bj)
#pragma unroll
                    for (int n = 0; n < 2; ++n) acc[ai][bj][m][n] *= f;
            }
    }
    __device__ __forceinline__ void operator()(const f32x4 (&acc)[2][2][4][2], const Unit& u, int wr, int wc, int fr, int fq) const {
        const PG8_LAS float* tab = (const PG8_LAS float*)(xlds + (wr * 4 + wc) * 1024);
        EPI_MAIN_LOOP(resid_row(a_, row, tab[2 * (ai * 64 + m * 16 + fr) + 1], u.pn, wc, fr, fq))
    }
    __device__ __forceinline__ void mid_row(f32x4 (&a)[2][2], int row) const { float f, rb; two_scales((size_t)(FRONT + row), f, rb);
#pragma unroll
        for (int bj = 0; bj < 2; ++bj)
#pragma unroll
            for (int n = 0; n < 2; ++n) a[bj][n] *= f; }
    __device__ __forceinline__ void row_epi(const f32x4 (&a)[2][2], int row, int pn, int wc, int fr, int fq) const { float f, rb; two_scales((size_t)(FRONT + row), f, rb); resid_row(a, row, rb, pn, wc, fr, fq); }
};
template <bool META> struct EpiDown : EpiResid {
    static constexpr bool MIDSCALE = false;
    __device__ __forceinline__ void mid(f32x4 (&)[2][2][4][2], const Unit&, int, int, int, int) const {}
    __device__ __forceinline__ void row_epi(const f32x4 (&a)[2][2], int row, int pn, int wc, int fr, int fq) const { resid_row(a, row, 1.0f, pn, wc, fr, fq); }
    __device__ __forceinline__ void operator()(const f32x4 (&acc)[2][2][4][2], const Unit& u, int wr, int wc, int fr, int fq) const { EPI_MAIN_LOOP(resid_row(a_, row, 1.0f, u.pn, wc, fr, fq)) }
};

template <bool META> struct EpiGU {
    static constexpr bool PERM = false, AFTER_DRAIN = false, MIDSCALE = false;
    const float* hss; bf16_t* act;
    __device__ __forceinline__ void mid(f32x4 (&)[2][2][4][2], const Unit&, int, int, int, int) const {}
    __device__ __forceinline__ void row_epi(const f32x4 (&a)[2][2], int row, int pn, int wc, int fr, int fq) const {
        const float rs = rsq(sum16(hss, row) * (1.0f / DM) + RMS_EPS);
#pragma unroll
        for (int n = 0; n < 2; ++n) { const f32x4 g = a[0][n] * rs, up = a[1][n] * rs; f32x4 o;
#pragma unroll
            for (int e = 0; e < 4; ++e) o[e] = g[e] * up[e] * __builtin_amdgcn_rcpf(1.0f + __builtin_amdgcn_exp2f(-g[e] * LOG2E));
            st_bf16x4(act + (size_t)row * DFF + 128 * pn + 32 * wc + 16 * n + 4 * fq, o); }
    }
    __device__ __forceinline__ void operator()(const f32x4 (&acc)[2][2][4][2], const Unit& u, int wr, int wc, int fr, int fq) const { EPI_MAIN_LOOP(row_epi(a_, row, u.pn, wc, fr, fq)) }
};

template <int K, class Epi>
__device__ __forceinline__ void skinny_phase(PG8_LAS unsigned char* lds, const bf16_t* A16, const bf16_t* Bt, int NN, const Epi& E, int wg0) {
    int tid_ = threadIdx.x; asm volatile("" : "+v"(tid_));
    const int tid = tid_, lane = tid & 63, wid = __builtin_amdgcn_readfirstlane(tid >> 6), fr = lane & 15, fq = lane >> 4;
    constexpr int nk = K / 32, NJ = (nk + 7) / 8;
    const int G = (int)gridDim.x; int first = (int)blockIdx.x - wg0; if (first < 0) first += G;
    for (int task = first; task < 4 * NN; task += G) {
        const int pn = task >> 2, wc = task & 3;
        f32x4 a[2][2];
#pragma unroll
        for (int bj = 0; bj < 2; ++bj)
#pragma unroll
            for (int n = 0; n < 2; ++n) a[bj][n] = (f32x4){0.f, 0.f, 0.f, 0.f};
        bool scaled = false;
        const bf16_t* ap = A16 + (size_t)fr * K + 8 * fq;
        const bf16_t* bp = Bt + (size_t)(256 * pn + 32 * wc + fr) * K + 8 * fq;
#pragma unroll 4
        for (int j = 0; j < NJ; ++j) {
            const int it = wid + 8 * j; if (it >= nk) break;
            const int k0 = 32 * it;
            if constexpr (Epi::MIDSCALE) { if (!scaled && k0 >= (K >> 1)) { E.mid_row(a, fr); scaled = true; } }
            const bf16x8 av = *(const bf16x8*)(ap + k0);
#pragma unroll
            for (int bj = 0; bj < 2; ++bj)
#pragma unroll
                for (int n = 0; n < 2; ++n) { const bf16x8 bv = *(const bf16x8*)(bp + (size_t)(128 * bj + 16 * n) * K + k0);
                    a[bj][n] = __builtin_amdgcn_mfma_f32_16x16x32_bf16(bv, av, a[bj][n], 0, 0, 0); }
        }
        if constexpr (Epi::MIDSCALE) { if (!scaled) E.mid_row(a, fr); }
        PG8_LAS f32x4* red = (PG8_LAS f32x4*)lds;
#pragma unroll
        for (int bj = 0; bj < 2; ++bj)
#pragma unroll
            for (int n = 0; n < 2; ++n) red[(wid * 64 + lane) * 4 + bj * 2 + n] = a[bj][n];
        __syncthreads();
        if (wid == 0) {
#pragma unroll
            for (int w = 1; w < 8; ++w)
#pragma unroll
                for (int bj = 0; bj < 2; ++bj)
#pragma unroll
                    for (int n = 0; n < 2; ++n) a[bj][n] += red[(w * 64 + lane) * 4 + bj * 2 + n];
            E.row_epi(a, fr, pn, wc, fr, fq);
        }
        __syncthreads();
    }
}
template <class Epi, class Sched, bool ALIGN_EPI = false, bool SP2 = false>
__device__ __forceinline__ void gemm_phase(PG8_LAS unsigned char* lds, const Gemm g, const Sched& S, const Epi& E) {
    int tid_ = threadIdx.x; asm volatile("" : "+v"(tid_));
    const int tid = tid_, wid = __builtin_amdgcn_readfirstlane(tid >> 6), lane = tid & 63, wr = wid >> 2, wc = wid & 3, fr = lane & 15, fq = lane >> 4;
    int K_ = g.K; asm volatile("" : "+s"(K_)); const int K = K_, nt = K / BK;
    unsigned voffA[2], voffB[2];
#pragma unroll
    for (int i = 0; i < 2; ++i) { int R, C; stage_rc(tid * 16 + i * 8192, R, C); const int Rb = Epi::PERM ? ((R & ~31) + perm32(R & 31)) : R;
        voffA[i] = (unsigned)(R * K + C) * 2u; voffB[i] = (unsigned)(Rb * K + C) * 2u; }
    const size_t kstep = (size_t)(BK * 2);
    const size_t hstep = (size_t)HALF * K * 2;
    const size_t tstep = 2 * hstep;
    const unsigned ldsw = (unsigned)wid * 1024u;
    const int aoff = lds_byte(wr * 64 + fr, fq * 8), boff = lds_byte(wc * 32 + fr, fq * 8);
#define PG8_SA(b, h) (((b) * 2 + (h)) * HTB)
#define PG8_SB(b, h) ((4 + (b) * 2 + (h)) * HTB)
#define PG8_STAGE(bufoff, gbase, voff) do { _Pragma("unroll") for (int _i = 0; _i < 2; ++_i) \
        __builtin_amdgcn_global_load_lds((const unsigned*)((const char*)(gbase) + (voff)[_i]), (PG8_LAS unsigned*)(lds + (bufoff) + ldsw + _i * 8192), 16, 0, 0); } while (0)
#define PG8_LDA(dst, b, h) do { _Pragma("unroll") for (int m = 0; m < 4; ++m) _Pragma("unroll") for (int k = 0; k < 2; ++k) dst[m][k] = *(const PG8_LAS bf16x8*)(lds + PG8_SA(b, h) + aoff + m * 2048 + k * 1024); } while (0)
#define PG8_LDB(dst, b, h) do { _Pragma("unroll") for (int n = 0; n < 2; ++n) _Pragma("unroll") for (int k = 0; k < 2; ++k) dst[n][k] = *(const PG8_LAS bf16x8*)(lds + PG8_SB(b, h) + boff + n * 2048 + k * 1024); } while (0)
#define PG8_MMA(ai, bj, At, Bt) do { __builtin_amdgcn_s_setprio(1); _Pragma("unroll") for (int m = 0; m < 4; ++m) _Pragma("unroll") for (int n = 0; n < 2; ++n) _Pragma("unroll") for (int k = 0; k < 2; ++k) \
        acc[ai][bj][m][n] = __builtin_amdgcn_mfma_f32_16x16x32_bf16(Bt[n][k], At[m][k], acc[ai][bj][m][n], 0, 0, 0); __builtin_amdgcn_s_setprio(0); } while (0)
#define PG8_WAIT_V(n) asm volatile("s_waitcnt vmcnt(" #n ")" ::: "memory")
#define PG8_WAIT_L(n) asm volatile("s_waitcnt lgkmcnt(" #n ")" ::: "memory")
#define PG8_BAR __builtin_amdgcn_s_barrier()
#define PG8_SCHED __builtin_amdgcn_sched_barrier(0)
    Unit cur, nxt; int ui = 0;
    if (!S.next(0, cur)) return;
    f32x4 acc[2][2][4][2];
#pragma unroll
    for (int a = 0; a < 2; ++a)
#pragma unroll
        for (int b = 0; b < 2; ++b)
#pragma unroll
            for (int m = 0; m < 4; ++m)
#pragma unroll
                for (int n = 0; n < 2; ++n) acc[a][b][m][n] = (f32x4){0.f, 0.f, 0.f, 0.f};
    bf16x8 At[4][2], B0[2][2], B1[2][2];
    const char* cA = (const char*)g.A + (size_t)cur.pm * tstep + (g.apad ? (size_t)((cur.pm >> 4) * 128 + 128) * (size_t)K * 2 : (size_t)0); const char* cB = (const char*)g.Bt + (size_t)cur.pn * tstep;
    S.a_ready(cur);
    if constexpr (SP2) {
        PG8_STAGE(PG8_SB(0, 0), cB, voffB); PG8_STAGE(PG8_SB(0, 1), cB + hstep, voffB); PG8_STAGE(PG8_SA(0, 0), cA, voffA); PG8_STAGE(PG8_SA(0, 1), cA + hstep, voffA);
        if (wr == 1) PG8_BAR;
        PG8_WAIT_V(2); PG8_BAR;
        PG8_STAGE(PG8_SB(1, 0), cB + kstep, voffB); PG8_STAGE(PG8_SA(1, 0), cA + kstep, voffA); PG8_STAGE(PG8_SB(1, 1), cB + hstep + kstep, voffB);
        PG8_WAIT_V(6); PG8_BAR;
    } else {
        PG8_STAGE(PG8_SB(0, 0), cB, voffB); PG8_STAGE(PG8_SA(0, 0), cA, voffA); PG8_STAGE(PG8_SB(0, 1), cB + hstep, voffB); PG8_STAGE(PG8_SA(0, 1), cA + hstep, voffA);
        if (wr == 1) PG8_BAR;
        PG8_WAIT_V(4); PG8_BAR;
        PG8_STAGE(PG8_SB(1, 0), cB + kstep, voffB); PG8_STAGE(PG8_SA(1, 0), cA + kstep, voffA); PG8_STAGE(PG8_SB(1, 1), cB + hstep + kstep, voffB);
        PG8_WAIT_V(6); PG8_BAR;
    }
    for (;;) {
        const bool has_next = S.next(ui + 1, nxt);
        if constexpr (Epi::MIDSCALE) E.prep(cur, wid, wr, lane);
        const char* nA = has_next ? (const char*)g.A + (size_t)nxt.pm * tstep + (g.apad ? (size_t)((nxt.pm >> 4) * 128 + 128) * (size_t)K * 2 : (size_t)0) : cA; const char* nB = has_next ? (const char*)g.Bt + (size_t)nxt.pn * tstep : cB;
        for (int t = 0; t < nt; t += 2) {
            const bool last = (t == nt - 2);
            if constexpr (Epi::MIDSCALE) { if (t == (nt >> 1)) E.mid(acc, cur, wr, wc, fr, fq); }
            const char* a1 = cA + (size_t)(t + 1) * kstep;
            const char* a2 = last ? nA : cA + (size_t)(t + 2) * kstep; const char* b2 = last ? nB : cB + (size_t)(t + 2) * kstep;
            const char* a3 = a2 + kstep; const char* b3 = b2 + kstep;
            if (last && has_next) S.a_ready(nxt);
            if constexpr (SP2) {
            PG8_LDB(B0, 0, 0); PG8_LDB(B1, 0, 1); PG8_SCHED; PG8_LDA(At, 0, 0); PG8_STAGE(PG8_SA(1, 1), a1 + hstep, voffA);
            PG8_WAIT_V(8); PG8_WAIT_L(0); PG8_BAR; PG8_MMA(0, 0, At, B0); PG8_MMA(0, 1, At, B1); PG8_BAR; PG8_SCHED;
            PG8_LDA(At, 0, 1); PG8_STAGE(PG8_SB(0, 0), b2, voffB); PG8_STAGE(PG8_SB(0, 1), b2 + hstep, voffB); PG8_STAGE(PG8_SA(0, 0), a2, voffA);
            PG8_WAIT_V(8); PG8_WAIT_L(0); PG8_BAR; PG8_MMA(1, 0, At, B0); PG8_MMA(1, 1, At, B1); PG8_BAR; PG8_SCHED;
            PG8_LDB(B0, 1, 0); PG8_LDB(B1, 1, 1); PG8_SCHED; PG8_LDA(At, 1, 0); PG8_STAGE(PG8_SA(0, 1), a2 + hstep, voffA);
            PG8_WAIT_V(8); PG8_WAIT_L(0); PG8_BAR; PG8_MMA(0, 0, At, B0); PG8_MMA(0, 1, At, B1); PG8_BAR; PG8_SCHED;
            PG8_LDA(At, 1, 1); PG8_STAGE(PG8_SB(1, 0), b3, voffB); PG8_STAGE(PG8_SB(1, 1), b3 + hstep, voffB); PG8_STAGE(PG8_SA(1, 0), a3, voffA);
            PG8_WAIT_V(8); PG8_WAIT_L(0); PG8_BAR; PG8_MMA(1, 0, At, B0); PG8_MMA(1, 1, At, B1); PG8_BAR; PG8_SCHED;
            } else {
            PG8_LDB(B0, 0, 0); PG8_SCHED; PG8_LDA(At, 0, 0); PG8_STAGE(PG8_SA(1, 1), a1 + hstep, voffA);
            PG8_WAIT_L(8); PG8_BAR; PG8_WAIT_L(0); PG8_MMA(0, 0, At, B0); PG8_BAR; PG8_SCHED;
            PG8_LDB(B1, 0, 1); PG8_STAGE(PG8_SB(0, 0), b2, voffB);
            PG8_BAR; PG8_WAIT_L(0); PG8_MMA(0, 1, At, B1); PG8_BAR;
            PG8_LDA(At, 0, 1); PG8_STAGE(PG8_SA(0, 0), a2, voffA);
            PG8_BAR; PG8_WAIT_L(0); PG8_MMA(1, 0, At, B0); PG8_BAR; PG8_SCHED;
            PG8_STAGE(PG8_SB(0, 1), b2 + hstep, voffB);
            PG8_WAIT_V(6); PG8_BAR; PG8_MMA(1, 1, At, B1); PG8_BAR;
            PG8_LDB(B0, 1, 0); PG8_SCHED; PG8_LDA(At, 1, 0); PG8_STAGE(PG8_SA(0, 1), a2 + hstep, voffA);
            PG8_WAIT_L(8); PG8_BAR; PG8_WAIT_L(0); PG8_MMA(0, 0, At, B0); PG8_BAR; PG8_SCHED;
            PG8_LDB(B1, 1, 1); PG8_STAGE(PG8_SB(1, 0), b3, voffB);
            PG8_BAR; PG8_WAIT_L(0); PG8_MMA(0, 1, At, B1); PG8_BAR;
            PG8_LDA(At, 1, 1); PG8_STAGE(PG8_SA(1, 0), a3, voffA);
            PG8_BAR; PG8_WAIT_L(0); PG8_MMA(1, 0, At, B0); PG8_BAR; PG8_SCHED;
            PG8_STAGE(PG8_SB(1, 1), b3 + hstep, voffB);
            PG8_WAIT_V(6); PG8_BAR; PG8_MMA(1, 1, At, B1); PG8_BAR;
            }
        }
        if constexpr (ALIGN_EPI) { if (wr == 0) PG8_BAR; }
        if constexpr (!Epi::AFTER_DRAIN) { E(acc, cur, wr, wc, fr, fq); S.done(cur); }
        if (!has_next) break;
#pragma unroll
        for (int a = 0; a < 2; ++a)
#pragma unroll
            for (int b = 0; b < 2; ++b)
#pragma unroll
                for (int m = 0; m < 4; ++m)
#pragma unroll
                    for (int n = 0; n < 2; ++n) acc[a][b][m][n] = (f32x4){0.f, 0.f, 0.f, 0.f};
        cur = nxt; cA = nA; cB = nB; ++ui;
        if constexpr (ALIGN_EPI) { if (wr == 1) PG8_BAR; }
    }
    PG8_WAIT_V(0);
    if constexpr (!ALIGN_EPI) { if (wr == 0) PG8_BAR; }
    PG8_BAR;
    if constexpr (Epi::AFTER_DRAIN) { E.fused(acc, cur, wr, wc, fr, fq, lds, wid, lane); S.done(cur); }
#undef PG8_SA
#undef PG8_SB
#undef PG8_STAGE
#undef PG8_LDA
#undef PG8_LDB
#undef PG8_MMA
#undef PG8_WAIT_V
#undef PG8_WAIT_L
#undef PG8_BAR
#undef PG8_SCHED
}
}
namespace att {
#define ALAS __attribute__((address_space(3)))
typedef unsigned short bf16_t;
typedef short bf16x8 __attribute__((ext_vector_type(8)));
typedef short s16x4 __attribute__((ext_vector_type(4)));
typedef float f32x16 __attribute__((ext_vector_type(16)));
typedef unsigned u32x4 __attribute__((ext_vector_type(4)));
typedef float f32x2_t __attribute__((ext_vector_type(2))); typedef __bf16 bf16x2_t __attribute__((ext_vector_type(2)));
constexpr int KPMAX = 208, VP = 144, KSZ = 64 * KPMAX, VSZ = 64 * VP;
constexpr int OFF_V = 2 * KSZ, OFF_SCR = OFF_V + 2 * VSZ, OFF_Q = OFF_SCR + 8 * 256, LDS_BYTES = OFF_Q + 64;
constexpr float NEGF = -1e30f, THR = 6.0f;
__device__ __forceinline__ int crow(int r, int hi) { return (r & 3) + 8 * (r >> 2) + 4 * hi; }
__device__ __forceinline__ unsigned cvtpk(float lo, float hi) { f32x2_t v = {lo, hi}; bf16x2_t b = __builtin_convertvector(v, bf16x2_t); return __builtin_bit_cast(unsigned, b); }
__device__ __forceinline__ bf16x8 pack8(const f32x16& p, int s) { u32x4 w; w.x = cvtpk(p[8 * s], p[8 * s + 1]); w.y = cvtpk(p[8 * s + 2], p[8 * s + 3]); w.z = cvtpk(p[8 * s + 4], p[8 * s + 5]); w.w = cvtpk(p[8 * s + 6], p[8 * s + 7]); return __builtin_bit_cast(bf16x8, w); }
typedef short v4i16_t __attribute__((ext_vector_type(4)));
__device__ __forceinline__ s16x4 vtr(const ALAS unsigned char* p) { return __builtin_bit_cast(s16x4, __builtin_amdgcn_ds_read_tr16_b64_v4i16((ALAS v4i16_t*)p)); }
__device__ __forceinline__ unsigned short f2bf(float f) { unsigned u = __builtin_bit_cast(unsigned, f); return (unsigned short)((u + 0x7fffu + ((u >> 16) & 1u)) >> 16); }

template <int DQK, bool SWA>
__device__ __forceinline__ void attn_unit(ALAS unsigned char* lds, const bf16_t* Qp, int qpitch, const bf16_t* Kp, int kpitch, const bf16_t* Krp, const bf16_t* Vp, int vpitch,
                                          bf16_t* Op, float* ssq, float sink2, int b, int qb) {
    constexpr int KP = DQK * 2 + 16, NS = DQK / 16;
    int tid_ = threadIdx.x; asm volatile("" : "+v"(tid_));
    const int tid = tid_, lane = tid & 63, wid = __builtin_amdgcn_readfirstlane(tid >> 6), r = lane & 31, h = lane >> 5;
    const size_t rowbase = (size_t)b * TT;
    const int q0 = qb * 256, q0w = q0 + wid * 32;
    const bool wave_valid = q0w < TT;
    const int NT = (q0 + 256) / 64 < TT / 64 ? (q0 + 256) / 64 : TT / 64;
    int t0 = 1; if (SWA) { t0 = (q0 - 128) / 64; if (t0 < 1) t0 = 1; }
    ALAS float* scr = (ALAS float*)(lds + OFF_SCR + wid * 256);
    bf16x8 qf[NS];
    { const int qr = (q0w + r) < TT ? (q0w + r) : TT - 1; const bf16_t* qrow = Qp + (rowbase + qr) * (size_t)qpitch;
#pragma unroll
      for (int s = 0; s < NS; ++s) qf[s] = *(const bf16x8*)(qrow + 16 * s + 8 * h); }
    const int srow = tid >> 3, sch = tid & 7, rrow = (tid >> 2) & 63, rch = tid & 3;
    u32x4 kregA, vregA, rregA = {0u, 0u, 0u, 0u}, kregB, vregB, rregB = {0u, 0u, 0u, 0u};
#define AT_GLOAD(t, S) do { const size_t kr_ = rowbase + 64 * (t) + srow; kreg##S = *(const u32x4*)(Kp + kr_ * (size_t)kpitch + sch * 8); vreg##S = *(const u32x4*)(Vp + kr_ * (size_t)vpitch + sch * 8); \
        if (DQK == 96) { if (tid < 256) rreg##S = *(const u32x4*)(Krp + (rowbase + 64 * (t) + rrow) * 32 + rch * 8); } } while (0)
#define AT_LSTORE(buf, S) do { *(ALAS u32x4*)(lds + (buf) * KSZ + srow * KP + sch * 16) = kreg##S; *(ALAS u32x4*)(lds + OFF_V + (buf) * VSZ + srow * VP + sch * 16) = vreg##S; \
        if (DQK == 96) { if (tid < 256) *(ALAS u32x4*)(lds + (buf) * KSZ + rrow * KP + 128 + rch * 16) = rreg##S; } } while (0)
    AT_GLOAD(t0, A); AT_LSTORE(0, A);
    if (t0 + 1 < NT) AT_GLOAD(t0 + 1, A);
    __syncthreads();
    float mrun = SWA ? sink2 : NEGF, lrun = (SWA && h == 0) ? 1.0f : 0.0f;
    f32x16 o0, o1;
#pragma unroll
    for (int i = 0; i < 16; ++i) { o0[i] = 0.f; o1[i] = 0.f; }
    const int q = q0w + r;
#define AT_PV(P, rowoff) do { \
                { const s16x4 lo = vtr(vb_ + (rowoff) * VP), hi = vtr(vb_ + ((rowoff) + 8) * VP); const bf16x8 vf = __builtin_shufflevector(lo, hi, 0, 1, 2, 3, 4, 5, 6, 7); o0 = __builtin_amdgcn_mfma_f32_32x32x16_bf16(P, vf, o0, 0, 0, 0); } \
                { const s16x4 lo = vtr(vb_ + (rowoff) * VP + 64), hi = vtr(vb_ + ((rowoff) + 8) * VP + 64); const bf16x8 vf = __builtin_shufflevector(lo, hi, 0, 1, 2, 3, 4, 5, 6, 7); o1 = __builtin_amdgcn_mfma_f32_32x32x16_bf16(P, vf, o1, 0, 0, 0); } } while (0)
#define AT_STEP(t, LS, SS) do { \
        const int buf = (t - t0) & 1; \
        if (t + 2 < NT) AT_GLOAD(t + 2, LS); \
        const int kfirst = 64 * t; \
        bool active = wave_valid && (kfirst <= q0w + 31); \
        if (SWA) active = active && (kfirst + 63 >= q0w - 127); \
        if (active) { \
            f32x16 s0, s1; \
_Pragma("unroll") \
            for (int i = 0; i < 16; ++i) { s0[i] = 0.f; s1[i] = 0.f; } \
            const ALAS unsigned char* kb = lds + buf * KSZ + r * KP + h * 16; \
_Pragma("unroll") \
            for (int s = 0; s < NS; ++s) { const bf16x8 k0 = *(const ALAS bf16x8*)(kb + s * 32), k1 = *(const ALAS bf16x8*)(kb + 32 * KP + s * 32); \
                s0 = __builtin_amdgcn_mfma_f32_32x32x16_bf16(k0, qf[s], s0, 0, 0, 0); s1 = __builtin_amdgcn_mfma_f32_32x32x16_bf16(k1, qf[s], s1, 0, 0, 0); } \
            const bool need_mask = SWA || (t == 1) || (kfirst + 63 > q0w); \
            if (need_mask) { \
_Pragma("unroll") \
                for (int i = 0; i < 16; ++i) { const int key = kfirst + crow(i, h), key1 = key + 32; \
                    bool ok0 = (key <= q) && (key >= FRONT), ok1 = (key1 <= q) && (key1 >= FRONT); \
                    if (SWA) { ok0 = ok0 && (q - key < 128); ok1 = ok1 && (q - key1 < 128); } \
                    s0[i] = ok0 ? s0[i] : NEGF; s1[i] = ok1 ? s1[i] : NEGF; } \
            } \
            float rm = fmaxf(s0[0], s1[0]); \
_Pragma("unroll") \
            for (int i = 1; i < 16; ++i) rm = fmaxf(rm, fmaxf(s0[i], s1[i])); \
            rm = fmaxf(rm, __shfl_xor(rm, 32)); \
            if (__any(rm > mrun + THR)) { \
                const float mn = fmaxf(mrun, rm), f = __builtin_amdgcn_exp2f(mrun - mn); mrun = mn; lrun *= f; \
                if (h == 0) scr[r] = f; \
_Pragma("unroll") \
                for (int i = 0; i < 16; ++i) { const float fi = scr[crow(i, h)]; o0[i] *= fi; o1[i] *= fi; } \
            } \
            float ls = 0.f; \
_Pragma("unroll") \
            for (int i = 0; i < 16; ++i) { s0[i] = __builtin_amdgcn_exp2f(s0[i] - mrun); s1[i] = __builtin_amdgcn_exp2f(s1[i] - mrun); ls += s0[i] + s1[i]; } \
            lrun += ls; \
            const bf16x8 p0 = pack8(s0, 0), p1 = pack8(s0, 1), p2 = pack8(s1, 0), p3 = pack8(s1, 1); \
            const ALAS unsigned char* vb_ = lds + OFF_V + buf * VSZ + (4 * h + ((lane & 15) >> 2)) * VP + ((lane >> 4) & 1) * 32 + (lane & 3) * 8; \
            AT_PV(p0, 0); AT_PV(p1, 16); AT_PV(p2, 32); AT_PV(p3, 48); \
        } \
        if (t + 1 < NT) AT_LSTORE(buf ^ 1, SS); \
        __syncthreads(); \
    } while (0)
    {
        int t = t0;
        for (; t + 1 < NT; t += 2) { AT_STEP(t, B, A); const int t1 = t + 1; AT_STEP(t1, A, B); }
        if (t < NT) AT_STEP(t, B, A);
    }
#undef AT_STEP
#undef AT_PV
#undef AT_GLOAD
#undef AT_LSTORE
    if (wave_valid) {
        const float lt = lrun + __shfl_xor(lrun, 32);
        if (h == 0) scr[32 + r] = lt;
#pragma unroll
        for (int i = 0; i < 16; ++i) {
            const float li = scr[32 + crow(i, h)], inv = li > 0.f ? 1.0f / li : 0.f;
            const float a = o0[i] * inv, c = o1[i] * inv; const size_t row = rowbase + q0w + crow(i, h);
            Op[row * 1024 + r] = f2bf(a); Op[row * 1024 + 32 + r] = f2bf(c);
            float ss = a * a + c * c;
            ss += __shfl_xor(ss, 1); ss += __shfl_xor(ss, 2); ss += __shfl_xor(ss, 4); ss += __shfl_xor(ss, 8); ss += __shfl_xor(ss, 16);
            if (r == 0) ssq[row * 16] = ss;
        }
    }
    __syncthreads();
}
}
typedef unsigned short bf16;
#define LAS __attribute__((address_space(3)))
constexpr size_t MiB = 1u << 20;
constexpr int NWAVES = 8, NTHREADS = 512;
constexpr int LDS_BYTES = 147456;
static_assert(att::LDS_BYTES <= 131072, "attention LDS");
constexpr size_t WS_CTL = 0, CTL_BYTES = 65536;
constexpr size_t WS_H = 1 * MiB;
constexpr size_t WS_HB = WS_H + (size_t)MROWS * DM * 4;
constexpr size_t WS_W = WS_HB + (size_t)MROWS * DM * 2;
constexpr size_t WL_IN = 0, WL_Q = WL_IN + (size_t)INP * DM * 2, WL_KV = WL_Q + (size_t)768 * 256 * 2, WL_O = WL_KV + (size_t)1024 * 128 * 2,
                 WL_GU = WL_O + (size_t)DM * DM * 2, WL_D = WL_GU + (size_t)GUP * DM * 2, WL_END = WL_D + (size_t)DM * DFF * 2;
constexpr size_t WBUF = 22 * MiB;
static_assert(WL_END <= WBUF, "weight buffer");
constexpr size_t WS_PART = WS_W + 2 * WBUF;
constexpr size_t P_HSSA = 0, P_HSSB = P_HSSA + (size_t)MROWS * 64, P_SSQO = P_HSSB + (size_t)MROWS * 64, P_SSQQ = P_SSQO + (size_t)MROWS * 64, P_SSQKV = P_SSQQ + (size_t)MROWS * 16, P_END = P_SSQKV + (size_t)MROWS * 16;
constexpr size_t PM_H = (P_END + 255) & ~(size_t)255, PM_HB = PM_H + 16 * DM * 4, PM_HSSA = PM_HB + 16 * DM * 2, PM_HSSB = PM_HSSA + 1024, PM_SSQQ = PM_HSSB + 1024, PM_SSQKV = PM_SSQQ + 256,
                 PM_QLAT = PM_SSQKV + 256, PM_KVLAT = PM_QLAT + 16 * 256 * 2, PM_ACT = PM_KVLAT + 16 * 128 * 2, PM_END = PM_ACT + 16 * DFF * 2;
static_assert(PM_END <= 8 * MiB, "partials");
constexpr int MC = BATCH * SEQ;
constexpr size_t WS_R = WS_PART + 8 * MiB;
constexpr size_t R_QA = 0, R_KA = R_QA + (size_t)MROWS * 512 * 2, R_VA = R_KA + (size_t)MROWS * 128 * 2, R_QLAT = R_VA + (size_t)MROWS * 128 * 2, R_KVLAT = R_QLAT + (size_t)MROWS * 256 * 2,
                 R_KR = R_KVLAT + (size_t)MROWS * 128 * 2, R_QM = R_KR + (size_t)MROWS * 32 * 2, R_KN = R_QM + (size_t)MROWS * 768 * 2, R_VB = R_KN + (size_t)MROWS * 512 * 2,
                 R_O = R_VB + (size_t)MROWS * 512 * 2, R_END = R_O + (size_t)MROWS * 1024 * 2;
constexpr size_t R_ACT = 0;
static_assert((size_t)MROWS * DFF * 2 <= R_END, "act overlay");
constexpr size_t WS_END = WS_R + R_END;
static_assert(WS_END <= 512 * MiB, "workspace must fit 512 MiB");

struct Args {
    const float *x, *meta, *attn_norm, *w_in, *q_norm, *w_q_up, *kv_norm, *w_kv_up, *sinks, *out_norm_swa, *out_norm_mla, *w_o, *ffn_norm, *w_gate, *w_up, *w_down, *final_norm;
    float* out; unsigned char* ws; int ph_lo, ph_hi;
};

__device__ __forceinline__ unsigned f2bf_u(float f) { unsigned u = __builtin_bit_cast(unsigned, f); return (u + 0x7fffu + ((u >> 16) & 1u)) >> 16; }
__device__ __forceinline__ unsigned pk2(float lo, float hi) { return f2bf_u(lo) | (f2bf_u(hi) << 16); }
__device__ __forceinline__ float wave_sum(float v) {
#pragma unroll
    for (int o = 1; o < 64; o <<= 1) v += __shfl_xor(v, o);
    return v;
}

__device__ __forceinline__ int src_in(int np) { const int pn = np >> 8, bj = (np >> 7) & 1, o = np & 127;
    if (pn < 2) return (4 * pn + (o >> 5)) * 64 + (o & 31) + 32 * bj;
    if (pn == 2) { if (o < 64) return 512 + (o >> 5) * 64 + (o & 31) + 32 * bj; if (o < 80) return 1152 + (o - 64) + 16 * bj; return -1; }
    if (pn == 3) return bj ? 1024 + o : 640 + o;
    return 768 + 128 * bj + o; }
__device__ __forceinline__ int src_qup(int np) { const int pn = np >> 8, op = np & 255;
    if (pn < 2) return (4 * pn + (op >> 6)) * 96 + (op & 63);
    const int bj = op >> 7, o = op & 127; return (o >> 4) * 96 + 64 + (o & 15) + 16 * bj; }
__device__ __forceinline__ int src_kvup(int np) { const int pn = np >> 8, op = np & 255; return (4 * (pn & 1) + (op >> 6)) * 128 + (pn >= 2 ? 64 : 0) + (op & 63); }

template <int MODE>
__device__ __forceinline__ void conv_item(const float* W, const float* W2, const float* gain, const float* gain2, int K, int Nsrc, bf16* WT, LAS float* scr, int item, int nblk, int lane) {
    const int kb = item / nblk, nb = item % nblk, k0 = 64 * kb, n0 = 32 * nb;
    const int np = n0 + (lane & 31);
    int src; float cs = 1.0f; const float* Wp = W;
    if (MODE == 0) { src = src_in(np); if (np < 512) cs = 0.125f * LOG2E; }
    else if (MODE == 1) { src = src_qup(np); cs = 0.10206207261596577f * LOG2E; }
    else if (MODE == 2) src = src_kvup(np);
    else if (MODE == 4) { src = 128 * (np >> 8) + (np & 127); if ((np >> 7) & 1) Wp = W2; }
    else src = np;
#pragma unroll 8
    for (int i = 0; i < 32; ++i) { const int kk = 2 * i + (lane >> 5), k = k0 + kk;
        float g = 1.0f; if (MODE == 3) g = (k < 512) ? gain[k] : gain2[k - 512]; else if (MODE != 5) g = gain[k];
        scr[kk * 33 + (lane & 31)] = (src >= 0) ? Wp[(size_t)k * Nsrc + src] * g * cs : 0.0f; }
    asm volatile("s_waitcnt lgkmcnt(0)" ::: "memory");
    const int c = lane & 7;
#pragma unroll
    for (int j = 0; j < 4; ++j) { const int n = (lane >> 3) + 8 * j; const LAS float* s = scr + (8 * c) * 33 + n;
        pg8::u32x4 o; o.x = pk2(s[0 * 33], s[1 * 33]); o.y = pk2(s[2 * 33], s[3 * 33]); o.z = pk2(s[4 * 33], s[5 * 33]); o.w = pk2(s[6 * 33], s[7 * 33]);
        *(pg8::u32x4*)(WT + (size_t)(n0 + n) * K + k0 + 8 * c) = o; }
    asm volatile("s_waitcnt lgkmcnt(0)" ::: "memory");
}
__device__ __forceinline__ void conv_layer(const Args& a, int l, unsigned char* wbuf, LAS unsigned char* lds) {
    int tid_ = threadIdx.x; asm volatile("" : "+v"(tid_));
    const int lane = tid_ & 63, wave = tid_ >> 6;
    LAS float* scr = (LAS float*)(lds + wave * 16384);
    const int gw = blockIdx.x * NWAVES + wave, NGW = gridDim.x * NWAVES;
    constexpr int I0 = (DM / 64) * (INP / 32), I1 = (256 / 64) * (768 / 32), I2 = (128 / 64) * (1024 / 32), I3 = (DM / 64) * (DM / 32), I4 = (DM / 64) * (GUP / 32), I5 = (DFF / 64) * (DM / 32);
    constexpr int NIT = I0 + I1 + I2 + I3 + I4 + I5;
    for (int it = gw; it < NIT; it += NGW) {
        int r = it;
        if (r < I0) { conv_item<0>(a.w_in + (size_t)l * DM * INW, nullptr, a.attn_norm + l * DM, nullptr, DM, INW, (bf16*)(wbuf + WL_IN), scr, r, INP / 32, lane); continue; } r -= I0;
        if (r < I1) { conv_item<1>(a.w_q_up + (size_t)l * 256 * 768, nullptr, a.q_norm + l * 256, nullptr, 256, 768, (bf16*)(wbuf + WL_Q), scr, r, 768 / 32, lane); continue; } r -= I1;
        if (r < I2) { conv_item<2>(a.w_kv_up + (size_t)l * 128 * 1024, nullptr, a.kv_norm + l * 128, nullptr, 128, 1024, (bf16*)(wbuf + WL_KV), scr, r, 1024 / 32, lane); continue; } r -= I2;
        if (r < I3) { conv_item<3>(a.w_o + (size_t)l * DM * DM, nullptr, a.out_norm_swa + l * 512, a.out_norm_mla + l * 512, DM, DM, (bf16*)(wbuf + WL_O), scr, r, DM / 32, lane); continue; } r -= I3;
        if (r < I4) { conv_item<4>(a.w_gate + (size_t)l * DM * DFF, a.w_up + (size_t)l * DM * DFF, a.ffn_norm + l * DM, nullptr, DM, DFF, (bf16*)(wbuf + WL_GU), scr, r, GUP / 32, lane); continue; } r -= I4;
        conv_item<5>(a.w_down + (size_t)l * DFF * DM, nullptr, nullptr, nullptr, DFF, DM, (bf16*)(wbuf + WL_D), scr, r, DM / 32, lane);
    }
}

__device__ __forceinline__ void init_rows(const Args& a, unsigned char* ws) {
    const int lane = threadIdx.x & 63, wave = threadIdx.x >> 6; const int gw = blockIdx.x * NWAVES + wave, NGW = gridDim.x * NWAVES;
    for (int row = gw; row < MC + NMETA; row += NGW) {
        const bool meta = row >= MC; const int r = meta ? row - MC : row;
        const float* src = meta ? a.meta + (size_t)r * DM : a.x + (size_t)r * DM;
        float* H = (float*)(ws + (meta ? WS_PART + PM_H : WS_H)); bf16* HB = (bf16*)(ws + (meta ? WS_PART + PM_HB : WS_HB)); float* hss = (float*)(ws + WS_PART + (meta ? PM_HSSA : P_HSSA));
        pg8::f32x4 v[4]; float s = 0.f;
#pragma unroll
        for (int j = 0; j < 4; ++j) { v[j] = *((const pg8::f32x4*)src + lane + 64 * j); s += pg8::sq4(v[j]); }
        s = wave_sum(s);
#pragma unroll
        for (int j = 0; j < 4; ++j) { pg8::st_bf16x4(HB + (size_t)r * DM + 4 * (lane + 64 * j), v[j]); }
        if (lane < 16) hss[(size_t)r * 16 + lane] = (lane == 0) ? s : 0.f;
    }
}
__device__ __forceinline__ void final_rows(const Args& a, const bf16* HBf, const float* hss) {
    const int lane = threadIdx.x & 63, wave = threadIdx.x >> 6; const int gw = blockIdx.x * NWAVES + wave, NGW = gridDim.x * NWAVES;
    for (int o = gw; o < BATCH * SEQ; o += NGW) {
        const int row = o;
        const float rs = pg8::rsq(pg8::sum16(hss, row) * (1.0f / DM) + RMS_EPS);
#pragma unroll
        for (int j = 0; j < 4; ++j) { const pg8::u32x2 hw = *((const pg8::u32x2*)(HBf + (size_t)row * DM) + lane + 64 * j); pg8::f32x4 v; v[0] = __builtin_bit_cast(float, hw.x << 16); v[1] = __builtin_bit_cast(float, hw.x & 0xffff0000u); v[2] = __builtin_bit_cast(float, hw.y << 16); v[3] = __builtin_bit_cast(float, hw.y & 0xffff0000u);
            const pg8::f32x4 g = *((const pg8::f32x4*)a.final_norm + lane + 64 * j);
            *((pg8::f32x4*)(a.out + (size_t)o * DM) + lane + 64 * j) = v * rs * g; }
    }
}

constexpr int N_ATT_UNITS = 2 * 17 * 64;
__device__ __forceinline__ void attn_phase(const Args& a, int l, unsigned char* ws, LAS unsigned char* lds) {
    const int lq = l; l &= 3;
    unsigned char* R = ws + WS_R;
    const bf16 *QA = (const bf16*)(R + R_QA), *KA = (const bf16*)(R + R_KA), *VA = (const bf16*)(R + R_VA), *KR = (const bf16*)(R + R_KR), *QM = (const bf16*)(R + R_QM), *KN = (const bf16*)(R + R_KN), *VB = (const bf16*)(R + R_VB);
    bf16* O = (bf16*)(R + R_O); float* ssqO = (float*)(ws + WS_PART + P_SSQO);
    LAS int* qslot = (LAS int*)(lds + att::OFF_Q);
    const unsigned xcc = ((unsigned)__builtin_amdgcn_s_getreg((3 << 11) | 20) & 0xFu) & 7u;
    unsigned* ctr = (unsigned*)(ws + WS_CTL) + 64 * lq + 8 * 64 * (int)xcc;
    constexpr int PER_X = N_ATT_UNITS / 8;
    for (int pass = 0; pass < 8; ++pass) {
        const unsigned x = (xcc + (unsigned)pass) & 7u; unsigned* c = (unsigned*)(ws + WS_CTL) + 64 * lq + 8 * 64 * (int)x;
        for (;;) {
            if (threadIdx.x == 0) *qslot = (int)atomicAdd(c, 1u);
            __syncthreads();
            const int u = *qslot;
            __syncthreads();
            if (u >= PER_X) break;
            if (u < PER_X / 2) {
                const int bh = 8 * (u / 17) + (int)x, qb = 16 - u % 17, b = bh >> 3, hd = bh & 7;
                att::attn_unit<96, false>(lds, QM + hd * 96, 768, KN + hd * 64, 512, KR, VB + hd * 64, 512, O + 512 + hd * 64, ssqO + 8 + hd, 0.f, b, qb);
            } else {
                const int v = u - PER_X / 2; const int bh = 8 * (v / 17) + (int)x, qb = 16 - v % 17, b = bh >> 3, hq = bh & 7, kv = hq >> 2;
                att::attn_unit<64, true>(lds, QA + hq * 64, 512, KA + kv * 64, 128, nullptr, VA + kv * 64, 128, O + hq * 64, ssqO + hq, a.sinks[l * 8 + hq] * LOG2E, b, qb);
            }
        }
    }
    (void)ctr;
}

#define XB_TMO      128
#define XB_XCNT(j)  (256  + 64 * (j))
#define XB_XSUB(j)  (1280 + 64 * (j))
#define XB_XGEN(j)  (2304 + 64 * (j))
#define XB_TOP      3328
#define XB_TOPGEN   3392
#define XCD_BAR_WORDS 3456
#define XB_SPIN_CAP (1u << 18)

__device__ __forceinline__ unsigned xb_ld(unsigned* p)              { return __hip_atomic_load(p, __ATOMIC_RELAXED, __HIP_MEMORY_SCOPE_AGENT); }
__device__ __forceinline__ unsigned xb_add(unsigned* p, unsigned v) { return __hip_atomic_fetch_add(p, v, __ATOMIC_RELAXED, __HIP_MEMORY_SCOPE_AGENT); }
__device__ __forceinline__ unsigned xb_xcc_id() { return (unsigned)__builtin_amdgcn_s_getreg((3 << 11) | 20) & 0xFu; }
#define XB_SPIN(cond, bar) do { unsigned _sp = 0; while (cond) { __builtin_amdgcn_s_sleep(1); \
    if ((++_sp & 255u) == 0u) { if (xb_ld(&(bar)[XB_TMO])) break; if (_sp > XB_SPIN_CAP) { atomicAdd(&(bar)[XB_TMO], 1u); break; } } } } while (0)

struct XcdBarrier {
    unsigned* bar; unsigned x;
    volatile LAS unsigned* st;
};

__device__ __forceinline__ XcdBarrier xcd_barrier_post(unsigned* bar, volatile LAS unsigned* st) {
    XcdBarrier b; b.bar = bar; b.x = xb_xcc_id(); b.st = st;
    if (threadIdx.x == 0) (void)xb_add(&bar[XB_XCNT(b.x)], 1u);
    return b;
}
__device__ __forceinline__ void xcd_barrier_complete(unsigned* bar, unsigned x, unsigned& nloc, unsigned& nx) {
    const unsigned G = gridDim.x * gridDim.y * gridDim.z;
    unsigned sum, cnt, mine, sp = 0u;
    for (;;) {
        sum = 0u; cnt = 0u; mine = 0u;
#pragma unroll
        for (unsigned j = 0; j < 16; ++j) { const unsigned c = xb_ld(&bar[XB_XCNT(j)]); sum += c; cnt += (c > 0u) ? 1u : 0u; mine = (j == x) ? c : mine; }
        if (sum == G) break;
        __builtin_amdgcn_s_sleep(1);
        if ((++sp & 255u) == 0u) { if (xb_ld(&bar[XB_TMO])) break; if (sp > XB_SPIN_CAP) { atomicAdd(&bar[XB_TMO], 1u); break; } }
    }
    nloc = mine > 0u ? mine : 1u; nx = cnt > 0u ? cnt : 1u;
}

__device__ __forceinline__ void xcd_barrier(const XcdBarrier& b) {
    asm volatile("s_waitcnt vmcnt(0)" ::: "memory");
    __syncthreads();
    if (threadIdx.x == 0) {
        unsigned* bar = b.bar;
        __builtin_amdgcn_s_waitcnt(0);
        unsigned nloc = b.st[0], nx = b.st[1];
        if (nloc == 0u) { xcd_barrier_complete(bar, b.x, nloc, nx); b.st[0] = nloc; b.st[1] = nx; }
        const unsigned old = xb_add(&bar[XB_XSUB(b.x)], 1u);
        const unsigned gen = old / nloc;
        if (old + 1u == (gen + 1u) * nloc) {
            __builtin_amdgcn_fence(__ATOMIC_RELEASE, "agent");
            asm volatile("s_waitcnt vmcnt(0)" ::: "memory");
            const unsigned og = xb_add(&bar[XB_TOP], 1u);
            const unsigned tg = og / nx;
            if (og + 1u == (tg + 1u) * nx) xb_add(&bar[XB_TOPGEN], 1u);
            else XB_SPIN(xb_ld(&bar[XB_TOPGEN]) == tg, bar);
            __builtin_amdgcn_fence(__ATOMIC_ACQUIRE, "agent");
            xb_add(&bar[XB_XGEN(b.x)], 1u);
            asm volatile("s_waitcnt vmcnt(0)" ::: "memory");
        } else {
            XB_SPIN(xb_ld(&bar[XB_XGEN(b.x)]) == gen, bar);
            __builtin_amdgcn_fence(__ATOMIC_ACQUIRE, "agent");
            asm volatile("s_waitcnt vmcnt(0)" ::: "memory");
        }
    }
    __syncthreads();
}

constexpr int CW_BAR = 4096;
constexpr int XB_LDS_OFF = 131072 + 8192;
#ifndef PHM
#define PHM 255
#endif
#ifndef PROBE_DUP
#define PROBE_DUP 0
#endif
#ifndef PROBE_SYNC
#define PROBE_SYNC 0
#endif
__global__ void __launch_bounds__(NTHREADS, 2) fwd_megakernel(Args a) {
    extern __shared__ __attribute__((aligned(16))) unsigned char lds_raw[];
    LAS unsigned char* lds = (LAS unsigned char*)lds_raw;
    cg::grid_group grid = cg::this_grid();
    const int lo = a.ph_lo, hi = a.ph_hi;
    if (threadIdx.x < 2) ((LAS unsigned*)(lds + XB_LDS_OFF))[threadIdx.x] = 0u;
    __syncthreads();
    const XcdBarrier xbar = xcd_barrier_post((unsigned*)(a.ws + WS_CTL) + CW_BAR, (volatile LAS unsigned*)(lds + XB_LDS_OFF));
#define IN_PH(k) (lo <= (k) && (k) < hi)
#define SEAM(k) do { if (IN_PH(k) && IN_PH((k) + 1)) { if ((k) == 0) grid.sync(); else xcd_barrier(xbar); if (PROBE_SYNC) xcd_barrier(xbar); } } while (0)
#define WSL(w) unsigned char* w = a.ws; asm volatile("" : "+s"(w))
    if (IN_PH(0) && (PHM & 1)) { WSL(ws); init_rows(a, ws); conv_layer(a, 0, ws + WS_W, lds); __syncthreads(); }
    SEAM(0);
#pragma unroll 1
    for (int l = 0; l < DEPTH; ++l) {
        const int p = 1 + 6 * l;
        if (IN_PH(p) && (PHM & 2)) {
            { WSL(ws); unsigned char* R = ws + WS_R; unsigned char* wb = ws + WS_W + (size_t)(l & 1) * WBUF; unsigned char* pm_ = ws + WS_PART;
              pg8::EpiIn<true> E{(const float*)(pm_ + PM_HSSA), (bf16*)(R + R_QA), (bf16*)(R + R_KA), (bf16*)(R + R_VA), (bf16*)(pm_ + PM_QLAT), (bf16*)(pm_ + PM_KVLAT), (bf16*)(R + R_KR), (float*)(pm_ + PM_SSQQ), (float*)(pm_ + PM_SSQKV)};
              pg8::skinny_phase<DM>(lds, (const bf16*)(pm_ + PM_HB), (const bf16*)(wb + WL_IN), INP / 256, E, 128); }
            WSL(ws); unsigned char* R = ws + WS_R; unsigned char* wb = ws + WS_W + (size_t)(l & 1) * WBUF;
            pg8::Gemm g{(const bf16*)(ws + WS_HB), (const bf16*)(wb + WL_IN), MC, INP, DM, 0}; pg8::OrderCT<MC / 256, INP / 256> S; S.init((int)gridDim.x, (int)blockIdx.x);
            pg8::EpiIn<false> E{(const float*)(ws + WS_PART + P_HSSA), (bf16*)(R + R_QA), (bf16*)(R + R_KA), (bf16*)(R + R_VA), (bf16*)(R + R_QLAT), (bf16*)(R + R_KVLAT), (bf16*)(R + R_KR),
                         (float*)(ws + WS_PART + P_SSQQ), (float*)(ws + WS_PART + P_SSQKV)};
            pg8::gemm_phase<pg8::EpiIn<false>, pg8::OrderCT<MC / 256, INP / 256>, true, true>(lds, g, S, E);
            if (PROBE_DUP & 2) pg8::gemm_phase<pg8::EpiIn<false>, pg8::OrderCT<MC / 256, INP / 256>, true, true>(lds, g, S, E);
        }
        SEAM(p);
        if (IN_PH(p + 1) && (PHM & 4)) {
            { WSL(ws); unsigned char* R = ws + WS_R; unsigned char* wb = ws + WS_W + (size_t)(l & 1) * WBUF; unsigned char* pm_ = ws + WS_PART;
              pg8::EpiQup<true> E{(const float*)(pm_ + PM_SSQQ), (bf16*)(R + R_QM)}; pg8::skinny_phase<256>(lds, (const bf16*)(pm_ + PM_QLAT), (const bf16*)(wb + WL_Q), 3, E, 128); }
            { WSL(ws); unsigned char* R = ws + WS_R; unsigned char* wb = ws + WS_W + (size_t)(l & 1) * WBUF;
              pg8::Gemm g{(const bf16*)(R + R_QLAT), (const bf16*)(wb + WL_Q), MC, 768, 256, 0}; pg8::OrderCT<MC / 256, 3> S; S.init((int)gridDim.x, (int)blockIdx.x);
              pg8::EpiQup<false> E{(const float*)(ws + WS_PART + P_SSQQ), (bf16*)(R + R_QM)}; pg8::gemm_phase<pg8::EpiQup<false>, pg8::OrderCT<MC / 256, 3>, true, true>(lds, g, S, E); if (PROBE_DUP & 4) pg8::gemm_phase<pg8::EpiQup<false>, pg8::OrderCT<MC / 256, 3>, true, true>(lds, g, S, E); }
            { WSL(ws); unsigned char* R = ws + WS_R; unsigned char* wb = ws + WS_W + (size_t)(l & 1) * WBUF; unsigned char* pm_ = ws + WS_PART;
              pg8::EpiKvup<true> E{(const float*)(pm_ + PM_SSQKV), (bf16*)(R + R_KN), (bf16*)(R + R_VB)}; pg8::skinny_phase<128>(lds, (const bf16*)(pm_ + PM_KVLAT), (const bf16*)(wb + WL_KV), 4, E, 0); }
            { WSL(ws); unsigned char* R = ws + WS_R; unsigned char* wb = ws + WS_W + (size_t)(l & 1) * WBUF;
              pg8::Gemm g{(const bf16*)(R + R_KVLAT), (const bf16*)(wb + WL_KV), MC, 1024, 128, 0}; pg8::OrderCT<MC / 256, 4> S; S.init((int)gridDim.x, (int)blockIdx.x);
              pg8::EpiKvup<false> E{(const float*)(ws + WS_PART + P_SSQKV), (bf16*)(R + R_KN), (bf16*)(R + R_VB)}; pg8::gemm_phase<pg8::EpiKvup<false>, pg8::OrderCT<MC / 256, 4>, true, true>(lds, g, S, E); if (PROBE_DUP & 4) pg8::gemm_phase<pg8::EpiKvup<false>, pg8::OrderCT<MC / 256, 4>, true, true>(lds, g, S, E); }
        }
        SEAM(p + 1);
        if (IN_PH(p + 2) && (PHM & 8)) { WSL(ws); if (l + 1 < DEPTH) { conv_layer(a, l + 1, ws + WS_W + (size_t)((l + 1) & 1) * WBUF, lds); __syncthreads(); if (PROBE_DUP & 256) { conv_layer(a, l + 1, ws + WS_W + (size_t)((l + 1) & 1) * WBUF, lds); __syncthreads(); } } attn_phase(a, l, ws, lds); if (PROBE_DUP & 8) attn_phase(a, l + 4, ws, lds); }
        SEAM(p + 2);
        if (IN_PH(p + 3) && (PHM & 16)) {
            { WSL(ws); unsigned char* R = ws + WS_R; unsigned char* wb = ws + WS_W + (size_t)(l & 1) * WBUF; unsigned char* pm_ = ws + WS_PART;
              pg8::EpiOut<true> E; E.H = (float*)(pm_ + PM_H); E.HB = (bf16*)(pm_ + PM_HB); E.hss_out = (float*)(pm_ + PM_HSSB); E.ssq_o = (const float*)(pm_ + P_SSQO); E.xlds = lds;
              pg8::skinny_phase<DM>(lds, (const bf16*)(R + R_O) + (size_t)FRONT * 1024, (const bf16*)(wb + WL_O), 4, E, 0); }
            WSL(ws); unsigned char* R = ws + WS_R; unsigned char* wb = ws + WS_W + (size_t)(l & 1) * WBUF;
            pg8::Gemm g{(const bf16*)(R + R_O), (const bf16*)(wb + WL_O), MC, DM, DM, 1}; pg8::OrderCT<MC / 256, 4> S; S.init((int)gridDim.x, (int)blockIdx.x);
            pg8::EpiOut<false> E; E.H = (float*)(ws + WS_H); E.HB = (bf16*)(ws + WS_HB); E.hss_out = (float*)(ws + WS_PART + P_HSSB); E.ssq_o = (const float*)(ws + WS_PART + P_SSQO); E.xlds = lds + pg8::STAGE_BYTES;
            pg8::gemm_phase<pg8::EpiOut<false>, pg8::OrderCT<MC / 256, 4>, true, true>(lds, g, S, E);
        }
        SEAM(p + 3);
        if (IN_PH(p + 4) && (PHM & 32)) {
            { WSL(ws); unsigned char* wb = ws + WS_W + (size_t)(l & 1) * WBUF; unsigned char* pm_ = ws + WS_PART;
              pg8::EpiGU<true> E{(const float*)(pm_ + PM_HSSB), (bf16*)(pm_ + PM_ACT)}; pg8::skinny_phase<DM>(lds, (const bf16*)(pm_ + PM_HB), (const bf16*)(wb + WL_GU), GUP / 256, E, 0); }
            WSL(ws); unsigned char* R = ws + WS_R; unsigned char* wb = ws + WS_W + (size_t)(l & 1) * WBUF;
            pg8::Gemm g{(const bf16*)(ws + WS_HB), (const bf16*)(wb + WL_GU), MC, GUP, DM, 0}; pg8::OrderCT<MC / 256, GUP / 256> S; S.init((int)gridDim.x, (int)blockIdx.x);
            pg8::EpiGU<false> E{(const float*)(ws + WS_PART + P_HSSB), (bf16*)(R + R_ACT)};
            pg8::gemm_phase<pg8::EpiGU<false>, pg8::OrderCT<MC / 256, GUP / 256>, true, true>(lds, g, S, E);
        }
        SEAM(p + 4);
        if (IN_PH(p + 5) && (PHM & 64)) {
            { WSL(ws); unsigned char* wb = ws + WS_W + (size_t)(l & 1) * WBUF; unsigned char* pm_ = ws + WS_PART;
              pg8::EpiDown<true> E; E.H = (float*)(pm_ + PM_H); E.HB = (bf16*)(pm_ + PM_HB); E.hss_out = (float*)(pm_ + PM_HSSA); E.ssq_o = nullptr;
              pg8::skinny_phase<DFF>(lds, (const bf16*)(pm_ + PM_ACT), (const bf16*)(wb + WL_D), 4, E, 0); }
            WSL(ws); unsigned char* R = ws + WS_R; unsigned char* wb = ws + WS_W + (size_t)(l & 1) * WBUF;
            pg8::Gemm g{(const bf16*)(R + R_ACT), (const bf16*)(wb + WL_D), MC, DM, DFF, 0}; pg8::OrderCT<MC / 256, 4> S; S.init((int)gridDim.x, (int)blockIdx.x);
            pg8::EpiDown<false> E; E.H = (float*)(ws + WS_H); E.HB = (bf16*)(ws + WS_HB); E.hss_out = (float*)(ws + WS_PART + P_HSSA); E.ssq_o = nullptr;
            pg8::gemm_phase<pg8::EpiDown<false>, pg8::OrderCT<MC / 256, 4>, true, true>(lds, g, S, E);
        }
        SEAM(p + 5);
    }
    if (IN_PH(1 + 6 * DEPTH) && (PHM & 128)) { WSL(ws); final_rows(a, (const bf16*)(ws + WS_HB), (const float*)(ws + WS_PART + P_HSSA)); }
#undef IN_PH
#undef SEAM
#undef WSL
}
constexpr int N_PHASES = 2 + 6 * DEPTH;

#ifndef MK_SPLIT
#define MK_SPLIT 0
#endif
extern "C" void kernel_launch(void* const* d_in, const int* in_sizes, int n_in, void* d_out, int out_size, void* d_ws, size_t ws_size, hipStream_t stream) {
    static int grid = 0;
    if (grid == 0) {
        if (n_in != 17 || ws_size < WS_END) { fprintf(stderr, "kernel_launch: need 17 inputs and >= %zu bytes of workspace; got n_in %d, ws %zu\n", (size_t)WS_END, n_in, ws_size); grid = -1; return; }
        int dev = 0, cus = 0, per_cu = 0;
        hipGetDevice(&dev); hipDeviceGetAttribute(&cus, hipDeviceAttributeMultiprocessorCount, dev);
        if (hipFuncSetAttribute((const void*)fwd_megakernel, hipFuncAttributeMaxDynamicSharedMemorySize, LDS_BYTES) != hipSuccess) { fprintf(stderr, "kernel_launch: hipFuncSetAttribute failed\n"); grid = -1; return; }
        if (hipOccupancyMaxActiveBlocksPerMultiprocessor(&per_cu, (const void*)fwd_megakernel, NTHREADS, LDS_BYTES) != hipSuccess || per_cu < 1) { fprintf(stderr, "kernel_launch: occupancy query says %d\n", per_cu); per_cu = 1; }
        (void)hipGetLastError();
        grid = cus * 1;
    }
    if (grid < 0) return;
    hipMemsetAsync((char*)d_ws + WS_CTL, 0, CTL_BYTES, stream);
    Args a{};
    const float** f = (const float**)&a;
    for (int i = 0; i < 17; ++i) f[i] = (const float*)d_in[i];
    a.out = (float*)d_out; a.ws = (unsigned char*)d_ws;
#if MK_SPLIT
    for (int ph = 0; ph < N_PHASES; ++ph) { a.ph_lo = ph; a.ph_hi = ph + 1; hipLaunchKernelGGL(fwd_megakernel, dim3(grid), dim3(NTHREADS), LDS_BYTES, stream, a); }
#else
    a.ph_lo = 0; a.ph_hi = N_PHASES;
    void* args[] = {&a};
    hipError_t e = hipLaunchCooperativeKernel((const void*)fwd_megakernel, dim3(grid), dim3(NTHREADS), args, LDS_BYTES, stream);
    if (e != hipSuccess) fprintf(stderr, "cooperative launch failed: %s (grid %d)\n", hipGetErrorString(e), grid);
#endif
}
```

```cpp
#include <hip/hip_runtime.h>
#include <hip/hip_cooperative_groups.h>
#include <cstdio>
#include <cstdint>
namespace cg = cooperative_groups;

constexpr int BATCH = 8, SEQ = 4096, DM = 1024, DEPTH = 4, NMETA = 16, FRONT = 112, TT = 4224;
constexpr int MROWS = BATCH * TT;
constexpr int INW = 1184, INP = 1280, DFF = 2816, GUP = 2 * DFF;
constexpr float RMS_EPS = 1e-6f;
constexpr float LOG2E = 1.4426950408889634f;
constexpr float LOG2_THETA = 13.287712379549449f;
constexpr float INV_2PI = 0.15915494309189535f;

namespace pg8 {
#define PG8_LAS __attribute__((address_space(3)))
typedef unsigned short bf16_t;
typedef short bf16x8 __attribute__((ext_vector_type(8)));
typedef float f32x4 __attribute__((ext_vector_type(4)));
typedef unsigned u32x4 __attribute__((ext_vector_type(4)));
constexpr int BM = 256, BK = 64, HALF = 128, HTB = HALF * BK * 2  , STAGE_BYTES = 8 * HTB, NXCD = 8, WGM = 8;

__host__ __device__ __forceinline__ int lds_byte(int r, int c) { const int st = (r >> 4) * 2 + (c >> 5), rr = r & 15, cc = c & 31, ob = rr * 64 + cc * 2; return st * 1024 + (ob ^ (((ob >> 9) & 1) << 5)); }
__host__ __device__ __forceinline__ void stage_rc(int b, int& R, int& C) { const int st = b / 1024, sb = b % 1024, swz = sb ^ (((sb >> 9) & 1) << 5); R = (st >> 1) * 16 + swz / 64; C = (st & 1) * 32 + (swz % 64) / 2; }
__host__ __device__ __forceinline__ int perm32(int rho) { const int n = rho >> 4, i = rho & 15; return 8 * (i >> 2) + 4 * n + (i & 3); }

struct Unit { int pm, pn; };
struct Gemm { const bf16_t* A; const bf16_t* Bt; int M, N, K; int apad; };

struct StaticOrder {
    int nM, nN, nwg, G, c;
    __host__ __device__ void init(int M, int N, int G_, int c_) { nM = M / BM; nN = N / BM; nwg = nM * nN; G = G_; c = c_; }
    __host__ __device__ bool next(int i, Unit& u) const {
        const long L = (long)i * G + c; if (L >= nwg) return false;
        int wgid = (int)L; { const int q = nwg / NXCD, r = nwg % NXCD, xcd = wgid % NXCD, off = wgid / NXCD; wgid = (xcd < r ? xcd * (q + 1) : r * (q + 1) + (xcd - r) * q) + off; }
        const int nig = WGM * nN, gid = wgid / nig, fm = gid * WGM, gsz = (nM - fm) < WGM ? (nM - fm) : WGM;
        u.pm = fm + ((wgid % nig) % gsz); u.pn = (wgid % nig) / gsz; return true;
    }
    __device__ __forceinline__ void a_ready(const Unit&) const {}
    __device__ __forceinline__ void done(const Unit&) const {}
};

__device__ __forceinline__ unsigned cvt_pk_bf16(float lo, float hi) { unsigned r; asm volatile("v_cvt_pk_bf16_f32 %0, %1, %2" : "=v"(r) : "v"(lo), "v"(hi)); return r; }

template <int NM, int NN> struct OrderCT {
    static_assert(NM % 8 == 0 || NM % 8 == 4, "last M group must be 8 or 4 tiles");
    int G, c;
    __device__ __forceinline__ void init(int G_, int c_) { G = G_; c = c_; }
    __device__ __forceinline__ bool next(int i, Unit& u) const {
        constexpr int nwg = NM * NN, q = nwg / NXCD, r = nwg % NXCD, nig = WGM * NN;
        const int L = i * G + c; if (L >= nwg) return false;
        const int xcd = L & (NXCD - 1), off = L >> 3;
        const int wgid = (xcd < r ? xcd * (q + 1) : r * (q + 1) + (xcd - r) * q) + off;
        const int gid = wgid / nig, rem = wgid - gid * nig, fm = gid * WGM;
        const int sh = (NM - fm) < WGM ? 2 : 3;
        u.pm = fm + (rem & ((1 << sh) - 1)); u.pn = rem >> sh; return true;
    }
    __device__ __forceinline__ void a_ready(const Unit&) const {}
    __device__ __forceinline__ void done(const Unit&) const {}
};
typedef unsigned u32x2 __attribute__((ext_vector_type(2)));
#define PG8_GAS __attribute__((address_space(1)))
__device__ __forceinline__ void st_bf16x4(bf16_t* p, f32x4 v) { u32x2 w; w.x = cvt_pk_bf16(v[0], v[1]); w.y = cvt_pk_bf16(v[2], v[3]); *(PG8_GAS u32x2*)p = w; }
__device__ __forceinline__ float sum16(const float* part, int row) {
    const PG8_GAS f32x4* p = (const PG8_GAS f32x4*)(part + (size_t)row * 16); const f32x4 a = p[0], b = p[1], c = p[2], d = p[3];
    return (((a.x + a.y) + (a.z + a.w)) + ((b.x + b.y) + (b.z + b.w))) + (((c.x + c.y) + (c.z + c.w)) + ((d.x + d.y) + (d.z + d.w)));
}
__device__ __forceinline__ float sum4(const float* part, int row) { const f32x4 a = *(const PG8_GAS f32x4*)(part + (size_t)row * 4); return (a.x + a.y) + (a.z + a.w); }
__device__ __forceinline__ float rsq(float x) { return 1.0f / sqrtf(x); }
__device__ __forceinline__ float sq4(f32x4 v) { return (v[0] * v[0] + v[1] * v[1]) + (v[2] * v[2] + v[3] * v[3]); }
#define EPI_ROWS(ai, m) for (int ai = 0; ai < 2; ++ai) for (int m = 0; m < 4; ++m)
#define EPI_ROW(u, ai, m) ((u).pm * BM + (ai) * HALF + wr * 64 + (m) * 16 + fr)

__device__ __forceinline__ int prow_of(int m) { return m + (m >> 12) * 128 + 128; }
#define EPI_NB (META ? BATCH : 1)
#define EPI_PROW(row, b) (META ? (size_t)((b) * TT + FRONT + (row)) : (size_t)prow_of(row))
#define EPI_MAIN_LOOP(CALL) _Pragma("unroll") for (int ai = 0; ai < 2; ++ai) _Pragma("unroll") for (int m = 0; m < 4; ++m) { asm volatile("" ::: "memory"); const int row = EPI_ROW(u, ai, m); \
        const f32x4 a_[2][2] = {{acc[ai][0][m][0], acc[ai][0][m][1]}, {acc[ai][1][m][0], acc[ai][1][m][1]}}; CALL; }

template <bool META> struct EpiIn {
    static constexpr bool PERM = false, AFTER_DRAIN = false, MIDSCALE = false;
    const float* hss; bf16_t *qa, *ka, *va, *qlat, *kvlat, *kr; float *ssq_q, *ssq_kv;
    __device__ __forceinline__ void mid(f32x4 (&)[2][2][4][2], const Unit&, int, int, int, int) const {}
    __device__ __forceinline__ void row_epi(const f32x4 (&a)[2][2], int row, int pn, int wc, int fr, int fq) const {
        const float rs = rsq(sum16(hss, row) * (1.0f / DM) + RMS_EPS);
        if (pn <= 2) {
            const bool is_kr = (pn == 2 && wc == 2);
            if (pn == 2 && wc == 3) return;
            const float pos = META ? (float)row : (float)((row & 4095) + NMETA);
#pragma unroll
            for (int n = 0; n < 2; ++n) {
                if (is_kr && n == 1) continue;
                const f32x4 x1 = a[0][n] * rs, x2 = a[1][n] * rs; f32x4 o1, o2;
#pragma unroll
                for (int e = 0; e < 4; ++e) { const float inv = is_kr ? __builtin_amdgcn_exp2f(-(float)(4 * fq + e) * (LOG2_THETA / 16.0f)) : __builtin_amdgcn_exp2f(-(float)(16 * n + 4 * fq + e) * (LOG2_THETA / 32.0f));
                    const float ang = pos * inv; float rev = ang * INV_2PI; rev = rev - floorf(rev);
                    const float sn = __builtin_amdgcn_sinf(rev), cs = __builtin_amdgcn_cosf(rev); o1[e] = x1[e] * cs - x2[e] * sn; o2[e] = x2[e] * cs + x1[e] * sn; }
#pragma unroll
                for (int b = 0; b < EPI_NB; ++b) { const size_t pr = EPI_PROW(row, b); bf16_t* d; int half;
                    if (pn < 2) { d = qa + pr * 512 + (4 * pn + wc) * 64 + 16 * n + 4 * fq; half = 32; }
                    else if (!is_kr) { d = ka + pr * 128 + wc * 64 + 16 * n + 4 * fq; half = 32; }
                    else { d = kr + pr * 32 + 4 * fq; half = 16; }
                    st_bf16x4(d, o1); st_bf16x4(d + half, o2); }
            }
        } else if (pn == 3) {
            float ss = 0.f;
#pragma unroll
            for (int n = 0; n < 2; ++n) { const int c = 32 * wc + 16 * n + 4 * fq; const f32x4 v = a[0][n] * rs, w = a[1][n] * rs;
#pragma unroll
                for (int b = 0; b < EPI_NB; ++b) st_bf16x4(va + EPI_PROW(row, b) * 128 + c, v);
                st_bf16x4(kvlat + (size_t)row * 128 + c, w); ss += sq4(w); }
            ss += __shfl_xor(ss, 16); ss += __shfl_xor(ss, 32);
            if (fq == 0) ((PG8_GAS float*)ssq_kv)[(size_t)row * 4 + wc] = ss;
        } else {
            float ss = 0.f;
#pragma unroll
            for (int bj = 0; bj < 2; ++bj)
#pragma unroll
                for (int n = 0; n < 2; ++n) { const int c = 128 * bj + 32 * wc + 16 * n + 4 * fq; const f32x4 v = a[bj][n] * rs; st_bf16x4(qlat + (size_t)row * 256 + c, v); ss += sq4(v); }
            ss += __shfl_xor(ss, 16); ss += __shfl_xor(ss, 32);
            if (fq == 0) ((PG8_GAS float*)ssq_q)[(size_t)row * 4 + wc] = ss;
        }
    }
    __device__ __forceinline__ void operator()(const f32x4 (&acc)[2][2][4][2], const Unit& u, int wr, int wc, int fr, int fq) const { EPI_MAIN_LOOP(row_epi(a_, row, u.pn, wc, fr, fq)) }
};

template <bool META> struct EpiQup {
    static constexpr bool PERM = false, AFTER_DRAIN = false, MIDSCALE = false;
    const float* ssq_q; bf16_t* qm;
    __device__ __forceinline__ void mid(f32x4 (&)[2][2][4][2], const Unit&, int, int, int, int) const {}
    __device__ __forceinline__ void row_epi(const f32x4 (&a)[2][2], int row, int pn, int wc, int fr, int fq) const {
        const float rs = rsq(sum4(ssq_q, row) * (1.0f / 256.0f) + RMS_EPS);
        if (pn < 2) {
#pragma unroll
            for (int bj = 0; bj < 2; ++bj)
#pragma unroll
                for (int n = 0; n < 2; ++n) { const int head = 4 * pn + 2 * bj + (wc >> 1), d = 32 * (wc & 1) + 16 * n + 4 * fq; const f32x4 v = a[bj][n] * rs;
#pragma unroll
                    for (int b = 0; b < EPI_NB; ++b) st_bf16x4(qm + EPI_PROW(row, b) * 768 + head * 96 + d, v); }
        } else {
            const float pos = META ? (float)row : (float)((row & 4095) + NMETA);
#pragma unroll
            for (int n = 0; n < 2; ++n) { const int head = 2 * wc + n; const f32x4 x1 = a[0][n] * rs, x2 = a[1][n] * rs; f32x4 o1, o2;
#pragma unroll
                for (int e = 0; e < 4; ++e) { const float inv = __builtin_amdgcn_exp2f(-(float)(4 * fq + e) * (LOG2_THETA / 16.0f)); const float ang = pos * inv; float rev = ang * INV_2PI; rev = rev - floorf(rev);
                    const float sn = __builtin_amdgcn_sinf(rev), cs = __builtin_amdgcn_cosf(rev); o1[e] = x1[e] * cs - x2[e] * sn; o2[e] = x2[e] * cs + x1[e] * sn; }
#pragma unroll
                for (int b = 0; b < EPI_NB; ++b) { bf16_t* qrow = qm + EPI_PROW(row, b) * 768; st_bf16x4(qrow + head * 96 + 64 + 4 * fq, o1); st_bf16x4(qrow + head * 96 + 80 + 4 * fq, o2); } }
        }
    }
    __device__ __forceinline__ void operator()(const f32x4 (&acc)[2][2][4][2], const Unit& u, int wr, int wc, int fr, int fq) const { EPI_MAIN_LOOP(row_epi(a_, row, u.pn, wc, fr, fq)) }
};

template <bool META> struct EpiKvup {
    static constexpr bool PERM = false, AFTER_DRAIN = false, MIDSCALE = false;
    const float* ssq_kv; bf16_t *kn, *vb;
    __device__ __forceinline__ void mid(f32x4 (&)[2][2][4][2], const Unit&, int, int, int, int) const {}
    __device__ __forceinline__ void row_epi(const f32x4 (&a)[2][2], int row, int pn, int wc, int fr, int fq) const {
        bf16_t* dst = (pn < 2 ? kn : vb) + (pn & 1) * 256;
        const float rs = rsq(sum4(ssq_kv, row) * (1.0f / 128.0f) + RMS_EPS);
#pragma unroll
        for (int bj = 0; bj < 2; ++bj)
#pragma unroll
            for (int n = 0; n < 2; ++n) { const f32x4 v = a[bj][n] * rs;
#pragma unroll
                for (int b = 0; b < EPI_NB; ++b) st_bf16x4(dst + EPI_PROW(row, b) * 512 + 128 * bj + 32 * wc + 16 * n + 4 * fq, v); }
    }
    __device__ __forceinline__ void operator()(const f32x4 (&acc)[2][2][4][2], const Unit& u, int wr, int wc, int fr, int fq) const { EPI_MAIN_LOOP(row_epi(a_, row, u.pn, wc, fr, fq)) }
};

struct EpiResid {
    static constexpr bool PERM = false, AFTER_DRAIN = false;
    float* H; bf16_t* HB; float* hss_out; const float* ssq_o;
    __device__ __forceinline__ void resid_row(const f32x4 (&a)[2][2], int row, float rs, int pn, int wc, int fr, int fq) const {
        float ss = 0.f;
#pragma unroll
        for (int bj = 0; bj < 2; ++bj)
#pragma unroll
            for (int n = 0; n < 2; ++n) { const size_t off = (size_t)row * DM + pn * BM + 128 * bj + 32 * wc + 16 * n + 4 * fq;
                const u32x2 hw = *(const PG8_GAS u32x2*)(HB + off); f32x4 hv; hv[0] = __builtin_bit_cast(float, hw.x << 16); hv[1] = __builtin_bit_cast(float, hw.x & 0xffff0000u); hv[2] = __builtin_bit_cast(float, hw.y << 16); hv[3] = __builtin_bit_cast(float, hw.y & 0xffff0000u);
                hv = hv + a[bj][n] * rs; st_bf16x4(HB + off, hv); ss += sq4(hv); }
        ss += __shfl_xor(ss, 16); ss += __shfl_xor(ss, 32);
        if (fq == 0) ((PG8_GAS float*)hss_out)[(size_t)row * 16 + 4 * pn + wc] = ss;
    }
    __device__ __forceinline__ void two_scales(size_t prow, float& f, float& rb) const {
        const PG8_GAS f32x4* p = (const PG8_GAS f32x4*)(ssq_o + prow * 16); const f32x4 a = p[0], b = p[1], c = p[2], d = p[3];
        const float sa = ((a.x + a.y) + (a.z + a.w)) + ((b.x + b.y) + (b.z + b.w)), sb = ((c.x + c.y) + (c.z + c.w)) + ((d.x + d.y) + (d.z + d.w));
        const float va = sa * (1.0f / 512.0f) + RMS_EPS, vb = sb * (1.0f / 512.0f) + RMS_EPS; f = sqrtf(vb / va); rb = rsq(vb);
    }
};
template <bool META> struct EpiOut : EpiResid {
    static constexpr bool MIDSCALE = true;
    PG8_LAS unsigned char* xlds;
    __device__ __forceinline__ void prep(const Unit& u, int wid, int wr, int lane) const {
        PG8_LAS float* tab = (PG8_LAS float*)(xlds + wid * 1024);
#pragma unroll
        for (int j = 0; j < 2; ++j) { const int idx = lane + 64 * j; const int row = u.pm * BM + (idx >> 6) * HALF + wr * 64 + (idx & 63);
            float f, rb; two_scales((size_t)prow_of(row), f, rb); tab[2 * idx] = f; tab[2 * idx + 1] = rb; }
    }
    __device__ __forceinline__ void mid(f32x4 (&acc)[2][2][4][2], const Unit& u, int wr, int wc, int fr, int fq) const {
        const int wid = wr * 4 + wc; const PG8_LAS float* tab = (const PG8_LAS float*)(xlds + wid * 1024);
#pragma unroll
        for (int ai = 0; ai < 2; ++ai)
#pragma unroll
            for (int m = 0; m < 4; ++m) {
                const float f = tab[2 * (ai * 64 + m * 16 + fr)];
#pragma unroll
                for (int bj = 0; bj < 2; ++bj)
#pragma unroll
                    for (int n = 0; n < 2; ++n) acc[ai][bj][m][n] *= f;
            }
    }
    __device__ __forceinline__ void operator()(const f32x4 (&acc)[2][2][4][2], const Unit& u, int wr, int wc, int fr, int fq) const {
        const PG8_LAS float* tab = (const PG8_LAS float*)(xlds + (wr * 4 + wc) * 1024);
        EPI_MAIN_LOOP(resid_row(a_, row, tab[2 * (ai * 64 + m * 16 + fr) + 1], u.pn, wc, fr, fq))
    }
    __device__ __forceinline__ void mid_row(f32x4 (&a)[2][2], int row) const { float f, rb; two_scales((size_t)(FRONT + row), f, rb);
#pragma unroll
        for (int bj = 0; bj < 2; ++bj)
#pragma unroll
            for (int n = 0; n < 2; ++n) a[bj][n] *= f; }
    __device__ __forceinline__ void row_epi(const f32x4 (&a)[2][2], int row, int pn, int wc, int fr, int fq) const { float f, rb; two_scales((size_t)(FRONT + row), f, rb); resid_row(a, row, rb, pn, wc, fr, fq); }
};
template <bool META> struct EpiDown : EpiResid {
    static constexpr bool MIDSCALE = false;
    __device__ __forceinline__ void mid(f32x4 (&)[2][2][4][2], const Unit&, int, int, int, int) const {}
    __device__ __forceinline__ void row_epi(const f32x4 (&a)[2][2], int row, int pn, int wc, int fr, int fq) const { resid_row(a, row, 1.0f, pn, wc, fr, fq); }
    __device__ __forceinline__ void operator()(const f32x4 (&acc)[2][2][4][2], const Unit& u, int wr, int wc, int fr, int fq) const { EPI_MAIN_LOOP(resid_row(a_, row, 1.0f, u.pn, wc, fr, fq)) }
};

template <bool META> struct EpiGU {
    static constexpr bool PERM = false, AFTER_DRAIN = false, MIDSCALE = false;
    const float* hss; bf16_t* act;
    __device__ __forceinline__ void mid(f32x4 (&)[2][2][4][2], const Unit&, int, int, int, int) const {}
    __device__ __forceinline__ void row_epi(const f32x4 (&a)[2][2], int row, int pn, int wc, int fr, int fq) const {
        const float rs = rsq(sum16(hss, row) * (1.0f / DM) + RMS_EPS);
#pragma unroll
        for (int n = 0; n < 2; ++n) { const f32x4 g = a[0][n] * rs, up = a[1][n] * rs; f32x4 o;
#pragma unroll
            for (int e = 0; e < 4; ++e) o[e] = g[e] * up[e] * __builtin_amdgcn_rcpf(1.0f + __builtin_amdgcn_exp2f(-g[e] * LOG2E));
            st_bf16x4(act + (size_t)row * DFF + 128 * pn + 32 * wc + 16 * n + 4 * fq, o); }
    }
    __device__ __forceinline__ void operator()(const f32x4 (&acc)[2][2][4][2], const Unit& u, int wr, int wc, int fr, int fq) const { EPI_MAIN_LOOP(row_epi(a_, row, u.pn, wc, fr, fq)) }
};

template <int K, class Epi>
__device__ __forceinline__ void skinny_phase(PG8_LAS unsigned char* lds, const bf16_t* A16, const bf16_t* Bt, int NN, const Epi& E, int wg0) {
    int tid_ = threadIdx.x; asm volatile("" : "+v"(tid_));
    const int tid = tid_, lane = tid & 63, wid = __builtin_amdgcn_readfirstlane(tid >> 6), fr = lane & 15, fq = lane >> 4;
    constexpr int nk = K / 32, NJ = (nk + 7) / 8;
    const int G = (int)gridDim.x; int first = (int)blockIdx.x - wg0; if (first < 0) first += G;
    for (int task = first; task < 4 * NN; task += G) {
        const int pn = task >> 2, wc = task & 3;
        f32x4 a[2][2];
#pragma unroll
        for (int bj = 0; bj < 2; ++bj)
#pragma unroll
            for (int n = 0; n < 2; ++n) a[bj][n] = (f32x4){0.f, 0.f, 0.f, 0.f};
        bool scaled = false;
        const bf16_t* ap = A16 + (size_t)fr * K + 8 * fq;
        const bf16_t* bp = Bt + (size_t)(256 * pn + 32 * wc + fr) * K + 8 * fq;
#pragma unroll 4
        for (int j = 0; j < NJ; ++j) {
            const int it = wid + 8 * j; if (it >= nk) break;
            const int k0 = 32 * it;
            if constexpr (Epi::MIDSCALE) { if (!scaled && k0 >= (K >> 1)) { E.mid_row(a, fr); scaled = true; } }
            const bf16x8 av = *(const PG8_GAS bf16x8*)(ap + k0);
#pragma unroll
            for (int bj = 0; bj < 2; ++bj)
#pragma unroll
                for (int n = 0; n < 2; ++n) { const bf16x8 bv = *(const PG8_GAS bf16x8*)(bp + (size_t)(128 * bj + 16 * n) * K + k0);
                    a[bj][n] = __builtin_amdgcn_mfma_f32_16x16x32_bf16(bv, av, a[bj][n], 0, 0, 0); }
        }
        if constexpr (Epi::MIDSCALE) { if (!scaled) E.mid_row(a, fr); }
        PG8_LAS f32x4* red = (PG8_LAS f32x4*)lds;
#pragma unroll
        for (int bj = 0; bj < 2; ++bj)
#pragma unroll
            for (int n = 0; n < 2; ++n) red[(wid * 64 + lane) * 4 + bj * 2 + n] = a[bj][n];
        __syncthreads();
        if (wid == 0) {
#pragma unroll
            for (int w = 1; w < 8; ++w)
#pragma unroll
                for (int bj = 0; bj < 2; ++bj)
#pragma unroll
                    for (int n = 0; n < 2; ++n) a[bj][n] += red[(w * 64 + lane) * 4 + bj * 2 + n];
            E.row_epi(a, fr, pn, wc, fr, fq);
        }
        __syncthreads();
    }
}
template <class Epi, class Sched, bool ALIGN_EPI = false, bool SP2 = false>
__device__ __forceinline__ void gemm_phase(PG8_LAS unsigned char* lds, const Gemm g, const Sched& S, const Epi& E) {
    int tid_ = threadIdx.x; asm volatile("" : "+v"(tid_));
    const int tid = tid_, wid = __builtin_amdgcn_readfirstlane(tid >> 6), lane = tid & 63, wr = wid >> 2, wc = wid & 3, fr = lane & 15, fq = lane >> 4;
    int K_ = g.K; asm volatile("" : "+s"(K_)); const int K = K_, nt = K / BK;
    unsigned voffA[2], voffB[2];
#pragma unroll
    for (int i = 0; i < 2; ++i) { int R, C; stage_rc(tid * 16 + i * 8192, R, C); const int Rb = Epi::PERM ? ((R & ~31) + perm32(R & 31)) : R;
        voffA[i] = (unsigned)(R * K + C) * 2u; voffB[i] = (unsigned)(Rb * K + C) * 2u; }
    const size_t kstep = (size_t)(BK * 2);
    const size_t hstep = (size_t)HALF * K * 2;
    const size_t tstep = 2 * hstep;
    const unsigned ldsw = (unsigned)wid * 1024u;
    const int aoff = lds_byte(wr * 64 + fr, fq * 8), boff = lds_byte(wc * 32 + fr, fq * 8);
#define PG8_SA(b, h) (((b) * 2 + (h)) * HTB)
#define PG8_SB(b, h) ((4 + (b) * 2 + (h)) * HTB)
#define PG8_STAGE(bufoff, gbase, voff) do { _Pragma("unroll") for (int _i = 0; _i < 2; ++_i) \
        __builtin_amdgcn_global_load_lds((const unsigned*)((const char*)(gbase) + (voff)[_i]), (PG8_LAS unsigned*)(lds + (bufoff) + ldsw + _i * 8192), 16, 0, 0); } while (0)
#define PG8_LDA(dst, b, h) do { _Pragma("unroll") for (int m = 0; m < 4; ++m) _Pragma("unroll") for (int k = 0; k < 2; ++k) dst[m][k] = *(const PG8_LAS bf16x8*)(lds + PG8_SA(b, h) + aoff + m * 2048 + k * 1024); } while (0)
#define PG8_LDB(dst, b, h) do { _Pragma("unroll") for (int n = 0; n < 2; ++n) _Pragma("unroll") for (int k = 0; k < 2; ++k) dst[n][k] = *(const PG8_LAS bf16x8*)(lds + PG8_SB(b, h) + boff + n * 2048 + k * 1024); } while (0)
#define PG8_MMA(ai, bj, At, Bt) do { __builtin_amdgcn_s_setprio(1); _Pragma("unroll") for (int m = 0; m < 4; ++m) _Pragma("unroll") for (int n = 0; n < 2; ++n) _Pragma("unroll") for (int k = 0; k < 2; ++k) \
        acc[ai][bj][m][n] = __builtin_amdgcn_mfma_f32_16x16x32_bf16(Bt[n][k], At[m][k], acc[ai][bj][m][n], 0, 0, 0); __builtin_amdgcn_s_setprio(0); } while (0)
#define PG8_WAIT_V(n) asm volatile("s_waitcnt vmcnt(" #n ")" ::: "memory")
#define PG8_WAIT_L(n) asm volatile("s_waitcnt lgkmcnt(" #n ")" ::: "memory")
#define PG8_BAR __builtin_amdgcn_s_barrier()
#define PG8_SCHED __builtin_amdgcn_sched_barrier(0)
    Unit cur, nxt; int ui = 0;
    if (!S.next(0, cur)) return;
    f32x4 acc[2][2][4][2];
#pragma unroll
    for (int a = 0; a < 2; ++a)
#pragma unroll
        for (int b = 0; b < 2; ++b)
#pragma unroll
            for (int m = 0; m < 4; ++m)
#pragma unroll
                for (int n = 0; n < 2; ++n) acc[a][b][m][n] = (f32x4){0.f, 0.f, 0.f, 0.f};
    bf16x8 At[4][2], B0[2][2], B1[2][2];
    const char* cA = (const char*)g.A + (size_t)cur.pm * tstep + (g.apad ? (size_t)((cur.pm >> 4) * 128 + 128) * (size_t)K * 2 : (size_t)0); const char* cB = (const char*)g.Bt + (size_t)cur.pn * tstep;
    S.a_ready(cur);
    if constexpr (SP2) {
        PG8_STAGE(PG8_SB(0, 0), cB, voffB); PG8_STAGE(PG8_SB(0, 1), cB + hstep, voffB); PG8_STAGE(PG8_SA(0, 0), cA, voffA); PG8_STAGE(PG8_SA(0, 1), cA + hstep, voffA);
        if (wr == 1) PG8_BAR;
        PG8_WAIT_V(2); PG8_BAR;
        PG8_STAGE(PG8_SB(1, 0), cB + kstep, voffB); PG8_STAGE(PG8_SA(1, 0), cA + kstep, voffA); PG8_STAGE(PG8_SB(1, 1), cB + hstep + kstep, voffB);
        PG8_WAIT_V(6); PG8_BAR;
    } else {
        PG8_STAGE(PG8_SB(0, 0), cB, voffB); PG8_STAGE(PG8_SA(0, 0), cA, voffA); PG8_STAGE(PG8_SB(0, 1), cB + hstep, voffB); PG8_STAGE(PG8_SA(0, 1), cA + hstep, voffA);
        if (wr == 1) PG8_BAR;
        PG8_WAIT_V(4); PG8_BAR;
        PG8_STAGE(PG8_SB(1, 0), cB + kstep, voffB); PG8_STAGE(PG8_SA(1, 0), cA + kstep, voffA); PG8_STAGE(PG8_SB(1, 1), cB + hstep + kstep, voffB);
        PG8_WAIT_V(6); PG8_BAR;
    }
    for (;;) {
        const bool has_next = S.next(ui + 1, nxt);
        if constexpr (Epi::MIDSCALE) E.prep(cur, wid, wr, lane);
        const char* nA = has_next ? (const char*)g.A + (size_t)nxt.pm * tstep + (g.apad ? (size_t)((nxt.pm >> 4) * 128 + 128) * (size_t)K * 2 : (size_t)0) : cA; const char* nB = has_next ? (const char*)g.Bt + (size_t)nxt.pn * tstep : cB;
        for (int t = 0; t < nt; t += 2) {
            const bool last = (t == nt - 2);
            if constexpr (Epi::MIDSCALE) { if (t == (nt >> 1)) E.mid(acc, cur, wr, wc, fr, fq); }
            const char* a1 = cA + (size_t)(t + 1) * kstep;
            const char* a2 = last ? nA : cA + (size_t)(t + 2) * kstep; const char* b2 = last ? nB : cB + (size_t)(t + 2) * kstep;
            const char* a3 = a2 + kstep; const char* b3 = b2 + kstep;
            if (last && has_next) S.a_ready(nxt);
            if constexpr (SP2) {
            PG8_LDB(B0, 0, 0); PG8_LDB(B1, 0, 1); PG8_SCHED; PG8_LDA(At, 0, 0); PG8_STAGE(PG8_SA(1, 1), a1 + hstep, voffA);
            PG8_WAIT_V(8); PG8_WAIT_L(0); PG8_BAR; PG8_MMA(0, 0, At, B0); PG8_MMA(0, 1, At, B1); PG8_BAR; PG8_SCHED;
            PG8_LDA(At, 0, 1); PG8_STAGE(PG8_SB(0, 0), b2, voffB); PG8_STAGE(PG8_SB(0, 1), b2 + hstep, voffB); PG8_STAGE(PG8_SA(0, 0), a2, voffA);
            PG8_WAIT_V(8); PG8_WAIT_L(0); PG8_BAR; PG8_MMA(1, 0, At, B0); PG8_MMA(1, 1, At, B1); PG8_BAR; PG8_SCHED;
            PG8_LDB(B0, 1, 0); PG8_LDB(B1, 1, 1); PG8_SCHED; PG8_LDA(At, 1, 0); PG8_STAGE(PG8_SA(0, 1), a2 + hstep, voffA);
            PG8_WAIT_V(8); PG8_WAIT_L(0); PG8_BAR; PG8_MMA(0, 0, At, B0); PG8_MMA(0, 1, At, B1); PG8_BAR; PG8_SCHED;
            PG8_LDA(At, 1, 1); PG8_STAGE(PG8_SB(1, 0), b3, voffB); PG8_STAGE(PG8_SB(1, 1), b3 + hstep, voffB); PG8_STAGE(PG8_SA(1, 0), a3, voffA);
            PG8_WAIT_V(8); PG8_WAIT_L(0); PG8_BAR; PG8_MMA(1, 0, At, B0); PG8_MMA(1, 1, At, B1); PG8_BAR; PG8_SCHED;
            } else {
            PG8_LDB(B0, 0, 0); PG8_SCHED; PG8_LDA(At, 0, 0); PG8_STAGE(PG8_SA(1, 1), a1 + hstep, voffA);
            PG8_WAIT_L(8); PG8_BAR; PG8_WAIT_L(0); PG8_MMA(0, 0, At, B0); PG8_BAR; PG8_SCHED;
            PG8_LDB(B1, 0, 1); PG8_STAGE(PG8_SB(0, 0), b2, voffB);
            PG8_BAR; PG8_WAIT_L(0); PG8_MMA(0, 1, At, B1); PG8_BAR;
            PG8_LDA(At, 0, 1); PG8_STAGE(PG8_SA(0, 0), a2, voffA);
            PG8_BAR; PG8_WAIT_L(0); PG8_MMA(1, 0, At, B0); PG8_BAR; PG8_SCHED;
            PG8_STAGE(PG8_SB(0, 1), b2 + hstep, voffB);
            PG8_WAIT_V(6); PG8_BAR; PG8_MMA(1, 1, At, B1); PG8_BAR;
            PG8_LDB(B0, 1, 0); PG8_SCHED; PG8_LDA(At, 1, 0); PG8_STAGE(PG8_SA(0, 1), a2 + hstep, voffA);
            PG8_WAIT_L(8); PG8_BAR; PG8_WAIT_L(0); PG8_MMA(0, 0, At, B0); PG8_BAR; PG8_SCHED;
            PG8_LDB(B1, 1, 1); PG8_STAGE(PG8_SB(1, 0), b3, voffB);
            PG8_BAR; PG8_WAIT_L(0); PG8_MMA(0, 1, At, B1); PG8_BAR;
            PG8_LDA(At, 1, 1); PG8_STAGE(PG8_SA(1, 0), a3, voffA);
            PG8_BAR; PG8_WAIT_L(0); PG8_MMA(1, 0, At, B0); PG8_BAR; PG8_SCHED;
            PG8_STAGE(PG8_SB(1, 1), b3 + hstep, voffB);
            PG8_WAIT_V(6); PG8_BAR; PG8_MMA(1, 1, At, B1); PG8_BAR;
            }
        }
        if constexpr (ALIGN_EPI) { if (wr == 0) PG8_BAR; }
        if constexpr (!Epi::AFTER_DRAIN) { E(acc, cur, wr, wc, fr, fq); S.done(cur); }
        if (!has_next) break;
#pragma unroll
        for (int a = 0; a < 2; ++a)
#pragma unroll
            for (int b = 0; b < 2; ++b)
#pragma unroll
                for (int m = 0; m < 4; ++m)
#pragma unroll
                    for (int n = 0; n < 2; ++n) acc[a][b][m][n] = (f32x4){0.f, 0.f, 0.f, 0.f};
        cur = nxt; cA = nA; cB = nB; ++ui;
        if constexpr (ALIGN_EPI) { if (wr == 1) PG8_BAR; }
    }
    PG8_WAIT_V(0);
    if constexpr (!ALIGN_EPI) { if (wr == 0) PG8_BAR; }
    PG8_BAR;
    if constexpr (Epi::AFTER_DRAIN) { E.fused(acc, cur, wr, wc, fr, fq, lds, wid, lane); S.done(cur); }
#undef PG8_SA
#undef PG8_SB
#undef PG8_STAGE
#undef PG8_LDA
#undef PG8_LDB
#undef PG8_MMA
#undef PG8_WAIT_V
#undef PG8_WAIT_L
#undef PG8_BAR
#undef PG8_SCHED
}
}
namespace att {
#define ALAS __attribute__((address_space(3)))
#define AGAS __attribute__((address_space(1)))
typedef unsigned short bf16_t;
typedef short bf16x8 __attribute__((ext_vector_type(8)));
typedef short s16x4 __attribute__((ext_vector_type(4)));
typedef float f32x16 __attribute__((ext_vector_type(16)));
typedef unsigned u32x4 __attribute__((ext_vector_type(4)));
typedef float f32x2_t __attribute__((ext_vector_type(2))); typedef __bf16 bf16x2_t __attribute__((ext_vector_type(2)));
constexpr int KPMAX = 208, VP = 192, KSZ = 64 * KPMAX, VSZ = 64 * VP;
constexpr int OFF_V = 2 * KSZ, OFF_SCR = OFF_V + 2 * VSZ, OFF_Q = OFF_SCR + 8 * 256, LDS_BYTES = OFF_Q + 64;
constexpr float NEGF = -1e30f, THR = 6.0f;
__device__ __forceinline__ int crow(int r, int hi) { return (r & 3) + 8 * (r >> 2) + 4 * hi; }
__device__ __forceinline__ unsigned cvtpk(float lo, float hi) { f32x2_t v = {lo, hi}; bf16x2_t b = __builtin_convertvector(v, bf16x2_t); return __builtin_bit_cast(unsigned, b); }
__device__ __forceinline__ bf16x8 pack8(const f32x16& p, int s) { u32x4 w; w.x = cvtpk(p[8 * s], p[8 * s + 1]); w.y = cvtpk(p[8 * s + 2], p[8 * s + 3]); w.z = cvtpk(p[8 * s + 4], p[8 * s + 5]); w.w = cvtpk(p[8 * s + 6], p[8 * s + 7]); return __builtin_bit_cast(bf16x8, w); }
typedef short v4i16_t __attribute__((ext_vector_type(4)));
__device__ __forceinline__ float max3f(float a, float b, float c) { float r; asm("v_max3_f32 %0, %1, %2, %3" : "=v"(r) : "v"(a), "v"(b), "v"(c)); return r; }
__device__ __forceinline__ float max2f(float a, float b) { float r; asm("v_max_f32_e32 %0, %1, %2" : "=v"(r) : "v"(a), "v"(b)); return r; }
__device__ __forceinline__ float xhalf_max(float m) { auto rr = __builtin_amdgcn_permlane32_swap(__float_as_uint(m), __float_as_uint(m), false, false); return max2f(__uint_as_float(rr[0]), __uint_as_float(rr[1])); }
__device__ __forceinline__ s16x4 vtr(const ALAS unsigned char* p) { return __builtin_bit_cast(s16x4, __builtin_amdgcn_ds_read_tr16_b64_v4i16((ALAS v4i16_t*)p)); }
__device__ __forceinline__ unsigned short f2bf(float f) { unsigned u = __builtin_bit_cast(unsigned, f); return (unsigned short)((u + 0x7fffu + ((u >> 16) & 1u)) >> 16); }

template <int DQK, bool SWA>
__device__ __forceinline__ void attn_unit(ALAS unsigned char* lds, const bf16_t* Qp, int qpitch, const bf16_t* Kp, int kpitch, const bf16_t* Krp, const bf16_t* Vp, int vpitch,
                                          bf16_t* Op, float* ssq, float sink2, int b, int qb) {
    constexpr int KP = DQK * 2 + 16, NS = DQK / 16;
    int tid_ = threadIdx.x; asm volatile("" : "+v"(tid_));
    const int tid = tid_, lane = tid & 63, wid = __builtin_amdgcn_readfirstlane(tid >> 6), r = lane & 31, h = lane >> 5;
    const size_t rowbase = (size_t)b * TT;
    const int q0 = qb * 256, q0w = q0 + wid * 32;
    const bool wave_valid = q0w < TT;
    const int NT = (q0 + 256) / 64 < TT / 64 ? (q0 + 256) / 64 : TT / 64;
    int t0 = 1; if (SWA) { t0 = (q0 - 128) / 64; if (t0 < 1) t0 = 1; }
    ALAS float* scr = (ALAS float*)(lds + OFF_SCR + wid * 256);
    bf16x8 qf[NS];
    { const int qr = (q0w + r) < TT ? (q0w + r) : TT - 1; const bf16_t* qrow = Qp + (rowbase + qr) * (size_t)qpitch;
#pragma unroll
      for (int s = 0; s < NS; ++s) qf[s] = *(const AGAS bf16x8*)(qrow + 16 * s + 8 * h); }
    const int srow = tid >> 3, sch = tid & 7, rrow = (tid >> 2) & 63, rch = tid & 3;
    u32x4 kregA, vregA, rregA = {0u, 0u, 0u, 0u}, kregB, vregB, rregB = {0u, 0u, 0u, 0u};
#define AT_GLOAD(t, S) do { const size_t kr_ = rowbase + 64 * (t) + srow; kreg##S = *(const AGAS u32x4*)(Kp + kr_ * (size_t)kpitch + sch * 8); vreg##S = *(const AGAS u32x4*)(Vp + kr_ * (size_t)vpitch + sch * 8); \
        if (DQK == 96) { if (tid < 256) rreg##S = *(const AGAS u32x4*)(Krp + (rowbase + 64 * (t) + rrow) * 32 + rch * 8); } } while (0)
#define AT_LSTORE(buf, S) do { *(ALAS u32x4*)(lds + (buf) * KSZ + srow * KP + sch * 16) = kreg##S; *(ALAS u32x4*)(lds + OFF_V + (buf) * VSZ + srow * VP + sch * 16) = vreg##S; \
        if (DQK == 96) { if (tid < 256) *(ALAS u32x4*)(lds + (buf) * KSZ + rrow * KP + 128 + rch * 16) = rreg##S; } } while (0)
    AT_GLOAD(t0, A); AT_LSTORE(0, A);
    if (t0 + 1 < NT) AT_GLOAD(t0 + 1, A);
    __syncthreads();
    float mrun = SWA ? sink2 : NEGF, lrun = (SWA && h == 0) ? 1.0f : 0.0f;
    f32x16 o0, o1;
#pragma unroll
    for (int i = 0; i < 16; ++i) { o0[i] = 0.f; o1[i] = 0.f; }
    const int q = q0w + r;
#define AT_PVF(P, j) do { o0 = __builtin_amdgcn_mfma_f32_32x32x16_bf16(P, __builtin_shufflevector(vlo[2 * (j)], vhi[2 * (j)], 0, 1, 2, 3, 4, 5, 6, 7), o0, 0, 0, 0); o1 = __builtin_amdgcn_mfma_f32_32x32x16_bf16(P, __builtin_shufflevector(vlo[2 * (j) + 1], vhi[2 * (j) + 1], 0, 1, 2, 3, 4, 5, 6, 7), o1, 0, 0, 0); } while (0)
#define AT_PV(P, rowoff) do { \
                { const s16x4 lo = vtr(vb_ + (rowoff) * VP), hi = vtr(vb_ + ((rowoff) + 8) * VP); const bf16x8 vf = __builtin_shufflevector(lo, hi, 0, 1, 2, 3, 4, 5, 6, 7); o0 = __builtin_amdgcn_mfma_f32_32x32x16_bf16(P, vf, o0, 0, 0, 0); } \
                { const s16x4 lo = vtr(vb_ + (rowoff) * VP + 64), hi = vtr(vb_ + ((rowoff) + 8) * VP + 64); const bf16x8 vf = __builtin_shufflevector(lo, hi, 0, 1, 2, 3, 4, 5, 6, 7); o1 = __builtin_amdgcn_mfma_f32_32x32x16_bf16(P, vf, o1, 0, 0, 0); } } while (0)
#define AT_STEP(t, LS, SS) do { \
        const int buf = (t - t0) & 1; \
        if (t + 2 < NT) AT_GLOAD(t + 2, LS); \
        const int kfirst = 64 * t; \
        bool active = wave_valid && (kfirst <= q0w + 31); \
        if (SWA) active = active && (kfirst + 63 >= q0w - 127); \
        if (active) { \
            f32x16 s0, s1; \
_Pragma("unroll") \
            for (int i = 0; i < 16; ++i) { s0[i] = 0.f; s1[i] = 0.f; } \
            const ALAS unsigned char* kb = lds + buf * KSZ + r * KP + h * 16; \
            bf16x8 kf[2 * NS]; \
_Pragma("unroll") \
            for (int s = 0; s < NS; ++s) { kf[2 * s] = *(const ALAS bf16x8*)(kb + s * 32); kf[2 * s + 1] = *(const ALAS bf16x8*)(kb + 32 * KP + s * 32); } \
            __builtin_amdgcn_sched_barrier(0); \
_Pragma("unroll") \
            for (int s = 0; s < NS; ++s) { s0 = __builtin_amdgcn_mfma_f32_32x32x16_bf16(kf[2 * s], qf[s], s0, 0, 0, 0); s1 = __builtin_amdgcn_mfma_f32_32x32x16_bf16(kf[2 * s + 1], qf[s], s1, 0, 0, 0); } \
            __builtin_amdgcn_sched_barrier(0); \
            const ALAS unsigned char* vb_ = lds + OFF_V + buf * VSZ + (4 * h + ((lane & 15) >> 2)) * VP + ((lane >> 4) & 1) * 32 + (lane & 3) * 8; \
            s16x4 vlo[8], vhi[8]; \
_Pragma("unroll") \
            for (int j = 0; j < 4; ++j) { vlo[2 * j] = vtr(vb_ + (16 * j) * VP); vhi[2 * j] = vtr(vb_ + (16 * j + 8) * VP); vlo[2 * j + 1] = vtr(vb_ + (16 * j) * VP + 64); vhi[2 * j + 1] = vtr(vb_ + (16 * j + 8) * VP + 64); } \
            __builtin_amdgcn_sched_barrier(0); \
            const bool need_mask = SWA || (t == 1) || (kfirst + 63 > q0w); \
            if (need_mask) { \
_Pragma("unroll") \
                for (int i = 0; i < 16; ++i) { const int key = kfirst + crow(i, h), key1 = key + 32; \
                    bool ok0 = (key <= q) && (key >= FRONT), ok1 = (key1 <= q) && (key1 >= FRONT); \
                    if (SWA) { ok0 = ok0 && (q - key < 128); ok1 = ok1 && (q - key1 < 128); } \
                    s0[i] = ok0 ? s0[i] : NEGF; s1[i] = ok1 ? s1[i] : NEGF; } \
            } \
            float rm = max3f(s0[0], s0[1], s1[0]), rm2 = max3f(s0[2], s0[3], s1[1]); rm = max3f(rm, s1[2], s1[3]); \
_Pragma("unroll") \
            for (int i = 4; i < 16; i += 4) { rm = max3f(rm, s0[i], s0[i + 1]); rm2 = max3f(rm2, s0[i + 2], s0[i + 3]); rm = max3f(rm, s1[i], s1[i + 1]); rm2 = max3f(rm2, s1[i + 2], s1[i + 3]); } \
            rm = xhalf_max(max2f(rm, rm2)); \
            if (__any(rm > mrun + THR)) { \
                const float mn = fmaxf(mrun, rm), f = __builtin_amdgcn_exp2f(mrun - mn); mrun = mn; lrun *= f; \
                if (h == 0) scr[r] = f; \
_Pragma("unroll") \
                for (int i = 0; i < 16; ++i) { const float fi = scr[crow(i, h)]; o0[i] *= fi; o1[i] *= fi; } \
            } \
            float ls = 0.f; \
_Pragma("unroll") \
            for (int i = 0; i < 16; ++i) { s0[i] = __builtin_amdgcn_exp2f(s0[i] - mrun); s1[i] = __builtin_amdgcn_exp2f(s1[i] - mrun); ls += s0[i] + s1[i]; } \
            lrun += ls; \
            const bf16x8 p0 = pack8(s0, 0), p1 = pack8(s0, 1), p2 = pack8(s1, 0), p3 = pack8(s1, 1); \
            __builtin_amdgcn_sched_barrier(0); \
            AT_PVF(p0, 0); AT_PVF(p1, 1); AT_PVF(p2, 2); AT_PVF(p3, 3); \
        } \
        if (t + 1 < NT) AT_LSTORE(buf ^ 1, SS); \
        __syncthreads(); \
    } while (0)
    {
        int t = t0;
        for (; t + 1 < NT; t += 2) { AT_STEP(t, B, A); const int t1 = t + 1; AT_STEP(t1, A, B); }
        if (t < NT) AT_STEP(t, B, A);
    }
#undef AT_STEP
#undef AT_PV
#undef AT_GLOAD
#undef AT_LSTORE
    if (wave_valid) {
        const float lt = lrun + __shfl_xor(lrun, 32);
        if (h == 0) scr[32 + r] = lt;
#pragma unroll
        for (int i = 0; i < 16; ++i) {
            const float li = scr[32 + crow(i, h)], inv = li > 0.f ? 1.0f / li : 0.f;
            const float a = o0[i] * inv, c = o1[i] * inv; const size_t row = rowbase + q0w + crow(i, h);
            ((AGAS bf16_t*)Op)[row * 1024 + r] = f2bf(a); ((AGAS bf16_t*)Op)[row * 1024 + 32 + r] = f2bf(c);
            float ss = a * a + c * c;
            ss += __shfl_xor(ss, 1); ss += __shfl_xor(ss, 2); ss += __shfl_xor(ss, 4); ss += __shfl_xor(ss, 8); ss += __shfl_xor(ss, 16);
            if (r == 0) ((AGAS float*)ssq)[row * 16] = ss;
        }
    }
    __syncthreads();
}
}
typedef unsigned short bf16;
#define LAS __attribute__((address_space(3)))
#define GAS __attribute__((address_space(1)))
constexpr size_t MiB = 1u << 20;
constexpr int NWAVES = 8, NTHREADS = 512;
constexpr int LDS_BYTES = 147456;
static_assert(att::LDS_BYTES <= 131072, "attention LDS");
constexpr size_t WS_CTL = 0, CTL_BYTES = 65536;
constexpr size_t WS_H = 1 * MiB;
constexpr size_t WS_HB = WS_H + (size_t)MROWS * DM * 4;
constexpr size_t WS_W = WS_HB + (size_t)MROWS * DM * 2;
constexpr size_t WL_IN = 0, WL_Q = WL_IN + (size_t)INP * DM * 2, WL_KV = WL_Q + (size_t)768 * 256 * 2, WL_O = WL_KV + (size_t)1024 * 128 * 2,
                 WL_GU = WL_O + (size_t)DM * DM * 2, WL_D = WL_GU + (size_t)GUP * DM * 2, WL_END = WL_D + (size_t)DM * DFF * 2;
constexpr size_t WBUF = 22 * MiB;
static_assert(WL_END <= WBUF, "weight buffer");
constexpr size_t WS_PART = WS_W + 2 * WBUF;
constexpr size_t P_HSSA = 0, P_HSSB = P_HSSA + (size_t)MROWS * 64, P_SSQO = P_HSSB + (size_t)MROWS * 64, P_SSQQ = P_SSQO + (size_t)MROWS * 64, P_SSQKV = P_SSQQ + (size_t)MROWS * 16, P_END = P_SSQKV + (size_t)MROWS * 16;
constexpr size_t PM_H = (P_END + 255) & ~(size_t)255, PM_HB = PM_H + 16 * DM * 4, PM_HSSA = PM_HB + 16 * DM * 2, PM_HSSB = PM_HSSA + 1024, PM_SSQQ = PM_HSSB + 1024, PM_SSQKV = PM_SSQQ + 256,
                 PM_QLAT = PM_SSQKV + 256, PM_KVLAT = PM_QLAT + 16 * 256 * 2, PM_ACT = PM_KVLAT + 16 * 128 * 2, PM_END = PM_ACT + 16 * DFF * 2;
static_assert(PM_END <= 8 * MiB, "partials");
constexpr int MC = BATCH * SEQ;
constexpr size_t WS_R = WS_PART + 8 * MiB;
constexpr size_t R_QA = 0, R_KA = R_QA + (size_t)MROWS * 512 * 2, R_VA = R_KA + (size_t)MROWS * 128 * 2, R_QLAT = R_VA + (size_t)MROWS * 128 * 2, R_KVLAT = R_QLAT + (size_t)MROWS * 256 * 2,
                 R_KR = R_KVLAT + (size_t)MROWS * 128 * 2, R_QM = R_KR + (size_t)MROWS * 32 * 2, R_KN = R_QM + (size_t)MROWS * 768 * 2, R_VB = R_KN + (size_t)MROWS * 512 * 2,
                 R_O = R_VB + (size_t)MROWS * 512 * 2, R_END = R_O + (size_t)MROWS * 1024 * 2;
constexpr size_t R_ACT = 0;
static_assert((size_t)MROWS * DFF * 2 <= R_END, "act overlay");
constexpr size_t WS_END = WS_R + R_END;
static_assert(WS_END <= 512 * MiB, "workspace must fit 512 MiB");

struct Args {
    const float *x, *meta, *attn_norm, *w_in, *q_norm, *w_q_up, *kv_norm, *w_kv_up, *sinks, *out_norm_swa, *out_norm_mla, *w_o, *ffn_norm, *w_gate, *w_up, *w_down, *final_norm;
    float* out; unsigned char* ws; int ph_lo, ph_hi;
};

__device__ __forceinline__ unsigned f2bf_u(float f) { unsigned u = __builtin_bit_cast(unsigned, f); return (u + 0x7fffu + ((u >> 16) & 1u)) >> 16; }
__device__ __forceinline__ unsigned pk2(float lo, float hi) { return f2bf_u(lo) | (f2bf_u(hi) << 16); }
__device__ __forceinline__ float wave_sum(float v) {
#pragma unroll
    for (int o = 1; o < 64; o <<= 1) v += __shfl_xor(v, o);
    return v;
}

__device__ __forceinline__ int src_in(int np) { const int pn = np >> 8, bj = (np >> 7) & 1, o = np & 127;
    if (pn < 2) return (4 * pn + (o >> 5)) * 64 + (o & 31) + 32 * bj;
    if (pn == 2) { if (o < 64) return 512 + (o >> 5) * 64 + (o & 31) + 32 * bj; if (o < 80) return 1152 + (o - 64) + 16 * bj; return -1; }
    if (pn == 3) return bj ? 1024 + o : 640 + o;
    return 768 + 128 * bj + o; }
__device__ __forceinline__ int src_qup(int np) { const int pn = np >> 8, op = np & 255;
    if (pn < 2) return (4 * pn + (op >> 6)) * 96 + (op & 63);
    const int bj = op >> 7, o = op & 127; return (o >> 4) * 96 + 64 + (o & 15) + 16 * bj; }
__device__ __forceinline__ int src_kvup(int np) { const int pn = np >> 8, op = np & 255; return (4 * (pn & 1) + (op >> 6)) * 128 + (pn >= 2 ? 64 : 0) + (op & 63); }

template <int MODE>
__device__ __forceinline__ void conv_item(const float* W, const float* W2, const float* gain, const float* gain2, int K, int Nsrc, bf16* WT, LAS float* scr, int item, int nblk, int lane) {
    const int kb = item / nblk, nb = item % nblk, k0 = 64 * kb, n0 = 32 * nb;
    const int np = n0 + (lane & 31);
    int src; float cs = 1.0f; const float* Wp = W;
    if (MODE == 0) { src = src_in(np); if (np < 512) cs = 0.125f * LOG2E; }
    else if (MODE == 1) { src = src_qup(np); cs = 0.10206207261596577f * LOG2E; }
    else if (MODE == 2) src = src_kvup(np);
    else if (MODE == 4) { src = 128 * (np >> 8) + (np & 127); if ((np >> 7) & 1) Wp = W2; }
    else src = np;
#pragma unroll 8
    for (int i = 0; i < 32; ++i) { const int kk = 2 * i + (lane >> 5), k = k0 + kk;
        float g = 1.0f; if (MODE == 3) g = (k < 512) ? ((const GAS float*)gain)[k] : ((const GAS float*)gain2)[k - 512]; else if (MODE != 5) g = ((const GAS float*)gain)[k];
        scr[kk * 33 + (lane & 31)] = (src >= 0) ? ((const GAS float*)Wp)[(size_t)k * Nsrc + src] * g * cs : 0.0f; }
    asm volatile("s_waitcnt lgkmcnt(0)" ::: "memory");
    const int c = lane & 7;
#pragma unroll
    for (int j = 0; j < 4; ++j) { const int n = (lane >> 3) + 8 * j; const LAS float* s = scr + (8 * c) * 33 + n;
        pg8::u32x4 o; o.x = pk2(s[0 * 33], s[1 * 33]); o.y = pk2(s[2 * 33], s[3 * 33]); o.z = pk2(s[4 * 33], s[5 * 33]); o.w = pk2(s[6 * 33], s[7 * 33]);
        *(GAS pg8::u32x4*)(WT + (size_t)(n0 + n) * K + k0 + 8 * c) = o; }
    asm volatile("s_waitcnt lgkmcnt(0)" ::: "memory");
}
__device__ __forceinline__ void conv_layer(const Args& a, int l, unsigned char* wbuf, LAS unsigned char* lds) {
    int tid_ = threadIdx.x; asm volatile("" : "+v"(tid_));
    const int lane = tid_ & 63, wave = tid_ >> 6;
    LAS float* scr = (LAS float*)(lds + wave * 16384);
    const int gw = blockIdx.x * NWAVES + wave, NGW = gridDim.x * NWAVES;
    constexpr int I0 = (DM / 64) * (INP / 32), I1 = (256 / 64) * (768 / 32), I2 = (128 / 64) * (1024 / 32), I3 = (DM / 64) * (DM / 32), I4 = (DM / 64) * (GUP / 32), I5 = (DFF / 64) * (DM / 32);
    constexpr int NIT = I0 + I1 + I2 + I3 + I4 + I5;
    for (int it = gw; it < NIT; it += NGW) {
        int r = it;
        if (r < I0) { conv_item<0>(a.w_in + (size_t)l * DM * INW, nullptr, a.attn_norm + l * DM, nullptr, DM, INW, (bf16*)(wbuf + WL_IN), scr, r, INP / 32, lane); continue; } r -= I0;
        if (r < I1) { conv_item<1>(a.w_q_up + (size_t)l * 256 * 768, nullptr, a.q_norm + l * 256, nullptr, 256, 768, (bf16*)(wbuf + WL_Q), scr, r, 768 / 32, lane); continue; } r -= I1;
        if (r < I2) { conv_item<2>(a.w_kv_up + (size_t)l * 128 * 1024, nullptr, a.kv_norm + l * 128, nullptr, 128, 1024, (bf16*)(wbuf + WL_KV), scr, r, 1024 / 32, lane); continue; } r -= I2;
        if (r < I3) { conv_item<3>(a.w_o + (size_t)l * DM * DM, nullptr, a.out_norm_swa + l * 512, a.out_norm_mla + l * 512, DM, DM, (bf16*)(wbuf + WL_O), scr, r, DM / 32, lane); continue; } r -= I3;
        if (r < I4) { conv_item<4>(a.w_gate + (size_t)l * DM * DFF, a.w_up + (size_t)l * DM * DFF, a.ffn_norm + l * DM, nullptr, DM, DFF, (bf16*)(wbuf + WL_GU), scr, r, GUP / 32, lane); continue; } r -= I4;
        conv_item<5>(a.w_down + (size_t)l * DFF * DM, nullptr, nullptr, nullptr, DFF, DM, (bf16*)(wbuf + WL_D), scr, r, DM / 32, lane);
    }
}

__device__ __forceinline__ void init_rows(const Args& a, unsigned char* ws) {
    const int lane = threadIdx.x & 63, wave = threadIdx.x >> 6; const int gw = blockIdx.x * NWAVES + wave, NGW = gridDim.x * NWAVES;
    for (int row = gw; row < MC + NMETA; row += NGW) {
        const bool meta = row >= MC; const int r = meta ? row - MC : row;
        const float* src = meta ? a.meta + (size_t)r * DM : a.x + (size_t)r * DM;
        float* H = (float*)(ws + (meta ? WS_PART + PM_H : WS_H)); bf16* HB = (bf16*)(ws + (meta ? WS_PART + PM_HB : WS_HB)); float* hss = (float*)(ws + WS_PART + (meta ? PM_HSSA : P_HSSA));
        pg8::f32x4 v[4]; float s = 0.f;
#pragma unroll
        for (int j = 0; j < 4; ++j) { v[j] = *((const GAS pg8::f32x4*)src + lane + 64 * j); s += pg8::sq4(v[j]); }
        s = wave_sum(s);
#pragma unroll
        for (int j = 0; j < 4; ++j) { pg8::st_bf16x4(HB + (size_t)r * DM + 4 * (lane + 64 * j), v[j]); }
        if (lane < 16) ((GAS float*)hss)[(size_t)r * 16 + lane] = (lane == 0) ? s : 0.f;
    }
}
__device__ __forceinline__ void final_rows(const Args& a, const bf16* HBf, const float* hss) {
    const int lane = threadIdx.x & 63, wave = threadIdx.x >> 6; const int gw = blockIdx.x * NWAVES + wave, NGW = gridDim.x * NWAVES;
    for (int o = gw; o < BATCH * SEQ; o += NGW) {
        const int row = o;
        const float rs = pg8::rsq(pg8::sum16(hss, row) * (1.0f / DM) + RMS_EPS);
#pragma unroll
        for (int j = 0; j < 4; ++j) { const pg8::u32x2 hw = *((const GAS pg8::u32x2*)(HBf + (size_t)row * DM) + lane + 64 * j); pg8::f32x4 v; v[0] = __builtin_bit_cast(float, hw.x << 16); v[1] = __builtin_bit_cast(float, hw.x & 0xffff0000u); v[2] = __builtin_bit_cast(float, hw.y << 16); v[3] = __builtin_bit_cast(float, hw.y & 0xffff0000u);
            const pg8::f32x4 g = *((const GAS pg8::f32x4*)a.final_norm + lane + 64 * j);
            *((GAS pg8::f32x4*)(a.out + (size_t)o * DM) + lane + 64 * j) = v * rs * g; }
    }
}

constexpr int N_ATT_UNITS = 2 * 17 * 64;
__device__ __forceinline__ void attn_phase(const Args& a, int l, unsigned char* ws, LAS unsigned char* lds, int mode = 0) {
    const int lq = l; l &= 3;
    unsigned char* R = ws + WS_R;
    const bf16 *QA = (const bf16*)(R + R_QA), *KA = (const bf16*)(R + R_KA), *VA = (const bf16*)(R + R_VA), *KR = (const bf16*)(R + R_KR), *QM = (const bf16*)(R + R_QM), *KN = (const bf16*)(R + R_KN), *VB = (const bf16*)(R + R_VB);
    bf16* O = (bf16*)(R + R_O); float* ssqO = (float*)(ws + WS_PART + P_SSQO);
    LAS int* qslot = (LAS int*)(lds + att::OFF_Q);
    const unsigned xcc = ((unsigned)__builtin_amdgcn_s_getreg((3 << 11) | 20) & 0xFu) & 7u;
    unsigned* ctr = (unsigned*)(ws + WS_CTL) + 64 * lq + 8 * 64 * (int)xcc;
    constexpr int PER_X = N_ATT_UNITS / 8;
    for (int pass = 0; pass < 8; ++pass) {
        const unsigned x = (xcc + (unsigned)pass) & 7u; unsigned* c = (unsigned*)(ws + WS_CTL) + 64 * lq + 8 * 64 * (int)x;
        for (;;) {
            if (threadIdx.x == 0) *qslot = (int)atomicAdd(c, 1u);
            __syncthreads();
            const int u = *qslot;
            __syncthreads();
            if (u >= (mode == 1 ? PER_X / 2 : PER_X)) break;
            if (u < PER_X / 2) {
                const int bh = 8 * (u / 17) + (int)x, qb = 16 - u % 17, b = bh >> 3, hd = bh & 7;
                att::attn_unit<96, false>(lds, QM + hd * 96, 768, KN + hd * 64, 512, KR, VB + hd * 64, 512, O + 512 + hd * 64, ssqO + 8 + hd, 0.f, b, qb);
            } else {
                const int v = u - PER_X / 2; const int bh = 8 * (v / 17) + (int)x, qb = 16 - v % 17, b = bh >> 3, hq = bh & 7, kv = hq >> 2;
                att::attn_unit<64, true>(lds, QA + hq * 64, 512, KA + kv * 64, 128, nullptr, VA + kv * 64, 128, O + hq * 64, ssqO + hq, a.sinks[l * 8 + hq] * LOG2E, b, qb);
            }
        }
    }
    (void)ctr;
}

#define XB_TMO      128
#define XB_XCNT(j)  (256  + 64 * (j))
#define XB_XSUB(j)  (1280 + 64 * (j))
#define XB_XGEN(j)  (2304 + 64 * (j))
#define XB_TOP      3328
#define XB_TOPGEN   3392
#define XCD_BAR_WORDS 3456
#define XB_SPIN_CAP (1u << 18)

__device__ __forceinline__ unsigned xb_ld(unsigned* p)              { return __hip_atomic_load(p, __ATOMIC_RELAXED, __HIP_MEMORY_SCOPE_AGENT); }
__device__ __forceinline__ unsigned xb_add(unsigned* p, unsigned v) { return __hip_atomic_fetch_add(p, v, __ATOMIC_RELAXED, __HIP_MEMORY_SCOPE_AGENT); }
__device__ __forceinline__ unsigned xb_xcc_id() { return (unsigned)__builtin_amdgcn_s_getreg((3 << 11) | 20) & 0xFu; }
#define XB_SPIN(cond, bar) do { unsigned _sp = 0; while (cond) { __builtin_amdgcn_s_sleep(1); \
    if ((++_sp & 255u) == 0u) { if (xb_ld(&(bar)[XB_TMO])) break; if (_sp > XB_SPIN_CAP) { atomicAdd(&(bar)[XB_TMO], 1u); break; } } } } while (0)

struct XcdBarrier {
    unsigned* bar; unsigned x;
    volatile LAS unsigned* st;
};

__device__ __forceinline__ XcdBarrier xcd_barrier_post(unsigned* bar, volatile LAS unsigned* st) {
    XcdBarrier b; b.bar = bar; b.x = xb_xcc_id(); b.st = st;
    if (threadIdx.x == 0) (void)xb_add(&bar[XB_XCNT(b.x)], 1u);
    return b;
}
__device__ __forceinline__ void xcd_barrier_complete(unsigned* bar, unsigned x, unsigned& nloc, unsigned& nx) {
    const unsigned G = gridDim.x * gridDim.y * gridDim.z;
    unsigned sum, cnt, mine, sp = 0u;
    for (;;) {
        sum = 0u; cnt = 0u; mine = 0u;
#pragma unroll
        for (unsigned j = 0; j < 16; ++j) { const unsigned c = xb_ld(&bar[XB_XCNT(j)]); sum += c; cnt += (c > 0u) ? 1u : 0u; mine = (j == x) ? c : mine; }
        if (sum == G) break;
        __builtin_amdgcn_s_sleep(1);
        if ((++sp & 255u) == 0u) { if (xb_ld(&bar[XB_TMO])) break; if (sp > XB_SPIN_CAP) { atomicAdd(&bar[XB_TMO], 1u); break; } }
    }
    nloc = mine > 0u ? mine : 1u; nx = cnt > 0u ? cnt : 1u;
}

__device__ __forceinline__ void xcd_barrier(const XcdBarrier& b) {
    asm volatile("s_waitcnt vmcnt(0)" ::: "memory");
    __syncthreads();
    if (threadIdx.x == 0) {
        unsigned* bar = b.bar;
        __builtin_amdgcn_s_waitcnt(0);
        unsigned nloc = b.st[0], nx = b.st[1];
        if (nloc == 0u) { xcd_barrier_complete(bar, b.x, nloc, nx); b.st[0] = nloc; b.st[1] = nx; }
        const unsigned old = xb_add(&bar[XB_XSUB(b.x)], 1u);
        const unsigned gen = old / nloc;
        if (old + 1u == (gen + 1u) * nloc) {
            __builtin_amdgcn_fence(__ATOMIC_RELEASE, "agent");
            asm volatile("s_waitcnt vmcnt(0)" ::: "memory");
            const unsigned og = xb_add(&bar[XB_TOP], 1u);
            const unsigned tg = og / nx;
            if (og + 1u == (tg + 1u) * nx) xb_add(&bar[XB_TOPGEN], 1u);
            else XB_SPIN(xb_ld(&bar[XB_TOPGEN]) == tg, bar);
            __builtin_amdgcn_fence(__ATOMIC_ACQUIRE, "agent");
            xb_add(&bar[XB_XGEN(b.x)], 1u);
            asm volatile("s_waitcnt vmcnt(0)" ::: "memory");
        } else {
            XB_SPIN(xb_ld(&bar[XB_XGEN(b.x)]) == gen, bar);
            __builtin_amdgcn_fence(__ATOMIC_ACQUIRE, "agent");
            asm volatile("s_waitcnt vmcnt(0)" ::: "memory");
        }
    }
    __syncthreads();
}

constexpr int CW_BAR = 4096;
constexpr int XB_LDS_OFF = 131072 + 8192;
#ifndef PHM
#define PHM 255
#endif
#ifndef PROBE_DUP
#define PROBE_DUP 0
#endif
#ifndef PROBE_SYNC
#define PROBE_SYNC 0
#endif
__global__ void __launch_bounds__(NTHREADS, 2) fwd_megakernel(Args a) {
    extern __shared__ __attribute__((aligned(16))) unsigned char lds_raw[];
    LAS unsigned char* lds = (LAS unsigned char*)lds_raw;
    cg::grid_group grid = cg::this_grid();
    const int lo = a.ph_lo, hi = a.ph_hi;
    if (threadIdx.x < 2) ((LAS unsigned*)(lds + XB_LDS_OFF))[threadIdx.x] = 0u;
    __syncthreads();
    const XcdBarrier xbar = xcd_barrier_post((unsigned*)(a.ws + WS_CTL) + CW_BAR, (volatile LAS unsigned*)(lds + XB_LDS_OFF));
#define IN_PH(k) (lo <= (k) && (k) < hi)
#define SEAM(k) do { if (IN_PH(k) && IN_PH((k) + 1)) { if ((k) == 0) grid.sync(); else xcd_barrier(xbar); if (PROBE_SYNC) xcd_barrier(xbar); } } while (0)
#define WSL(w) unsigned char* w = a.ws; asm volatile("" : "+s"(w))
    if (IN_PH(0) && (PHM & 1)) { WSL(ws); init_rows(a, ws); conv_layer(a, 0, ws + WS_W, lds); __syncthreads(); }
    SEAM(0);
#pragma unroll 1
    for (int l = 0; l < DEPTH; ++l) {
        const int p = 1 + 6 * l;
        if (IN_PH(p) && (PHM & 2)) {
            { WSL(ws); unsigned char* R = ws + WS_R; unsigned char* wb = ws + WS_W + (size_t)(l & 1) * WBUF; unsigned char* pm_ = ws + WS_PART;
              pg8::EpiIn<true> E{(const float*)(pm_ + PM_HSSA), (bf16*)(R + R_QA), (bf16*)(R + R_KA), (bf16*)(R + R_VA), (bf16*)(pm_ + PM_QLAT), (bf16*)(pm_ + PM_KVLAT), (bf16*)(R + R_KR), (float*)(pm_ + PM_SSQQ), (float*)(pm_ + PM_SSQKV)};
              pg8::skinny_phase<DM>(lds, (const bf16*)(pm_ + PM_HB), (const bf16*)(wb + WL_IN), INP / 256, E, 128); }
            WSL(ws); unsigned char* R = ws + WS_R; unsigned char* wb = ws + WS_W + (size_t)(l & 1) * WBUF;
            pg8::Gemm g{(const bf16*)(ws + WS_HB), (const bf16*)(wb + WL_IN), MC, INP, DM, 0}; pg8::OrderCT<MC / 256, INP / 256> S; S.init((int)gridDim.x, (int)blockIdx.x);
            pg8::EpiIn<false> E{(const float*)(ws + WS_PART + P_HSSA), (bf16*)(R + R_QA), (bf16*)(R + R_KA), (bf16*)(R + R_VA), (bf16*)(R + R_QLAT), (bf16*)(R + R_KVLAT), (bf16*)(R + R_KR),
                         (float*)(ws + WS_PART + P_SSQQ), (float*)(ws + WS_PART + P_SSQKV)};
            pg8::gemm_phase<pg8::EpiIn<false>, pg8::OrderCT<MC / 256, INP / 256>, true, true>(lds, g, S, E);
            if (PROBE_DUP & 2) pg8::gemm_phase<pg8::EpiIn<false>, pg8::OrderCT<MC / 256, INP / 256>, true, true>(lds, g, S, E);
        }
        SEAM(p);
        if (IN_PH(p + 1) && (PHM & 4)) {
            { WSL(ws); unsigned char* R = ws + WS_R; unsigned char* wb = ws + WS_W + (size_t)(l & 1) * WBUF; unsigned char* pm_ = ws + WS_PART;
              pg8::EpiQup<true> E{(const float*)(pm_ + PM_SSQQ), (bf16*)(R + R_QM)}; pg8::skinny_phase<256>(lds, (const bf16*)(pm_ + PM_QLAT), (const bf16*)(wb + WL_Q), 3, E, 128); }
            { WSL(ws); unsigned char* R = ws + WS_R; unsigned char* wb = ws + WS_W + (size_t)(l & 1) * WBUF;
              pg8::Gemm g{(const bf16*)(R + R_QLAT), (const bf16*)(wb + WL_Q), MC, 768, 256, 0}; pg8::OrderCT<MC / 256, 3> S; S.init((int)gridDim.x, (int)blockIdx.x);
              pg8::EpiQup<false> E{(const float*)(ws + WS_PART + P_SSQQ), (bf16*)(R + R_QM)}; pg8::gemm_phase<pg8::EpiQup<false>, pg8::OrderCT<MC / 256, 3>, true, true>(lds, g, S, E); if (PROBE_DUP & 4) pg8::gemm_phase<pg8::EpiQup<false>, pg8::OrderCT<MC / 256, 3>, true, true>(lds, g, S, E); }
            { WSL(ws); unsigned char* R = ws + WS_R; unsigned char* wb = ws + WS_W + (size_t)(l & 1) * WBUF; unsigned char* pm_ = ws + WS_PART;
              pg8::EpiKvup<true> E{(const float*)(pm_ + PM_SSQKV), (bf16*)(R + R_KN), (bf16*)(R + R_VB)}; pg8::skinny_phase<128>(lds, (const bf16*)(pm_ + PM_KVLAT), (const bf16*)(wb + WL_KV), 4, E, 0); }
            { WSL(ws); unsigned char* R = ws + WS_R; unsigned char* wb = ws + WS_W + (size_t)(l & 1) * WBUF;
              pg8::Gemm g{(const bf16*)(R + R_KVLAT), (const bf16*)(wb + WL_KV), MC, 1024, 128, 0}; pg8::OrderCT<MC / 256, 4> S; S.init((int)gridDim.x, (int)blockIdx.x);
              pg8::EpiKvup<false> E{(const float*)(ws + WS_PART + P_SSQKV), (bf16*)(R + R_KN), (bf16*)(R + R_VB)}; pg8::gemm_phase<pg8::EpiKvup<false>, pg8::OrderCT<MC / 256, 4>, true, true>(lds, g, S, E); if (PROBE_DUP & 4) pg8::gemm_phase<pg8::EpiKvup<false>, pg8::OrderCT<MC / 256, 4>, true, true>(lds, g, S, E); }
        }
        SEAM(p + 1);
        if (IN_PH(p + 2) && (PHM & 8)) { WSL(ws); if (l + 1 < DEPTH) { conv_layer(a, l + 1, ws + WS_W + (size_t)((l + 1) & 1) * WBUF, lds); __syncthreads(); if (PROBE_DUP & 256) { conv_layer(a, l + 1, ws + WS_W + (size_t)((l + 1) & 1) * WBUF, lds); __syncthreads(); } } attn_phase(a, l, ws, lds); if (PROBE_DUP & 8) attn_phase(a, l + 4, ws, lds); if (PROBE_DUP & 1024) attn_phase(a, l + 4, ws, lds, 1); }
        SEAM(p + 2);
        if (IN_PH(p + 3) && (PHM & 16)) {
            { WSL(ws); unsigned char* R = ws + WS_R; unsigned char* wb = ws + WS_W + (size_t)(l & 1) * WBUF; unsigned char* pm_ = ws + WS_PART;
              pg8::EpiOut<true> E; E.H = (float*)(pm_ + PM_H); E.HB = (bf16*)(pm_ + PM_HB); E.hss_out = (float*)(pm_ + PM_HSSB); E.ssq_o = (const float*)(pm_ + P_SSQO); E.xlds = lds;
              pg8::skinny_phase<DM>(lds, (const bf16*)(R + R_O) + (size_t)FRONT * 1024, (const bf16*)(wb + WL_O), 4, E, 0); }
            WSL(ws); unsigned char* R = ws + WS_R; unsigned char* wb = ws + WS_W + (size_t)(l & 1) * WBUF;
            pg8::Gemm g{(const bf16*)(R + R_O), (const bf16*)(wb + WL_O), MC, DM, DM, 1}; pg8::OrderCT<MC / 256, 4> S; S.init((int)gridDim.x, (int)blockIdx.x);
            pg8::EpiOut<false> E; E.H = (float*)(ws + WS_H); E.HB = (bf16*)(ws + WS_HB); E.hss_out = (float*)(ws + WS_PART + P_HSSB); E.ssq_o = (const float*)(ws + WS_PART + P_SSQO); E.xlds = lds + pg8::STAGE_BYTES;
            pg8::gemm_phase<pg8::EpiOut<false>, pg8::OrderCT<MC / 256, 4>, true, true>(lds, g, S, E);
        }
        SEAM(p + 3);
        if (IN_PH(p + 4) && (PHM & 32)) {
            { WSL(ws); unsigned char* wb = ws + WS_W + (size_t)(l & 1) * WBUF; unsigned char* pm_ = ws + WS_PART;
              pg8::EpiGU<true> E{(const float*)(pm_ + PM_HSSB), (bf16*)(pm_ + PM_ACT)}; pg8::skinny_phase<DM>(lds, (const bf16*)(pm_ + PM_HB), (const bf16*)(wb + WL_GU), GUP / 256, E, 0); }
            WSL(ws); unsigned char* R = ws + WS_R; unsigned char* wb = ws + WS_W + (size_t)(l & 1) * WBUF;
            pg8::Gemm g{(const bf16*)(ws + WS_HB), (const bf16*)(wb + WL_GU), MC, GUP, DM, 0}; pg8::OrderCT<MC / 256, GUP / 256> S; S.init((int)gridDim.x, (int)blockIdx.x);
            pg8::EpiGU<false> E{(const float*)(ws + WS_PART + P_HSSB), (bf16*)(R + R_ACT)};
            pg8::gemm_phase<pg8::EpiGU<false>, pg8::OrderCT<MC / 256, GUP / 256>, true, true>(lds, g, S, E);
        }
        SEAM(p + 4);
        if (IN_PH(p + 5) && (PHM & 64)) {
            { WSL(ws); unsigned char* wb = ws + WS_W + (size_t)(l & 1) * WBUF; unsigned char* pm_ = ws + WS_PART;
              pg8::EpiDown<true> E; E.H = (float*)(pm_ + PM_H); E.HB = (bf16*)(pm_ + PM_HB); E.hss_out = (float*)(pm_ + PM_HSSA); E.ssq_o = nullptr;
              pg8::skinny_phase<DFF>(lds, (const bf16*)(pm_ + PM_ACT), (const bf16*)(wb + WL_D), 4, E, 0); }
            WSL(ws); unsigned char* R = ws + WS_R; unsigned char* wb = ws + WS_W + (size_t)(l & 1) * WBUF;
            pg8::Gemm g{(const bf16*)(R + R_ACT), (const bf16*)(wb + WL_D), MC, DM, DFF, 0}; pg8::OrderCT<MC / 256, 4> S; S.init((int)gridDim.x, (int)blockIdx.x);
            pg8::EpiDown<false> E; E.H = (float*)(ws + WS_H); E.HB = (bf16*)(ws + WS_HB); E.hss_out = (float*)(ws + WS_PART + P_HSSA); E.ssq_o = nullptr;
            pg8::gemm_phase<pg8::EpiDown<false>, pg8::OrderCT<MC / 256, 4>, true, true>(lds, g, S, E);
        }
        SEAM(p + 5);
    }
    if (IN_PH(1 + 6 * DEPTH) && (PHM & 128)) { WSL(ws); final_rows(a, (const bf16*)(ws + WS_HB), (const float*)(ws + WS_PART + P_HSSA)); }
#undef IN_PH
#undef SEAM
#undef WSL
}
constexpr int N_PHASES = 2 + 6 * DEPTH;

#ifndef MK_SPLIT
#define MK_SPLIT 0
#endif
extern "C" void kernel_launch(void* const* d_in, const int* in_sizes, int n_in, void* d_out, int out_size, void* d_ws, size_t ws_size, hipStream_t stream) {
    static int grid = 0;
    if (grid == 0) {
        if (n_in != 17 || ws_size < WS_END) { fprintf(stderr, "kernel_launch: need 17 inputs and >= %zu bytes of workspace; got n_in %d, ws %zu\n", (size_t)WS_END, n_in, ws_size); grid = -1; return; }
        int dev = 0, cus = 0, per_cu = 0;
        hipGetDevice(&dev); hipDeviceGetAttribute(&cus, hipDeviceAttributeMultiprocessorCount, dev);
        if (hipFuncSetAttribute((const void*)fwd_megakernel, hipFuncAttributeMaxDynamicSharedMemorySize, LDS_BYTES) != hipSuccess) { fprintf(stderr, "kernel_launch: hipFuncSetAttribute failed\n"); grid = -1; return; }
        if (hipOccupancyMaxActiveBlocksPerMultiprocessor(&per_cu, (const void*)fwd_megakernel, NTHREADS, LDS_BYTES) != hipSuccess || per_cu < 1) { fprintf(stderr, "kernel_launch: occupancy query says %d\n", per_cu); per_cu = 1; }
        (void)hipGetLastError();
        grid = cus * 1;
    }
    if (grid < 0) return;
    hipMemsetAsync((char*)d_ws + WS_CTL, 0, CTL_BYTES, stream);
    Args a{};
    const float** f = (const float**)&a;
    for (int i = 0; i < 17; ++i) f[i] = (const float*)d_in[i];
    a.out = (float*)d_out; a.ws = (unsigned char*)d_ws;
#if MK_SPLIT
    for (int ph = 0; ph < N_PHASES; ++ph) { a.ph_lo = ph; a.ph_hi = ph + 1; hipLaunchKernelGGL(fwd_megakernel, dim3(grid), dim3(NTHREADS), LDS_BYTES, stream, a); }
#else
    a.ph_lo = 0; a.ph_hi = N_PHASES;
    void* args[] = {&a};
    hipError_t e = hipLaunchCooperativeKernel((const void*)fwd_megakernel, dim3(grid), dim3(NTHREADS), args, LDS_BYTES, stream);
    if (e != hipSuccess) fprintf(stderr, "cooperative launch failed: %s (grid %d)\n", hipGetErrorString(e), grid);
#endif
}
```

```cpp
#include <hip/hip_runtime.h>
#include <hip/hip_cooperative_groups.h>
#include <cstdio>
#include <cstdint>
namespace cg = cooperative_groups;

constexpr int BATCH = 8, SEQ = 4096, DM = 1024, DEPTH = 4, NMETA = 16, FRONT = 112, TT = 4224;
constexpr int MROWS = BATCH * TT;
constexpr int INW = 1184, INP = 1280, DFF = 2816, GUP = 2 * DFF;
constexpr float RMS_EPS = 1e-6f;
constexpr float LOG2E = 1.4426950408889634f;
constexpr float LOG2_THETA = 13.287712379549449f;
constexpr float INV_2PI = 0.15915494309189535f;

namespace pg8 {
#define PG8_LAS __attribute__((address_space(3)))
typedef unsigned short bf16_t;
typedef short bf16x8 __attribute__((ext_vector_type(8)));
typedef float f32x4 __attribute__((ext_vector_type(4)));
typedef unsigned u32x4 __attribute__((ext_vector_type(4)));
constexpr int BM = 256, BK = 64, HALF = 128, HTB = HALF * BK * 2  , STAGE_BYTES = 8 * HTB, NXCD = 8, WGM = 8;

__host__ __device__ __forceinline__ int lds_byte(int r, int c) { const int st = (r >> 4) * 2 + (c >> 5), rr = r & 15, cc = c & 31, ob = rr * 64 + cc * 2; return st * 1024 + (ob ^ (((ob >> 9) & 1) << 5)); }
__host__ __device__ __forceinline__ void stage_rc(int b, int& R, int& C) { const int st = b / 1024, sb = b % 1024, swz = sb ^ (((sb >> 9) & 1) << 5); R = (st >> 1) * 16 + swz / 64; C = (st & 1) * 32 + (swz % 64) / 2; }
__host__ __device__ __forceinline__ int perm32(int rho) { const int n = rho >> 4, i = rho & 15; return 8 * (i >> 2) + 4 * n + (i & 3); }

struct Unit { int pm, pn; };
struct Gemm { const bf16_t* A; const bf16_t* Bt; int M, N, K; int apad; };

struct StaticOrder {
    int nM, nN, nwg, G, c;
    __host__ __device__ void init(int M, int N, int G_, int c_) { nM = M / BM; nN = N / BM; nwg = nM * nN; G = G_; c = c_; }
    __host__ __device__ bool next(int i, Unit& u) const {
        const long L = (long)i * G + c; if (L >= nwg) return false;
        int wgid = (int)L; { const int q = nwg / NXCD, r = nwg % NXCD, xcd = wgid % NXCD, off = wgid / NXCD; wgid = (xcd < r ? xcd * (q + 1) : r * (q + 1) + (xcd - r) * q) + off; }
        const int nig = WGM * nN, gid = wgid / nig, fm = gid * WGM, gsz = (nM - fm) < WGM ? (nM - fm) : WGM;
        u.pm = fm + ((wgid % nig) % gsz); u.pn = (wgid % nig) / gsz; return true;
    }
    __device__ __forceinline__ void a_ready(const Unit&) const {}
    __device__ __forceinline__ void done(const Unit&) const {}
};

__device__ __forceinline__ unsigned cvt_pk_bf16(float lo, float hi) { unsigned r; asm volatile("v_cvt_pk_bf16_f32 %0, %1, %2" : "=v"(r) : "v"(lo), "v"(hi)); return r; }

template <int NM, int NN> struct OrderCT {
    static_assert(NM % 8 == 0 || NM % 8 == 4, "last M group must be 8 or 4 tiles");
    int G, c;
    __device__ __forceinline__ void init(int G_, int c_) { G = G_; c = c_; }
    __device__ __forceinline__ bool next(int i, Unit& u) const {
        constexpr int nwg = NM * NN, q = nwg / NXCD, r = nwg % NXCD, nig = WGM * NN;
        const int L = i * G + c; if (L >= nwg) return false;
        const int xcd = L & (NXCD - 1), off = L >> 3;
        const int wgid = (xcd < r ? xcd * (q + 1) : r * (q + 1) + (xcd - r) * q) + off;
        const int gid = wgid / nig, rem = wgid - gid * nig, fm = gid * WGM;
        const int sh = (NM - fm) < WGM ? 2 : 3;
        u.pm = fm + (rem & ((1 << sh) - 1)); u.pn = rem >> sh; return true;
    }
    __device__ __forceinline__ void a_ready(const Unit&) const {}
    __device__ __forceinline__ void done(const Unit&) const {}
};
typedef unsigned u32x2 __attribute__((ext_vector_type(2)));
#define PG8_GAS __attribute__((address_space(1)))
__device__ __forceinline__ void st_bf16x4(bf16_t* p, f32x4 v) { u32x2 w; w.x = cvt_pk_bf16(v[0], v[1]); w.y = cvt_pk_bf16(v[2], v[3]); *(PG8_GAS u32x2*)p = w; }
__device__ __forceinline__ float sum16(const float* part, int row) {
    const PG8_GAS f32x4* p = (const PG8_GAS f32x4*)(part + (size_t)row * 16); const f32x4 a = p[0], b = p[1], c = p[2], d = p[3];
    return (((a.x + a.y) + (a.z + a.w)) + ((b.x + b.y) + (b.z + b.w))) + (((c.x + c.y) + (c.z + c.w)) + ((d.x + d.y) + (d.z + d.w)));
}
__device__ __forceinline__ float sum4(const float* part, int row) { const f32x4 a = *(const PG8_GAS f32x4*)(part + (size_t)row * 4); return (a.x + a.y) + (a.z + a.w); }
__device__ __forceinline__ float rsq(float x) { return 1.0f / sqrtf(x); }
__device__ __forceinline__ float sq4(f32x4 v) { return (v[0] * v[0] + v[1] * v[1]) + (v[2] * v[2] + v[3] * v[3]); }
#define EPI_ROWS(ai, m) for (int ai = 0; ai < 2; ++ai) for (int m = 0; m < 4; ++m)
#define EPI_ROW(u, ai, m) ((u).pm * BM + (ai) * HALF + wr * 64 + (m) * 16 + fr)

__device__ __forceinline__ int prow_of(int m) { return m + (m >> 12) * 128 + 128; }
#define EPI_NB (META ? BATCH : 1)
#define EPI_PROW(row, b) (META ? (size_t)((b) * TT + FRONT + (row)) : (size_t)prow_of(row))
#define EPI_MAIN_LOOP(CALL) _Pragma("unroll") for (int ai = 0; ai < 2; ++ai) _Pragma("unroll") for (int m = 0; m < 4; ++m) { asm volatile("" ::: "memory"); const int row = EPI_ROW(u, ai, m); \
        const f32x4 a_[2][2] = {{acc[ai][0][m][0], acc[ai][0][m][1]}, {acc[ai][1][m][0], acc[ai][1][m][1]}}; CALL; }

template <bool META> struct EpiIn {
    static constexpr bool PERM = false, AFTER_DRAIN = false, MIDSCALE = false;
    const float* hss; bf16_t *qa, *ka, *va, *qlat, *kvlat, *kr; float *ssq_q, *ssq_kv;
    __device__ __forceinline__ void mid(f32x4 (&)[2][2][4][2], const Unit&, int, int, int, int) const {}
    __device__ __forceinline__ void row_epi(const f32x4 (&a)[2][2], int row, int pn, int wc, int fr, int fq) const {
        const float rs = rsq(sum16(hss, row) * (1.0f / DM) + RMS_EPS);
        if (pn <= 2) {
            const bool is_kr = (pn == 2 && wc == 2);
            if (pn == 2 && wc == 3) return;
            const float pos = META ? (float)row : (float)((row & 4095) + NMETA);
#pragma unroll
            for (int n = 0; n < 2; ++n) {
                if (is_kr && n == 1) continue;
                const f32x4 x1 = a[0][n] * rs, x2 = a[1][n] * rs; f32x4 o1, o2;
#pragma unroll
                for (int e = 0; e < 4; ++e) { const float inv = is_kr ? __builtin_amdgcn_exp2f(-(float)(4 * fq + e) * (LOG2_THETA / 16.0f)) : __builtin_amdgcn_exp2f(-(float)(16 * n + 4 * fq + e) * (LOG2_THETA / 32.0f));
                    const float ang = pos * inv; float rev = ang * INV_2PI; rev = rev - floorf(rev);
                    const float sn = __builtin_amdgcn_sinf(rev), cs = __builtin_amdgcn_cosf(rev); o1[e] = x1[e] * cs - x2[e] * sn; o2[e] = x2[e] * cs + x1[e] * sn; }
#pragma unroll
                for (int b = 0; b < EPI_NB; ++b) { const size_t pr = EPI_PROW(row, b); bf16_t* d; int half;
                    if (pn < 2) { d = qa + pr * 512 + (4 * pn + wc) * 64 + 16 * n + 4 * fq; half = 32; }
                    else if (!is_kr) { d = ka + pr * 128 + wc * 64 + 16 * n + 4 * fq; half = 32; }
                    else { d = kr + pr * 32 + 4 * fq; half = 16; }
                    st_bf16x4(d, o1); st_bf16x4(d + half, o2); }
            }
        } else if (pn == 3) {
            float ss = 0.f;
#pragma unroll
            for (int n = 0; n < 2; ++n) { const int c = 32 * wc + 16 * n + 4 * fq; const f32x4 v = a[0][n] * rs, w = a[1][n] * rs;
#pragma unroll
                for (int b = 0; b < EPI_NB; ++b) st_bf16x4(va + EPI_PROW(row, b) * 128 + c, v);
                st_bf16x4(kvlat + (size_t)row * 128 + c, w); ss += sq4(w); }
            ss += __shfl_xor(ss, 16); ss += __shfl_xor(ss, 32);
            if (fq == 0) ((PG8_GAS float*)ssq_kv)[(size_t)row * 4 + wc] = ss;
        } else {
            float ss = 0.f;
#pragma unroll
            for (int bj = 0; bj < 2; ++bj)
#pragma unroll
                for (int n = 0; n < 2; ++n) { const int c = 128 * bj + 32 * wc + 16 * n + 4 * fq; const f32x4 v = a[bj][n] * rs; st_bf16x4(qlat + (size_t)row * 256 + c, v); ss += sq4(v); }
            ss += __shfl_xor(ss, 16); ss += __shfl_xor(ss, 32);
            if (fq == 0) ((PG8_GAS float*)ssq_q)[(size_t)row * 4 + wc] = ss;
        }
    }
    __device__ __forceinline__ void operator()(const f32x4 (&acc)[2][2][4][2], const Unit& u, int wr, int wc, int fr, int fq) const { EPI_MAIN_LOOP(row_epi(a_, row, u.pn, wc, fr, fq)) }
};

template <bool META> struct EpiQup {
    static constexpr bool PERM = false, AFTER_DRAIN = false, MIDSCALE = false;
    const float* ssq_q; bf16_t* qm;
    __device__ __forceinline__ void mid(f32x4 (&)[2][2][4][2], const Unit&, int, int, int, int) const {}
    __device__ __forceinline__ void row_epi(const f32x4 (&a)[2][2], int row, int pn, int wc, int fr, int fq) const {
        const float rs = rsq(sum4(ssq_q, row) * (1.0f / 256.0f) + RMS_EPS);
        if (pn < 2) {
#pragma unroll
            for (int bj = 0; bj < 2; ++bj)
#pragma unroll
                for (int n = 0; n < 2; ++n) { const int head = 4 * pn + 2 * bj + (wc >> 1), d = 32 * (wc & 1) + 16 * n + 4 * fq; const f32x4 v = a[bj][n] * rs;
#pragma unroll
                    for (int b = 0; b < EPI_NB; ++b) st_bf16x4(qm + EPI_PROW(row, b) * 768 + head * 96 + d, v); }
        } else {
            const float pos = META ? (float)row : (float)((row & 4095) + NMETA);
#pragma unroll
            for (int n = 0; n < 2; ++n) { const int head = 2 * wc + n; const f32x4 x1 = a[0][n] * rs, x2 = a[1][n] * rs; f32x4 o1, o2;
#pragma unroll
                for (int e = 0; e < 4; ++e) { const float inv = __builtin_amdgcn_exp2f(-(float)(4 * fq + e) * (LOG2_THETA / 16.0f)); const float ang = pos * inv; float rev = ang * INV_2PI; rev = rev - floorf(rev);
                    const float sn = __builtin_amdgcn_sinf(rev), cs = __builtin_amdgcn_cosf(rev); o1[e] = x1[e] * cs - x2[e] * sn; o2[e] = x2[e] * cs + x1[e] * sn; }
#pragma unroll
                for (int b = 0; b < EPI_NB; ++b) { bf16_t* qrow = qm + EPI_PROW(row, b) * 768; st_bf16x4(qrow + head * 96 + 64 + 4 * fq, o1); st_bf16x4(qrow + head * 96 + 80 + 4 * fq, o2); } }
        }
    }
    __device__ __forceinline__ void operator()(const f32x4 (&acc)[2][2][4][2], const Unit& u, int wr, int wc, int fr, int fq) const { EPI_MAIN_LOOP(row_epi(a_, row, u.pn, wc, fr, fq)) }
};

template <bool META> struct EpiKvup {
    static constexpr bool PERM = false, AFTER_DRAIN = false, MIDSCALE = false;
    const float* ssq_kv; bf16_t *kn, *vb;
    __device__ __forceinline__ void mid(f32x4 (&)[2][2][4][2], const Unit&, int, int, int, int) const {}
    __device__ __forceinline__ void row_epi(const f32x4 (&a)[2][2], int row, int pn, int wc, int fr, int fq) const {
        bf16_t* dst = (pn < 2 ? kn : vb) + (pn & 1) * 256;
        const float rs = rsq(sum4(ssq_kv, row) * (1.0f / 128.0f) + RMS_EPS);
#pragma unroll
        for (int bj = 0; bj < 2; ++bj)
#pragma unroll
            for (int n = 0; n < 2; ++n) { const f32x4 v = a[bj][n] * rs;
#pragma unroll
                for (int b = 0; b < EPI_NB; ++b) st_bf16x4(dst + EPI_PROW(row, b) * 512 + 128 * bj + 32 * wc + 16 * n + 4 * fq, v); }
    }
    __device__ __forceinline__ void operator()(const f32x4 (&acc)[2][2][4][2], const Unit& u, int wr, int wc, int fr, int fq) const { EPI_MAIN_LOOP(row_epi(a_, row, u.pn, wc, fr, fq)) }
};

struct EpiResid {
    static constexpr bool PERM = false, AFTER_DRAIN = false;
    float* H; bf16_t* HB; float* hss_out; const float* ssq_o;
    __device__ __forceinline__ void resid_row(const f32x4 (&a)[2][2], int row, float rs, int pn, int wc, int fr, int fq) const {
        float ss = 0.f;
#pragma unroll
        for (int bj = 0; bj < 2; ++bj)
#pragma unroll
            for (int n = 0; n < 2; ++n) { const size_t off = (size_t)row * DM + pn * BM + 128 * bj + 32 * wc + 16 * n + 4 * fq;
                const u32x2 hw = *(const PG8_GAS u32x2*)(HB + off); f32x4 hv; hv[0] = __builtin_bit_cast(float, hw.x << 16); hv[1] = __builtin_bit_cast(float, hw.x & 0xffff0000u); hv[2] = __builtin_bit_cast(float, hw.y << 16); hv[3] = __builtin_bit_cast(float, hw.y & 0xffff0000u);
                hv = hv + a[bj][n] * rs; st_bf16x4(HB + off, hv); ss += sq4(hv); }
        ss += __shfl_xor(ss, 16); ss += __shfl_xor(ss, 32);
        if (fq == 0) ((PG8_GAS float*)hss_out)[(size_t)row * 16 + 4 * pn + wc] = ss;
    }
    __device__ __forceinline__ void two_scales(size_t prow, float& f, float& rb) const {
        const PG8_GAS f32x4* p = (const PG8_GAS f32x4*)(ssq_o + prow * 16); const f32x4 a = p[0], b = p[1], c = p[2], d = p[3];
        const float sa = ((a.x + a.y) + (a.z + a.w)) + ((b.x + b.y) + (b.z + b.w)), sb = ((c.x + c.y) + (c.z + c.w)) + ((d.x + d.y) + (d.z + d.w));
        const float va = sa * (1.0f / 512.0f) + RMS_EPS, vb = sb * (1.0f / 512.0f) + RMS_EPS; f = sqrtf(vb / va); rb = rsq(vb);
    }
};
template <bool META> struct EpiOut : EpiResid {
    static constexpr bool MIDSCALE = true;
    PG8_LAS unsigned char* xlds;
    __device__ __forceinline__ void prep(const Unit& u, int wid, int wr, int lane) const {
        PG8_LAS float* tab = (PG8_LAS float*)(xlds + wid * 1024);
#pragma unroll
        for (int j = 0; j < 2; ++j) { const int idx = lane + 64 * j; const int row = u.pm * BM + (idx >> 6) * HALF + wr * 64 + (idx & 63);
            float f, rb; two_scales((size_t)prow_of(row), f, rb); tab[2 * idx] = f; tab[2 * idx + 1] = rb; }
    }
    __device__ __forceinline__ void mid(f32x4 (&acc)[2][2][4][2], const Unit& u, int wr, int wc, int fr, int fq) const {
        const int wid = wr * 4 + wc; const PG8_LAS float* tab = (const PG8_LAS float*)(xlds + wid * 1024);
#pragma unroll
        for (int ai = 0; ai < 2; ++ai)
#pragma unroll
            for (int m = 0; m < 4; ++m) {
                const float f = tab[2 * (ai * 64 + m * 16 + fr)];
#pragma unroll
                for (int bj = 0; bj < 2; ++bj)
#pragma unroll
                    for (int n = 0; n < 2; ++n) acc[ai][bj][m][n] *= f;
            }
    }
    __device__ __forceinline__ void operator()(const f32x4 (&acc)[2][2][4][2], const Unit& u, int wr, int wc, int fr, int fq) const {
        const PG8_LAS float* tab = (const PG8_LAS float*)(xlds + (wr * 4 + wc) * 1024);
        EPI_MAIN_LOOP(resid_row(a_, row, tab[2 * (ai * 64 + m * 16 + fr) + 1], u.pn, wc, fr, fq))
    }
    __device__ __forceinline__ void mid_row(f32x4 (&a)[2][2], int row) const { float f, rb; two_scales((size_t)(FRONT + row), f, rb);
#pragma unroll
        for (int bj = 0; bj < 2; ++bj)
#pragma unroll
            for (int n = 0; n < 2; ++n) a[bj][n] *= f; }
    __device__ __forceinline__ void row_epi(const f32x4 (&a)[2][2], int row, int pn, int wc, int fr, int fq) const { float f, rb; two_scales((size_t)(FRONT + row), f, rb); resid_row(a, row, rb, pn, wc, fr, fq); }
};
template <bool META> struct EpiDown : EpiResid {
    static constexpr bool MIDSCALE = false;
    __device__ __forceinline__ void mid(f32x4 (&)[2][2][4][2], const Unit&, int, int, int, int) const {}
    __device__ __forceinline__ void row_epi(const f32x4 (&a)[2][2], int row, int pn, int wc, int fr, int fq) const { resid_row(a, row, 1.0f, pn, wc, fr, fq); }
    __device__ __forceinline__ void operator()(const f32x4 (&acc)[2][2][4][2], const Unit& u, int wr, int wc, int fr, int fq) const { EPI_MAIN_LOOP(resid_row(a_, row, 1.0f, u.pn, wc, fr, fq)) }
};

template <bool META> struct EpiGU {
    static constexpr bool PERM = false, AFTER_DRAIN = false, MIDSCALE = false;
    const float* hss; bf16_t* act;
    __device__ __forceinline__ void mid(f32x4 (&)[2][2][4][2], const Unit&, int, int, int, int) const {}
    __device__ __forceinline__ void row_epi(const f32x4 (&a)[2][2], int row, int pn, int wc, int fr, int fq) const {
        const float rs = rsq(sum16(hss, row) * (1.0f / DM) + RMS_EPS);
#pragma unroll
        for (int n = 0; n < 2; ++n) { const f32x4 g = a[0][n] * rs, up = a[1][n] * rs; f32x4 o;
#pragma unroll
            for (int e = 0; e < 4; ++e) o[e] = g[e] * up[e] * __builtin_amdgcn_rcpf(1.0f + __builtin_amdgcn_exp2f(-g[e] * LOG2E));
            st_bf16x4(act + (size_t)row * DFF + 128 * pn + 32 * wc + 16 * n + 4 * fq, o); }
    }
    __device__ __forceinline__ void operator()(const f32x4 (&acc)[2][2][4][2], const Unit& u, int wr, int wc, int fr, int fq) const { EPI_MAIN_LOOP(row_epi(a_, row, u.pn, wc, fr, fq)) }
};

template <int K, class Epi>
__device__ __forceinline__ void skinny_phase(PG8_LAS unsigned char* lds, const bf16_t* A16, const bf16_t* Bt, int NN, const Epi& E, int wg0) {
    int tid_ = threadIdx.x; asm volatile("" : "+v"(tid_));
    const int tid = tid_, lane = tid & 63, wid = __builtin_amdgcn_readfirstlane(tid >> 6), fr = lane & 15, fq = lane >> 4;
    constexpr int nk = K / 32, NJ = (nk + 7) / 8;
    const int G = (int)gridDim.x; int first = (int)blockIdx.x - wg0; if (first < 0) first += G;
    for (int task = first; task < 4 * NN; task += G) {
        const int pn = task >> 2, wc = task & 3;
        f32x4 a[2][2];
#pragma unroll
        for (int bj = 0; bj < 2; ++bj)
#pragma unroll
            for (int n = 0; n < 2; ++n) a[bj][n] = (f32x4){0.f, 0.f, 0.f, 0.f};
        bool scaled = false;
        const bf16_t* ap = A16 + (size_t)fr * K + 8 * fq;
        const bf16_t* bp = Bt + (size_t)(256 * pn + 32 * wc + fr) * K + 8 * fq;
#pragma unroll 4
        for (int j = 0; j < NJ; ++j) {
            const int it = wid + 8 * j; if (it >= nk) break;
            const int k0 = 32 * it;
            if constexpr (Epi::MIDSCALE) { if (!scaled && k0 >= (K >> 1)) { E.mid_row(a, fr); scaled = true; } }
            const bf16x8 av = *(const PG8_GAS bf16x8*)(ap + k0);
#pragma unroll
            for (int bj = 0; bj < 2; ++bj)
#pragma unroll
                for (int n = 0; n < 2; ++n) { const bf16x8 bv = *(const PG8_GAS bf16x8*)(bp + (size_t)(128 * bj + 16 * n) * K + k0);
                    a[bj][n] = __builtin_amdgcn_mfma_f32_16x16x32_bf16(bv, av, a[bj][n], 0, 0, 0); }
        }
        if constexpr (Epi::MIDSCALE) { if (!scaled) E.mid_row(a, fr); }
        PG8_LAS f32x4* red = (PG8_LAS f32x4*)lds;
#pragma unroll
        for (int bj = 0; bj < 2; ++bj)
#pragma unroll
            for (int n = 0; n < 2; ++n) red[(wid * 64 + lane) * 4 + bj * 2 + n] = a[bj][n];
        __syncthreads();
        if (wid == 0) {
#pragma unroll
            for (int w = 1; w < 8; ++w)
#pragma unroll
                for (int bj = 0; bj < 2; ++bj)
#pragma unroll
                    for (int n = 0; n < 2; ++n) a[bj][n] += red[(w * 64 + lane) * 4 + bj * 2 + n];
            E.row_epi(a, fr, pn, wc, fr, fq);
        }
        __syncthreads();
    }
}
template <class Epi, class Sched, bool ALIGN_EPI = false, bool SP2 = false>
__device__ __forceinline__ void gemm_phase(PG8_LAS unsigned char* lds, const Gemm g, const Sched& S, const Epi& E) {
    int tid_ = threadIdx.x; asm volatile("" : "+v"(tid_));
    const int tid = tid_, wid = __builtin_amdgcn_readfirstlane(tid >> 6), lane = tid & 63, wr = wid >> 2, wc = wid & 3, fr = lane & 15, fq = lane >> 4;
    int K_ = g.K; asm volatile("" : "+s"(K_)); const int K = K_, nt = K / BK;
    unsigned voffA[2], voffB[2];
#pragma unroll
    for (int i = 0; i < 2; ++i) { int R, C; stage_rc(tid * 16 + i * 8192, R, C); const int Rb = Epi::PERM ? ((R & ~31) + perm32(R & 31)) : R;
        voffA[i] = (unsigned)(R * K + C) * 2u; voffB[i] = (unsigned)(Rb * K + C) * 2u; }
    const size_t kstep = (size_t)(BK * 2);
    const size_t hstep = (size_t)HALF * K * 2;
    const size_t tstep = 2 * hstep;
    const unsigned ldsw = (unsigned)wid * 1024u;
    const int aoff = lds_byte(wr * 64 + fr, fq * 8), boff = lds_byte(wc * 32 + fr, fq * 8);
#define PG8_SA(b, h) (((b) * 2 + (h)) * HTB)
#define PG8_SB(b, h) ((4 + (b) * 2 + (h)) * HTB)
#define PG8_STAGE(bufoff, gbase, voff) do { _Pragma("unroll") for (int _i = 0; _i < 2; ++_i) \
        __builtin_amdgcn_global_load_lds((const unsigned*)((const char*)(gbase) + (voff)[_i]), (PG8_LAS unsigned*)(lds + (bufoff) + ldsw + _i * 8192), 16, 0, 0); } while (0)
#define PG8_LDA(dst, b, h) do { _Pragma("unroll") for (int m = 0; m < 4; ++m) _Pragma("unroll") for (int k = 0; k < 2; ++k) dst[m][k] = *(const PG8_LAS bf16x8*)(lds + PG8_SA(b, h) + aoff + m * 2048 + k * 1024); } while (0)
#define PG8_LDB(dst, b, h) do { _Pragma("unroll") for (int n = 0; n < 2; ++n) _Pragma("unroll") for (int k = 0; k < 2; ++k) dst[n][k] = *(const PG8_LAS bf16x8*)(lds + PG8_SB(b, h) + boff + n * 2048 + k * 1024); } while (0)
#define PG8_MMA(ai, bj, At, Bt) do { __builtin_amdgcn_s_setprio(1); _Pragma("unroll") for (int m = 0; m < 4; ++m) _Pragma("unroll") for (int n = 0; n < 2; ++n) _Pragma("unroll") for (int k = 0; k < 2; ++k) \
        acc[ai][bj][m][n] = __builtin_amdgcn_mfma_f32_16x16x32_bf16(Bt[n][k], At[m][k], acc[ai][bj][m][n], 0, 0, 0); __builtin_amdgcn_s_setprio(0); } while (0)
#define PG8_WAIT_V(n) asm volatile("s_waitcnt vmcnt(" #n ")" ::: "memory")
#define PG8_WAIT_L(n) asm volatile("s_waitcnt lgkmcnt(" #n ")" ::: "memory")
#define PG8_BAR __builtin_amdgcn_s_barrier()
#define PG8_SCHED __builtin_amdgcn_sched_barrier(0)
    Unit cur, nxt; int ui = 0;
    if (!S.next(0, cur)) return;
    f32x4 acc[2][2][4][2];
#pragma unroll
    for (int a = 0; a < 2; ++a)
#pragma unroll
        for (int b = 0; b < 2; ++b)
#pragma unroll
            for (int m = 0; m < 4; ++m)
#pragma unroll
                for (int n = 0; n < 2; ++n) acc[a][b][m][n] = (f32x4){0.f, 0.f, 0.f, 0.f};
    bf16x8 At[4][2], B0[2][2], B1[2][2];
    const char* cA = (const char*)g.A + (size_t)cur.pm * tstep + (g.apad ? (size_t)((cur.pm >> 4) * 128 + 128) * (size_t)K * 2 : (size_t)0); const char* cB = (const char*)g.Bt + (size_t)cur.pn * tstep;
    S.a_ready(cur);
    if constexpr (SP2) {
        PG8_STAGE(PG8_SB(0, 0), cB, voffB); PG8_STAGE(PG8_SB(0, 1), cB + hstep, voffB); PG8_STAGE(PG8_SA(0, 0), cA, voffA); PG8_STAGE(PG8_SA(0, 1), cA + hstep, voffA);
        if (wr == 1) PG8_BAR;
        PG8_WAIT_V(2); PG8_BAR;
        PG8_STAGE(PG8_SB(1, 0), cB + kstep, voffB); PG8_STAGE(PG8_SA(1, 0), cA + kstep, voffA); PG8_STAGE(PG8_SB(1, 1), cB + hstep + kstep, voffB);
        PG8_WAIT_V(6); PG8_BAR;
    } else {
        PG8_STAGE(PG8_SB(0, 0), cB, voffB); PG8_STAGE(PG8_SA(0, 0), cA, voffA); PG8_STAGE(PG8_SB(0, 1), cB + hstep, voffB); PG8_STAGE(PG8_SA(0, 1), cA + hstep, voffA);
        if (wr == 1) PG8_BAR;
        PG8_WAIT_V(4); PG8_BAR;
        PG8_STAGE(PG8_SB(1, 0), cB + kstep, voffB); PG8_STAGE(PG8_SA(1, 0), cA + kstep, voffA); PG8_STAGE(PG8_SB(1, 1), cB + hstep + kstep, voffB);
        PG8_WAIT_V(6); PG8_BAR;
    }
    for (;;) {
        const bool has_next = S.next(ui + 1, nxt);
        if constexpr (Epi::MIDSCALE) E.prep(cur, wid, wr, lane);
        const char* nA = has_next ? (const char*)g.A + (size_t)nxt.pm * tstep + (g.apad ? (size_t)((nxt.pm >> 4) * 128 + 128) * (size_t)K * 2 : (size_t)0) : cA; const char* nB = has_next ? (const char*)g.Bt + (size_t)nxt.pn * tstep : cB;
        for (int t = 0; t < nt; t += 2) {
            const bool last = (t == nt - 2);
            if constexpr (Epi::MIDSCALE) { if (t == (nt >> 1)) E.mid(acc, cur, wr, wc, fr, fq); }
            const char* a1 = cA + (size_t)(t + 1) * kstep;
            const char* a2 = last ? nA : cA + (size_t)(t + 2) * kstep; const char* b2 = last ? nB : cB + (size_t)(t + 2) * kstep;
            const char* a3 = a2 + kstep; const char* b3 = b2 + kstep;
            if (last && has_next) S.a_ready(nxt);
            if constexpr (SP2) {
            PG8_LDB(B0, 0, 0); PG8_LDB(B1, 0, 1); PG8_SCHED; PG8_LDA(At, 0, 0); PG8_STAGE(PG8_SA(1, 1), a1 + hstep, voffA);
            PG8_WAIT_V(8); PG8_WAIT_L(0); PG8_BAR; PG8_MMA(0, 0, At, B0); PG8_MMA(0, 1, At, B1); PG8_BAR; PG8_SCHED;
            PG8_LDA(At, 0, 1); PG8_STAGE(PG8_SB(0, 0), b2, voffB); PG8_STAGE(PG8_SB(0, 1), b2 + hstep, voffB); PG8_STAGE(PG8_SA(0, 0), a2, voffA);
            PG8_WAIT_V(8); PG8_WAIT_L(0); PG8_BAR; PG8_MMA(1, 0, At, B0); PG8_MMA(1, 1, At, B1); PG8_BAR; PG8_SCHED;
            PG8_LDB(B0, 1, 0); PG8_LDB(B1, 1, 1); PG8_SCHED; PG8_LDA(At, 1, 0); PG8_STAGE(PG8_SA(0, 1), a2 + hstep, voffA);
            PG8_WAIT_V(8); PG8_WAIT_L(0); PG8_BAR; PG8_MMA(0, 0, At, B0); PG8_MMA(0, 1, At, B1); PG8_BAR; PG8_SCHED;
            PG8_LDA(At, 1, 1); PG8_STAGE(PG8_SB(1, 0), b3, voffB); PG8_STAGE(PG8_SB(1, 1), b3 + hstep, voffB); PG8_STAGE(PG8_SA(1, 0), a3, voffA);
            PG8_WAIT_V(8); PG8_WAIT_L(0); PG8_BAR; PG8_MMA(1, 0, At, B0); PG8_MMA(1, 1, At, B1); PG8_BAR; PG8_SCHED;
            } else {
            PG8_LDB(B0, 0, 0); PG8_SCHED; PG8_LDA(At, 0, 0); PG8_STAGE(PG8_SA(1, 1), a1 + hstep, voffA);
            PG8_WAIT_L(8); PG8_BAR; PG8_WAIT_L(0); PG8_MMA(0, 0, At, B0); PG8_BAR; PG8_SCHED;
            PG8_LDB(B1, 0, 1); PG8_STAGE(PG8_SB(0, 0), b2, voffB);
            PG8_BAR; PG8_WAIT_L(0); PG8_MMA(0, 1, At, B1); PG8_BAR;
            PG8_LDA(At, 0, 1); PG8_STAGE(PG8_SA(0, 0), a2, voffA);
            PG8_BAR; PG8_WAIT_L(0); PG8_MMA(1, 0, At, B0); PG8_BAR; PG8_SCHED;
            PG8_STAGE(PG8_SB(0, 1), b2 + hstep, voffB);
            PG8_WAIT_V(6); PG8_BAR; PG8_MMA(1, 1, At, B1); PG8_BAR;
            PG8_LDB(B0, 1, 0); PG8_SCHED; PG8_LDA(At, 1, 0); PG8_STAGE(PG8_SA(0, 1), a2 + hstep, voffA);
            PG8_WAIT_L(8); PG8_BAR; PG8_WAIT_L(0); PG8_MMA(0, 0, At, B0); PG8_BAR; PG8_SCHED;
            PG8_LDB(B1, 1, 1); PG8_STAGE(PG8_SB(1, 0), b3, voffB);
            PG8_BAR; PG8_WAIT_L(0); PG8_MMA(0, 1, At, B1); PG8_BAR;
            PG8_LDA(At, 1, 1); PG8_STAGE(PG8_SA(1, 0), a3, voffA);
            PG8_BAR; PG8_WAIT_L(0); PG8_MMA(1, 0, At, B0); PG8_BAR; PG8_SCHED;
            PG8_STAGE(PG8_SB(1, 1), b3 + hstep, voffB);
            PG8_WAIT_V(6); PG8_BAR; PG8_MMA(1, 1, At, B1); PG8_BAR;
            }
        }
        if constexpr (ALIGN_EPI) { if (wr == 0) PG8_BAR; }
        if constexpr (!Epi::AFTER_DRAIN) { E(acc, cur, wr, wc, fr, fq); S.done(cur); }
        if (!has_next) break;
#pragma unroll
        for (int a = 0; a < 2; ++a)
#pragma unroll
            for (int b = 0; b < 2; ++b)
#pragma unroll
                for (int m = 0; m < 4; ++m)
#pragma unroll
                    for (int n = 0; n < 2; ++n) acc[a][b][m][n] = (f32x4){0.f, 0.f, 0.f, 0.f};
        cur = nxt; cA = nA; cB = nB; ++ui;
        if constexpr (ALIGN_EPI) { if (wr == 1) PG8_BAR; }
    }
    PG8_WAIT_V(0);
    if constexpr (!ALIGN_EPI) { if (wr == 0) PG8_BAR; }
    PG8_BAR;
    if constexpr (Epi::AFTER_DRAIN) { E.fused(acc, cur, wr, wc, fr, fq, lds, wid, lane); S.done(cur); }
#undef PG8_SA
#undef PG8_SB
#undef PG8_STAGE
#undef PG8_LDA
#undef PG8_LDB
#undef PG8_MMA
#undef PG8_WAIT_V
#undef PG8_WAIT_L
#undef PG8_BAR
#undef PG8_SCHED
}
}
namespace att {
#define ALAS __attribute__((address_space(3)))
#define AGAS __attribute__((address_space(1)))
typedef unsigned short bf16_t;
typedef short bf16x8 __attribute__((ext_vector_type(8)));
typedef short s16x4 __attribute__((ext_vector_type(4)));
typedef float f32x16 __attribute__((ext_vector_type(16)));
typedef unsigned u32x4 __attribute__((ext_vector_type(4)));
typedef float f32x2_t __attribute__((ext_vector_type(2))); typedef __bf16 bf16x2_t __attribute__((ext_vector_type(2)));
constexpr int KPMAX = 208, VP = 192, KSZ = 64 * KPMAX, VSZ = 64 * VP;
constexpr int OFF_V = 2 * KSZ, OFF_SCR = OFF_V + 2 * VSZ, OFF_Q = OFF_SCR + 8 * 256, LDS_BYTES = OFF_Q + 64;
constexpr float NEGF = -1e30f, THR = 6.0f;
__device__ __forceinline__ int crow(int r, int hi) { return (r & 3) + 8 * (r >> 2) + 4 * hi; }
__device__ __forceinline__ unsigned cvtpk(float lo, float hi) { f32x2_t v = {lo, hi}; bf16x2_t b = __builtin_convertvector(v, bf16x2_t); return __builtin_bit_cast(unsigned, b); }
__device__ __forceinline__ bf16x8 pack8(const f32x16& p, int s) { u32x4 w; w.x = cvtpk(p[8 * s], p[8 * s + 1]); w.y = cvtpk(p[8 * s + 2], p[8 * s + 3]); w.z = cvtpk(p[8 * s + 4], p[8 * s + 5]); w.w = cvtpk(p[8 * s + 6], p[8 * s + 7]); return __builtin_bit_cast(bf16x8, w); }
typedef short v4i16_t __attribute__((ext_vector_type(4)));
__device__ __forceinline__ float max3f(float a, float b, float c) { float r; asm("v_max3_f32 %0, %1, %2, %3" : "=v"(r) : "v"(a), "v"(b), "v"(c)); return r; }
__device__ __forceinline__ float max2f(float a, float b) { float r; asm("v_max_f32_e32 %0, %1, %2" : "=v"(r) : "v"(a), "v"(b)); return r; }
__device__ __forceinline__ float xhalf_max(float m) { auto rr = __builtin_amdgcn_permlane32_swap(__float_as_uint(m), __float_as_uint(m), false, false); return max2f(__uint_as_float(rr[0]), __uint_as_float(rr[1])); }
__device__ __forceinline__ s16x4 vtr(const ALAS unsigned char* p) { return __builtin_bit_cast(s16x4, __builtin_amdgcn_ds_read_tr16_b64_v4i16((ALAS v4i16_t*)p)); }
__device__ __forceinline__ unsigned short f2bf(float f) { unsigned u = __builtin_bit_cast(unsigned, f); return (unsigned short)((u + 0x7fffu + ((u >> 16) & 1u)) >> 16); }

template <int DQK, bool SWA>
__device__ __forceinline__ void attn_unit(ALAS unsigned char* lds, const bf16_t* Qp, int qpitch, const bf16_t* Kp, int kpitch, const bf16_t* Krp, const bf16_t* Vp, int vpitch,
                                          bf16_t* Op, float* ssq, float sink2, int b, int qb) {
    constexpr int KP = DQK * 2 + 16, NS = DQK / 16;
    int tid_ = threadIdx.x; asm volatile("" : "+v"(tid_));
    const int tid = tid_, lane = tid & 63, wid = __builtin_amdgcn_readfirstlane(tid >> 6), r = lane & 31, h = lane >> 5;
    const size_t rowbase = (size_t)b * TT;
    const int q0 = qb * 256, q0w = q0 + wid * 32;
    const bool wave_valid = q0w < TT;
    const int NT = (q0 + 256) / 64 < TT / 64 ? (q0 + 256) / 64 : TT / 64;
    int t0 = 1; if (SWA) { t0 = (q0 - 128) / 64; if (t0 < 1) t0 = 1; }
    ALAS float* scr = (ALAS float*)(lds + OFF_SCR + wid * 256);
    bf16x8 qf[NS];
    { const int qr = (q0w + r) < TT ? (q0w + r) : TT - 1; const bf16_t* qrow = Qp + (rowbase + qr) * (size_t)qpitch;
#pragma unroll
      for (int s = 0; s < NS; ++s) qf[s] = *(const AGAS bf16x8*)(qrow + 16 * s + 8 * h); }
    const int srow = tid >> 3, sch = tid & 7, rrow = (tid >> 2) & 63, rch = tid & 3;
    u32x4 kregA, vregA, rregA = {0u, 0u, 0u, 0u}, kregB, vregB, rregB = {0u, 0u, 0u, 0u};
#define AT_GLOAD(t, S) do { const size_t kr_ = rowbase + 64 * (t) + srow; kreg##S = *(const AGAS u32x4*)(Kp + kr_ * (size_t)kpitch + sch * 8); vreg##S = *(const AGAS u32x4*)(Vp + kr_ * (size_t)vpitch + sch * 8); \
        if (DQK == 96) { if (tid < 256) rreg##S = *(const AGAS u32x4*)(Krp + (rowbase + 64 * (t) + rrow) * 32 + rch * 8); } } while (0)
#define AT_LSTORE(buf, S) do { *(ALAS u32x4*)(lds + (buf) * KSZ + srow * KP + sch * 16) = kreg##S; *(ALAS u32x4*)(lds + OFF_V + (buf) * VSZ + srow * VP + sch * 16) = vreg##S; \
        if (DQK == 96) { if (tid < 256) *(ALAS u32x4*)(lds + (buf) * KSZ + rrow * KP + 128 + rch * 16) = rreg##S; } } while (0)
    AT_GLOAD(t0, A); AT_LSTORE(0, A);
    if (t0 + 1 < NT) AT_GLOAD(t0 + 1, A);
    __syncthreads();
    float mrun = SWA ? sink2 : 0.0f, lrun = (SWA && h == 0) ? 1.0f : 0.0f;
    bool first_ = !SWA;
    f32x16 negm;
#pragma unroll
    for (int i = 0; i < 16; ++i) negm[i] = -mrun;
    f32x16 o0, o1;
#pragma unroll
    for (int i = 0; i < 16; ++i) { o0[i] = 0.f; o1[i] = 0.f; }
    const int q = q0w + r;
#define AT_PVF(P, j) do { o0 = __builtin_amdgcn_mfma_f32_32x32x16_bf16(P, __builtin_shufflevector(vlo[2 * (j)], vhi[2 * (j)], 0, 1, 2, 3, 4, 5, 6, 7), o0, 0, 0, 0); o1 = __builtin_amdgcn_mfma_f32_32x32x16_bf16(P, __builtin_shufflevector(vlo[2 * (j) + 1], vhi[2 * (j) + 1], 0, 1, 2, 3, 4, 5, 6, 7), o1, 0, 0, 0); } while (0)
#define AT_PV(P, rowoff) do { \
                { const s16x4 lo = vtr(vb_ + (rowoff) * VP), hi = vtr(vb_ + ((rowoff) + 8) * VP); const bf16x8 vf = __builtin_shufflevector(lo, hi, 0, 1, 2, 3, 4, 5, 6, 7); o0 = __builtin_amdgcn_mfma_f32_32x32x16_bf16(P, vf, o0, 0, 0, 0); } \
                { const s16x4 lo = vtr(vb_ + (rowoff) * VP + 64), hi = vtr(vb_ + ((rowoff) + 8) * VP + 64); const bf16x8 vf = __builtin_shufflevector(lo, hi, 0, 1, 2, 3, 4, 5, 6, 7); o1 = __builtin_amdgcn_mfma_f32_32x32x16_bf16(P, vf, o1, 0, 0, 0); } } while (0)
#define AT_STEP(t, LS, SS) do { \
        const int buf = (t - t0) & 1; \
        if (t + 2 < NT) AT_GLOAD(t + 2, LS); \
        const int kfirst = 64 * t; \
        bool active = wave_valid && (kfirst <= q0w + 31); \
        if (SWA) active = active && (kfirst + 63 >= q0w - 127); \
        if (active) { \
            f32x16 s0, s1; \
            const ALAS unsigned char* kb = lds + buf * KSZ + r * KP + h * 16; \
            bf16x8 kf[2 * NS]; \
_Pragma("unroll") \
            for (int s = 0; s < NS; ++s) { kf[2 * s] = *(const ALAS bf16x8*)(kb + s * 32); kf[2 * s + 1] = *(const ALAS bf16x8*)(kb + 32 * KP + s * 32); } \
            __builtin_amdgcn_sched_barrier(0); \
_Pragma("unroll") \
            for (int s = 0; s < NS; ++s) { if (s == 0) { s0 = __builtin_amdgcn_mfma_f32_32x32x16_bf16(kf[0], qf[0], negm, 0, 0, 0); s1 = __builtin_amdgcn_mfma_f32_32x32x16_bf16(kf[1], qf[0], negm, 0, 0, 0); } else { s0 = __builtin_amdgcn_mfma_f32_32x32x16_bf16(kf[2 * s], qf[s], s0, 0, 0, 0); s1 = __builtin_amdgcn_mfma_f32_32x32x16_bf16(kf[2 * s + 1], qf[s], s1, 0, 0, 0); } } \
            __builtin_amdgcn_sched_barrier(0); \
            const ALAS unsigned char* vb_ = lds + OFF_V + buf * VSZ + (4 * h + ((lane & 15) >> 2)) * VP + ((lane >> 4) & 1) * 32 + (lane & 3) * 8; \
            s16x4 vlo[8], vhi[8]; \
_Pragma("unroll") \
            for (int j = 0; j < 4; ++j) { vlo[2 * j] = vtr(vb_ + (16 * j) * VP); vhi[2 * j] = vtr(vb_ + (16 * j + 8) * VP); vlo[2 * j + 1] = vtr(vb_ + (16 * j) * VP + 64); vhi[2 * j + 1] = vtr(vb_ + (16 * j + 8) * VP + 64); } \
            __builtin_amdgcn_sched_barrier(0); \
            const bool need_mask = SWA || (t == 1) || (kfirst + 63 > q0w); \
            if (need_mask) { \
_Pragma("unroll") \
                for (int i = 0; i < 16; ++i) { const int key = kfirst + crow(i, h), key1 = key + 32; \
                    bool ok0 = (key <= q) && (key >= FRONT), ok1 = (key1 <= q) && (key1 >= FRONT); \
                    if (SWA) { ok0 = ok0 && (q - key < 128); ok1 = ok1 && (q - key1 < 128); } \
                    s0[i] = ok0 ? s0[i] : NEGF; s1[i] = ok1 ? s1[i] : NEGF; } \
            } \
            float rm = max3f(s0[0], s0[1], s1[0]), rm2 = max3f(s0[2], s0[3], s1[1]); rm = max3f(rm, s1[2], s1[3]); \
_Pragma("unroll") \
            for (int i = 4; i < 16; i += 4) { rm = max3f(rm, s0[i], s0[i + 1]); rm2 = max3f(rm2, s0[i + 2], s0[i + 3]); rm = max3f(rm, s1[i], s1[i + 1]); rm2 = max3f(rm2, s1[i + 2], s1[i + 3]); } \
            rm = xhalf_max(max2f(rm, rm2)); \
            if (first_ || __any(rm > THR)) { \
                const float dl = first_ ? (rm > -1e29f ? rm : 0.f) : max2f(rm, 0.f); first_ = false; \
                mrun += dl; const float f = __builtin_amdgcn_exp2f(-dl); lrun *= f; \
_Pragma("unroll") \
                for (int i = 0; i < 16; ++i) { s0[i] -= dl; s1[i] -= dl; negm[i] = -mrun; } \
                if (h == 0) scr[r] = f; \
_Pragma("unroll") \
                for (int i = 0; i < 16; ++i) { const float fi = scr[crow(i, h)]; o0[i] *= fi; o1[i] *= fi; } \
            } \
            float ls = 0.f; \
_Pragma("unroll") \
            for (int i = 0; i < 16; ++i) { s0[i] = __builtin_amdgcn_exp2f(s0[i]); s1[i] = __builtin_amdgcn_exp2f(s1[i]); ls += s0[i] + s1[i]; } \
            lrun += ls; \
            const bf16x8 p0 = pack8(s0, 0), p1 = pack8(s0, 1), p2 = pack8(s1, 0), p3 = pack8(s1, 1); \
            __builtin_amdgcn_sched_barrier(0); \
            AT_PVF(p0, 0); AT_PVF(p1, 1); AT_PVF(p2, 2); AT_PVF(p3, 3); \
        } \
        if (t + 1 < NT) AT_LSTORE(buf ^ 1, SS); \
        __syncthreads(); \
    } while (0)
    {
        int t = t0;
        for (; t + 1 < NT; t += 2) { AT_STEP(t, B, A); const int t1 = t + 1; AT_STEP(t1, A, B); }
        if (t < NT) AT_STEP(t, B, A);
    }
#undef AT_STEP
#undef AT_PV
#undef AT_GLOAD
#undef AT_LSTORE
    if (wave_valid) {
        const float lt = lrun + __shfl_xor(lrun, 32);
        if (h == 0) scr[32 + r] = lt;
#pragma unroll
        for (int i = 0; i < 16; ++i) {
            const float li = scr[32 + crow(i, h)], inv = li > 0.f ? 1.0f / li : 0.f;
            const float a = o0[i] * inv, c = o1[i] * inv; const size_t row = rowbase + q0w + crow(i, h);
            ((AGAS bf16_t*)Op)[row * 1024 + r] = f2bf(a); ((AGAS bf16_t*)Op)[row * 1024 + 32 + r] = f2bf(c);
            float ss = a * a + c * c;
            ss += __shfl_xor(ss, 1); ss += __shfl_xor(ss, 2); ss += __shfl_xor(ss, 4); ss += __shfl_xor(ss, 8); ss += __shfl_xor(ss, 16);
            if (r == 0) ((AGAS float*)ssq)[row * 16] = ss;
        }
    }
    __syncthreads();
}
}
typedef unsigned short bf16;
#define LAS __attribute__((address_space(3)))
#define GAS __attribute__((address_space(1)))
constexpr size_t MiB = 1u << 20;
constexpr int NWAVES = 8, NTHREADS = 512;
constexpr int LDS_BYTES = 147456;
static_assert(att::LDS_BYTES <= 131072, "attention LDS");
constexpr size_t WS_CTL = 0, CTL_BYTES = 65536;
constexpr size_t WS_H = 1 * MiB;
constexpr size_t WS_HB = WS_H + (size_t)MROWS * DM * 4;
constexpr size_t WS_W = WS_HB + (size_t)MROWS * DM * 2;
constexpr size_t WL_IN = 0, WL_Q = WL_IN + (size_t)INP * DM * 2, WL_KV = WL_Q + (size_t)768 * 256 * 2, WL_O = WL_KV + (size_t)1024 * 128 * 2,
                 WL_GU = WL_O + (size_t)DM * DM * 2, WL_D = WL_GU + (size_t)GUP * DM * 2, WL_END = WL_D + (size_t)DM * DFF * 2;
constexpr size_t WBUF = 22 * MiB;
static_assert(WL_END <= WBUF, "weight buffer");
constexpr size_t WS_PART = WS_W + 2 * WBUF;
constexpr size_t P_HSSA = 0, P_HSSB = P_HSSA + (size_t)MROWS * 64, P_SSQO = P_HSSB + (size_t)MROWS * 64, P_SSQQ = P_SSQO + (size_t)MROWS * 64, P_SSQKV = P_SSQQ + (size_t)MROWS * 16, P_END = P_SSQKV + (size_t)MROWS * 16;
constexpr size_t PM_H = (P_END + 255) & ~(size_t)255, PM_HB = PM_H + 16 * DM * 4, PM_HSSA = PM_HB + 16 * DM * 2, PM_HSSB = PM_HSSA + 1024, PM_SSQQ = PM_HSSB + 1024, PM_SSQKV = PM_SSQQ + 256,
                 PM_QLAT = PM_SSQKV + 256, PM_KVLAT = PM_QLAT + 16 * 256 * 2, PM_ACT = PM_KVLAT + 16 * 128 * 2, PM_END = PM_ACT + 16 * DFF * 2;
static_assert(PM_END <= 8 * MiB, "partials");
constexpr int MC = BATCH * SEQ;
constexpr size_t WS_R = WS_PART + 8 * MiB;
constexpr size_t R_QA = 0, R_KA = R_QA + (size_t)MROWS * 512 * 2, R_VA = R_KA + (size_t)MROWS * 128 * 2, R_QLAT = R_VA + (size_t)MROWS * 128 * 2, R_KVLAT = R_QLAT + (size_t)MROWS * 256 * 2,
                 R_KR = R_KVLAT + (size_t)MROWS * 128 * 2, R_QM = R_KR + (size_t)MROWS * 32 * 2, R_KN = R_QM + (size_t)MROWS * 768 * 2, R_VB = R_KN + (size_t)MROWS * 512 * 2,
                 R_O = R_VB + (size_t)MROWS * 512 * 2, R_END = R_O + (size_t)MROWS * 1024 * 2;
constexpr size_t R_ACT = 0;
static_assert((size_t)MROWS * DFF * 2 <= R_END, "act overlay");
constexpr size_t WS_END = WS_R + R_END;
static_assert(WS_END <= 512 * MiB, "workspace must fit 512 MiB");

struct Args {
    const float *x, *meta, *attn_norm, *w_in, *q_norm, *w_q_up, *kv_norm, *w_kv_up, *sinks, *out_norm_swa, *out_norm_mla, *w_o, *ffn_norm, *w_gate, *w_up, *w_down, *final_norm;
    float* out; unsigned char* ws; int ph_lo, ph_hi;
};

__device__ __forceinline__ unsigned f2bf_u(float f) { unsigned u = __builtin_bit_cast(unsigned, f); return (u + 0x7fffu + ((u >> 16) & 1u)) >> 16; }
__device__ __forceinline__ unsigned pk2(float lo, float hi) { return f2bf_u(lo) | (f2bf_u(hi) << 16); }
__device__ __forceinline__ float wave_sum(float v) {
#pragma unroll
    for (int o = 1; o < 64; o <<= 1) v += __shfl_xor(v, o);
    return v;
}

__device__ __forceinline__ int src_in(int np) { const int pn = np >> 8, bj = (np >> 7) & 1, o = np & 127;
    if (pn < 2) return (4 * pn + (o >> 5)) * 64 + (o & 31) + 32 * bj;
    if (pn == 2) { if (o < 64) return 512 + (o >> 5) * 64 + (o & 31) + 32 * bj; if (o < 80) return 1152 + (o - 64) + 16 * bj; return -1; }
    if (pn == 3) return bj ? 1024 + o : 640 + o;
    return 768 + 128 * bj + o; }
__device__ __forceinline__ int src_qup(int np) { const int pn = np >> 8, op = np & 255;
    if (pn < 2) return (4 * pn + (op >> 6)) * 96 + (op & 63);
    const int bj = op >> 7, o = op & 127; return (o >> 4) * 96 + 64 + (o & 15) + 16 * bj; }
__device__ __forceinline__ int src_kvup(int np) { const int pn = np >> 8, op = np & 255; return (4 * (pn & 1) + (op >> 6)) * 128 + (pn >= 2 ? 64 : 0) + (op & 63); }

template <int MODE>
__device__ __forceinline__ void conv_item(const float* W, const float* W2, const float* gain, const float* gain2, int K, int Nsrc, bf16* WT, LAS float* scr, int item, int nblk, int lane) {
    const int kb = item / nblk, nb = item % nblk, k0 = 64 * kb, n0 = 32 * nb;
    const int np = n0 + (lane & 31);
    int src; float cs = 1.0f; const float* Wp = W;
    if (MODE == 0) { src = src_in(np); if (np < 512) cs = 0.125f * LOG2E; }
    else if (MODE == 1) { src = src_qup(np); cs = 0.10206207261596577f * LOG2E; }
    else if (MODE == 2) src = src_kvup(np);
    else if (MODE == 4) { src = 128 * (np >> 8) + (np & 127); if ((np >> 7) & 1) Wp = W2; }
    else src = np;
#pragma unroll 8
    for (int i = 0; i < 32; ++i) { const int kk = 2 * i + (lane >> 5), k = k0 + kk;
        float g = 1.0f; if (MODE == 3) g = (k < 512) ? ((const GAS float*)gain)[k] : ((const GAS float*)gain2)[k - 512]; else if (MODE != 5) g = ((const GAS float*)gain)[k];
        scr[kk * 33 + (lane & 31)] = (src >= 0) ? ((const GAS float*)Wp)[(size_t)k * Nsrc + src] * g * cs : 0.0f; }
    asm volatile("s_waitcnt lgkmcnt(0)" ::: "memory");
    const int c = lane & 7;
#pragma unroll
    for (int j = 0; j < 4; ++j) { const int n = (lane >> 3) + 8 * j; const LAS float* s = scr + (8 * c) * 33 + n;
        pg8::u32x4 o; o.x = pk2(s[0 * 33], s[1 * 33]); o.y = pk2(s[2 * 33], s[3 * 33]); o.z = pk2(s[4 * 33], s[5 * 33]); o.w = pk2(s[6 * 33], s[7 * 33]);
        *(GAS pg8::u32x4*)(WT + (size_t)(n0 + n) * K + k0 + 8 * c) = o; }
    asm volatile("s_waitcnt lgkmcnt(0)" ::: "memory");
}
__device__ __forceinline__ void conv_layer(const Args& a, int l, unsigned char* wbuf, LAS unsigned char* lds) {
    int tid_ = threadIdx.x; asm volatile("" : "+v"(tid_));
    const int lane = tid_ & 63, wave = tid_ >> 6;
    LAS float* scr = (LAS float*)(lds + wave * 16384);
    const int gw = blockIdx.x * NWAVES + wave, NGW = gridDim.x * NWAVES;
    constexpr int I0 = (DM / 64) * (INP / 32), I1 = (256 / 64) * (768 / 32), I2 = (128 / 64) * (1024 / 32), I3 = (DM / 64) * (DM / 32), I4 = (DM / 64) * (GUP / 32), I5 = (DFF / 64) * (DM / 32);
    constexpr int NIT = I0 + I1 + I2 + I3 + I4 + I5;
    for (int it = gw; it < NIT; it += NGW) {
        int r = it;
        if (r < I0) { conv_item<0>(a.w_in + (size_t)l * DM * INW, nullptr, a.attn_norm + l * DM, nullptr, DM, INW, (bf16*)(wbuf + WL_IN), scr, r, INP / 32, lane); continue; } r -= I0;
        if (r < I1) { conv_item<1>(a.w_q_up + (size_t)l * 256 * 768, nullptr, a.q_norm + l * 256, nullptr, 256, 768, (bf16*)(wbuf + WL_Q), scr, r, 768 / 32, lane); continue; } r -= I1;
        if (r < I2) { conv_item<2>(a.w_kv_up + (size_t)l * 128 * 1024, nullptr, a.kv_norm + l * 128, nullptr, 128, 1024, (bf16*)(wbuf + WL_KV), scr, r, 1024 / 32, lane); continue; } r -= I2;
        if (r < I3) { conv_item<3>(a.w_o + (size_t)l * DM * DM, nullptr, a.out_norm_swa + l * 512, a.out_norm_mla + l * 512, DM, DM, (bf16*)(wbuf + WL_O), scr, r, DM / 32, lane); continue; } r -= I3;
        if (r < I4) { conv_item<4>(a.w_gate + (size_t)l * DM * DFF, a.w_up + (size_t)l * DM * DFF, a.ffn_norm + l * DM, nullptr, DM, DFF, (bf16*)(wbuf + WL_GU), scr, r, GUP / 32, lane); continue; } r -= I4;
        conv_item<5>(a.w_down + (size_t)l * DFF * DM, nullptr, nullptr, nullptr, DFF, DM, (bf16*)(wbuf + WL_D), scr, r, DM / 32, lane);
    }
}

__device__ __forceinline__ void init_rows(const Args& a, unsigned char* ws) {
    const int lane = threadIdx.x & 63, wave = threadIdx.x >> 6; const int gw = blockIdx.x * NWAVES + wave, NGW = gridDim.x * NWAVES;
    for (int row = gw; row < MC + NMETA; row += NGW) {
        const bool meta = row >= MC; const int r = meta ? row - MC : row;
        const float* src = meta ? a.meta + (size_t)r * DM : a.x + (size_t)r * DM;
        float* H = (float*)(ws + (meta ? WS_PART + PM_H : WS_H)); bf16* HB = (bf16*)(ws + (meta ? WS_PART + PM_HB : WS_HB)); float* hss = (float*)(ws + WS_PART + (meta ? PM_HSSA : P_HSSA));
        pg8::f32x4 v[4]; float s = 0.f;
#pragma unroll
        for (int j = 0; j < 4; ++j) { v[j] = *((const GAS pg8::f32x4*)src + lane + 64 * j); s += pg8::sq4(v[j]); }
        s = wave_sum(s);
#pragma unroll
        for (int j = 0; j < 4; ++j) { pg8::st_bf16x4(HB + (size_t)r * DM + 4 * (lane + 64 * j), v[j]); }
        if (lane < 16) ((GAS float*)hss)[(size_t)r * 16 + lane] = (lane == 0) ? s : 0.f;
    }
}
__device__ __forceinline__ void final_rows(const Args& a, const bf16* HBf, const float* hss) {
    const int lane = threadIdx.x & 63, wave = threadIdx.x >> 6; const int gw = blockIdx.x * NWAVES + wave, NGW = gridDim.x * NWAVES;
    for (int o = gw; o < BATCH * SEQ; o += NGW) {
        const int row = o;
        const float rs = pg8::rsq(pg8::sum16(hss, row) * (1.0f / DM) + RMS_EPS);
#pragma unroll
        for (int j = 0; j < 4; ++j) { const pg8::u32x2 hw = *((const GAS pg8::u32x2*)(HBf + (size_t)row * DM) + lane + 64 * j); pg8::f32x4 v; v[0] = __builtin_bit_cast(float, hw.x << 16); v[1] = __builtin_bit_cast(float, hw.x & 0xffff0000u); v[2] = __builtin_bit_cast(float, hw.y << 16); v[3] = __builtin_bit_cast(float, hw.y & 0xffff0000u);
            const pg8::f32x4 g = *((const GAS pg8::f32x4*)a.final_norm + lane + 64 * j);
            *((GAS pg8::f32x4*)(a.out + (size_t)o * DM) + lane + 64 * j) = v * rs * g; }
    }
}

constexpr int N_ATT_UNITS = 2 * 17 * 64;
__device__ __forceinline__ void attn_phase(const Args& a, int l, unsigned char* ws, LAS unsigned char* lds, int mode = 0) {
    const int lq = l; l &= 3;
    unsigned char* R = ws + WS_R;
    const bf16 *QA = (const bf16*)(R + R_QA), *KA = (const bf16*)(R + R_KA), *VA = (const bf16*)(R + R_VA), *KR = (const bf16*)(R + R_KR), *QM = (const bf16*)(R + R_QM), *KN = (const bf16*)(R + R_KN), *VB = (const bf16*)(R + R_VB);
    bf16* O = (bf16*)(R + R_O); float* ssqO = (float*)(ws + WS_PART + P_SSQO);
    LAS int* qslot = (LAS int*)(lds + att::OFF_Q);
    const unsigned xcc = ((unsigned)__builtin_amdgcn_s_getreg((3 << 11) | 20) & 0xFu) & 7u;
    unsigned* ctr = (unsigned*)(ws + WS_CTL) + 64 * lq + 8 * 64 * (int)xcc;
    constexpr int PER_X = N_ATT_UNITS / 8;
    for (int pass = 0; pass < 8; ++pass) {
        const unsigned x = (xcc + (unsigned)pass) & 7u; unsigned* c = (unsigned*)(ws + WS_CTL) + 64 * lq + 8 * 64 * (int)x;
        for (;;) {
            if (threadIdx.x == 0) *qslot = (int)atomicAdd(c, 1u);
            __syncthreads();
            const int u = *qslot;
            __syncthreads();
            if (u >= (mode == 1 ? PER_X / 2 : PER_X)) break;
            if (u < PER_X / 2) {
                const int bh = 8 * (u / 17) + (int)x, qb = 16 - u % 17, b = bh >> 3, hd = bh & 7;
                att::attn_unit<96, false>(lds, QM + hd * 96, 768, KN + hd * 64, 512, KR, VB + hd * 64, 512, O + 512 + hd * 64, ssqO + 8 + hd, 0.f, b, qb);
            } else {
                const int v = u - PER_X / 2; const int bh = 8 * (v / 17) + (int)x, qb = 16 - v % 17, b = bh >> 3, hq = bh & 7, kv = hq >> 2;
                att::attn_unit<64, true>(lds, QA + hq * 64, 512, KA + kv * 64, 128, nullptr, VA + kv * 64, 128, O + hq * 64, ssqO + hq, a.sinks[l * 8 + hq] * LOG2E, b, qb);
            }
        }
    }
    (void)ctr;
}

#define XB_TMO      128
#define XB_XCNT(j)  (256  + 64 * (j))
#define XB_XSUB(j)  (1280 + 64 * (j))
#define XB_XGEN(j)  (2304 + 64 * (j))
#define XB_TOP      3328
#define XB_TOPGEN   3392
#define XCD_BAR_WORDS 3456
#define XB_SPIN_CAP (1u << 18)

__device__ __forceinline__ unsigned xb_ld(unsigned* p)              { return __hip_atomic_load(p, __ATOMIC_RELAXED, __HIP_MEMORY_SCOPE_AGENT); }
__device__ __forceinline__ unsigned xb_add(unsigned* p, unsigned v) { return __hip_atomic_fetch_add(p, v, __ATOMIC_RELAXED, __HIP_MEMORY_SCOPE_AGENT); }
__device__ __forceinline__ unsigned xb_xcc_id() { return (unsigned)__builtin_amdgcn_s_getreg((3 << 11) | 20) & 0xFu; }
#define XB_SPIN(cond, bar) do { unsigned _sp = 0; while (cond) { __builtin_amdgcn_s_sleep(1); \
    if ((++_sp & 255u) == 0u) { if (xb_ld(&(bar)[XB_TMO])) break; if (_sp > XB_SPIN_CAP) { atomicAdd(&(bar)[XB_TMO], 1u); break; } } } } while (0)

struct XcdBarrier {
    unsigned* bar; unsigned x;
    volatile LAS unsigned* st;
};

__device__ __forceinline__ XcdBarrier xcd_barrier_post(unsigned* bar, volatile LAS unsigned* st) {
    XcdBarrier b; b.bar = bar; b.x = xb_xcc_id(); b.st = st;
    if (threadIdx.x == 0) (void)xb_add(&bar[XB_XCNT(b.x)], 1u);
    return b;
}
__device__ __forceinline__ void xcd_barrier_complete(unsigned* bar, unsigned x, unsigned& nloc, unsigned& nx) {
    const unsigned G = gridDim.x * gridDim.y * gridDim.z;
    unsigned sum, cnt, mine, sp = 0u;
    for (;;) {
        sum = 0u; cnt = 0u; mine = 0u;
#pragma unroll
        for (unsigned j = 0; j < 16; ++j) { const unsigned c = xb_ld(&bar[XB_XCNT(j)]); sum += c; cnt += (c > 0u) ? 1u : 0u; mine = (j == x) ? c : mine; }
        if (sum == G) break;
        __builtin_amdgcn_s_sleep(1);
        if ((++sp & 255u) == 0u) { if (xb_ld(&bar[XB_TMO])) break; if (sp > XB_SPIN_CAP) { atomicAdd(&bar[XB_TMO], 1u); break; } }
    }
    nloc = mine > 0u ? mine : 1u; nx = cnt > 0u ? cnt : 1u;
}

__device__ __forceinline__ void xcd_barrier(const XcdBarrier& b) {
    asm volatile("s_waitcnt vmcnt(0)" ::: "memory");
    __syncthreads();
    if (threadIdx.x == 0) {
        unsigned* bar = b.bar;
        __builtin_amdgcn_s_waitcnt(0);
        unsigned nloc = b.st[0], nx = b.st[1];
        if (nloc == 0u) { xcd_barrier_complete(bar, b.x, nloc, nx); b.st[0] = nloc; b.st[1] = nx; }
        const unsigned old = xb_add(&bar[XB_XSUB(b.x)], 1u);
        const unsigned gen = old / nloc;
        if (old + 1u == (gen + 1u) * nloc) {
            __builtin_amdgcn_fence(__ATOMIC_RELEASE, "agent");
            asm volatile("s_waitcnt vmcnt(0)" ::: "memory");
            const unsigned og = xb_add(&bar[XB_TOP], 1u);
            const unsigned tg = og / nx;
            if (og + 1u == (tg + 1u) * nx) xb_add(&bar[XB_TOPGEN], 1u);
            else XB_SPIN(xb_ld(&bar[XB_TOPGEN]) == tg, bar);
            __builtin_amdgcn_fence(__ATOMIC_ACQUIRE, "agent");
            xb_add(&bar[XB_XGEN(b.x)], 1u);
            asm volatile("s_waitcnt vmcnt(0)" ::: "memory");
        } else {
            XB_SPIN(xb_ld(&bar[XB_XGEN(b.x)]) == gen, bar);
            __builtin_amdgcn_fence(__ATOMIC_ACQUIRE, "agent");
            asm volatile("s_waitcnt vmcnt(0)" ::: "memory");
        }
    }
    __syncthreads();
}

constexpr int CW_BAR = 4096;
constexpr int XB_LDS_OFF = 131072 + 8192;
#ifndef PHM
#define PHM 255
#endif
#ifndef PROBE_DUP
#define PROBE_DUP 0
#endif
#ifndef PROBE_SYNC
#define PROBE_SYNC 0
#endif
__global__ void __launch_bounds__(NTHREADS, 2) fwd_megakernel(Args a) {
    extern __shared__ __attribute__((aligned(16))) unsigned char lds_raw[];
    LAS unsigned char* lds = (LAS unsigned char*)lds_raw;
    cg::grid_group grid = cg::this_grid();
    const int lo = a.ph_lo, hi = a.ph_hi;
    if (threadIdx.x < 2) ((LAS unsigned*)(lds + XB_LDS_OFF))[threadIdx.x] = 0u;
    __syncthreads();
    const XcdBarrier xbar = xcd_barrier_post((unsigned*)(a.ws + WS_CTL) + CW_BAR, (volatile LAS unsigned*)(lds + XB_LDS_OFF));
#define IN_PH(k) (lo <= (k) && (k) < hi)
#define SEAM(k) do { if (IN_PH(k) && IN_PH((k) + 1)) { if ((k) == 0) grid.sync(); else xcd_barrier(xbar); if (PROBE_SYNC) xcd_barrier(xbar); } } while (0)
#define WSL(w) unsigned char* w = a.ws; asm volatile("" : "+s"(w))
    if (IN_PH(0) && (PHM & 1)) { WSL(ws); init_rows(a, ws); conv_layer(a, 0, ws + WS_W, lds); __syncthreads(); }
    SEAM(0);
#pragma unroll 1
    for (int l = 0; l < DEPTH; ++l) {
        const int p = 1 + 6 * l;
        if (IN_PH(p) && (PHM & 2)) {
            { WSL(ws); unsigned char* R = ws + WS_R; unsigned char* wb = ws + WS_W + (size_t)(l & 1) * WBUF; unsigned char* pm_ = ws + WS_PART;
              pg8::EpiIn<true> E{(const float*)(pm_ + PM_HSSA), (bf16*)(R + R_QA), (bf16*)(R + R_KA), (bf16*)(R + R_VA), (bf16*)(pm_ + PM_QLAT), (bf16*)(pm_ + PM_KVLAT), (bf16*)(R + R_KR), (float*)(pm_ + PM_SSQQ), (float*)(pm_ + PM_SSQKV)};
              pg8::skinny_phase<DM>(lds, (const bf16*)(pm_ + PM_HB), (const bf16*)(wb + WL_IN), INP / 256, E, 128); }
            WSL(ws); unsigned char* R = ws + WS_R; unsigned char* wb = ws + WS_W + (size_t)(l & 1) * WBUF;
            pg8::Gemm g{(const bf16*)(ws + WS_HB), (const bf16*)(wb + WL_IN), MC, INP, DM, 0}; pg8::OrderCT<MC / 256, INP / 256> S; S.init((int)gridDim.x, (int)blockIdx.x);
            pg8::EpiIn<false> E{(const float*)(ws + WS_PART + P_HSSA), (bf16*)(R + R_QA), (bf16*)(R + R_KA), (bf16*)(R + R_VA), (bf16*)(R + R_QLAT), (bf16*)(R + R_KVLAT), (bf16*)(R + R_KR),
                         (float*)(ws + WS_PART + P_SSQQ), (float*)(ws + WS_PART + P_SSQKV)};
            pg8::gemm_phase<pg8::EpiIn<false>, pg8::OrderCT<MC / 256, INP / 256>, true, true>(lds, g, S, E);
            if (PROBE_DUP & 2) pg8::gemm_phase<pg8::EpiIn<false>, pg8::OrderCT<MC / 256, INP / 256>, true, true>(lds, g, S, E);
        }
        SEAM(p);
        if (IN_PH(p + 1) && (PHM & 4)) {
            { WSL(ws); unsigned char* R = ws + WS_R; unsigned char* wb = ws + WS_W + (size_t)(l & 1) * WBUF; unsigned char* pm_ = ws + WS_PART;
              pg8::EpiQup<true> E{(const float*)(pm_ + PM_SSQQ), (bf16*)(R + R_QM)}; pg8::skinny_phase<256>(lds, (const bf16*)(pm_ + PM_QLAT), (const bf16*)(wb + WL_Q), 3, E, 128); }
            { WSL(ws); unsigned char* R = ws + WS_R; unsigned char* wb = ws + WS_W + (size_t)(l & 1) * WBUF;
              pg8::Gemm g{(const bf16*)(R + R_QLAT), (const bf16*)(wb + WL_Q), MC, 768, 256, 0}; pg8::OrderCT<MC / 256, 3> S; S.init((int)gridDim.x, (int)blockIdx.x);
              pg8::EpiQup<false> E{(const float*)(ws + WS_PART + P_SSQQ), (bf16*)(R + R_QM)}; pg8::gemm_phase<pg8::EpiQup<false>, pg8::OrderCT<MC / 256, 3>, true, true>(lds, g, S, E); if (PROBE_DUP & 4) pg8::gemm_phase<pg8::EpiQup<false>, pg8::OrderCT<MC / 256, 3>, true, true>(lds, g, S, E); }
            { WSL(ws); unsigned char* R = ws + WS_R; unsigned char* wb = ws + WS_W + (size_t)(l & 1) * WBUF; unsigned char* pm_ = ws + WS_PART;
              pg8::EpiKvup<true> E{(const float*)(pm_ + PM_SSQKV), (bf16*)(R + R_KN), (bf16*)(R + R_VB)}; pg8::skinny_phase<128>(lds, (const bf16*)(pm_ + PM_KVLAT), (const bf16*)(wb + WL_KV), 4, E, 0); }
            { WSL(ws); unsigned char* R = ws + WS_R; unsigned char* wb = ws + WS_W + (size_t)(l & 1) * WBUF;
              pg8::Gemm g{(const bf16*)(R + R_KVLAT), (const bf16*)(wb + WL_KV), MC, 1024, 128, 0}; pg8::OrderCT<MC / 256, 4> S; S.init((int)gridDim.x, (int)blockIdx.x);
              pg8::EpiKvup<false> E{(const float*)(ws + WS_PART + P_SSQKV), (bf16*)(R + R_KN), (bf16*)(R + R_VB)}; pg8::gemm_phase<pg8::EpiKvup<false>, pg8::OrderCT<MC / 256, 4>, true, true>(lds, g, S, E); if (PROBE_DUP & 4) pg8::gemm_phase<pg8::EpiKvup<false>, pg8::OrderCT<MC / 256, 4>, true, true>(lds, g, S, E); }
        }
        SEAM(p + 1);
        if (IN_PH(p + 2) && (PHM & 8)) { WSL(ws); if (l + 1 < DEPTH) { conv_layer(a, l + 1, ws + WS_W + (size_t)((l + 1) & 1) * WBUF, lds); __syncthreads(); if (PROBE_DUP & 256) { conv_layer(a, l + 1, ws + WS_W + (size_t)((l + 1) & 1) * WBUF, lds); __syncthreads(); } } attn_phase(a, l, ws, lds); if (PROBE_DUP & 8) attn_phase(a, l + 4, ws, lds); if (PROBE_DUP & 1024) attn_phase(a, l + 4, ws, lds, 1); }
        SEAM(p + 2);
        if (IN_PH(p + 3) && (PHM & 16)) {
            { WSL(ws); unsigned char* R = ws + WS_R; unsigned char* wb = ws + WS_W + (size_t)(l & 1) * WBUF; unsigned char* pm_ = ws + WS_PART;
              pg8::EpiOut<true> E; E.H = (float*)(pm_ + PM_H); E.HB = (bf16*)(pm_ + PM_HB); E.hss_out = (float*)(pm_ + PM_HSSB); E.ssq_o = (const float*)(pm_ + P_SSQO); E.xlds = lds;
              pg8::skinny_phase<DM>(lds, (const bf16*)(R + R_O) + (size_t)FRONT * 1024, (const bf16*)(wb + WL_O), 4, E, 0); }
            WSL(ws); unsigned char* R = ws + WS_R; unsigned char* wb = ws + WS_W + (size_t)(l & 1) * WBUF;
            pg8::Gemm g{(const bf16*)(R + R_O), (const bf16*)(wb + WL_O), MC, DM, DM, 1}; pg8::OrderCT<MC / 256, 4> S; S.init((int)gridDim.x, (int)blockIdx.x);
            pg8::EpiOut<false> E; E.H = (float*)(ws + WS_H); E.HB = (bf16*)(ws + WS_HB); E.hss_out = (float*)(ws + WS_PART + P_HSSB); E.ssq_o = (const float*)(ws + WS_PART + P_SSQO); E.xlds = lds + pg8::STAGE_BYTES;
            pg8::gemm_phase<pg8::EpiOut<false>, pg8::OrderCT<MC / 256, 4>, true, true>(lds, g, S, E);
        }
        SEAM(p + 3);
        if (IN_PH(p + 4) && (PHM & 32)) {
            { WSL(ws); unsigned char* wb = ws + WS_W + (size_t)(l & 1) * WBUF; unsigned char* pm_ = ws + WS_PART;
              pg8::EpiGU<true> E{(const float*)(pm_ + PM_HSSB), (bf16*)(pm_ + PM_ACT)}; pg8::skinny_phase<DM>(lds, (const bf16*)(pm_ + PM_HB), (const bf16*)(wb + WL_GU), GUP / 256, E, 0); }
            WSL(ws); unsigned char* R = ws + WS_R; unsigned char* wb = ws + WS_W + (size_t)(l & 1) * WBUF;
            pg8::Gemm g{(const bf16*)(ws + WS_HB), (const bf16*)(wb + WL_GU), MC, GUP, DM, 0}; pg8::OrderCT<MC / 256, GUP / 256> S; S.init((int)gridDim.x, (int)blockIdx.x);
            pg8::EpiGU<false> E{(const float*)(ws + WS_PART + P_HSSB), (bf16*)(R + R_ACT)};
            pg8::gemm_phase<pg8::EpiGU<false>, pg8::OrderCT<MC / 256, GUP / 256>, true, true>(lds, g, S, E);
        }
        SEAM(p + 4);
        if (IN_PH(p + 5) && (PHM & 64)) {
            { WSL(ws); unsigned char* wb = ws + WS_W + (size_t)(l & 1) * WBUF; unsigned char* pm_ = ws + WS_PART;
              pg8::EpiDown<true> E; E.H = (float*)(pm_ + PM_H); E.HB = (bf16*)(pm_ + PM_HB); E.hss_out = (float*)(pm_ + PM_HSSA); E.ssq_o = nullptr;
              pg8::skinny_phase<DFF>(lds, (const bf16*)(pm_ + PM_ACT), (const bf16*)(wb + WL_D), 4, E, 0); }
            WSL(ws); unsigned char* R = ws + WS_R; unsigned char* wb = ws + WS_W + (size_t)(l & 1) * WBUF;
            pg8::Gemm g{(const bf16*)(R + R_ACT), (const bf16*)(wb + WL_D), MC, DM, DFF, 0}; pg8::OrderCT<MC / 256, 4> S; S.init((int)gridDim.x, (int)blockIdx.x);
            pg8::EpiDown<false> E; E.H = (float*)(ws + WS_H); E.HB = (bf16*)(ws + WS_HB); E.hss_out = (float*)(ws + WS_PART + P_HSSA); E.ssq_o = nullptr;
            pg8::gemm_phase<pg8::EpiDown<false>, pg8::OrderCT<MC / 256, 4>, true, true>(lds, g, S, E);
        }
        SEAM(p + 5);
    }
    if (IN_PH(1 + 6 * DEPTH) && (PHM & 128)) { WSL(ws); final_rows(a, (const bf16*)(ws + WS_HB), (const float*)(ws + WS_PART + P_HSSA)); }
#undef IN_PH
#undef SEAM
#undef WSL
}
constexpr int N_PHASES = 2 + 6 * DEPTH;

#ifndef MK_SPLIT
#define MK_SPLIT 0
#endif
extern "C" void kernel_launch(void* const* d_in, const int* in_sizes, int n_in, void* d_out, int out_size, void* d_ws, size_t ws_size, hipStream_t stream) {
    static int grid = 0;
    if (grid == 0) {
        if (n_in != 17 || ws_size < WS_END) { fprintf(stderr, "kernel_launch: need 17 inputs and >= %zu bytes of workspace; got n_in %d, ws %zu\n", (size_t)WS_END, n_in, ws_size); grid = -1; return; }
        int dev = 0, cus = 0, per_cu = 0;
        hipGetDevice(&dev); hipDeviceGetAttribute(&cus, hipDeviceAttributeMultiprocessorCount, dev);
        if (hipFuncSetAttribute((const void*)fwd_megakernel, hipFuncAttributeMaxDynamicSharedMemorySize, LDS_BYTES) != hipSuccess) { fprintf(stderr, "kernel_launch: hipFuncSetAttribute failed\n"); grid = -1; return; }
        if (hipOccupancyMaxActiveBlocksPerMultiprocessor(&per_cu, (const void*)fwd_megakernel, NTHREADS, LDS_BYTES) != hipSuccess || per_cu < 1) { fprintf(stderr, "kernel_launch: occupancy query says %d\n", per_cu); per_cu = 1; }
        (void)hipGetLastError();
        grid = cus * 1;
    }
    if (grid < 0) return;
    hipMemsetAsync((char*)d_ws + WS_CTL, 0, CTL_BYTES, stream);
    Args a{};
    const float** f = (const float**)&a;
    for (int i = 0; i < 17; ++i) f[i] = (const float*)d_in[i];
    a.out = (float*)d_out; a.ws = (unsigned char*)d_ws;
#if MK_SPLIT
    for (int ph = 0; ph < N_PHASES; ++ph) { a.ph_lo = ph; a.ph_hi = ph + 1; hipLaunchKernelGGL(fwd_megakernel, dim3(grid), dim3(NTHREADS), LDS_BYTES, stream, a); }
#else
    a.ph_lo = 0; a.ph_hi = N_PHASES;
    void* args[] = {&a};
    hipError_t e = hipLaunchCooperativeKernel((const void*)fwd_megakernel, dim3(grid), dim3(NTHREADS), args, LDS_BYTES, stream);
    if (e != hipSuccess) fprintf(stderr, "cooperative launch failed: %s (grid %d)\n", hipGetErrorString(e), grid);
#endif
}
```

```cpp
#include <hip/hip_runtime.h>
#include <hip/hip_cooperative_groups.h>
#include <cstdio>
#include <cstdint>
namespace cg = cooperative_groups;

constexpr int BATCH = 8, SEQ = 4096, DM = 1024, DEPTH = 4, NMETA = 16, FRONT = 112, TT = 4224;
constexpr int MROWS = BATCH * TT;
constexpr int INW = 1184, INP = 1280, DFF = 2816, GUP = 2 * DFF;
constexpr float RMS_EPS = 1e-6f;
constexpr float LOG2E = 1.4426950408889634f;
constexpr float LOG2_THETA = 13.287712379549449f;
constexpr float INV_2PI = 0.15915494309189535f;

namespace pg8 {
#define PG8_LAS __attribute__((address_space(3)))
typedef unsigned short bf16_t;
typedef short bf16x8 __attribute__((ext_vector_type(8)));
typedef float f32x4 __attribute__((ext_vector_type(4)));
typedef unsigned u32x4 __attribute__((ext_vector_type(4)));
constexpr int BM = 256, BK = 64, HALF = 128, HTB = HALF * BK * 2  , STAGE_BYTES = 8 * HTB, NXCD = 8, WGM = 8;

__host__ __device__ __forceinline__ int lds_byte(int r, int c) { const int st = (r >> 4) * 2 + (c >> 5), rr = r & 15, cc = c & 31, ob = rr * 64 + cc * 2; return st * 1024 + (ob ^ (((ob >> 9) & 1) << 5)); }
__host__ __device__ __forceinline__ void stage_rc(int b, int& R, int& C) { const int st = b / 1024, sb = b % 1024, swz = sb ^ (((sb >> 9) & 1) << 5); R = (st >> 1) * 16 + swz / 64; C = (st & 1) * 32 + (swz % 64) / 2; }
__host__ __device__ __forceinline__ int perm32(int rho) { const int n = rho >> 4, i = rho & 15; return 8 * (i >> 2) + 4 * n + (i & 3); }

struct Unit { int pm, pn; };
struct Gemm { const bf16_t* A; const bf16_t* Bt; int M, N, K; int apad; };

struct StaticOrder {
    int nM, nN, nwg, G, c;
    __host__ __device__ void init(int M, int N, int G_, int c_) { nM = M / BM; nN = N / BM; nwg = nM * nN; G = G_; c = c_; }
    __host__ __device__ bool next(int i, Unit& u) const {
        const long L = (long)i * G + c; if (L >= nwg) return false;
        int wgid = (int)L; { const int q = nwg / NXCD, r = nwg % NXCD, xcd = wgid % NXCD, off = wgid / NXCD; wgid = (xcd < r ? xcd * (q + 1) : r * (q + 1) + (xcd - r) * q) + off; }
        const int nig = WGM * nN, gid = wgid / nig, fm = gid * WGM, gsz = (nM - fm) < WGM ? (nM - fm) : WGM;
        u.pm = fm + ((wgid % nig) % gsz); u.pn = (wgid % nig) / gsz; return true;
    }
    __device__ __forceinline__ void a_ready(const Unit&) const {}
    __device__ __forceinline__ void done(const Unit&) const {}
};

__device__ __forceinline__ unsigned cvt_pk_bf16(float lo, float hi) { unsigned r; asm volatile("v_cvt_pk_bf16_f32 %0, %1, %2" : "=v"(r) : "v"(lo), "v"(hi)); return r; }

template <int NM, int NN> struct OrderCT {
    static_assert(NM % 8 == 0 || NM % 8 == 4, "last M group must be 8 or 4 tiles");
    int G, c;
    __device__ __forceinline__ void init(int G_, int c_) { G = G_; c = c_; }
    __device__ __forceinline__ bool next(int i, Unit& u) const {
        constexpr int nwg = NM * NN, q = nwg / NXCD, r = nwg % NXCD, nig = WGM * NN;
        const int L = i * G + c; if (L >= nwg) return false;
        const int xcd = L & (NXCD - 1), off = L >> 3;
        const int wgid = (xcd < r ? xcd * (q + 1) : r * (q + 1) + (xcd - r) * q) + off;
        const int gid = wgid / nig, rem = wgid - gid * nig, fm = gid * WGM;
        const int sh = (NM - fm) < WGM ? 2 : 3;
        u.pm = fm + (rem & ((1 << sh) - 1)); u.pn = rem >> sh; return true;
    }
    __device__ __forceinline__ void a_ready(const Unit&) const {}
    __device__ __forceinline__ void done(const Unit&) const {}
};
typedef unsigned u32x2 __attribute__((ext_vector_type(2)));
#define PG8_GAS __attribute__((address_space(1)))
__device__ __forceinline__ void st_bf16x4(bf16_t* p, f32x4 v) { u32x2 w; w.x = cvt_pk_bf16(v[0], v[1]); w.y = cvt_pk_bf16(v[2], v[3]); *(PG8_GAS u32x2*)p = w; }
__device__ __forceinline__ float sum16(const float* part, int row) {
    const PG8_GAS f32x4* p = (const PG8_GAS f32x4*)(part + (size_t)row * 16); const f32x4 a = p[0], b = p[1], c = p[2], d = p[3];
    return (((a.x + a.y) + (a.z + a.w)) + ((b.x + b.y) + (b.z + b.w))) + (((c.x + c.y) + (c.z + c.w)) + ((d.x + d.y) + (d.z + d.w)));
}
__device__ __forceinline__ float sum4(const float* part, int row) { const f32x4 a = *(const PG8_GAS f32x4*)(part + (size_t)row * 4); return (a.x + a.y) + (a.z + a.w); }
__device__ __forceinline__ float rsq(float x) { return 1.0f / sqrtf(x); }
__device__ __forceinline__ float sq4(f32x4 v) { return (v[0] * v[0] + v[1] * v[1]) + (v[2] * v[2] + v[3] * v[3]); }
#define EPI_ROWS(ai, m) for (int ai = 0; ai < 2; ++ai) for (int m = 0; m < 4; ++m)
#define EPI_ROW(u, ai, m) ((u).pm * BM + (ai) * HALF + wr * 64 + (m) * 16 + fr)

__device__ __forceinline__ int prow_of(int m) { return m + (m >> 12) * 128 + 128; }
#define EPI_NB (META ? BATCH : 1)
#define EPI_PROW(row, b) (META ? (size_t)((b) * TT + FRONT + (row)) : (size_t)prow_of(row))
#define EPI_MAIN_LOOP(CALL) _Pragma("unroll") for (int ai = 0; ai < 2; ++ai) _Pragma("unroll") for (int m = 0; m < 4; ++m) { asm volatile("" ::: "memory"); const int row = EPI_ROW(u, ai, m); \
        const f32x4 a_[2][2] = {{acc[ai][0][m][0], acc[ai][0][m][1]}, {acc[ai][1][m][0], acc[ai][1][m][1]}}; CALL; }

template <bool META> struct EpiIn {
    static constexpr bool PERM = false, AFTER_DRAIN = false, MIDSCALE = false;
    const float* hss; bf16_t *qa, *ka, *va, *qlat, *kvlat, *kr; float *ssq_q, *ssq_kv;
    __device__ __forceinline__ void mid(f32x4 (&)[2][2][4][2], const Unit&, int, int, int, int) const {}
    __device__ __forceinline__ void row_epi(const f32x4 (&a)[2][2], int row, int pn, int wc, int fr, int fq) const {
        const float rs = rsq(sum16(hss, row) * (1.0f / DM) + RMS_EPS);
        if (pn <= 2) {
            const bool is_kr = (pn == 2 && wc == 2);
            if (pn == 2 && wc == 3) return;
            const float pos = META ? (float)row : (float)((row & 4095) + NMETA);
#pragma unroll
            for (int n = 0; n < 2; ++n) {
                if (is_kr && n == 1) continue;
                const f32x4 x1 = a[0][n] * rs, x2 = a[1][n] * rs; f32x4 o1, o2;
#pragma unroll
                for (int e = 0; e < 4; ++e) { const float inv = is_kr ? __builtin_amdgcn_exp2f(-(float)(4 * fq + e) * (LOG2_THETA / 16.0f)) : __builtin_amdgcn_exp2f(-(float)(16 * n + 4 * fq + e) * (LOG2_THETA / 32.0f));
                    const float ang = pos * inv; float rev = ang * INV_2PI; rev = rev - floorf(rev);
                    const float sn = __builtin_amdgcn_sinf(rev), cs = __builtin_amdgcn_cosf(rev); o1[e] = x1[e] * cs - x2[e] * sn; o2[e] = x2[e] * cs + x1[e] * sn; }
#pragma unroll
                for (int b = 0; b < EPI_NB; ++b) { const size_t pr = EPI_PROW(row, b); bf16_t* d; int half;
                    if (pn < 2) { d = qa + pr * 512 + (4 * pn + wc) * 64 + 16 * n + 4 * fq; half = 32; }
                    else if (!is_kr) { d = ka + pr * 128 + wc * 64 + 16 * n + 4 * fq; half = 32; }
                    else { d = kr + pr * 32 + 4 * fq; half = 16; }
                    st_bf16x4(d, o1); st_bf16x4(d + half, o2); }
            }
        } else if (pn == 3) {
            float ss = 0.f;
#pragma unroll
            for (int n = 0; n < 2; ++n) { const int c = 32 * wc + 16 * n + 4 * fq; const f32x4 v = a[0][n] * rs, w = a[1][n] * rs;
#pragma unroll
                for (int b = 0; b < EPI_NB; ++b) st_bf16x4(va + EPI_PROW(row, b) * 128 + c, v);
                st_bf16x4(kvlat + (size_t)row * 128 + c, w); ss += sq4(w); }
            ss += __shfl_xor(ss, 16); ss += __shfl_xor(ss, 32);
            if (fq == 0) ((PG8_GAS float*)ssq_kv)[(size_t)row * 4 + wc] = ss;
        } else {
            float ss = 0.f;
#pragma unroll
            for (int bj = 0; bj < 2; ++bj)
#pragma unroll
                for (int n = 0; n < 2; ++n) { const int c = 128 * bj + 32 * wc + 16 * n + 4 * fq; const f32x4 v = a[bj][n] * rs; st_bf16x4(qlat + (size_t)row * 256 + c, v); ss += sq4(v); }
            ss += __shfl_xor(ss, 16); ss += __shfl_xor(ss, 32);
            if (fq == 0) ((PG8_GAS float*)ssq_q)[(size_t)row * 4 + wc] = ss;
        }
    }
    __device__ __forceinline__ void operator()(const f32x4 (&acc)[2][2][4][2], const Unit& u, int wr, int wc, int fr, int fq) const { EPI_MAIN_LOOP(row_epi(a_, row, u.pn, wc, fr, fq)) }
};

template <bool META> struct EpiQup {
    static constexpr bool PERM = false, AFTER_DRAIN = false, MIDSCALE = false;
    const float* ssq_q; bf16_t* qm;
    __device__ __forceinline__ void mid(f32x4 (&)[2][2][4][2], const Unit&, int, int, int, int) const {}
    __device__ __forceinline__ void row_epi(const f32x4 (&a)[2][2], int row, int pn, int wc, int fr, int fq) const {
        const float rs = rsq(sum4(ssq_q, row) * (1.0f / 256.0f) + RMS_EPS);
        if (pn < 2) {
#pragma unroll
            for (int bj = 0; bj < 2; ++bj)
#pragma unroll
                for (int n = 0; n < 2; ++n) { const int head = 4 * pn + 2 * bj + (wc >> 1), d = 32 * (wc & 1) + 16 * n + 4 * fq; const f32x4 v = a[bj][n] * rs;
#pragma unroll
                    for (int b = 0; b < EPI_NB; ++b) st_bf16x4(qm + EPI_PROW(row, b) * 768 + head * 96 + d, v); }
        } else {
            const float pos = META ? (float)row : (float)((row & 4095) + NMETA);
#pragma unroll
            for (int n = 0; n < 2; ++n) { const int head = 2 * wc + n; const f32x4 x1 = a[0][n] * rs, x2 = a[1][n] * rs; f32x4 o1, o2;
#pragma unroll
                for (int e = 0; e < 4; ++e) { const float inv = __builtin_amdgcn_exp2f(-(float)(4 * fq + e) * (LOG2_THETA / 16.0f)); const float ang = pos * inv; float rev = ang * INV_2PI; rev = rev - floorf(rev);
                    const float sn = __builtin_amdgcn_sinf(rev), cs = __builtin_amdgcn_cosf(rev); o1[e] = x1[e] * cs - x2[e] * sn; o2[e] = x2[e] * cs + x1[e] * sn; }
#pragma unroll
                for (int b = 0; b < EPI_NB; ++b) { bf16_t* qrow = qm + EPI_PROW(row, b) * 768; st_bf16x4(qrow + head * 96 + 64 + 4 * fq, o1); st_bf16x4(qrow + head * 96 + 80 + 4 * fq, o2); } }
        }
    }
    __device__ __forceinline__ void operator()(const f32x4 (&acc)[2][2][4][2], const Unit& u, int wr, int wc, int fr, int fq) const { EPI_MAIN_LOOP(row_epi(a_, row, u.pn, wc, fr, fq)) }
};

template <bool META> struct EpiKvup {
    static constexpr bool PERM = false, AFTER_DRAIN = false, MIDSCALE = false;
    const float* ssq_kv; bf16_t *kn, *vb;
    __device__ __forceinline__ void mid(f32x4 (&)[2][2][4][2], const Unit&, int, int, int, int) const {}
    __device__ __forceinline__ void row_epi(const f32x4 (&a)[2][2], int row, int pn, int wc, int fr, int fq) const {
        bf16_t* dst = (pn < 2 ? kn : vb) + (pn & 1) * 256;
        const float rs = rsq(sum4(ssq_kv, row) * (1.0f / 128.0f) + RMS_EPS);
#pragma unroll
        for (int bj = 0; bj < 2; ++bj)
#pragma unroll
            for (int n = 0; n < 2; ++n) { const f32x4 v = a[bj][n] * rs;
#pragma unroll
                for (int b = 0; b < EPI_NB; ++b) st_bf16x4(dst + EPI_PROW(row, b) * 512 + 128 * bj + 32 * wc + 16 * n + 4 * fq, v); }
    }
    __device__ __forceinline__ void operator()(const f32x4 (&acc)[2][2][4][2], const Unit& u, int wr, int wc, int fr, int fq) const { EPI_MAIN_LOOP(row_epi(a_, row, u.pn, wc, fr, fq)) }
};

struct EpiResid {
    static constexpr bool PERM = false, AFTER_DRAIN = false;
    float* H; bf16_t* HB; float* hss_out; const float* ssq_o;
    __device__ __forceinline__ void resid_row(const f32x4 (&a)[2][2], int row, float rs, int pn, int wc, int fr, int fq) const {
        float ss = 0.f;
#pragma unroll
        for (int bj = 0; bj < 2; ++bj)
#pragma unroll
            for (int n = 0; n < 2; ++n) { const size_t off = (size_t)row * DM + pn * BM + 128 * bj + 32 * wc + 16 * n + 4 * fq;
                const u32x2 hw = *(const PG8_GAS u32x2*)(HB + off); f32x4 hv; hv[0] = __builtin_bit_cast(float, hw.x << 16); hv[1] = __builtin_bit_cast(float, hw.x & 0xffff0000u); hv[2] = __builtin_bit_cast(float, hw.y << 16); hv[3] = __builtin_bit_cast(float, hw.y & 0xffff0000u);
                hv = hv + a[bj][n] * rs; st_bf16x4(HB + off, hv); ss += sq4(hv); }
        ss += __shfl_xor(ss, 16); ss += __shfl_xor(ss, 32);
        if (fq == 0) ((PG8_GAS float*)hss_out)[(size_t)row * 16 + 4 * pn + wc] = ss;
    }
    __device__ __forceinline__ void two_scales(size_t prow, float& f, float& rb) const {
        const PG8_GAS f32x4* p = (const PG8_GAS f32x4*)(ssq_o + prow * 16); const f32x4 a = p[0], b = p[1], c = p[2], d = p[3];
        const float sa = ((a.x + a.y) + (a.z + a.w)) + ((b.x + b.y) + (b.z + b.w)), sb = ((c.x + c.y) + (c.z + c.w)) + ((d.x + d.y) + (d.z + d.w));
        const float va = sa * (1.0f / 512.0f) + RMS_EPS, vb = sb * (1.0f / 512.0f) + RMS_EPS; f = sqrtf(vb / va); rb = rsq(vb);
    }
};
template <bool META> struct EpiOut : EpiResid {
    static constexpr bool MIDSCALE = true;
    PG8_LAS unsigned char* xlds;
    __device__ __forceinline__ void prep(const Unit& u, int wid, int wr, int lane) const {
        PG8_LAS float* tab = (PG8_LAS float*)(xlds + wid * 1024);
#pragma unroll
        for (int j = 0; j < 2; ++j) { const int idx = lane + 64 * j; const int row = u.pm * BM + (idx >> 6) * HALF + wr * 64 + (idx & 63);
            float f, rb; two_scales((size_t)prow_of(row), f, rb); tab[2 * idx] = f; tab[2 * idx + 1] = rb; }
    }
    __device__ __forceinline__ void mid(f32x4 (&acc)[2][2][4][2], const Unit& u, int wr, int wc, int fr, int fq) const {
        const int wid = wr * 4 + wc; const PG8_LAS float* tab = (const PG8_LAS float*)(xlds + wid * 1024);
#pragma unroll
        for (int ai = 0; ai < 2; ++ai)
#pragma unroll
            for (int m = 0; m < 4; ++m) {
                const float f = tab[2 * (ai * 64 + m * 16 + fr)];
#pragma unroll
                for (int bj = 0; bj < 2; ++bj)
#pragma unroll
                    for (int n = 0; n < 2; ++n) acc[ai][bj][m][n] *= f;
            }
    }
    __device__ __forceinline__ void operator()(const f32x4 (&acc)[2][2][4][2], const Unit& u, int wr, int wc, int fr, int fq) const {
        const PG8_LAS float* tab = (const PG8_LAS float*)(xlds + (wr * 4 + wc) * 1024);
        EPI_MAIN_LOOP(resid_row(a_, row, tab[2 * (ai * 64 + m * 16 + fr) + 1], u.pn, wc, fr, fq))
    }
    __device__ __forceinline__ void mid_row(f32x4 (&a)[2][2], int row) const { float f, rb; two_scales((size_t)(FRONT + row), f, rb);
#pragma unroll
        for (int bj = 0; bj < 2; ++bj)
#pragma unroll
            for (int n = 0; n < 2; ++n) a[bj][n] *= f; }
    __device__ __forceinline__ void row_epi(const f32x4 (&a)[2][2], int row, int pn, int wc, int fr, int fq) const { float f, rb; two_scales((size_t)(FRONT + row), f, rb); resid_row(a, row, rb, pn, wc, fr, fq); }
};
template <bool META> struct EpiDown : EpiResid {
    static constexpr bool MIDSCALE = false;
    __device__ __forceinline__ void mid(f32x4 (&)[2][2][4][2], const Unit&, int, int, int, int) const {}
    __device__ __forceinline__ void row_epi(const f32x4 (&a)[2][2], int row, int pn, int wc, int fr, int fq) const { resid_row(a, row, 1.0f, pn, wc, fr, fq); }
    __device__ __forceinline__ void operator()(const f32x4 (&acc)[2][2][4][2], const Unit& u, int wr, int wc, int fr, int fq) const { EPI_MAIN_LOOP(resid_row(a_, row, 1.0f, u.pn, wc, fr, fq)) }
};

template <bool META> struct EpiGU {
    static constexpr bool PERM = false, AFTER_DRAIN = false, MIDSCALE = false;
    const float* hss; bf16_t* act;
    __device__ __forceinline__ void mid(f32x4 (&)[2][2][4][2], const Unit&, int, int, int, int) const {}
    __device__ __forceinline__ void row_epi(const f32x4 (&a)[2][2], int row, int pn, int wc, int fr, int fq) const {
        const float rs = rsq(sum16(hss, row) * (1.0f / DM) + RMS_EPS);
#pragma unroll
        for (int n = 0; n < 2; ++n) { const f32x4 g = a[0][n] * rs, up = a[1][n] * rs; f32x4 o;
#pragma unroll
            for (int e = 0; e < 4; ++e) o[e] = g[e] * up[e] * __builtin_amdgcn_rcpf(1.0f + __builtin_amdgcn_exp2f(-g[e] * LOG2E));
            st_bf16x4(act + (size_t)row * DFF + 128 * pn + 32 * wc + 16 * n + 4 * fq, o); }
    }
    __device__ __forceinline__ void operator()(const f32x4 (&acc)[2][2][4][2], const Unit& u, int wr, int wc, int fr, int fq) const { EPI_MAIN_LOOP(row_epi(a_, row, u.pn, wc, fr, fq)) }
};

template <int K, class Epi>
__device__ __forceinline__ void skinny_phase(PG8_LAS unsigned char* lds, const bf16_t* A16, const bf16_t* Bt, int NN, const Epi& E, int wg0) {
    int tid_ = threadIdx.x; asm volatile("" : "+v"(tid_));
    const int tid = tid_, lane = tid & 63, wid = __builtin_amdgcn_readfirstlane(tid >> 6), fr = lane & 15, fq = lane >> 4;
    constexpr int nk = K / 32, NJ = (nk + 7) / 8;
    const int G = (int)gridDim.x; int first = (int)blockIdx.x - wg0; if (first < 0) first += G;
    for (int task = first; task < 4 * NN; task += G) {
        const int pn = task >> 2, wc = task & 3;
        f32x4 a[2][2];
#pragma unroll
        for (int bj = 0; bj < 2; ++bj)
#pragma unroll
            for (int n = 0; n < 2; ++n) a[bj][n] = (f32x4){0.f, 0.f, 0.f, 0.f};
        bool scaled = false;
        const bf16_t* ap = A16 + (size_t)fr * K + 8 * fq;
        const bf16_t* bp = Bt + (size_t)(256 * pn + 32 * wc + fr) * K + 8 * fq;
#pragma unroll 4
        for (int j = 0; j < NJ; ++j) {
            const int it = wid + 8 * j; if (it >= nk) break;
            const int k0 = 32 * it;
            if constexpr (Epi::MIDSCALE) { if (!scaled && k0 >= (K >> 1)) { E.mid_row(a, fr); scaled = true; } }
            const bf16x8 av = *(const PG8_GAS bf16x8*)(ap + k0);
#pragma unroll
            for (int bj = 0; bj < 2; ++bj)
#pragma unroll
                for (int n = 0; n < 2; ++n) { const bf16x8 bv = *(const PG8_GAS bf16x8*)(bp + (size_t)(128 * bj + 16 * n) * K + k0);
                    a[bj][n] = __builtin_amdgcn_mfma_f32_16x16x32_bf16(bv, av, a[bj][n], 0, 0, 0); }
        }
        if constexpr (Epi::MIDSCALE) { if (!scaled) E.mid_row(a, fr); }
        PG8_LAS f32x4* red = (PG8_LAS f32x4*)lds;
#pragma unroll
        for (int bj = 0; bj < 2; ++bj)
#pragma unroll
            for (int n = 0; n < 2; ++n) red[(wid * 64 + lane) * 4 + bj * 2 + n] = a[bj][n];
        __syncthreads();
        if (wid == 0) {
#pragma unroll
            for (int w = 1; w < 8; ++w)
#pragma unroll
                for (int bj = 0; bj < 2; ++bj)
#pragma unroll
                    for (int n = 0; n < 2; ++n) a[bj][n] += red[(w * 64 + lane) * 4 + bj * 2 + n];
            E.row_epi(a, fr, pn, wc, fr, fq);
        }
        __syncthreads();
    }
}
template <class Epi, class Sched, bool ALIGN_EPI = false, bool SP2 = false>
__device__ __forceinline__ void gemm_phase(PG8_LAS unsigned char* lds, const Gemm g, const Sched& S, const Epi& E) {
    int tid_ = threadIdx.x; asm volatile("" : "+v"(tid_));
    const int tid = tid_, wid = __builtin_amdgcn_readfirstlane(tid >> 6), lane = tid & 63, wr = wid >> 2, wc = wid & 3, fr = lane & 15, fq = lane >> 4;
    int K_ = g.K; asm volatile("" : "+s"(K_)); const int K = K_, nt = K / BK;
    unsigned voffA[2], voffB[2];
#pragma unroll
    for (int i = 0; i < 2; ++i) { int R, C; stage_rc(tid * 16 + i * 8192, R, C); const int Rb = Epi::PERM ? ((R & ~31) + perm32(R & 31)) : R;
        voffA[i] = (unsigned)(R * K + C) * 2u; voffB[i] = (unsigned)(Rb * K + C) * 2u; }
    const size_t kstep = (size_t)(BK * 2);
    const size_t hstep = (size_t)HALF * K * 2;
    const size_t tstep = 2 * hstep;
    const unsigned ldsw = (unsigned)wid * 1024u;
    const int aoff = lds_byte(wr * 64 + fr, fq * 8), boff = lds_byte(wc * 32 + fr, fq * 8);
#define PG8_SA(b, h) (((b) * 2 + (h)) * HTB)
#define PG8_SB(b, h) ((4 + (b) * 2 + (h)) * HTB)
#define PG8_STAGE(bufoff, gbase, voff) do { _Pragma("unroll") for (int _i = 0; _i < 2; ++_i) \
        __builtin_amdgcn_global_load_lds((const unsigned*)((const char*)(gbase) + (voff)[_i]), (PG8_LAS unsigned*)(lds + (bufoff) + ldsw + _i * 8192), 16, 0, 0); } while (0)
#define PG8_LDA(dst, b, h) do { _Pragma("unroll") for (int m = 0; m < 4; ++m) _Pragma("unroll") for (int k = 0; k < 2; ++k) dst[m][k] = *(const PG8_LAS bf16x8*)(lds + PG8_SA(b, h) + aoff + m * 2048 + k * 1024); } while (0)
#define PG8_LDB(dst, b, h) do { _Pragma("unroll") for (int n = 0; n < 2; ++n) _Pragma("unroll") for (int k = 0; k < 2; ++k) dst[n][k] = *(const PG8_LAS bf16x8*)(lds + PG8_SB(b, h) + boff + n * 2048 + k * 1024); } while (0)
#define PG8_MMA(ai, bj, At, Bt) do { __builtin_amdgcn_s_setprio(1); _Pragma("unroll") for (int m = 0; m < 4; ++m) _Pragma("unroll") for (int n = 0; n < 2; ++n) _Pragma("unroll") for (int k = 0; k < 2; ++k) \
        acc[ai][bj][m][n] = __builtin_amdgcn_mfma_f32_16x16x32_bf16(Bt[n][k], At[m][k], acc[ai][bj][m][n], 0, 0, 0); __builtin_amdgcn_s_setprio(0); } while (0)
#define PG8_WAIT_V(n) asm volatile("s_waitcnt vmcnt(" #n ")" ::: "memory")
#define PG8_WAIT_L(n) asm volatile("s_waitcnt lgkmcnt(" #n ")" ::: "memory")
#define PG8_BAR __builtin_amdgcn_s_barrier()
#define PG8_SCHED __builtin_amdgcn_sched_barrier(0)
    Unit cur, nxt; int ui = 0;
    if (!S.next(0, cur)) return;
    f32x4 acc[2][2][4][2];
#pragma unroll
    for (int a = 0; a < 2; ++a)
#pragma unroll
        for (int b = 0; b < 2; ++b)
#pragma unroll
            for (int m = 0; m < 4; ++m)
#pragma unroll
                for (int n = 0; n < 2; ++n) acc[a][b][m][n] = (f32x4){0.f, 0.f, 0.f, 0.f};
    bf16x8 At[4][2], B0[2][2], B1[2][2];
    const char* cA = (const char*)g.A + (size_t)cur.pm * tstep + (g.apad ? (size_t)((cur.pm >> 4) * 128 + 128) * (size_t)K * 2 : (size_t)0); const char* cB = (const char*)g.Bt + (size_t)cur.pn * tstep;
    S.a_ready(cur);
    if constexpr (SP2) {
        PG8_STAGE(PG8_SB(0, 0), cB, voffB); PG8_STAGE(PG8_SB(0, 1), cB + hstep, voffB); PG8_STAGE(PG8_SA(0, 0), cA, voffA); PG8_STAGE(PG8_SA(0, 1), cA + hstep, voffA);
        if (wr == 1) PG8_BAR;
        PG8_WAIT_V(2); PG8_BAR;
        PG8_STAGE(PG8_SB(1, 0), cB + kstep, voffB); PG8_STAGE(PG8_SA(1, 0), cA + kstep, voffA); PG8_STAGE(PG8_SB(1, 1), cB + hstep + kstep, voffB);
        PG8_WAIT_V(6); PG8_BAR;
    } else {
        PG8_STAGE(PG8_SB(0, 0), cB, voffB); PG8_STAGE(PG8_SA(0, 0), cA, voffA); PG8_STAGE(PG8_SB(0, 1), cB + hstep, voffB); PG8_STAGE(PG8_SA(0, 1), cA + hstep, voffA);
        if (wr == 1) PG8_BAR;
        PG8_WAIT_V(4); PG8_BAR;
        PG8_STAGE(PG8_SB(1, 0), cB + kstep, voffB); PG8_STAGE(PG8_SA(1, 0), cA + kstep, voffA); PG8_STAGE(PG8_SB(1, 1), cB + hstep + kstep, voffB);
        PG8_WAIT_V(6); PG8_BAR;
    }
    for (;;) {
        const bool has_next = S.next(ui + 1, nxt);
        if constexpr (Epi::MIDSCALE) E.prep(cur, wid, wr, lane);
        const char* nA = has_next ? (const char*)g.A + (size_t)nxt.pm * tstep + (g.apad ? (size_t)((nxt.pm >> 4) * 128 + 128) * (size_t)K * 2 : (size_t)0) : cA; const char* nB = has_next ? (const char*)g.Bt + (size_t)nxt.pn * tstep : cB;
        for (int t = 0; t < nt; t += 2) {
            const bool last = (t == nt - 2);
            if constexpr (Epi::MIDSCALE) { if (t == (nt >> 1)) E.mid(acc, cur, wr, wc, fr, fq); }
            const char* a1 = cA + (size_t)(t + 1) * kstep;
            const char* a2 = last ? nA : cA + (size_t)(t + 2) * kstep; const char* b2 = last ? nB : cB + (size_t)(t + 2) * kstep;
            const char* a3 = a2 + kstep; const char* b3 = b2 + kstep;
            if (last && has_next) S.a_ready(nxt);
            if constexpr (SP2) {
            PG8_LDB(B0, 0, 0); PG8_LDB(B1, 0, 1); PG8_SCHED; PG8_LDA(At, 0, 0); PG8_STAGE(PG8_SA(1, 1), a1 + hstep, voffA);
            PG8_WAIT_V(8); PG8_WAIT_L(0); PG8_BAR; PG8_MMA(0, 0, At, B0); PG8_MMA(0, 1, At, B1); PG8_BAR; PG8_SCHED;
            PG8_LDA(At, 0, 1); PG8_STAGE(PG8_SB(0, 0), b2, voffB); PG8_STAGE(PG8_SB(0, 1), b2 + hstep, voffB); PG8_STAGE(PG8_SA(0, 0), a2, voffA);
            PG8_WAIT_V(8); PG8_WAIT_L(0); PG8_BAR; PG8_MMA(1, 0, At, B0); PG8_MMA(1, 1, At, B1); PG8_BAR; PG8_SCHED;
            PG8_LDB(B0, 1, 0); PG8_LDB(B1, 1, 1); PG8_SCHED; PG8_LDA(At, 1, 0); PG8_STAGE(PG8_SA(0, 1), a2 + hstep, voffA);
            PG8_WAIT_V(8); PG8_WAIT_L(0); PG8_BAR; PG8_MMA(0, 0, At, B0); PG8_MMA(0, 1, At, B1); PG8_BAR; PG8_SCHED;
            PG8_LDA(At, 1, 1); PG8_STAGE(PG8_SB(1, 0), b3, voffB); PG8_STAGE(PG8_SB(1, 1), b3 + hstep, voffB); PG8_STAGE(PG8_SA(1, 0), a3, voffA);
            PG8_WAIT_V(8); PG8_WAIT_L(0); PG8_BAR; PG8_MMA(1, 0, At, B0); PG8_MMA(1, 1, At, B1); PG8_BAR; PG8_SCHED;
            } else {
            PG8_LDB(B0, 0, 0); PG8_SCHED; PG8_LDA(At, 0, 0); PG8_STAGE(PG8_SA(1, 1), a1 + hstep, voffA);
            PG8_WAIT_L(8); PG8_BAR; PG8_WAIT_L(0); PG8_MMA(0, 0, At, B0); PG8_BAR; PG8_SCHED;
            PG8_LDB(B1, 0, 1); PG8_STAGE(PG8_SB(0, 0), b2, voffB);
            PG8_BAR; PG8_WAIT_L(0); PG8_MMA(0, 1, At, B1); PG8_BAR;
            PG8_LDA(At, 0, 1); PG8_STAGE(PG8_SA(0, 0), a2, voffA);
            PG8_BAR; PG8_WAIT_L(0); PG8_MMA(1, 0, At, B0); PG8_BAR; PG8_SCHED;
            PG8_STAGE(PG8_SB(0, 1), b2 + hstep, voffB);
            PG8_WAIT_V(6); PG8_BAR; PG8_MMA(1, 1, At, B1); PG8_BAR;
            PG8_LDB(B0, 1, 0); PG8_SCHED; PG8_LDA(At, 1, 0); PG8_STAGE(PG8_SA(0, 1), a2 + hstep, voffA);
            PG8_WAIT_L(8); PG8_BAR; PG8_WAIT_L(0); PG8_MMA(0, 0, At, B0); PG8_BAR; PG8_SCHED;
            PG8_LDB(B1, 1, 1); PG8_STAGE(PG8_SB(1, 0), b3, voffB);
            PG8_BAR; PG8_WAIT_L(0); PG8_MMA(0, 1, At, B1); PG8_BAR;
            PG8_LDA(At, 1, 1); PG8_STAGE(PG8_SA(1, 0), a3, voffA);
            PG8_BAR; PG8_WAIT_L(0); PG8_MMA(1, 0, At, B0); PG8_BAR; PG8_SCHED;
            PG8_STAGE(PG8_SB(1, 1), b3 + hstep, voffB);
            PG8_WAIT_V(6); PG8_BAR; PG8_MMA(1, 1, At, B1); PG8_BAR;
            }
        }
        if constexpr (ALIGN_EPI) { if (wr == 0) PG8_BAR; }
        if constexpr (!Epi::AFTER_DRAIN) { E(acc, cur, wr, wc, fr, fq); S.done(cur); }
        if (!has_next) break;
#pragma unroll
        for (int a = 0; a < 2; ++a)
#pragma unroll
            for (int b = 0; b < 2; ++b)
#pragma unroll
                for (int m = 0; m < 4; ++m)
#pragma unroll
                    for (int n = 0; n < 2; ++n) acc[a][b][m][n] = (f32x4){0.f, 0.f, 0.f, 0.f};
        cur = nxt; cA = nA; cB = nB; ++ui;
        if constexpr (ALIGN_EPI) { if (wr == 1) PG8_BAR; }
    }
    PG8_WAIT_V(0);
    if constexpr (!ALIGN_EPI) { if (wr == 0) PG8_BAR; }
    PG8_BAR;
    if constexpr (Epi::AFTER_DRAIN) { E.fused(acc, cur, wr, wc, fr, fq, lds, wid, lane); S.done(cur); }
#undef PG8_SA
#undef PG8_SB
#undef PG8_STAGE
#undef PG8_LDA
#undef PG8_LDB
#undef PG8_MMA
#undef PG8_WAIT_V
#undef PG8_WAIT_L
#undef PG8_BAR
#undef PG8_SCHED
}
}
namespace att {
#define ALAS __attribute__((address_space(3)))
#define AGAS __attribute__((address_space(1)))
typedef unsigned short bf16_t;
typedef short bf16x8 __attribute__((ext_vector_type(8)));
typedef short s16x4 __attribute__((ext_vector_type(4)));
typedef float f32x16 __attribute__((ext_vector_type(16)));
typedef unsigned u32x4 __attribute__((ext_vector_type(4)));
typedef float f32x2_t __attribute__((ext_vector_type(2))); typedef __bf16 bf16x2_t __attribute__((ext_vector_type(2)));
constexpr int KPMAX = 208, VP = 192, KSZ = 64 * KPMAX, VSZ = 64 * VP;
constexpr int OFF_V = 2 * KSZ, OFF_SCR = OFF_V + 2 * VSZ, OFF_Q = OFF_SCR + 8 * 256, LDS_BYTES = OFF_Q + 64;
constexpr float NEGF = -1e30f, THR = 6.0f;
__device__ __forceinline__ int crow(int r, int hi) { return (r & 3) + 8 * (r >> 2) + 4 * hi; }
__device__ __forceinline__ unsigned cvtpk(float lo, float hi) { f32x2_t v = {lo, hi}; bf16x2_t b = __builtin_convertvector(v, bf16x2_t); return __builtin_bit_cast(unsigned, b); }
__device__ __forceinline__ bf16x8 pack8(const f32x16& p, int s) { u32x4 w; w.x = cvtpk(p[8 * s], p[8 * s + 1]); w.y = cvtpk(p[8 * s + 2], p[8 * s + 3]); w.z = cvtpk(p[8 * s + 4], p[8 * s + 5]); w.w = cvtpk(p[8 * s + 6], p[8 * s + 7]); return __builtin_bit_cast(bf16x8, w); }
typedef short v4i16_t __attribute__((ext_vector_type(4)));
__device__ __forceinline__ float max3f(float a, float b, float c) { float r; asm("v_max3_f32 %0, %1, %2, %3" : "=v"(r) : "v"(a), "v"(b), "v"(c)); return r; }
__device__ __forceinline__ float max2f(float a, float b) { float r; asm("v_max_f32_e32 %0, %1, %2" : "=v"(r) : "v"(a), "v"(b)); return r; }
__device__ __forceinline__ float xhalf_max(float m) { auto rr = __builtin_amdgcn_permlane32_swap(__float_as_uint(m), __float_as_uint(m), false, false); return max2f(__uint_as_float(rr[0]), __uint_as_float(rr[1])); }
__device__ __forceinline__ s16x4 vtr(const ALAS unsigned char* p) { return __builtin_bit_cast(s16x4, __builtin_amdgcn_ds_read_tr16_b64_v4i16((ALAS v4i16_t*)p)); }
__device__ __forceinline__ unsigned short f2bf(float f) { unsigned u = __builtin_bit_cast(unsigned, f); return (unsigned short)((u + 0x7fffu + ((u >> 16) & 1u)) >> 16); }

template <int DQK, bool SWA>
__device__ __forceinline__ void attn_unit(ALAS unsigned char* lds, const bf16_t* Qp, int qpitch, const bf16_t* Kp, int kpitch, const bf16_t* Krp, const bf16_t* Vp, int vpitch,
                                          bf16_t* Op, float* ssq, float sink2, int b, int qb) {
    constexpr int KP = DQK * 2 + 16, NS = DQK / 16;
    int tid_ = threadIdx.x; asm volatile("" : "+v"(tid_));
    const int tid = tid_, lane = tid & 63, wid = __builtin_amdgcn_readfirstlane(tid >> 6), r = lane & 31, h = lane >> 5;
    const size_t rowbase = (size_t)b * TT;
    const int q0 = qb * 256, q0w = q0 + wid * 32;
    const bool wave_valid = q0w < TT;
    const int NT = (q0 + 256) / 64 < TT / 64 ? (q0 + 256) / 64 : TT / 64;
    int t0 = 1; if (SWA) { t0 = (q0 - 128) / 64; if (t0 < 1) t0 = 1; }
    ALAS float* scr = (ALAS float*)(lds + OFF_SCR + wid * 256);
    bf16x8 qf[NS];
    { const int qr = (q0w + r) < TT ? (q0w + r) : TT - 1; const bf16_t* qrow = Qp + (rowbase + qr) * (size_t)qpitch;
#pragma unroll
      for (int s = 0; s < NS; ++s) qf[s] = *(const AGAS bf16x8*)(qrow + 16 * s + 8 * h); }
    const int srow = tid >> 3, sch = tid & 7, rrow = (tid >> 2) & 63, rch = tid & 3;
    u32x4 kregA, vregA, rregA = {0u, 0u, 0u, 0u}, kregB, vregB, rregB = {0u, 0u, 0u, 0u};
#define AT_GLOAD(t, S) do { const size_t kr_ = rowbase + 64 * (t) + srow; kreg##S = *(const AGAS u32x4*)(Kp + kr_ * (size_t)kpitch + sch * 8); vreg##S = *(const AGAS u32x4*)(Vp + kr_ * (size_t)vpitch + sch * 8); \
        if (DQK == 96) { if (tid < 256) rreg##S = *(const AGAS u32x4*)(Krp + (rowbase + 64 * (t) + rrow) * 32 + rch * 8); } } while (0)
#define AT_LSTORE(buf, S) do { *(ALAS u32x4*)(lds + (buf) * KSZ + srow * KP + sch * 16) = kreg##S; *(ALAS u32x4*)(lds + OFF_V + (buf) * VSZ + srow * VP + sch * 16) = vreg##S; \
        if (DQK == 96) { if (tid < 256) *(ALAS u32x4*)(lds + (buf) * KSZ + rrow * KP + 128 + rch * 16) = rreg##S; } } while (0)
    AT_GLOAD(t0, A); AT_LSTORE(0, A);
    if (t0 + 1 < NT) AT_GLOAD(t0 + 1, A);
    __syncthreads();
    float mrun = SWA ? sink2 : 0.0f, lrun = (SWA && h == 0) ? 1.0f : 0.0f;
    bool first_ = !SWA;
    f32x16 negm;
#pragma unroll
    for (int i = 0; i < 16; ++i) negm[i] = -mrun;
    f32x16 o0, o1;
#pragma unroll
    for (int i = 0; i < 16; ++i) { o0[i] = 0.f; o1[i] = 0.f; }
    const int q = q0w + r;
#define AT_PVF(P, j) do { o0 = __builtin_amdgcn_mfma_f32_32x32x16_bf16(P, __builtin_shufflevector(vlo[2 * (j)], vhi[2 * (j)], 0, 1, 2, 3, 4, 5, 6, 7), o0, 0, 0, 0); o1 = __builtin_amdgcn_mfma_f32_32x32x16_bf16(P, __builtin_shufflevector(vlo[2 * (j) + 1], vhi[2 * (j) + 1], 0, 1, 2, 3, 4, 5, 6, 7), o1, 0, 0, 0); } while (0)
#define AT_PV(P, rowoff) do { \
                { const s16x4 lo = vtr(vb_ + (rowoff) * VP), hi = vtr(vb_ + ((rowoff) + 8) * VP); const bf16x8 vf = __builtin_shufflevector(lo, hi, 0, 1, 2, 3, 4, 5, 6, 7); o0 = __builtin_amdgcn_mfma_f32_32x32x16_bf16(P, vf, o0, 0, 0, 0); } \
                { const s16x4 lo = vtr(vb_ + (rowoff) * VP + 64), hi = vtr(vb_ + ((rowoff) + 8) * VP + 64); const bf16x8 vf = __builtin_shufflevector(lo, hi, 0, 1, 2, 3, 4, 5, 6, 7); o1 = __builtin_amdgcn_mfma_f32_32x32x16_bf16(P, vf, o1, 0, 0, 0); } } while (0)
#define AT_STEP(t, LS, SS) do { \
        const int buf = (t - t0) & 1; \
        if (t + 2 < NT) AT_GLOAD(t + 2, LS); \
        const int kfirst = 64 * t; \
        bool active = wave_valid && (kfirst <= q0w + 31); \
        if (SWA) active = active && (kfirst + 63 >= q0w - 127); \
        if (active) { \
            f32x16 s0, s1; \
            const ALAS unsigned char* kb = lds + buf * KSZ + r * KP + h * 16; \
            bf16x8 kf[2 * NS]; \
_Pragma("unroll") \
            for (int s = 0; s < NS; ++s) { kf[2 * s] = *(const ALAS bf16x8*)(kb + s * 32); kf[2 * s + 1] = *(const ALAS bf16x8*)(kb + 32 * KP + s * 32); } \
            __builtin_amdgcn_sched_barrier(0); \
_Pragma("unroll") \
            for (int s = 0; s < NS; ++s) { if (s == 0) { s0 = __builtin_amdgcn_mfma_f32_32x32x16_bf16(kf[0], qf[0], negm, 0, 0, 0); s1 = __builtin_amdgcn_mfma_f32_32x32x16_bf16(kf[1], qf[0], negm, 0, 0, 0); } else { s0 = __builtin_amdgcn_mfma_f32_32x32x16_bf16(kf[2 * s], qf[s], s0, 0, 0, 0); s1 = __builtin_amdgcn_mfma_f32_32x32x16_bf16(kf[2 * s + 1], qf[s], s1, 0, 0, 0); } } \
            __builtin_amdgcn_sched_barrier(0); \
            const ALAS unsigned char* vb_ = lds + OFF_V + buf * VSZ + (4 * h + ((lane & 15) >> 2)) * VP + ((lane >> 4) & 1) * 32 + (lane & 3) * 8; \
            s16x4 vlo[8], vhi[8]; \
_Pragma("unroll") \
            for (int j = 0; j < 4; ++j) { vlo[2 * j] = vtr(vb_ + (16 * j) * VP); vhi[2 * j] = vtr(vb_ + (16 * j + 8) * VP); vlo[2 * j + 1] = vtr(vb_ + (16 * j) * VP + 64); vhi[2 * j + 1] = vtr(vb_ + (16 * j + 8) * VP + 64); } \
            __builtin_amdgcn_sched_barrier(0); \
            const bool need_mask = SWA || (t == 1) || (kfirst + 63 > q0w); \
            if (need_mask) { \
_Pragma("unroll") \
                for (int i = 0; i < 16; ++i) { const int key = kfirst + crow(i, h), key1 = key + 32; \
                    bool ok0 = (key <= q) && (key >= FRONT), ok1 = (key1 <= q) && (key1 >= FRONT); \
                    if (SWA) { ok0 = ok0 && (q - key < 128); ok1 = ok1 && (q - key1 < 128); } \
                    s0[i] = ok0 ? s0[i] : NEGF; s1[i] = ok1 ? s1[i] : NEGF; } \
            } \
            float rm = max3f(s0[0], s0[1], s1[0]), rm2 = max3f(s0[2], s0[3], s1[1]); rm = max3f(rm, s1[2], s1[3]); \
_Pragma("unroll") \
            for (int i = 4; i < 16; i += 4) { rm = max3f(rm, s0[i], s0[i + 1]); rm2 = max3f(rm2, s0[i + 2], s0[i + 3]); rm = max3f(rm, s1[i], s1[i + 1]); rm2 = max3f(rm2, s1[i + 2], s1[i + 3]); } \
            rm = xhalf_max(max2f(rm, rm2)); \
            if (first_ || __any(rm > THR)) { \
                const float dl = first_ ? (rm > -1e29f ? rm : 0.f) : max2f(rm, 0.f); first_ = false; \
                mrun += dl; const float f = __builtin_amdgcn_exp2f(-dl); lrun *= f; \
_Pragma("unroll") \
                for (int i = 0; i < 16; ++i) { s0[i] -= dl; s1[i] -= dl; negm[i] = -mrun; } \
                if (h == 0) scr[r] = f; \
_Pragma("unroll") \
                for (int i = 0; i < 16; ++i) { const float fi = scr[crow(i, h)]; o0[i] *= fi; o1[i] *= fi; } \
            } \
            float ls = 0.f; \
_Pragma("unroll") \
            for (int i = 0; i < 16; ++i) { s0[i] = __builtin_amdgcn_exp2f(s0[i]); s1[i] = __builtin_amdgcn_exp2f(s1[i]); ls += s0[i] + s1[i]; } \
            lrun += ls; \
            const bf16x8 p0 = pack8(s0, 0), p1 = pack8(s0, 1), p2 = pack8(s1, 0), p3 = pack8(s1, 1); \
            __builtin_amdgcn_sched_barrier(0); \
            AT_PVF(p0, 0); AT_PVF(p1, 1); AT_PVF(p2, 2); AT_PVF(p3, 3); \
        } \
        if (t + 1 < NT) AT_LSTORE(buf ^ 1, SS); \
        __syncthreads(); \
    } while (0)
    {
        int t = t0;
        for (; t + 1 < NT; t += 2) { AT_STEP(t, B, A); const int t1 = t + 1; AT_STEP(t1, A, B); }
        if (t < NT) AT_STEP(t, B, A);
    }
#undef AT_STEP
#undef AT_PV
#undef AT_GLOAD
#undef AT_LSTORE
    if (wave_valid) {
        const float lt = lrun + __shfl_xor(lrun, 32);
        if (h == 0) scr[32 + r] = lt;
#pragma unroll
        for (int i = 0; i < 16; ++i) {
            const float li = scr[32 + crow(i, h)], inv = li > 0.f ? 1.0f / li : 0.f;
            const float a = o0[i] * inv, c = o1[i] * inv; const size_t row = rowbase + q0w + crow(i, h);
            ((AGAS bf16_t*)Op)[row * 1024 + r] = f2bf(a); ((AGAS bf16_t*)Op)[row * 1024 + 32 + r] = f2bf(c);
            float ss = a * a + c * c;
            ss += __shfl_xor(ss, 1); ss += __shfl_xor(ss, 2); ss += __shfl_xor(ss, 4); ss += __shfl_xor(ss, 8); ss += __shfl_xor(ss, 16);
            if (r == 0) ((AGAS float*)ssq)[row * 16] = ss;
        }
    }
    __syncthreads();
}
}
typedef unsigned short bf16;
#define LAS __attribute__((address_space(3)))
#define GAS __attribute__((address_space(1)))
constexpr size_t MiB = 1u << 20;
constexpr int NWAVES = 8, NTHREADS = 512;
constexpr int LDS_BYTES = 147456;
static_assert(att::LDS_BYTES <= 131072, "attention LDS");
constexpr size_t WS_CTL = 0, CTL_BYTES = 65536;
constexpr size_t WS_H = 1 * MiB;
constexpr size_t WS_HB = WS_H + (size_t)MROWS * DM * 4;
constexpr size_t WS_W = WS_HB + (size_t)MROWS * DM * 2;
constexpr size_t WL_IN = 0, WL_Q = WL_IN + (size_t)INP * DM * 2, WL_KV = WL_Q + (size_t)768 * 256 * 2, WL_O = WL_KV + (size_t)1024 * 128 * 2,
                 WL_GU = WL_O + (size_t)DM * DM * 2, WL_D = WL_GU + (size_t)GUP * DM * 2, WL_END = WL_D + (size_t)DM * DFF * 2;
constexpr size_t WBUF = 22 * MiB;
static_assert(WL_END <= WBUF, "weight buffer");
constexpr size_t WS_PART = WS_W + 2 * WBUF;
constexpr size_t P_HSSA = 0, P_HSSB = P_HSSA + (size_t)MROWS * 64, P_SSQO = P_HSSB + (size_t)MROWS * 64, P_SSQQ = P_SSQO + (size_t)MROWS * 64, P_SSQKV = P_SSQQ + (size_t)MROWS * 16, P_END = P_SSQKV + (size_t)MROWS * 16;
constexpr size_t PM_H = (P_END + 255) & ~(size_t)255, PM_HB = PM_H + 16 * DM * 4, PM_HSSA = PM_HB + 16 * DM * 2, PM_HSSB = PM_HSSA + 1024, PM_SSQQ = PM_HSSB + 1024, PM_SSQKV = PM_SSQQ + 256,
                 PM_QLAT = PM_SSQKV + 256, PM_KVLAT = PM_QLAT + 16 * 256 * 2, PM_ACT = PM_KVLAT + 16 * 128 * 2, PM_END = PM_ACT + 16 * DFF * 2;
static_assert(PM_END <= 8 * MiB, "partials");
constexpr int MC = BATCH * SEQ;
constexpr size_t WS_R = WS_PART + 8 * MiB;
constexpr size_t R_QA = 0, R_KA = R_QA + (size_t)MROWS * 512 * 2, R_VA = R_KA + (size_t)MROWS * 128 * 2, R_QLAT = R_VA + (size_t)MROWS * 128 * 2, R_KVLAT = R_QLAT + (size_t)MROWS * 256 * 2,
                 R_KR = R_KVLAT + (size_t)MROWS * 128 * 2, R_QM = R_KR + (size_t)MROWS * 32 * 2, R_KN = R_QM + (size_t)MROWS * 768 * 2, R_VB = R_KN + (size_t)MROWS * 512 * 2,
                 R_O = R_VB + (size_t)MROWS * 512 * 2, R_END = R_O + (size_t)MROWS * 1024 * 2;
constexpr size_t R_ACT = 0;
static_assert((size_t)MROWS * DFF * 2 <= R_END, "act overlay");
constexpr size_t WS_END = WS_R + R_END;
static_assert(WS_END <= 512 * MiB, "workspace must fit 512 MiB");

struct Args {
    const float *x, *meta, *attn_norm, *w_in, *q_norm, *w_q_up, *kv_norm, *w_kv_up, *sinks, *out_norm_swa, *out_norm_mla, *w_o, *ffn_norm, *w_gate, *w_up, *w_down, *final_norm;
    float* out; unsigned char* ws; int ph_lo, ph_hi;
};

__device__ __forceinline__ unsigned f2bf_u(float f) { unsigned u = __builtin_bit_cast(unsigned, f); return (u + 0x7fffu + ((u >> 16) & 1u)) >> 16; }
__device__ __forceinline__ unsigned pk2(float lo, float hi) { return f2bf_u(lo) | (f2bf_u(hi) << 16); }
__device__ __forceinline__ float wave_sum(float v) {
#pragma unroll
    for (int o = 1; o < 64; o <<= 1) v += __shfl_xor(v, o);
    return v;
}

__device__ __forceinline__ int src_in(int np) { const int pn = np >> 8, bj = (np >> 7) & 1, o = np & 127;
    if (pn < 2) return (4 * pn + (o >> 5)) * 64 + (o & 31) + 32 * bj;
    if (pn == 2) { if (o < 64) return 512 + (o >> 5) * 64 + (o & 31) + 32 * bj; if (o < 80) return 1152 + (o - 64) + 16 * bj; return -1; }
    if (pn == 3) return bj ? 1024 + o : 640 + o;
    return 768 + 128 * bj + o; }
__device__ __forceinline__ int src_qup(int np) { const int pn = np >> 8, op = np & 255;
    if (pn < 2) return (4 * pn + (op >> 6)) * 96 + (op & 63);
    const int bj = op >> 7, o = op & 127; return (o >> 4) * 96 + 64 + (o & 15) + 16 * bj; }
__device__ __forceinline__ int src_kvup(int np) { const int pn = np >> 8, op = np & 255; return (4 * (pn & 1) + (op >> 6)) * 128 + (pn >= 2 ? 64 : 0) + (op & 63); }

template <int MODE>
__device__ __forceinline__ void conv_item(const float* W, const float* W2, const float* gain, const float* gain2, int K, int Nsrc, bf16* WT, LAS float* scr, int item, int nblk, int lane) {
    const int kb = item / nblk, nb = item % nblk, k0 = 64 * kb, n0 = 32 * nb;
    const int np = n0 + (lane & 31);
    int src; float cs = 1.0f; const float* Wp = W;
    if (MODE == 0) { src = src_in(np); if (np < 512) cs = 0.125f * LOG2E; }
    else if (MODE == 1) { src = src_qup(np); cs = 0.10206207261596577f * LOG2E; }
    else if (MODE == 2) src = src_kvup(np);
    else if (MODE == 4) { src = 128 * (np >> 8) + (np & 127); if ((np >> 7) & 1) Wp = W2; }
    else src = np;
#pragma unroll 8
    for (int i = 0; i < 32; ++i) { const int kk = 2 * i + (lane >> 5), k = k0 + kk;
        float g = 1.0f; if (MODE == 3) g = (k < 512) ? ((const GAS float*)gain)[k] : ((const GAS float*)gain2)[k - 512]; else if (MODE != 5) g = ((const GAS float*)gain)[k];
        scr[kk * 33 + (lane & 31)] = (src >= 0) ? ((const GAS float*)Wp)[(size_t)k * Nsrc + src] * g * cs : 0.0f; }
    asm volatile("s_waitcnt lgkmcnt(0)" ::: "memory");
    const int c = lane & 7;
#pragma unroll
    for (int j = 0; j < 4; ++j) { const int n = (lane >> 3) + 8 * j; const LAS float* s = scr + (8 * c) * 33 + n;
        pg8::u32x4 o; o.x = pk2(s[0 * 33], s[1 * 33]); o.y = pk2(s[2 * 33], s[3 * 33]); o.z = pk2(s[4 * 33], s[5 * 33]); o.w = pk2(s[6 * 33], s[7 * 33]);
        *(GAS pg8::u32x4*)(WT + (size_t)(n0 + n) * K + k0 + 8 * c) = o; }
    asm volatile("s_waitcnt lgkmcnt(0)" ::: "memory");
}
__device__ __forceinline__ void conv_layer(const Args& a, int l, unsigned char* wbuf, LAS unsigned char* lds) {
    int tid_ = threadIdx.x; asm volatile("" : "+v"(tid_));
    const int lane = tid_ & 63, wave = tid_ >> 6;
    LAS float* scr = (LAS float*)(lds + wave * 16384);
    const int gw = blockIdx.x * NWAVES + wave, NGW = gridDim.x * NWAVES;
    constexpr int I0 = (DM / 64) * (INP / 32), I1 = (256 / 64) * (768 / 32), I2 = (128 / 64) * (1024 / 32), I3 = (DM / 64) * (DM / 32), I4 = (DM / 64) * (GUP / 32), I5 = (DFF / 64) * (DM / 32);
    constexpr int NIT = I0 + I1 + I2 + I3 + I4 + I5;
    for (int it = gw; it < NIT; it += NGW) {
        int r = it;
        if (r < I0) { conv_item<0>(a.w_in + (size_t)l * DM * INW, nullptr, a.attn_norm + l * DM, nullptr, DM, INW, (bf16*)(wbuf + WL_IN), scr, r, INP / 32, lane); continue; } r -= I0;
        if (r < I1) { conv_item<1>(a.w_q_up + (size_t)l * 256 * 768, nullptr, a.q_norm + l * 256, nullptr, 256, 768, (bf16*)(wbuf + WL_Q), scr, r, 768 / 32, lane); continue; } r -= I1;
        if (r < I2) { conv_item<2>(a.w_kv_up + (size_t)l * 128 * 1024, nullptr, a.kv_norm + l * 128, nullptr, 128, 1024, (bf16*)(wbuf + WL_KV), scr, r, 1024 / 32, lane); continue; } r -= I2;
        if (r < I3) { conv_item<3>(a.w_o + (size_t)l * DM * DM, nullptr, a.out_norm_swa + l * 512, a.out_norm_mla + l * 512, DM, DM, (bf16*)(wbuf + WL_O), scr, r, DM / 32, lane); continue; } r -= I3;
        if (r < I4) { conv_item<4>(a.w_gate + (size_t)l * DM * DFF, a.w_up + (size_t)l * DM * DFF, a.ffn_norm + l * DM, nullptr, DM, DFF, (bf16*)(wbuf + WL_GU), scr, r, GUP / 32, lane); continue; } r -= I4;
        conv_item<5>(a.w_down + (size_t)l * DFF * DM, nullptr, nullptr, nullptr, DFF, DM, (bf16*)(wbuf + WL_D), scr, r, DM / 32, lane);
    }
}

__device__ __forceinline__ void init_rows(const Args& a, unsigned char* ws) {
    const int lane = threadIdx.x & 63, wave = threadIdx.x >> 6; const int gw = blockIdx.x * NWAVES + wave, NGW = gridDim.x * NWAVES;
    for (int row = gw; row < MC + NMETA; row += NGW) {
        const bool meta = row >= MC; const int r = meta ? row - MC : row;
        const float* src = meta ? a.meta + (size_t)r * DM : a.x + (size_t)r * DM;
        float* H = (float*)(ws + (meta ? WS_PART + PM_H : WS_H)); bf16* HB = (bf16*)(ws + (meta ? WS_PART + PM_HB : WS_HB)); float* hss = (float*)(ws + WS_PART + (meta ? PM_HSSA : P_HSSA));
        pg8::f32x4 v[4]; float s = 0.f;
#pragma unroll
        for (int j = 0; j < 4; ++j) { v[j] = *((const GAS pg8::f32x4*)src + lane + 64 * j); s += pg8::sq4(v[j]); }
        s = wave_sum(s);
#pragma unroll
        for (int j = 0; j < 4; ++j) { pg8::st_bf16x4(HB + (size_t)r * DM + 4 * (lane + 64 * j), v[j]); }
        if (lane < 16) ((GAS float*)hss)[(size_t)r * 16 + lane] = (lane == 0) ? s : 0.f;
    }
}
__device__ __forceinline__ void final_rows(const Args& a, const bf16* HBf, const float* hss) {
    const int lane = threadIdx.x & 63, wave = threadIdx.x >> 6; const int gw = blockIdx.x * NWAVES + wave, NGW = gridDim.x * NWAVES;
    for (int o = gw; o < BATCH * SEQ; o += NGW) {
        const int row = o;
        const float rs = pg8::rsq(pg8::sum16(hss, row) * (1.0f / DM) + RMS_EPS);
#pragma unroll
        for (int j = 0; j < 4; ++j) { const pg8::u32x2 hw = *((const GAS pg8::u32x2*)(HBf + (size_t)row * DM) + lane + 64 * j); pg8::f32x4 v; v[0] = __builtin_bit_cast(float, hw.x << 16); v[1] = __builtin_bit_cast(float, hw.x & 0xffff0000u); v[2] = __builtin_bit_cast(float, hw.y << 16); v[3] = __builtin_bit_cast(float, hw.y & 0xffff0000u);
            const pg8::f32x4 g = *((const GAS pg8::f32x4*)a.final_norm + lane + 64 * j);
            *((GAS pg8::f32x4*)(a.out + (size_t)o * DM) + lane + 64 * j) = v * rs * g; }
    }
}

constexpr int N_ATT_UNITS = 2 * 17 * 64;
__device__ __forceinline__ void attn_phase(const Args& a, int l, unsigned char* ws, LAS unsigned char* lds, int mode = 0) {
    const int lq = l; l &= 3;
    unsigned char* R = ws + WS_R;
    const bf16 *QA = (const bf16*)(R + R_QA), *KA = (const bf16*)(R + R_KA), *VA = (const bf16*)(R + R_VA), *KR = (const bf16*)(R + R_KR), *QM = (const bf16*)(R + R_QM), *KN = (const bf16*)(R + R_KN), *VB = (const bf16*)(R + R_VB);
    bf16* O = (bf16*)(R + R_O); float* ssqO = (float*)(ws + WS_PART + P_SSQO);
    LAS int* qslot = (LAS int*)(lds + att::OFF_Q);
    const unsigned xcc = ((unsigned)__builtin_amdgcn_s_getreg((3 << 11) | 20) & 0xFu) & 7u;
    unsigned* ctr = (unsigned*)(ws + WS_CTL) + 64 * lq + 8 * 64 * (int)xcc;
    constexpr int PER_X = N_ATT_UNITS / 8;
    for (int pass = 0; pass < 8; ++pass) {
        const unsigned x = (xcc + (unsigned)pass) & 7u; unsigned* c = (unsigned*)(ws + WS_CTL) + 64 * lq + 8 * 64 * (int)x;
        for (;;) {
            if (threadIdx.x == 0) *qslot = (int)atomicAdd(c, 1u);
            __syncthreads();
            const int u = *qslot;
            __syncthreads();
            if (u >= (mode == 1 ? PER_X / 2 : PER_X)) break;
            if (u < PER_X / 2) {
                const int bh = 8 * (u / 17) + (int)x, qb = 16 - u % 17, b = bh >> 3, hd = bh & 7;
                att::attn_unit<96, false>(lds, QM + hd * 96, 768, KN + hd * 64, 512, KR, VB + hd * 64, 512, O + 512 + hd * 64, ssqO + 8 + hd, 0.f, b, qb);
            } else {
                const int v = u - PER_X / 2; const int bh = 8 * (v / 17) + (int)x, qb = 16 - v % 17, b = bh >> 3, hq = bh & 7, kv = hq >> 2;
                att::attn_unit<64, true>(lds, QA + hq * 64, 512, KA + kv * 64, 128, nullptr, VA + kv * 64, 128, O + hq * 64, ssqO + hq, a.sinks[l * 8 + hq] * LOG2E, b, qb);
            }
        }
    }
    (void)ctr;
}

#define XB_TMO      128
#define XB_XCNT(j)  (256  + 64 * (j))
#define XB_XSUB(j)  (1280 + 64 * (j))
#define XB_XGEN(j)  (2304 + 64 * (j))
#define XB_TOP      3328
#define XB_TOPGEN   3392
#define XCD_BAR_WORDS 3456
#define XB_SPIN_CAP (1u << 18)

__device__ __forceinline__ unsigned xb_ld(unsigned* p)              { return __hip_atomic_load(p, __ATOMIC_RELAXED, __HIP_MEMORY_SCOPE_AGENT); }
__device__ __forceinline__ unsigned xb_add(unsigned* p, unsigned v) { return __hip_atomic_fetch_add(p, v, __ATOMIC_RELAXED, __HIP_MEMORY_SCOPE_AGENT); }
__device__ __forceinline__ unsigned xb_xcc_id() { return (unsigned)__builtin_amdgcn_s_getreg((3 << 11) | 20) & 0xFu; }
#define XB_SPIN(cond, bar) do { unsigned _sp = 0; while (cond) { __builtin_amdgcn_s_sleep(1); \
    if ((++_sp & 255u) == 0u) { if (xb_ld(&(bar)[XB_TMO])) break; if (_sp > XB_SPIN_CAP) { atomicAdd(&(bar)[XB_TMO], 1u); break; } } } } while (0)

struct XcdBarrier {
    unsigned* bar; unsigned x;
    volatile LAS unsigned* st;
};

__device__ __forceinline__ XcdBarrier xcd_barrier_post(unsigned* bar, volatile LAS unsigned* st) {
    XcdBarrier b; b.bar = bar; b.x = xb_xcc_id(); b.st = st;
    if (threadIdx.x == 0) (void)xb_add(&bar[XB_XCNT(b.x)], 1u);
    return b;
}
__device__ __forceinline__ void xcd_barrier_complete(unsigned* bar, unsigned x, unsigned& nloc, unsigned& nx) {
    const unsigned G = gridDim.x * gridDim.y * gridDim.z;
    unsigned sum, cnt, mine, sp = 0u;
    for (;;) {
        sum = 0u; cnt = 0u; mine = 0u;
#pragma unroll
        for (unsigned j = 0; j < 16; ++j) { const unsigned c = xb_ld(&bar[XB_XCNT(j)]); sum += c; cnt += (c > 0u) ? 1u : 0u; mine = (j == x) ? c : mine; }
        if (sum == G) break;
        __builtin_amdgcn_s_sleep(1);
        if ((++sp & 255u) == 0u) { if (xb_ld(&bar[XB_TMO])) break; if (sp > XB_SPIN_CAP) { atomicAdd(&bar[XB_TMO], 1u); break; } }
    }
    nloc = mine > 0u ? mine : 1u; nx = cnt > 0u ? cnt : 1u;
}

__device__ __forceinline__ void xcd_barrier(const XcdBarrier& b) {
    asm volatile("s_waitcnt vmcnt(0)" ::: "memory");
    __syncthreads();
    if (threadIdx.x == 0) {
        unsigned* bar = b.bar;
        __builtin_amdgcn_s_waitcnt(0);
        unsigned nloc = b.st[0], nx = b.st[1];
        if (nloc == 0u) { xcd_barrier_complete(bar, b.x, nloc, nx); b.st[0] = nloc; b.st[1] = nx; }
        const unsigned old = xb_add(&bar[XB_XSUB(b.x)], 1u);
        const unsigned gen = old / nloc;
        if (old + 1u == (gen + 1u) * nloc) {
            __builtin_amdgcn_fence(__ATOMIC_RELEASE, "agent");
            asm volatile("s_waitcnt vmcnt(0)" ::: "memory");
            const unsigned og = xb_add(&bar[XB_TOP], 1u);
            const unsigned tg = og / nx;
            if (og + 1u == (tg + 1u) * nx) xb_add(&bar[XB_TOPGEN], 1u);
            else XB_SPIN(xb_ld(&bar[XB_TOPGEN]) == tg, bar);
            __builtin_amdgcn_fence(__ATOMIC_ACQUIRE, "agent");
            xb_add(&bar[XB_XGEN(b.x)], 1u);
            asm volatile("s_waitcnt vmcnt(0)" ::: "memory");
        } else {
            XB_SPIN(xb_ld(&bar[XB_XGEN(b.x)]) == gen, bar);
            __builtin_amdgcn_fence(__ATOMIC_ACQUIRE, "agent");
            asm volatile("s_waitcnt vmcnt(0)" ::: "memory");
        }
    }
    __syncthreads();
}

constexpr int CW_BAR = 4096;
constexpr int XB_LDS_OFF = 131072 + 8192;
#ifndef PHM
#define PHM 255
#endif
#ifndef PROBE_DUP
#define PROBE_DUP 0
#endif
#ifndef PROBE_SYNC
#define PROBE_SYNC 0
#endif
__global__ void __launch_bounds__(NTHREADS, 2) fwd_megakernel(Args a) {
    extern __shared__ __attribute__((aligned(16))) unsigned char lds_raw[];
    LAS unsigned char* lds = (LAS unsigned char*)lds_raw;
    cg::grid_group grid = cg::this_grid();
    const int lo = a.ph_lo, hi = a.ph_hi;
    if (threadIdx.x < 2) ((LAS unsigned*)(lds + XB_LDS_OFF))[threadIdx.x] = 0u;
    __syncthreads();
    if (a.ph_hi < 0) grid.sync();
    const XcdBarrier xbar = xcd_barrier_post((unsigned*)(a.ws + WS_CTL) + CW_BAR, (volatile LAS unsigned*)(lds + XB_LDS_OFF));
#define IN_PH(k) (lo <= (k) && (k) < hi)
#define SEAM(k) do { if (IN_PH(k) && IN_PH((k) + 1)) { xcd_barrier(xbar); if (PROBE_SYNC) xcd_barrier(xbar); } } while (0)
#define WSL(w) unsigned char* w = a.ws; asm volatile("" : "+s"(w))
    if (IN_PH(0) && (PHM & 1)) { WSL(ws); init_rows(a, ws); conv_layer(a, 0, ws + WS_W, lds); __syncthreads(); }
    SEAM(0);
#pragma unroll 1
    for (int l = 0; l < DEPTH; ++l) {
        const int p = 1 + 6 * l;
        if (IN_PH(p) && (PHM & 2)) {
            { WSL(ws); unsigned char* R = ws + WS_R; unsigned char* wb = ws + WS_W + (size_t)(l & 1) * WBUF; unsigned char* pm_ = ws + WS_PART;
              pg8::EpiIn<true> E{(const float*)(pm_ + PM_HSSA), (bf16*)(R + R_QA), (bf16*)(R + R_KA), (bf16*)(R + R_VA), (bf16*)(pm_ + PM_QLAT), (bf16*)(pm_ + PM_KVLAT), (bf16*)(R + R_KR), (float*)(pm_ + PM_SSQQ), (float*)(pm_ + PM_SSQKV)};
              pg8::skinny_phase<DM>(lds, (const bf16*)(pm_ + PM_HB), (const bf16*)(wb + WL_IN), INP / 256, E, 128); }
            WSL(ws); unsigned char* R = ws + WS_R; unsigned char* wb = ws + WS_W + (size_t)(l & 1) * WBUF;
            pg8::Gemm g{(const bf16*)(ws + WS_HB), (const bf16*)(wb + WL_IN), MC, INP, DM, 0}; pg8::OrderCT<MC / 256, INP / 256> S; S.init((int)gridDim.x, (int)blockIdx.x);
            pg8::EpiIn<false> E{(const float*)(ws + WS_PART + P_HSSA), (bf16*)(R + R_QA), (bf16*)(R + R_KA), (bf16*)(R + R_VA), (bf16*)(R + R_QLAT), (bf16*)(R + R_KVLAT), (bf16*)(R + R_KR),
                         (float*)(ws + WS_PART + P_SSQQ), (float*)(ws + WS_PART + P_SSQKV)};
            pg8::gemm_phase<pg8::EpiIn<false>, pg8::OrderCT<MC / 256, INP / 256>, true, true>(lds, g, S, E);
            if (PROBE_DUP & 2) pg8::gemm_phase<pg8::EpiIn<false>, pg8::OrderCT<MC / 256, INP / 256>, true, true>(lds, g, S, E);
        }
        SEAM(p);
        if (IN_PH(p + 1) && (PHM & 4)) {
            { WSL(ws); unsigned char* R = ws + WS_R; unsigned char* wb = ws + WS_W + (size_t)(l & 1) * WBUF; unsigned char* pm_ = ws + WS_PART;
              pg8::EpiQup<true> E{(const float*)(pm_ + PM_SSQQ), (bf16*)(R + R_QM)}; pg8::skinny_phase<256>(lds, (const bf16*)(pm_ + PM_QLAT), (const bf16*)(wb + WL_Q), 3, E, 128); }
            { WSL(ws); unsigned char* R = ws + WS_R; unsigned char* wb = ws + WS_W + (size_t)(l & 1) * WBUF;
              pg8::Gemm g{(const bf16*)(R + R_QLAT), (const bf16*)(wb + WL_Q), MC, 768, 256, 0}; pg8::OrderCT<MC / 256, 3> S; S.init((int)gridDim.x, (int)blockIdx.x);
              pg8::EpiQup<false> E{(const float*)(ws + WS_PART + P_SSQQ), (bf16*)(R + R_QM)}; pg8::gemm_phase<pg8::EpiQup<false>, pg8::OrderCT<MC / 256, 3>, true, true>(lds, g, S, E); if (PROBE_DUP & 4) pg8::gemm_phase<pg8::EpiQup<false>, pg8::OrderCT<MC / 256, 3>, true, true>(lds, g, S, E); }
            { WSL(ws); unsigned char* R = ws + WS_R; unsigned char* wb = ws + WS_W + (size_t)(l & 1) * WBUF; unsigned char* pm_ = ws + WS_PART;
              pg8::EpiKvup<true> E{(const float*)(pm_ + PM_SSQKV), (bf16*)(R + R_KN), (bf16*)(R + R_VB)}; pg8::skinny_phase<128>(lds, (const bf16*)(pm_ + PM_KVLAT), (const bf16*)(wb + WL_KV), 4, E, 0); }
            { WSL(ws); unsigned char* R = ws + WS_R; unsigned char* wb = ws + WS_W + (size_t)(l & 1) * WBUF;
              pg8::Gemm g{(const bf16*)(R + R_KVLAT), (const bf16*)(wb + WL_KV), MC, 1024, 128, 0}; pg8::OrderCT<MC / 256, 4> S; S.init((int)gridDim.x, (int)blockIdx.x);
              pg8::EpiKvup<false> E{(const float*)(ws + WS_PART + P_SSQKV), (bf16*)(R + R_KN), (bf16*)(R + R_VB)}; pg8::gemm_phase<pg8::EpiKvup<false>, pg8::OrderCT<MC / 256, 4>, true, true>(lds, g, S, E); if (PROBE_DUP & 4) pg8::gemm_phase<pg8::EpiKvup<false>, pg8::OrderCT<MC / 256, 4>, true, true>(lds, g, S, E); }
        }
        SEAM(p + 1);
        if (IN_PH(p + 2) && (PHM & 8)) { WSL(ws); if (l + 1 < DEPTH) { conv_layer(a, l + 1, ws + WS_W + (size_t)((l + 1) & 1) * WBUF, lds); __syncthreads(); if (PROBE_DUP & 256) { conv_layer(a, l + 1, ws + WS_W + (size_t)((l + 1) & 1) * WBUF, lds); __syncthreads(); } } attn_phase(a, l, ws, lds); if (PROBE_DUP & 8) attn_phase(a, l + 4, ws, lds); if (PROBE_DUP & 1024) attn_phase(a, l + 4, ws, lds, 1); }
        SEAM(p + 2);
        if (IN_PH(p + 3) && (PHM & 16)) {
            { WSL(ws); unsigned char* R = ws + WS_R; unsigned char* wb = ws + WS_W + (size_t)(l & 1) * WBUF; unsigned char* pm_ = ws + WS_PART;
              pg8::EpiOut<true> E; E.H = (float*)(pm_ + PM_H); E.HB = (bf16*)(pm_ + PM_HB); E.hss_out = (float*)(pm_ + PM_HSSB); E.ssq_o = (const float*)(pm_ + P_SSQO); E.xlds = lds;
              pg8::skinny_phase<DM>(lds, (const bf16*)(R + R_O) + (size_t)FRONT * 1024, (const bf16*)(wb + WL_O), 4, E, 0); }
            WSL(ws); unsigned char* R = ws + WS_R; unsigned char* wb = ws + WS_W + (size_t)(l & 1) * WBUF;
            pg8::Gemm g{(const bf16*)(R + R_O), (const bf16*)(wb + WL_O), MC, DM, DM, 1}; pg8::OrderCT<MC / 256, 4> S; S.init((int)gridDim.x, (int)blockIdx.x);
            pg8::EpiOut<false> E; E.H = (float*)(ws + WS_H); E.HB = (bf16*)(ws + WS_HB); E.hss_out = (float*)(ws + WS_PART + P_HSSB); E.ssq_o = (const float*)(ws + WS_PART + P_SSQO); E.xlds = lds + pg8::STAGE_BYTES;
            pg8::gemm_phase<pg8::EpiOut<false>, pg8::OrderCT<MC / 256, 4>, true, true>(lds, g, S, E);
        }
        SEAM(p + 3);
        if (IN_PH(p + 4) && (PHM & 32)) {
            { WSL(ws); unsigned char* wb = ws + WS_W + (size_t)(l & 1) * WBUF; unsigned char* pm_ = ws + WS_PART;
              pg8::EpiGU<true> E{(const float*)(pm_ + PM_HSSB), (bf16*)(pm_ + PM_ACT)}; pg8::skinny_phase<DM>(lds, (const bf16*)(pm_ + PM_HB), (const bf16*)(wb + WL_GU), GUP / 256, E, 0); }
            WSL(ws); unsigned char* R = ws + WS_R; unsigned char* wb = ws + WS_W + (size_t)(l & 1) * WBUF;
            pg8::Gemm g{(const bf16*)(ws + WS_HB), (const bf16*)(wb + WL_GU), MC, GUP, DM, 0}; pg8::OrderCT<MC / 256, GUP / 256> S; S.init((int)gridDim.x, (int)blockIdx.x);
            pg8::EpiGU<false> E{(const float*)(ws + WS_PART + P_HSSB), (bf16*)(R + R_ACT)};
            pg8::gemm_phase<pg8::EpiGU<false>, pg8::OrderCT<MC / 256, GUP / 256>, true, true>(lds, g, S, E);
        }
        SEAM(p + 4);
        if (IN_PH(p + 5) && (PHM & 64)) {
            { WSL(ws); unsigned char* wb = ws + WS_W + (size_t)(l & 1) * WBUF; unsigned char* pm_ = ws + WS_PART;
              pg8::EpiDown<true> E; E.H = (float*)(pm_ + PM_H); E.HB = (bf16*)(pm_ + PM_HB); E.hss_out = (float*)(pm_ + PM_HSSA); E.ssq_o = nullptr;
              pg8::skinny_phase<DFF>(lds, (const bf16*)(pm_ + PM_ACT), (const bf16*)(wb + WL_D), 4, E, 0); }
            WSL(ws); unsigned char* R = ws + WS_R; unsigned char* wb = ws + WS_W + (size_t)(l & 1) * WBUF;
            pg8::Gemm g{(const bf16*)(R + R_ACT), (const bf16*)(wb + WL_D), MC, DM, DFF, 0}; pg8::OrderCT<MC / 256, 4> S; S.init((int)gridDim.x, (int)blockIdx.x);
            pg8::EpiDown<false> E; E.H = (float*)(ws + WS_H); E.HB = (bf16*)(ws + WS_HB); E.hss_out = (float*)(ws + WS_PART + P_HSSA); E.ssq_o = nullptr;
            pg8::gemm_phase<pg8::EpiDown<false>, pg8::OrderCT<MC / 256, 4>, true, true>(lds, g, S, E);
        }
        SEAM(p + 5);
    }
    if (IN_PH(1 + 6 * DEPTH) && (PHM & 128)) { WSL(ws); final_rows(a, (const bf16*)(ws + WS_HB), (const float*)(ws + WS_PART + P_HSSA)); }
#undef IN_PH
#undef SEAM
#undef WSL
}
constexpr int N_PHASES = 2 + 6 * DEPTH;

#ifndef MK_SPLIT
#define MK_SPLIT 0
#endif
extern "C" void kernel_launch(void* const* d_in, const int* in_sizes, int n_in, void* d_out, int out_size, void* d_ws, size_t ws_size, hipStream_t stream) {
    static int grid = 0;
    if (grid == 0) {
        if (n_in != 17 || ws_size < WS_END) { fprintf(stderr, "kernel_launch: need 17 inputs and >= %zu bytes of workspace; got n_in %d, ws %zu\n", (size_t)WS_END, n_in, ws_size); grid = -1; return; }
        int dev = 0, cus = 0, per_cu = 0;
        hipGetDevice(&dev); hipDeviceGetAttribute(&cus, hipDeviceAttributeMultiprocessorCount, dev);
        if (hipFuncSetAttribute((const void*)fwd_megakernel, hipFuncAttributeMaxDynamicSharedMemorySize, LDS_BYTES) != hipSuccess) { fprintf(stderr, "kernel_launch: hipFuncSetAttribute failed\n"); grid = -1; return; }
        if (hipOccupancyMaxActiveBlocksPerMultiprocessor(&per_cu, (const void*)fwd_megakernel, NTHREADS, LDS_BYTES) != hipSuccess || per_cu < 1) { fprintf(stderr, "kernel_launch: occupancy query says %d\n", per_cu); per_cu = 1; }
        (void)hipGetLastError();
        grid = cus * 1;
    }
    if (grid < 0) return;
    hipMemsetAsync((char*)d_ws + WS_CTL, 0, CTL_BYTES, stream);
    Args a{};
    const float** f = (const float**)&a;
    for (int i = 0; i < 17; ++i) f[i] = (const float*)d_in[i];
    a.out = (float*)d_out; a.ws = (unsigned char*)d_ws;
#if MK_SPLIT
    for (int ph = 0; ph < N_PHASES; ++ph) { a.ph_lo = ph; a.ph_hi = ph + 1; hipLaunchKernelGGL(fwd_megakernel, dim3(grid), dim3(NTHREADS), LDS_BYTES, stream, a); }
#else
    a.ph_lo = 0; a.ph_hi = N_PHASES;
    void* args[] = {&a};
    hipError_t e = hipLaunchCooperativeKernel((const void*)fwd_megakernel, dim3(grid), dim3(NTHREADS), args, LDS_BYTES, stream);
    if (e != hipSuccess) fprintf(stderr, "cooperative launch failed: %s (grid %d)\n", hipGetErrorString(e), grid);
#endif
}
```

```cpp
#include <hip/hip_runtime.h>
#include <hip/hip_cooperative_groups.h>
#include <cstdio>
#include <cstdint>
namespace cg = cooperative_groups;

constexpr int BATCH = 8, SEQ = 4096, DM = 1024, DEPTH = 4, NMETA = 16, FRONT = 112, TT = 4224;
constexpr int MROWS = BATCH * TT;
constexpr int INW = 1184, INP = 1280, DFF = 2816, GUP = 2 * DFF;
constexpr float RMS_EPS = 1e-6f;
constexpr float LOG2E = 1.4426950408889634f;
constexpr float LOG2_THETA = 13.287712379549449f;
constexpr float INV_2PI = 0.15915494309189535f;

namespace pg8 {
#define PG8_LAS __attribute__((address_space(3)))
typedef unsigned short bf16_t;
typedef short bf16x8 __attribute__((ext_vector_type(8)));
typedef float f32x4 __attribute__((ext_vector_type(4)));
typedef unsigned u32x4 __attribute__((ext_vector_type(4)));
constexpr int BM = 256, BK = 64, HALF = 128, HTB = HALF * BK * 2  , STAGE_BYTES = 8 * HTB, NXCD = 8, WGM = 8;

__host__ __device__ __forceinline__ int lds_byte(int r, int c) { const int st = (r >> 4) * 2 + (c >> 5), rr = r & 15, cc = c & 31, ob = rr * 64 + cc * 2; return st * 1024 + (ob ^ (((ob >> 9) & 1) << 5)); }
__host__ __device__ __forceinline__ void stage_rc(int b, int& R, int& C) { const int st = b / 1024, sb = b % 1024, swz = sb ^ (((sb >> 9) & 1) << 5); R = (st >> 1) * 16 + swz / 64; C = (st & 1) * 32 + (swz % 64) / 2; }
__host__ __device__ __forceinline__ int perm32(int rho) { const int n = rho >> 4, i = rho & 15; return 8 * (i >> 2) + 4 * n + (i & 3); }

struct Unit { int pm, pn; };
struct Gemm { const bf16_t* A; const bf16_t* Bt; int M, N, K; int apad; };

struct StaticOrder {
    int nM, nN, nwg, G, c;
    __host__ __device__ void init(int M, int N, int G_, int c_) { nM = M / BM; nN = N / BM; nwg = nM * nN; G = G_; c = c_; }
    __host__ __device__ bool next(int i, Unit& u) const {
        const long L = (long)i * G + c; if (L >= nwg) return false;
        int wgid = (int)L; { const int q = nwg / NXCD, r = nwg % NXCD, xcd = wgid % NXCD, off = wgid / NXCD; wgid = (xcd < r ? xcd * (q + 1) : r * (q + 1) + (xcd - r) * q) + off; }
        const int nig = WGM * nN, gid = wgid / nig, fm = gid * WGM, gsz = (nM - fm) < WGM ? (nM - fm) : WGM;
        u.pm = fm + ((wgid % nig) % gsz); u.pn = (wgid % nig) / gsz; return true;
    }
    __device__ __forceinline__ void a_ready(const Unit&) const {}
    __device__ __forceinline__ void done(const Unit&) const {}
};

__device__ __forceinline__ unsigned cvt_pk_bf16(float lo, float hi) { unsigned r; asm volatile("v_cvt_pk_bf16_f32 %0, %1, %2" : "=v"(r) : "v"(lo), "v"(hi)); return r; }

template <int NM, int NN> struct OrderCT {
    static_assert(NM % 8 == 0 || NM % 8 == 4, "last M group must be 8 or 4 tiles");
    int G, c;
    __device__ __forceinline__ void init(int G_, int c_) { G = G_; c = c_; }
    __device__ __forceinline__ bool next(int i, Unit& u) const {
        constexpr int nwg = NM * NN, q = nwg / NXCD, r = nwg % NXCD, nig = WGM * NN;
        const int L = i * G + c; if (L >= nwg) return false;
        const int xcd = L & (NXCD - 1), off = L >> 3;
        const int wgid = (xcd < r ? xcd * (q + 1) : r * (q + 1) + (xcd - r) * q) + off;
        const int gid = wgid / nig, rem = wgid - gid * nig, fm = gid * WGM;
        const int sh = (NM - fm) < WGM ? 2 : 3;
        u.pm = fm + (rem & ((1 << sh) - 1)); u.pn = rem >> sh; return true;
    }
    __device__ __forceinline__ void a_ready(const Unit&) const {}
    __device__ __forceinline__ void done(const Unit&) const {}
};
typedef unsigned u32x2 __attribute__((ext_vector_type(2)));
#define PG8_GAS __attribute__((address_space(1)))
__device__ __forceinline__ void st_bf16x4(bf16_t* p, f32x4 v) { u32x2 w; w.x = cvt_pk_bf16(v[0], v[1]); w.y = cvt_pk_bf16(v[2], v[3]); *(PG8_GAS u32x2*)p = w; }
__device__ __forceinline__ void st_bf16x8(bf16_t* p, f32x4 v0, f32x4 v1) { u32x4 w; w.x = cvt_pk_bf16(v0[0], v0[1]); w.y = cvt_pk_bf16(v0[2], v0[3]); w.z = cvt_pk_bf16(v1[0], v1[1]); w.w = cvt_pk_bf16(v1[2], v1[3]); *(PG8_GAS u32x4*)p = w; }
__device__ __forceinline__ float sum16(const float* part, int row) {
    const PG8_GAS f32x4* p = (const PG8_GAS f32x4*)(part + (size_t)row * 16); const f32x4 a = p[0], b = p[1], c = p[2], d = p[3];
    return (((a.x + a.y) + (a.z + a.w)) + ((b.x + b.y) + (b.z + b.w))) + (((c.x + c.y) + (c.z + c.w)) + ((d.x + d.y) + (d.z + d.w)));
}
__device__ __forceinline__ float sum4(const float* part, int row) { const f32x4 a = *(const PG8_GAS f32x4*)(part + (size_t)row * 4); return (a.x + a.y) + (a.z + a.w); }
__device__ __forceinline__ float rsq(float x) { return 1.0f / sqrtf(x); }
__device__ __forceinline__ float sq4(f32x4 v) { return (v[0] * v[0] + v[1] * v[1]) + (v[2] * v[2] + v[3] * v[3]); }
#define EPI_ROWS(ai, m) for (int ai = 0; ai < 2; ++ai) for (int m = 0; m < 4; ++m)
#define EPI_ROW(u, ai, m) ((u).pm * BM + (ai) * HALF + wr * 64 + (m) * 16 + fr)

__device__ __forceinline__ int prow_of(int m) { return m + (m >> 12) * 128 + 128; }
#define EPI_NB (META ? BATCH : 1)
#define EPI_PROW(row, b) (META ? (size_t)((b) * TT + FRONT + (row)) : (size_t)prow_of(row))
#define EPI_MAIN_LOOP(CALL) _Pragma("unroll") for (int ai = 0; ai < 2; ++ai) _Pragma("unroll") for (int m = 0; m < 4; ++m) { asm volatile("" ::: "memory"); const int row = EPI_ROW(u, ai, m); \
        const f32x4 a_[2][2] = {{acc[ai][0][m][0], acc[ai][0][m][1]}, {acc[ai][1][m][0], acc[ai][1][m][1]}}; CALL; }

template <bool META> struct EpiIn {
    static constexpr bool PERM = true, AFTER_DRAIN = false, MIDSCALE = false;
    const float* hss; bf16_t *qa, *ka, *va, *qlat, *kvlat, *kr; float *ssq_q, *ssq_kv;
    __device__ __forceinline__ void mid(f32x4 (&)[2][2][4][2], const Unit&, int, int, int, int) const {}
    __device__ __forceinline__ void row_epi(const f32x4 (&a)[2][2], int row, int pn, int wc, int fr, int fq) const {
        const float rs = rsq(sum16(hss, row) * (1.0f / DM) + RMS_EPS);
        if (pn <= 2) {
            const bool is_kr = (pn == 2 && wc == 2);
            if (pn == 2 && wc == 3) return;
            const float pos = META ? (float)row : (float)((row & 4095) + NMETA);
            f32x4 o1[2], o2[2];
#pragma unroll
            for (int n = 0; n < 2; ++n) {
                const f32x4 x1 = a[0][n] * rs, x2 = a[1][n] * rs;
#pragma unroll
                for (int e = 0; e < 4; ++e) { const float d1 = (float)(8 * fq + 4 * n + e); const float inv = __builtin_amdgcn_exp2f(-d1 * (is_kr ? (LOG2_THETA / 16.0f) : (LOG2_THETA / 32.0f)));
                    const float ang = pos * inv; float rev = ang * INV_2PI; rev = rev - floorf(rev);
                    const float sn = __builtin_amdgcn_sinf(rev), cs = __builtin_amdgcn_cosf(rev); o1[n][e] = x1[e] * cs - x2[e] * sn; o2[n][e] = x2[e] * cs + x1[e] * sn; }
            }
            if (is_kr && fq >= 2) return;
#pragma unroll
            for (int b = 0; b < EPI_NB; ++b) { const size_t pr = EPI_PROW(row, b); bf16_t* d; int half;
                if (pn < 2) { d = qa + pr * 512 + (4 * pn + wc) * 64 + 8 * fq; half = 32; }
                else if (!is_kr) { d = ka + pr * 128 + wc * 64 + 8 * fq; half = 32; }
                else { d = kr + pr * 32 + 8 * fq; half = 16; }
                st_bf16x8(d, o1[0], o1[1]); st_bf16x8(d + half, o2[0], o2[1]); }
        } else if (pn == 3) {
            const int c = 32 * wc + 8 * fq; const f32x4 v0 = a[0][0] * rs, v1 = a[0][1] * rs, w0 = a[1][0] * rs, w1 = a[1][1] * rs;
#pragma unroll
            for (int b = 0; b < EPI_NB; ++b) st_bf16x8(va + EPI_PROW(row, b) * 128 + c, v0, v1);
            st_bf16x8(kvlat + (size_t)row * 128 + c, w0, w1);
            float ss = sq4(w0) + sq4(w1);
            ss += __shfl_xor(ss, 16); ss += __shfl_xor(ss, 32);
            if (fq == 0) ((PG8_GAS float*)ssq_kv)[(size_t)row * 4 + wc] = ss;
        } else {
            float ss = 0.f;
#pragma unroll
            for (int bj = 0; bj < 2; ++bj) { const int c = 128 * bj + 32 * wc + 8 * fq; const f32x4 v0 = a[bj][0] * rs, v1 = a[bj][1] * rs; st_bf16x8(qlat + (size_t)row * 256 + c, v0, v1); ss += sq4(v0) + sq4(v1); }
            ss += __shfl_xor(ss, 16); ss += __shfl_xor(ss, 32);
            if (fq == 0) ((PG8_GAS float*)ssq_q)[(size_t)row * 4 + wc] = ss;
        }
    }
    __device__ __forceinline__ void operator()(const f32x4 (&acc)[2][2][4][2], const Unit& u, int wr, int wc, int fr, int fq) const { EPI_MAIN_LOOP(row_epi(a_, row, u.pn, wc, fr, fq)) }
};

template <bool META> struct EpiQup {
    static constexpr bool PERM = true, AFTER_DRAIN = false, MIDSCALE = false;
    const float* ssq_q; bf16_t* qm;
    __device__ __forceinline__ void mid(f32x4 (&)[2][2][4][2], const Unit&, int, int, int, int) const {}
    __device__ __forceinline__ void row_epi(const f32x4 (&a)[2][2], int row, int pn, int wc, int fr, int fq) const {
        const float rs = rsq(sum4(ssq_q, row) * (1.0f / 256.0f) + RMS_EPS);
        if (pn < 2) {
#pragma unroll
            for (int bj = 0; bj < 2; ++bj) { const int head = 4 * pn + 2 * bj + (wc >> 1), d = 32 * (wc & 1) + 8 * fq; const f32x4 v0 = a[bj][0] * rs, v1 = a[bj][1] * rs;
#pragma unroll
                for (int b = 0; b < EPI_NB; ++b) st_bf16x8(qm + EPI_PROW(row, b) * 768 + head * 96 + d, v0, v1); }
        } else {
            const float pos = META ? (float)row : (float)((row & 4095) + NMETA);
            const int head = 2 * wc + (fq >> 1), i0 = 8 * (fq & 1); f32x4 o1[2], o2[2];
#pragma unroll
            for (int n = 0; n < 2; ++n) { const f32x4 x1 = a[0][n] * rs, x2 = a[1][n] * rs;
#pragma unroll
                for (int e = 0; e < 4; ++e) { const float inv = __builtin_amdgcn_exp2f(-(float)(i0 + 4 * n + e) * (LOG2_THETA / 16.0f)); const float ang = pos * inv; float rev = ang * INV_2PI; rev = rev - floorf(rev);
                    const float sn = __builtin_amdgcn_sinf(rev), cs = __builtin_amdgcn_cosf(rev); o1[n][e] = x1[e] * cs - x2[e] * sn; o2[n][e] = x2[e] * cs + x1[e] * sn; } }
#pragma unroll
            for (int b = 0; b < EPI_NB; ++b) { bf16_t* qrow = qm + EPI_PROW(row, b) * 768 + head * 96; st_bf16x8(qrow + 64 + i0, o1[0], o1[1]); st_bf16x8(qrow + 80 + i0, o2[0], o2[1]); }
        }
    }
    __device__ __forceinline__ void operator()(const f32x4 (&acc)[2][2][4][2], const Unit& u, int wr, int wc, int fr, int fq) const { EPI_MAIN_LOOP(row_epi(a_, row, u.pn, wc, fr, fq)) }
};

template <bool META> struct EpiKvup {
    static constexpr bool PERM = true, AFTER_DRAIN = false, MIDSCALE = false;
    const float* ssq_kv; bf16_t *kn, *vb;
    __device__ __forceinline__ void mid(f32x4 (&)[2][2][4][2], const Unit&, int, int, int, int) const {}
    __device__ __forceinline__ void row_epi(const f32x4 (&a)[2][2], int row, int pn, int wc, int fr, int fq) const {
        bf16_t* dst = (pn < 2 ? kn : vb) + (pn & 1) * 256;
        const float rs = rsq(sum4(ssq_kv, row) * (1.0f / 128.0f) + RMS_EPS);
#pragma unroll
        for (int bj = 0; bj < 2; ++bj) { const f32x4 v0 = a[bj][0] * rs, v1 = a[bj][1] * rs;
#pragma unroll
            for (int b = 0; b < EPI_NB; ++b) st_bf16x8(dst + EPI_PROW(row, b) * 512 + 128 * bj + 32 * wc + 8 * fq, v0, v1); }
    }
    __device__ __forceinline__ void operator()(const f32x4 (&acc)[2][2][4][2], const Unit& u, int wr, int wc, int fr, int fq) const { EPI_MAIN_LOOP(row_epi(a_, row, u.pn, wc, fr, fq)) }
};

struct EpiResid {
    static constexpr bool PERM = true, AFTER_DRAIN = false;
    float* H; bf16_t* HB; float* hss_out; const float* ssq_o;
    __device__ __forceinline__ void resid_row(const f32x4 (&a)[2][2], int row, float rs, int pn, int wc, int fr, int fq) const {
        float ss = 0.f;
#pragma unroll
        for (int bj = 0; bj < 2; ++bj) { const size_t off = (size_t)row * DM + pn * BM + 128 * bj + 32 * wc + 8 * fq;
            const u32x4 hw = *(const PG8_GAS u32x4*)(HB + off); f32x4 h0, h1;
            h0[0] = __builtin_bit_cast(float, hw.x << 16); h0[1] = __builtin_bit_cast(float, hw.x & 0xffff0000u); h0[2] = __builtin_bit_cast(float, hw.y << 16); h0[3] = __builtin_bit_cast(float, hw.y & 0xffff0000u);
            h1[0] = __builtin_bit_cast(float, hw.z << 16); h1[1] = __builtin_bit_cast(float, hw.z & 0xffff0000u); h1[2] = __builtin_bit_cast(float, hw.w << 16); h1[3] = __builtin_bit_cast(float, hw.w & 0xffff0000u);
            h0 = h0 + a[bj][0] * rs; h1 = h1 + a[bj][1] * rs; st_bf16x8(HB + off, h0, h1); ss += sq4(h0) + sq4(h1); }
        ss += __shfl_xor(ss, 16); ss += __shfl_xor(ss, 32);
        if (fq == 0) ((PG8_GAS float*)hss_out)[(size_t)row * 16 + 4 * pn + wc] = ss;
    }
    __device__ __forceinline__ void two_scales(size_t prow, float& f, float& rb) const {
        const PG8_GAS f32x4* p = (const PG8_GAS f32x4*)(ssq_o + prow * 16); const f32x4 a = p[0], b = p[1], c = p[2], d = p[3];
        const float sa = ((a.x + a.y) + (a.z + a.w)) + ((b.x + b.y) + (b.z + b.w)), sb = ((c.x + c.y) + (c.z + c.w)) + ((d.x + d.y) + (d.z + d.w));
        const float va = sa * (1.0f / 512.0f) + RMS_EPS, vb = sb * (1.0f / 512.0f) + RMS_EPS; f = sqrtf(vb / va); rb = rsq(vb);
    }
};
template <bool META> struct EpiOut : EpiResid {
    static constexpr bool MIDSCALE = true;
    PG8_LAS unsigned char* xlds;
    __device__ __forceinline__ void prep(const Unit& u, int wid, int wr, int lane) const {
        PG8_LAS float* tab = (PG8_LAS float*)(xlds + wid * 1024);
#pragma unroll
        for (int j = 0; j < 2; ++j) { const int idx = lane + 64 * j; const int row = u.pm * BM + (idx >> 6) * HALF + wr * 64 + (idx & 63);
            float f, rb; two_scales((size_t)prow_of(row), f, rb); tab[2 * idx] = f; tab[2 * idx + 1] = rb; }
    }
    __device__ __forceinline__ void mid(f32x4 (&acc)[2][2][4][2], const Unit& u, int wr, int wc, int fr, int fq) const {
        const int wid = wr * 4 + wc; const PG8_LAS float* tab = (const PG8_LAS float*)(xlds + wid * 1024);
#pragma unroll
        for (int ai = 0; ai < 2; ++ai)
#pragma unroll
            for (int m = 0; m < 4; ++m) {
                const float f = tab[2 * (ai * 64 + m * 16 + fr)];
#pragma unroll
                for (int bj = 0; bj < 2; ++bj)
#pragma unroll
                    for (int n = 0; n < 2; ++n) acc[ai][bj][m][n] *= f;
            }
    }
    __device__ __forceinline__ void operator()(const f32x4 (&acc)[2][2][4][2], const Unit& u, int wr, int wc, int fr, int fq) const {
        const PG8_LAS float* tab = (const PG8_LAS float*)(xlds + (wr * 4 + wc) * 1024);
        EPI_MAIN_LOOP(resid_row(a_, row, tab[2 * (ai * 64 + m * 16 + fr) + 1], u.pn, wc, fr, fq))
    }
    __device__ __forceinline__ void mid_row(f32x4 (&a)[2][2], int row) const { float f, rb; two_scales((size_t)(FRONT + row), f, rb);
#pragma unroll
        for (int bj = 0; bj < 2; ++bj)
#pragma unroll
            for (int n = 0; n < 2; ++n) a[bj][n] *= f; }
    __device__ __forceinline__ void row_epi(const f32x4 (&a)[2][2], int row, int pn, int wc, int fr, int fq) const { float f, rb; two_scales((size_t)(FRONT + row), f, rb); resid_row(a, row, rb, pn, wc, fr, fq); }
};
template <bool META> struct EpiDown : EpiResid {
    static constexpr bool MIDSCALE = false;
    __device__ __forceinline__ void mid(f32x4 (&)[2][2][4][2], const Unit&, int, int, int, int) const {}
    __device__ __forceinline__ void row_epi(const f32x4 (&a)[2][2], int row, int pn, int wc, int fr, int fq) const { resid_row(a, row, 1.0f, pn, wc, fr, fq); }
    __device__ __forceinline__ void operator()(const f32x4 (&acc)[2][2][4][2], const Unit& u, int wr, int wc, int fr, int fq) const { EPI_MAIN_LOOP(resid_row(a_, row, 1.0f, u.pn, wc, fr, fq)) }
};

template <bool META> struct EpiGU {
    static constexpr bool PERM = true, AFTER_DRAIN = false, MIDSCALE = false;
    const float* hss; bf16_t* act;
    __device__ __forceinline__ void mid(f32x4 (&)[2][2][4][2], const Unit&, int, int, int, int) const {}
    __device__ __forceinline__ void row_epi(const f32x4 (&a)[2][2], int row, int pn, int wc, int fr, int fq) const {
        const float rs = rsq(sum16(hss, row) * (1.0f / DM) + RMS_EPS); f32x4 o[2];
#pragma unroll
        for (int n = 0; n < 2; ++n) { const f32x4 g = a[0][n] * rs, up = a[1][n] * rs;
#pragma unroll
            for (int e = 0; e < 4; ++e) o[n][e] = g[e] * up[e] * __builtin_amdgcn_rcpf(1.0f + __builtin_amdgcn_exp2f(-g[e] * LOG2E)); }
        st_bf16x8(act + (size_t)row * DFF + 128 * pn + 32 * wc + 8 * fq, o[0], o[1]);
    }
    __device__ __forceinline__ void operator()(const f32x4 (&acc)[2][2][4][2], const Unit& u, int wr, int wc, int fr, int fq) const { EPI_MAIN_LOOP(row_epi(a_, row, u.pn, wc, fr, fq)) }
};

template <int K, class Epi>
__device__ __forceinline__ void skinny_phase(PG8_LAS unsigned char* lds, const bf16_t* A16, const bf16_t* Bt, int NN, const Epi& E, int wg0) {
    int tid_ = threadIdx.x; asm volatile("" : "+v"(tid_));
    const int tid = tid_, lane = tid & 63, wid = __builtin_amdgcn_readfirstlane(tid >> 6), fr = lane & 15, fq = lane >> 4;
    constexpr int nk = K / 32, NJ = (nk + 7) / 8;
    const int G = (int)gridDim.x; int first = (int)blockIdx.x - wg0; if (first < 0) first += G;
    for (int task = first; task < 4 * NN; task += G) {
        const int pn = task >> 2, wc = task & 3;
        f32x4 a[2][2];
#pragma unroll
        for (int bj = 0; bj < 2; ++bj)
#pragma unroll
            for (int n = 0; n < 2; ++n) a[bj][n] = (f32x4){0.f, 0.f, 0.f, 0.f};
        bool scaled = false;
        const bf16_t* ap = A16 + (size_t)fr * K + 8 * fq;
        const bf16_t* bp = Bt + (size_t)(256 * pn + 32 * wc + 8 * (fr >> 2) + (fr & 3)) * K + 8 * fq;
#pragma unroll 4
        for (int j = 0; j < NJ; ++j) {
            const int it = wid + 8 * j; if (it >= nk) break;
            const int k0 = 32 * it;
            if constexpr (Epi::MIDSCALE) { if (!scaled && k0 >= (K >> 1)) { E.mid_row(a, fr); scaled = true; } }
            const bf16x8 av = *(const PG8_GAS bf16x8*)(ap + k0);
#pragma unroll
            for (int bj = 0; bj < 2; ++bj)
#pragma unroll
                for (int n = 0; n < 2; ++n) { const bf16x8 bv = *(const PG8_GAS bf16x8*)(bp + (size_t)(128 * bj + 4 * n) * K + k0);
                    a[bj][n] = __builtin_amdgcn_mfma_f32_16x16x32_bf16(bv, av, a[bj][n], 0, 0, 0); }
        }
        if constexpr (Epi::MIDSCALE) { if (!scaled) E.mid_row(a, fr); }
        PG8_LAS f32x4* red = (PG8_LAS f32x4*)lds;
#pragma unroll
        for (int bj = 0; bj < 2; ++bj)
#pragma unroll
            for (int n = 0; n < 2; ++n) red[(wid * 64 + lane) * 4 + bj * 2 + n] = a[bj][n];
        __syncthreads();
        if (wid == 0) {
#pragma unroll
            for (int w = 1; w < 8; ++w)
#pragma unroll
                for (int bj = 0; bj < 2; ++bj)
#pragma unroll
                    for (int n = 0; n < 2; ++n) a[bj][n] += red[(w * 64 + lane) * 4 + bj * 2 + n];
            E.row_epi(a, fr, pn, wc, fr, fq);
        }
        __syncthreads();
    }
}
template <class Epi, class Sched, bool ALIGN_EPI = false, bool SP2 = false>
__device__ __forceinline__ void gemm_phase(PG8_LAS unsigned char* lds, const Gemm g, const Sched& S, const Epi& E) {
    int tid_ = threadIdx.x; asm volatile("" : "+v"(tid_));
    const int tid = tid_, wid = __builtin_amdgcn_readfirstlane(tid >> 6), lane = tid & 63, wr = wid >> 2, wc = wid & 3, fr = lane & 15, fq = lane >> 4;
    int K_ = g.K; asm volatile("" : "+s"(K_)); const int K = K_, nt = K / BK;
    unsigned voffA[2], voffB[2];
#pragma unroll
    for (int i = 0; i < 2; ++i) { int R, C; stage_rc(tid * 16 + i * 8192, R, C); const int Rb = Epi::PERM ? ((R & ~31) + perm32(R & 31)) : R;
        voffA[i] = (unsigned)(R * K + C) * 2u; voffB[i] = (unsigned)(Rb * K + C) * 2u; }
    const size_t kstep = (size_t)(BK * 2);
    const size_t hstep = (size_t)HALF * K * 2;
    const size_t tstep = 2 * hstep;
    const unsigned ldsw = (unsigned)wid * 1024u;
    const int aoff = lds_byte(wr * 64 + fr, fq * 8), boff = lds_byte(wc * 32 + fr, fq * 8);
#define PG8_SA(b, h) (((b) * 2 + (h)) * HTB)
#define PG8_SB(b, h) ((4 + (b) * 2 + (h)) * HTB)
#define PG8_STAGE(bufoff, gbase, voff) do { _Pragma("unroll") for (int _i = 0; _i < 2; ++_i) \
        __builtin_amdgcn_global_load_lds((const unsigned*)((const char*)(gbase) + (voff)[_i]), (PG8_LAS unsigned*)(lds + (bufoff) + ldsw + _i * 8192), 16, 0, 0); } while (0)
#define PG8_LDA(dst, b, h) do { _Pragma("unroll") for (int m = 0; m < 4; ++m) _Pragma("unroll") for (int k = 0; k < 2; ++k) dst[m][k] = *(const PG8_LAS bf16x8*)(lds + PG8_SA(b, h) + aoff + m * 2048 + k * 1024); } while (0)
#define PG8_LDB(dst, b, h) do { _Pragma("unroll") for (int n = 0; n < 2; ++n) _Pragma("unroll") for (int k = 0; k < 2; ++k) dst[n][k] = *(const PG8_LAS bf16x8*)(lds + PG8_SB(b, h) + boff + n * 2048 + k * 1024); } while (0)
#define PG8_MMA(ai, bj, At, Bt) do { __builtin_amdgcn_s_setprio(1); _Pragma("unroll") for (int m = 0; m < 4; ++m) _Pragma("unroll") for (int n = 0; n < 2; ++n) _Pragma("unroll") for (int k = 0; k < 2; ++k) \
        acc[ai][bj][m][n] = __builtin_amdgcn_mfma_f32_16x16x32_bf16(Bt[n][k], At[m][k], acc[ai][bj][m][n], 0, 0, 0); __builtin_amdgcn_s_setprio(0); } while (0)
#define PG8_WAIT_V(n) asm volatile("s_waitcnt vmcnt(" #n ")" ::: "memory")
#define PG8_WAIT_L(n) asm volatile("s_waitcnt lgkmcnt(" #n ")" ::: "memory")
#define PG8_BAR __builtin_amdgcn_s_barrier()
#define PG8_SCHED __builtin_amdgcn_sched_barrier(0)
    Unit cur, nxt; int ui = 0;
    if (!S.next(0, cur)) return;
    f32x4 acc[2][2][4][2];
#pragma unroll
    for (int a = 0; a < 2; ++a)
#pragma unroll
        for (int b = 0; b < 2; ++b)
#pragma unroll
            for (int m = 0; m < 4; ++m)
#pragma unroll
                for (int n = 0; n < 2; ++n) acc[a][b][m][n] = (f32x4){0.f, 0.f, 0.f, 0.f};
    bf16x8 At[4][2], B0[2][2], B1[2][2];
    const char* cA = (const char*)g.A + (size_t)cur.pm * tstep + (g.apad ? (size_t)((cur.pm >> 4) * 128 + 128) * (size_t)K * 2 : (size_t)0); const char* cB = (const char*)g.Bt + (size_t)cur.pn * tstep;
    S.a_ready(cur);
    if constexpr (SP2) {
        PG8_STAGE(PG8_SB(0, 0), cB, voffB); PG8_STAGE(PG8_SB(0, 1), cB + hstep, voffB); PG8_STAGE(PG8_SA(0, 0), cA, voffA); PG8_STAGE(PG8_SA(0, 1), cA + hstep, voffA);
        if (wr == 1) PG8_BAR;
        PG8_WAIT_V(2); PG8_BAR;
        PG8_STAGE(PG8_SB(1, 0), cB + kstep, voffB); PG8_STAGE(PG8_SA(1, 0), cA + kstep, voffA); PG8_STAGE(PG8_SB(1, 1), cB + hstep + kstep, voffB);
        PG8_WAIT_V(6); PG8_BAR;
    } else {
        PG8_STAGE(PG8_SB(0, 0), cB, voffB); PG8_STAGE(PG8_SA(0, 0), cA, voffA); PG8_STAGE(PG8_SB(0, 1), cB + hstep, voffB); PG8_STAGE(PG8_SA(0, 1), cA + hstep, voffA);
        if (wr == 1) PG8_BAR;
        PG8_WAIT_V(4); PG8_BAR;
        PG8_STAGE(PG8_SB(1, 0), cB + kstep, voffB); PG8_STAGE(PG8_SA(1, 0), cA + kstep, voffA); PG8_STAGE(PG8_SB(1, 1), cB + hstep + kstep, voffB);
        PG8_WAIT_V(6); PG8_BAR;
    }
    for (;;) {
        const bool has_next = S.next(ui + 1, nxt);
        if constexpr (Epi::MIDSCALE) E.prep(cur, wid, wr, lane);
        const char* nA = has_next ? (const char*)g.A + (size_t)nxt.pm * tstep + (g.apad ? (size_t)((nxt.pm >> 4) * 128 + 128) * (size_t)K * 2 : (size_t)0) : cA; const char* nB = has_next ? (const char*)g.Bt + (size_t)nxt.pn * tstep : cB;
        for (int t = 0; t < nt; t += 2) {
            const bool last = (t == nt - 2);
            if constexpr (Epi::MIDSCALE) { if (t == (nt >> 1)) E.mid(acc, cur, wr, wc, fr, fq); }
            const char* a1 = cA + (size_t)(t + 1) * kstep;
            const char* a2 = last ? nA : cA + (size_t)(t + 2) * kstep; const char* b2 = last ? nB : cB + (size_t)(t + 2) * kstep;
            const char* a3 = a2 + kstep; const char* b3 = b2 + kstep;
            if (last && has_next) S.a_ready(nxt);
            if constexpr (SP2) {
            PG8_LDB(B0, 0, 0); PG8_LDB(B1, 0, 1); PG8_SCHED; PG8_LDA(At, 0, 0); PG8_STAGE(PG8_SA(1, 1), a1 + hstep, voffA);
            PG8_WAIT_V(8); PG8_WAIT_L(0); PG8_BAR; PG8_MMA(0, 0, At, B0); PG8_MMA(0, 1, At, B1); PG8_BAR; PG8_SCHED;
            PG8_LDA(At, 0, 1); PG8_STAGE(PG8_SB(0, 0), b2, voffB); PG8_STAGE(PG8_SB(0, 1), b2 + hstep, voffB); PG8_STAGE(PG8_SA(0, 0), a2, voffA);
            PG8_WAIT_V(8); PG8_WAIT_L(0); PG8_BAR; PG8_MMA(1, 0, At, B0); PG8_MMA(1, 1, At, B1); PG8_BAR; PG8_SCHED;
            PG8_LDB(B0, 1, 0); PG8_LDB(B1, 1, 1); PG8_SCHED; PG8_LDA(At, 1, 0); PG8_STAGE(PG8_SA(0, 1), a2 + hstep, voffA);
            PG8_WAIT_V(8); PG8_WAIT_L(0); PG8_BAR; PG8_MMA(0, 0, At, B0); PG8_MMA(0, 1, At, B1); PG8_BAR; PG8_SCHED;
            PG8_LDA(At, 1, 1); PG8_STAGE(PG8_SB(1, 0), b3, voffB); PG8_STAGE(PG8_SB(1, 1), b3 + hstep, voffB); PG8_STAGE(PG8_SA(1, 0), a3, voffA);
            PG8_WAIT_V(8); PG8_WAIT_L(0); PG8_BAR; PG8_MMA(1, 0, At, B0); PG8_MMA(1, 1, At, B1); PG8_BAR; PG8_SCHED;
            } else {
            PG8_LDB(B0, 0, 0); PG8_SCHED; PG8_LDA(At, 0, 0); PG8_STAGE(PG8_SA(1, 1), a1 + hstep, voffA);
            PG8_WAIT_L(8); PG8_BAR; PG8_WAIT_L(0); PG8_MMA(0, 0, At, B0); PG8_BAR; PG8_SCHED;
            PG8_LDB(B1, 0, 1); PG8_STAGE(PG8_SB(0, 0), b2, voffB);
            PG8_BAR; PG8_WAIT_L(0); PG8_MMA(0, 1, At, B1); PG8_BAR;
            PG8_LDA(At, 0, 1); PG8_STAGE(PG8_SA(0, 0), a2, voffA);
            PG8_BAR; PG8_WAIT_L(0); PG8_MMA(1, 0, At, B0); PG8_BAR; PG8_SCHED;
            PG8_STAGE(PG8_SB(0, 1), b2 + hstep, voffB);
            PG8_WAIT_V(6); PG8_BAR; PG8_MMA(1, 1, At, B1); PG8_BAR;
            PG8_LDB(B0, 1, 0); PG8_SCHED; PG8_LDA(At, 1, 0); PG8_STAGE(PG8_SA(0, 1), a2 + hstep, voffA);
            PG8_WAIT_L(8); PG8_BAR; PG8_WAIT_L(0); PG8_MMA(0, 0, At, B0); PG8_BAR; PG8_SCHED;
            PG8_LDB(B1, 1, 1); PG8_STAGE(PG8_SB(1, 0), b3, voffB);
            PG8_BAR; PG8_WAIT_L(0); PG8_MMA(0, 1, At, B1); PG8_BAR;
            PG8_LDA(At, 1, 1); PG8_STAGE(PG8_SA(1, 0), a3, voffA);
            PG8_BAR; PG8_WAIT_L(0); PG8_MMA(1, 0, At, B0); PG8_BAR; PG8_SCHED;
            PG8_STAGE(PG8_SB(1, 1), b3 + hstep, voffB);
            PG8_WAIT_V(6); PG8_BAR; PG8_MMA(1, 1, At, B1); PG8_BAR;
            }
        }
        if constexpr (ALIGN_EPI) { if (wr == 0) PG8_BAR; }
        if constexpr (!Epi::AFTER_DRAIN) { E(acc, cur, wr, wc, fr, fq); S.done(cur); }
        if (!has_next) break;
#pragma unroll
        for (int a = 0; a < 2; ++a)
#pragma unroll
            for (int b = 0; b < 2; ++b)
#pragma unroll
                for (int m = 0; m < 4; ++m)
#pragma unroll
                    for (int n = 0; n < 2; ++n) acc[a][b][m][n] = (f32x4){0.f, 0.f, 0.f, 0.f};
        cur = nxt; cA = nA; cB = nB; ++ui;
        if constexpr (ALIGN_EPI) { if (wr == 1) PG8_BAR; }
    }
    PG8_WAIT_V(0);
    if constexpr (!ALIGN_EPI) { if (wr == 0) PG8_BAR; }
    PG8_BAR;
    if constexpr (Epi::AFTER_DRAIN) { E.fused(acc, cur, wr, wc, fr, fq, lds, wid, lane); S.done(cur); }
#undef PG8_SA
#undef PG8_SB
#undef PG8_STAGE
#undef PG8_LDA
#undef PG8_LDB
#undef PG8_MMA
#undef PG8_WAIT_V
#undef PG8_WAIT_L
#undef PG8_BAR
#undef PG8_SCHED
}
}
namespace att {
#define ALAS __attribute__((address_space(3)))
#define AGAS __attribute__((address_space(1)))
typedef unsigned short bf16_t;
typedef short bf16x8 __attribute__((ext_vector_type(8)));
typedef short s16x4 __attribute__((ext_vector_type(4)));
typedef float f32x16 __attribute__((ext_vector_type(16)));
typedef unsigned u32x4 __attribute__((ext_vector_type(4)));
typedef float f32x2_t __attribute__((ext_vector_type(2))); typedef __bf16 bf16x2_t __attribute__((ext_vector_type(2)));
constexpr int KPMAX = 208, VP = 192, KSZ = 64 * KPMAX, VSZ = 64 * VP;
constexpr int OFF_V = 2 * KSZ, OFF_SCR = OFF_V + 2 * VSZ, OFF_Q = OFF_SCR + 8 * 256, LDS_BYTES = OFF_Q + 64;
constexpr float NEGF = -1e30f, THR = 6.0f;
__device__ __forceinline__ int crow(int r, int hi) { return (r & 3) + 8 * (r >> 2) + 4 * hi; }
__device__ __forceinline__ unsigned cvtpk(float lo, float hi) { f32x2_t v = {lo, hi}; bf16x2_t b = __builtin_convertvector(v, bf16x2_t); return __builtin_bit_cast(unsigned, b); }
__device__ __forceinline__ bf16x8 pack8(const f32x16& p, int s) { u32x4 w; w.x = cvtpk(p[8 * s], p[8 * s + 1]); w.y = cvtpk(p[8 * s + 2], p[8 * s + 3]); w.z = cvtpk(p[8 * s + 4], p[8 * s + 5]); w.w = cvtpk(p[8 * s + 6], p[8 * s + 7]); return __builtin_bit_cast(bf16x8, w); }
typedef short v4i16_t __attribute__((ext_vector_type(4)));
__device__ __forceinline__ float max3f(float a, float b, float c) { float r; asm("v_max3_f32 %0, %1, %2, %3" : "=v"(r) : "v"(a), "v"(b), "v"(c)); return r; }
__device__ __forceinline__ float max2f(float a, float b) { float r; asm("v_max_f32_e32 %0, %1, %2" : "=v"(r) : "v"(a), "v"(b)); return r; }
__device__ __forceinline__ float xhalf_max(float m) { auto rr = __builtin_amdgcn_permlane32_swap(__float_as_uint(m), __float_as_uint(m), false, false); return max2f(__uint_as_float(rr[0]), __uint_as_float(rr[1])); }
__device__ __forceinline__ s16x4 vtr(const ALAS unsigned char* p) { return __builtin_bit_cast(s16x4, __builtin_amdgcn_ds_read_tr16_b64_v4i16((ALAS v4i16_t*)p)); }
__device__ __forceinline__ unsigned short f2bf(float f) { unsigned u = __builtin_bit_cast(unsigned, f); return (unsigned short)((u + 0x7fffu + ((u >> 16) & 1u)) >> 16); }

template <int DQK, bool SWA>
__device__ __forceinline__ void attn_unit(ALAS unsigned char* lds, const bf16_t* Qp, int qpitch, const bf16_t* Kp, int kpitch, const bf16_t* Krp, const bf16_t* Vp, int vpitch,
                                          bf16_t* Op, float* ssq, float sink2, int b, int qb) {
    constexpr int KP = DQK * 2 + 16, NS = DQK / 16;
    int tid_ = threadIdx.x; asm volatile("" : "+v"(tid_));
    const int tid = tid_, lane = tid & 63, wid = __builtin_amdgcn_readfirstlane(tid >> 6), r = lane & 31, h = lane >> 5;
    const size_t rowbase = (size_t)b * TT;
    const int q0 = qb * 256, q0w = q0 + wid * 32;
    const bool wave_valid = q0w < TT;
    const int NT = (q0 + 256) / 64 < TT / 64 ? (q0 + 256) / 64 : TT / 64;
    int t0 = 1; if (SWA) { t0 = (q0 - 128) / 64; if (t0 < 1) t0 = 1; }
    ALAS float* scr = (ALAS float*)(lds + OFF_SCR + wid * 256);
    bf16x8 qf[NS];
    { const int qr = (q0w + r) < TT ? (q0w + r) : TT - 1; const bf16_t* qrow = Qp + (rowbase + qr) * (size_t)qpitch;
#pragma unroll
      for (int s = 0; s < NS; ++s) qf[s] = *(const AGAS bf16x8*)(qrow + 16 * s + 8 * h); }
    const int srow = tid >> 3, sch = tid & 7, rrow = (tid >> 2) & 63, rch = tid & 3;
    u32x4 kregA, vregA, rregA = {0u, 0u, 0u, 0u}, kregB, vregB, rregB = {0u, 0u, 0u, 0u};
#define AT_GLOAD(t, S) do { const size_t kr_ = rowbase + 64 * (t) + srow; kreg##S = *(const AGAS u32x4*)(Kp + kr_ * (size_t)kpitch + sch * 8); vreg##S = *(const AGAS u32x4*)(Vp + kr_ * (size_t)vpitch + sch * 8); \
        if (DQK == 96) { if (tid < 256) rreg##S = *(const AGAS u32x4*)(Krp + (rowbase + 64 * (t) + rrow) * 32 + rch * 8); } } while (0)
#define AT_LSTORE(buf, S) do { *(ALAS u32x4*)(lds + (buf) * KSZ + srow * KP + sch * 16) = kreg##S; *(ALAS u32x4*)(lds + OFF_V + (buf) * VSZ + srow * VP + sch * 16) = vreg##S; \
        if (DQK == 96) { if (tid < 256) *(ALAS u32x4*)(lds + (buf) * KSZ + rrow * KP + 128 + rch * 16) = rreg##S; } } while (0)
    AT_GLOAD(t0, A); AT_LSTORE(0, A);
    if (t0 + 1 < NT) AT_GLOAD(t0 + 1, A);
    __syncthreads();
    float mrun = SWA ? sink2 : 0.0f, lrun = (SWA && h == 0) ? 1.0f : 0.0f;
    bool first_ = !SWA;
    f32x16 negm;
#pragma unroll
    for (int i = 0; i < 16; ++i) negm[i] = -mrun;
    f32x16 o0, o1;
#pragma unroll
    for (int i = 0; i < 16; ++i) { o0[i] = 0.f; o1[i] = 0.f; }
    const int q = q0w + r;
#define AT_PVF(P, j) do { o0 = __builtin_amdgcn_mfma_f32_32x32x16_bf16(P, __builtin_shufflevector(vlo[2 * (j)], vhi[2 * (j)], 0, 1, 2, 3, 4, 5, 6, 7), o0, 0, 0, 0); o1 = __builtin_amdgcn_mfma_f32_32x32x16_bf16(P, __builtin_shufflevector(vlo[2 * (j) + 1], vhi[2 * (j) + 1], 0, 1, 2, 3, 4, 5, 6, 7), o1, 0, 0, 0); } while (0)
#define AT_PV(P, rowoff) do { \
                { const s16x4 lo = vtr(vb_ + (rowoff) * VP), hi = vtr(vb_ + ((rowoff) + 8) * VP); const bf16x8 vf = __builtin_shufflevector(lo, hi, 0, 1, 2, 3, 4, 5, 6, 7); o0 = __builtin_amdgcn_mfma_f32_32x32x16_bf16(P, vf, o0, 0, 0, 0); } \
                { const s16x4 lo = vtr(vb_ + (rowoff) * VP + 64), hi = vtr(vb_ + ((rowoff) + 8) * VP + 64); const bf16x8 vf = __builtin_shufflevector(lo, hi, 0, 1, 2, 3, 4, 5, 6, 7); o1 = __builtin_amdgcn_mfma_f32_32x32x16_bf16(P, vf, o1, 0, 0, 0); } } while (0)
#define AT_STEP(t, LS, SS) do { \
        const int buf = (t - t0) & 1; \
        if (t + 2 < NT) AT_GLOAD(t + 2, LS); \
        const int kfirst = 64 * t; \
        bool active = wave_valid && (kfirst <= q0w + 31); \
        if (SWA) active = active && (kfirst + 63 >= q0w - 127); \
        if (active) { \
            f32x16 s0, s1; \
            const ALAS unsigned char* kb = lds + buf * KSZ + r * KP + h * 16; \
            bf16x8 kf[2 * NS]; \
_Pragma("unroll") \
            for (int s = 0; s < NS; ++s) { kf[2 * s] = *(const ALAS bf16x8*)(kb + s * 32); kf[2 * s + 1] = *(const ALAS bf16x8*)(kb + 32 * KP + s * 32); } \
            __builtin_amdgcn_sched_barrier(0); \
_Pragma("unroll") \
            for (int s = 0; s < NS; ++s) { if (s == 0) { s0 = __builtin_amdgcn_mfma_f32_32x32x16_bf16(kf[0], qf[0], negm, 0, 0, 0); s1 = __builtin_amdgcn_mfma_f32_32x32x16_bf16(kf[1], qf[0], negm, 0, 0, 0); } else { s0 = __builtin_amdgcn_mfma_f32_32x32x16_bf16(kf[2 * s], qf[s], s0, 0, 0, 0); s1 = __builtin_amdgcn_mfma_f32_32x32x16_bf16(kf[2 * s + 1], qf[s], s1, 0, 0, 0); } } \
            __builtin_amdgcn_sched_barrier(0); \
            const ALAS unsigned char* vb_ = lds + OFF_V + buf * VSZ + (4 * h + ((lane & 15) >> 2)) * VP + ((lane >> 4) & 1) * 32 + (lane & 3) * 8; \
            s16x4 vlo[8], vhi[8]; \
_Pragma("unroll") \
            for (int j = 0; j < 4; ++j) { vlo[2 * j] = vtr(vb_ + (16 * j) * VP); vhi[2 * j] = vtr(vb_ + (16 * j + 8) * VP); vlo[2 * j + 1] = vtr(vb_ + (16 * j) * VP + 64); vhi[2 * j + 1] = vtr(vb_ + (16 * j + 8) * VP + 64); } \
            __builtin_amdgcn_sched_barrier(0); \
            const bool need_mask = SWA || (t == 1) || (kfirst + 63 > q0w); \
            if (need_mask) { \
_Pragma("unroll") \
                for (int i = 0; i < 16; ++i) { const int key = kfirst + crow(i, h), key1 = key + 32; \
                    bool ok0 = (key <= q) && (key >= FRONT), ok1 = (key1 <= q) && (key1 >= FRONT); \
                    if (SWA) { ok0 = ok0 && (q - key < 128); ok1 = ok1 && (q - key1 < 128); } \
                    s0[i] = ok0 ? s0[i] : NEGF; s1[i] = ok1 ? s1[i] : NEGF; } \
            } \
            float rm = max3f(s0[0], s0[1], s1[0]), rm2 = max3f(s0[2], s0[3], s1[1]); rm = max3f(rm, s1[2], s1[3]); \
_Pragma("unroll") \
            for (int i = 4; i < 16; i += 4) { rm = max3f(rm, s0[i], s0[i + 1]); rm2 = max3f(rm2, s0[i + 2], s0[i + 3]); rm = max3f(rm, s1[i], s1[i + 1]); rm2 = max3f(rm2, s1[i + 2], s1[i + 3]); } \
            rm = xhalf_max(max2f(rm, rm2)); \
            if (first_ || __any(rm > THR)) { \
                const float dl = first_ ? (rm > -1e29f ? rm : 0.f) : max2f(rm, 0.f); first_ = false; \
                mrun += dl; const float f = __builtin_amdgcn_exp2f(-dl); lrun *= f; \
_Pragma("unroll") \
                for (int i = 0; i < 16; ++i) { s0[i] -= dl; s1[i] -= dl; negm[i] = -mrun; } \
                if (h == 0) scr[r] = f; \
_Pragma("unroll") \
                for (int i = 0; i < 16; ++i) { const float fi = scr[crow(i, h)]; o0[i] *= fi; o1[i] *= fi; } \
            } \
            float ls = 0.f; \
_Pragma("unroll") \
            for (int i = 0; i < 16; ++i) { s0[i] = __builtin_amdgcn_exp2f(s0[i]); s1[i] = __builtin_amdgcn_exp2f(s1[i]); ls += s0[i] + s1[i]; } \
            lrun += ls; \
            const bf16x8 p0 = pack8(s0, 0), p1 = pack8(s0, 1), p2 = pack8(s1, 0), p3 = pack8(s1, 1); \
            __builtin_amdgcn_sched_barrier(0); \
            AT_PVF(p0, 0); AT_PVF(p1, 1); AT_PVF(p2, 2); AT_PVF(p3, 3); \
        } \
        if (t + 1 < NT) AT_LSTORE(buf ^ 1, SS); \
        __syncthreads(); \
    } while (0)
    {
        int t = t0;
        for (; t + 1 < NT; t += 2) { AT_STEP(t, B, A); const int t1 = t + 1; AT_STEP(t1, A, B); }
        if (t < NT) AT_STEP(t, B, A);
    }
#undef AT_STEP
#undef AT_PV
#undef AT_GLOAD
#undef AT_LSTORE
    if (wave_valid) {
        const float lt = lrun + __shfl_xor(lrun, 32);
        if (h == 0) scr[32 + r] = lt;
#pragma unroll
        for (int i = 0; i < 16; ++i) {
            const float li = scr[32 + crow(i, h)], inv = li > 0.f ? 1.0f / li : 0.f;
            const float a = o0[i] * inv, c = o1[i] * inv; const size_t row = rowbase + q0w + crow(i, h);
            ((AGAS bf16_t*)Op)[row * 1024 + r] = f2bf(a); ((AGAS bf16_t*)Op)[row * 1024 + 32 + r] = f2bf(c);
            float ss = a * a + c * c;
            ss += __shfl_xor(ss, 1); ss += __shfl_xor(ss, 2); ss += __shfl_xor(ss, 4); ss += __shfl_xor(ss, 8); ss += __shfl_xor(ss, 16);
            if (r == 0) ((AGAS float*)ssq)[row * 16] = ss;
        }
    }
    __syncthreads();
}
}
typedef unsigned short bf16;
#define LAS __attribute__((address_space(3)))
#define GAS __attribute__((address_space(1)))
constexpr size_t MiB = 1u << 20;
constexpr int NWAVES = 8, NTHREADS = 512;
constexpr int LDS_BYTES = 147456;
static_assert(att::LDS_BYTES <= 131072, "attention LDS");
constexpr size_t WS_CTL = 0, CTL_BYTES = 65536;
constexpr size_t WS_H = 1 * MiB;
constexpr size_t WS_HB = WS_H + (size_t)MROWS * DM * 4;
constexpr size_t WS_W = WS_HB + (size_t)MROWS * DM * 2;
constexpr size_t WL_IN = 0, WL_Q = WL_IN + (size_t)INP * DM * 2, WL_KV = WL_Q + (size_t)768 * 256 * 2, WL_O = WL_KV + (size_t)1024 * 128 * 2,
                 WL_GU = WL_O + (size_t)DM * DM * 2, WL_D = WL_GU + (size_t)GUP * DM * 2, WL_END = WL_D + (size_t)DM * DFF * 2;
constexpr size_t WBUF = 22 * MiB;
static_assert(WL_END <= WBUF, "weight buffer");
constexpr size_t WS_PART = WS_W + 2 * WBUF;
constexpr size_t P_HSSA = 0, P_HSSB = P_HSSA + (size_t)MROWS * 64, P_SSQO = P_HSSB + (size_t)MROWS * 64, P_SSQQ = P_SSQO + (size_t)MROWS * 64, P_SSQKV = P_SSQQ + (size_t)MROWS * 16, P_END = P_SSQKV + (size_t)MROWS * 16;
constexpr size_t PM_H = (P_END + 255) & ~(size_t)255, PM_HB = PM_H + 16 * DM * 4, PM_HSSA = PM_HB + 16 * DM * 2, PM_HSSB = PM_HSSA + 1024, PM_SSQQ = PM_HSSB + 1024, PM_SSQKV = PM_SSQQ + 256,
                 PM_QLAT = PM_SSQKV + 256, PM_KVLAT = PM_QLAT + 16 * 256 * 2, PM_ACT = PM_KVLAT + 16 * 128 * 2, PM_END = PM_ACT + 16 * DFF * 2;
static_assert(PM_END <= 8 * MiB, "partials");
constexpr int MC = BATCH * SEQ;
constexpr size_t WS_R = WS_PART + 8 * MiB;
constexpr size_t R_QA = 0, R_KA = R_QA + (size_t)MROWS * 512 * 2, R_VA = R_KA + (size_t)MROWS * 128 * 2, R_QLAT = R_VA + (size_t)MROWS * 128 * 2, R_KVLAT = R_QLAT + (size_t)MROWS * 256 * 2,
                 R_KR = R_KVLAT + (size_t)MROWS * 128 * 2, R_QM = R_KR + (size_t)MROWS * 32 * 2, R_KN = R_QM + (size_t)MROWS * 768 * 2, R_VB = R_KN + (size_t)MROWS * 512 * 2,
                 R_O = R_VB + (size_t)MROWS * 512 * 2, R_END = R_O + (size_t)MROWS * 1024 * 2;
constexpr size_t R_ACT = 0;
static_assert((size_t)MROWS * DFF * 2 <= R_END, "act overlay");
constexpr size_t WS_END = WS_R + R_END;
static_assert(WS_END <= 512 * MiB, "workspace must fit 512 MiB");

struct Args {
    const float *x, *meta, *attn_norm, *w_in, *q_norm, *w_q_up, *kv_norm, *w_kv_up, *sinks, *out_norm_swa, *out_norm_mla, *w_o, *ffn_norm, *w_gate, *w_up, *w_down, *final_norm;
    float* out; unsigned char* ws; int ph_lo, ph_hi;
};

__device__ __forceinline__ unsigned f2bf_u(float f) { unsigned u = __builtin_bit_cast(unsigned, f); return (u + 0x7fffu + ((u >> 16) & 1u)) >> 16; }
__device__ __forceinline__ unsigned pk2(float lo, float hi) { return f2bf_u(lo) | (f2bf_u(hi) << 16); }
__device__ __forceinline__ float wave_sum(float v) {
#pragma unroll
    for (int o = 1; o < 64; o <<= 1) v += __shfl_xor(v, o);
    return v;
}

__device__ __forceinline__ int src_in(int np) { const int pn = np >> 8, bj = (np >> 7) & 1, o = np & 127;
    if (pn < 2) return (4 * pn + (o >> 5)) * 64 + (o & 31) + 32 * bj;
    if (pn == 2) { if (o < 64) return 512 + (o >> 5) * 64 + (o & 31) + 32 * bj; if (o < 80) return 1152 + (o - 64) + 16 * bj; return -1; }
    if (pn == 3) return bj ? 1024 + o : 640 + o;
    return 768 + 128 * bj + o; }
__device__ __forceinline__ int src_qup(int np) { const int pn = np >> 8, op = np & 255;
    if (pn < 2) return (4 * pn + (op >> 6)) * 96 + (op & 63);
    const int bj = op >> 7, o = op & 127; return (o >> 4) * 96 + 64 + (o & 15) + 16 * bj; }
__device__ __forceinline__ int src_kvup(int np) { const int pn = np >> 8, op = np & 255; return (4 * (pn & 1) + (op >> 6)) * 128 + (pn >= 2 ? 64 : 0) + (op & 63); }

template <int MODE>
__device__ __forceinline__ void conv_item(const float* W, const float* W2, const float* gain, const float* gain2, int K, int Nsrc, bf16* WT, LAS float* scr, int item, int nblk, int lane) {
    const int kb = item / nblk, nb = item % nblk, k0 = 64 * kb, n0 = 32 * nb;
    const int np = n0 + (lane & 31);
    int src; float cs = 1.0f; const float* Wp = W;
    if (MODE == 0) { src = src_in(np); if (np < 512) cs = 0.125f * LOG2E; }
    else if (MODE == 1) { src = src_qup(np); cs = 0.10206207261596577f * LOG2E; }
    else if (MODE == 2) src = src_kvup(np);
    else if (MODE == 4) { src = 128 * (np >> 8) + (np & 127); if ((np >> 7) & 1) Wp = W2; }
    else src = np;
#pragma unroll 8
    for (int i = 0; i < 32; ++i) { const int kk = 2 * i + (lane >> 5), k = k0 + kk;
        float g = 1.0f; if (MODE == 3) g = (k < 512) ? ((const GAS float*)gain)[k] : ((const GAS float*)gain2)[k - 512]; else if (MODE != 5) g = ((const GAS float*)gain)[k];
        scr[kk * 33 + (lane & 31)] = (src >= 0) ? ((const GAS float*)Wp)[(size_t)k * Nsrc + src] * g * cs : 0.0f; }
    asm volatile("s_waitcnt lgkmcnt(0)" ::: "memory");
    const int c = lane & 7;
#pragma unroll
    for (int j = 0; j < 4; ++j) { const int n = (lane >> 3) + 8 * j; const LAS float* s = scr + (8 * c) * 33 + n;
        pg8::u32x4 o; o.x = pk2(s[0 * 33], s[1 * 33]); o.y = pk2(s[2 * 33], s[3 * 33]); o.z = pk2(s[4 * 33], s[5 * 33]); o.w = pk2(s[6 * 33], s[7 * 33]);
        *(GAS pg8::u32x4*)(WT + (size_t)(n0 + n) * K + k0 + 8 * c) = o; }
    asm volatile("s_waitcnt lgkmcnt(0)" ::: "memory");
}
__device__ __forceinline__ void conv_layer(const Args& a, int l, unsigned char* wbuf, LAS unsigned char* lds) {
    int tid_ = threadIdx.x; asm volatile("" : "+v"(tid_));
    const int lane = tid_ & 63, wave = tid_ >> 6;
    LAS float* scr = (LAS float*)(lds + wave * 16384);
    const int gw = blockIdx.x * NWAVES + wave, NGW = gridDim.x * NWAVES;
    constexpr int I0 = (DM / 64) * (INP / 32), I1 = (256 / 64) * (768 / 32), I2 = (128 / 64) * (1024 / 32), I3 = (DM / 64) * (DM / 32), I4 = (DM / 64) * (GUP / 32), I5 = (DFF / 64) * (DM / 32);
    constexpr int NIT = I0 + I1 + I2 + I3 + I4 + I5;
    for (int it = gw; it < NIT; it += NGW) {
        int r = it;
        if (r < I0) { conv_item<0>(a.w_in + (size_t)l * DM * INW, nullptr, a.attn_norm + l * DM, nullptr, DM, INW, (bf16*)(wbuf + WL_IN), scr, r, INP / 32, lane); continue; } r -= I0;
        if (r < I1) { conv_item<1>(a.w_q_up + (size_t)l * 256 * 768, nullptr, a.q_norm + l * 256, nullptr, 256, 768, (bf16*)(wbuf + WL_Q), scr, r, 768 / 32, lane); continue; } r -= I1;
        if (r < I2) { conv_item<2>(a.w_kv_up + (size_t)l * 128 * 1024, nullptr, a.kv_norm + l * 128, nullptr, 128, 1024, (bf16*)(wbuf + WL_KV), scr, r, 1024 / 32, lane); continue; } r -= I2;
        if (r < I3) { conv_item<3>(a.w_o + (size_t)l * DM * DM, nullptr, a.out_norm_swa + l * 512, a.out_norm_mla + l * 512, DM, DM, (bf16*)(wbuf + WL_O), scr, r, DM / 32, lane); continue; } r -= I3;
        if (r < I4) { conv_item<4>(a.w_gate + (size_t)l * DM * DFF, a.w_up + (size_t)l * DM * DFF, a.ffn_norm + l * DM, nullptr, DM, DFF, (bf16*)(wbuf + WL_GU), scr, r, GUP / 32, lane); continue; } r -= I4;
        conv_item<5>(a.w_down + (size_t)l * DFF * DM, nullptr, nullptr, nullptr, DFF, DM, (bf16*)(wbuf + WL_D), scr, r, DM / 32, lane);
    }
}

__device__ __forceinline__ void init_rows(const Args& a, unsigned char* ws) {
    const int lane = threadIdx.x & 63, wave = threadIdx.x >> 6; const int gw = blockIdx.x * NWAVES + wave, NGW = gridDim.x * NWAVES;
    for (int row = gw; row < MC + NMETA; row += NGW) {
        const bool meta = row >= MC; const int r = meta ? row - MC : row;
        const float* src = meta ? a.meta + (size_t)r * DM : a.x + (size_t)r * DM;
        float* H = (float*)(ws + (meta ? WS_PART + PM_H : WS_H)); bf16* HB = (bf16*)(ws + (meta ? WS_PART + PM_HB : WS_HB)); float* hss = (float*)(ws + WS_PART + (meta ? PM_HSSA : P_HSSA));
        pg8::f32x4 v[4]; float s = 0.f;
#pragma unroll
        for (int j = 0; j < 4; ++j) { v[j] = *((const GAS pg8::f32x4*)src + lane + 64 * j); s += pg8::sq4(v[j]); }
        s = wave_sum(s);
#pragma unroll
        for (int j = 0; j < 4; ++j) { pg8::st_bf16x4(HB + (size_t)r * DM + 4 * (lane + 64 * j), v[j]); }
        if (lane < 16) ((GAS float*)hss)[(size_t)r * 16 + lane] = (lane == 0) ? s : 0.f;
    }
}
__device__ __forceinline__ void final_rows(const Args& a, const bf16* HBf, const float* hss) {
    const int lane = threadIdx.x & 63, wave = threadIdx.x >> 6; const int gw = blockIdx.x * NWAVES + wave, NGW = gridDim.x * NWAVES;
    for (int o = gw; o < BATCH * SEQ; o += NGW) {
        const int row = o;
        const float rs = pg8::rsq(pg8::sum16(hss, row) * (1.0f / DM) + RMS_EPS);
#pragma unroll
        for (int j = 0; j < 4; ++j) { const pg8::u32x2 hw = *((const GAS pg8::u32x2*)(HBf + (size_t)row * DM) + lane + 64 * j); pg8::f32x4 v; v[0] = __builtin_bit_cast(float, hw.x << 16); v[1] = __builtin_bit_cast(float, hw.x & 0xffff0000u); v[2] = __builtin_bit_cast(float, hw.y << 16); v[3] = __builtin_bit_cast(float, hw.y & 0xffff0000u);
            const pg8::f32x4 g = *((const GAS pg8::f32x4*)a.final_norm + lane + 64 * j);
            *((GAS pg8::f32x4*)(a.out + (size_t)o * DM) + lane + 64 * j) = v * rs * g; }
    }
}

constexpr int N_ATT_UNITS = 2 * 17 * 64;
__device__ __forceinline__ void attn_phase(const Args& a, int l, unsigned char* ws, LAS unsigned char* lds, int mode = 0) {
    const int lq = l; l &= 3;
    unsigned char* R = ws + WS_R;
    const bf16 *QA = (const bf16*)(R + R_QA), *KA = (const bf16*)(R + R_KA), *VA = (const bf16*)(R + R_VA), *KR = (const bf16*)(R + R_KR), *QM = (const bf16*)(R + R_QM), *KN = (const bf16*)(R + R_KN), *VB = (const bf16*)(R + R_VB);
    bf16* O = (bf16*)(R + R_O); float* ssqO = (float*)(ws + WS_PART + P_SSQO);
    LAS int* qslot = (LAS int*)(lds + att::OFF_Q);
    const unsigned xcc = ((unsigned)__builtin_amdgcn_s_getreg((3 << 11) | 20) & 0xFu) & 7u;
    unsigned* ctr = (unsigned*)(ws + WS_CTL) + 64 * lq + 8 * 64 * (int)xcc;
    constexpr int PER_X = N_ATT_UNITS / 8;
    for (int pass = 0; pass < 8; ++pass) {
        const unsigned x = (xcc + (unsigned)pass) & 7u; unsigned* c = (unsigned*)(ws + WS_CTL) + 64 * lq + 8 * 64 * (int)x;
        for (;;) {
            if (threadIdx.x == 0) *qslot = (int)atomicAdd(c, 1u);
            __syncthreads();
            const int u = *qslot;
            __syncthreads();
            if (u >= (mode == 1 ? PER_X / 2 : PER_X)) break;
            if (u < PER_X / 2) {
                const int bh = 8 * (u / 17) + (int)x, qb = 16 - u % 17, b = bh >> 3, hd = bh & 7;
                att::attn_unit<96, false>(lds, QM + hd * 96, 768, KN + hd * 64, 512, KR, VB + hd * 64, 512, O + 512 + hd * 64, ssqO + 8 + hd, 0.f, b, qb);
            } else {
                const int v = u - PER_X / 2; const int bh = 8 * (v / 17) + (int)x, qb = 16 - v % 17, b = bh >> 3, hq = bh & 7, kv = hq >> 2;
                att::attn_unit<64, true>(lds, QA + hq * 64, 512, KA + kv * 64, 128, nullptr, VA + kv * 64, 128, O + hq * 64, ssqO + hq, a.sinks[l * 8 + hq] * LOG2E, b, qb);
            }
        }
    }
    (void)ctr;
}

#define XB_TMO      128
#define XB_XCNT(j)  (256  + 64 * (j))
#define XB_XSUB(j)  (1280 + 64 * (j))
#define XB_XGEN(j)  (2304 + 64 * (j))
#define XB_TOP      3328
#define XB_TOPGEN   3392
#define XCD_BAR_WORDS 3456
#define XB_SPIN_CAP (1u << 18)

__device__ __forceinline__ unsigned xb_ld(unsigned* p)              { return __hip_atomic_load(p, __ATOMIC_RELAXED, __HIP_MEMORY_SCOPE_AGENT); }
__device__ __forceinline__ unsigned xb_add(unsigned* p, unsigned v) { return __hip_atomic_fetch_add(p, v, __ATOMIC_RELAXED, __HIP_MEMORY_SCOPE_AGENT); }
__device__ __forceinline__ unsigned xb_xcc_id() { return (unsigned)__builtin_amdgcn_s_getreg((3 << 11) | 20) & 0xFu; }
#define XB_SPIN(cond, bar) do { unsigned _sp = 0; while (cond) { __builtin_amdgcn_s_sleep(1); \
    if ((++_sp & 255u) == 0u) { if (xb_ld(&(bar)[XB_TMO])) break; if (_sp > XB_SPIN_CAP) { atomicAdd(&(bar)[XB_TMO], 1u); break; } } } } while (0)

struct XcdBarrier {
    unsigned* bar; unsigned x;
    volatile LAS unsigned* st;
};

__device__ __forceinline__ XcdBarrier xcd_barrier_post(unsigned* bar, volatile LAS unsigned* st) {
    XcdBarrier b; b.bar = bar; b.x = xb_xcc_id(); b.st = st;
    if (threadIdx.x == 0) (void)xb_add(&bar[XB_XCNT(b.x)], 1u);
    return b;
}
__device__ __forceinline__ void xcd_barrier_complete(unsigned* bar, unsigned x, unsigned& nloc, unsigned& nx) {
    const unsigned G = gridDim.x * gridDim.y * gridDim.z;
    unsigned sum, cnt, mine, sp = 0u;
    for (;;) {
        sum = 0u; cnt = 0u; mine = 0u;
#pragma unroll
        for (unsigned j = 0; j < 16; ++j) { const unsigned c = xb_ld(&bar[XB_XCNT(j)]); sum += c; cnt += (c > 0u) ? 1u : 0u; mine = (j == x) ? c : mine; }
        if (sum == G) break;
        __builtin_amdgcn_s_sleep(1);
        if ((++sp & 255u) == 0u) { if (xb_ld(&bar[XB_TMO])) break; if (sp > XB_SPIN_CAP) { atomicAdd(&bar[XB_TMO], 1u); break; } }
    }
    nloc = mine > 0u ? mine : 1u; nx = cnt > 0u ? cnt : 1u;
}

__device__ __forceinline__ void xcd_barrier(const XcdBarrier& b) {
    asm volatile("s_waitcnt vmcnt(0)" ::: "memory");
    __syncthreads();
    if (threadIdx.x == 0) {
        unsigned* bar = b.bar;
        __builtin_amdgcn_s_waitcnt(0);
        unsigned nloc = b.st[0], nx = b.st[1];
        if (nloc == 0u) { xcd_barrier_complete(bar, b.x, nloc, nx); b.st[0] = nloc; b.st[1] = nx; }
        const unsigned old = xb_add(&bar[XB_XSUB(b.x)], 1u);
        const unsigned gen = old / nloc;
        if (old + 1u == (gen + 1u) * nloc) {
            __builtin_amdgcn_fence(__ATOMIC_RELEASE, "agent");
            asm volatile("s_waitcnt vmcnt(0)" ::: "memory");
            const unsigned og = xb_add(&bar[XB_TOP], 1u);
            const unsigned tg = og / nx;
            if (og + 1u == (tg + 1u) * nx) xb_add(&bar[XB_TOPGEN], 1u);
            else XB_SPIN(xb_ld(&bar[XB_TOPGEN]) == tg, bar);
            __builtin_amdgcn_fence(__ATOMIC_ACQUIRE, "agent");
            xb_add(&bar[XB_XGEN(b.x)], 1u);
            asm volatile("s_waitcnt vmcnt(0)" ::: "memory");
        } else {
            XB_SPIN(xb_ld(&bar[XB_XGEN(b.x)]) == gen, bar);
            __builtin_amdgcn_fence(__ATOMIC_ACQUIRE, "agent");
            asm volatile("s_waitcnt vmcnt(0)" ::: "memory");
        }
    }
    __syncthreads();
}

constexpr int CW_BAR = 4096;
constexpr int XB_LDS_OFF = 131072 + 8192;
#ifndef PHM
#define PHM 255
#endif
#ifndef PROBE_DUP
#define PROBE_DUP 0
#endif
#ifndef PROBE_SYNC
#define PROBE_SYNC 0
#endif
__global__ void __launch_bounds__(NTHREADS, 2) fwd_megakernel(Args a) {
    extern __shared__ __attribute__((aligned(16))) unsigned char lds_raw[];
    LAS unsigned char* lds = (LAS unsigned char*)lds_raw;
    cg::grid_group grid = cg::this_grid();
    const int lo = a.ph_lo, hi = a.ph_hi;
    if (threadIdx.x < 2) ((LAS unsigned*)(lds + XB_LDS_OFF))[threadIdx.x] = 0u;
    __syncthreads();
    if (a.ph_hi < 0) grid.sync();
    const XcdBarrier xbar = xcd_barrier_post((unsigned*)(a.ws + WS_CTL) + CW_BAR, (volatile LAS unsigned*)(lds + XB_LDS_OFF));
#define IN_PH(k) (lo <= (k) && (k) < hi)
#define SEAM(k) do { if (IN_PH(k) && IN_PH((k) + 1)) { xcd_barrier(xbar); if (PROBE_SYNC) xcd_barrier(xbar); } } while (0)
#define WSL(w) unsigned char* w = a.ws; asm volatile("" : "+s"(w))
    if (IN_PH(0) && (PHM & 1)) { WSL(ws); init_rows(a, ws); conv_layer(a, 0, ws + WS_W, lds); __syncthreads(); }
    SEAM(0);
#pragma unroll 1
    for (int l = 0; l < DEPTH; ++l) {
        const int p = 1 + 6 * l;
        if (IN_PH(p) && (PHM & 2)) {
            { WSL(ws); unsigned char* R = ws + WS_R; unsigned char* wb = ws + WS_W + (size_t)(l & 1) * WBUF; unsigned char* pm_ = ws + WS_PART;
              pg8::EpiIn<true> E{(const float*)(pm_ + PM_HSSA), (bf16*)(R + R_QA), (bf16*)(R + R_KA), (bf16*)(R + R_VA), (bf16*)(pm_ + PM_QLAT), (bf16*)(pm_ + PM_KVLAT), (bf16*)(R + R_KR), (float*)(pm_ + PM_SSQQ), (float*)(pm_ + PM_SSQKV)};
              pg8::skinny_phase<DM>(lds, (const bf16*)(pm_ + PM_HB), (const bf16*)(wb + WL_IN), INP / 256, E, 128); }
            WSL(ws); unsigned char* R = ws + WS_R; unsigned char* wb = ws + WS_W + (size_t)(l & 1) * WBUF;
            pg8::Gemm g{(const bf16*)(ws + WS_HB), (const bf16*)(wb + WL_IN), MC, INP, DM, 0}; pg8::OrderCT<MC / 256, INP / 256> S; S.init((int)gridDim.x, (int)blockIdx.x);
            pg8::EpiIn<false> E{(const float*)(ws + WS_PART + P_HSSA), (bf16*)(R + R_QA), (bf16*)(R + R_KA), (bf16*)(R + R_VA), (bf16*)(R + R_QLAT), (bf16*)(R + R_KVLAT), (bf16*)(R + R_KR),
                         (float*)(ws + WS_PART + P_SSQQ), (float*)(ws + WS_PART + P_SSQKV)};
            pg8::gemm_phase<pg8::EpiIn<false>, pg8::OrderCT<MC / 256, INP / 256>, true, true>(lds, g, S, E);
            if (PROBE_DUP & 2) pg8::gemm_phase<pg8::EpiIn<false>, pg8::OrderCT<MC / 256, INP / 256>, true, true>(lds, g, S, E);
        }
        SEAM(p);
        if (IN_PH(p + 1) && (PHM & 4)) {
            { WSL(ws); unsigned char* R = ws + WS_R; unsigned char* wb = ws + WS_W + (size_t)(l & 1) * WBUF; unsigned char* pm_ = ws + WS_PART;
              pg8::EpiQup<true> E{(const float*)(pm_ + PM_SSQQ), (bf16*)(R + R_QM)}; pg8::skinny_phase<256>(lds, (const bf16*)(pm_ + PM_QLAT), (const bf16*)(wb + WL_Q), 3, E, 128); }
            { WSL(ws); unsigned char* R = ws + WS_R; unsigned char* wb = ws + WS_W + (size_t)(l & 1) * WBUF;
              pg8::Gemm g{(const bf16*)(R + R_QLAT), (const bf16*)(wb + WL_Q), MC, 768, 256, 0}; pg8::OrderCT<MC / 256, 3> S; S.init((int)gridDim.x, (int)blockIdx.x);
              pg8::EpiQup<false> E{(const float*)(ws + WS_PART + P_SSQQ), (bf16*)(R + R_QM)}; pg8::gemm_phase<pg8::EpiQup<false>, pg8::OrderCT<MC / 256, 3>, true, true>(lds, g, S, E); if (PROBE_DUP & 4) pg8::gemm_phase<pg8::EpiQup<false>, pg8::OrderCT<MC / 256, 3>, true, true>(lds, g, S, E); }
            { WSL(ws); unsigned char* R = ws + WS_R; unsigned char* wb = ws + WS_W + (size_t)(l & 1) * WBUF; unsigned char* pm_ = ws + WS_PART;
              pg8::EpiKvup<true> E{(const float*)(pm_ + PM_SSQKV), (bf16*)(R + R_KN), (bf16*)(R + R_VB)}; pg8::skinny_phase<128>(lds, (const bf16*)(pm_ + PM_KVLAT), (const bf16*)(wb + WL_KV), 4, E, 0); }
            { WSL(ws); unsigned char* R = ws + WS_R; unsigned char* wb = ws + WS_W + (size_t)(l & 1) * WBUF;
              pg8::Gemm g{(const bf16*)(R + R_KVLAT), (const bf16*)(wb + WL_KV), MC, 1024, 128, 0}; pg8::OrderCT<MC / 256, 4> S; S.init((int)gridDim.x, (int)blockIdx.x);
              pg8::EpiKvup<false> E{(const float*)(ws + WS_PART + P_SSQKV), (bf16*)(R + R_KN), (bf16*)(R + R_VB)}; pg8::gemm_phase<pg8::EpiKvup<false>, pg8::OrderCT<MC / 256, 4>, true, true>(lds, g, S, E); if (PROBE_DUP & 4) pg8::gemm_phase<pg8::EpiKvup<false>, pg8::OrderCT<MC / 256, 4>, true, true>(lds, g, S, E); }
        }
        SEAM(p + 1);
        if (IN_PH(p + 2) && (PHM & 8)) { WSL(ws); if (l + 1 < DEPTH) { conv_layer(a, l + 1, ws + WS_W + (size_t)((l + 1) & 1) * WBUF, lds); __syncthreads(); if (PROBE_DUP & 256) { conv_layer(a, l + 1, ws + WS_W + (size_t)((l + 1) & 1) * WBUF, lds); __syncthreads(); } } attn_phase(a, l, ws, lds); if (PROBE_DUP & 8) attn_phase(a, l + 4, ws, lds); if (PROBE_DUP & 1024) attn_phase(a, l + 4, ws, lds, 1); }
        SEAM(p + 2);
        if (IN_PH(p + 3) && (PHM & 16)) {
            { WSL(ws); unsigned char* R = ws + WS_R; unsigned char* wb = ws + WS_W + (size_t)(l & 1) * WBUF; unsigned char* pm_ = ws + WS_PART;
              pg8::EpiOut<true> E; E.H = (float*)(pm_ + PM_H); E.HB = (bf16*)(pm_ + PM_HB); E.hss_out = (float*)(pm_ + PM_HSSB); E.ssq_o = (const float*)(pm_ + P_SSQO); E.xlds = lds;
              pg8::skinny_phase<DM>(lds, (const bf16*)(R + R_O) + (size_t)FRONT * 1024, (const bf16*)(wb + WL_O), 4, E, 0); }
            WSL(ws); unsigned char* R = ws + WS_R; unsigned char* wb = ws + WS_W + (size_t)(l & 1) * WBUF;
            pg8::Gemm g{(const bf16*)(R + R_O), (const bf16*)(wb + WL_O), MC, DM, DM, 1}; pg8::OrderCT<MC / 256, 4> S; S.init((int)gridDim.x, (int)blockIdx.x);
            pg8::EpiOut<false> E; E.H = (float*)(ws + WS_H); E.HB = (bf16*)(ws + WS_HB); E.hss_out = (float*)(ws + WS_PART + P_HSSB); E.ssq_o = (const float*)(ws + WS_PART + P_SSQO); E.xlds = lds + pg8::STAGE_BYTES;
            pg8::gemm_phase<pg8::EpiOut<false>, pg8::OrderCT<MC / 256, 4>, true, true>(lds, g, S, E);
        }
        SEAM(p + 3);
        if (IN_PH(p + 4) && (PHM & 32)) {
            { WSL(ws); unsigned char* wb = ws + WS_W + (size_t)(l & 1) * WBUF; unsigned char* pm_ = ws + WS_PART;
              pg8::EpiGU<true> E{(const float*)(pm_ + PM_HSSB), (bf16*)(pm_ + PM_ACT)}; pg8::skinny_phase<DM>(lds, (const bf16*)(pm_ + PM_HB), (const bf16*)(wb + WL_GU), GUP / 256, E, 0); }
            WSL(ws); unsigned char* R = ws + WS_R; unsigned char* wb = ws + WS_W + (size_t)(l & 1) * WBUF;
            pg8::Gemm g{(const bf16*)(ws + WS_HB), (const bf16*)(wb + WL_GU), MC, GUP, DM, 0}; pg8::OrderCT<MC / 256, GUP / 256> S; S.init((int)gridDim.x, (int)blockIdx.x);
            pg8::EpiGU<false> E{(const float*)(ws + WS_PART + P_HSSB), (bf16*)(R + R_ACT)};
            pg8::gemm_phase<pg8::EpiGU<false>, pg8::OrderCT<MC / 256, GUP / 256>, true, true>(lds, g, S, E);
        }
        SEAM(p + 4);
        if (IN_PH(p + 5) && (PHM & 64)) {
            { WSL(ws); unsigned char* wb = ws + WS_W + (size_t)(l & 1) * WBUF; unsigned char* pm_ = ws + WS_PART;
              pg8::EpiDown<true> E; E.H = (float*)(pm_ + PM_H); E.HB = (bf16*)(pm_ + PM_HB); E.hss_out = (float*)(pm_ + PM_HSSA); E.ssq_o = nullptr;
              pg8::skinny_phase<DFF>(lds, (const bf16*)(pm_ + PM_ACT), (const bf16*)(wb + WL_D), 4, E, 0); }
            WSL(ws); unsigned char* R = ws + WS_R; unsigned char* wb = ws + WS_W + (size_t)(l & 1) * WBUF;
            pg8::Gemm g{(const bf16*)(R + R_ACT), (const bf16*)(wb + WL_D), MC, DM, DFF, 0}; pg8::OrderCT<MC / 256, 4> S; S.init((int)gridDim.x, (int)blockIdx.x);
            pg8::EpiDown<false> E; E.H = (float*)(ws + WS_H); E.HB = (bf16*)(ws + WS_HB); E.hss_out = (float*)(ws + WS_PART + P_HSSA); E.ssq_o = nullptr;
            pg8::gemm_phase<pg8::EpiDown<false>, pg8::OrderCT<MC / 256, 4>, true, true>(lds, g, S, E);
        }
        SEAM(p + 5);
    }
    if (IN_PH(1 + 6 * DEPTH) && (PHM & 128)) { WSL(ws); final_rows(a, (const bf16*)(ws + WS_HB), (const float*)(ws + WS_PART + P_HSSA)); }
#undef IN_PH
#undef SEAM
#undef WSL
}
constexpr int N_PHASES = 2 + 6 * DEPTH;

#ifndef MK_SPLIT
#define MK_SPLIT 0
#endif
extern "C" void kernel_launch(void* const* d_in, const int* in_sizes, int n_in, void* d_out, int out_size, void* d_ws, size_t ws_size, hipStream_t stream) {
    static int grid = 0;
    if (grid == 0) {
        if (n_in != 17 || ws_size < WS_END) { fprintf(stderr, "kernel_launch: need 17 inputs and >= %zu bytes of workspace; got n_in %d, ws %zu\n", (size_t)WS_END, n_in, ws_size); grid = -1; return; }
        int dev = 0, cus = 0, per_cu = 0;
        hipGetDevice(&dev); hipDeviceGetAttribute(&cus, hipDeviceAttributeMultiprocessorCount, dev);
        if (hipFuncSetAttribute((const void*)fwd_megakernel, hipFuncAttributeMaxDynamicSharedMemorySize, LDS_BYTES) != hipSuccess) { fprintf(stderr, "kernel_launch: hipFuncSetAttribute failed\n"); grid = -1; return; }
        if (hipOccupancyMaxActiveBlocksPerMultiprocessor(&per_cu, (const void*)fwd_megakernel, NTHREADS, LDS_BYTES) != hipSuccess || per_cu < 1) { fprintf(stderr, "kernel_launch: occupancy query says %d\n", per_cu); per_cu = 1; }
        (void)hipGetLastError();
        grid = cus * 1;
    }
    if (grid < 0) return;
    hipMemsetAsync((char*)d_ws + WS_CTL, 0, CTL_BYTES, stream);
    Args a{};
    const float** f = (const float**)&a;
    for (int i = 0; i < 17; ++i) f[i] = (const float*)d_in[i];
    a.out = (float*)d_out; a.ws = (unsigned char*)d_ws;
#if MK_SPLIT
    for (int ph = 0; ph < N_PHASES; ++ph) { a.ph_lo = ph; a.ph_hi = ph + 1; hipLaunchKernelGGL(fwd_megakernel, dim3(grid), dim3(NTHREADS), LDS_BYTES, stream, a); }
#else
    a.ph_lo = 0; a.ph_hi = N_PHASES;
    void* args[] = {&a};
    hipError_t e = hipLaunchCooperativeKernel((const void*)fwd_megakernel, dim3(grid), dim3(NTHREADS), args, LDS_BYTES, stream);
    if (e != hipSuccess) fprintf(stderr, "cooperative launch failed: %s (grid %d)\n", hipGetErrorString(e), grid);
#endif
}
```

```cpp
#include <hip/hip_runtime.h>
#include <hip/hip_cooperative_groups.h>
#include <cstdio>
#include <cstdint>
namespace cg = cooperative_groups;

constexpr int BATCH = 8, SEQ = 4096, DM = 1024, DEPTH = 4, NMETA = 16, FRONT = 112, TT = 4224;
constexpr int MROWS = BATCH * TT;
constexpr int INW = 1184, INP = 1280, DFF = 2816, GUP = 2 * DFF;
constexpr float RMS_EPS = 1e-6f;
constexpr float LOG2E = 1.4426950408889634f;
constexpr float LOG2_THETA = 13.287712379549449f;
constexpr float INV_2PI = 0.15915494309189535f;

namespace pg8 {
#define PG8_LAS __attribute__((address_space(3)))
typedef unsigned short bf16_t;
typedef short bf16x8 __attribute__((ext_vector_type(8)));
typedef float f32x4 __attribute__((ext_vector_type(4)));
typedef unsigned u32x4 __attribute__((ext_vector_type(4)));
constexpr int BM = 256, BK = 64, HALF = 128, HTB = HALF * BK * 2  , STAGE_BYTES = 8 * HTB, NXCD = 8, WGM = 8;

__host__ __device__ __forceinline__ int lds_byte(int r, int c) { const int st = (r >> 4) * 2 + (c >> 5), rr = r & 15, cc = c & 31, ob = rr * 64 + cc * 2; return st * 1024 + (ob ^ (((ob >> 9) & 1) << 5)); }
__host__ __device__ __forceinline__ void stage_rc(int b, int& R, int& C) { const int st = b / 1024, sb = b % 1024, swz = sb ^ (((sb >> 9) & 1) << 5); R = (st >> 1) * 16 + swz / 64; C = (st & 1) * 32 + (swz % 64) / 2; }
__host__ __device__ __forceinline__ int perm32(int rho) { const int n = rho >> 4, i = rho & 15; return 8 * (i >> 2) + 4 * n + (i & 3); }

struct Unit { int pm, pn; };
struct Gemm { const bf16_t* A; const bf16_t* Bt; int M, N, K; int apad; };

struct StaticOrder {
    int nM, nN, nwg, G, c;
    __host__ __device__ void init(int M, int N, int G_, int c_) { nM = M / BM; nN = N / BM; nwg = nM * nN; G = G_; c = c_; }
    __host__ __device__ bool next(int i, Unit& u) const {
        const long L = (long)i * G + c; if (L >= nwg) return false;
        int wgid = (int)L; { const int q = nwg / NXCD, r = nwg % NXCD, xcd = wgid % NXCD, off = wgid / NXCD; wgid = (xcd < r ? xcd * (q + 1) : r * (q + 1) + (xcd - r) * q) + off; }
        const int nig = WGM * nN, gid = wgid / nig, fm = gid * WGM, gsz = (nM - fm) < WGM ? (nM - fm) : WGM;
        u.pm = fm + ((wgid % nig) % gsz); u.pn = (wgid % nig) / gsz; return true;
    }
    __device__ __forceinline__ void a_ready(const Unit&) const {}
    __device__ __forceinline__ void done(const Unit&) const {}
};

__device__ __forceinline__ unsigned cvt_pk_bf16(float lo, float hi) { unsigned r; asm volatile("v_cvt_pk_bf16_f32 %0, %1, %2" : "=v"(r) : "v"(lo), "v"(hi)); return r; }

template <int NM, int NN> struct OrderCT {
    static_assert(NM % 8 == 0 || NM % 8 == 4, "last M group must be 8 or 4 tiles");
    int G, c;
    __device__ __forceinline__ void init(int G_, int c_) { G = G_; c = c_; }
    __device__ __forceinline__ bool next(int i, Unit& u) const {
        constexpr int nwg = NM * NN, q = nwg / NXCD, r = nwg % NXCD, nig = WGM * NN;
        const int L = i * G + c; if (L >= nwg) return false;
        const int xcd = L & (NXCD - 1), off = L >> 3;
        const int wgid = (xcd < r ? xcd * (q + 1) : r * (q + 1) + (xcd - r) * q) + off;
        const int gid = wgid / nig, rem = wgid - gid * nig, fm = gid * WGM;
        const int sh = (NM - fm) < WGM ? 2 : 3;
        u.pm = fm + (rem & ((1 << sh) - 1)); u.pn = rem >> sh; return true;
    }
    __device__ __forceinline__ void a_ready(const Unit&) const {}
    __device__ __forceinline__ void done(const Unit&) const {}
};
typedef unsigned u32x2 __attribute__((ext_vector_type(2)));
#define PG8_GAS __attribute__((address_space(1)))
__device__ __forceinline__ void st_bf16x4(bf16_t* p, f32x4 v) { u32x2 w; w.x = cvt_pk_bf16(v[0], v[1]); w.y = cvt_pk_bf16(v[2], v[3]); *(PG8_GAS u32x2*)p = w; }
__device__ __forceinline__ void st_bf16x8(bf16_t* p, f32x4 v0, f32x4 v1) { u32x4 w; w.x = cvt_pk_bf16(v0[0], v0[1]); w.y = cvt_pk_bf16(v0[2], v0[3]); w.z = cvt_pk_bf16(v1[0], v1[1]); w.w = cvt_pk_bf16(v1[2], v1[3]); *(PG8_GAS u32x4*)p = w; }
__device__ __forceinline__ float sum16(const float* part, int row) {
    const PG8_GAS f32x4* p = (const PG8_GAS f32x4*)(part + (size_t)row * 16); const f32x4 a = p[0], b = p[1], c = p[2], d = p[3];
    return (((a.x + a.y) + (a.z + a.w)) + ((b.x + b.y) + (b.z + b.w))) + (((c.x + c.y) + (c.z + c.w)) + ((d.x + d.y) + (d.z + d.w)));
}
__device__ __forceinline__ float sum16q(const float* part, int row, int fq) {
    const f32x4 a = *((const PG8_GAS f32x4*)(part + (size_t)row * 16) + fq); float s = (a.x + a.y) + (a.z + a.w);
    s += __shfl_xor(s, 16); s += __shfl_xor(s, 32); return s;
}
__device__ __forceinline__ float sum4(const float* part, int row) { const f32x4 a = *(const PG8_GAS f32x4*)(part + (size_t)row * 4); return (a.x + a.y) + (a.z + a.w); }
__device__ __forceinline__ float rsq(float x) { return 1.0f / sqrtf(x); }
__device__ __forceinline__ float sq4(f32x4 v) { return (v[0] * v[0] + v[1] * v[1]) + (v[2] * v[2] + v[3] * v[3]); }
#define EPI_ROWS(ai, m) for (int ai = 0; ai < 2; ++ai) for (int m = 0; m < 4; ++m)
#define EPI_ROW(u, ai, m) ((u).pm * BM + (ai) * HALF + wr * 64 + (m) * 16 + fr)

__device__ __forceinline__ int prow_of(int m) { return m + (m >> 12) * 128 + 128; }
#define EPI_NB (META ? BATCH : 1)
#define EPI_PROW(row, b) (META ? (size_t)((b) * TT + FRONT + (row)) : (size_t)prow_of(row))
#define EPI_MAIN_LOOP(CALL) _Pragma("unroll") for (int ai = 0; ai < 2; ++ai) _Pragma("unroll") for (int m = 0; m < 4; ++m) { asm volatile("" ::: "memory"); const int row = EPI_ROW(u, ai, m); \
        const f32x4 a_[2][2] = {{acc[ai][0][m][0], acc[ai][0][m][1]}, {acc[ai][1][m][0], acc[ai][1][m][1]}}; CALL; }

template <bool META> struct EpiIn {
    static constexpr bool PERM = true, AFTER_DRAIN = false, MIDSCALE = false;
    const float* hss; bf16_t *qa, *ka, *va, *qlat, *kvlat, *kr; float *ssq_q, *ssq_kv;
    __device__ __forceinline__ void mid(f32x4 (&)[2][2][4][2], const Unit&, int, int, int, int) const {}
    __device__ __forceinline__ void row_epi(const f32x4 (&a)[2][2], int row, int pn, int wc, int fr, int fq) const {
        const float rs = rsq(sum16q(hss, row, fq) * (1.0f / DM) + RMS_EPS);
        if (pn <= 2) {
            const bool is_kr = (pn == 2 && wc == 2);
            if (pn == 2 && wc == 3) return;
            const float pos = META ? (float)row : (float)((row & 4095) + NMETA);
            f32x4 o1[2], o2[2];
#pragma unroll
            for (int n = 0; n < 2; ++n) {
                const f32x4 x1 = a[0][n] * rs, x2 = a[1][n] * rs;
#pragma unroll
                for (int e = 0; e < 4; ++e) { const float d1 = (float)(8 * fq + 4 * n + e); const float inv = __builtin_amdgcn_exp2f(-d1 * (is_kr ? (LOG2_THETA / 16.0f) : (LOG2_THETA / 32.0f)));
                    const float ang = pos * inv; float rev = ang * INV_2PI; rev = rev - floorf(rev);
                    const float sn = __builtin_amdgcn_sinf(rev), cs = __builtin_amdgcn_cosf(rev); o1[n][e] = x1[e] * cs - x2[e] * sn; o2[n][e] = x2[e] * cs + x1[e] * sn; }
            }
            if (is_kr && fq >= 2) return;
#pragma unroll
            for (int b = 0; b < EPI_NB; ++b) { const size_t pr = EPI_PROW(row, b); bf16_t* d; int half;
                if (pn < 2) { d = qa + pr * 512 + (4 * pn + wc) * 64 + 8 * fq; half = 32; }
                else if (!is_kr) { d = ka + pr * 128 + wc * 64 + 8 * fq; half = 32; }
                else { d = kr + pr * 32 + 8 * fq; half = 16; }
                st_bf16x8(d, o1[0], o1[1]); st_bf16x8(d + half, o2[0], o2[1]); }
        } else if (pn == 3) {
            const int c = 32 * wc + 8 * fq; const f32x4 v0 = a[0][0] * rs, v1 = a[0][1] * rs, w0 = a[1][0] * rs, w1 = a[1][1] * rs;
#pragma unroll
            for (int b = 0; b < EPI_NB; ++b) st_bf16x8(va + EPI_PROW(row, b) * 128 + c, v0, v1);
            st_bf16x8(kvlat + (size_t)row * 128 + c, w0, w1);
            float ss = sq4(w0) + sq4(w1);
            ss += __shfl_xor(ss, 16); ss += __shfl_xor(ss, 32);
            if (fq == 0) ((PG8_GAS float*)ssq_kv)[(size_t)row * 4 + wc] = ss;
        } else {
            float ss = 0.f;
#pragma unroll
            for (int bj = 0; bj < 2; ++bj) { const int c = 128 * bj + 32 * wc + 8 * fq; const f32x4 v0 = a[bj][0] * rs, v1 = a[bj][1] * rs; st_bf16x8(qlat + (size_t)row * 256 + c, v0, v1); ss += sq4(v0) + sq4(v1); }
            ss += __shfl_xor(ss, 16); ss += __shfl_xor(ss, 32);
            if (fq == 0) ((PG8_GAS float*)ssq_q)[(size_t)row * 4 + wc] = ss;
        }
    }
    __device__ __forceinline__ void operator()(const f32x4 (&acc)[2][2][4][2], const Unit& u, int wr, int wc, int fr, int fq) const { EPI_MAIN_LOOP(row_epi(a_, row, u.pn, wc, fr, fq)) }
};

template <bool META> struct EpiQup {
    static constexpr bool PERM = true, AFTER_DRAIN = false, MIDSCALE = false;
    const float* ssq_q; bf16_t* qm;
    __device__ __forceinline__ void mid(f32x4 (&)[2][2][4][2], const Unit&, int, int, int, int) const {}
    __device__ __forceinline__ void row_epi(const f32x4 (&a)[2][2], int row, int pn, int wc, int fr, int fq) const {
        const float rs = rsq(sum4(ssq_q, row) * (1.0f / 256.0f) + RMS_EPS);
        if (pn < 2) {
#pragma unroll
            for (int bj = 0; bj < 2; ++bj) { const int head = 4 * pn + 2 * bj + (wc >> 1), d = 32 * (wc & 1) + 8 * fq; const f32x4 v0 = a[bj][0] * rs, v1 = a[bj][1] * rs;
#pragma unroll
                for (int b = 0; b < EPI_NB; ++b) st_bf16x8(qm + EPI_PROW(row, b) * 768 + head * 96 + d, v0, v1); }
        } else {
            const float pos = META ? (float)row : (float)((row & 4095) + NMETA);
            const int head = 2 * wc + (fq >> 1), i0 = 8 * (fq & 1); f32x4 o1[2], o2[2];
#pragma unroll
            for (int n = 0; n < 2; ++n) { const f32x4 x1 = a[0][n] * rs, x2 = a[1][n] * rs;
#pragma unroll
                for (int e = 0; e < 4; ++e) { const float inv = __builtin_amdgcn_exp2f(-(float)(i0 + 4 * n + e) * (LOG2_THETA / 16.0f)); const float ang = pos * inv; float rev = ang * INV_2PI; rev = rev - floorf(rev);
                    const float sn = __builtin_amdgcn_sinf(rev), cs = __builtin_amdgcn_cosf(rev); o1[n][e] = x1[e] * cs - x2[e] * sn; o2[n][e] = x2[e] * cs + x1[e] * sn; } }
#pragma unroll
            for (int b = 0; b < EPI_NB; ++b) { bf16_t* qrow = qm + EPI_PROW(row, b) * 768 + head * 96; st_bf16x8(qrow + 64 + i0, o1[0], o1[1]); st_bf16x8(qrow + 80 + i0, o2[0], o2[1]); }
        }
    }
    __device__ __forceinline__ void operator()(const f32x4 (&acc)[2][2][4][2], const Unit& u, int wr, int wc, int fr, int fq) const { EPI_MAIN_LOOP(row_epi(a_, row, u.pn, wc, fr, fq)) }
};

template <bool META> struct EpiKvup {
    static constexpr bool PERM = true, AFTER_DRAIN = false, MIDSCALE = false;
    const float* ssq_kv; bf16_t *kn, *vb;
    __device__ __forceinline__ void mid(f32x4 (&)[2][2][4][2], const Unit&, int, int, int, int) const {}
    __device__ __forceinline__ void row_epi(const f32x4 (&a)[2][2], int row, int pn, int wc, int fr, int fq) const {
        bf16_t* dst = (pn < 2 ? kn : vb) + (pn & 1) * 256;
        const float rs = rsq(sum4(ssq_kv, row) * (1.0f / 128.0f) + RMS_EPS);
#pragma unroll
        for (int bj = 0; bj < 2; ++bj) { const f32x4 v0 = a[bj][0] * rs, v1 = a[bj][1] * rs;
#pragma unroll
            for (int b = 0; b < EPI_NB; ++b) st_bf16x8(dst + EPI_PROW(row, b) * 512 + 128 * bj + 32 * wc + 8 * fq, v0, v1); }
    }
    __device__ __forceinline__ void operator()(const f32x4 (&acc)[2][2][4][2], const Unit& u, int wr, int wc, int fr, int fq) const { EPI_MAIN_LOOP(row_epi(a_, row, u.pn, wc, fr, fq)) }
};

struct EpiResid {
    static constexpr bool PERM = true, AFTER_DRAIN = false;
    float* H; bf16_t* HB; float* hss_out; const float* ssq_o;
    __device__ __forceinline__ void resid_row(const f32x4 (&a)[2][2], int row, float rs, int pn, int wc, int fr, int fq) const {
        float ss = 0.f;
#pragma unroll
        for (int bj = 0; bj < 2; ++bj) { const size_t off = (size_t)row * DM + pn * BM + 128 * bj + 32 * wc + 8 * fq;
            const u32x4 hw = *(const PG8_GAS u32x4*)(HB + off); f32x4 h0, h1;
            h0[0] = __builtin_bit_cast(float, hw.x << 16); h0[1] = __builtin_bit_cast(float, hw.x & 0xffff0000u); h0[2] = __builtin_bit_cast(float, hw.y << 16); h0[3] = __builtin_bit_cast(float, hw.y & 0xffff0000u);
            h1[0] = __builtin_bit_cast(float, hw.z << 16); h1[1] = __builtin_bit_cast(float, hw.z & 0xffff0000u); h1[2] = __builtin_bit_cast(float, hw.w << 16); h1[3] = __builtin_bit_cast(float, hw.w & 0xffff0000u);
            h0 = h0 + a[bj][0] * rs; h1 = h1 + a[bj][1] * rs; st_bf16x8(HB + off, h0, h1); ss += sq4(h0) + sq4(h1); }
        ss += __shfl_xor(ss, 16); ss += __shfl_xor(ss, 32);
        if (fq == 0) ((PG8_GAS float*)hss_out)[(size_t)row * 16 + 4 * pn + wc] = ss;
    }
    __device__ __forceinline__ void two_scales(size_t prow, float& f, float& rb) const {
        const PG8_GAS f32x4* p = (const PG8_GAS f32x4*)(ssq_o + prow * 16); const f32x4 a = p[0], b = p[1], c = p[2], d = p[3];
        const float sa = ((a.x + a.y) + (a.z + a.w)) + ((b.x + b.y) + (b.z + b.w)), sb = ((c.x + c.y) + (c.z + c.w)) + ((d.x + d.y) + (d.z + d.w));
        const float va = sa * (1.0f / 512.0f) + RMS_EPS, vb = sb * (1.0f / 512.0f) + RMS_EPS; f = sqrtf(vb / va); rb = rsq(vb);
    }
};
template <bool META> struct EpiOut : EpiResid {
    static constexpr bool MIDSCALE = true;
    PG8_LAS unsigned char* xlds;
    __device__ __forceinline__ void prep(const Unit& u, int wid, int wr, int lane) const {
        PG8_LAS float* tab = (PG8_LAS float*)(xlds + wid * 1024);
#pragma unroll
        for (int j = 0; j < 2; ++j) { const int idx = lane + 64 * j; const int row = u.pm * BM + (idx >> 6) * HALF + wr * 64 + (idx & 63);
            float f, rb; two_scales((size_t)prow_of(row), f, rb); tab[2 * idx] = f; tab[2 * idx + 1] = rb; }
    }
    __device__ __forceinline__ void mid(f32x4 (&acc)[2][2][4][2], const Unit& u, int wr, int wc, int fr, int fq) const {
        const int wid = wr * 4 + wc; const PG8_LAS float* tab = (const PG8_LAS float*)(xlds + wid * 1024);
#pragma unroll
        for (int ai = 0; ai < 2; ++ai)
#pragma unroll
            for (int m = 0; m < 4; ++m) {
                const float f = tab[2 * (ai * 64 + m * 16 + fr)];
#pragma unroll
                for (int bj = 0; bj < 2; ++bj)
#pragma unroll
                    for (int n = 0; n < 2; ++n) acc[ai][bj][m][n] *= f;
            }
    }
    __device__ __forceinline__ void operator()(const f32x4 (&acc)[2][2][4][2], const Unit& u, int wr, int wc, int fr, int fq) const {
        const PG8_LAS float* tab = (const PG8_LAS float*)(xlds + (wr * 4 + wc) * 1024);
        EPI_MAIN_LOOP(resid_row(a_, row, tab[2 * (ai * 64 + m * 16 + fr) + 1], u.pn, wc, fr, fq))
    }
    __device__ __forceinline__ void mid_row(f32x4 (&a)[2][2], int row) const { float f, rb; two_scales((size_t)(FRONT + row), f, rb);
#pragma unroll
        for (int bj = 0; bj < 2; ++bj)
#pragma unroll
            for (int n = 0; n < 2; ++n) a[bj][n] *= f; }
    __device__ __forceinline__ void row_epi(const f32x4 (&a)[2][2], int row, int pn, int wc, int fr, int fq) const { float f, rb; two_scales((size_t)(FRONT + row), f, rb); resid_row(a, row, rb, pn, wc, fr, fq); }
};
template <bool META> struct EpiDown : EpiResid {
    static constexpr bool MIDSCALE = false;
    __device__ __forceinline__ void mid(f32x4 (&)[2][2][4][2], const Unit&, int, int, int, int) const {}
    __device__ __forceinline__ void row_epi(const f32x4 (&a)[2][2], int row, int pn, int wc, int fr, int fq) const { resid_row(a, row, 1.0f, pn, wc, fr, fq); }
    __device__ __forceinline__ void operator()(const f32x4 (&acc)[2][2][4][2], const Unit& u, int wr, int wc, int fr, int fq) const { EPI_MAIN_LOOP(resid_row(a_, row, 1.0f, u.pn, wc, fr, fq)) }
};

template <bool META> struct EpiGU {
    static constexpr bool PERM = true, AFTER_DRAIN = false, MIDSCALE = false;
    const float* hss; bf16_t* act;
    __device__ __forceinline__ void mid(f32x4 (&)[2][2][4][2], const Unit&, int, int, int, int) const {}
    __device__ __forceinline__ void row_epi(const f32x4 (&a)[2][2], int row, int pn, int wc, int fr, int fq) const {
        const float rs = rsq(sum16q(hss, row, fq) * (1.0f / DM) + RMS_EPS); f32x4 o[2];
#pragma unroll
        for (int n = 0; n < 2; ++n) { const f32x4 g = a[0][n] * rs, up = a[1][n] * rs;
#pragma unroll
            for (int e = 0; e < 4; ++e) o[n][e] = g[e] * up[e] * __builtin_amdgcn_rcpf(1.0f + __builtin_amdgcn_exp2f(-g[e] * LOG2E)); }
        st_bf16x8(act + (size_t)row * DFF + 128 * pn + 32 * wc + 8 * fq, o[0], o[1]);
    }
    __device__ __forceinline__ void operator()(const f32x4 (&acc)[2][2][4][2], const Unit& u, int wr, int wc, int fr, int fq) const { EPI_MAIN_LOOP(row_epi(a_, row, u.pn, wc, fr, fq)) }
};

template <int K, class Epi>
__device__ __forceinline__ void skinny_phase(PG8_LAS unsigned char* lds, const bf16_t* A16, const bf16_t* Bt, int NN, const Epi& E, int wg0) {
    int tid_ = threadIdx.x; asm volatile("" : "+v"(tid_));
    const int tid = tid_, lane = tid & 63, wid = __builtin_amdgcn_readfirstlane(tid >> 6), fr = lane & 15, fq = lane >> 4;
    constexpr int nk = K / 32, NJ = (nk + 7) / 8;
    const int G = (int)gridDim.x; int first = (int)blockIdx.x - wg0; if (first < 0) first += G;
    for (int task = first; task < 4 * NN; task += G) {
        const int pn = task >> 2, wc = task & 3;
        f32x4 a[2][2];
#pragma unroll
        for (int bj = 0; bj < 2; ++bj)
#pragma unroll
            for (int n = 0; n < 2; ++n) a[bj][n] = (f32x4){0.f, 0.f, 0.f, 0.f};
        bool scaled = false;
        const bf16_t* ap = A16 + (size_t)fr * K + 8 * fq;
        const bf16_t* bp = Bt + (size_t)(256 * pn + 32 * wc + 8 * (fr >> 2) + (fr & 3)) * K + 8 * fq;
#pragma unroll 4
        for (int j = 0; j < NJ; ++j) {
            const int it = wid + 8 * j; if (it >= nk) break;
            const int k0 = 32 * it;
            if constexpr (Epi::MIDSCALE) { if (!scaled && k0 >= (K >> 1)) { E.mid_row(a, fr); scaled = true; } }
            const bf16x8 av = *(const PG8_GAS bf16x8*)(ap + k0);
#pragma unroll
            for (int bj = 0; bj < 2; ++bj)
#pragma unroll
                for (int n = 0; n < 2; ++n) { const bf16x8 bv = *(const PG8_GAS bf16x8*)(bp + (size_t)(128 * bj + 4 * n) * K + k0);
                    a[bj][n] = __builtin_amdgcn_mfma_f32_16x16x32_bf16(bv, av, a[bj][n], 0, 0, 0); }
        }
        if constexpr (Epi::MIDSCALE) { if (!scaled) E.mid_row(a, fr); }
        PG8_LAS f32x4* red = (PG8_LAS f32x4*)lds;
#pragma unroll
        for (int bj = 0; bj < 2; ++bj)
#pragma unroll
            for (int n = 0; n < 2; ++n) red[(wid * 64 + lane) * 4 + bj * 2 + n] = a[bj][n];
        __syncthreads();
        if (wid == 0) {
#pragma unroll
            for (int w = 1; w < 8; ++w)
#pragma unroll
                for (int bj = 0; bj < 2; ++bj)
#pragma unroll
                    for (int n = 0; n < 2; ++n) a[bj][n] += red[(w * 64 + lane) * 4 + bj * 2 + n];
            E.row_epi(a, fr, pn, wc, fr, fq);
        }
        __syncthreads();
    }
}
template <class Epi, class Sched, bool ALIGN_EPI = false, bool SP2 = false>
__device__ __forceinline__ void gemm_phase(PG8_LAS unsigned char* lds, const Gemm g, const Sched& S, const Epi& E) {
    int tid_ = threadIdx.x; asm volatile("" : "+v"(tid_));
    const int tid = tid_, wid = __builtin_amdgcn_readfirstlane(tid >> 6), lane = tid & 63, wr = wid >> 2, wc = wid & 3, fr = lane & 15, fq = lane >> 4;
    int K_ = g.K; asm volatile("" : "+s"(K_)); const int K = K_, nt = K / BK;
    unsigned voffA[2], voffB[2];
#pragma unroll
    for (int i = 0; i < 2; ++i) { int R, C; stage_rc(tid * 16 + i * 8192, R, C); const int Rb = Epi::PERM ? ((R & ~31) + perm32(R & 31)) : R;
        voffA[i] = (unsigned)(R * K + C) * 2u; voffB[i] = (unsigned)(Rb * K + C) * 2u; }
    const size_t kstep = (size_t)(BK * 2);
    const size_t hstep = (size_t)HALF * K * 2;
    const size_t tstep = 2 * hstep;
    const unsigned ldsw = (unsigned)wid * 1024u;
    const int aoff = lds_byte(wr * 64 + fr, fq * 8), boff = lds_byte(wc * 32 + fr, fq * 8);
#define PG8_SA(b, h) (((b) * 2 + (h)) * HTB)
#define PG8_SB(b, h) ((4 + (b) * 2 + (h)) * HTB)
#define PG8_STAGE(bufoff, gbase, voff) do { _Pragma("unroll") for (int _i = 0; _i < 2; ++_i) \
        __builtin_amdgcn_global_load_lds((const unsigned*)((const char*)(gbase) + (voff)[_i]), (PG8_LAS unsigned*)(lds + (bufoff) + ldsw + _i * 8192), 16, 0, 0); } while (0)
#define PG8_LDA(dst, b, h) do { _Pragma("unroll") for (int m = 0; m < 4; ++m) _Pragma("unroll") for (int k = 0; k < 2; ++k) dst[m][k] = *(const PG8_LAS bf16x8*)(lds + PG8_SA(b, h) + aoff + m * 2048 + k * 1024); } while (0)
#define PG8_LDB(dst, b, h) do { _Pragma("unroll") for (int n = 0; n < 2; ++n) _Pragma("unroll") for (int k = 0; k < 2; ++k) dst[n][k] = *(const PG8_LAS bf16x8*)(lds + PG8_SB(b, h) + boff + n * 2048 + k * 1024); } while (0)
#define PG8_MMA(ai, bj, At, Bt) do { __builtin_amdgcn_s_setprio(1); _Pragma("unroll") for (int m = 0; m < 4; ++m) _Pragma("unroll") for (int n = 0; n < 2; ++n) _Pragma("unroll") for (int k = 0; k < 2; ++k) \
        acc[ai][bj][m][n] = __builtin_amdgcn_mfma_f32_16x16x32_bf16(Bt[n][k], At[m][k], acc[ai][bj][m][n], 0, 0, 0); __builtin_amdgcn_s_setprio(0); } while (0)
#define PG8_WAIT_V(n) asm volatile("s_waitcnt vmcnt(" #n ")" ::: "memory")
#define PG8_WAIT_L(n) asm volatile("s_waitcnt lgkmcnt(" #n ")" ::: "memory")
#define PG8_BAR __builtin_amdgcn_s_barrier()
#define PG8_SCHED __builtin_amdgcn_sched_barrier(0)
    Unit cur, nxt; int ui = 0;
    if (!S.next(0, cur)) return;
    f32x4 acc[2][2][4][2];
#pragma unroll
    for (int a = 0; a < 2; ++a)
#pragma unroll
        for (int b = 0; b < 2; ++b)
#pragma unroll
            for (int m = 0; m < 4; ++m)
#pragma unroll
                for (int n = 0; n < 2; ++n) acc[a][b][m][n] = (f32x4){0.f, 0.f, 0.f, 0.f};
    bf16x8 At[4][2], B0[2][2], B1[2][2];
    const char* cA = (const char*)g.A + (size_t)cur.pm * tstep + (g.apad ? (size_t)((cur.pm >> 4) * 128 + 128) * (size_t)K * 2 : (size_t)0); const char* cB = (const char*)g.Bt + (size_t)cur.pn * tstep;
    S.a_ready(cur);
    if constexpr (SP2) {
        PG8_STAGE(PG8_SB(0, 0), cB, voffB); PG8_STAGE(PG8_SB(0, 1), cB + hstep, voffB); PG8_STAGE(PG8_SA(0, 0), cA, voffA); PG8_STAGE(PG8_SA(0, 1), cA + hstep, voffA);
        if (wr == 1) PG8_BAR;
        PG8_WAIT_V(2); PG8_BAR;
        PG8_STAGE(PG8_SB(1, 0), cB + kstep, voffB); PG8_STAGE(PG8_SA(1, 0), cA + kstep, voffA); PG8_STAGE(PG8_SB(1, 1), cB + hstep + kstep, voffB);
        PG8_WAIT_V(6); PG8_BAR;
    } else {
        PG8_STAGE(PG8_SB(0, 0), cB, voffB); PG8_STAGE(PG8_SA(0, 0), cA, voffA); PG8_STAGE(PG8_SB(0, 1), cB + hstep, voffB); PG8_STAGE(PG8_SA(0, 1), cA + hstep, voffA);
        if (wr == 1) PG8_BAR;
        PG8_WAIT_V(4); PG8_BAR;
        PG8_STAGE(PG8_SB(1, 0), cB + kstep, voffB); PG8_STAGE(PG8_SA(1, 0), cA + kstep, voffA); PG8_STAGE(PG8_SB(1, 1), cB + hstep + kstep, voffB);
        PG8_WAIT_V(6); PG8_BAR;
    }
    for (;;) {
        const bool has_next = S.next(ui + 1, nxt);
        if constexpr (Epi::MIDSCALE) E.prep(cur, wid, wr, lane);
        const char* nA = has_next ? (const char*)g.A + (size_t)nxt.pm * tstep + (g.apad ? (size_t)((nxt.pm >> 4) * 128 + 128) * (size_t)K * 2 : (size_t)0) : cA; const char* nB = has_next ? (const char*)g.Bt + (size_t)nxt.pn * tstep : cB;
        for (int t = 0; t < nt; t += 2) {
            const bool last = (t == nt - 2);
            if constexpr (Epi::MIDSCALE) { if (t == (nt >> 1)) E.mid(acc, cur, wr, wc, fr, fq); }
            const char* a1 = cA + (size_t)(t + 1) * kstep;
            const char* a2 = last ? nA : cA + (size_t)(t + 2) * kstep; const char* b2 = last ? nB : cB + (size_t)(t + 2) * kstep;
            const char* a3 = a2 + kstep; const char* b3 = b2 + kstep;
            if (last && has_next) S.a_ready(nxt);
            if constexpr (SP2) {
            PG8_LDB(B0, 0, 0); PG8_LDB(B1, 0, 1); PG8_SCHED; PG8_LDA(At, 0, 0); PG8_STAGE(PG8_SA(1, 1), a1 + hstep, voffA);
            PG8_WAIT_V(8); PG8_WAIT_L(0); PG8_BAR; PG8_MMA(0, 0, At, B0); PG8_MMA(0, 1, At, B1); PG8_BAR; PG8_SCHED;
            PG8_LDA(At, 0, 1); PG8_STAGE(PG8_SB(0, 0), b2, voffB); PG8_STAGE(PG8_SB(0, 1), b2 + hstep, voffB); PG8_STAGE(PG8_SA(0, 0), a2, voffA);
            PG8_WAIT_V(8); PG8_WAIT_L(0); PG8_BAR; PG8_MMA(1, 0, At, B0); PG8_MMA(1, 1, At, B1); PG8_BAR; PG8_SCHED;
            PG8_LDB(B0, 1, 0); PG8_LDB(B1, 1, 1); PG8_SCHED; PG8_LDA(At, 1, 0); PG8_STAGE(PG8_SA(0, 1), a2 + hstep, voffA);
            PG8_WAIT_V(8); PG8_WAIT_L(0); PG8_BAR; PG8_MMA(0, 0, At, B0); PG8_MMA(0, 1, At, B1); PG8_BAR; PG8_SCHED;
            PG8_LDA(At, 1, 1); PG8_STAGE(PG8_SB(1, 0), b3, voffB); PG8_STAGE(PG8_SB(1, 1), b3 + hstep, voffB); PG8_STAGE(PG8_SA(1, 0), a3, voffA);
            PG8_WAIT_V(8); PG8_WAIT_L(0); PG8_BAR; PG8_MMA(1, 0, At, B0); PG8_MMA(1, 1, At, B1); PG8_BAR; PG8_SCHED;
            } else {
            PG8_LDB(B0, 0, 0); PG8_SCHED; PG8_LDA(At, 0, 0); PG8_STAGE(PG8_SA(1, 1), a1 + hstep, voffA);
            PG8_WAIT_L(8); PG8_BAR; PG8_WAIT_L(0); PG8_MMA(0, 0, At, B0); PG8_BAR; PG8_SCHED;
            PG8_LDB(B1, 0, 1); PG8_STAGE(PG8_SB(0, 0), b2, voffB);
            PG8_BAR; PG8_WAIT_L(0); PG8_MMA(0, 1, At, B1); PG8_BAR;
            PG8_LDA(At, 0, 1); PG8_STAGE(PG8_SA(0, 0), a2, voffA);
            PG8_BAR; PG8_WAIT_L(0); PG8_MMA(1, 0, At, B0); PG8_BAR; PG8_SCHED;
            PG8_STAGE(PG8_SB(0, 1), b2 + hstep, voffB);
            PG8_WAIT_V(6); PG8_BAR; PG8_MMA(1, 1, At, B1); PG8_BAR;
            PG8_LDB(B0, 1, 0); PG8_SCHED; PG8_LDA(At, 1, 0); PG8_STAGE(PG8_SA(0, 1), a2 + hstep, voffA);
            PG8_WAIT_L(8); PG8_BAR; PG8_WAIT_L(0); PG8_MMA(0, 0, At, B0); PG8_BAR; PG8_SCHED;
            PG8_LDB(B1, 1, 1); PG8_STAGE(PG8_SB(1, 0), b3, voffB);
            PG8_BAR; PG8_WAIT_L(0); PG8_MMA(0, 1, At, B1); PG8_BAR;
            PG8_LDA(At, 1, 1); PG8_STAGE(PG8_SA(1, 0), a3, voffA);
            PG8_BAR; PG8_WAIT_L(0); PG8_MMA(1, 0, At, B0); PG8_BAR; PG8_SCHED;
            PG8_STAGE(PG8_SB(1, 1), b3 + hstep, voffB);
            PG8_WAIT_V(6); PG8_BAR; PG8_MMA(1, 1, At, B1); PG8_BAR;
            }
        }
        if constexpr (ALIGN_EPI) { if (wr == 0) PG8_BAR; }
        if constexpr (!Epi::AFTER_DRAIN) { E(acc, cur, wr, wc, fr, fq); S.done(cur); }
        if (!has_next) break;
#pragma unroll
        for (int a = 0; a < 2; ++a)
#pragma unroll
            for (int b = 0; b < 2; ++b)
#pragma unroll
                for (int m = 0; m < 4; ++m)
#pragma unroll
                    for (int n = 0; n < 2; ++n) acc[a][b][m][n] = (f32x4){0.f, 0.f, 0.f, 0.f};
        cur = nxt; cA = nA; cB = nB; ++ui;
        if constexpr (ALIGN_EPI) { if (wr == 1) PG8_BAR; }
    }
    PG8_WAIT_V(0);
    if constexpr (!ALIGN_EPI) { if (wr == 0) PG8_BAR; }
    PG8_BAR;
    if constexpr (Epi::AFTER_DRAIN) { E.fused(acc, cur, wr, wc, fr, fq, lds, wid, lane); S.done(cur); }
#undef PG8_SA
#undef PG8_SB
#undef PG8_STAGE
#undef PG8_LDA
#undef PG8_LDB
#undef PG8_MMA
#undef PG8_WAIT_V
#undef PG8_WAIT_L
#undef PG8_BAR
#undef PG8_SCHED
}
}
namespace att {
#define ALAS __attribute__((address_space(3)))
#define AGAS __attribute__((address_space(1)))
typedef unsigned short bf16_t;
typedef short bf16x8 __attribute__((ext_vector_type(8)));
typedef short s16x4 __attribute__((ext_vector_type(4)));
typedef float f32x16 __attribute__((ext_vector_type(16)));
typedef unsigned u32x4 __attribute__((ext_vector_type(4)));
typedef float f32x2_t __attribute__((ext_vector_type(2))); typedef __bf16 bf16x2_t __attribute__((ext_vector_type(2)));
constexpr int KPMAX = 208, VP = 192, KSZ = 64 * KPMAX, VSZ = 64 * VP;
constexpr int OFF_V = 2 * KSZ, OFF_SCR = OFF_V + 2 * VSZ, OFF_Q = OFF_SCR + 8 * 256, LDS_BYTES = OFF_Q + 64;
constexpr float NEGF = -1e30f, THR = 6.0f;
__device__ __forceinline__ int crow(int r, int hi) { return (r & 3) + 8 * (r >> 2) + 4 * hi; }
__device__ __forceinline__ unsigned cvtpk(float lo, float hi) { f32x2_t v = {lo, hi}; bf16x2_t b = __builtin_convertvector(v, bf16x2_t); return __builtin_bit_cast(unsigned, b); }
__device__ __forceinline__ bf16x8 pack8(const f32x16& p, int s) { u32x4 w; w.x = cvtpk(p[8 * s], p[8 * s + 1]); w.y = cvtpk(p[8 * s + 2], p[8 * s + 3]); w.z = cvtpk(p[8 * s + 4], p[8 * s + 5]); w.w = cvtpk(p[8 * s + 6], p[8 * s + 7]); return __builtin_bit_cast(bf16x8, w); }
typedef short v4i16_t __attribute__((ext_vector_type(4)));
__device__ __forceinline__ float max3f(float a, float b, float c) { float r; asm("v_max3_f32 %0, %1, %2, %3" : "=v"(r) : "v"(a), "v"(b), "v"(c)); return r; }
__device__ __forceinline__ float max2f(float a, float b) { float r; asm("v_max_f32_e32 %0, %1, %2" : "=v"(r) : "v"(a), "v"(b)); return r; }
__device__ __forceinline__ float xhalf_max(float m) { auto rr = __builtin_amdgcn_permlane32_swap(__float_as_uint(m), __float_as_uint(m), false, false); return max2f(__uint_as_float(rr[0]), __uint_as_float(rr[1])); }
__device__ __forceinline__ s16x4 vtr(const ALAS unsigned char* p) { return __builtin_bit_cast(s16x4, __builtin_amdgcn_ds_read_tr16_b64_v4i16((ALAS v4i16_t*)p)); }
__device__ __forceinline__ unsigned short f2bf(float f) { unsigned u = __builtin_bit_cast(unsigned, f); return (unsigned short)((u + 0x7fffu + ((u >> 16) & 1u)) >> 16); }

template <int DQK, bool SWA>
__device__ __forceinline__ void attn_unit(ALAS unsigned char* lds, const bf16_t* Qp, int qpitch, const bf16_t* Kp, int kpitch, const bf16_t* Krp, const bf16_t* Vp, int vpitch,
                                          bf16_t* Op, float* ssq, float sink2, int b, int qb) {
    constexpr int KP = DQK * 2 + 16, NS = DQK / 16;
    int tid_ = threadIdx.x; asm volatile("" : "+v"(tid_));
    const int tid = tid_, lane = tid & 63, wid = __builtin_amdgcn_readfirstlane(tid >> 6), r = lane & 31, h = lane >> 5;
    const size_t rowbase = (size_t)b * TT;
    const int q0 = qb * 256, q0w = q0 + wid * 32;
    const bool wave_valid = q0w < TT;
    const int NT = (q0 + 256) / 64 < TT / 64 ? (q0 + 256) / 64 : TT / 64;
    int t0 = 1; if (SWA) { t0 = (q0 - 128) / 64; if (t0 < 1) t0 = 1; }
    ALAS float* scr = (ALAS float*)(lds + OFF_SCR + wid * 256);
    bf16x8 qf[NS];
    { const int qr = (q0w + r) < TT ? (q0w + r) : TT - 1; const bf16_t* qrow = Qp + (rowbase + qr) * (size_t)qpitch;
#pragma unroll
      for (int s = 0; s < NS; ++s) qf[s] = *(const AGAS bf16x8*)(qrow + 16 * s + 8 * h); }
    const int srow = tid >> 3, sch = tid & 7, rrow = (tid >> 2) & 63, rch = tid & 3;
    u32x4 kregA, vregA, rregA = {0u, 0u, 0u, 0u}, kregB, vregB, rregB = {0u, 0u, 0u, 0u};
#define AT_GLOAD(t, S) do { const size_t kr_ = rowbase + 64 * (t) + srow; kreg##S = *(const AGAS u32x4*)(Kp + kr_ * (size_t)kpitch + sch * 8); vreg##S = *(const AGAS u32x4*)(Vp + kr_ * (size_t)vpitch + sch * 8); \
        if (DQK == 96) { if (tid < 256) rreg##S = *(const AGAS u32x4*)(Krp + (rowbase + 64 * (t) + rrow) * 32 + rch * 8); } } while (0)
#define AT_LSTORE(buf, S) do { *(ALAS u32x4*)(lds + (buf) * KSZ + srow * KP + sch * 16) = kreg##S; *(ALAS u32x4*)(lds + OFF_V + (buf) * VSZ + srow * VP + sch * 16) = vreg##S; \
        if (DQK == 96) { if (tid < 256) *(ALAS u32x4*)(lds + (buf) * KSZ + rrow * KP + 128 + rch * 16) = rreg##S; } } while (0)
    AT_GLOAD(t0, A); AT_LSTORE(0, A);
    if (t0 + 1 < NT) AT_GLOAD(t0 + 1, A);
    __syncthreads();
    float mrun = SWA ? sink2 : 0.0f, lrun = (SWA && h == 0) ? 1.0f : 0.0f;
    bool first_ = !SWA;
    f32x16 negm;
#pragma unroll
    for (int i = 0; i < 16; ++i) negm[i] = -mrun;
    f32x16 o0, o1;
#pragma unroll
    for (int i = 0; i < 16; ++i) { o0[i] = 0.f; o1[i] = 0.f; }
    const int q = q0w + r;
#define AT_PVF(P, j) do { o0 = __builtin_amdgcn_mfma_f32_32x32x16_bf16(P, __builtin_shufflevector(vlo[2 * (j)], vhi[2 * (j)], 0, 1, 2, 3, 4, 5, 6, 7), o0, 0, 0, 0); o1 = __builtin_amdgcn_mfma_f32_32x32x16_bf16(P, __builtin_shufflevector(vlo[2 * (j) + 1], vhi[2 * (j) + 1], 0, 1, 2, 3, 4, 5, 6, 7), o1, 0, 0, 0); } while (0)
#define AT_PV(P, rowoff) do { \
                { const s16x4 lo = vtr(vb_ + (rowoff) * VP), hi = vtr(vb_ + ((rowoff) + 8) * VP); const bf16x8 vf = __builtin_shufflevector(lo, hi, 0, 1, 2, 3, 4, 5, 6, 7); o0 = __builtin_amdgcn_mfma_f32_32x32x16_bf16(P, vf, o0, 0, 0, 0); } \
                { const s16x4 lo = vtr(vb_ + (rowoff) * VP + 64), hi = vtr(vb_ + ((rowoff) + 8) * VP + 64); const bf16x8 vf = __builtin_shufflevector(lo, hi, 0, 1, 2, 3, 4, 5, 6, 7); o1 = __builtin_amdgcn_mfma_f32_32x32x16_bf16(P, vf, o1, 0, 0, 0); } } while (0)
#define AT_STEP(t, LS, SS) do { \
        const int buf = (t - t0) & 1; \
        if (t + 2 < NT) AT_GLOAD(t + 2, LS); \
        const int kfirst = 64 * t; \
        bool active = wave_valid && (kfirst <= q0w + 31); \
        if (SWA) active = active && (kfirst + 63 >= q0w - 127); \
        if (active) { \
            f32x16 s0, s1; \
            const ALAS unsigned char* kb = lds + buf * KSZ + r * KP + h * 16; \
            bf16x8 kf[2 * NS]; \
_Pragma("unroll") \
            for (int s = 0; s < NS; ++s) { kf[2 * s] = *(const ALAS bf16x8*)(kb + s * 32); kf[2 * s + 1] = *(const ALAS bf16x8*)(kb + 32 * KP + s * 32); } \
            __builtin_amdgcn_sched_barrier(0); \
_Pragma("unroll") \
            for (int s = 0; s < NS; ++s) { if (s == 0) { s0 = __builtin_amdgcn_mfma_f32_32x32x16_bf16(kf[0], qf[0], negm, 0, 0, 0); s1 = __builtin_amdgcn_mfma_f32_32x32x16_bf16(kf[1], qf[0], negm, 0, 0, 0); } else { s0 = __builtin_amdgcn_mfma_f32_32x32x16_bf16(kf[2 * s], qf[s], s0, 0, 0, 0); s1 = __builtin_amdgcn_mfma_f32_32x32x16_bf16(kf[2 * s + 1], qf[s], s1, 0, 0, 0); } } \
            __builtin_amdgcn_sched_barrier(0); \
            const ALAS unsigned char* vb_ = lds + OFF_V + buf * VSZ + (4 * h + ((lane & 15) >> 2)) * VP + ((lane >> 4) & 1) * 32 + (lane & 3) * 8; \
            s16x4 vlo[8], vhi[8]; \
_Pragma("unroll") \
            for (int j = 0; j < 4; ++j) { vlo[2 * j] = vtr(vb_ + (16 * j) * VP); vhi[2 * j] = vtr(vb_ + (16 * j + 8) * VP); vlo[2 * j + 1] = vtr(vb_ + (16 * j) * VP + 64); vhi[2 * j + 1] = vtr(vb_ + (16 * j + 8) * VP + 64); } \
            __builtin_amdgcn_sched_barrier(0); \
            const bool need_mask = SWA || (t == 1) || (kfirst + 63 > q0w); \
            if (need_mask) { \
_Pragma("unroll") \
                for (int i = 0; i < 16; ++i) { const int key = kfirst + crow(i, h), key1 = key + 32; \
                    bool ok0 = (key <= q) && (key >= FRONT), ok1 = (key1 <= q) && (key1 >= FRONT); \
                    if (SWA) { ok0 = ok0 && (q - key < 128); ok1 = ok1 && (q - key1 < 128); } \
                    s0[i] = ok0 ? s0[i] : NEGF; s1[i] = ok1 ? s1[i] : NEGF; } \
            } \
            float rm = max3f(s0[0], s0[1], s1[0]), rm2 = max3f(s0[2], s0[3], s1[1]); rm = max3f(rm, s1[2], s1[3]); \
_Pragma("unroll") \
            for (int i = 4; i < 16; i += 4) { rm = max3f(rm, s0[i], s0[i + 1]); rm2 = max3f(rm2, s0[i + 2], s0[i + 3]); rm = max3f(rm, s1[i], s1[i + 1]); rm2 = max3f(rm2, s1[i + 2], s1[i + 3]); } \
            rm = xhalf_max(max2f(rm, rm2)); \
            if (first_ || __any(rm > THR)) { \
                const float dl = first_ ? (rm > -1e29f ? rm : 0.f) : max2f(rm, 0.f); first_ = false; \
                mrun += dl; const float f = __builtin_amdgcn_exp2f(-dl); lrun *= f; \
_Pragma("unroll") \
                for (int i = 0; i < 16; ++i) { s0[i] -= dl; s1[i] -= dl; negm[i] = -mrun; } \
                if (h == 0) scr[r] = f; \
_Pragma("unroll") \
                for (int i = 0; i < 16; ++i) { const float fi = scr[crow(i, h)]; o0[i] *= fi; o1[i] *= fi; } \
            } \
            float ls = 0.f; \
_Pragma("unroll") \
            for (int i = 0; i < 16; ++i) { s0[i] = __builtin_amdgcn_exp2f(s0[i]); s1[i] = __builtin_amdgcn_exp2f(s1[i]); ls += s0[i] + s1[i]; } \
            lrun += ls; \
            const bf16x8 p0 = pack8(s0, 0), p1 = pack8(s0, 1), p2 = pack8(s1, 0), p3 = pack8(s1, 1); \
            __builtin_amdgcn_sched_barrier(0); \
            AT_PVF(p0, 0); AT_PVF(p1, 1); AT_PVF(p2, 2); AT_PVF(p3, 3); \
        } \
        if (t + 1 < NT) AT_LSTORE(buf ^ 1, SS); \
        __syncthreads(); \
    } while (0)
    {
        int t = t0;
        for (; t + 1 < NT; t += 2) { AT_STEP(t, B, A); const int t1 = t + 1; AT_STEP(t1, A, B); }
        if (t < NT) AT_STEP(t, B, A);
    }
#undef AT_STEP
#undef AT_PV
#undef AT_GLOAD
#undef AT_LSTORE
    if (wave_valid) {
        const float lt = lrun + __shfl_xor(lrun, 32);
        if (h == 0) scr[32 + r] = lt;
#pragma unroll
        for (int i = 0; i < 16; ++i) {
            const float li = scr[32 + crow(i, h)], inv = li > 0.f ? 1.0f / li : 0.f;
            const float a = o0[i] * inv, c = o1[i] * inv; const size_t row = rowbase + q0w + crow(i, h);
            ((AGAS bf16_t*)Op)[row * 1024 + r] = f2bf(a); ((AGAS bf16_t*)Op)[row * 1024 + 32 + r] = f2bf(c);
            float ss = a * a + c * c;
            ss += __shfl_xor(ss, 1); ss += __shfl_xor(ss, 2); ss += __shfl_xor(ss, 4); ss += __shfl_xor(ss, 8); ss += __shfl_xor(ss, 16);
            if (r == 0) ((AGAS float*)ssq)[row * 16] = ss;
        }
    }
    __syncthreads();
}
}
typedef unsigned short bf16;
#define LAS __attribute__((address_space(3)))
#define GAS __attribute__((address_space(1)))
constexpr size_t MiB = 1u << 20;
constexpr int NWAVES = 8, NTHREADS = 512;
constexpr int LDS_BYTES = 147456;
static_assert(att::LDS_BYTES <= 131072, "attention LDS");
constexpr size_t WS_CTL = 0, CTL_BYTES = 65536;
constexpr size_t WS_H = 1 * MiB;
constexpr size_t WS_HB = WS_H + (size_t)MROWS * DM * 4;
constexpr size_t WS_W = WS_HB + (size_t)MROWS * DM * 2;
constexpr size_t WL_IN = 0, WL_Q = WL_IN + (size_t)INP * DM * 2, WL_KV = WL_Q + (size_t)768 * 256 * 2, WL_O = WL_KV + (size_t)1024 * 128 * 2,
                 WL_GU = WL_O + (size_t)DM * DM * 2, WL_D = WL_GU + (size_t)GUP * DM * 2, WL_END = WL_D + (size_t)DM * DFF * 2;
constexpr size_t WBUF = 22 * MiB;
static_assert(WL_END <= WBUF, "weight buffer");
constexpr size_t WS_PART = WS_W + 2 * WBUF;
constexpr size_t P_HSSA = 0, P_HSSB = P_HSSA + (size_t)MROWS * 64, P_SSQO = P_HSSB + (size_t)MROWS * 64, P_SSQQ = P_SSQO + (size_t)MROWS * 64, P_SSQKV = P_SSQQ + (size_t)MROWS * 16, P_END = P_SSQKV + (size_t)MROWS * 16;
constexpr size_t PM_H = (P_END + 255) & ~(size_t)255, PM_HB = PM_H + 16 * DM * 4, PM_HSSA = PM_HB + 16 * DM * 2, PM_HSSB = PM_HSSA + 1024, PM_SSQQ = PM_HSSB + 1024, PM_SSQKV = PM_SSQQ + 256,
                 PM_QLAT = PM_SSQKV + 256, PM_KVLAT = PM_QLAT + 16 * 256 * 2, PM_ACT = PM_KVLAT + 16 * 128 * 2, PM_END = PM_ACT + 16 * DFF * 2;
static_assert(PM_END <= 8 * MiB, "partials");
constexpr int MC = BATCH * SEQ;
constexpr size_t WS_R = WS_PART + 8 * MiB;
constexpr size_t R_QA = 0, R_KA = R_QA + (size_t)MROWS * 512 * 2, R_VA = R_KA + (size_t)MROWS * 128 * 2, R_QLAT = R_VA + (size_t)MROWS * 128 * 2, R_KVLAT = R_QLAT + (size_t)MROWS * 256 * 2,
                 R_KR = R_KVLAT + (size_t)MROWS * 128 * 2, R_QM = R_KR + (size_t)MROWS * 32 * 2, R_KN = R_QM + (size_t)MROWS * 768 * 2, R_VB = R_KN + (size_t)MROWS * 512 * 2,
                 R_O = R_VB + (size_t)MROWS * 512 * 2, R_END = R_O + (size_t)MROWS * 1024 * 2;
constexpr size_t R_ACT = 0;
static_assert((size_t)MROWS * DFF * 2 <= R_END, "act overlay");
constexpr size_t WS_END = WS_R + R_END;
static_assert(WS_END <= 512 * MiB, "workspace must fit 512 MiB");

struct Args {
    const float *x, *meta, *attn_norm, *w_in, *q_norm, *w_q_up, *kv_norm, *w_kv_up, *sinks, *out_norm_swa, *out_norm_mla, *w_o, *ffn_norm, *w_gate, *w_up, *w_down, *final_norm;
    float* out; unsigned char* ws; int ph_lo, ph_hi;
};

__device__ __forceinline__ unsigned f2bf_u(float f) { unsigned u = __builtin_bit_cast(unsigned, f); return (u + 0x7fffu + ((u >> 16) & 1u)) >> 16; }
__device__ __forceinline__ unsigned pk2(float lo, float hi) { return f2bf_u(lo) | (f2bf_u(hi) << 16); }
__device__ __forceinline__ float wave_sum(float v) {
#pragma unroll
    for (int o = 1; o < 64; o <<= 1) v += __shfl_xor(v, o);
    return v;
}

__device__ __forceinline__ int src_in(int np) { const int pn = np >> 8, bj = (np >> 7) & 1, o = np & 127;
    if (pn < 2) return (4 * pn + (o >> 5)) * 64 + (o & 31) + 32 * bj;
    if (pn == 2) { if (o < 64) return 512 + (o >> 5) * 64 + (o & 31) + 32 * bj; if (o < 80) return 1152 + (o - 64) + 16 * bj; return -1; }
    if (pn == 3) return bj ? 1024 + o : 640 + o;
    return 768 + 128 * bj + o; }
__device__ __forceinline__ int src_qup(int np) { const int pn = np >> 8, op = np & 255;
    if (pn < 2) return (4 * pn + (op >> 6)) * 96 + (op & 63);
    const int bj = op >> 7, o = op & 127; return (o >> 4) * 96 + 64 + (o & 15) + 16 * bj; }
__device__ __forceinline__ int src_kvup(int np) { const int pn = np >> 8, op = np & 255; return (4 * (pn & 1) + (op >> 6)) * 128 + (pn >= 2 ? 64 : 0) + (op & 63); }

template <int MODE>
__device__ __forceinline__ void conv_item(const float* W, const float* W2, const float* gain, const float* gain2, int K, int Nsrc, bf16* WT, LAS float* scr, int item, int nblk, int lane) {
    const int kb = item / nblk, nb = item % nblk, k0 = 64 * kb, n0 = 32 * nb;
    const int np = n0 + (lane & 31);
    int src; float cs = 1.0f; const float* Wp = W;
    if (MODE == 0) { src = src_in(np); if (np < 512) cs = 0.125f * LOG2E; }
    else if (MODE == 1) { src = src_qup(np); cs = 0.10206207261596577f * LOG2E; }
    else if (MODE == 2) src = src_kvup(np);
    else if (MODE == 4) { src = 128 * (np >> 8) + (np & 127); if ((np >> 7) & 1) Wp = W2; }
    else src = np;
#pragma unroll 8
    for (int i = 0; i < 32; ++i) { const int kk = 2 * i + (lane >> 5), k = k0 + kk;
        float g = 1.0f; if (MODE == 3) g = (k < 512) ? ((const GAS float*)gain)[k] : ((const GAS float*)gain2)[k - 512]; else if (MODE != 5) g = ((const GAS float*)gain)[k];
        scr[kk * 33 + (lane & 31)] = (src >= 0) ? ((const GAS float*)Wp)[(size_t)k * Nsrc + src] * g * cs : 0.0f; }
    asm volatile("s_waitcnt lgkmcnt(0)" ::: "memory");
    const int c = lane & 7;
#pragma unroll
    for (int j = 0; j < 4; ++j) { const int n = (lane >> 3) + 8 * j; const LAS float* s = scr + (8 * c) * 33 + n;
        pg8::u32x4 o; o.x = pk2(s[0 * 33], s[1 * 33]); o.y = pk2(s[2 * 33], s[3 * 33]); o.z = pk2(s[4 * 33], s[5 * 33]); o.w = pk2(s[6 * 33], s[7 * 33]);
        *(GAS pg8::u32x4*)(WT + (size_t)(n0 + n) * K + k0 + 8 * c) = o; }
    asm volatile("s_waitcnt lgkmcnt(0)" ::: "memory");
}
__device__ __forceinline__ void conv_layer(const Args& a, int l, unsigned char* wbuf, LAS unsigned char* lds) {
    int tid_ = threadIdx.x; asm volatile("" : "+v"(tid_));
    const int lane = tid_ & 63, wave = tid_ >> 6;
    LAS float* scr = (LAS float*)(lds + wave * 16384);
    const int gw = blockIdx.x * NWAVES + wave, NGW = gridDim.x * NWAVES;
    constexpr int I0 = (DM / 64) * (INP / 32), I1 = (256 / 64) * (768 / 32), I2 = (128 / 64) * (1024 / 32), I3 = (DM / 64) * (DM / 32), I4 = (DM / 64) * (GUP / 32), I5 = (DFF / 64) * (DM / 32);
    constexpr int NIT = I0 + I1 + I2 + I3 + I4 + I5;
    for (int it = gw; it < NIT; it += NGW) {
        int r = it;
        if (r < I0) { conv_item<0>(a.w_in + (size_t)l * DM * INW, nullptr, a.attn_norm + l * DM, nullptr, DM, INW, (bf16*)(wbuf + WL_IN), scr, r, INP / 32, lane); continue; } r -= I0;
        if (r < I1) { conv_item<1>(a.w_q_up + (size_t)l * 256 * 768, nullptr, a.q_norm + l * 256, nullptr, 256, 768, (bf16*)(wbuf + WL_Q), scr, r, 768 / 32, lane); continue; } r -= I1;
        if (r < I2) { conv_item<2>(a.w_kv_up + (size_t)l * 128 * 1024, nullptr, a.kv_norm + l * 128, nullptr, 128, 1024, (bf16*)(wbuf + WL_KV), scr, r, 1024 / 32, lane); continue; } r -= I2;
        if (r < I3) { conv_item<3>(a.w_o + (size_t)l * DM * DM, nullptr, a.out_norm_swa + l * 512, a.out_norm_mla + l * 512, DM, DM, (bf16*)(wbuf + WL_O), scr, r, DM / 32, lane); continue; } r -= I3;
        if (r < I4) { conv_item<4>(a.w_gate + (size_t)l * DM * DFF, a.w_up + (size_t)l * DM * DFF, a.ffn_norm + l * DM, nullptr, DM, DFF, (bf16*)(wbuf + WL_GU), scr, r, GUP / 32, lane); continue; } r -= I4;
        conv_item<5>(a.w_down + (size_t)l * DFF * DM, nullptr, nullptr, nullptr, DFF, DM, (bf16*)(wbuf + WL_D), scr, r, DM / 32, lane);
    }
}

__device__ __forceinline__ void init_rows(const Args& a, unsigned char* ws) {
    const int lane = threadIdx.x & 63, wave = threadIdx.x >> 6; const int gw = blockIdx.x * NWAVES + wave, NGW = gridDim.x * NWAVES;
    for (int row = gw; row < MC + NMETA; row += NGW) {
        const bool meta = row >= MC; const int r = meta ? row - MC : row;
        const float* src = meta ? a.meta + (size_t)r * DM : a.x + (size_t)r * DM;
        float* H = (float*)(ws + (meta ? WS_PART + PM_H : WS_H)); bf16* HB = (bf16*)(ws + (meta ? WS_PART + PM_HB : WS_HB)); float* hss = (float*)(ws + WS_PART + (meta ? PM_HSSA : P_HSSA));
        pg8::f32x4 v[4]; float s = 0.f;
#pragma unroll
        for (int j = 0; j < 4; ++j) { v[j] = *((const GAS pg8::f32x4*)src + lane + 64 * j); s += pg8::sq4(v[j]); }
        s = wave_sum(s);
#pragma unroll
        for (int j = 0; j < 4; ++j) { pg8::st_bf16x4(HB + (size_t)r * DM + 4 * (lane + 64 * j), v[j]); }
        if (lane < 16) ((GAS float*)hss)[(size_t)r * 16 + lane] = (lane == 0) ? s : 0.f;
    }
}
__device__ __forceinline__ void final_rows(const Args& a, const bf16* HBf, const float* hss) {
    const int lane = threadIdx.x & 63, wave = threadIdx.x >> 6; const int gw = blockIdx.x * NWAVES + wave, NGW = gridDim.x * NWAVES;
    for (int o = gw; o < BATCH * SEQ; o += NGW) {
        const int row = o;
        const float rs = pg8::rsq(pg8::sum16(hss, row) * (1.0f / DM) + RMS_EPS);
#pragma unroll
        for (int j = 0; j < 4; ++j) { const pg8::u32x2 hw = *((const GAS pg8::u32x2*)(HBf + (size_t)row * DM) + lane + 64 * j); pg8::f32x4 v; v[0] = __builtin_bit_cast(float, hw.x << 16); v[1] = __builtin_bit_cast(float, hw.x & 0xffff0000u); v[2] = __builtin_bit_cast(float, hw.y << 16); v[3] = __builtin_bit_cast(float, hw.y & 0xffff0000u);
            const pg8::f32x4 g = *((const GAS pg8::f32x4*)a.final_norm + lane + 64 * j);
            *((GAS pg8::f32x4*)(a.out + (size_t)o * DM) + lane + 64 * j) = v * rs * g; }
    }
}

constexpr int N_ATT_UNITS = 2 * 17 * 64;
__device__ __forceinline__ void attn_phase(const Args& a, int l, unsigned char* ws, LAS unsigned char* lds, int mode = 0) {
    const int lq = l; l &= 3;
    unsigned char* R = ws + WS_R;
    const bf16 *QA = (const bf16*)(R + R_QA), *KA = (const bf16*)(R + R_KA), *VA = (const bf16*)(R + R_VA), *KR = (const bf16*)(R + R_KR), *QM = (const bf16*)(R + R_QM), *KN = (const bf16*)(R + R_KN), *VB = (const bf16*)(R + R_VB);
    bf16* O = (bf16*)(R + R_O); float* ssqO = (float*)(ws + WS_PART + P_SSQO);
    LAS int* qslot = (LAS int*)(lds + att::OFF_Q);
    const unsigned xcc = ((unsigned)__builtin_amdgcn_s_getreg((3 << 11) | 20) & 0xFu) & 7u;
    unsigned* ctr = (unsigned*)(ws + WS_CTL) + 64 * lq + 8 * 64 * (int)xcc;
    constexpr int PER_X = N_ATT_UNITS / 8;
    for (int pass = 0; pass < 8; ++pass) {
        const unsigned x = (xcc + (unsigned)pass) & 7u; unsigned* c = (unsigned*)(ws + WS_CTL) + 64 * lq + 8 * 64 * (int)x;
        for (;;) {
            if (threadIdx.x == 0) *qslot = (int)atomicAdd(c, 1u);
            __syncthreads();
            const int u = *qslot;
            __syncthreads();
            if (u >= (mode == 1 ? PER_X / 2 : PER_X)) break;
            if (u < PER_X / 2) {
                const int bh = 8 * (u / 17) + (int)x, qb = 16 - u % 17, b = bh >> 3, hd = bh & 7;
                att::attn_unit<96, false>(lds, QM + hd * 96, 768, KN + hd * 64, 512, KR, VB + hd * 64, 512, O + 512 + hd * 64, ssqO + 8 + hd, 0.f, b, qb);
            } else {
                const int v = u - PER_X / 2; const int bh = 8 * (v / 17) + (int)x, qb = 16 - v % 17, b = bh >> 3, hq = bh & 7, kv = hq >> 2;
                att::attn_unit<64, true>(lds, QA + hq * 64, 512, KA + kv * 64, 128, nullptr, VA + kv * 64, 128, O + hq * 64, ssqO + hq, a.sinks[l * 8 + hq] * LOG2E, b, qb);
            }
        }
    }
    (void)ctr;
}

#define XB_TMO      128
#define XB_XCNT(j)  (256  + 64 * (j))
#define XB_XSUB(j)  (1280 + 64 * (j))
#define XB_XGEN(j)  (2304 + 64 * (j))
#define XB_TOP      3328
#define XB_TOPGEN   3392
#define XCD_BAR_WORDS 3456
#define XB_SPIN_CAP (1u << 18)

__device__ __forceinline__ unsigned xb_ld(unsigned* p)              { return __hip_atomic_load(p, __ATOMIC_RELAXED, __HIP_MEMORY_SCOPE_AGENT); }
__device__ __forceinline__ unsigned xb_add(unsigned* p, unsigned v) { return __hip_atomic_fetch_add(p, v, __ATOMIC_RELAXED, __HIP_MEMORY_SCOPE_AGENT); }
__device__ __forceinline__ unsigned xb_xcc_id() { return (unsigned)__builtin_amdgcn_s_getreg((3 << 11) | 20) & 0xFu; }
#define XB_SPIN(cond, bar) do { unsigned _sp = 0; while (cond) { __builtin_amdgcn_s_sleep(1); \
    if ((++_sp & 255u) == 0u) { if (xb_ld(&(bar)[XB_TMO])) break; if (_sp > XB_SPIN_CAP) { atomicAdd(&(bar)[XB_TMO], 1u); break; } } } } while (0)

struct XcdBarrier {
    unsigned* bar; unsigned x;
    volatile LAS unsigned* st;
};

__device__ __forceinline__ XcdBarrier xcd_barrier_post(unsigned* bar, volatile LAS unsigned* st) {
    XcdBarrier b; b.bar = bar; b.x = xb_xcc_id(); b.st = st;
    if (threadIdx.x == 0) (void)xb_add(&bar[XB_XCNT(b.x)], 1u);
    return b;
}
__device__ __forceinline__ void xcd_barrier_complete(unsigned* bar, unsigned x, unsigned& nloc, unsigned& nx) {
    const unsigned G = gridDim.x * gridDim.y * gridDim.z;
    unsigned sum, cnt, mine, sp = 0u;
    for (;;) {
        sum = 0u; cnt = 0u; mine = 0u;
#pragma unroll
        for (unsigned j = 0; j < 16; ++j) { const unsigned c = xb_ld(&bar[XB_XCNT(j)]); sum += c; cnt += (c > 0u) ? 1u : 0u; mine = (j == x) ? c : mine; }
        if (sum == G) break;
        __builtin_amdgcn_s_sleep(1);
        if ((++sp & 255u) == 0u) { if (xb_ld(&bar[XB_TMO])) break; if (sp > XB_SPIN_CAP) { atomicAdd(&bar[XB_TMO], 1u); break; } }
    }
    nloc = mine > 0u ? mine : 1u; nx = cnt > 0u ? cnt : 1u;
}

__device__ __forceinline__ void xcd_barrier(const XcdBarrier& b) {
    asm volatile("s_waitcnt vmcnt(0)" ::: "memory");
    __syncthreads();
    if (threadIdx.x == 0) {
        unsigned* bar = b.bar;
        __builtin_amdgcn_s_waitcnt(0);
        unsigned nloc = b.st[0], nx = b.st[1];
        if (nloc == 0u) { xcd_barrier_complete(bar, b.x, nloc, nx); b.st[0] = nloc; b.st[1] = nx; }
        const unsigned old = xb_add(&bar[XB_XSUB(b.x)], 1u);
        const unsigned gen = old / nloc;
        if (old + 1u == (gen + 1u) * nloc) {
            __builtin_amdgcn_fence(__ATOMIC_RELEASE, "agent");
            asm volatile("s_waitcnt vmcnt(0)" ::: "memory");
            const unsigned og = xb_add(&bar[XB_TOP], 1u);
            const unsigned tg = og / nx;
            if (og + 1u == (tg + 1u) * nx) xb_add(&bar[XB_TOPGEN], 1u);
            else XB_SPIN(xb_ld(&bar[XB_TOPGEN]) == tg, bar);
            __builtin_amdgcn_fence(__ATOMIC_ACQUIRE, "agent");
            xb_add(&bar[XB_XGEN(b.x)], 1u);
            asm volatile("s_waitcnt vmcnt(0)" ::: "memory");
        } else {
            XB_SPIN(xb_ld(&bar[XB_XGEN(b.x)]) == gen, bar);
            __builtin_amdgcn_fence(__ATOMIC_ACQUIRE, "agent");
            asm volatile("s_waitcnt vmcnt(0)" ::: "memory");
        }
    }
    __syncthreads();
}

constexpr int CW_BAR = 4096;
constexpr int XB_LDS_OFF = 131072 + 8192;
#ifndef PHM
#define PHM 255
#endif
#ifndef PROBE_DUP
#define PROBE_DUP 0
#endif
#ifndef PROBE_SYNC
#define PROBE_SYNC 0
#endif
__global__ void __launch_bounds__(NTHREADS, 2) fwd_megakernel(Args a) {
    extern __shared__ __attribute__((aligned(16))) unsigned char lds_raw[];
    LAS unsigned char* lds = (LAS unsigned char*)lds_raw;
    cg::grid_group grid = cg::this_grid();
    const int lo = a.ph_lo, hi = a.ph_hi;
    if (threadIdx.x < 2) ((LAS unsigned*)(lds + XB_LDS_OFF))[threadIdx.x] = 0u;
    __syncthreads();
    if (a.ph_hi < 0) grid.sync();
    const XcdBarrier xbar = xcd_barrier_post((unsigned*)(a.ws + WS_CTL) + CW_BAR, (volatile LAS unsigned*)(lds + XB_LDS_OFF));
#define IN_PH(k) (lo <= (k) && (k) < hi)
#define SEAM(k) do { if (IN_PH(k) && IN_PH((k) + 1)) { xcd_barrier(xbar); if (PROBE_SYNC) xcd_barrier(xbar); } } while (0)
#define WSL(w) unsigned char* w = a.ws; asm volatile("" : "+s"(w))
    if (IN_PH(0) && (PHM & 1)) { WSL(ws); init_rows(a, ws); conv_layer(a, 0, ws + WS_W, lds); __syncthreads(); }
    SEAM(0);
#pragma unroll 1
    for (int l = 0; l < DEPTH; ++l) {
        const int p = 1 + 6 * l;
        if (IN_PH(p) && (PHM & 2)) {
            { WSL(ws); unsigned char* R = ws + WS_R; unsigned char* wb = ws + WS_W + (size_t)(l & 1) * WBUF; unsigned char* pm_ = ws + WS_PART;
              pg8::EpiIn<true> E{(const float*)(pm_ + PM_HSSA), (bf16*)(R + R_QA), (bf16*)(R + R_KA), (bf16*)(R + R_VA), (bf16*)(pm_ + PM_QLAT), (bf16*)(pm_ + PM_KVLAT), (bf16*)(R + R_KR), (float*)(pm_ + PM_SSQQ), (float*)(pm_ + PM_SSQKV)};
              pg8::skinny_phase<DM>(lds, (const bf16*)(pm_ + PM_HB), (const bf16*)(wb + WL_IN), INP / 256, E, 128); }
            WSL(ws); unsigned char* R = ws + WS_R; unsigned char* wb = ws + WS_W + (size_t)(l & 1) * WBUF;
            pg8::Gemm g{(const bf16*)(ws + WS_HB), (const bf16*)(wb + WL_IN), MC, INP, DM, 0}; pg8::OrderCT<MC / 256, INP / 256> S; S.init((int)gridDim.x, (int)blockIdx.x);
            pg8::EpiIn<false> E{(const float*)(ws + WS_PART + P_HSSA), (bf16*)(R + R_QA), (bf16*)(R + R_KA), (bf16*)(R + R_VA), (bf16*)(R + R_QLAT), (bf16*)(R + R_KVLAT), (bf16*)(R + R_KR),
                         (float*)(ws + WS_PART + P_SSQQ), (float*)(ws + WS_PART + P_SSQKV)};
            pg8::gemm_phase<pg8::EpiIn<false>, pg8::OrderCT<MC / 256, INP / 256>, true, true>(lds, g, S, E);
            if (PROBE_DUP & 2) pg8::gemm_phase<pg8::EpiIn<false>, pg8::OrderCT<MC / 256, INP / 256>, true, true>(lds, g, S, E);
        }
        SEAM(p);
        if (IN_PH(p + 1) && (PHM & 4)) {
            { WSL(ws); unsigned char* R = ws + WS_R; unsigned char* wb = ws + WS_W + (size_t)(l & 1) * WBUF; unsigned char* pm_ = ws + WS_PART;
              pg8::EpiQup<true> E{(const float*)(pm_ + PM_SSQQ), (bf16*)(R + R_QM)}; pg8::skinny_phase<256>(lds, (const bf16*)(pm_ + PM_QLAT), (const bf16*)(wb + WL_Q), 3, E, 128); }
            { WSL(ws); unsigned char* R = ws + WS_R; unsigned char* wb = ws + WS_W + (size_t)(l & 1) * WBUF;
              pg8::Gemm g{(const bf16*)(R + R_QLAT), (const bf16*)(wb + WL_Q), MC, 768, 256, 0}; pg8::OrderCT<MC / 256, 3> S; S.init((int)gridDim.x, (int)blockIdx.x);
              pg8::EpiQup<false> E{(const float*)(ws + WS_PART + P_SSQQ), (bf16*)(R + R_QM)}; pg8::gemm_phase<pg8::EpiQup<false>, pg8::OrderCT<MC / 256, 3>, true, true>(lds, g, S, E); if (PROBE_DUP & 4) pg8::gemm_phase<pg8::EpiQup<false>, pg8::OrderCT<MC / 256, 3>, true, true>(lds, g, S, E); }
            { WSL(ws); unsigned char* R = ws + WS_R; unsigned char* wb = ws + WS_W + (size_t)(l & 1) * WBUF; unsigned char* pm_ = ws + WS_PART;
              pg8::EpiKvup<true> E{(const float*)(pm_ + PM_SSQKV), (bf16*)(R + R_KN), (bf16*)(R + R_VB)}; pg8::skinny_phase<128>(lds, (const bf16*)(pm_ + PM_KVLAT), (const bf16*)(wb + WL_KV), 4, E, 0); }
            { WSL(ws); unsigned char* R = ws + WS_R; unsigned char* wb = ws + WS_W + (size_t)(l & 1) * WBUF;
              pg8::Gemm g{(const bf16*)(R + R_KVLAT), (const bf16*)(wb + WL_KV), MC, 1024, 128, 0}; pg8::OrderCT<MC / 256, 4> S; S.init((int)gridDim.x, (int)blockIdx.x);
              pg8::EpiKvup<false> E{(const float*)(ws + WS_PART + P_SSQKV), (bf16*)(R + R_KN), (bf16*)(R + R_VB)}; pg8::gemm_phase<pg8::EpiKvup<false>, pg8::OrderCT<MC / 256, 4>, true, true>(lds, g, S, E); if (PROBE_DUP & 4) pg8::gemm_phase<pg8::EpiKvup<false>, pg8::OrderCT<MC / 256, 4>, true, true>(lds, g, S, E); }
        }
        SEAM(p + 1);
        if (IN_PH(p + 2) && (PHM & 8)) { WSL(ws); if (l + 1 < DEPTH) { conv_layer(a, l + 1, ws + WS_W + (size_t)((l + 1) & 1) * WBUF, lds); __syncthreads(); if (PROBE_DUP & 256) { conv_layer(a, l + 1, ws + WS_W + (size_t)((l + 1) & 1) * WBUF, lds); __syncthreads(); } } attn_phase(a, l, ws, lds); if (PROBE_DUP & 8) attn_phase(a, l + 4, ws, lds); if (PROBE_DUP & 1024) attn_phase(a, l + 4, ws, lds, 1); }
        SEAM(p + 2);
        if (IN_PH(p + 3) && (PHM & 16)) {
            { WSL(ws); unsigned char* R = ws + WS_R; unsigned char* wb = ws + WS_W + (size_t)(l & 1) * WBUF; unsigned char* pm_ = ws + WS_PART;
              pg8::EpiOut<true> E; E.H = (float*)(pm_ + PM_H); E.HB = (bf16*)(pm_ + PM_HB); E.hss_out = (float*)(pm_ + PM_HSSB); E.ssq_o = (const float*)(pm_ + P_SSQO); E.xlds = lds;
              pg8::skinny_phase<DM>(lds, (const bf16*)(R + R_O) + (size_t)FRONT * 1024, (const bf16*)(wb + WL_O), 4, E, 0); }
            WSL(ws); unsigned char* R = ws + WS_R; unsigned char* wb = ws + WS_W + (size_t)(l & 1) * WBUF;
            pg8::Gemm g{(const bf16*)(R + R_O), (const bf16*)(wb + WL_O), MC, DM, DM, 1}; pg8::OrderCT<MC / 256, 4> S; S.init((int)gridDim.x, (int)blockIdx.x);
            pg8::EpiOut<false> E; E.H = (float*)(ws + WS_H); E.HB = (bf16*)(ws + WS_HB); E.hss_out = (float*)(ws + WS_PART + P_HSSB); E.ssq_o = (const float*)(ws + WS_PART + P_SSQO); E.xlds = lds + pg8::STAGE_BYTES;
            pg8::gemm_phase<pg8::EpiOut<false>, pg8::OrderCT<MC / 256, 4>, true, true>(lds, g, S, E);
        }
        SEAM(p + 3);
        if (IN_PH(p + 4) && (PHM & 32)) {
            { WSL(ws); unsigned char* wb = ws + WS_W + (size_t)(l & 1) * WBUF; unsigned char* pm_ = ws + WS_PART;
              pg8::EpiGU<true> E{(const float*)(pm_ + PM_HSSB), (bf16*)(pm_ + PM_ACT)}; pg8::skinny_phase<DM>(lds, (const bf16*)(pm_ + PM_HB), (const bf16*)(wb + WL_GU), GUP / 256, E, 0); }
            WSL(ws); unsigned char* R = ws + WS_R; unsigned char* wb = ws + WS_W + (size_t)(l & 1) * WBUF;
            pg8::Gemm g{(const bf16*)(ws + WS_HB), (const bf16*)(wb + WL_GU), MC, GUP, DM, 0}; pg8::OrderCT<MC / 256, GUP / 256> S; S.init((int)gridDim.x, (int)blockIdx.x);
            pg8::EpiGU<false> E{(const float*)(ws + WS_PART + P_HSSB), (bf16*)(R + R_ACT)};
            pg8::gemm_phase<pg8::EpiGU<false>, pg8::OrderCT<MC / 256, GUP / 256>, true, true>(lds, g, S, E);
        }
        SEAM(p + 4);
        if (IN_PH(p + 5) && (PHM & 64)) {
            { WSL(ws); unsigned char* wb = ws + WS_W + (size_t)(l & 1) * WBUF; unsigned char* pm_ = ws + WS_PART;
              pg8::EpiDown<true> E; E.H = (float*)(pm_ + PM_H); E.HB = (bf16*)(pm_ + PM_HB); E.hss_out = (float*)(pm_ + PM_HSSA); E.ssq_o = nullptr;
              pg8::skinny_phase<DFF>(lds, (const bf16*)(pm_ + PM_ACT), (const bf16*)(wb + WL_D), 4, E, 0); }
            WSL(ws); unsigned char* R = ws + WS_R; unsigned char* wb = ws + WS_W + (size_t)(l & 1) * WBUF;
            pg8::Gemm g{(const bf16*)(R + R_ACT), (const bf16*)(wb + WL_D), MC, DM, DFF, 0}; pg8::OrderCT<MC / 256, 4> S; S.init((int)gridDim.x, (int)blockIdx.x);
            pg8::EpiDown<false> E; E.H = (float*)(ws + WS_H); E.HB = (bf16*)(ws + WS_HB); E.hss_out = (float*)(ws + WS_PART + P_HSSA); E.ssq_o = nullptr;
            pg8::gemm_phase<pg8::EpiDown<false>, pg8::OrderCT<MC / 256, 4>, true, true>(lds, g, S, E);
        }
        SEAM(p + 5);
    }
    if (IN_PH(1 + 6 * DEPTH) && (PHM & 128)) { WSL(ws); final_rows(a, (const bf16*)(ws + WS_HB), (const float*)(ws + WS_PART + P_HSSA)); }
#undef IN_PH
#undef SEAM
#undef WSL
}
constexpr int N_PHASES = 2 + 6 * DEPTH;

#ifndef MK_SPLIT
#define MK_SPLIT 0
#endif
extern "C" void kernel_launch(void* const* d_in, const int* in_sizes, int n_in, void* d_out, int out_size, void* d_ws, size_t ws_size, hipStream_t stream) {
    static int grid = 0;
    if (grid == 0) {
        if (n_in != 17 || ws_size < WS_END) { fprintf(stderr, "kernel_launch: need 17 inputs and >= %zu bytes of workspace; got n_in %d, ws %zu\n", (size_t)WS_END, n_in, ws_size); grid = -1; return; }
        int dev = 0, cus = 0, per_cu = 0;
        hipGetDevice(&dev); hipDeviceGetAttribute(&cus, hipDeviceAttributeMultiprocessorCount, dev);
        if (hipFuncSetAttribute((const void*)fwd_megakernel, hipFuncAttributeMaxDynamicSharedMemorySize, LDS_BYTES) != hipSuccess) { fprintf(stderr, "kernel_launch: hipFuncSetAttribute failed\n"); grid = -1; return; }
        if (hipOccupancyMaxActiveBlocksPerMultiprocessor(&per_cu, (const void*)fwd_megakernel, NTHREADS, LDS_BYTES) != hipSuccess || per_cu < 1) { fprintf(stderr, "kernel_launch: occupancy query says %d\n", per_cu); per_cu = 1; }
        (void)hipGetLastError();
        grid = cus * 1;
    }
    if (grid < 0) return;
    hipMemsetAsync((char*)d_ws + WS_CTL, 0, CTL_BYTES, stream);
    Args a{};
    const float** f = (const float**)&a;
    for (int i = 0; i < 17; ++i) f[i] = (const float*)d_in[i];
    a.out = (float*)d_out; a.ws = (unsigned char*)d_ws;
#if MK_SPLIT
    for (int ph = 0; ph < N_PHASES; ++ph) { a.ph_lo = ph; a.ph_hi = ph + 1; hipLaunchKernelGGL(fwd_megakernel, dim3(grid), dim3(NTHREADS), LDS_BYTES, stream, a); }
#else
    a.ph_lo = 0; a.ph_hi = N_PHASES;
    void* args[] = {&a};
    hipError_t e = hipLaunchCooperativeKernel((const void*)fwd_megakernel, dim3(grid), dim3(NTHREADS), args, LDS_BYTES, stream);
    if (e != hipSuccess) fprintf(stderr, "cooperative launch failed: %s (grid %d)\n", hipGetErrorString(e), grid);
#endif
}
```

```cpp
#include <hip/hip_runtime.h>
#include <hip/hip_cooperative_groups.h>
#include <cstdio>
#include <cstdint>
namespace cg = cooperative_groups;

constexpr int BATCH = 8, SEQ = 4096, DM = 1024, DEPTH = 4, NMETA = 16, FRONT = 112, TT = 4224;
constexpr int MROWS = BATCH * TT;
constexpr int INW = 1184, INP = 1280, DFF = 2816, GUP = 2 * DFF;
constexpr float RMS_EPS = 1e-6f;
constexpr float LOG2E = 1.4426950408889634f;
constexpr float LOG2_THETA = 13.287712379549449f;
constexpr float INV_2PI = 0.15915494309189535f;

namespace pg8 {
#define PG8_LAS __attribute__((address_space(3)))
typedef unsigned short bf16_t;
typedef short bf16x8 __attribute__((ext_vector_type(8)));
typedef float f32x4 __attribute__((ext_vector_type(4)));
typedef unsigned u32x4 __attribute__((ext_vector_type(4)));
constexpr int BM = 256, BK = 64, HALF = 128, HTB = HALF * BK * 2  , STAGE_BYTES = 8 * HTB, NXCD = 8, WGM = 8;

__host__ __device__ __forceinline__ int lds_byte(int r, int c) { const int st = (r >> 4) * 2 + (c >> 5), rr = r & 15, cc = c & 31, ob = rr * 64 + cc * 2; return st * 1024 + (ob ^ (((ob >> 9) & 1) << 5)); }
__host__ __device__ __forceinline__ void stage_rc(int b, int& R, int& C) { const int st = b / 1024, sb = b % 1024, swz = sb ^ (((sb >> 9) & 1) << 5); R = (st >> 1) * 16 + swz / 64; C = (st & 1) * 32 + (swz % 64) / 2; }
__host__ __device__ __forceinline__ int perm32(int rho) { const int n = rho >> 4, i = rho & 15; return 8 * (i >> 2) + 4 * n + (i & 3); }

struct Unit { int pm, pn; };
struct Gemm { const bf16_t* A; const bf16_t* Bt; int M, N, K; int apad; };

struct StaticOrder {
    int nM, nN, nwg, G, c;
    __host__ __device__ void init(int M, int N, int G_, int c_) { nM = M / BM; nN = N / BM; nwg = nM * nN; G = G_; c = c_; }
    __host__ __device__ bool next(int i, Unit& u) const {
        const long L = (long)i * G + c; if (L >= nwg) return false;
        int wgid = (int)L; { const int q = nwg / NXCD, r = nwg % NXCD, xcd = wgid % NXCD, off = wgid / NXCD; wgid = (xcd < r ? xcd * (q + 1) : r * (q + 1) + (xcd - r) * q) + off; }
        const int nig = WGM * nN, gid = wgid / nig, fm = gid * WGM, gsz = (nM - fm) < WGM ? (nM - fm) : WGM;
        u.pm = fm + ((wgid % nig) % gsz); u.pn = (wgid % nig) / gsz; return true;
    }
    __device__ __forceinline__ void a_ready(const Unit&) const {}
    __device__ __forceinline__ void done(const Unit&) const {}
};

__device__ __forceinline__ unsigned cvt_pk_bf16(float lo, float hi) { unsigned r; asm volatile("v_cvt_pk_bf16_f32 %0, %1, %2" : "=v"(r) : "v"(lo), "v"(hi)); return r; }

template <int NM, int NN> struct OrderCT {
    static_assert(NM % 8 == 0 || NM % 8 == 4, "last M group must be 8 or 4 tiles");
    int G, c;
    __device__ __forceinline__ void init(int G_, int c_) { G = G_; c = c_; }
    __device__ __forceinline__ bool next(int i, Unit& u) const {
        constexpr int nwg = NM * NN, q = nwg / NXCD, r = nwg % NXCD, nig = WGM * NN;
        const int L = i * G + c; if (L >= nwg) return false;
        const int xcd = L & (NXCD - 1), off = L >> 3;
        const int wgid = (xcd < r ? xcd * (q + 1) : r * (q + 1) + (xcd - r) * q) + off;
        const int gid = wgid / nig, rem = wgid - gid * nig, fm = gid * WGM;
        const int sh = (NM - fm) < WGM ? 2 : 3;
        u.pm = fm + (rem & ((1 << sh) - 1)); u.pn = rem >> sh; return true;
    }
    __device__ __forceinline__ void a_ready(const Unit&) const {}
    __device__ __forceinline__ void done(const Unit&) const {}
};
typedef unsigned u32x2 __attribute__((ext_vector_type(2)));
#define PG8_GAS __attribute__((address_space(1)))
__device__ __forceinline__ void st_bf16x4(bf16_t* p, f32x4 v) { u32x2 w; w.x = cvt_pk_bf16(v[0], v[1]); w.y = cvt_pk_bf16(v[2], v[3]); *(PG8_GAS u32x2*)p = w; }
__device__ __forceinline__ void st_bf16x8(bf16_t* p, f32x4 v0, f32x4 v1) { u32x4 w; w.x = cvt_pk_bf16(v0[0], v0[1]); w.y = cvt_pk_bf16(v0[2], v0[3]); w.z = cvt_pk_bf16(v1[0], v1[1]); w.w = cvt_pk_bf16(v1[2], v1[3]); *(PG8_GAS u32x4*)p = w; }
__device__ __forceinline__ float sum16(const float* part, int row) {
    const PG8_GAS f32x4* p = (const PG8_GAS f32x4*)(part + (size_t)row * 16); const f32x4 a = p[0], b = p[1], c = p[2], d = p[3];
    return (((a.x + a.y) + (a.z + a.w)) + ((b.x + b.y) + (b.z + b.w))) + (((c.x + c.y) + (c.z + c.w)) + ((d.x + d.y) + (d.z + d.w)));
}
__device__ __forceinline__ float sum16q(const float* part, int row, int fq) {
    const f32x4 a = *((const PG8_GAS f32x4*)(part + (size_t)row * 16) + fq); float s = (a.x + a.y) + (a.z + a.w);
    s += __shfl_xor(s, 16); s += __shfl_xor(s, 32); return s;
}
__device__ __forceinline__ float sum4(const float* part, int row) { const f32x4 a = *(const PG8_GAS f32x4*)(part + (size_t)row * 4); return (a.x + a.y) + (a.z + a.w); }
__device__ __forceinline__ float rsq(float x) { return 1.0f / sqrtf(x); }
__device__ __forceinline__ float sq4(f32x4 v) { return (v[0] * v[0] + v[1] * v[1]) + (v[2] * v[2] + v[3] * v[3]); }
#define EPI_ROWS(ai, m) for (int ai = 0; ai < 2; ++ai) for (int m = 0; m < 4; ++m)
#define EPI_ROW(u, ai, m) ((u).pm * BM + (ai) * HALF + wr * 64 + (m) * 16 + fr)

__device__ __forceinline__ int prow_of(int m) { return m + (m >> 12) * 128 + 128; }
#define EPI_NB (META ? BATCH : 1)
#define EPI_PROW(row, b) (META ? (size_t)((b) * TT + FRONT + (row)) : (size_t)prow_of(row))
#define EPI_MAIN_LOOP(CALL) _Pragma("unroll") for (int ai = 0; ai < 2; ++ai) _Pragma("unroll") for (int m = 0; m < 4; ++m) { asm volatile("" ::: "memory"); const int row = EPI_ROW(u, ai, m); \
        const f32x4 a_[2][2] = {{acc[ai][0][m][0], acc[ai][0][m][1]}, {acc[ai][1][m][0], acc[ai][1][m][1]}}; CALL; }

template <bool META> struct EpiIn {
    static constexpr bool PERM = true, AFTER_DRAIN = false, MIDSCALE = false;
    const float* hss; bf16_t *qa, *ka, *va, *qlat, *kvlat, *kr; float *ssq_q, *ssq_kv;
    __device__ __forceinline__ void mid(f32x4 (&)[2][2][4][2], const Unit&, int, int, int, int) const {}
    __device__ __forceinline__ void row_epi(const f32x4 (&a)[2][2], int row, int pn, int wc, int fr, int fq) const {
        const float rs = rsq(sum16q(hss, row, fq) * (1.0f / DM) + RMS_EPS);
        if (pn <= 2) {
            const bool is_kr = (pn == 2 && wc == 2);
            if (pn == 2 && wc == 3) return;
            const float pos = META ? (float)row : (float)((row & 4095) + NMETA);
            f32x4 o1[2], o2[2];
#pragma unroll
            for (int n = 0; n < 2; ++n) {
                const f32x4 x1 = a[0][n] * rs, x2 = a[1][n] * rs;
#pragma unroll
                for (int e = 0; e < 4; ++e) { const float d1 = (float)(8 * fq + 4 * n + e); const float inv = __builtin_amdgcn_exp2f(-d1 * (is_kr ? (LOG2_THETA / 16.0f) : (LOG2_THETA / 32.0f)));
                    const float ang = pos * inv; float rev = ang * INV_2PI; rev = rev - floorf(rev);
                    const float sn = __builtin_amdgcn_sinf(rev), cs = __builtin_amdgcn_cosf(rev); o1[n][e] = x1[e] * cs - x2[e] * sn; o2[n][e] = x2[e] * cs + x1[e] * sn; }
            }
            if (is_kr && fq >= 2) return;
#pragma unroll
            for (int b = 0; b < EPI_NB; ++b) { const size_t pr = EPI_PROW(row, b); bf16_t* d; int half;
                if (pn < 2) { d = qa + pr * 512 + (4 * pn + wc) * 64 + 8 * fq; half = 32; }
                else if (!is_kr) { d = ka + pr * 128 + wc * 64 + 8 * fq; half = 32; }
                else { d = kr + pr * 32 + 8 * fq; half = 16; }
                st_bf16x8(d, o1[0], o1[1]); st_bf16x8(d + half, o2[0], o2[1]); }
        } else if (pn == 3) {
            const int c = 32 * wc + 8 * fq; const f32x4 v0 = a[0][0] * rs, v1 = a[0][1] * rs, w0 = a[1][0] * rs, w1 = a[1][1] * rs;
#pragma unroll
            for (int b = 0; b < EPI_NB; ++b) st_bf16x8(va + EPI_PROW(row, b) * 128 + c, v0, v1);
            st_bf16x8(kvlat + (size_t)row * 128 + c, w0, w1);
            float ss = sq4(w0) + sq4(w1);
            ss += __shfl_xor(ss, 16); ss += __shfl_xor(ss, 32);
            if (fq == 0) ((PG8_GAS float*)ssq_kv)[(size_t)row * 4 + wc] = ss;
        } else {
            float ss = 0.f;
#pragma unroll
            for (int bj = 0; bj < 2; ++bj) { const int c = 128 * bj + 32 * wc + 8 * fq; const f32x4 v0 = a[bj][0] * rs, v1 = a[bj][1] * rs; st_bf16x8(qlat + (size_t)row * 256 + c, v0, v1); ss += sq4(v0) + sq4(v1); }
            ss += __shfl_xor(ss, 16); ss += __shfl_xor(ss, 32);
            if (fq == 0) ((PG8_GAS float*)ssq_q)[(size_t)row * 4 + wc] = ss;
        }
    }
    __device__ __forceinline__ void operator()(const f32x4 (&acc)[2][2][4][2], const Unit& u, int wr, int wc, int fr, int fq) const { EPI_MAIN_LOOP(row_epi(a_, row, u.pn, wc, fr, fq)) }
};

template <bool META> struct EpiQup {
    static constexpr bool PERM = true, AFTER_DRAIN = false, MIDSCALE = false;
    const float* ssq_q; bf16_t* qm;
    __device__ __forceinline__ void mid(f32x4 (&)[2][2][4][2], const Unit&, int, int, int, int) const {}
    __device__ __forceinline__ void row_epi(const f32x4 (&a)[2][2], int row, int pn, int wc, int fr, int fq) const {
        const float rs = rsq(sum4(ssq_q, row) * (1.0f / 256.0f) + RMS_EPS);
        if (pn < 2) {
#pragma unroll
            for (int bj = 0; bj < 2; ++bj) { const int head = 4 * pn + 2 * bj + (wc >> 1), d = 32 * (wc & 1) + 8 * fq; const f32x4 v0 = a[bj][0] * rs, v1 = a[bj][1] * rs;
#pragma unroll
                for (int b = 0; b < EPI_NB; ++b) st_bf16x8(qm + EPI_PROW(row, b) * 768 + head * 96 + d, v0, v1); }
        } else {
            const float pos = META ? (float)row : (float)((row & 4095) + NMETA);
            const int head = 2 * wc + (fq >> 1), i0 = 8 * (fq & 1); f32x4 o1[2], o2[2];
#pragma unroll
            for (int n = 0; n < 2; ++n) { const f32x4 x1 = a[0][n] * rs, x2 = a[1][n] * rs;
#pragma unroll
                for (int e = 0; e < 4; ++e) { const float inv = __builtin_amdgcn_exp2f(-(float)(i0 + 4 * n + e) * (LOG2_THETA / 16.0f)); const float ang = pos * inv; float rev = ang * INV_2PI; rev = rev - floorf(rev);
                    const float sn = __builtin_amdgcn_sinf(rev), cs = __builtin_amdgcn_cosf(rev); o1[n][e] = x1[e] * cs - x2[e] * sn; o2[n][e] = x2[e] * cs + x1[e] * sn; } }
#pragma unroll
            for (int b = 0; b < EPI_NB; ++b) { bf16_t* qrow = qm + EPI_PROW(row, b) * 768 + head * 96; st_bf16x8(qrow + 64 + i0, o1[0], o1[1]); st_bf16x8(qrow + 80 + i0, o2[0], o2[1]); }
        }
    }
    __device__ __forceinline__ void operator()(const f32x4 (&acc)[2][2][4][2], const Unit& u, int wr, int wc, int fr, int fq) const { EPI_MAIN_LOOP(row_epi(a_, row, u.pn, wc, fr, fq)) }
};

template <bool META> struct EpiKvup {
    static constexpr bool PERM = true, AFTER_DRAIN = false, MIDSCALE = false;
    const float* ssq_kv; bf16_t *kn, *vb;
    __device__ __forceinline__ void mid(f32x4 (&)[2][2][4][2], const Unit&, int, int, int, int) const {}
    __device__ __forceinline__ void row_epi(const f32x4 (&a)[2][2], int row, int pn, int wc, int fr, int fq) const {
        bf16_t* dst = (pn < 2 ? kn : vb) + (pn & 1) * 256;
        const float rs = rsq(sum4(ssq_kv, row) * (1.0f / 128.0f) + RMS_EPS);
#pragma unroll
        for (int bj = 0; bj < 2; ++bj) { const f32x4 v0 = a[bj][0] * rs, v1 = a[bj][1] * rs;
#pragma unroll
            for (int b = 0; b < EPI_NB; ++b) st_bf16x8(dst + EPI_PROW(row, b) * 512 + 128 * bj + 32 * wc + 8 * fq, v0, v1); }
    }
    __device__ __forceinline__ void operator()(const f32x4 (&acc)[2][2][4][2], const Unit& u, int wr, int wc, int fr, int fq) const { EPI_MAIN_LOOP(row_epi(a_, row, u.pn, wc, fr, fq)) }
};

struct EpiResid {
    static constexpr bool PERM = true, AFTER_DRAIN = false;
    float* H; bf16_t* HB; float* hss_out; const float* ssq_o;
    __device__ __forceinline__ void resid_row(const f32x4 (&a)[2][2], int row, float rs, int pn, int wc, int fr, int fq) const {
        float ss = 0.f;
#pragma unroll
        for (int bj = 0; bj < 2; ++bj) { const size_t off = (size_t)row * DM + pn * BM + 128 * bj + 32 * wc + 8 * fq;
            const u32x4 hw = *(const PG8_GAS u32x4*)(HB + off); f32x4 h0, h1;
            h0[0] = __builtin_bit_cast(float, hw.x << 16); h0[1] = __builtin_bit_cast(float, hw.x & 0xffff0000u); h0[2] = __builtin_bit_cast(float, hw.y << 16); h0[3] = __builtin_bit_cast(float, hw.y & 0xffff0000u);
            h1[0] = __builtin_bit_cast(float, hw.z << 16); h1[1] = __builtin_bit_cast(float, hw.z & 0xffff0000u); h1[2] = __builtin_bit_cast(float, hw.w << 16); h1[3] = __builtin_bit_cast(float, hw.w & 0xffff0000u);
            h0 = h0 + a[bj][0] * rs; h1 = h1 + a[bj][1] * rs; st_bf16x8(HB + off, h0, h1); ss += sq4(h0) + sq4(h1); }
        ss += __shfl_xor(ss, 16); ss += __shfl_xor(ss, 32);
        if (fq == 0) ((PG8_GAS float*)hss_out)[(size_t)row * 16 + 4 * pn + wc] = ss;
    }
    __device__ __forceinline__ void two_scales(size_t prow, float& f, float& rb) const {
        const PG8_GAS f32x4* p = (const PG8_GAS f32x4*)(ssq_o + prow * 16); const f32x4 a = p[0], b = p[1], c = p[2], d = p[3];
        const float sa = ((a.x + a.y) + (a.z + a.w)) + ((b.x + b.y) + (b.z + b.w)), sb = ((c.x + c.y) + (c.z + c.w)) + ((d.x + d.y) + (d.z + d.w));
        const float va = sa * (1.0f / 512.0f) + RMS_EPS, vb = sb * (1.0f / 512.0f) + RMS_EPS; f = sqrtf(vb / va); rb = rsq(vb);
    }
};
template <bool META> struct EpiOut : EpiResid {
    static constexpr bool MIDSCALE = true;
    PG8_LAS unsigned char* xlds;
    __device__ __forceinline__ void prep(const Unit& u, int wid, int wr, int lane) const {
        PG8_LAS float* tab = (PG8_LAS float*)(xlds + wid * 1024);
#pragma unroll
        for (int j = 0; j < 2; ++j) { const int idx = lane + 64 * j; const int row = u.pm * BM + (idx >> 6) * HALF + wr * 64 + (idx & 63);
            float f, rb; two_scales((size_t)prow_of(row), f, rb); tab[2 * idx] = f; tab[2 * idx + 1] = rb; }
    }
    __device__ __forceinline__ void mid(f32x4 (&acc)[2][2][4][2], const Unit& u, int wr, int wc, int fr, int fq) const {
        const int wid = wr * 4 + wc; const PG8_LAS float* tab = (const PG8_LAS float*)(xlds + wid * 1024);
#pragma unroll
        for (int ai = 0; ai < 2; ++ai)
#pragma unroll
            for (int m = 0; m < 4; ++m) {
                const float f = tab[2 * (ai * 64 + m * 16 + fr)];
#pragma unroll
                for (int bj = 0; bj < 2; ++bj)
#pragma unroll
                    for (int n = 0; n < 2; ++n) acc[ai][bj][m][n] *= f;
            }
    }
    __device__ __forceinline__ void operator()(const f32x4 (&acc)[2][2][4][2], const Unit& u, int wr, int wc, int fr, int fq) const {
        const PG8_LAS float* tab = (const PG8_LAS float*)(xlds + (wr * 4 + wc) * 1024);
        EPI_MAIN_LOOP(resid_row(a_, row, tab[2 * (ai * 64 + m * 16 + fr) + 1], u.pn, wc, fr, fq))
    }
    __device__ __forceinline__ void mid_row(f32x4 (&a)[2][2], int row) const { float f, rb; two_scales((size_t)(FRONT + row), f, rb);
#pragma unroll
        for (int bj = 0; bj < 2; ++bj)
#pragma unroll
            for (int n = 0; n < 2; ++n) a[bj][n] *= f; }
    __device__ __forceinline__ void row_epi(const f32x4 (&a)[2][2], int row, int pn, int wc, int fr, int fq) const { float f, rb; two_scales((size_t)(FRONT + row), f, rb); resid_row(a, row, rb, pn, wc, fr, fq); }
};
template <bool META> struct EpiDown : EpiResid {
    static constexpr bool MIDSCALE = false;
    __device__ __forceinline__ void mid(f32x4 (&)[2][2][4][2], const Unit&, int, int, int, int) const {}
    __device__ __forceinline__ void row_epi(const f32x4 (&a)[2][2], int row, int pn, int wc, int fr, int fq) const { resid_row(a, row, 1.0f, pn, wc, fr, fq); }
    __device__ __forceinline__ void operator()(const f32x4 (&acc)[2][2][4][2], const Unit& u, int wr, int wc, int fr, int fq) const { EPI_MAIN_LOOP(resid_row(a_, row, 1.0f, u.pn, wc, fr, fq)) }
};

template <bool META> struct EpiGU {
    static constexpr bool PERM = true, AFTER_DRAIN = false, MIDSCALE = false;
    const float* hss; bf16_t* act;
    __device__ __forceinline__ void mid(f32x4 (&)[2][2][4][2], const Unit&, int, int, int, int) const {}
    __device__ __forceinline__ void row_epi(const f32x4 (&a)[2][2], int row, int pn, int wc, int fr, int fq) const {
        const float rs = rsq(sum16q(hss, row, fq) * (1.0f / DM) + RMS_EPS); f32x4 o[2];
#pragma unroll
        for (int n = 0; n < 2; ++n) { const f32x4 g = a[0][n] * rs, up = a[1][n] * rs;
#pragma unroll
            for (int e = 0; e < 4; ++e) o[n][e] = g[e] * up[e] * __builtin_amdgcn_rcpf(1.0f + __builtin_amdgcn_exp2f(-g[e] * LOG2E)); }
        st_bf16x8(act + (size_t)row * DFF + 128 * pn + 32 * wc + 8 * fq, o[0], o[1]);
    }
    __device__ __forceinline__ void operator()(const f32x4 (&acc)[2][2][4][2], const Unit& u, int wr, int wc, int fr, int fq) const { EPI_MAIN_LOOP(row_epi(a_, row, u.pn, wc, fr, fq)) }
};

template <int K, class Epi>
__device__ __forceinline__ void skinny_phase(PG8_LAS unsigned char* lds, const bf16_t* A16, const bf16_t* Bt, int NN, const Epi& E, int wg0) {
    int tid_ = threadIdx.x; asm volatile("" : "+v"(tid_));
    const int tid = tid_, lane = tid & 63, wid = __builtin_amdgcn_readfirstlane(tid >> 6), fr = lane & 15, fq = lane >> 4;
    constexpr int nk = K / 32, NJ = (nk + 7) / 8;
    const int G = (int)gridDim.x; int first = (int)blockIdx.x - wg0; if (first < 0) first += G;
    for (int task = first; task < 4 * NN; task += G) {
        const int pn = task >> 2, wc = task & 3;
        f32x4 a[2][2];
#pragma unroll
        for (int bj = 0; bj < 2; ++bj)
#pragma unroll
            for (int n = 0; n < 2; ++n) a[bj][n] = (f32x4){0.f, 0.f, 0.f, 0.f};
        bool scaled = false;
        const bf16_t* ap = A16 + (size_t)fr * K + 8 * fq;
        const bf16_t* bp = Bt + (size_t)(256 * pn + 32 * wc + 8 * (fr >> 2) + (fr & 3)) * K + 8 * fq;
#pragma unroll 4
        for (int j = 0; j < NJ; ++j) {
            const int it = wid + 8 * j; if (it >= nk) break;
            const int k0 = 32 * it;
            if constexpr (Epi::MIDSCALE) { if (!scaled && k0 >= (K >> 1)) { E.mid_row(a, fr); scaled = true; } }
            const bf16x8 av = *(const PG8_GAS bf16x8*)(ap + k0);
#pragma unroll
            for (int bj = 0; bj < 2; ++bj)
#pragma unroll
                for (int n = 0; n < 2; ++n) { const bf16x8 bv = *(const PG8_GAS bf16x8*)(bp + (size_t)(128 * bj + 4 * n) * K + k0);
                    a[bj][n] = __builtin_amdgcn_mfma_f32_16x16x32_bf16(bv, av, a[bj][n], 0, 0, 0); }
        }
        if constexpr (Epi::MIDSCALE) { if (!scaled) E.mid_row(a, fr); }
        PG8_LAS f32x4* red = (PG8_LAS f32x4*)lds;
#pragma unroll
        for (int bj = 0; bj < 2; ++bj)
#pragma unroll
            for (int n = 0; n < 2; ++n) red[(wid * 64 + lane) * 4 + bj * 2 + n] = a[bj][n];
        __syncthreads();
        if (wid == 0) {
#pragma unroll
            for (int w = 1; w < 8; ++w)
#pragma unroll
                for (int bj = 0; bj < 2; ++bj)
#pragma unroll
                    for (int n = 0; n < 2; ++n) a[bj][n] += red[(w * 64 + lane) * 4 + bj * 2 + n];
            E.row_epi(a, fr, pn, wc, fr, fq);
        }
        __syncthreads();
    }
}
template <class Epi, class Sched, bool ALIGN_EPI = false, bool SP2 = false>
__device__ __forceinline__ void gemm_phase(PG8_LAS unsigned char* lds, const Gemm g, const Sched& S, const Epi& E) {
    int tid_ = threadIdx.x; asm volatile("" : "+v"(tid_));
    const int tid = tid_, wid = __builtin_amdgcn_readfirstlane(tid >> 6), lane = tid & 63, wr = wid >> 2, wc = wid & 3, fr = lane & 15, fq = lane >> 4;
    int K_ = g.K; asm volatile("" : "+s"(K_)); const int K = K_, nt = K / BK;
    unsigned voffA[2], voffB[2];
#pragma unroll
    for (int i = 0; i < 2; ++i) { int R, C; stage_rc(tid * 16 + i * 8192, R, C); const int Rb = Epi::PERM ? ((R & ~31) + perm32(R & 31)) : R;
        voffA[i] = (unsigned)(R * K + C) * 2u; voffB[i] = (unsigned)(Rb * K + C) * 2u; }
    const size_t kstep = (size_t)(BK * 2);
    const size_t hstep = (size_t)HALF * K * 2;
    const size_t tstep = 2 * hstep;
    const unsigned ldsw = (unsigned)wid * 1024u;
    const int aoff = lds_byte(wr * 64 + fr, fq * 8), boff = lds_byte(wc * 32 + fr, fq * 8);
#define PG8_SA(b, h) (((b) * 2 + (h)) * HTB)
#define PG8_SB(b, h) ((4 + (b) * 2 + (h)) * HTB)
#define PG8_STAGE(bufoff, gbase, voff) do { _Pragma("unroll") for (int _i = 0; _i < 2; ++_i) \
        __builtin_amdgcn_global_load_lds((const unsigned*)((const char*)(gbase) + (voff)[_i]), (PG8_LAS unsigned*)(lds + (bufoff) + ldsw + _i * 8192), 16, 0, 0); } while (0)
#define PG8_LDA(dst, b, h) do { _Pragma("unroll") for (int m = 0; m < 4; ++m) _Pragma("unroll") for (int k = 0; k < 2; ++k) dst[m][k] = *(const PG8_LAS bf16x8*)(lds + PG8_SA(b, h) + aoff + m * 2048 + k * 1024); } while (0)
#define PG8_LDB(dst, b, h) do { _Pragma("unroll") for (int n = 0; n < 2; ++n) _Pragma("unroll") for (int k = 0; k < 2; ++k) dst[n][k] = *(const PG8_LAS bf16x8*)(lds + PG8_SB(b, h) + boff + n * 2048 + k * 1024); } while (0)
#define PG8_MMA(ai, bj, At, Bt) do { __builtin_amdgcn_s_setprio(1); _Pragma("unroll") for (int m = 0; m < 4; ++m) _Pragma("unroll") for (int n = 0; n < 2; ++n) _Pragma("unroll") for (int k = 0; k < 2; ++k) \
        acc[ai][bj][m][n] = __builtin_amdgcn_mfma_f32_16x16x32_bf16(Bt[n][k], At[m][k], acc[ai][bj][m][n], 0, 0, 0); __builtin_amdgcn_s_setprio(0); } while (0)
#define PG8_WAIT_V(n) asm volatile("s_waitcnt vmcnt(" #n ")" ::: "memory")
#define PG8_WAIT_L(n) asm volatile("s_waitcnt lgkmcnt(" #n ")" ::: "memory")
#define PG8_BAR __builtin_amdgcn_s_barrier()
#define PG8_SCHED __builtin_amdgcn_sched_barrier(0)
    Unit cur, nxt; int ui = 0;
    if (!S.next(0, cur)) return;
    f32x4 acc[2][2][4][2];
#pragma unroll
    for (int a = 0; a < 2; ++a)
#pragma unroll
        for (int b = 0; b < 2; ++b)
#pragma unroll
            for (int m = 0; m < 4; ++m)
#pragma unroll
                for (int n = 0; n < 2; ++n) acc[a][b][m][n] = (f32x4){0.f, 0.f, 0.f, 0.f};
    bf16x8 At[4][2], B0[2][2], B1[2][2];
    const char* cA = (const char*)g.A + (size_t)cur.pm * tstep + (g.apad ? (size_t)((cur.pm >> 4) * 128 + 128) * (size_t)K * 2 : (size_t)0); const char* cB = (const char*)g.Bt + (size_t)cur.pn * tstep;
    S.a_ready(cur);
    if constexpr (SP2) {
        PG8_STAGE(PG8_SB(0, 0), cB, voffB); PG8_STAGE(PG8_SB(0, 1), cB + hstep, voffB); PG8_STAGE(PG8_SA(0, 0), cA, voffA); PG8_STAGE(PG8_SA(0, 1), cA + hstep, voffA);
        if (wr == 1) PG8_BAR;
        PG8_WAIT_V(2); PG8_BAR;
        PG8_STAGE(PG8_SB(1, 0), cB + kstep, voffB); PG8_STAGE(PG8_SA(1, 0), cA + kstep, voffA); PG8_STAGE(PG8_SB(1, 1), cB + hstep + kstep, voffB);
        PG8_WAIT_V(6); PG8_BAR;
    } else {
        PG8_STAGE(PG8_SB(0, 0), cB, voffB); PG8_STAGE(PG8_SA(0, 0), cA, voffA); PG8_STAGE(PG8_SB(0, 1), cB + hstep, voffB); PG8_STAGE(PG8_SA(0, 1), cA + hstep, voffA);
        if (wr == 1) PG8_BAR;
        PG8_WAIT_V(4); PG8_BAR;
        PG8_STAGE(PG8_SB(1, 0), cB + kstep, voffB); PG8_STAGE(PG8_SA(1, 0), cA + kstep, voffA); PG8_STAGE(PG8_SB(1, 1), cB + hstep + kstep, voffB);
        PG8_WAIT_V(6); PG8_BAR;
    }
    for (;;) {
        const bool has_next = S.next(ui + 1, nxt);
        if constexpr (Epi::MIDSCALE) E.prep(cur, wid, wr, lane);
        const char* nA = has_next ? (const char*)g.A + (size_t)nxt.pm * tstep + (g.apad ? (size_t)((nxt.pm >> 4) * 128 + 128) * (size_t)K * 2 : (size_t)0) : cA; const char* nB = has_next ? (const char*)g.Bt + (size_t)nxt.pn * tstep : cB;
        for (int t = 0; t < nt; t += 2) {
            const bool last = (t == nt - 2);
            if constexpr (Epi::MIDSCALE) { if (t == (nt >> 1)) E.mid(acc, cur, wr, wc, fr, fq); }
            const char* a1 = cA + (size_t)(t + 1) * kstep;
            const char* a2 = last ? nA : cA + (size_t)(t + 2) * kstep; const char* b2 = last ? nB : cB + (size_t)(t + 2) * kstep;
            const char* a3 = a2 + kstep; const char* b3 = b2 + kstep;
            if (last && has_next) S.a_ready(nxt);
            if constexpr (SP2) {
            PG8_LDB(B0, 0, 0); PG8_LDB(B1, 0, 1); PG8_SCHED; PG8_LDA(At, 0, 0); PG8_STAGE(PG8_SA(1, 1), a1 + hstep, voffA);
            PG8_WAIT_V(8); PG8_WAIT_L(0); PG8_BAR; PG8_MMA(0, 0, At, B0); PG8_MMA(0, 1, At, B1); PG8_BAR; PG8_SCHED;
            PG8_LDA(At, 0, 1); PG8_STAGE(PG8_SB(0, 0), b2, voffB); PG8_STAGE(PG8_SB(0, 1), b2 + hstep, voffB); PG8_STAGE(PG8_SA(0, 0), a2, voffA);
            PG8_WAIT_V(8); PG8_WAIT_L(0); PG8_BAR; PG8_MMA(1, 0, At, B0); PG8_MMA(1, 1, At, B1); PG8_BAR; PG8_SCHED;
            PG8_LDB(B0, 1, 0); PG8_LDB(B1, 1, 1); PG8_SCHED; PG8_LDA(At, 1, 0); PG8_STAGE(PG8_SA(0, 1), a2 + hstep, voffA);
            PG8_WAIT_V(8); PG8_WAIT_L(0); PG8_BAR; PG8_MMA(0, 0, At, B0); PG8_MMA(0, 1, At, B1); PG8_BAR; PG8_SCHED;
            PG8_LDA(At, 1, 1); PG8_STAGE(PG8_SB(1, 0), b3, voffB); PG8_STAGE(PG8_SB(1, 1), b3 + hstep, voffB); PG8_STAGE(PG8_SA(1, 0), a3, voffA);
            PG8_WAIT_V(8); PG8_WAIT_L(0); PG8_BAR; PG8_MMA(1, 0, At, B0); PG8_MMA(1, 1, At, B1); PG8_BAR; PG8_SCHED;
            } else {
            PG8_LDB(B0, 0, 0); PG8_SCHED; PG8_LDA(At, 0, 0); PG8_STAGE(PG8_SA(1, 1), a1 + hstep, voffA);
            PG8_WAIT_L(8); PG8_BAR; PG8_WAIT_L(0); PG8_MMA(0, 0, At, B0); PG8_BAR; PG8_SCHED;
            PG8_LDB(B1, 0, 1); PG8_STAGE(PG8_SB(0, 0), b2, voffB);
            PG8_BAR; PG8_WAIT_L(0); PG8_MMA(0, 1, At, B1); PG8_BAR;
            PG8_LDA(At, 0, 1); PG8_STAGE(PG8_SA(0, 0), a2, voffA);
            PG8_BAR; PG8_WAIT_L(0); PG8_MMA(1, 0, At, B0); PG8_BAR; PG8_SCHED;
            PG8_STAGE(PG8_SB(0, 1), b2 + hstep, voffB);
            PG8_WAIT_V(6); PG8_BAR; PG8_MMA(1, 1, At, B1); PG8_BAR;
            PG8_LDB(B0, 1, 0); PG8_SCHED; PG8_LDA(At, 1, 0); PG8_STAGE(PG8_SA(0, 1), a2 + hstep, voffA);
            PG8_WAIT_L(8); PG8_BAR; PG8_WAIT_L(0); PG8_MMA(0, 0, At, B0); PG8_BAR; PG8_SCHED;
            PG8_LDB(B1, 1, 1); PG8_STAGE(PG8_SB(1, 0), b3, voffB);
            PG8_BAR; PG8_WAIT_L(0); PG8_MMA(0, 1, At, B1); PG8_BAR;
            PG8_LDA(At, 1, 1); PG8_STAGE(PG8_SA(1, 0), a3, voffA);
            PG8_BAR; PG8_WAIT_L(0); PG8_MMA(1, 0, At, B0); PG8_BAR; PG8_SCHED;
            PG8_STAGE(PG8_SB(1, 1), b3 + hstep, voffB);
            PG8_WAIT_V(6); PG8_BAR; PG8_MMA(1, 1, At, B1); PG8_BAR;
            }
        }
        if constexpr (ALIGN_EPI) { if (wr == 0) PG8_BAR; }
        if constexpr (!Epi::AFTER_DRAIN) { E(acc, cur, wr, wc, fr, fq); S.done(cur); }
        if (!has_next) break;
#pragma unroll
        for (int a = 0; a < 2; ++a)
#pragma unroll
            for (int b = 0; b < 2; ++b)
#pragma unroll
                for (int m = 0; m < 4; ++m)
#pragma unroll
                    for (int n = 0; n < 2; ++n) acc[a][b][m][n] = (f32x4){0.f, 0.f, 0.f, 0.f};
        cur = nxt; cA = nA; cB = nB; ++ui;
        if constexpr (ALIGN_EPI) { if (wr == 1) PG8_BAR; }
    }
    PG8_WAIT_V(0);
    if constexpr (!ALIGN_EPI) { if (wr == 0) PG8_BAR; }
    PG8_BAR;
    if constexpr (Epi::AFTER_DRAIN) { E.fused(acc, cur, wr, wc, fr, fq, lds, wid, lane); S.done(cur); }
#undef PG8_SA
#undef PG8_SB
#undef PG8_STAGE
#undef PG8_LDA
#undef PG8_LDB
#undef PG8_MMA
#undef PG8_WAIT_V
#undef PG8_WAIT_L
#undef PG8_BAR
#undef PG8_SCHED
}
}
namespace att {
#define ALAS __attribute__((address_space(3)))
#define AGAS __attribute__((address_space(1)))
typedef unsigned short bf16_t;
typedef short bf16x8 __attribute__((ext_vector_type(8)));
typedef short s16x4 __attribute__((ext_vector_type(4)));
typedef float f32x16 __attribute__((ext_vector_type(16)));
typedef unsigned u32x4 __attribute__((ext_vector_type(4)));
typedef float f32x2_t __attribute__((ext_vector_type(2))); typedef __bf16 bf16x2_t __attribute__((ext_vector_type(2)));
constexpr int KPMAX = 208, VP = 192, KSZ = 64 * KPMAX, VSZ = 64 * VP;
constexpr int OFF_V = 2 * KSZ, OFF_SCR = OFF_V + 2 * VSZ, OFF_Q = OFF_SCR + 8 * 256, LDS_BYTES = OFF_Q + 64;
constexpr float NEGF = -1e30f, THR = 6.0f;
__device__ __forceinline__ int crow(int r, int hi) { return (r & 3) + 8 * (r >> 2) + 4 * hi; }
__device__ __forceinline__ unsigned cvtpk(float lo, float hi) { f32x2_t v = {lo, hi}; bf16x2_t b = __builtin_convertvector(v, bf16x2_t); return __builtin_bit_cast(unsigned, b); }
__device__ __forceinline__ bf16x8 pack8(const f32x16& p, int s) { u32x4 w; w.x = cvtpk(p[8 * s], p[8 * s + 1]); w.y = cvtpk(p[8 * s + 2], p[8 * s + 3]); w.z = cvtpk(p[8 * s + 4], p[8 * s + 5]); w.w = cvtpk(p[8 * s + 6], p[8 * s + 7]); return __builtin_bit_cast(bf16x8, w); }
typedef short v4i16_t __attribute__((ext_vector_type(4)));
__device__ __forceinline__ float max3f(float a, float b, float c) { float r; asm("v_max3_f32 %0, %1, %2, %3" : "=v"(r) : "v"(a), "v"(b), "v"(c)); return r; }
__device__ __forceinline__ float max2f(float a, float b) { float r; asm("v_max_f32_e32 %0, %1, %2" : "=v"(r) : "v"(a), "v"(b)); return r; }
__device__ __forceinline__ float xhalf_max(float m) { auto rr = __builtin_amdgcn_permlane32_swap(__float_as_uint(m), __float_as_uint(m), false, false); return max2f(__uint_as_float(rr[0]), __uint_as_float(rr[1])); }
__device__ __forceinline__ s16x4 vtr(const ALAS unsigned char* p) { return __builtin_bit_cast(s16x4, __builtin_amdgcn_ds_read_tr16_b64_v4i16((ALAS v4i16_t*)p)); }
__device__ __forceinline__ unsigned short f2bf(float f) { unsigned u = __builtin_bit_cast(unsigned, f); return (unsigned short)((u + 0x7fffu + ((u >> 16) & 1u)) >> 16); }

template <int DQK, bool SWA>
__device__ __forceinline__ void attn_unit(ALAS unsigned char* lds, const bf16_t* Qp, int qpitch, const bf16_t* Kp, int kpitch, const bf16_t* Krp, const bf16_t* Vp, int vpitch,
                                          bf16_t* Op, float* ssq, float sink2, int b, int qb) {
    constexpr int KP = DQK * 2 + 16, NS = DQK / 16;
    int tid_ = threadIdx.x; asm volatile("" : "+v"(tid_));
    const int tid = tid_, lane = tid & 63, wid = __builtin_amdgcn_readfirstlane(tid >> 6), r = lane & 31, h = lane >> 5;
    const size_t rowbase = (size_t)b * TT;
    const int q0 = qb * 256, q0w = q0 + wid * 32;
    const bool wave_valid = q0w < TT;
    const int NT = (q0 + 256) / 64 < TT / 64 ? (q0 + 256) / 64 : TT / 64;
    int t0 = 1; if (SWA) { t0 = (q0 - 128) / 64; if (t0 < 1) t0 = 1; }
    ALAS float* scr = (ALAS float*)(lds + OFF_SCR + wid * 256);
    bf16x8 qf[NS];
    { const int qr = (q0w + r) < TT ? (q0w + r) : TT - 1; const bf16_t* qrow = Qp + (rowbase + qr) * (size_t)qpitch;
#pragma unroll
      for (int s = 0; s < NS; ++s) qf[s] = *(const AGAS bf16x8*)(qrow + 16 * s + 8 * h); }
    const int srow = tid >> 3, sch = tid & 7, rrow = (tid >> 2) & 63, rch = tid & 3;
    u32x4 kregA, vregA, rregA = {0u, 0u, 0u, 0u}, kregB, vregB, rregB = {0u, 0u, 0u, 0u};
#define AT_GLOAD(t, S) do { const size_t kr_ = rowbase + 64 * (t) + srow; kreg##S = *(const AGAS u32x4*)(Kp + kr_ * (size_t)kpitch + sch * 8); vreg##S = *(const AGAS u32x4*)(Vp + kr_ * (size_t)vpitch + sch * 8); \
        if (DQK == 96) { if (tid < 256) rreg##S = *(const AGAS u32x4*)(Krp + (rowbase + 64 * (t) + rrow) * 32 + rch * 8); } } while (0)
#define AT_LSTORE(buf, S) do { *(ALAS u32x4*)(lds + (buf) * KSZ + srow * KP + sch * 16) = kreg##S; *(ALAS u32x4*)(lds + OFF_V + (buf) * VSZ + srow * VP + sch * 16) = vreg##S; \
        if (DQK == 96) { if (tid < 256) *(ALAS u32x4*)(lds + (buf) * KSZ + rrow * KP + 128 + rch * 16) = rreg##S; } } while (0)
    AT_GLOAD(t0, A); AT_LSTORE(0, A);
    if (t0 + 1 < NT) AT_GLOAD(t0 + 1, A);
    __syncthreads();
    float mrun = SWA ? sink2 : 0.0f, lrun = (SWA && h == 0) ? 1.0f : 0.0f;
    bool first_ = !SWA;
    f32x16 negm;
#pragma unroll
    for (int i = 0; i < 16; ++i) negm[i] = -mrun;
    f32x16 o0, o1;
#pragma unroll
    for (int i = 0; i < 16; ++i) { o0[i] = 0.f; o1[i] = 0.f; }
    const int q = q0w + r;
#define AT_PVF(P, j) do { o0 = __builtin_amdgcn_mfma_f32_32x32x16_bf16(P, __builtin_shufflevector(vlo[2 * (j)], vhi[2 * (j)], 0, 1, 2, 3, 4, 5, 6, 7), o0, 0, 0, 0); o1 = __builtin_amdgcn_mfma_f32_32x32x16_bf16(P, __builtin_shufflevector(vlo[2 * (j) + 1], vhi[2 * (j) + 1], 0, 1, 2, 3, 4, 5, 6, 7), o1, 0, 0, 0); } while (0)
#define AT_PV(P, rowoff) do { \
                { const s16x4 lo = vtr(vb_ + (rowoff) * VP), hi = vtr(vb_ + ((rowoff) + 8) * VP); const bf16x8 vf = __builtin_shufflevector(lo, hi, 0, 1, 2, 3, 4, 5, 6, 7); o0 = __builtin_amdgcn_mfma_f32_32x32x16_bf16(P, vf, o0, 0, 0, 0); } \
                { const s16x4 lo = vtr(vb_ + (rowoff) * VP + 64), hi = vtr(vb_ + ((rowoff) + 8) * VP + 64); const bf16x8 vf = __builtin_shufflevector(lo, hi, 0, 1, 2, 3, 4, 5, 6, 7); o1 = __builtin_amdgcn_mfma_f32_32x32x16_bf16(P, vf, o1, 0, 0, 0); } } while (0)
#define AT_STEP(t, LS, SS) do { \
        const int buf = (t - t0) & 1; \
        if (t + 2 < NT) AT_GLOAD(t + 2, LS); \
        const int kfirst = 64 * t; \
        bool active = wave_valid && (kfirst <= q0w + 31); \
        if (SWA) active = active && (kfirst + 63 >= q0w - 127); \
        if (active) { \
            f32x16 s0, s1; \
            const ALAS unsigned char* kb = lds + buf * KSZ + r * KP + h * 16; \
            bf16x8 kf[2 * NS]; \
_Pragma("unroll") \
            for (int s = 0; s < NS; ++s) { kf[2 * s] = *(const ALAS bf16x8*)(kb + s * 32); kf[2 * s + 1] = *(const ALAS bf16x8*)(kb + 32 * KP + s * 32); } \
            __builtin_amdgcn_sched_barrier(0); \
_Pragma("unroll") \
            for (int s = 0; s < NS; ++s) { if (s == 0) { s0 = __builtin_amdgcn_mfma_f32_32x32x16_bf16(kf[0], qf[0], negm, 0, 0, 0); s1 = __builtin_amdgcn_mfma_f32_32x32x16_bf16(kf[1], qf[0], negm, 0, 0, 0); } else { s0 = __builtin_amdgcn_mfma_f32_32x32x16_bf16(kf[2 * s], qf[s], s0, 0, 0, 0); s1 = __builtin_amdgcn_mfma_f32_32x32x16_bf16(kf[2 * s + 1], qf[s], s1, 0, 0, 0); } } \
            __builtin_amdgcn_sched_barrier(0); \
            const ALAS unsigned char* vb_ = lds + OFF_V + buf * VSZ + (4 * h + ((lane & 15) >> 2)) * VP + ((lane >> 4) & 1) * 32 + (lane & 3) * 8; \
            s16x4 vlo[8], vhi[8]; \
_Pragma("unroll") \
            for (int j = 0; j < 4; ++j) { vlo[2 * j] = vtr(vb_ + (16 * j) * VP); vhi[2 * j] = vtr(vb_ + (16 * j + 8) * VP); vlo[2 * j + 1] = vtr(vb_ + (16 * j) * VP + 64); vhi[2 * j + 1] = vtr(vb_ + (16 * j + 8) * VP + 64); } \
            __builtin_amdgcn_sched_barrier(0); \
            const bool need_mask = SWA || (t == 1) || (kfirst + 63 > q0w); \
            if (need_mask) { \
_Pragma("unroll") \
                for (int i = 0; i < 16; ++i) { const int key = kfirst + crow(i, h), key1 = key + 32; \
                    bool ok0 = (key <= q) && (key >= FRONT), ok1 = (key1 <= q) && (key1 >= FRONT); \
                    if (SWA) { ok0 = ok0 && (q - key < 128); ok1 = ok1 && (q - key1 < 128); } \
                    s0[i] = ok0 ? s0[i] : NEGF; s1[i] = ok1 ? s1[i] : NEGF; } \
            } \
            float rm = max3f(s0[0], s0[1], s1[0]), rm2 = max3f(s0[2], s0[3], s1[1]); rm = max3f(rm, s1[2], s1[3]); \
_Pragma("unroll") \
            for (int i = 4; i < 16; i += 4) { rm = max3f(rm, s0[i], s0[i + 1]); rm2 = max3f(rm2, s0[i + 2], s0[i + 3]); rm = max3f(rm, s1[i], s1[i + 1]); rm2 = max3f(rm2, s1[i + 2], s1[i + 3]); } \
            rm = xhalf_max(max2f(rm, rm2)); \
            if (first_ || __any(rm > THR)) { \
                const float dl = first_ ? (rm > -1e29f ? rm : 0.f) : max2f(rm, 0.f); first_ = false; \
                mrun += dl; const float f = __builtin_amdgcn_exp2f(-dl); lrun *= f; \
_Pragma("unroll") \
                for (int i = 0; i < 16; ++i) { s0[i] -= dl; s1[i] -= dl; negm[i] = -mrun; } \
                if (h == 0) scr[r] = f; \
_Pragma("unroll") \
                for (int i = 0; i < 16; ++i) { const float fi = scr[crow(i, h)]; o0[i] *= fi; o1[i] *= fi; } \
            } \
            float ls = 0.f; \
_Pragma("unroll") \
            for (int i = 0; i < 16; ++i) { s0[i] = __builtin_amdgcn_exp2f(s0[i]); s1[i] = __builtin_amdgcn_exp2f(s1[i]); ls += s0[i] + s1[i]; } \
            lrun += ls; \
            const bf16x8 p0 = pack8(s0, 0), p1 = pack8(s0, 1), p2 = pack8(s1, 0), p3 = pack8(s1, 1); \
            __builtin_amdgcn_sched_barrier(0); \
            AT_PVF(p0, 0); AT_PVF(p1, 1); AT_PVF(p2, 2); AT_PVF(p3, 3); \
        } \
        if (t + 1 < NT) AT_LSTORE(buf ^ 1, SS); \
        __syncthreads(); \
    } while (0)
    {
        int t = t0;
        for (; t + 1 < NT; t += 2) { AT_STEP(t, B, A); const int t1 = t + 1; AT_STEP(t1, A, B); }
        if (t < NT) AT_STEP(t, B, A);
    }
#undef AT_STEP
#undef AT_PV
#undef AT_GLOAD
#undef AT_LSTORE
    if (wave_valid) {
        const float lt = lrun + __shfl_xor(lrun, 32);
        if (h == 0) scr[32 + r] = lt;
        ALAS bf16_t* stg = (ALAS bf16_t*)(lds + wid * 4096);
#pragma unroll
        for (int i = 0; i < 16; ++i) {
            const float li = scr[32 + crow(i, h)], inv = li > 0.f ? 1.0f / li : 0.f;
            const int orow = crow(i, h);
            stg[orow * 64 + r] = f2bf(o0[i] * inv); stg[orow * 64 + 32 + r] = f2bf(o1[i] * inv);
        }
#pragma unroll
        for (int i = 0; i < 4; ++i) {
            const int lrow = i * 8 + (lane >> 3), ch = lane & 7; const u32x4 v = *(const ALAS u32x4*)(stg + lrow * 64 + ch * 8);
            const size_t row = rowbase + q0w + lrow;
            *(AGAS u32x4*)(Op + row * 1024 + ch * 8) = v;
            float ss = 0.f;
#pragma unroll
            for (int j = 0; j < 4; ++j) { const unsigned w = v[j]; const float lo = __builtin_bit_cast(float, w << 16), hi = __builtin_bit_cast(float, w & 0xffff0000u); ss += lo * lo + hi * hi; }
            ss += __shfl_xor(ss, 1); ss += __shfl_xor(ss, 2); ss += __shfl_xor(ss, 4);
            if (ch == 0) ((AGAS float*)ssq)[row * 16] = ss;
        }
    }
    __syncthreads();
}
}
typedef unsigned short bf16;
#define LAS __attribute__((address_space(3)))
#define GAS __attribute__((address_space(1)))
constexpr size_t MiB = 1u << 20;
constexpr int NWAVES = 8, NTHREADS = 512;
constexpr int LDS_BYTES = 147456;
static_assert(att::LDS_BYTES <= 131072, "attention LDS");
constexpr size_t WS_CTL = 0, CTL_BYTES = 65536;
constexpr size_t WS_H = 1 * MiB;
constexpr size_t WS_HB = WS_H + (size_t)MROWS * DM * 4;
constexpr size_t WS_W = WS_HB + (size_t)MROWS * DM * 2;
constexpr size_t WL_IN = 0, WL_Q = WL_IN + (size_t)INP * DM * 2, WL_KV = WL_Q + (size_t)768 * 256 * 2, WL_O = WL_KV + (size_t)1024 * 128 * 2,
                 WL_GU = WL_O + (size_t)DM * DM * 2, WL_D = WL_GU + (size_t)GUP * DM * 2, WL_END = WL_D + (size_t)DM * DFF * 2;
constexpr size_t WBUF = 22 * MiB;
static_assert(WL_END <= WBUF, "weight buffer");
constexpr size_t WS_PART = WS_W + 2 * WBUF;
constexpr size_t P_HSSA = 0, P_HSSB = P_HSSA + (size_t)MROWS * 64, P_SSQO = P_HSSB + (size_t)MROWS * 64, P_SSQQ = P_SSQO + (size_t)MROWS * 64, P_SSQKV = P_SSQQ + (size_t)MROWS * 16, P_END = P_SSQKV + (size_t)MROWS * 16;
constexpr size_t PM_H = (P_END + 255) & ~(size_t)255, PM_HB = PM_H + 16 * DM * 4, PM_HSSA = PM_HB + 16 * DM * 2, PM_HSSB = PM_HSSA + 1024, PM_SSQQ = PM_HSSB + 1024, PM_SSQKV = PM_SSQQ + 256,
                 PM_QLAT = PM_SSQKV + 256, PM_KVLAT = PM_QLAT + 16 * 256 * 2, PM_ACT = PM_KVLAT + 16 * 128 * 2, PM_END = PM_ACT + 16 * DFF * 2;
static_assert(PM_END <= 8 * MiB, "partials");
constexpr int MC = BATCH * SEQ;
constexpr size_t WS_R = WS_PART + 8 * MiB;
constexpr size_t R_QA = 0, R_KA = R_QA + (size_t)MROWS * 512 * 2, R_VA = R_KA + (size_t)MROWS * 128 * 2, R_QLAT = R_VA + (size_t)MROWS * 128 * 2, R_KVLAT = R_QLAT + (size_t)MROWS * 256 * 2,
                 R_KR = R_KVLAT + (size_t)MROWS * 128 * 2, R_QM = R_KR + (size_t)MROWS * 32 * 2, R_KN = R_QM + (size_t)MROWS * 768 * 2, R_VB = R_KN + (size_t)MROWS * 512 * 2,
                 R_O = R_VB + (size_t)MROWS * 512 * 2, R_END = R_O + (size_t)MROWS * 1024 * 2;
constexpr size_t R_ACT = 0;
static_assert((size_t)MROWS * DFF * 2 <= R_END, "act overlay");
constexpr size_t WS_END = WS_R + R_END;
static_assert(WS_END <= 512 * MiB, "workspace must fit 512 MiB");

struct Args {
    const float *x, *meta, *attn_norm, *w_in, *q_norm, *w_q_up, *kv_norm, *w_kv_up, *sinks, *out_norm_swa, *out_norm_mla, *w_o, *ffn_norm, *w_gate, *w_up, *w_down, *final_norm;
    float* out; unsigned char* ws; int ph_lo, ph_hi;
};

__device__ __forceinline__ unsigned f2bf_u(float f) { unsigned u = __builtin_bit_cast(unsigned, f); return (u + 0x7fffu + ((u >> 16) & 1u)) >> 16; }
__device__ __forceinline__ unsigned pk2(float lo, float hi) { return f2bf_u(lo) | (f2bf_u(hi) << 16); }
__device__ __forceinline__ float wave_sum(float v) {
#pragma unroll
    for (int o = 1; o < 64; o <<= 1) v += __shfl_xor(v, o);
    return v;
}

__device__ __forceinline__ int src_in(int np) { const int pn = np >> 8, bj = (np >> 7) & 1, o = np & 127;
    if (pn < 2) return (4 * pn + (o >> 5)) * 64 + (o & 31) + 32 * bj;
    if (pn == 2) { if (o < 64) return 512 + (o >> 5) * 64 + (o & 31) + 32 * bj; if (o < 80) return 1152 + (o - 64) + 16 * bj; return -1; }
    if (pn == 3) return bj ? 1024 + o : 640 + o;
    return 768 + 128 * bj + o; }
__device__ __forceinline__ int src_qup(int np) { const int pn = np >> 8, op = np & 255;
    if (pn < 2) return (4 * pn + (op >> 6)) * 96 + (op & 63);
    const int bj = op >> 7, o = op & 127; return (o >> 4) * 96 + 64 + (o & 15) + 16 * bj; }
__device__ __forceinline__ int src_kvup(int np) { const int pn = np >> 8, op = np & 255; return (4 * (pn & 1) + (op >> 6)) * 128 + (pn >= 2 ? 64 : 0) + (op & 63); }

template <int MODE>
__device__ __forceinline__ void conv_item(const float* W, const float* W2, const float* gain, const float* gain2, int K, int Nsrc, bf16* WT, LAS float* scr, int item, int nblk, int lane) {
    const int kb = item / nblk, nb = item % nblk, k0 = 64 * kb, n0 = 32 * nb;
    const int np = n0 + (lane & 31);
    int src; float cs = 1.0f; const float* Wp = W;
    if (MODE == 0) { src = src_in(np); if (np < 512) cs = 0.125f * LOG2E; }
    else if (MODE == 1) { src = src_qup(np); cs = 0.10206207261596577f * LOG2E; }
    else if (MODE == 2) src = src_kvup(np);
    else if (MODE == 4) { src = 128 * (np >> 8) + (np & 127); if ((np >> 7) & 1) Wp = W2; }
    else src = np;
#pragma unroll 8
    for (int i = 0; i < 32; ++i) { const int kk = 2 * i + (lane >> 5), k = k0 + kk;
        float g = 1.0f; if (MODE == 3) g = (k < 512) ? ((const GAS float*)gain)[k] : ((const GAS float*)gain2)[k - 512]; else if (MODE != 5) g = ((const GAS float*)gain)[k];
        scr[kk * 33 + (lane & 31)] = (src >= 0) ? ((const GAS float*)Wp)[(size_t)k * Nsrc + src] * g * cs : 0.0f; }
    asm volatile("s_waitcnt lgkmcnt(0)" ::: "memory");
    const int c = lane & 7;
#pragma unroll
    for (int j = 0; j < 4; ++j) { const int n = (lane >> 3) + 8 * j; const LAS float* s = scr + (8 * c) * 33 + n;
        pg8::u32x4 o; o.x = pk2(s[0 * 33], s[1 * 33]); o.y = pk2(s[2 * 33], s[3 * 33]); o.z = pk2(s[4 * 33], s[5 * 33]); o.w = pk2(s[6 * 33], s[7 * 33]);
        *(GAS pg8::u32x4*)(WT + (size_t)(n0 + n) * K + k0 + 8 * c) = o; }
    asm volatile("s_waitcnt lgkmcnt(0)" ::: "memory");
}
__device__ __forceinline__ void conv_layer(const Args& a, int l, unsigned char* wbuf, LAS unsigned char* lds) {
    int tid_ = threadIdx.x; asm volatile("" : "+v"(tid_));
    const int lane = tid_ & 63, wave = tid_ >> 6;
    LAS float* scr = (LAS float*)(lds + wave * 16384);
    const int gw = blockIdx.x * NWAVES + wave, NGW = gridDim.x * NWAVES;
    constexpr int I0 = (DM / 64) * (INP / 32), I1 = (256 / 64) * (768 / 32), I2 = (128 / 64) * (1024 / 32), I3 = (DM / 64) * (DM / 32), I4 = (DM / 64) * (GUP / 32), I5 = (DFF / 64) * (DM / 32);
    constexpr int NIT = I0 + I1 + I2 + I3 + I4 + I5;
    for (int it = gw; it < NIT; it += NGW) {
        int r = it;
        if (r < I0) { conv_item<0>(a.w_in + (size_t)l * DM * INW, nullptr, a.attn_norm + l * DM, nullptr, DM, INW, (bf16*)(wbuf + WL_IN), scr, r, INP / 32, lane); continue; } r -= I0;
        if (r < I1) { conv_item<1>(a.w_q_up + (size_t)l * 256 * 768, nullptr, a.q_norm + l * 256, nullptr, 256, 768, (bf16*)(wbuf + WL_Q), scr, r, 768 / 32, lane); continue; } r -= I1;
        if (r < I2) { conv_item<2>(a.w_kv_up + (size_t)l * 128 * 1024, nullptr, a.kv_norm + l * 128, nullptr, 128, 1024, (bf16*)(wbuf + WL_KV), scr, r, 1024 / 32, lane); continue; } r -= I2;
        if (r < I3) { conv_item<3>(a.w_o + (size_t)l * DM * DM, nullptr, a.out_norm_swa + l * 512, a.out_norm_mla + l * 512, DM, DM, (bf16*)(wbuf + WL_O), scr, r, DM / 32, lane); continue; } r -= I3;
        if (r < I4) { conv_item<4>(a.w_gate + (size_t)l * DM * DFF, a.w_up + (size_t)l * DM * DFF, a.ffn_norm + l * DM, nullptr, DM, DFF, (bf16*)(wbuf + WL_GU), scr, r, GUP / 32, lane); continue; } r -= I4;
        conv_item<5>(a.w_down + (size_t)l * DFF * DM, nullptr, nullptr, nullptr, DFF, DM, (bf16*)(wbuf + WL_D), scr, r, DM / 32, lane);
    }
}

__device__ __forceinline__ void init_rows(const Args& a, unsigned char* ws) {
    const int lane = threadIdx.x & 63, wave = threadIdx.x >> 6; const int gw = blockIdx.x * NWAVES + wave, NGW = gridDim.x * NWAVES;
    for (int row = gw; row < MC + NMETA; row += NGW) {
        const bool meta = row >= MC; const int r = meta ? row - MC : row;
        const float* src = meta ? a.meta + (size_t)r * DM : a.x + (size_t)r * DM;
        float* H = (float*)(ws + (meta ? WS_PART + PM_H : WS_H)); bf16* HB = (bf16*)(ws + (meta ? WS_PART + PM_HB : WS_HB)); float* hss = (float*)(ws + WS_PART + (meta ? PM_HSSA : P_HSSA));
        pg8::f32x4 v[4]; float s = 0.f;
#pragma unroll
        for (int j = 0; j < 4; ++j) { v[j] = *((const GAS pg8::f32x4*)src + lane + 64 * j); s += pg8::sq4(v[j]); }
        s = wave_sum(s);
#pragma unroll
        for (int j = 0; j < 4; ++j) { pg8::st_bf16x4(HB + (size_t)r * DM + 4 * (lane + 64 * j), v[j]); }
        if (lane < 16) ((GAS float*)hss)[(size_t)r * 16 + lane] = (lane == 0) ? s : 0.f;
    }
}
__device__ __forceinline__ void final_rows(const Args& a, const bf16* HBf, const float* hss) {
    const int lane = threadIdx.x & 63, wave = threadIdx.x >> 6; const int gw = blockIdx.x * NWAVES + wave, NGW = gridDim.x * NWAVES;
    for (int o = gw; o < BATCH * SEQ; o += NGW) {
        const int row = o;
        const float rs = pg8::rsq(pg8::sum16(hss, row) * (1.0f / DM) + RMS_EPS);
#pragma unroll
        for (int j = 0; j < 4; ++j) { const pg8::u32x2 hw = *((const GAS pg8::u32x2*)(HBf + (size_t)row * DM) + lane + 64 * j); pg8::f32x4 v; v[0] = __builtin_bit_cast(float, hw.x << 16); v[1] = __builtin_bit_cast(float, hw.x & 0xffff0000u); v[2] = __builtin_bit_cast(float, hw.y << 16); v[3] = __builtin_bit_cast(float, hw.y & 0xffff0000u);
            const pg8::f32x4 g = *((const GAS pg8::f32x4*)a.final_norm + lane + 64 * j);
            *((GAS pg8::f32x4*)(a.out + (size_t)o * DM) + lane + 64 * j) = v * rs * g; }
    }
}

constexpr int N_ATT_UNITS = 2 * 17 * 64;
__device__ __forceinline__ void attn_phase(const Args& a, int l, unsigned char* ws, LAS unsigned char* lds, int mode = 0) {
    const int lq = l; l &= 3;
    unsigned char* R = ws + WS_R;
    const bf16 *QA = (const bf16*)(R + R_QA), *KA = (const bf16*)(R + R_KA), *VA = (const bf16*)(R + R_VA), *KR = (const bf16*)(R + R_KR), *QM = (const bf16*)(R + R_QM), *KN = (const bf16*)(R + R_KN), *VB = (const bf16*)(R + R_VB);
    bf16* O = (bf16*)(R + R_O); float* ssqO = (float*)(ws + WS_PART + P_SSQO);
    LAS int* qslot = (LAS int*)(lds + att::OFF_Q);
    const unsigned xcc = ((unsigned)__builtin_amdgcn_s_getreg((3 << 11) | 20) & 0xFu) & 7u;
    unsigned* ctr = (unsigned*)(ws + WS_CTL) + 64 * lq + 8 * 64 * (int)xcc;
    constexpr int PER_X = N_ATT_UNITS / 8;
    for (int pass = 0; pass < 8; ++pass) {
        const unsigned x = (xcc + (unsigned)pass) & 7u; unsigned* c = (unsigned*)(ws + WS_CTL) + 64 * lq + 8 * 64 * (int)x;
        for (;;) {
            if (threadIdx.x == 0) *qslot = (int)atomicAdd(c, 1u);
            __syncthreads();
            const int u = *qslot;
            __syncthreads();
            if (u >= (mode == 1 ? PER_X / 2 : PER_X)) break;
            if (u < PER_X / 2) {
                const int bh = 8 * (u / 17) + (int)x, qb = 16 - u % 17, b = bh >> 3, hd = bh & 7;
                att::attn_unit<96, false>(lds, QM + hd * 96, 768, KN + hd * 64, 512, KR, VB + hd * 64, 512, O + 512 + hd * 64, ssqO + 8 + hd, 0.f, b, qb);
            } else {
                const int v = u - PER_X / 2; const int bh = 8 * (v / 17) + (int)x, qb = 16 - v % 17, b = bh >> 3, hq = bh & 7, kv = hq >> 2;
                att::attn_unit<64, true>(lds, QA + hq * 64, 512, KA + kv * 64, 128, nullptr, VA + kv * 64, 128, O + hq * 64, ssqO + hq, a.sinks[l * 8 + hq] * LOG2E, b, qb);
            }
        }
    }
    (void)ctr;
}

#define XB_TMO      128
#define XB_XCNT(j)  (256  + 64 * (j))
#define XB_XSUB(j)  (1280 + 64 * (j))
#define XB_XGEN(j)  (2304 + 64 * (j))
#define XB_TOP      3328
#define XB_TOPGEN   3392
#define XCD_BAR_WORDS 3456
#define XB_SPIN_CAP (1u << 18)

__device__ __forceinline__ unsigned xb_ld(unsigned* p)              { return __hip_atomic_load(p, __ATOMIC_RELAXED, __HIP_MEMORY_SCOPE_AGENT); }
__device__ __forceinline__ unsigned xb_add(unsigned* p, unsigned v) { return __hip_atomic_fetch_add(p, v, __ATOMIC_RELAXED, __HIP_MEMORY_SCOPE_AGENT); }
__device__ __forceinline__ unsigned xb_xcc_id() { return (unsigned)__builtin_amdgcn_s_getreg((3 << 11) | 20) & 0xFu; }
#define XB_SPIN(cond, bar) do { unsigned _sp = 0; while (cond) { __builtin_amdgcn_s_sleep(1); \
    if ((++_sp & 255u) == 0u) { if (xb_ld(&(bar)[XB_TMO])) break; if (_sp > XB_SPIN_CAP) { atomicAdd(&(bar)[XB_TMO], 1u); break; } } } } while (0)

struct XcdBarrier {
    unsigned* bar; unsigned x;
    volatile LAS unsigned* st;
};

__device__ __forceinline__ XcdBarrier xcd_barrier_post(unsigned* bar, volatile LAS unsigned* st) {
    XcdBarrier b; b.bar = bar; b.x = xb_xcc_id(); b.st = st;
    if (threadIdx.x == 0) (void)xb_add(&bar[XB_XCNT(b.x)], 1u);
    return b;
}
__device__ __forceinline__ void xcd_barrier_complete(unsigned* bar, unsigned x, unsigned& nloc, unsigned& nx) {
    const unsigned G = gridDim.x * gridDim.y * gridDim.z;
    unsigned sum, cnt, mine, sp = 0u;
    for (;;) {
        sum = 0u; cnt = 0u; mine = 0u;
#pragma unroll
        for (unsigned j = 0; j < 16; ++j) { const unsigned c = xb_ld(&bar[XB_XCNT(j)]); sum += c; cnt += (c > 0u) ? 1u : 0u; mine = (j == x) ? c : mine; }
        if (sum == G) break;
        __builtin_amdgcn_s_sleep(1);
        if ((++sp & 255u) == 0u) { if (xb_ld(&bar[XB_TMO])) break; if (sp > XB_SPIN_CAP) { atomicAdd(&bar[XB_TMO], 1u); break; } }
    }
    nloc = mine > 0u ? mine : 1u; nx = cnt > 0u ? cnt : 1u;
}

__device__ __forceinline__ void xcd_barrier(const XcdBarrier& b) {
    asm volatile("s_waitcnt vmcnt(0)" ::: "memory");
    __syncthreads();
    if (threadIdx.x == 0) {
        unsigned* bar = b.bar;
        __builtin_amdgcn_s_waitcnt(0);
        unsigned nloc = b.st[0], nx = b.st[1];
        if (nloc == 0u) { xcd_barrier_complete(bar, b.x, nloc, nx); b.st[0] = nloc; b.st[1] = nx; }
        const unsigned old = xb_add(&bar[XB_XSUB(b.x)], 1u);
        const unsigned gen = old / nloc;
        if (old + 1u == (gen + 1u) * nloc) {
            __builtin_amdgcn_fence(__ATOMIC_RELEASE, "agent");
            asm volatile("s_waitcnt vmcnt(0)" ::: "memory");
            const unsigned og = xb_add(&bar[XB_TOP], 1u);
            const unsigned tg = og / nx;
            if (og + 1u == (tg + 1u) * nx) xb_add(&bar[XB_TOPGEN], 1u);
            else XB_SPIN(xb_ld(&bar[XB_TOPGEN]) == tg, bar);
            __builtin_amdgcn_fence(__ATOMIC_ACQUIRE, "agent");
            xb_add(&bar[XB_XGEN(b.x)], 1u);
            asm volatile("s_waitcnt vmcnt(0)" ::: "memory");
        } else {
            XB_SPIN(xb_ld(&bar[XB_XGEN(b.x)]) == gen, bar);
            __builtin_amdgcn_fence(__ATOMIC_ACQUIRE, "agent");
            asm volatile("s_waitcnt vmcnt(0)" ::: "memory");
        }
    }
    __syncthreads();
}

constexpr int CW_BAR = 4096;
constexpr int XB_LDS_OFF = 131072 + 8192;
#ifndef PHM
#define PHM 255
#endif
#ifndef PROBE_DUP
#define PROBE_DUP 0
#endif
#ifndef PROBE_SYNC
#define PROBE_SYNC 0
#endif
__global__ void __launch_bounds__(NTHREADS, 2) fwd_megakernel(Args a) {
    extern __shared__ __attribute__((aligned(16))) unsigned char lds_raw[];
    LAS unsigned char* lds = (LAS unsigned char*)lds_raw;
    cg::grid_group grid = cg::this_grid();
    const int lo = a.ph_lo, hi = a.ph_hi;
    if (threadIdx.x < 2) ((LAS unsigned*)(lds + XB_LDS_OFF))[threadIdx.x] = 0u;
    __syncthreads();
    if (a.ph_hi < 0) grid.sync();
    const XcdBarrier xbar = xcd_barrier_post((unsigned*)(a.ws + WS_CTL) + CW_BAR, (volatile LAS unsigned*)(lds + XB_LDS_OFF));
#define IN_PH(k) (lo <= (k) && (k) < hi)
#define SEAM(k) do { if (IN_PH(k) && IN_PH((k) + 1)) { xcd_barrier(xbar); if (PROBE_SYNC) xcd_barrier(xbar); } } while (0)
#define WSL(w) unsigned char* w = a.ws; asm volatile("" : "+s"(w))
    if (IN_PH(0) && (PHM & 1)) { WSL(ws); init_rows(a, ws); conv_layer(a, 0, ws + WS_W, lds); __syncthreads(); }
    SEAM(0);
#pragma unroll 1
    for (int l = 0; l < DEPTH; ++l) {
        const int p = 1 + 6 * l;
        if (IN_PH(p) && (PHM & 2)) {
            { WSL(ws); unsigned char* R = ws + WS_R; unsigned char* wb = ws + WS_W + (size_t)(l & 1) * WBUF; unsigned char* pm_ = ws + WS_PART;
              pg8::EpiIn<true> E{(const float*)(pm_ + PM_HSSA), (bf16*)(R + R_QA), (bf16*)(R + R_KA), (bf16*)(R + R_VA), (bf16*)(pm_ + PM_QLAT), (bf16*)(pm_ + PM_KVLAT), (bf16*)(R + R_KR), (float*)(pm_ + PM_SSQQ), (float*)(pm_ + PM_SSQKV)};
              pg8::skinny_phase<DM>(lds, (const bf16*)(pm_ + PM_HB), (const bf16*)(wb + WL_IN), INP / 256, E, 128); }
            WSL(ws); unsigned char* R = ws + WS_R; unsigned char* wb = ws + WS_W + (size_t)(l & 1) * WBUF;
            pg8::Gemm g{(const bf16*)(ws + WS_HB), (const bf16*)(wb + WL_IN), MC, INP, DM, 0}; pg8::OrderCT<MC / 256, INP / 256> S; S.init((int)gridDim.x, (int)blockIdx.x);
            pg8::EpiIn<false> E{(const float*)(ws + WS_PART + P_HSSA), (bf16*)(R + R_QA), (bf16*)(R + R_KA), (bf16*)(R + R_VA), (bf16*)(R + R_QLAT), (bf16*)(R + R_KVLAT), (bf16*)(R + R_KR),
                         (float*)(ws + WS_PART + P_SSQQ), (float*)(ws + WS_PART + P_SSQKV)};
            pg8::gemm_phase<pg8::EpiIn<false>, pg8::OrderCT<MC / 256, INP / 256>, true, true>(lds, g, S, E);
            if (PROBE_DUP & 2) pg8::gemm_phase<pg8::EpiIn<false>, pg8::OrderCT<MC / 256, INP / 256>, true, true>(lds, g, S, E);
        }
        SEAM(p);
        if (IN_PH(p + 1) && (PHM & 4)) {
            { WSL(ws); unsigned char* R = ws + WS_R; unsigned char* wb = ws + WS_W + (size_t)(l & 1) * WBUF; unsigned char* pm_ = ws + WS_PART;
              pg8::EpiQup<true> E{(const float*)(pm_ + PM_SSQQ), (bf16*)(R + R_QM)}; pg8::skinny_phase<256>(lds, (const bf16*)(pm_ + PM_QLAT), (const bf16*)(wb + WL_Q), 3, E, 128); }
            { WSL(ws); unsigned char* R = ws + WS_R; unsigned char* wb = ws + WS_W + (size_t)(l & 1) * WBUF;
              pg8::Gemm g{(const bf16*)(R + R_QLAT), (const bf16*)(wb + WL_Q), MC, 768, 256, 0}; pg8::OrderCT<MC / 256, 3> S; S.init((int)gridDim.x, (int)blockIdx.x);
              pg8::EpiQup<false> E{(const float*)(ws + WS_PART + P_SSQQ), (bf16*)(R + R_QM)}; pg8::gemm_phase<pg8::EpiQup<false>, pg8::OrderCT<MC / 256, 3>, true, true>(lds, g, S, E); if (PROBE_DUP & 4) pg8::gemm_phase<pg8::EpiQup<false>, pg8::OrderCT<MC / 256, 3>, true, true>(lds, g, S, E); }
            { WSL(ws); unsigned char* R = ws + WS_R; unsigned char* wb = ws + WS_W + (size_t)(l & 1) * WBUF; unsigned char* pm_ = ws + WS_PART;
              pg8::EpiKvup<true> E{(const float*)(pm_ + PM_SSQKV), (bf16*)(R + R_KN), (bf16*)(R + R_VB)}; pg8::skinny_phase<128>(lds, (const bf16*)(pm_ + PM_KVLAT), (const bf16*)(wb + WL_KV), 4, E, 0); }
            { WSL(ws); unsigned char* R = ws + WS_R; unsigned char* wb = ws + WS_W + (size_t)(l & 1) * WBUF;
              pg8::Gemm g{(const bf16*)(R + R_KVLAT), (const bf16*)(wb + WL_KV), MC, 1024, 128, 0}; pg8::OrderCT<MC / 256, 4> S; S.init((int)gridDim.x, (int)blockIdx.x);
              pg8::EpiKvup<false> E{(const float*)(ws + WS_PART + P_SSQKV), (bf16*)(R + R_KN), (bf16*)(R + R_VB)}; pg8::gemm_phase<pg8::EpiKvup<false>, pg8::OrderCT<MC / 256, 4>, true, true>(lds, g, S, E); if (PROBE_DUP & 4) pg8::gemm_phase<pg8::EpiKvup<false>, pg8::OrderCT<MC / 256, 4>, true, true>(lds, g, S, E); }
        }
        SEAM(p + 1);
        if (IN_PH(p + 2) && (PHM & 8)) { WSL(ws); if (l + 1 < DEPTH) { conv_layer(a, l + 1, ws + WS_W + (size_t)((l + 1) & 1) * WBUF, lds); __syncthreads(); if (PROBE_DUP & 256) { conv_layer(a, l + 1, ws + WS_W + (size_t)((l + 1) & 1) * WBUF, lds); __syncthreads(); } } attn_phase(a, l, ws, lds); if (PROBE_DUP & 8) attn_phase(a, l + 4, ws, lds); if (PROBE_DUP & 1024) attn_phase(a, l + 4, ws, lds, 1); }
        SEAM(p + 2);
        if (IN_PH(p + 3) && (PHM & 16)) {
            { WSL(ws); unsigned char* R = ws + WS_R; unsigned char* wb = ws + WS_W + (size_t)(l & 1) * WBUF; unsigned char* pm_ = ws + WS_PART;
              pg8::EpiOut<true> E; E.H = (float*)(pm_ + PM_H); E.HB = (bf16*)(pm_ + PM_HB); E.hss_out = (float*)(pm_ + PM_HSSB); E.ssq_o = (const float*)(pm_ + P_SSQO); E.xlds = lds;
              pg8::skinny_phase<DM>(lds, (const bf16*)(R + R_O) + (size_t)FRONT * 1024, (const bf16*)(wb + WL_O), 4, E, 0); }
            WSL(ws); unsigned char* R = ws + WS_R; unsigned char* wb = ws + WS_W + (size_t)(l & 1) * WBUF;
            pg8::Gemm g{(const bf16*)(R + R_O), (const bf16*)(wb + WL_O), MC, DM, DM, 1}; pg8::OrderCT<MC / 256, 4> S; S.init((int)gridDim.x, (int)blockIdx.x);
            pg8::EpiOut<false> E; E.H = (float*)(ws + WS_H); E.HB = (bf16*)(ws + WS_HB); E.hss_out = (float*)(ws + WS_PART + P_HSSB); E.ssq_o = (const float*)(ws + WS_PART + P_SSQO); E.xlds = lds + pg8::STAGE_BYTES;
            pg8::gemm_phase<pg8::EpiOut<false>, pg8::OrderCT<MC / 256, 4>, true, true>(lds, g, S, E);
        }
        SEAM(p + 3);
        if (IN_PH(p + 4) && (PHM & 32)) {
            { WSL(ws); unsigned char* wb = ws + WS_W + (size_t)(l & 1) * WBUF; unsigned char* pm_ = ws + WS_PART;
              pg8::EpiGU<true> E{(const float*)(pm_ + PM_HSSB), (bf16*)(pm_ + PM_ACT)}; pg8::skinny_phase<DM>(lds, (const bf16*)(pm_ + PM_HB), (const bf16*)(wb + WL_GU), GUP / 256, E, 0); }
            WSL(ws); unsigned char* R = ws + WS_R; unsigned char* wb = ws + WS_W + (size_t)(l & 1) * WBUF;
            pg8::Gemm g{(const bf16*)(ws + WS_HB), (const bf16*)(wb + WL_GU), MC, GUP, DM, 0}; pg8::OrderCT<MC / 256, GUP / 256> S; S.init((int)gridDim.x, (int)blockIdx.x);
            pg8::EpiGU<false> E{(const float*)(ws + WS_PART + P_HSSB), (bf16*)(R + R_ACT)};
            pg8::gemm_phase<pg8::EpiGU<false>, pg8::OrderCT<MC / 256, GUP / 256>, true, true>(lds, g, S, E);
        }
        SEAM(p + 4);
        if (IN_PH(p + 5) && (PHM & 64)) {
            { WSL(ws); unsigned char* wb = ws + WS_W + (size_t)(l & 1) * WBUF; unsigned char* pm_ = ws + WS_PART;
              pg8::EpiDown<true> E; E.H = (float*)(pm_ + PM_H); E.HB = (bf16*)(pm_ + PM_HB); E.hss_out = (float*)(pm_ + PM_HSSA); E.ssq_o = nullptr;
              pg8::skinny_phase<DFF>(lds, (const bf16*)(pm_ + PM_ACT), (const bf16*)(wb + WL_D), 4, E, 0); }
            WSL(ws); unsigned char* R = ws + WS_R; unsigned char* wb = ws + WS_W + (size_t)(l & 1) * WBUF;
            pg8::Gemm g{(const bf16*)(R + R_ACT), (const bf16*)(wb + WL_D), MC, DM, DFF, 0}; pg8::OrderCT<MC / 256, 4> S; S.init((int)gridDim.x, (int)blockIdx.x);
            pg8::EpiDown<false> E; E.H = (float*)(ws + WS_H); E.HB = (bf16*)(ws + WS_HB); E.hss_out = (float*)(ws + WS_PART + P_HSSA); E.ssq_o = nullptr;
            pg8::gemm_phase<pg8::EpiDown<false>, pg8::OrderCT<MC / 256, 4>, true, true>(lds, g, S, E);
        }
        SEAM(p + 5);
    }
    if (IN_PH(1 + 6 * DEPTH) && (PHM & 128)) { WSL(ws); final_rows(a, (const bf16*)(ws + WS_HB), (const float*)(ws + WS_PART + P_HSSA)); }
#undef IN_PH
#undef SEAM
#undef WSL
}
constexpr int N_PHASES = 2 + 6 * DEPTH;

#ifndef MK_SPLIT
#define MK_SPLIT 0
#endif
extern "C" void kernel_launch(void* const* d_in, const int* in_sizes, int n_in, void* d_out, int out_size, void* d_ws, size_t ws_size, hipStream_t stream) {
    static int grid = 0;
    if (grid == 0) {
        if (n_in != 17 || ws_size < WS_END) { fprintf(stderr, "kernel_launch: need 17 inputs and >= %zu bytes of workspace; got n_in %d, ws %zu\n", (size_t)WS_END, n_in, ws_size); grid = -1; return; }
        int dev = 0, cus = 0, per_cu = 0;
        hipGetDevice(&dev); hipDeviceGetAttribute(&cus, hipDeviceAttributeMultiprocessorCount, dev);
        if (hipFuncSetAttribute((const void*)fwd_megakernel, hipFuncAttributeMaxDynamicSharedMemorySize, LDS_BYTES) != hipSuccess) { fprintf(stderr, "kernel_launch: hipFuncSetAttribute failed\n"); grid = -1; return; }
        if (hipOccupancyMaxActiveBlocksPerMultiprocessor(&per_cu, (const void*)fwd_megakernel, NTHREADS, LDS_BYTES) != hipSuccess || per_cu < 1) { fprintf(stderr, "kernel_launch: occupancy query says %d\n", per_cu); per_cu = 1; }
        (void)hipGetLastError();
        grid = cus * 1;
    }
    if (grid < 0) return;
    hipMemsetAsync((char*)d_ws + WS_CTL, 0, CTL_BYTES, stream);
    Args a{};
    const float** f = (const float**)&a;
    for (int i = 0; i < 17; ++i) f[i] = (const float*)d_in[i];
    a.out = (float*)d_out; a.ws = (unsigned char*)d_ws;
#if MK_SPLIT
    for (int ph = 0; ph < N_PHASES; ++ph) { a.ph_lo = ph; a.ph_hi = ph + 1; hipLaunchKernelGGL(fwd_megakernel, dim3(grid), dim3(NTHREADS), LDS_BYTES, stream, a); }
#else
    a.ph_lo = 0; a.ph_hi = N_PHASES;
    void* args[] = {&a};
    hipError_t e = hipLaunchCooperativeKernel((const void*)fwd_megakernel, dim3(grid), dim3(NTHREADS), args, LDS_BYTES, stream);
    if (e != hipSuccess) fprintf(stderr, "cooperative launch failed: %s (grid %d)\n", hipGetErrorString(e), grid);
#endif
}
```

```cpp
#include <hip/hip_runtime.h>
#include <hip/hip_cooperative_groups.h>
#include <cstdio>
#include <cstdint>
namespace cg = cooperative_groups;

constexpr int BATCH = 8, SEQ = 4096, DM = 1024, DEPTH = 4, NMETA = 16, FRONT = 112, TT = 4224;
constexpr int MROWS = BATCH * TT;
constexpr int INW = 1184, INP = 1280, DFF = 2816, GUP = 2 * DFF;
constexpr float RMS_EPS = 1e-6f;
constexpr float LOG2E = 1.4426950408889634f;
constexpr float LOG2_THETA = 13.287712379549449f;
constexpr float INV_2PI = 0.15915494309189535f;

namespace pg8 {
#define PG8_LAS __attribute__((address_space(3)))
typedef unsigned short bf16_t;
typedef short bf16x8 __attribute__((ext_vector_type(8)));
typedef float f32x4 __attribute__((ext_vector_type(4)));
typedef unsigned u32x4 __attribute__((ext_vector_type(4)));
constexpr int BM = 256, BK = 64, HALF = 128, HTB = HALF * BK * 2  , STAGE_BYTES = 8 * HTB, NXCD = 8, WGM = 8;

__host__ __device__ __forceinline__ int lds_byte(int r, int c) { const int st = (r >> 4) * 2 + (c >> 5), rr = r & 15, cc = c & 31, ob = rr * 64 + cc * 2; return st * 1024 + (ob ^ (((ob >> 9) & 1) << 5)); }
__host__ __device__ __forceinline__ void stage_rc(int b, int& R, int& C) { const int st = b / 1024, sb = b % 1024, swz = sb ^ (((sb >> 9) & 1) << 5); R = (st >> 1) * 16 + swz / 64; C = (st & 1) * 32 + (swz % 64) / 2; }
__host__ __device__ __forceinline__ int perm32(int rho) { const int n = rho >> 4, i = rho & 15; return 8 * (i >> 2) + 4 * n + (i & 3); }

struct Unit { int pm, pn; };
struct Gemm { const bf16_t* A; const bf16_t* Bt; int M, N, K; int apad; };

struct StaticOrder {
    int nM, nN, nwg, G, c;
    __host__ __device__ void init(int M, int N, int G_, int c_) { nM = M / BM; nN = N / BM; nwg = nM * nN; G = G_; c = c_; }
    __host__ __device__ bool next(int i, Unit& u) const {
        const long L = (long)i * G + c; if (L >= nwg) return false;
        int wgid = (int)L; { const int q = nwg / NXCD, r = nwg % NXCD, xcd = wgid % NXCD, off = wgid / NXCD; wgid = (xcd < r ? xcd * (q + 1) : r * (q + 1) + (xcd - r) * q) + off; }
        const int nig = WGM * nN, gid = wgid / nig, fm = gid * WGM, gsz = (nM - fm) < WGM ? (nM - fm) : WGM;
        u.pm = fm + ((wgid % nig) % gsz); u.pn = (wgid % nig) / gsz; return true;
    }
    __device__ __forceinline__ void a_ready(const Unit&) const {}
    __device__ __forceinline__ void done(const Unit&) const {}
};

__device__ __forceinline__ unsigned cvt_pk_bf16(float lo, float hi) { unsigned r; asm volatile("v_cvt_pk_bf16_f32 %0, %1, %2" : "=v"(r) : "v"(lo), "v"(hi)); return r; }

template <int NM, int NN> struct OrderCT {
    static_assert(NM % 8 == 0 || NM % 8 == 4, "last M group must be 8 or 4 tiles");
    int G, c;
    __device__ __forceinline__ void init(int G_, int c_) { G = G_; c = c_; }
    __device__ __forceinline__ bool next(int i, Unit& u) const {
        constexpr int nwg = NM * NN, q = nwg / NXCD, r = nwg % NXCD, nig = WGM * NN;
        const int L = i * G + c; if (L >= nwg) return false;
        const int xcd = L & (NXCD - 1), off = L >> 3;
        const int wgid = (xcd < r ? xcd * (q + 1) : r * (q + 1) + (xcd - r) * q) + off;
        const int gid = wgid / nig, rem = wgid - gid * nig, fm = gid * WGM;
        const int sh = (NM - fm) < WGM ? 2 : 3;
        u.pm = fm + (rem & ((1 << sh) - 1)); u.pn = rem >> sh; return true;
    }
    __device__ __forceinline__ void a_ready(const Unit&) const {}
    __device__ __forceinline__ void done(const Unit&) const {}
};
typedef unsigned u32x2 __attribute__((ext_vector_type(2)));
#define PG8_GAS __attribute__((address_space(1)))
__device__ __forceinline__ void st_bf16x4(bf16_t* p, f32x4 v) { u32x2 w; w.x = cvt_pk_bf16(v[0], v[1]); w.y = cvt_pk_bf16(v[2], v[3]); *(PG8_GAS u32x2*)p = w; }
__device__ __forceinline__ void st_bf16x8(bf16_t* p, f32x4 v0, f32x4 v1) { u32x4 w; w.x = cvt_pk_bf16(v0[0], v0[1]); w.y = cvt_pk_bf16(v0[2], v0[3]); w.z = cvt_pk_bf16(v1[0], v1[1]); w.w = cvt_pk_bf16(v1[2], v1[3]); *(PG8_GAS u32x4*)p = w; }
__device__ __forceinline__ float sum16(const float* part, int row) {
    const PG8_GAS f32x4* p = (const PG8_GAS f32x4*)(part + (size_t)row * 16); const f32x4 a = p[0], b = p[1], c = p[2], d = p[3];
    return (((a.x + a.y) + (a.z + a.w)) + ((b.x + b.y) + (b.z + b.w))) + (((c.x + c.y) + (c.z + c.w)) + ((d.x + d.y) + (d.z + d.w)));
}
__device__ __forceinline__ float sum16q(const float* part, int row, int fq) {
    const f32x4 a = *((const PG8_GAS f32x4*)(part + (size_t)row * 16) + fq); float s = (a.x + a.y) + (a.z + a.w);
    s += __shfl_xor(s, 16); s += __shfl_xor(s, 32); return s;
}
__device__ __forceinline__ float sum4(const float* part, int row) { const f32x4 a = *(const PG8_GAS f32x4*)(part + (size_t)row * 4); return (a.x + a.y) + (a.z + a.w); }
__device__ __forceinline__ float rsq(float x) { return 1.0f / sqrtf(x); }
__device__ __forceinline__ float sq4(f32x4 v) { return (v[0] * v[0] + v[1] * v[1]) + (v[2] * v[2] + v[3] * v[3]); }
#define EPI_ROWS(ai, m) for (int ai = 0; ai < 2; ++ai) for (int m = 0; m < 4; ++m)
#define EPI_ROW(u, ai, m) ((u).pm * BM + (ai) * HALF + wr * 64 + (m) * 16 + fr)

__device__ __forceinline__ int prow_of(int m) { return m + (m >> 12) * 128 + 128; }
#define EPI_NB (META ? BATCH : 1)
#define EPI_PROW(row, b) (META ? (size_t)((b) * TT + FRONT + (row)) : (size_t)prow_of(row))
#define EPI_MAIN_LOOP(CALL) _Pragma("unroll") for (int ai = 0; ai < 2; ++ai) _Pragma("unroll") for (int m = 0; m < 4; ++m) { asm volatile("" ::: "memory"); const int row = EPI_ROW(u, ai, m); \
        const f32x4 a_[2][2] = {{acc[ai][0][m][0], acc[ai][0][m][1]}, {acc[ai][1][m][0], acc[ai][1][m][1]}}; CALL; }

template <bool META> struct EpiIn {
    static constexpr bool PERM = true, AFTER_DRAIN = false, MIDSCALE = false;
    const float* hss; bf16_t *qa, *ka, *va, *qlat, *kvlat, *kr; float *ssq_q, *ssq_kv;
    __device__ __forceinline__ void mid(f32x4 (&)[2][2][4][2], const Unit&, int, int, int, int) const {}
    __device__ __forceinline__ void row_epi(const f32x4 (&a)[2][2], int row, int pn, int wc, int fr, int fq) const {
        const float rs = rsq(sum16q(hss, row, fq) * (1.0f / DM) + RMS_EPS);
        if (pn <= 2) {
            const bool is_kr = (pn == 2 && wc == 2);
            if (pn == 2 && wc == 3) return;
            const float pos = META ? (float)row : (float)((row & 4095) + NMETA);
            f32x4 o1[2], o2[2];
#pragma unroll
            for (int n = 0; n < 2; ++n) {
                const f32x4 x1 = a[0][n] * rs, x2 = a[1][n] * rs;
#pragma unroll
                for (int e = 0; e < 4; ++e) { const float d1 = (float)(8 * fq + 4 * n + e); const float inv = __builtin_amdgcn_exp2f(-d1 * (is_kr ? (LOG2_THETA / 16.0f) : (LOG2_THETA / 32.0f)));
                    const float ang = pos * inv; float rev = ang * INV_2PI; rev = rev - floorf(rev);
                    const float sn = __builtin_amdgcn_sinf(rev), cs = __builtin_amdgcn_cosf(rev); o1[n][e] = x1[e] * cs - x2[e] * sn; o2[n][e] = x2[e] * cs + x1[e] * sn; }
            }
            if (is_kr && fq >= 2) return;
#pragma unroll
            for (int b = 0; b < EPI_NB; ++b) { const size_t pr = EPI_PROW(row, b); bf16_t* d; int half;
                if (pn < 2) { d = qa + pr * 512 + (4 * pn + wc) * 64 + 8 * fq; half = 32; }
                else if (!is_kr) { d = ka + pr * 128 + wc * 64 + 8 * fq; half = 32; }
                else { d = kr + pr * 32 + 8 * fq; half = 16; }
                st_bf16x8(d, o1[0], o1[1]); st_bf16x8(d + half, o2[0], o2[1]); }
        } else if (pn == 3) {
            const int c = 32 * wc + 8 * fq; const f32x4 v0 = a[0][0] * rs, v1 = a[0][1] * rs, w0 = a[1][0] * rs, w1 = a[1][1] * rs;
#pragma unroll
            for (int b = 0; b < EPI_NB; ++b) st_bf16x8(va + EPI_PROW(row, b) * 128 + c, v0, v1);
            st_bf16x8(kvlat + (size_t)row * 128 + c, w0, w1);
            float ss = sq4(w0) + sq4(w1);
            ss += __shfl_xor(ss, 16); ss += __shfl_xor(ss, 32);
            if (fq == 0) ((PG8_GAS float*)ssq_kv)[(size_t)row * 4 + wc] = ss;
        } else {
            float ss = 0.f;
#pragma unroll
            for (int bj = 0; bj < 2; ++bj) { const int c = 128 * bj + 32 * wc + 8 * fq; const f32x4 v0 = a[bj][0] * rs, v1 = a[bj][1] * rs; st_bf16x8(qlat + (size_t)row * 256 + c, v0, v1); ss += sq4(v0) + sq4(v1); }
            ss += __shfl_xor(ss, 16); ss += __shfl_xor(ss, 32);
            if (fq == 0) ((PG8_GAS float*)ssq_q)[(size_t)row * 4 + wc] = ss;
        }
    }
    __device__ __forceinline__ void operator()(const f32x4 (&acc)[2][2][4][2], const Unit& u, int wr, int wc, int fr, int fq) const { EPI_MAIN_LOOP(row_epi(a_, row, u.pn, wc, fr, fq)) }
};

template <bool META> struct EpiQup {
    static constexpr bool PERM = true, AFTER_DRAIN = false, MIDSCALE = false;
    const float* ssq_q; bf16_t* qm;
    __device__ __forceinline__ void mid(f32x4 (&)[2][2][4][2], const Unit&, int, int, int, int) const {}
    __device__ __forceinline__ void row_epi(const f32x4 (&a)[2][2], int row, int pn, int wc, int fr, int fq) const {
        const float rs = rsq(sum4(ssq_q, row) * (1.0f / 256.0f) + RMS_EPS);
        if (pn < 2) {
#pragma unroll
            for (int bj = 0; bj < 2; ++bj) { const int head = 4 * pn + 2 * bj + (wc >> 1), d = 32 * (wc & 1) + 8 * fq; const f32x4 v0 = a[bj][0] * rs, v1 = a[bj][1] * rs;
#pragma unroll
                for (int b = 0; b < EPI_NB; ++b) st_bf16x8(qm + EPI_PROW(row, b) * 768 + head * 96 + d, v0, v1); }
        } else {
            const float pos = META ? (float)row : (float)((row & 4095) + NMETA);
            const int head = 2 * wc + (fq >> 1), i0 = 8 * (fq & 1); f32x4 o1[2], o2[2];
#pragma unroll
            for (int n = 0; n < 2; ++n) { const f32x4 x1 = a[0][n] * rs, x2 = a[1][n] * rs;
#pragma unroll
                for (int e = 0; e < 4; ++e) { const float inv = __builtin_amdgcn_exp2f(-(float)(i0 + 4 * n + e) * (LOG2_THETA / 16.0f)); const float ang = pos * inv; float rev = ang * INV_2PI; rev = rev - floorf(rev);
                    const float sn = __builtin_amdgcn_sinf(rev), cs = __builtin_amdgcn_cosf(rev); o1[n][e] = x1[e] * cs - x2[e] * sn; o2[n][e] = x2[e] * cs + x1[e] * sn; } }
#pragma unroll
            for (int b = 0; b < EPI_NB; ++b) { bf16_t* qrow = qm + EPI_PROW(row, b) * 768 + head * 96; st_bf16x8(qrow + 64 + i0, o1[0], o1[1]); st_bf16x8(qrow + 80 + i0, o2[0], o2[1]); }
        }
    }
    __device__ __forceinline__ void operator()(const f32x4 (&acc)[2][2][4][2], const Unit& u, int wr, int wc, int fr, int fq) const { EPI_MAIN_LOOP(row_epi(a_, row, u.pn, wc, fr, fq)) }
};

template <bool META> struct EpiKvup {
    static constexpr bool PERM = true, AFTER_DRAIN = false, MIDSCALE = false;
    const float* ssq_kv; bf16_t *kn, *vb;
    __device__ __forceinline__ void mid(f32x4 (&)[2][2][4][2], const Unit&, int, int, int, int) const {}
    __device__ __forceinline__ void row_epi(const f32x4 (&a)[2][2], int row, int pn, int wc, int fr, int fq) const {
        bf16_t* dst = (pn < 2 ? kn : vb) + (pn & 1) * 256;
        const float rs = rsq(sum4(ssq_kv, row) * (1.0f / 128.0f) + RMS_EPS);
#pragma unroll
        for (int bj = 0; bj < 2; ++bj) { const f32x4 v0 = a[bj][0] * rs, v1 = a[bj][1] * rs;
#pragma unroll
            for (int b = 0; b < EPI_NB; ++b) st_bf16x8(dst + EPI_PROW(row, b) * 512 + 128 * bj + 32 * wc + 8 * fq, v0, v1); }
    }
    __device__ __forceinline__ void operator()(const f32x4 (&acc)[2][2][4][2], const Unit& u, int wr, int wc, int fr, int fq) const { EPI_MAIN_LOOP(row_epi(a_, row, u.pn, wc, fr, fq)) }
};

struct EpiResid {
    static constexpr bool PERM = true, AFTER_DRAIN = false;
    float* H; bf16_t* HB; float* hss_out; const float* ssq_o;
    __device__ __forceinline__ void resid_row(const f32x4 (&a)[2][2], int row, float rs, int pn, int wc, int fr, int fq) const {
        float ss = 0.f;
#pragma unroll
        for (int bj = 0; bj < 2; ++bj) { const size_t off = (size_t)row * DM + pn * BM + 128 * bj + 32 * wc + 8 * fq;
            const u32x4 hw = *(const PG8_GAS u32x4*)(HB + off); f32x4 h0, h1;
            h0[0] = __builtin_bit_cast(float, hw.x << 16); h0[1] = __builtin_bit_cast(float, hw.x & 0xffff0000u); h0[2] = __builtin_bit_cast(float, hw.y << 16); h0[3] = __builtin_bit_cast(float, hw.y & 0xffff0000u);
            h1[0] = __builtin_bit_cast(float, hw.z << 16); h1[1] = __builtin_bit_cast(float, hw.z & 0xffff0000u); h1[2] = __builtin_bit_cast(float, hw.w << 16); h1[3] = __builtin_bit_cast(float, hw.w & 0xffff0000u);
            h0 = h0 + a[bj][0] * rs; h1 = h1 + a[bj][1] * rs; st_bf16x8(HB + off, h0, h1); ss += sq4(h0) + sq4(h1); }
        ss += __shfl_xor(ss, 16); ss += __shfl_xor(ss, 32);
        if (fq == 0) ((PG8_GAS float*)hss_out)[(size_t)row * 16 + 4 * pn + wc] = ss;
    }
    __device__ __forceinline__ void two_scales(size_t prow, float& f, float& rb) const {
        const PG8_GAS f32x4* p = (const PG8_GAS f32x4*)(ssq_o + prow * 16); const f32x4 a = p[0], b = p[1], c = p[2], d = p[3];
        const float sa = ((a.x + a.y) + (a.z + a.w)) + ((b.x + b.y) + (b.z + b.w)), sb = ((c.x + c.y) + (c.z + c.w)) + ((d.x + d.y) + (d.z + d.w));
        const float va = sa * (1.0f / 512.0f) + RMS_EPS, vb = sb * (1.0f / 512.0f) + RMS_EPS; f = sqrtf(vb / va); rb = rsq(vb);
    }
};
template <bool META> struct EpiOut : EpiResid {
    static constexpr bool MIDSCALE = true;
    PG8_LAS unsigned char* xlds;
    __device__ __forceinline__ void prep(const Unit& u, int wid, int wr, int lane) const {
        PG8_LAS float* tab = (PG8_LAS float*)(xlds + wid * 1024);
#pragma unroll
        for (int j = 0; j < 2; ++j) { const int idx = lane + 64 * j; const int row = u.pm * BM + (idx >> 6) * HALF + wr * 64 + (idx & 63);
            float f, rb; two_scales((size_t)prow_of(row), f, rb); tab[2 * idx] = f; tab[2 * idx + 1] = rb; }
    }
    __device__ __forceinline__ void mid(f32x4 (&acc)[2][2][4][2], const Unit& u, int wr, int wc, int fr, int fq) const {
        const int wid = wr * 4 + wc; const PG8_LAS float* tab = (const PG8_LAS float*)(xlds + wid * 1024);
#pragma unroll
        for (int ai = 0; ai < 2; ++ai)
#pragma unroll
            for (int m = 0; m < 4; ++m) {
                const float f = tab[2 * (ai * 64 + m * 16 + fr)];
#pragma unroll
                for (int bj = 0; bj < 2; ++bj)
#pragma unroll
                    for (int n = 0; n < 2; ++n) acc[ai][bj][m][n] *= f;
            }
    }
    __device__ __forceinline__ void operator()(const f32x4 (&acc)[2][2][4][2], const Unit& u, int wr, int wc, int fr, int fq) const {
        const PG8_LAS float* tab = (const PG8_LAS float*)(xlds + (wr * 4 + wc) * 1024);
        EPI_MAIN_LOOP(resid_row(a_, row, tab[2 * (ai * 64 + m * 16 + fr) + 1], u.pn, wc, fr, fq))
    }
    __device__ __forceinline__ void mid_row(f32x4 (&a)[2][2], int row) const { float f, rb; two_scales((size_t)(FRONT + row), f, rb);
#pragma unroll
        for (int bj = 0; bj < 2; ++bj)
#pragma unroll
            for (int n = 0; n < 2; ++n) a[bj][n] *= f; }
    __device__ __forceinline__ void row_epi(const f32x4 (&a)[2][2], int row, int pn, int wc, int fr, int fq) const { float f, rb; two_scales((size_t)(FRONT + row), f, rb); resid_row(a, row, rb, pn, wc, fr, fq); }
};
template <bool META> struct EpiDown : EpiResid {
    static constexpr bool MIDSCALE = false;
    __device__ __forceinline__ void mid(f32x4 (&)[2][2][4][2], const Unit&, int, int, int, int) const {}
    __device__ __forceinline__ void row_epi(const f32x4 (&a)[2][2], int row, int pn, int wc, int fr, int fq) const { resid_row(a, row, 1.0f, pn, wc, fr, fq); }
    __device__ __forceinline__ void operator()(const f32x4 (&acc)[2][2][4][2], const Unit& u, int wr, int wc, int fr, int fq) const { EPI_MAIN_LOOP(resid_row(a_, row, 1.0f, u.pn, wc, fr, fq)) }
};

template <bool META> struct EpiGU {
    static constexpr bool PERM = true, AFTER_DRAIN = false, MIDSCALE = false;
    const float* hss; bf16_t* act;
    __device__ __forceinline__ void mid(f32x4 (&)[2][2][4][2], const Unit&, int, int, int, int) const {}
    __device__ __forceinline__ void row_epi(const f32x4 (&a)[2][2], int row, int pn, int wc, int fr, int fq) const {
        const float rs = rsq(sum16q(hss, row, fq) * (1.0f / DM) + RMS_EPS); f32x4 o[2];
#pragma unroll
        for (int n = 0; n < 2; ++n) { const f32x4 g = a[0][n] * rs, up = a[1][n] * rs;
#pragma unroll
            for (int e = 0; e < 4; ++e) o[n][e] = g[e] * up[e] * __builtin_amdgcn_rcpf(1.0f + __builtin_amdgcn_exp2f(-g[e] * LOG2E)); }
        st_bf16x8(act + (size_t)row * DFF + 128 * pn + 32 * wc + 8 * fq, o[0], o[1]);
    }
    __device__ __forceinline__ void operator()(const f32x4 (&acc)[2][2][4][2], const Unit& u, int wr, int wc, int fr, int fq) const { EPI_MAIN_LOOP(row_epi(a_, row, u.pn, wc, fr, fq)) }
};

template <int K, class Epi>
__device__ __forceinline__ void skinny_phase(PG8_LAS unsigned char* lds, const bf16_t* A16, const bf16_t* Bt, int NN, const Epi& E, int wg0) {
    int tid_ = threadIdx.x; asm volatile("" : "+v"(tid_));
    const int tid = tid_, lane = tid & 63, wid = __builtin_amdgcn_readfirstlane(tid >> 6), fr = lane & 15, fq = lane >> 4;
    constexpr int nk = K / 32, NJ = (nk + 7) / 8;
    const int G = (int)gridDim.x; int first = (int)blockIdx.x - wg0; if (first < 0) first += G;
    for (int task = first; task < 4 * NN; task += G) {
        const int pn = task >> 2, wc = task & 3;
        f32x4 a[2][2];
#pragma unroll
        for (int bj = 0; bj < 2; ++bj)
#pragma unroll
            for (int n = 0; n < 2; ++n) a[bj][n] = (f32x4){0.f, 0.f, 0.f, 0.f};
        bool scaled = false;
        const bf16_t* ap = A16 + (size_t)fr * K + 8 * fq;
        const bf16_t* bp = Bt + (size_t)(256 * pn + 32 * wc + 8 * (fr >> 2) + (fr & 3)) * K + 8 * fq;
#pragma unroll 4
        for (int j = 0; j < NJ; ++j) {
            const int it = wid + 8 * j; if (it >= nk) break;
            const int k0 = 32 * it;
            if constexpr (Epi::MIDSCALE) { if (!scaled && k0 >= (K >> 1)) { E.mid_row(a, fr); scaled = true; } }
            const bf16x8 av = *(const PG8_GAS bf16x8*)(ap + k0);
#pragma unroll
            for (int bj = 0; bj < 2; ++bj)
#pragma unroll
                for (int n = 0; n < 2; ++n) { const bf16x8 bv = *(const PG8_GAS bf16x8*)(bp + (size_t)(128 * bj + 4 * n) * K + k0);
                    a[bj][n] = __builtin_amdgcn_mfma_f32_16x16x32_bf16(bv, av, a[bj][n], 0, 0, 0); }
        }
        if constexpr (Epi::MIDSCALE) { if (!scaled) E.mid_row(a, fr); }
        PG8_LAS f32x4* red = (PG8_LAS f32x4*)lds;
#pragma unroll
        for (int bj = 0; bj < 2; ++bj)
#pragma unroll
            for (int n = 0; n < 2; ++n) red[(wid * 64 + lane) * 4 + bj * 2 + n] = a[bj][n];
        __syncthreads();
        if (wid == 0) {
#pragma unroll
            for (int w = 1; w < 8; ++w)
#pragma unroll
                for (int bj = 0; bj < 2; ++bj)
#pragma unroll
                    for (int n = 0; n < 2; ++n) a[bj][n] += red[(w * 64 + lane) * 4 + bj * 2 + n];
            E.row_epi(a, fr, pn, wc, fr, fq);
        }
        __syncthreads();
    }
}
template <class Epi, class Sched, bool ALIGN_EPI = false, bool SP2 = false>
__device__ __forceinline__ void gemm_phase(PG8_LAS unsigned char* lds, const Gemm g, const Sched& S, const Epi& E) {
    int tid_ = threadIdx.x; asm volatile("" : "+v"(tid_));
    const int tid = tid_, wid = __builtin_amdgcn_readfirstlane(tid >> 6), lane = tid & 63, wr = wid >> 2, wc = wid & 3, fr = lane & 15, fq = lane >> 4;
    int K_ = g.K; asm volatile("" : "+s"(K_)); const int K = K_, nt = K / BK;
    unsigned voffA[2], voffB[2];
#pragma unroll
    for (int i = 0; i < 2; ++i) { int R, C; stage_rc(tid * 16 + i * 8192, R, C); const int Rb = Epi::PERM ? ((R & ~31) + perm32(R & 31)) : R;
        voffA[i] = (unsigned)(R * K + C) * 2u; voffB[i] = (unsigned)(Rb * K + C) * 2u; }
    const size_t kstep = (size_t)(BK * 2);
    const size_t hstep = (size_t)HALF * K * 2;
    const size_t tstep = 2 * hstep;
    const unsigned ldsw = (unsigned)wid * 1024u;
    const int aoff = lds_byte(wr * 64 + fr, fq * 8), boff = lds_byte(wc * 32 + fr, fq * 8);
#define PG8_SA(b, h) (((b) * 2 + (h)) * HTB)
#define PG8_SB(b, h) ((4 + (b) * 2 + (h)) * HTB)
#define PG8_STAGE(bufoff, gbase, voff) do { _Pragma("unroll") for (int _i = 0; _i < 2; ++_i) \
        __builtin_amdgcn_global_load_lds((const unsigned*)((const char*)(gbase) + (voff)[_i]), (PG8_LAS unsigned*)(lds + (bufoff) + ldsw + _i * 8192), 16, 0, 0); } while (0)
#define PG8_LDA(dst, b, h) do { _Pragma("unroll") for (int m = 0; m < 4; ++m) _Pragma("unroll") for (int k = 0; k < 2; ++k) dst[m][k] = *(const PG8_LAS bf16x8*)(lds + PG8_SA(b, h) + aoff + m * 2048 + k * 1024); } while (0)
#define PG8_LDB(dst, b, h) do { _Pragma("unroll") for (int n = 0; n < 2; ++n) _Pragma("unroll") for (int k = 0; k < 2; ++k) dst[n][k] = *(const PG8_LAS bf16x8*)(lds + PG8_SB(b, h) + boff + n * 2048 + k * 1024); } while (0)
#define PG8_MMA(ai, bj, At, Bt) do { __builtin_amdgcn_s_setprio(1); _Pragma("unroll") for (int m = 0; m < 4; ++m) _Pragma("unroll") for (int n = 0; n < 2; ++n) _Pragma("unroll") for (int k = 0; k < 2; ++k) \
        acc[ai][bj][m][n] = __builtin_amdgcn_mfma_f32_16x16x32_bf16(Bt[n][k], At[m][k], acc[ai][bj][m][n], 0, 0, 0); __builtin_amdgcn_s_setprio(0); } while (0)
#define PG8_WAIT_V(n) asm volatile("s_waitcnt vmcnt(" #n ")" ::: "memory")
#define PG8_WAIT_L(n) asm volatile("s_waitcnt lgkmcnt(" #n ")" ::: "memory")
#define PG8_BAR __builtin_amdgcn_s_barrier()
#define PG8_SCHED __builtin_amdgcn_sched_barrier(0)
    Unit cur, nxt; int ui = 0;
    if (!S.next(0, cur)) return;
    f32x4 acc[2][2][4][2];
#pragma unroll
    for (int a = 0; a < 2; ++a)
#pragma unroll
        for (int b = 0; b < 2; ++b)
#pragma unroll
            for (int m = 0; m < 4; ++m)
#pragma unroll
                for (int n = 0; n < 2; ++n) acc[a][b][m][n] = (f32x4){0.f, 0.f, 0.f, 0.f};
    bf16x8 At[4][2], B0[2][2], B1[2][2];
    const char* cA = (const char*)g.A + (size_t)cur.pm * tstep + (g.apad ? (size_t)((cur.pm >> 4) * 128 + 128) * (size_t)K * 2 : (size_t)0); const char* cB = (const char*)g.Bt + (size_t)cur.pn * tstep;
    S.a_ready(cur);
    if constexpr (SP2) {
        PG8_STAGE(PG8_SB(0, 0), cB, voffB); PG8_STAGE(PG8_SB(0, 1), cB + hstep, voffB); PG8_STAGE(PG8_SA(0, 0), cA, voffA); PG8_STAGE(PG8_SA(0, 1), cA + hstep, voffA);
        if (wr == 1) PG8_BAR;
        PG8_WAIT_V(2); PG8_BAR;
        PG8_STAGE(PG8_SB(1, 0), cB + kstep, voffB); PG8_STAGE(PG8_SA(1, 0), cA + kstep, voffA); PG8_STAGE(PG8_SB(1, 1), cB + hstep + kstep, voffB);
        PG8_WAIT_V(6); PG8_BAR;
    } else {
        PG8_STAGE(PG8_SB(0, 0), cB, voffB); PG8_STAGE(PG8_SA(0, 0), cA, voffA); PG8_STAGE(PG8_SB(0, 1), cB + hstep, voffB); PG8_STAGE(PG8_SA(0, 1), cA + hstep, voffA);
        if (wr == 1) PG8_BAR;
        PG8_WAIT_V(4); PG8_BAR;
        PG8_STAGE(PG8_SB(1, 0), cB + kstep, voffB); PG8_STAGE(PG8_SA(1, 0), cA + kstep, voffA); PG8_STAGE(PG8_SB(1, 1), cB + hstep + kstep, voffB);
        PG8_WAIT_V(6); PG8_BAR;
    }
    for (;;) {
        const bool has_next = S.next(ui + 1, nxt);
        if constexpr (Epi::MIDSCALE) E.prep(cur, wid, wr, lane);
        const char* nA = has_next ? (const char*)g.A + (size_t)nxt.pm * tstep + (g.apad ? (size_t)((nxt.pm >> 4) * 128 + 128) * (size_t)K * 2 : (size_t)0) : cA; const char* nB = has_next ? (const char*)g.Bt + (size_t)nxt.pn * tstep : cB;
        for (int t = 0; t < nt; t += 2) {
            const bool last = (t == nt - 2);
            if constexpr (Epi::MIDSCALE) { if (t == (nt >> 1)) E.mid(acc, cur, wr, wc, fr, fq); }
            const char* a1 = cA + (size_t)(t + 1) * kstep;
            const char* a2 = last ? nA : cA + (size_t)(t + 2) * kstep; const char* b2 = last ? nB : cB + (size_t)(t + 2) * kstep;
            const char* a3 = a2 + kstep; const char* b3 = b2 + kstep;
            if (last && has_next) S.a_ready(nxt);
            if constexpr (SP2) {
            PG8_LDB(B0, 0, 0); PG8_LDB(B1, 0, 1); PG8_SCHED; PG8_LDA(At, 0, 0); PG8_STAGE(PG8_SA(1, 1), a1 + hstep, voffA);
            PG8_WAIT_V(8); PG8_WAIT_L(0); PG8_BAR; PG8_MMA(0, 0, At, B0); PG8_MMA(0, 1, At, B1); PG8_BAR; PG8_SCHED;
            PG8_LDA(At, 0, 1); PG8_STAGE(PG8_SB(0, 0), b2, voffB); PG8_STAGE(PG8_SB(0, 1), b2 + hstep, voffB); PG8_STAGE(PG8_SA(0, 0), a2, voffA);
            PG8_WAIT_V(8); PG8_WAIT_L(0); PG8_BAR; PG8_MMA(1, 0, At, B0); PG8_MMA(1, 1, At, B1); PG8_BAR; PG8_SCHED;
            PG8_LDB(B0, 1, 0); PG8_LDB(B1, 1, 1); PG8_SCHED; PG8_LDA(At, 1, 0); PG8_STAGE(PG8_SA(0, 1), a2 + hstep, voffA);
            PG8_WAIT_V(8); PG8_WAIT_L(0); PG8_BAR; PG8_MMA(0, 0, At, B0); PG8_MMA(0, 1, At, B1); PG8_BAR; PG8_SCHED;
            PG8_LDA(At, 1, 1); PG8_STAGE(PG8_SB(1, 0), b3, voffB); PG8_STAGE(PG8_SB(1, 1), b3 + hstep, voffB); PG8_STAGE(PG8_SA(1, 0), a3, voffA);
            PG8_WAIT_V(8); PG8_WAIT_L(0); PG8_BAR; PG8_MMA(1, 0, At, B0); PG8_MMA(1, 1, At, B1); PG8_BAR; PG8_SCHED;
            } else {
            PG8_LDB(B0, 0, 0); PG8_SCHED; PG8_LDA(At, 0, 0); PG8_STAGE(PG8_SA(1, 1), a1 + hstep, voffA);
            PG8_WAIT_L(8); PG8_BAR; PG8_WAIT_L(0); PG8_MMA(0, 0, At, B0); PG8_BAR; PG8_SCHED;
            PG8_LDB(B1, 0, 1); PG8_STAGE(PG8_SB(0, 0), b2, voffB);
            PG8_BAR; PG8_WAIT_L(0); PG8_MMA(0, 1, At, B1); PG8_BAR;
            PG8_LDA(At, 0, 1); PG8_STAGE(PG8_SA(0, 0), a2, voffA);
            PG8_BAR; PG8_WAIT_L(0); PG8_MMA(1, 0, At, B0); PG8_BAR; PG8_SCHED;
            PG8_STAGE(PG8_SB(0, 1), b2 + hstep, voffB);
            PG8_WAIT_V(6); PG8_BAR; PG8_MMA(1, 1, At, B1); PG8_BAR;
            PG8_LDB(B0, 1, 0); PG8_SCHED; PG8_LDA(At, 1, 0); PG8_STAGE(PG8_SA(0, 1), a2 + hstep, voffA);
            PG8_WAIT_L(8); PG8_BAR; PG8_WAIT_L(0); PG8_MMA(0, 0, At, B0); PG8_BAR; PG8_SCHED;
            PG8_LDB(B1, 1, 1); PG8_STAGE(PG8_SB(1, 0), b3, voffB);
            PG8_BAR; PG8_WAIT_L(0); PG8_MMA(0, 1, At, B1); PG8_BAR;
            PG8_LDA(At, 1, 1); PG8_STAGE(PG8_SA(1, 0), a3, voffA);
            PG8_BAR; PG8_WAIT_L(0); PG8_MMA(1, 0, At, B0); PG8_BAR; PG8_SCHED;
            PG8_STAGE(PG8_SB(1, 1), b3 + hstep, voffB);
            PG8_WAIT_V(6); PG8_BAR; PG8_MMA(1, 1, At, B1); PG8_BAR;
            }
        }
        if constexpr (ALIGN_EPI) { if (wr == 0) PG8_BAR; }
        if constexpr (!Epi::AFTER_DRAIN) { E(acc, cur, wr, wc, fr, fq); S.done(cur); }
        if (!has_next) break;
#pragma unroll
        for (int a = 0; a < 2; ++a)
#pragma unroll
            for (int b = 0; b < 2; ++b)
#pragma unroll
                for (int m = 0; m < 4; ++m)
#pragma unroll
                    for (int n = 0; n < 2; ++n) acc[a][b][m][n] = (f32x4){0.f, 0.f, 0.f, 0.f};
        cur = nxt; cA = nA; cB = nB; ++ui;
        if constexpr (ALIGN_EPI) { if (wr == 1) PG8_BAR; }
    }
    PG8_WAIT_V(0);
    if constexpr (!ALIGN_EPI) { if (wr == 0) PG8_BAR; }
    PG8_BAR;
    if constexpr (Epi::AFTER_DRAIN) { E.fused(acc, cur, wr, wc, fr, fq, lds, wid, lane); S.done(cur); }
#undef PG8_SA
#undef PG8_SB
#undef PG8_STAGE
#undef PG8_LDA
#undef PG8_LDB
#undef PG8_MMA
#undef PG8_WAIT_V
#undef PG8_WAIT_L
#undef PG8_BAR
#undef PG8_SCHED
}
}
namespace att {
#define ALAS __attribute__((address_space(3)))
#define AGAS __attribute__((address_space(1)))
typedef unsigned short bf16_t;
typedef short bf16x8 __attribute__((ext_vector_type(8)));
typedef short s16x4 __attribute__((ext_vector_type(4)));
typedef float f32x16 __attribute__((ext_vector_type(16)));
typedef unsigned u32x4 __attribute__((ext_vector_type(4)));
typedef float f32x2_t __attribute__((ext_vector_type(2))); typedef __bf16 bf16x2_t __attribute__((ext_vector_type(2)));
constexpr int KPMAX = 208, VP = 192, KSZ = 64 * KPMAX, VSZ = 64 * VP;
constexpr int OFF_V = 2 * KSZ, OFF_SCR = OFF_V + 2 * VSZ, OFF_Q = OFF_SCR + 8 * 256, LDS_BYTES = OFF_Q + 64;
constexpr float NEGF = -1e30f, THR = 6.0f;
__device__ __forceinline__ int crow(int r, int hi) { return (r & 3) + 8 * (r >> 2) + 4 * hi; }
__device__ __forceinline__ unsigned cvtpk(float lo, float hi) { f32x2_t v = {lo, hi}; bf16x2_t b = __builtin_convertvector(v, bf16x2_t); return __builtin_bit_cast(unsigned, b); }
__device__ __forceinline__ bf16x8 pack8(const f32x16& p, int s) { u32x4 w; w.x = cvtpk(p[8 * s], p[8 * s + 1]); w.y = cvtpk(p[8 * s + 2], p[8 * s + 3]); w.z = cvtpk(p[8 * s + 4], p[8 * s + 5]); w.w = cvtpk(p[8 * s + 6], p[8 * s + 7]); return __builtin_bit_cast(bf16x8, w); }
typedef short v4i16_t __attribute__((ext_vector_type(4)));
__device__ __forceinline__ float max3f(float a, float b, float c) { float r; asm("v_max3_f32 %0, %1, %2, %3" : "=v"(r) : "v"(a), "v"(b), "v"(c)); return r; }
__device__ __forceinline__ float max2f(float a, float b) { float r; asm("v_max_f32_e32 %0, %1, %2" : "=v"(r) : "v"(a), "v"(b)); return r; }
__device__ __forceinline__ float xhalf_max(float m) { auto rr = __builtin_amdgcn_permlane32_swap(__float_as_uint(m), __float_as_uint(m), false, false); return max2f(__uint_as_float(rr[0]), __uint_as_float(rr[1])); }
__device__ __forceinline__ s16x4 vtr(const ALAS unsigned char* p) { return __builtin_bit_cast(s16x4, __builtin_amdgcn_ds_read_tr16_b64_v4i16((ALAS v4i16_t*)p)); }
__device__ __forceinline__ unsigned short f2bf(float f) { unsigned u = __builtin_bit_cast(unsigned, f); return (unsigned short)((u + 0x7fffu + ((u >> 16) & 1u)) >> 16); }

template <int DQK, bool SWA>
__device__ __forceinline__ void attn_unit(ALAS unsigned char* lds, const bf16_t* Qp, int qpitch, const bf16_t* Kp, int kpitch, const bf16_t* Krp, const bf16_t* Vp, int vpitch,
                                          bf16_t* Op, float* ssq, float sink2, int b, int qb) {
    constexpr int KP = DQK * 2 + 16, NS = DQK / 16;
    int tid_ = threadIdx.x; asm volatile("" : "+v"(tid_));
    const int tid = tid_, lane = tid & 63, wid = __builtin_amdgcn_readfirstlane(tid >> 6), r = lane & 31, h = lane >> 5;
    const size_t rowbase = (size_t)b * TT;
    const int q0 = qb * 256, q0w = q0 + wid * 32;
    const bool wave_valid = q0w < TT;
    const int NT = (q0 + 256) / 64 < TT / 64 ? (q0 + 256) / 64 : TT / 64;
    int t0 = 1; if (SWA) { t0 = (q0 - 128) / 64; if (t0 < 1) t0 = 1; }
    ALAS float* scr = (ALAS float*)(lds + OFF_SCR + wid * 256);
    bf16x8 qf[NS];
    { const int qr = (q0w + r) < TT ? (q0w + r) : TT - 1; const bf16_t* qrow = Qp + (rowbase + qr) * (size_t)qpitch;
#pragma unroll
      for (int s = 0; s < NS; ++s) qf[s] = *(const AGAS bf16x8*)(qrow + 16 * s + 8 * h); }
    const int srow = tid >> 3, sch = tid & 7, rrow = (tid >> 2) & 63, rch = tid & 3;
    u32x4 kregA, vregA, rregA = {0u, 0u, 0u, 0u}, kregB, vregB, rregB = {0u, 0u, 0u, 0u};
#define AT_GLOAD(t, S) do { const size_t kr_ = rowbase + 64 * (t) + srow; kreg##S = *(const AGAS u32x4*)(Kp + kr_ * (size_t)kpitch + sch * 8); vreg##S = *(const AGAS u32x4*)(Vp + kr_ * (size_t)vpitch + sch * 8); \
        if (DQK == 96) { if (tid < 256) rreg##S = *(const AGAS u32x4*)(Krp + (rowbase + 64 * (t) + rrow) * 32 + rch * 8); } } while (0)
#define AT_LSTORE(buf, S) do { *(ALAS u32x4*)(lds + (buf) * KSZ + srow * KP + sch * 16) = kreg##S; *(ALAS u32x4*)(lds + OFF_V + (buf) * VSZ + srow * VP + sch * 16) = vreg##S; \
        if (DQK == 96) { if (tid < 256) *(ALAS u32x4*)(lds + (buf) * KSZ + rrow * KP + 128 + rch * 16) = rreg##S; } } while (0)
    AT_GLOAD(t0, A); AT_LSTORE(0, A);
    if (t0 + 1 < NT) AT_GLOAD(t0 + 1, A);
    __syncthreads();
    if (wid >= 4) __builtin_amdgcn_s_setprio(1);
    float mrun = SWA ? sink2 : 0.0f, lrun = (SWA && h == 0) ? 1.0f : 0.0f;
    bool first_ = !SWA;
    f32x16 negm;
#pragma unroll
    for (int i = 0; i < 16; ++i) negm[i] = -mrun;
    f32x16 o0, o1;
#pragma unroll
    for (int i = 0; i < 16; ++i) { o0[i] = 0.f; o1[i] = 0.f; }
    const int q = q0w + r;
#define AT_PVF(P, j) do { o0 = __builtin_amdgcn_mfma_f32_32x32x16_bf16(P, __builtin_shufflevector(vlo[2 * (j)], vhi[2 * (j)], 0, 1, 2, 3, 4, 5, 6, 7), o0, 0, 0, 0); o1 = __builtin_amdgcn_mfma_f32_32x32x16_bf16(P, __builtin_shufflevector(vlo[2 * (j) + 1], vhi[2 * (j) + 1], 0, 1, 2, 3, 4, 5, 6, 7), o1, 0, 0, 0); } while (0)
#define AT_PV(P, rowoff) do { \
                { const s16x4 lo = vtr(vb_ + (rowoff) * VP), hi = vtr(vb_ + ((rowoff) + 8) * VP); const bf16x8 vf = __builtin_shufflevector(lo, hi, 0, 1, 2, 3, 4, 5, 6, 7); o0 = __builtin_amdgcn_mfma_f32_32x32x16_bf16(P, vf, o0, 0, 0, 0); } \
                { const s16x4 lo = vtr(vb_ + (rowoff) * VP + 64), hi = vtr(vb_ + ((rowoff) + 8) * VP + 64); const bf16x8 vf = __builtin_shufflevector(lo, hi, 0, 1, 2, 3, 4, 5, 6, 7); o1 = __builtin_amdgcn_mfma_f32_32x32x16_bf16(P, vf, o1, 0, 0, 0); } } while (0)
#define AT_STEP(t, LS, SS) do { \
        const int buf = (t - t0) & 1; \
        if (t + 2 < NT) AT_GLOAD(t + 2, LS); \
        const int kfirst = 64 * t; \
        bool active = wave_valid && (kfirst <= q0w + 31); \
        if (SWA) active = active && (kfirst + 63 >= q0w - 127); \
        if (active) { \
            f32x16 s0, s1; \
            const ALAS unsigned char* kb = lds + buf * KSZ + r * KP + h * 16; \
            bf16x8 kf[2 * NS]; \
_Pragma("unroll") \
            for (int s = 0; s < NS; ++s) { kf[2 * s] = *(const ALAS bf16x8*)(kb + s * 32); kf[2 * s + 1] = *(const ALAS bf16x8*)(kb + 32 * KP + s * 32); } \
            __builtin_amdgcn_sched_barrier(0); \
_Pragma("unroll") \
            for (int s = 0; s < NS; ++s) { if (s == 0) { s0 = __builtin_amdgcn_mfma_f32_32x32x16_bf16(kf[0], qf[0], negm, 0, 0, 0); s1 = __builtin_amdgcn_mfma_f32_32x32x16_bf16(kf[1], qf[0], negm, 0, 0, 0); } else { s0 = __builtin_amdgcn_mfma_f32_32x32x16_bf16(kf[2 * s], qf[s], s0, 0, 0, 0); s1 = __builtin_amdgcn_mfma_f32_32x32x16_bf16(kf[2 * s + 1], qf[s], s1, 0, 0, 0); } } \
            __builtin_amdgcn_sched_barrier(0); \
            const ALAS unsigned char* vb_ = lds + OFF_V + buf * VSZ + (4 * h + ((lane & 15) >> 2)) * VP + ((lane >> 4) & 1) * 32 + (lane & 3) * 8; \
            s16x4 vlo[8], vhi[8]; \
_Pragma("unroll") \
            for (int j = 0; j < 4; ++j) { vlo[2 * j] = vtr(vb_ + (16 * j) * VP); vhi[2 * j] = vtr(vb_ + (16 * j + 8) * VP); vlo[2 * j + 1] = vtr(vb_ + (16 * j) * VP + 64); vhi[2 * j + 1] = vtr(vb_ + (16 * j + 8) * VP + 64); } \
            __builtin_amdgcn_sched_barrier(0); \
            const bool need_mask = SWA || (t == 1) || (kfirst + 63 > q0w); \
            if (need_mask) { \
_Pragma("unroll") \
                for (int i = 0; i < 16; ++i) { const int key = kfirst + crow(i, h), key1 = key + 32; \
                    bool ok0 = (key <= q) && (key >= FRONT), ok1 = (key1 <= q) && (key1 >= FRONT); \
                    if (SWA) { ok0 = ok0 && (q - key < 128); ok1 = ok1 && (q - key1 < 128); } \
                    s0[i] = ok0 ? s0[i] : NEGF; s1[i] = ok1 ? s1[i] : NEGF; } \
            } \
            float rm = max3f(s0[0], s0[1], s1[0]), rm2 = max3f(s0[2], s0[3], s1[1]); rm = max3f(rm, s1[2], s1[3]); \
_Pragma("unroll") \
            for (int i = 4; i < 16; i += 4) { rm = max3f(rm, s0[i], s0[i + 1]); rm2 = max3f(rm2, s0[i + 2], s0[i + 3]); rm = max3f(rm, s1[i], s1[i + 1]); rm2 = max3f(rm2, s1[i + 2], s1[i + 3]); } \
            rm = xhalf_max(max2f(rm, rm2)); \
            if (first_ || __any(rm > THR)) { \
                const float dl = first_ ? (rm > -1e29f ? rm : 0.f) : max2f(rm, 0.f); first_ = false; \
                mrun += dl; const float f = __builtin_amdgcn_exp2f(-dl); lrun *= f; \
_Pragma("unroll") \
                for (int i = 0; i < 16; ++i) { s0[i] -= dl; s1[i] -= dl; negm[i] = -mrun; } \
                if (h == 0) scr[r] = f; \
_Pragma("unroll") \
                for (int i = 0; i < 16; ++i) { const float fi = scr[crow(i, h)]; o0[i] *= fi; o1[i] *= fi; } \
            } \
            float ls = 0.f; \
_Pragma("unroll") \
            for (int i = 0; i < 16; ++i) { s0[i] = __builtin_amdgcn_exp2f(s0[i]); s1[i] = __builtin_amdgcn_exp2f(s1[i]); ls += s0[i] + s1[i]; } \
            lrun += ls; \
            const bf16x8 p0 = pack8(s0, 0), p1 = pack8(s0, 1), p2 = pack8(s1, 0), p3 = pack8(s1, 1); \
            __builtin_amdgcn_sched_barrier(0); \
            AT_PVF(p0, 0); AT_PVF(p1, 1); AT_PVF(p2, 2); AT_PVF(p3, 3); \
        } \
        if (t + 1 < NT) AT_LSTORE(buf ^ 1, SS); \
        __syncthreads(); \
    } while (0)
    {
        int t = t0;
        for (; t + 1 < NT; t += 2) { AT_STEP(t, B, A); const int t1 = t + 1; AT_STEP(t1, A, B); }
        if (t < NT) AT_STEP(t, B, A);
    }
#undef AT_STEP
#undef AT_PV
#undef AT_GLOAD
#undef AT_LSTORE
    __builtin_amdgcn_s_setprio(0);
    if (wave_valid) {
        const float lt = lrun + __shfl_xor(lrun, 32);
        if (h == 0) scr[32 + r] = lt;
        ALAS bf16_t* stg = (ALAS bf16_t*)(lds + wid * 4096);
#pragma unroll
        for (int i = 0; i < 16; ++i) {
            const float li = scr[32 + crow(i, h)], inv = li > 0.f ? 1.0f / li : 0.f;
            const int orow = crow(i, h);
            stg[orow * 64 + r] = f2bf(o0[i] * inv); stg[orow * 64 + 32 + r] = f2bf(o1[i] * inv);
        }
#pragma unroll
        for (int i = 0; i < 4; ++i) {
            const int lrow = i * 8 + (lane >> 3), ch = lane & 7; const u32x4 v = *(const ALAS u32x4*)(stg + lrow * 64 + ch * 8);
            const size_t row = rowbase + q0w + lrow;
            *(AGAS u32x4*)(Op + row * 1024 + ch * 8) = v;
            float ss = 0.f;
#pragma unroll
            for (int j = 0; j < 4; ++j) { const unsigned w = v[j]; const float lo = __builtin_bit_cast(float, w << 16), hi = __builtin_bit_cast(float, w & 0xffff0000u); ss += lo * lo + hi * hi; }
            ss += __shfl_xor(ss, 1); ss += __shfl_xor(ss, 2); ss += __shfl_xor(ss, 4);
            if (ch == 0) ((AGAS float*)ssq)[row * 16] = ss;
        }
    }
    __syncthreads();
}
}
typedef unsigned short bf16;
#define LAS __attribute__((address_space(3)))
#define GAS __attribute__((address_space(1)))
constexpr size_t MiB = 1u << 20;
constexpr int NWAVES = 8, NTHREADS = 512;
constexpr int LDS_BYTES = 147456;
static_assert(att::LDS_BYTES <= 131072, "attention LDS");
constexpr size_t WS_CTL = 0, CTL_BYTES = 65536;
constexpr size_t WS_H = 1 * MiB;
constexpr size_t WS_HB = WS_H + (size_t)MROWS * DM * 4;
constexpr size_t WS_W = WS_HB + (size_t)MROWS * DM * 2;
constexpr size_t WL_IN = 0, WL_Q = WL_IN + (size_t)INP * DM * 2, WL_KV = WL_Q + (size_t)768 * 256 * 2, WL_O = WL_KV + (size_t)1024 * 128 * 2,
                 WL_GU = WL_O + (size_t)DM * DM * 2, WL_D = WL_GU + (size_t)GUP * DM * 2, WL_END = WL_D + (size_t)DM * DFF * 2;
constexpr size_t WBUF = 22 * MiB;
static_assert(WL_END <= WBUF, "weight buffer");
constexpr size_t WS_PART = WS_W + 2 * WBUF;
constexpr size_t P_HSSA = 0, P_HSSB = P_HSSA + (size_t)MROWS * 64, P_SSQO = P_HSSB + (size_t)MROWS * 64, P_SSQQ = P_SSQO + (size_t)MROWS * 64, P_SSQKV = P_SSQQ + (size_t)MROWS * 16, P_END = P_SSQKV + (size_t)MROWS * 16;
constexpr size_t PM_H = (P_END + 255) & ~(size_t)255, PM_HB = PM_H + 16 * DM * 4, PM_HSSA = PM_HB + 16 * DM * 2, PM_HSSB = PM_HSSA + 1024, PM_SSQQ = PM_HSSB + 1024, PM_SSQKV = PM_SSQQ + 256,
                 PM_QLAT = PM_SSQKV + 256, PM_KVLAT = PM_QLAT + 16 * 256 * 2, PM_ACT = PM_KVLAT + 16 * 128 * 2, PM_END = PM_ACT + 16 * DFF * 2;
static_assert(PM_END <= 8 * MiB, "partials");
constexpr int MC = BATCH * SEQ;
constexpr size_t WS_R = WS_PART + 8 * MiB;
constexpr size_t R_QA = 0, R_KA = R_QA + (size_t)MROWS * 512 * 2, R_VA = R_KA + (size_t)MROWS * 128 * 2, R_QLAT = R_VA + (size_t)MROWS * 128 * 2, R_KVLAT = R_QLAT + (size_t)MROWS * 256 * 2,
                 R_KR = R_KVLAT + (size_t)MROWS * 128 * 2, R_QM = R_KR + (size_t)MROWS * 32 * 2, R_KN = R_QM + (size_t)MROWS * 768 * 2, R_VB = R_KN + (size_t)MROWS * 512 * 2,
                 R_O = R_VB + (size_t)MROWS * 512 * 2, R_END = R_O + (size_t)MROWS * 1024 * 2;
constexpr size_t R_ACT = 0;
static_assert((size_t)MROWS * DFF * 2 <= R_END, "act overlay");
constexpr size_t WS_END = WS_R + R_END;
static_assert(WS_END <= 512 * MiB, "workspace must fit 512 MiB");

struct Args {
    const float *x, *meta, *attn_norm, *w_in, *q_norm, *w_q_up, *kv_norm, *w_kv_up, *sinks, *out_norm_swa, *out_norm_mla, *w_o, *ffn_norm, *w_gate, *w_up, *w_down, *final_norm;
    float* out; unsigned char* ws; int ph_lo, ph_hi;
};

__device__ __forceinline__ unsigned f2bf_u(float f) { unsigned u = __builtin_bit_cast(unsigned, f); return (u + 0x7fffu + ((u >> 16) & 1u)) >> 16; }
__device__ __forceinline__ unsigned pk2(float lo, float hi) { return f2bf_u(lo) | (f2bf_u(hi) << 16); }
__device__ __forceinline__ float wave_sum(float v) {
#pragma unroll
    for (int o = 1; o < 64; o <<= 1) v += __shfl_xor(v, o);
    return v;
}

__device__ __forceinline__ int src_in(int np) { const int pn = np >> 8, bj = (np >> 7) & 1, o = np & 127;
    if (pn < 2) return (4 * pn + (o >> 5)) * 64 + (o & 31) + 32 * bj;
    if (pn == 2) { if (o < 64) return 512 + (o >> 5) * 64 + (o & 31) + 32 * bj; if (o < 80) return 1152 + (o - 64) + 16 * bj; return -1; }
    if (pn == 3) return bj ? 1024 + o : 640 + o;
    return 768 + 128 * bj + o; }
__device__ __forceinline__ int src_qup(int np) { const int pn = np >> 8, op = np & 255;
    if (pn < 2) return (4 * pn + (op >> 6)) * 96 + (op & 63);
    const int bj = op >> 7, o = op & 127; return (o >> 4) * 96 + 64 + (o & 15) + 16 * bj; }
__device__ __forceinline__ int src_kvup(int np) { const int pn = np >> 8, op = np & 255; return (4 * (pn & 1) + (op >> 6)) * 128 + (pn >= 2 ? 64 : 0) + (op & 63); }

template <int MODE>
__device__ __forceinline__ void conv_item(const float* W, const float* W2, const float* gain, const float* gain2, int K, int Nsrc, bf16* WT, LAS float* scr, int item, int nblk, int lane) {
    const int kb = item / nblk, nb = item % nblk, k0 = 64 * kb, n0 = 32 * nb;
    const int np = n0 + (lane & 31);
    int src; float cs = 1.0f; const float* Wp = W;
    if (MODE == 0) { src = src_in(np); if (np < 512) cs = 0.125f * LOG2E; }
    else if (MODE == 1) { src = src_qup(np); cs = 0.10206207261596577f * LOG2E; }
    else if (MODE == 2) src = src_kvup(np);
    else if (MODE == 4) { src = 128 * (np >> 8) + (np & 127); if ((np >> 7) & 1) Wp = W2; }
    else src = np;
#pragma unroll 8
    for (int i = 0; i < 32; ++i) { const int kk = 2 * i + (lane >> 5), k = k0 + kk;
        float g = 1.0f; if (MODE == 3) g = (k < 512) ? ((const GAS float*)gain)[k] : ((const GAS float*)gain2)[k - 512]; else if (MODE != 5) g = ((const GAS float*)gain)[k];
        scr[kk * 33 + (lane & 31)] = (src >= 0) ? ((const GAS float*)Wp)[(size_t)k * Nsrc + src] * g * cs : 0.0f; }
    asm volatile("s_waitcnt lgkmcnt(0)" ::: "memory");
    const int c = lane & 7;
#pragma unroll
    for (int j = 0; j < 4; ++j) { const int n = (lane >> 3) + 8 * j; const LAS float* s = scr + (8 * c) * 33 + n;
        pg8::u32x4 o; o.x = pk2(s[0 * 33], s[1 * 33]); o.y = pk2(s[2 * 33], s[3 * 33]); o.z = pk2(s[4 * 33], s[5 * 33]); o.w = pk2(s[6 * 33], s[7 * 33]);
        *(GAS pg8::u32x4*)(WT + (size_t)(n0 + n) * K + k0 + 8 * c) = o; }
    asm volatile("s_waitcnt lgkmcnt(0)" ::: "memory");
}
__device__ __forceinline__ void conv_layer(const Args& a, int l, unsigned char* wbuf, LAS unsigned char* lds) {
    int tid_ = threadIdx.x; asm volatile("" : "+v"(tid_));
    const int lane = tid_ & 63, wave = tid_ >> 6;
    LAS float* scr = (LAS float*)(lds + wave * 16384);
    const int gw = blockIdx.x * NWAVES + wave, NGW = gridDim.x * NWAVES;
    constexpr int I0 = (DM / 64) * (INP / 32), I1 = (256 / 64) * (768 / 32), I2 = (128 / 64) * (1024 / 32), I3 = (DM / 64) * (DM / 32), I4 = (DM / 64) * (GUP / 32), I5 = (DFF / 64) * (DM / 32);
    constexpr int NIT = I0 + I1 + I2 + I3 + I4 + I5;
    for (int it = gw; it < NIT; it += NGW) {
        int r = it;
        if (r < I0) { conv_item<0>(a.w_in + (size_t)l * DM * INW, nullptr, a.attn_norm + l * DM, nullptr, DM, INW, (bf16*)(wbuf + WL_IN), scr, r, INP / 32, lane); continue; } r -= I0;
        if (r < I1) { conv_item<1>(a.w_q_up + (size_t)l * 256 * 768, nullptr, a.q_norm + l * 256, nullptr, 256, 768, (bf16*)(wbuf + WL_Q), scr, r, 768 / 32, lane); continue; } r -= I1;
        if (r < I2) { conv_item<2>(a.w_kv_up + (size_t)l * 128 * 1024, nullptr, a.kv_norm + l * 128, nullptr, 128, 1024, (bf16*)(wbuf + WL_KV), scr, r, 1024 / 32, lane); continue; } r -= I2;
        if (r < I3) { conv_item<3>(a.w_o + (size_t)l * DM * DM, nullptr, a.out_norm_swa + l * 512, a.out_norm_mla + l * 512, DM, DM, (bf16*)(wbuf + WL_O), scr, r, DM / 32, lane); continue; } r -= I3;
        if (r < I4) { conv_item<4>(a.w_gate + (size_t)l * DM * DFF, a.w_up + (size_t)l * DM * DFF, a.ffn_norm + l * DM, nullptr, DM, DFF, (bf16*)(wbuf + WL_GU), scr, r, GUP / 32, lane); continue; } r -= I4;
        conv_item<5>(a.w_down + (size_t)l * DFF * DM, nullptr, nullptr, nullptr, DFF, DM, (bf16*)(wbuf + WL_D), scr, r, DM / 32, lane);
    }
}

__device__ __forceinline__ void init_rows(const Args& a, unsigned char* ws) {
    const int lane = threadIdx.x & 63, wave = threadIdx.x >> 6; const int gw = blockIdx.x * NWAVES + wave, NGW = gridDim.x * NWAVES;
    for (int row = gw; row < MC + NMETA; row += NGW) {
        const bool meta = row >= MC; const int r = meta ? row - MC : row;
        const float* src = meta ? a.meta + (size_t)r * DM : a.x + (size_t)r * DM;
        float* H = (float*)(ws + (meta ? WS_PART + PM_H : WS_H)); bf16* HB = (bf16*)(ws + (meta ? WS_PART + PM_HB : WS_HB)); float* hss = (float*)(ws + WS_PART + (meta ? PM_HSSA : P_HSSA));
        pg8::f32x4 v[4]; float s = 0.f;
#pragma unroll
        for (int j = 0; j < 4; ++j) { v[j] = *((const GAS pg8::f32x4*)src + lane + 64 * j); s += pg8::sq4(v[j]); }
        s = wave_sum(s);
#pragma unroll
        for (int j = 0; j < 4; ++j) { pg8::st_bf16x4(HB + (size_t)r * DM + 4 * (lane + 64 * j), v[j]); }
        if (lane < 16) ((GAS float*)hss)[(size_t)r * 16 + lane] = (lane == 0) ? s : 0.f;
    }
}
__device__ __forceinline__ void final_rows(const Args& a, const bf16* HBf, const float* hss) {
    const int lane = threadIdx.x & 63, wave = threadIdx.x >> 6; const int gw = blockIdx.x * NWAVES + wave, NGW = gridDim.x * NWAVES;
    for (int o = gw; o < BATCH * SEQ; o += NGW) {
        const int row = o;
        const float rs = pg8::rsq(pg8::sum16(hss, row) * (1.0f / DM) + RMS_EPS);
#pragma unroll
        for (int j = 0; j < 4; ++j) { const pg8::u32x2 hw = *((const GAS pg8::u32x2*)(HBf + (size_t)row * DM) + lane + 64 * j); pg8::f32x4 v; v[0] = __builtin_bit_cast(float, hw.x << 16); v[1] = __builtin_bit_cast(float, hw.x & 0xffff0000u); v[2] = __builtin_bit_cast(float, hw.y << 16); v[3] = __builtin_bit_cast(float, hw.y & 0xffff0000u);
            const pg8::f32x4 g = *((const GAS pg8::f32x4*)a.final_norm + lane + 64 * j);
            *((GAS pg8::f32x4*)(a.out + (size_t)o * DM) + lane + 64 * j) = v * rs * g; }
    }
}

constexpr int N_ATT_UNITS = 2 * 17 * 64;
__device__ __forceinline__ void attn_phase(const Args& a, int l, unsigned char* ws, LAS unsigned char* lds, int mode = 0) {
    const int lq = l; l &= 3;
    unsigned char* R = ws + WS_R;
    const bf16 *QA = (const bf16*)(R + R_QA), *KA = (const bf16*)(R + R_KA), *VA = (const bf16*)(R + R_VA), *KR = (const bf16*)(R + R_KR), *QM = (const bf16*)(R + R_QM), *KN = (const bf16*)(R + R_KN), *VB = (const bf16*)(R + R_VB);
    bf16* O = (bf16*)(R + R_O); float* ssqO = (float*)(ws + WS_PART + P_SSQO);
    LAS int* qslot = (LAS int*)(lds + att::OFF_Q);
    const unsigned xcc = ((unsigned)__builtin_amdgcn_s_getreg((3 << 11) | 20) & 0xFu) & 7u;
    unsigned* ctr = (unsigned*)(ws + WS_CTL) + 64 * lq + 8 * 64 * (int)xcc;
    constexpr int PER_X = N_ATT_UNITS / 8;
    for (int pass = 0; pass < 8; ++pass) {
        const unsigned x = (xcc + (unsigned)pass) & 7u; unsigned* c = (unsigned*)(ws + WS_CTL) + 64 * lq + 8 * 64 * (int)x;
        for (;;) {
            if (threadIdx.x == 0) *qslot = (int)atomicAdd(c, 1u);
            __syncthreads();
            const int u = *qslot;
            __syncthreads();
            if (u >= (mode == 1 ? PER_X / 2 : PER_X)) break;
            if (u < PER_X / 2) {
                const int bh = 8 * (u / 17) + (int)x, qb = 16 - u % 17, b = bh >> 3, hd = bh & 7;
                att::attn_unit<96, false>(lds, QM + hd * 96, 768, KN + hd * 64, 512, KR, VB + hd * 64, 512, O + 512 + hd * 64, ssqO + 8 + hd, 0.f, b, qb);
            } else {
                const int v = u - PER_X / 2; const int bh = 8 * (v / 17) + (int)x, qb = 16 - v % 17, b = bh >> 3, hq = bh & 7, kv = hq >> 2;
                att::attn_unit<64, true>(lds, QA + hq * 64, 512, KA + kv * 64, 128, nullptr, VA + kv * 64, 128, O + hq * 64, ssqO + hq, a.sinks[l * 8 + hq] * LOG2E, b, qb);
            }
        }
    }
    (void)ctr;
}

#define XB_TMO      128
#define XB_XCNT(j)  (256  + 64 * (j))
#define XB_XSUB(j)  (1280 + 64 * (j))
#define XB_XGEN(j)  (2304 + 64 * (j))
#define XB_TOP      3328
#define XB_TOPGEN   3392
#define XCD_BAR_WORDS 3456
#define XB_SPIN_CAP (1u << 18)

__device__ __forceinline__ unsigned xb_ld(unsigned* p)              { return __hip_atomic_load(p, __ATOMIC_RELAXED, __HIP_MEMORY_SCOPE_AGENT); }
__device__ __forceinline__ unsigned xb_add(unsigned* p, unsigned v) { return __hip_atomic_fetch_add(p, v, __ATOMIC_RELAXED, __HIP_MEMORY_SCOPE_AGENT); }
__device__ __forceinline__ unsigned xb_xcc_id() { return (unsigned)__builtin_amdgcn_s_getreg((3 << 11) | 20) & 0xFu; }
#define XB_SPIN(cond, bar) do { unsigned _sp = 0; while (cond) { __builtin_amdgcn_s_sleep(1); \
    if ((++_sp & 255u) == 0u) { if (xb_ld(&(bar)[XB_TMO])) break; if (_sp > XB_SPIN_CAP) { atomicAdd(&(bar)[XB_TMO], 1u); break; } } } } while (0)

struct XcdBarrier {
    unsigned* bar; unsigned x;
    volatile LAS unsigned* st;
};

__device__ __forceinline__ XcdBarrier xcd_barrier_post(unsigned* bar, volatile LAS unsigned* st) {
    XcdBarrier b; b.bar = bar; b.x = xb_xcc_id(); b.st = st;
    if (threadIdx.x == 0) (void)xb_add(&bar[XB_XCNT(b.x)], 1u);
    return b;
}
__device__ __forceinline__ void xcd_barrier_complete(unsigned* bar, unsigned x, unsigned& nloc, unsigned& nx) {
    const unsigned G = gridDim.x * gridDim.y * gridDim.z;
    unsigned sum, cnt, mine, sp = 0u;
    for (;;) {
        sum = 0u; cnt = 0u; mine = 0u;
#pragma unroll
        for (unsigned j = 0; j < 16; ++j) { const unsigned c = xb_ld(&bar[XB_XCNT(j)]); sum += c; cnt += (c > 0u) ? 1u : 0u; mine = (j == x) ? c : mine; }
        if (sum == G) break;
        __builtin_amdgcn_s_sleep(1);
        if ((++sp & 255u) == 0u) { if (xb_ld(&bar[XB_TMO])) break; if (sp > XB_SPIN_CAP) { atomicAdd(&bar[XB_TMO], 1u); break; } }
    }
    nloc = mine > 0u ? mine : 1u; nx = cnt > 0u ? cnt : 1u;
}

__device__ __forceinline__ void xcd_barrier(const XcdBarrier& b) {
    asm volatile("s_waitcnt vmcnt(0)" ::: "memory");
    __syncthreads();
    if (threadIdx.x == 0) {
        unsigned* bar = b.bar;
        __builtin_amdgcn_s_waitcnt(0);
        unsigned nloc = b.st[0], nx = b.st[1];
        if (nloc == 0u) { xcd_barrier_complete(bar, b.x, nloc, nx); b.st[0] = nloc; b.st[1] = nx; }
        const unsigned old = xb_add(&bar[XB_XSUB(b.x)], 1u);
        const unsigned gen = old / nloc;
        if (old + 1u == (gen + 1u) * nloc) {
            __builtin_amdgcn_fence(__ATOMIC_RELEASE, "agent");
            asm volatile("s_waitcnt vmcnt(0)" ::: "memory");
            const unsigned og = xb_add(&bar[XB_TOP], 1u);
            const unsigned tg = og / nx;
            if (og + 1u == (tg + 1u) * nx) xb_add(&bar[XB_TOPGEN], 1u);
            else XB_SPIN(xb_ld(&bar[XB_TOPGEN]) == tg, bar);
            __builtin_amdgcn_fence(__ATOMIC_ACQUIRE, "agent");
            xb_add(&bar[XB_XGEN(b.x)], 1u);
            asm volatile("s_waitcnt vmcnt(0)" ::: "memory");
        } else {
            XB_SPIN(xb_ld(&bar[XB_XGEN(b.x)]) == gen, bar);
            __builtin_amdgcn_fence(__ATOMIC_ACQUIRE, "agent");
            asm volatile("s_waitcnt vmcnt(0)" ::: "memory");
        }
    }
    __syncthreads();
}

constexpr int CW_BAR = 4096;
constexpr int XB_LDS_OFF = 131072 + 8192;
#ifndef PHM
#define PHM 255
#endif
#ifndef PROBE_DUP
#define PROBE_DUP 0
#endif
#ifndef PROBE_SYNC
#define PROBE_SYNC 0
#endif
__global__ void __launch_bounds__(NTHREADS, 2) fwd_megakernel(Args a) {
    extern __shared__ __attribute__((aligned(16))) unsigned char lds_raw[];
    LAS unsigned char* lds = (LAS unsigned char*)lds_raw;
    cg::grid_group grid = cg::this_grid();
    const int lo = a.ph_lo, hi = a.ph_hi;
    if (threadIdx.x < 2) ((LAS unsigned*)(lds + XB_LDS_OFF))[threadIdx.x] = 0u;
    __syncthreads();
    if (a.ph_hi < 0) grid.sync();
    const XcdBarrier xbar = xcd_barrier_post((unsigned*)(a.ws + WS_CTL) + CW_BAR, (volatile LAS unsigned*)(lds + XB_LDS_OFF));
#define IN_PH(k) (lo <= (k) && (k) < hi)
#define SEAM(k) do { if (IN_PH(k) && IN_PH((k) + 1)) { xcd_barrier(xbar); if (PROBE_SYNC) xcd_barrier(xbar); } } while (0)
#define WSL(w) unsigned char* w = a.ws; asm volatile("" : "+s"(w))
    if (IN_PH(0) && (PHM & 1)) { WSL(ws); init_rows(a, ws); conv_layer(a, 0, ws + WS_W, lds); __syncthreads(); }
    SEAM(0);
#pragma unroll 1
    for (int l = 0; l < DEPTH; ++l) {
        const int p = 1 + 6 * l;
        if (IN_PH(p) && (PHM & 2)) {
            { WSL(ws); unsigned char* R = ws + WS_R; unsigned char* wb = ws + WS_W + (size_t)(l & 1) * WBUF; unsigned char* pm_ = ws + WS_PART;
              pg8::EpiIn<true> E{(const float*)(pm_ + PM_HSSA), (bf16*)(R + R_QA), (bf16*)(R + R_KA), (bf16*)(R + R_VA), (bf16*)(pm_ + PM_QLAT), (bf16*)(pm_ + PM_KVLAT), (bf16*)(R + R_KR), (float*)(pm_ + PM_SSQQ), (float*)(pm_ + PM_SSQKV)};
              pg8::skinny_phase<DM>(lds, (const bf16*)(pm_ + PM_HB), (const bf16*)(wb + WL_IN), INP / 256, E, 128); }
            WSL(ws); unsigned char* R = ws + WS_R; unsigned char* wb = ws + WS_W + (size_t)(l & 1) * WBUF;
            pg8::Gemm g{(const bf16*)(ws + WS_HB), (const bf16*)(wb + WL_IN), MC, INP, DM, 0}; pg8::OrderCT<MC / 256, INP / 256> S; S.init((int)gridDim.x, (int)blockIdx.x);
            pg8::EpiIn<false> E{(const float*)(ws + WS_PART + P_HSSA), (bf16*)(R + R_QA), (bf16*)(R + R_KA), (bf16*)(R + R_VA), (bf16*)(R + R_QLAT), (bf16*)(R + R_KVLAT), (bf16*)(R + R_KR),
                         (float*)(ws + WS_PART + P_SSQQ), (float*)(ws + WS_PART + P_SSQKV)};
            pg8::gemm_phase<pg8::EpiIn<false>, pg8::OrderCT<MC / 256, INP / 256>, true, true>(lds, g, S, E);
            if (PROBE_DUP & 2) pg8::gemm_phase<pg8::EpiIn<false>, pg8::OrderCT<MC / 256, INP / 256>, true, true>(lds, g, S, E);
        }
        SEAM(p);
        if (IN_PH(p + 1) && (PHM & 4)) {
            { WSL(ws); unsigned char* R = ws + WS_R; unsigned char* wb = ws + WS_W + (size_t)(l & 1) * WBUF; unsigned char* pm_ = ws + WS_PART;
              pg8::EpiQup<true> E{(const float*)(pm_ + PM_SSQQ), (bf16*)(R + R_QM)}; pg8::skinny_phase<256>(lds, (const bf16*)(pm_ + PM_QLAT), (const bf16*)(wb + WL_Q), 3, E, 128); }
            { WSL(ws); unsigned char* R = ws + WS_R; unsigned char* wb = ws + WS_W + (size_t)(l & 1) * WBUF;
              pg8::Gemm g{(const bf16*)(R + R_QLAT), (const bf16*)(wb + WL_Q), MC, 768, 256, 0}; pg8::OrderCT<MC / 256, 3> S; S.init((int)gridDim.x, (int)blockIdx.x);
              pg8::EpiQup<false> E{(const float*)(ws + WS_PART + P_SSQQ), (bf16*)(R + R_QM)}; pg8::gemm_phase<pg8::EpiQup<false>, pg8::OrderCT<MC / 256, 3>, true, true>(lds, g, S, E); if (PROBE_DUP & 4) pg8::gemm_phase<pg8::EpiQup<false>, pg8::OrderCT<MC / 256, 3>, true, true>(lds, g, S, E); }
            { WSL(ws); unsigned char* R = ws + WS_R; unsigned char* wb = ws + WS_W + (size_t)(l & 1) * WBUF; unsigned char* pm_ = ws + WS_PART;
              pg8::EpiKvup<true> E{(const float*)(pm_ + PM_SSQKV), (bf16*)(R + R_KN), (bf16*)(R + R_VB)}; pg8::skinny_phase<128>(lds, (const bf16*)(pm_ + PM_KVLAT), (const bf16*)(wb + WL_KV), 4, E, 0); }
            { WSL(ws); unsigned char* R = ws + WS_R; unsigned char* wb = ws + WS_W + (size_t)(l & 1) * WBUF;
              pg8::Gemm g{(const bf16*)(R + R_KVLAT), (const bf16*)(wb + WL_KV), MC, 1024, 128, 0}; pg8::OrderCT<MC / 256, 4> S; S.init((int)gridDim.x, (int)blockIdx.x);
              pg8::EpiKvup<false> E{(const float*)(ws + WS_PART + P_SSQKV), (bf16*)(R + R_KN), (bf16*)(R + R_VB)}; pg8::gemm_phase<pg8::EpiKvup<false>, pg8::OrderCT<MC / 256, 4>, true, true>(lds, g, S, E); if (PROBE_DUP & 4) pg8::gemm_phase<pg8::EpiKvup<false>, pg8::OrderCT<MC / 256, 4>, true, true>(lds, g, S, E); }
        }
        SEAM(p + 1);
        if (IN_PH(p + 2) && (PHM & 8)) { WSL(ws); if (l + 1 < DEPTH) { conv_layer(a, l + 1, ws + WS_W + (size_t)((l + 1) & 1) * WBUF, lds); __syncthreads(); if (PROBE_DUP & 256) { conv_layer(a, l + 1, ws + WS_W + (size_t)((l + 1) & 1) * WBUF, lds); __syncthreads(); } } attn_phase(a, l, ws, lds); if (PROBE_DUP & 8) attn_phase(a, l + 4, ws, lds); if (PROBE_DUP & 1024) attn_phase(a, l + 4, ws, lds, 1); }
        SEAM(p + 2);
        if (IN_PH(p + 3) && (PHM & 16)) {
            { WSL(ws); unsigned char* R = ws + WS_R; unsigned char* wb = ws + WS_W + (size_t)(l & 1) * WBUF; unsigned char* pm_ = ws + WS_PART;
              pg8::EpiOut<true> E; E.H = (float*)(pm_ + PM_H); E.HB = (bf16*)(pm_ + PM_HB); E.hss_out = (float*)(pm_ + PM_HSSB); E.ssq_o = (const float*)(pm_ + P_SSQO); E.xlds = lds;
              pg8::skinny_phase<DM>(lds, (const bf16*)(R + R_O) + (size_t)FRONT * 1024, (const bf16*)(wb + WL_O), 4, E, 0); }
            WSL(ws); unsigned char* R = ws + WS_R; unsigned char* wb = ws + WS_W + (size_t)(l & 1) * WBUF;
            pg8::Gemm g{(const bf16*)(R + R_O), (const bf16*)(wb + WL_O), MC, DM, DM, 1}; pg8::OrderCT<MC / 256, 4> S; S.init((int)gridDim.x, (int)blockIdx.x);
            pg8::EpiOut<false> E; E.H = (float*)(ws + WS_H); E.HB = (bf16*)(ws + WS_HB); E.hss_out = (float*)(ws + WS_PART + P_HSSB); E.ssq_o = (const float*)(ws + WS_PART + P_SSQO); E.xlds = lds + pg8::STAGE_BYTES;
            pg8::gemm_phase<pg8::EpiOut<false>, pg8::OrderCT<MC / 256, 4>, true, true>(lds, g, S, E);
        }
        SEAM(p + 3);
        if (IN_PH(p + 4) && (PHM & 32)) {
            { WSL(ws); unsigned char* wb = ws + WS_W + (size_t)(l & 1) * WBUF; unsigned char* pm_ = ws + WS_PART;
              pg8::EpiGU<true> E{(const float*)(pm_ + PM_HSSB), (bf16*)(pm_ + PM_ACT)}; pg8::skinny_phase<DM>(lds, (const bf16*)(pm_ + PM_HB), (const bf16*)(wb + WL_GU), GUP / 256, E, 0); }
            WSL(ws); unsigned char* R = ws + WS_R; unsigned char* wb = ws + WS_W + (size_t)(l & 1) * WBUF;
            pg8::Gemm g{(const bf16*)(ws + WS_HB), (const bf16*)(wb + WL_GU), MC, GUP, DM, 0}; pg8::OrderCT<MC / 256, GUP / 256> S; S.init((int)gridDim.x, (int)blockIdx.x);
            pg8::EpiGU<false> E{(const float*)(ws + WS_PART + P_HSSB), (bf16*)(R + R_ACT)};
            pg8::gemm_phase<pg8::EpiGU<false>, pg8::OrderCT<MC / 256, GUP / 256>, true, true>(lds, g, S, E);
        }
        SEAM(p + 4);
        if (IN_PH(p + 5) && (PHM & 64)) {
            { WSL(ws); unsigned char* wb = ws + WS_W + (size_t)(l & 1) * WBUF; unsigned char* pm_ = ws + WS_PART;
              pg8::EpiDown<true> E; E.H = (float*)(pm_ + PM_H); E.HB = (bf16*)(pm_ + PM_HB); E.hss_out = (float*)(pm_ + PM_HSSA); E.ssq_o = nullptr;
              pg8::skinny_phase<DFF>(lds, (const bf16*)(pm_ + PM_ACT), (const bf16*)(wb + WL_D), 4, E, 0); }
            WSL(ws); unsigned char* R = ws + WS_R; unsigned char* wb = ws + WS_W + (size_t)(l & 1) * WBUF;
            pg8::Gemm g{(const bf16*)(R + R_ACT), (const bf16*)(wb + WL_D), MC, DM, DFF, 0}; pg8::OrderCT<MC / 256, 4> S; S.init((int)gridDim.x, (int)blockIdx.x);
            pg8::EpiDown<false> E; E.H = (float*)(ws + WS_H); E.HB = (bf16*)(ws + WS_HB); E.hss_out = (float*)(ws + WS_PART + P_HSSA); E.ssq_o = nullptr;
            pg8::gemm_phase<pg8::EpiDown<false>, pg8::OrderCT<MC / 256, 4>, true, true>(lds, g, S, E);
        }
        SEAM(p + 5);
    }
    if (IN_PH(1 + 6 * DEPTH) && (PHM & 128)) { WSL(ws); final_rows(a, (const bf16*)(ws + WS_HB), (const float*)(ws + WS_PART + P_HSSA)); }
#undef IN_PH
#undef SEAM
#undef WSL
}
constexpr int N_PHASES = 2 + 6 * DEPTH;

#ifndef MK_SPLIT
#define MK_SPLIT 0
#endif
extern "C" void kernel_launch(void* const* d_in, const int* in_sizes, int n_in, void* d_out, int out_size, void* d_ws, size_t ws_size, hipStream_t stream) {
    static int grid = 0;
    if (grid == 0) {
        if (n_in != 17 || ws_size < WS_END) { fprintf(stderr, "kernel_launch: need 17 inputs and >= %zu bytes of workspace; got n_in %d, ws %zu\n", (size_t)WS_END, n_in, ws_size); grid = -1; return; }
        int dev = 0, cus = 0, per_cu = 0;
        hipGetDevice(&dev); hipDeviceGetAttribute(&cus, hipDeviceAttributeMultiprocessorCount, dev);
        if (hipFuncSetAttribute((const void*)fwd_megakernel, hipFuncAttributeMaxDynamicSharedMemorySize, LDS_BYTES) != hipSuccess) { fprintf(stderr, "kernel_launch: hipFuncSetAttribute failed\n"); grid = -1; return; }
        if (hipOccupancyMaxActiveBlocksPerMultiprocessor(&per_cu, (const void*)fwd_megakernel, NTHREADS, LDS_BYTES) != hipSuccess || per_cu < 1) { fprintf(stderr, "kernel_launch: occupancy query says %d\n", per_cu); per_cu = 1; }
        (void)hipGetLastError();
        grid = cus * 1;
    }
    if (grid < 0) return;
    hipMemsetAsync((char*)d_ws + WS_CTL, 0, CTL_BYTES, stream);
    Args a{};
    const float** f = (const float**)&a;
    for (int i = 0; i < 17; ++i) f[i] = (const float*)d_in[i];
    a.out = (float*)d_out; a.ws = (unsigned char*)d_ws;
#if MK_SPLIT
    for (int ph = 0; ph < N_PHASES; ++ph) { a.ph_lo = ph; a.ph_hi = ph + 1; hipLaunchKernelGGL(fwd_megakernel, dim3(grid), dim3(NTHREADS), LDS_BYTES, stream, a); }
#else
    a.ph_lo = 0; a.ph_hi = N_PHASES;
    void* args[] = {&a};
    hipError_t e = hipLaunchCooperativeKernel((const void*)fwd_megakernel, dim3(grid), dim3(NTHREADS), args, LDS_BYTES, stream);
    if (e != hipSuccess) fprintf(stderr, "cooperative launch failed: %s (grid %d)\n", hipGetErrorString(e), grid);
#endif
}
```

```cpp
#include <hip/hip_runtime.h>
#include <hip/hip_cooperative_groups.h>
#include <cstdio>
#include <cstdint>
namespace cg = cooperative_groups;

constexpr int BATCH = 8, SEQ = 4096, DM = 1024, DEPTH = 4, NMETA = 16, FRONT = 112, TT = 4224;
constexpr int MROWS = BATCH * TT;
constexpr int INW = 1184, INP = 1280, DFF = 2816, GUP = 2 * DFF;
constexpr float RMS_EPS = 1e-6f;
constexpr float LOG2E = 1.4426950408889634f;
constexpr float LOG2_THETA = 13.287712379549449f;
constexpr float INV_2PI = 0.15915494309189535f;

namespace pg8 {
#define PG8_LAS __attribute__((address_space(3)))
typedef unsigned short bf16_t;
typedef short bf16x8 __attribute__((ext_vector_type(8)));
typedef float f32x4 __attribute__((ext_vector_type(4)));
typedef unsigned u32x4 __attribute__((ext_vector_type(4)));
constexpr int BM = 256, BK = 64, HALF = 128, HTB = HALF * BK * 2  , STAGE_BYTES = 8 * HTB, NXCD = 8, WGM = 8;

__host__ __device__ __forceinline__ int lds_byte(int r, int c) { const int st = (r >> 4) * 2 + (c >> 5), rr = r & 15, cc = c & 31, ob = rr * 64 + cc * 2; return st * 1024 + (ob ^ (((ob >> 9) & 1) << 5)); }
__host__ __device__ __forceinline__ void stage_rc(int b, int& R, int& C) { const int st = b / 1024, sb = b % 1024, swz = sb ^ (((sb >> 9) & 1) << 5); R = (st >> 1) * 16 + swz / 64; C = (st & 1) * 32 + (swz % 64) / 2; }
__host__ __device__ __forceinline__ int perm32(int rho) { const int n = rho >> 4, i = rho & 15; return 8 * (i >> 2) + 4 * n + (i & 3); }

struct Unit { int pm, pn; };
struct Gemm { const bf16_t* A; const bf16_t* Bt; int M, N, K; int apad; };

struct StaticOrder {
    int nM, nN, nwg, G, c;
    __host__ __device__ void init(int M, int N, int G_, int c_) { nM = M / BM; nN = N / BM; nwg = nM * nN; G = G_; c = c_; }
    __host__ __device__ bool next(int i, Unit& u) const {
        const long L = (long)i * G + c; if (L >= nwg) return false;
        int wgid = (int)L; { const int q = nwg / NXCD, r = nwg % NXCD, xcd = wgid % NXCD, off = wgid / NXCD; wgid = (xcd < r ? xcd * (q + 1) : r * (q + 1) + (xcd - r) * q) + off; }
        const int nig = WGM * nN, gid = wgid / nig, fm = gid * WGM, gsz = (nM - fm) < WGM ? (nM - fm) : WGM;
        u.pm = fm + ((wgid % nig) % gsz); u.pn = (wgid % nig) / gsz; return true;
    }
    __device__ __forceinline__ void a_ready(const Unit&) const {}
    __device__ __forceinline__ void done(const Unit&) const {}
};

__device__ __forceinline__ unsigned cvt_pk_bf16(float lo, float hi) { unsigned r; asm volatile("v_cvt_pk_bf16_f32 %0, %1, %2" : "=v"(r) : "v"(lo), "v"(hi)); return r; }

template <int NM, int NN> struct OrderCT {
    static_assert(NM % 8 == 0 || NM % 8 == 4, "last M group must be 8 or 4 tiles");
    int G, c;
    __device__ __forceinline__ void init(int G_, int c_) { G = G_; c = c_; }
    __device__ __forceinline__ bool next(int i, Unit& u) const {
        constexpr int nwg = NM * NN, q = nwg / NXCD, r = nwg % NXCD, nig = WGM * NN;
        const int L = i * G + c; if (L >= nwg) return false;
        const int xcd = L & (NXCD - 1), off = L >> 3;
        const int wgid = (xcd < r ? xcd * (q + 1) : r * (q + 1) + (xcd - r) * q) + off;
        const int gid = wgid / nig, rem = wgid - gid * nig, fm = gid * WGM;
        const int sh = (NM - fm) < WGM ? 2 : 3;
        u.pm = fm + (rem & ((1 << sh) - 1)); u.pn = rem >> sh; return true;
    }
    __device__ __forceinline__ void a_ready(const Unit&) const {}
    __device__ __forceinline__ void done(const Unit&) const {}
};
typedef unsigned u32x2 __attribute__((ext_vector_type(2)));
#define PG8_GAS __attribute__((address_space(1)))
__device__ __forceinline__ void st_bf16x4(bf16_t* p, f32x4 v) { u32x2 w; w.x = cvt_pk_bf16(v[0], v[1]); w.y = cvt_pk_bf16(v[2], v[3]); *(PG8_GAS u32x2*)p = w; }
__device__ __forceinline__ void st_bf16x8(bf16_t* p, f32x4 v0, f32x4 v1) { u32x4 w; w.x = cvt_pk_bf16(v0[0], v0[1]); w.y = cvt_pk_bf16(v0[2], v0[3]); w.z = cvt_pk_bf16(v1[0], v1[1]); w.w = cvt_pk_bf16(v1[2], v1[3]); *(PG8_GAS u32x4*)p = w; }
__device__ __forceinline__ float sum16(const float* part, int row) {
    const PG8_GAS f32x4* p = (const PG8_GAS f32x4*)(part + (size_t)row * 16); const f32x4 a = p[0], b = p[1], c = p[2], d = p[3];
    return (((a.x + a.y) + (a.z + a.w)) + ((b.x + b.y) + (b.z + b.w))) + (((c.x + c.y) + (c.z + c.w)) + ((d.x + d.y) + (d.z + d.w)));
}
__device__ __forceinline__ float sum16q(const float* part, int row, int fq) {
    const f32x4 a = *((const PG8_GAS f32x4*)(part + (size_t)row * 16) + fq); float s = (a.x + a.y) + (a.z + a.w);
    s += __shfl_xor(s, 16); s += __shfl_xor(s, 32); return s;
}
__device__ __forceinline__ float sum4(const float* part, int row) { const f32x4 a = *(const PG8_GAS f32x4*)(part + (size_t)row * 4); return (a.x + a.y) + (a.z + a.w); }
__device__ __forceinline__ float rsq(float x) { return 1.0f / sqrtf(x); }
__device__ __forceinline__ float sq4(f32x4 v) { return (v[0] * v[0] + v[1] * v[1]) + (v[2] * v[2] + v[3] * v[3]); }
#define EPI_ROWS(ai, m) for (int ai = 0; ai < 2; ++ai) for (int m = 0; m < 4; ++m)
#define EPI_ROW(u, ai, m) ((u).pm * BM + (ai) * HALF + wr * 64 + (m) * 16 + fr)

__device__ __forceinline__ int prow_of(int m) { return m + (m >> 12) * 128 + 128; }
#define EPI_NB (META ? BATCH : 1)
#define EPI_PROW(row, b) (META ? (size_t)((b) * TT + FRONT + (row)) : (size_t)prow_of(row))
#define EPI_MAIN_LOOP(CALL) _Pragma("unroll") for (int ai = 0; ai < 2; ++ai) _Pragma("unroll") for (int m = 0; m < 4; ++m) { asm volatile("" ::: "memory"); const int row = EPI_ROW(u, ai, m); \
        const f32x4 a_[2][2] = {{acc[ai][0][m][0], acc[ai][0][m][1]}, {acc[ai][1][m][0], acc[ai][1][m][1]}}; CALL; }

template <bool META> struct EpiIn {
    static constexpr bool PERM = true, AFTER_DRAIN = false, MIDSCALE = false;
    const float* hss; bf16_t *qa, *ka, *va, *qlat, *kvlat, *kr; float *ssq_q, *ssq_kv;
    __device__ __forceinline__ void mid(f32x4 (&)[2][2][4][2], const Unit&, int, int, int, int) const {}
    __device__ __forceinline__ void row_epi(const f32x4 (&a)[2][2], int row, int pn, int wc, int fr, int fq) const {
        const float rs = rsq(sum16q(hss, row, fq) * (1.0f / DM) + RMS_EPS);
        if (pn <= 2) {
            const bool is_kr = (pn == 2 && wc == 2);
            if (pn == 2 && wc == 3) return;
            const float pos = META ? (float)row : (float)((row & 4095) + NMETA);
            f32x4 o1[2], o2[2];
#pragma unroll
            for (int n = 0; n < 2; ++n) {
                const f32x4 x1 = a[0][n] * rs, x2 = a[1][n] * rs;
#pragma unroll
                for (int e = 0; e < 4; ++e) { const float d1 = (float)(8 * fq + 4 * n + e); const float inv = __builtin_amdgcn_exp2f(-d1 * (is_kr ? (LOG2_THETA / 16.0f) : (LOG2_THETA / 32.0f)));
                    const float ang = pos * inv; float rev = ang * INV_2PI; rev = rev - floorf(rev);
                    const float sn = __builtin_amdgcn_sinf(rev), cs = __builtin_amdgcn_cosf(rev); o1[n][e] = x1[e] * cs - x2[e] * sn; o2[n][e] = x2[e] * cs + x1[e] * sn; }
            }
            if (is_kr && fq >= 2) return;
#pragma unroll
            for (int b = 0; b < EPI_NB; ++b) { const size_t pr = EPI_PROW(row, b); bf16_t* d; int half;
                if (pn < 2) { d = qa + pr * 512 + (4 * pn + wc) * 64 + 8 * fq; half = 32; }
                else if (!is_kr) { d = ka + pr * 128 + wc * 64 + 8 * fq; half = 32; }
                else { d = kr + pr * 32 + 8 * fq; half = 16; }
                st_bf16x8(d, o1[0], o1[1]); st_bf16x8(d + half, o2[0], o2[1]); }
        } else if (pn == 3) {
            const int c = 32 * wc + 8 * fq; const f32x4 v0 = a[0][0] * rs, v1 = a[0][1] * rs, w0 = a[1][0] * rs, w1 = a[1][1] * rs;
#pragma unroll
            for (int b = 0; b < EPI_NB; ++b) st_bf16x8(va + EPI_PROW(row, b) * 128 + c, v0, v1);
            st_bf16x8(kvlat + (size_t)row * 128 + c, w0, w1);
            float ss = sq4(w0) + sq4(w1);
            ss += __shfl_xor(ss, 16); ss += __shfl_xor(ss, 32);
            if (fq == 0) ((PG8_GAS float*)ssq_kv)[(size_t)row * 4 + wc] = ss;
        } else {
            float ss = 0.f;
#pragma unroll
            for (int bj = 0; bj < 2; ++bj) { const int c = 128 * bj + 32 * wc + 8 * fq; const f32x4 v0 = a[bj][0] * rs, v1 = a[bj][1] * rs; st_bf16x8(qlat + (size_t)row * 256 + c, v0, v1); ss += sq4(v0) + sq4(v1); }
            ss += __shfl_xor(ss, 16); ss += __shfl_xor(ss, 32);
            if (fq == 0) ((PG8_GAS float*)ssq_q)[(size_t)row * 4 + wc] = ss;
        }
    }
    __device__ __forceinline__ void operator()(const f32x4 (&acc)[2][2][4][2], const Unit& u, int wr, int wc, int fr, int fq) const { EPI_MAIN_LOOP(row_epi(a_, row, u.pn, wc, fr, fq)) }
};

template <bool META> struct EpiQup {
    static constexpr bool PERM = true, AFTER_DRAIN = false, MIDSCALE = false;
    const float* ssq_q; bf16_t* qm;
    __device__ __forceinline__ void mid(f32x4 (&)[2][2][4][2], const Unit&, int, int, int, int) const {}
    __device__ __forceinline__ void row_epi(const f32x4 (&a)[2][2], int row, int pn, int wc, int fr, int fq) const {
        const float rs = rsq(sum4(ssq_q, row) * (1.0f / 256.0f) + RMS_EPS);
        if (pn < 2) {
#pragma unroll
            for (int bj = 0; bj < 2; ++bj) { const int head = 4 * pn + 2 * bj + (wc >> 1), d = 32 * (wc & 1) + 8 * fq; const f32x4 v0 = a[bj][0] * rs, v1 = a[bj][1] * rs;
#pragma unroll
                for (int b = 0; b < EPI_NB; ++b) st_bf16x8(qm + EPI_PROW(row, b) * 768 + head * 96 + d, v0, v1); }
        } else {
            const float pos = META ? (float)row : (float)((row & 4095) + NMETA);
            const int head = 2 * wc + (fq >> 1), i0 = 8 * (fq & 1); f32x4 o1[2], o2[2];
#pragma unroll
            for (int n = 0; n < 2; ++n) { const f32x4 x1 = a[0][n] * rs, x2 = a[1][n] * rs;
#pragma unroll
                for (int e = 0; e < 4; ++e) { const float inv = __builtin_amdgcn_exp2f(-(float)(i0 + 4 * n + e) * (LOG2_THETA / 16.0f)); const float ang = pos * inv; float rev = ang * INV_2PI; rev = rev - floorf(rev);
                    const float sn = __builtin_amdgcn_sinf(rev), cs = __builtin_amdgcn_cosf(rev); o1[n][e] = x1[e] * cs - x2[e] * sn; o2[n][e] = x2[e] * cs + x1[e] * sn; } }
#pragma unroll
            for (int b = 0; b < EPI_NB; ++b) { bf16_t* qrow = qm + EPI_PROW(row, b) * 768 + head * 96; st_bf16x8(qrow + 64 + i0, o1[0], o1[1]); st_bf16x8(qrow + 80 + i0, o2[0], o2[1]); }
        }
    }
    __device__ __forceinline__ void operator()(const f32x4 (&acc)[2][2][4][2], const Unit& u, int wr, int wc, int fr, int fq) const { EPI_MAIN_LOOP(row_epi(a_, row, u.pn, wc, fr, fq)) }
};

template <bool META> struct EpiKvup {
    static constexpr bool PERM = true, AFTER_DRAIN = false, MIDSCALE = false;
    const float* ssq_kv; bf16_t *kn, *vb;
    __device__ __forceinline__ void mid(f32x4 (&)[2][2][4][2], const Unit&, int, int, int, int) const {}
    __device__ __forceinline__ void row_epi(const f32x4 (&a)[2][2], int row, int pn, int wc, int fr, int fq) const {
        bf16_t* dst = (pn < 2 ? kn : vb) + (pn & 1) * 256;
        const float rs = rsq(sum4(ssq_kv, row) * (1.0f / 128.0f) + RMS_EPS);
#pragma unroll
        for (int bj = 0; bj < 2; ++bj) { const f32x4 v0 = a[bj][0] * rs, v1 = a[bj][1] * rs;
#pragma unroll
            for (int b = 0; b < EPI_NB; ++b) st_bf16x8(dst + EPI_PROW(row, b) * 512 + 128 * bj + 32 * wc + 8 * fq, v0, v1); }
    }
    __device__ __forceinline__ void operator()(const f32x4 (&acc)[2][2][4][2], const Unit& u, int wr, int wc, int fr, int fq) const { EPI_MAIN_LOOP(row_epi(a_, row, u.pn, wc, fr, fq)) }
};

struct EpiResid {
    static constexpr bool PERM = true, AFTER_DRAIN = false;
    float* H; bf16_t* HB; float* hss_out; const float* ssq_o;
    __device__ __forceinline__ void resid_row(const f32x4 (&a)[2][2], int row, float rs, int pn, int wc, int fr, int fq) const {
        float ss = 0.f;
#pragma unroll
        for (int bj = 0; bj < 2; ++bj) { const size_t off = (size_t)row * DM + pn * BM + 128 * bj + 32 * wc + 8 * fq;
            const u32x4 hw = *(const PG8_GAS u32x4*)(HB + off); f32x4 h0, h1;
            h0[0] = __builtin_bit_cast(float, hw.x << 16); h0[1] = __builtin_bit_cast(float, hw.x & 0xffff0000u); h0[2] = __builtin_bit_cast(float, hw.y << 16); h0[3] = __builtin_bit_cast(float, hw.y & 0xffff0000u);
            h1[0] = __builtin_bit_cast(float, hw.z << 16); h1[1] = __builtin_bit_cast(float, hw.z & 0xffff0000u); h1[2] = __builtin_bit_cast(float, hw.w << 16); h1[3] = __builtin_bit_cast(float, hw.w & 0xffff0000u);
            h0 = h0 + a[bj][0] * rs; h1 = h1 + a[bj][1] * rs; st_bf16x8(HB + off, h0, h1); ss += sq4(h0) + sq4(h1); }
        ss += __shfl_xor(ss, 16); ss += __shfl_xor(ss, 32);
        if (fq == 0) ((PG8_GAS float*)hss_out)[(size_t)row * 16 + 4 * pn + wc] = ss;
    }
    __device__ __forceinline__ void two_scales(size_t prow, float& f, float& rb) const {
        const PG8_GAS f32x4* p = (const PG8_GAS f32x4*)(ssq_o + prow * 16); const f32x4 a = p[0], b = p[1], c = p[2], d = p[3];
        const float sa = ((a.x + a.y) + (a.z + a.w)) + ((b.x + b.y) + (b.z + b.w)), sb = ((c.x + c.y) + (c.z + c.w)) + ((d.x + d.y) + (d.z + d.w));
        const float va = sa * (1.0f / 512.0f) + RMS_EPS, vb = sb * (1.0f / 512.0f) + RMS_EPS; f = sqrtf(vb / va); rb = rsq(vb);
    }
};
template <bool META> struct EpiOut : EpiResid {
    static constexpr bool MIDSCALE = true;
    PG8_LAS unsigned char* xlds;
    __device__ __forceinline__ void prep(const Unit& u, int wid, int wr, int lane) const {
        PG8_LAS float* tab = (PG8_LAS float*)(xlds + wid * 1024);
#pragma unroll
        for (int j = 0; j < 2; ++j) { const int idx = lane + 64 * j; const int row = u.pm * BM + (idx >> 6) * HALF + wr * 64 + (idx & 63);
            float f, rb; two_scales((size_t)prow_of(row), f, rb); tab[2 * idx] = f; tab[2 * idx + 1] = rb; }
    }
    __device__ __forceinline__ void mid(f32x4 (&acc)[2][2][4][2], const Unit& u, int wr, int wc, int fr, int fq) const {
        const int wid = wr * 4 + wc; const PG8_LAS float* tab = (const PG8_LAS float*)(xlds + wid * 1024);
#pragma unroll
        for (int ai = 0; ai < 2; ++ai)
#pragma unroll
            for (int m = 0; m < 4; ++m) {
                const float f = tab[2 * (ai * 64 + m * 16 + fr)];
#pragma unroll
                for (int bj = 0; bj < 2; ++bj)
#pragma unroll
                    for (int n = 0; n < 2; ++n) acc[ai][bj][m][n] *= f;
            }
    }
    __device__ __forceinline__ void operator()(const f32x4 (&acc)[2][2][4][2], const Unit& u, int wr, int wc, int fr, int fq) const {
        const PG8_LAS float* tab = (const PG8_LAS float*)(xlds + (wr * 4 + wc) * 1024);
        EPI_MAIN_LOOP(resid_row(a_, row, tab[2 * (ai * 64 + m * 16 + fr) + 1], u.pn, wc, fr, fq))
    }
    __device__ __forceinline__ void mid_row(f32x4 (&a)[2][2], int row) const { float f, rb; two_scales((size_t)(FRONT + row), f, rb);
#pragma unroll
        for (int bj = 0; bj < 2; ++bj)
#pragma unroll
            for (int n = 0; n < 2; ++n) a[bj][n] *= f; }
    __device__ __forceinline__ void row_epi(const f32x4 (&a)[2][2], int row, int pn, int wc, int fr, int fq) const { float f, rb; two_scales((size_t)(FRONT + row), f, rb); resid_row(a, row, rb, pn, wc, fr, fq); }
};
template <bool META> struct EpiDown : EpiResid {
    static constexpr bool MIDSCALE = false;
    __device__ __forceinline__ void mid(f32x4 (&)[2][2][4][2], const Unit&, int, int, int, int) const {}
    __device__ __forceinline__ void row_epi(const f32x4 (&a)[2][2], int row, int pn, int wc, int fr, int fq) const { resid_row(a, row, 1.0f, pn, wc, fr, fq); }
    __device__ __forceinline__ void operator()(const f32x4 (&acc)[2][2][4][2], const Unit& u, int wr, int wc, int fr, int fq) const { EPI_MAIN_LOOP(resid_row(a_, row, 1.0f, u.pn, wc, fr, fq)) }
};

template <bool META> struct EpiGU {
    static constexpr bool PERM = true, AFTER_DRAIN = false, MIDSCALE = false;
    const float* hss; bf16_t* act;
    __device__ __forceinline__ void mid(f32x4 (&)[2][2][4][2], const Unit&, int, int, int, int) const {}
    __device__ __forceinline__ void row_epi(const f32x4 (&a)[2][2], int row, int pn, int wc, int fr, int fq) const {
        const float rs = rsq(sum16q(hss, row, fq) * (1.0f / DM) + RMS_EPS); f32x4 o[2];
#pragma unroll
        for (int n = 0; n < 2; ++n) { const f32x4 g = a[0][n] * rs, up = a[1][n] * rs;
#pragma unroll
            for (int e = 0; e < 4; ++e) o[n][e] = g[e] * up[e] * __builtin_amdgcn_rcpf(1.0f + __builtin_amdgcn_exp2f(-g[e] * LOG2E)); }
        st_bf16x8(act + (size_t)row * DFF + 128 * pn + 32 * wc + 8 * fq, o[0], o[1]);
    }
    __device__ __forceinline__ void operator()(const f32x4 (&acc)[2][2][4][2], const Unit& u, int wr, int wc, int fr, int fq) const { EPI_MAIN_LOOP(row_epi(a_, row, u.pn, wc, fr, fq)) }
};

template <int K, class Epi>
__device__ __forceinline__ void skinny_phase(PG8_LAS unsigned char* lds, const bf16_t* A16, const bf16_t* Bt, int NN, const Epi& E, int wg0) {
    int tid_ = threadIdx.x; asm volatile("" : "+v"(tid_));
    const int tid = tid_, lane = tid & 63, wid = __builtin_amdgcn_readfirstlane(tid >> 6), fr = lane & 15, fq = lane >> 4;
    constexpr int nk = K / 32, NJ = (nk + 7) / 8;
    const int G = (int)gridDim.x; int first = (int)blockIdx.x - wg0; if (first < 0) first += G;
    for (int task = first; task < 4 * NN; task += G) {
        const int pn = task >> 2, wc = task & 3;
        f32x4 a[2][2];
#pragma unroll
        for (int bj = 0; bj < 2; ++bj)
#pragma unroll
            for (int n = 0; n < 2; ++n) a[bj][n] = (f32x4){0.f, 0.f, 0.f, 0.f};
        bool scaled = false;
        const bf16_t* ap = A16 + (size_t)fr * K + 8 * fq;
        const bf16_t* bp = Bt + (size_t)(256 * pn + 32 * wc + 8 * (fr >> 2) + (fr & 3)) * K + 8 * fq;
#pragma unroll 4
        for (int j = 0; j < NJ; ++j) {
            const int it = wid + 8 * j; if (it >= nk) break;
            const int k0 = 32 * it;
            if constexpr (Epi::MIDSCALE) { if (!scaled && k0 >= (K >> 1)) { E.mid_row(a, fr); scaled = true; } }
            const bf16x8 av = *(const PG8_GAS bf16x8*)(ap + k0);
#pragma unroll
            for (int bj = 0; bj < 2; ++bj)
#pragma unroll
                for (int n = 0; n < 2; ++n) { const bf16x8 bv = *(const PG8_GAS bf16x8*)(bp + (size_t)(128 * bj + 4 * n) * K + k0);
                    a[bj][n] = __builtin_amdgcn_mfma_f32_16x16x32_bf16(bv, av, a[bj][n], 0, 0, 0); }
        }
        if constexpr (Epi::MIDSCALE) { if (!scaled) E.mid_row(a, fr); }
        PG8_LAS f32x4* red = (PG8_LAS f32x4*)lds;
#pragma unroll
        for (int bj = 0; bj < 2; ++bj)
#pragma unroll
            for (int n = 0; n < 2; ++n) red[(wid * 64 + lane) * 4 + bj * 2 + n] = a[bj][n];
        __syncthreads();
        if (wid == 0) {
#pragma unroll
            for (int w = 1; w < 8; ++w)
#pragma unroll
                for (int bj = 0; bj < 2; ++bj)
#pragma unroll
                    for (int n = 0; n < 2; ++n) a[bj][n] += red[(w * 64 + lane) * 4 + bj * 2 + n];
            E.row_epi(a, fr, pn, wc, fr, fq);
        }
        __syncthreads();
    }
}
template <class Epi, class Sched, bool ALIGN_EPI = false, bool SP2 = false>
__device__ __forceinline__ void gemm_phase(PG8_LAS unsigned char* lds, const Gemm g, const Sched& S, const Epi& E) {
    int tid_ = threadIdx.x; asm volatile("" : "+v"(tid_));
    const int tid = tid_, wid = __builtin_amdgcn_readfirstlane(tid >> 6), lane = tid & 63, wr = wid >> 2, wc = wid & 3, fr = lane & 15, fq = lane >> 4;
    int K_ = g.K; asm volatile("" : "+s"(K_)); const int K = K_, nt = K / BK;
    unsigned voffA[2], voffB[2];
#pragma unroll
    for (int i = 0; i < 2; ++i) { int R, C; stage_rc(tid * 16 + i * 8192, R, C); const int Rb = Epi::PERM ? ((R & ~31) + perm32(R & 31)) : R;
        voffA[i] = (unsigned)(R * K + C) * 2u; voffB[i] = (unsigned)(Rb * K + C) * 2u; }
    const size_t kstep = (size_t)(BK * 2);
    const size_t hstep = (size_t)HALF * K * 2;
    const size_t tstep = 2 * hstep;
    const unsigned ldsw = (unsigned)wid * 1024u;
    const int aoff = lds_byte(wr * 64 + fr, fq * 8), boff = lds_byte(wc * 32 + fr, fq * 8);
#define PG8_SA(b, h) (((b) * 2 + (h)) * HTB)
#define PG8_SB(b, h) ((4 + (b) * 2 + (h)) * HTB)
#define PG8_STAGE(bufoff, gbase, voff) do { _Pragma("unroll") for (int _i = 0; _i < 2; ++_i) \
        __builtin_amdgcn_global_load_lds((const unsigned*)((const char*)(gbase) + (voff)[_i]), (PG8_LAS unsigned*)(lds + (bufoff) + ldsw + _i * 8192), 16, 0, 0); } while (0)
#define PG8_LDA(dst, b, h) do { _Pragma("unroll") for (int m = 0; m < 4; ++m) _Pragma("unroll") for (int k = 0; k < 2; ++k) dst[m][k] = *(const PG8_LAS bf16x8*)(lds + PG8_SA(b, h) + aoff + m * 2048 + k * 1024); } while (0)
#define PG8_LDB(dst, b, h) do { _Pragma("unroll") for (int n = 0; n < 2; ++n) _Pragma("unroll") for (int k = 0; k < 2; ++k) dst[n][k] = *(const PG8_LAS bf16x8*)(lds + PG8_SB(b, h) + boff + n * 2048 + k * 1024); } while (0)
#define PG8_MMA(ai, bj, At, Bt) do { __builtin_amdgcn_s_setprio(1); _Pragma("unroll") for (int m = 0; m < 4; ++m) _Pragma("unroll") for (int n = 0; n < 2; ++n) _Pragma("unroll") for (int k = 0; k < 2; ++k) \
        acc[ai][bj][m][n] = __builtin_amdgcn_mfma_f32_16x16x32_bf16(Bt[n][k], At[m][k], acc[ai][bj][m][n], 0, 0, 0); __builtin_amdgcn_s_setprio(0); } while (0)
#define PG8_WAIT_V(n) asm volatile("s_waitcnt vmcnt(" #n ")" ::: "memory")
#define PG8_WAIT_L(n) asm volatile("s_waitcnt lgkmcnt(" #n ")" ::: "memory")
#define PG8_BAR __builtin_amdgcn_s_barrier()
#define PG8_SCHED __builtin_amdgcn_sched_barrier(0)
    Unit cur, nxt; int ui = 0;
    if (!S.next(0, cur)) return;
    f32x4 acc[2][2][4][2];
#pragma unroll
    for (int a = 0; a < 2; ++a)
#pragma unroll
        for (int b = 0; b < 2; ++b)
#pragma unroll
            for (int m = 0; m < 4; ++m)
#pragma unroll
                for (int n = 0; n < 2; ++n) acc[a][b][m][n] = (f32x4){0.f, 0.f, 0.f, 0.f};
    bf16x8 At[4][2], B0[2][2], B1[2][2];
    const char* cA = (const char*)g.A + (size_t)cur.pm * tstep + (g.apad ? (size_t)((cur.pm >> 4) * 128 + 128) * (size_t)K * 2 : (size_t)0); const char* cB = (const char*)g.Bt + (size_t)cur.pn * tstep;
    S.a_ready(cur);
    if constexpr (SP2) {
        PG8_STAGE(PG8_SB(0, 0), cB, voffB); PG8_STAGE(PG8_SB(0, 1), cB + hstep, voffB); PG8_STAGE(PG8_SA(0, 0), cA, voffA); PG8_STAGE(PG8_SA(0, 1), cA + hstep, voffA);
        if (wr == 1) PG8_BAR;
        PG8_WAIT_V(2); PG8_BAR;
        PG8_STAGE(PG8_SB(1, 0), cB + kstep, voffB); PG8_STAGE(PG8_SA(1, 0), cA + kstep, voffA); PG8_STAGE(PG8_SB(1, 1), cB + hstep + kstep, voffB);
        PG8_WAIT_V(6); PG8_BAR;
    } else {
        PG8_STAGE(PG8_SB(0, 0), cB, voffB); PG8_STAGE(PG8_SA(0, 0), cA, voffA); PG8_STAGE(PG8_SB(0, 1), cB + hstep, voffB); PG8_STAGE(PG8_SA(0, 1), cA + hstep, voffA);
        if (wr == 1) PG8_BAR;
        PG8_WAIT_V(4); PG8_BAR;
        PG8_STAGE(PG8_SB(1, 0), cB + kstep, voffB); PG8_STAGE(PG8_SA(1, 0), cA + kstep, voffA); PG8_STAGE(PG8_SB(1, 1), cB + hstep + kstep, voffB);
        PG8_WAIT_V(6); PG8_BAR;
    }
    for (;;) {
        const bool has_next = S.next(ui + 1, nxt);
        if constexpr (Epi::MIDSCALE) E.prep(cur, wid, wr, lane);
        const char* nA = has_next ? (const char*)g.A + (size_t)nxt.pm * tstep + (g.apad ? (size_t)((nxt.pm >> 4) * 128 + 128) * (size_t)K * 2 : (size_t)0) : cA; const char* nB = has_next ? (const char*)g.Bt + (size_t)nxt.pn * tstep : cB;
        for (int t = 0; t < nt; t += 2) {
            const bool last = (t == nt - 2);
            if constexpr (Epi::MIDSCALE) { if (t == (nt >> 1)) E.mid(acc, cur, wr, wc, fr, fq); }
            const char* a1 = cA + (size_t)(t + 1) * kstep;
            const char* a2 = last ? nA : cA + (size_t)(t + 2) * kstep; const char* b2 = last ? nB : cB + (size_t)(t + 2) * kstep;
            const char* a3 = a2 + kstep; const char* b3 = b2 + kstep;
            if (last && has_next) S.a_ready(nxt);
            if constexpr (SP2) {
            PG8_LDB(B0, 0, 0); PG8_LDB(B1, 0, 1); PG8_SCHED; PG8_LDA(At, 0, 0); PG8_STAGE(PG8_SA(1, 1), a1 + hstep, voffA);
            PG8_WAIT_V(8); PG8_WAIT_L(0); PG8_BAR; PG8_MMA(0, 0, At, B0); PG8_MMA(0, 1, At, B1); PG8_BAR; PG8_SCHED;
            PG8_LDA(At, 0, 1); PG8_STAGE(PG8_SB(0, 0), b2, voffB); PG8_STAGE(PG8_SB(0, 1), b2 + hstep, voffB); PG8_STAGE(PG8_SA(0, 0), a2, voffA);
            PG8_WAIT_V(8); PG8_WAIT_L(0); PG8_BAR; PG8_MMA(1, 0, At, B0); PG8_MMA(1, 1, At, B1); PG8_BAR; PG8_SCHED;
            PG8_LDB(B0, 1, 0); PG8_LDB(B1, 1, 1); PG8_SCHED; PG8_LDA(At, 1, 0); PG8_STAGE(PG8_SA(0, 1), a2 + hstep, voffA);
            PG8_WAIT_V(8); PG8_WAIT_L(0); PG8_BAR; PG8_MMA(0, 0, At, B0); PG8_MMA(0, 1, At, B1); PG8_BAR; PG8_SCHED;
            PG8_LDA(At, 1, 1); PG8_STAGE(PG8_SB(1, 0), b3, voffB); PG8_STAGE(PG8_SB(1, 1), b3 + hstep, voffB); PG8_STAGE(PG8_SA(1, 0), a3, voffA);
            PG8_WAIT_V(8); PG8_WAIT_L(0); PG8_BAR; PG8_MMA(1, 0, At, B0); PG8_MMA(1, 1, At, B1); PG8_BAR; PG8_SCHED;
            } else {
            PG8_LDB(B0, 0, 0); PG8_SCHED; PG8_LDA(At, 0, 0); PG8_STAGE(PG8_SA(1, 1), a1 + hstep, voffA);
            PG8_WAIT_L(8); PG8_BAR; PG8_WAIT_L(0); PG8_MMA(0, 0, At, B0); PG8_BAR; PG8_SCHED;
            PG8_LDB(B1, 0, 1); PG8_STAGE(PG8_SB(0, 0), b2, voffB);
            PG8_BAR; PG8_WAIT_L(0); PG8_MMA(0, 1, At, B1); PG8_BAR;
            PG8_LDA(At, 0, 1); PG8_STAGE(PG8_SA(0, 0), a2, voffA);
            PG8_BAR; PG8_WAIT_L(0); PG8_MMA(1, 0, At, B0); PG8_BAR; PG8_SCHED;
            PG8_STAGE(PG8_SB(0, 1), b2 + hstep, voffB);
            PG8_WAIT_V(6); PG8_BAR; PG8_MMA(1, 1, At, B1); PG8_BAR;
            PG8_LDB(B0, 1, 0); PG8_SCHED; PG8_LDA(At, 1, 0); PG8_STAGE(PG8_SA(0, 1), a2 + hstep, voffA);
            PG8_WAIT_L(8); PG8_BAR; PG8_WAIT_L(0); PG8_MMA(0, 0, At, B0); PG8_BAR; PG8_SCHED;
            PG8_LDB(B1, 1, 1); PG8_STAGE(PG8_SB(1, 0), b3, voffB);
            PG8_BAR; PG8_WAIT_L(0); PG8_MMA(0, 1, At, B1); PG8_BAR;
            PG8_LDA(At, 1, 1); PG8_STAGE(PG8_SA(1, 0), a3, voffA);
            PG8_BAR; PG8_WAIT_L(0); PG8_MMA(1, 0, At, B0); PG8_BAR; PG8_SCHED;
            PG8_STAGE(PG8_SB(1, 1), b3 + hstep, voffB);
            PG8_WAIT_V(6); PG8_BAR; PG8_MMA(1, 1, At, B1); PG8_BAR;
            }
        }
        if constexpr (ALIGN_EPI) { if (wr == 0) PG8_BAR; }
        if constexpr (!Epi::AFTER_DRAIN) { E(acc, cur, wr, wc, fr, fq); S.done(cur); }
        if (!has_next) break;
#pragma unroll
        for (int a = 0; a < 2; ++a)
#pragma unroll
            for (int b = 0; b < 2; ++b)
#pragma unroll
                for (int m = 0; m < 4; ++m)
#pragma unroll
                    for (int n = 0; n < 2; ++n) acc[a][b][m][n] = (f32x4){0.f, 0.f, 0.f, 0.f};
        cur = nxt; cA = nA; cB = nB; ++ui;
        if constexpr (ALIGN_EPI) { if (wr == 1) PG8_BAR; }
    }
    PG8_WAIT_V(0);
    if constexpr (!ALIGN_EPI) { if (wr == 0) PG8_BAR; }
    PG8_BAR;
    if constexpr (Epi::AFTER_DRAIN) { E.fused(acc, cur, wr, wc, fr, fq, lds, wid, lane); S.done(cur); }
#undef PG8_SA
#undef PG8_SB
#undef PG8_STAGE
#undef PG8_LDA
#undef PG8_LDB
#undef PG8_MMA
#undef PG8_WAIT_V
#undef PG8_WAIT_L
#undef PG8_BAR
#undef PG8_SCHED
}
}
namespace att {
#define ALAS __attribute__((address_space(3)))
#define AGAS __attribute__((address_space(1)))
typedef unsigned short bf16_t;
typedef short bf16x8 __attribute__((ext_vector_type(8)));
typedef short s16x4 __attribute__((ext_vector_type(4)));
typedef float f32x16 __attribute__((ext_vector_type(16)));
typedef unsigned u32x4 __attribute__((ext_vector_type(4)));
typedef float f32x2_t __attribute__((ext_vector_type(2))); typedef __bf16 bf16x2_t __attribute__((ext_vector_type(2)));
constexpr int KPMAX = 208, VP = 192, KSZ = 64 * KPMAX, VSZ = 64 * VP;
constexpr int OFF_V = 2 * KSZ, OFF_SCR = OFF_V + 2 * VSZ, OFF_Q = OFF_SCR + 8 * 256, LDS_BYTES = OFF_Q + 64;
constexpr float NEGF = -1e30f, THR = 6.0f;
__device__ __forceinline__ int crow(int r, int hi) { return (r & 3) + 8 * (r >> 2) + 4 * hi; }
__device__ __forceinline__ unsigned cvtpk(float lo, float hi) { f32x2_t v = {lo, hi}; bf16x2_t b = __builtin_convertvector(v, bf16x2_t); return __builtin_bit_cast(unsigned, b); }
__device__ __forceinline__ bf16x8 pack8(const f32x16& p, int s) { u32x4 w; w.x = cvtpk(p[8 * s], p[8 * s + 1]); w.y = cvtpk(p[8 * s + 2], p[8 * s + 3]); w.z = cvtpk(p[8 * s + 4], p[8 * s + 5]); w.w = cvtpk(p[8 * s + 6], p[8 * s + 7]); return __builtin_bit_cast(bf16x8, w); }
typedef short v4i16_t __attribute__((ext_vector_type(4)));
__device__ __forceinline__ float max3f(float a, float b, float c) { float r; asm("v_max3_f32 %0, %1, %2, %3" : "=v"(r) : "v"(a), "v"(b), "v"(c)); return r; }
__device__ __forceinline__ float max2f(float a, float b) { float r; asm("v_max_f32_e32 %0, %1, %2" : "=v"(r) : "v"(a), "v"(b)); return r; }
__device__ __forceinline__ float xhalf_max(float m) { auto rr = __builtin_amdgcn_permlane32_swap(__float_as_uint(m), __float_as_uint(m), false, false); return max2f(__uint_as_float(rr[0]), __uint_as_float(rr[1])); }
__device__ __forceinline__ s16x4 vtr(const ALAS unsigned char* p) { return __builtin_bit_cast(s16x4, __builtin_amdgcn_ds_read_tr16_b64_v4i16((ALAS v4i16_t*)p)); }
__device__ __forceinline__ unsigned short f2bf(float f) { unsigned u = __builtin_bit_cast(unsigned, f); return (unsigned short)((u + 0x7fffu + ((u >> 16) & 1u)) >> 16); }

template <int DQK, bool SWA>
__device__ __forceinline__ void attn_unit(ALAS unsigned char* lds, const bf16_t* Qp, int qpitch, const bf16_t* Kp, int kpitch, const bf16_t* Krp, const bf16_t* Vp, int vpitch,
                                          bf16_t* Op, float* ssq, float sink2, int b, int qb) {
    constexpr int KP = DQK * 2 + 16, NS = DQK / 16;
    int tid_ = threadIdx.x; asm volatile("" : "+v"(tid_));
    const int tid = tid_, lane = tid & 63, wid = __builtin_amdgcn_readfirstlane(tid >> 6), r = lane & 31, h = lane >> 5;
    const size_t rowbase = (size_t)b * TT;
    const int q0 = qb * 256, q0w = q0 + wid * 32;
    const bool wave_valid = q0w < TT;
    const int NT = (q0 + 256) / 64 < TT / 64 ? (q0 + 256) / 64 : TT / 64;
    int t0 = 1; if (SWA) { t0 = (q0 - 128) / 64; if (t0 < 1) t0 = 1; }
    ALAS float* scr = (ALAS float*)(lds + OFF_SCR + wid * 256);
    bf16x8 qf[NS];
    { const int qr = (q0w + r) < TT ? (q0w + r) : TT - 1; const bf16_t* qrow = Qp + (rowbase + qr) * (size_t)qpitch;
#pragma unroll
      for (int s = 0; s < NS; ++s) qf[s] = *(const AGAS bf16x8*)(qrow + 16 * s + 8 * h); }
    const int srow = tid >> 3, sch = tid & 7, rrow = (tid >> 2) & 63, rch = tid & 3;
    u32x4 kregA, vregA, rregA = {0u, 0u, 0u, 0u}, kregB, vregB, rregB = {0u, 0u, 0u, 0u};
#define AT_GLOAD(t, S) do { const size_t kr_ = rowbase + 64 * (t) + srow; kreg##S = *(const AGAS u32x4*)(Kp + kr_ * (size_t)kpitch + sch * 8); vreg##S = *(const AGAS u32x4*)(Vp + kr_ * (size_t)vpitch + sch * 8); \
        if (DQK == 96) { if (tid < 256) rreg##S = *(const AGAS u32x4*)(Krp + (rowbase + 64 * (t) + rrow) * 32 + rch * 8); } } while (0)
#define AT_LSTORE(buf, S) do { *(ALAS u32x4*)(lds + (buf) * KSZ + srow * KP + sch * 16) = kreg##S; *(ALAS u32x4*)(lds + OFF_V + (buf) * VSZ + srow * VP + sch * 16) = vreg##S; \
        if (DQK == 96) { if (tid < 256) *(ALAS u32x4*)(lds + (buf) * KSZ + rrow * KP + 128 + rch * 16) = rreg##S; } } while (0)
    AT_GLOAD(t0, A); AT_LSTORE(0, A);
    if (t0 + 1 < NT) AT_GLOAD(t0 + 1, A);
    __syncthreads();
    if (wid >= 4) __builtin_amdgcn_s_setprio(1);
    float mrun = SWA ? sink2 : 0.0f, lrun = (SWA && h == 0) ? 1.0f : 0.0f;
    bool first_ = !SWA;
    f32x16 negm;
#pragma unroll
    for (int i = 0; i < 16; ++i) negm[i] = -mrun;
    f32x16 o0, o1;
#pragma unroll
    for (int i = 0; i < 16; ++i) { o0[i] = 0.f; o1[i] = 0.f; }
    const int q = q0w + r;
#define AT_PVF(P, j) do { o0 = __builtin_amdgcn_mfma_f32_32x32x16_bf16(P, __builtin_shufflevector(vlo[2 * (j)], vhi[2 * (j)], 0, 1, 2, 3, 4, 5, 6, 7), o0, 0, 0, 0); o1 = __builtin_amdgcn_mfma_f32_32x32x16_bf16(P, __builtin_shufflevector(vlo[2 * (j) + 1], vhi[2 * (j) + 1], 0, 1, 2, 3, 4, 5, 6, 7), o1, 0, 0, 0); } while (0)
#define AT_PV(P, rowoff) do { \
                { const s16x4 lo = vtr(vb_ + (rowoff) * VP), hi = vtr(vb_ + ((rowoff) + 8) * VP); const bf16x8 vf = __builtin_shufflevector(lo, hi, 0, 1, 2, 3, 4, 5, 6, 7); o0 = __builtin_amdgcn_mfma_f32_32x32x16_bf16(P, vf, o0, 0, 0, 0); } \
                { const s16x4 lo = vtr(vb_ + (rowoff) * VP + 64), hi = vtr(vb_ + ((rowoff) + 8) * VP + 64); const bf16x8 vf = __builtin_shufflevector(lo, hi, 0, 1, 2, 3, 4, 5, 6, 7); o1 = __builtin_amdgcn_mfma_f32_32x32x16_bf16(P, vf, o1, 0, 0, 0); } } while (0)
#define AT_STEP(t, LS, SS) do { \
        const int buf = (t - t0) & 1; \
        if (t + 2 < NT) AT_GLOAD(t + 2, LS); \
        const int kfirst = 64 * t; \
        bool active = wave_valid && (kfirst <= q0w + 31); \
        if (SWA) active = active && (kfirst + 63 >= q0w - 127); \
        if (active) { \
            f32x16 s0, s1; \
            const ALAS unsigned char* kb = lds + buf * KSZ + r * KP + h * 16; \
            bf16x8 kf[2 * NS]; \
_Pragma("unroll") \
            for (int s = 0; s < NS; ++s) { kf[2 * s] = *(const ALAS bf16x8*)(kb + s * 32); kf[2 * s + 1] = *(const ALAS bf16x8*)(kb + 32 * KP + s * 32); } \
            __builtin_amdgcn_sched_barrier(0); \
_Pragma("unroll") \
            for (int s = 0; s < NS; ++s) { if (s == 0) { s0 = __builtin_amdgcn_mfma_f32_32x32x16_bf16(kf[0], qf[0], negm, 0, 0, 0); s1 = __builtin_amdgcn_mfma_f32_32x32x16_bf16(kf[1], qf[0], negm, 0, 0, 0); } else { s0 = __builtin_amdgcn_mfma_f32_32x32x16_bf16(kf[2 * s], qf[s], s0, 0, 0, 0); s1 = __builtin_amdgcn_mfma_f32_32x32x16_bf16(kf[2 * s + 1], qf[s], s1, 0, 0, 0); } } \
            __builtin_amdgcn_sched_barrier(0); \
            const ALAS unsigned char* vb_ = lds + OFF_V + buf * VSZ + (4 * h + ((lane & 15) >> 2)) * VP + ((lane >> 4) & 1) * 32 + (lane & 3) * 8; \
            s16x4 vlo[8], vhi[8]; \
_Pragma("unroll") \
            for (int j = 0; j < 4; ++j) { vlo[2 * j] = vtr(vb_ + (16 * j) * VP); vhi[2 * j] = vtr(vb_ + (16 * j + 8) * VP); vlo[2 * j + 1] = vtr(vb_ + (16 * j) * VP + 64); vhi[2 * j + 1] = vtr(vb_ + (16 * j + 8) * VP + 64); } \
            __builtin_amdgcn_sched_barrier(0); \
            const bool need_mask = SWA || (t == 1) || (kfirst + 63 > q0w); \
            if (need_mask) { \
_Pragma("unroll") \
                for (int i = 0; i < 16; ++i) { const int key = kfirst + crow(i, h), key1 = key + 32; \
                    bool ok0 = (key <= q) && (key >= FRONT), ok1 = (key1 <= q) && (key1 >= FRONT); \
                    if (SWA) { ok0 = ok0 && (q - key < 128); ok1 = ok1 && (q - key1 < 128); } \
                    s0[i] = ok0 ? s0[i] : NEGF; s1[i] = ok1 ? s1[i] : NEGF; } \
            } \
            float rm = max3f(s0[0], s0[1], s1[0]), rm2 = max3f(s0[2], s0[3], s1[1]); rm = max3f(rm, s1[2], s1[3]); \
_Pragma("unroll") \
            for (int i = 4; i < 16; i += 4) { rm = max3f(rm, s0[i], s0[i + 1]); rm2 = max3f(rm2, s0[i + 2], s0[i + 3]); rm = max3f(rm, s1[i], s1[i + 1]); rm2 = max3f(rm2, s1[i + 2], s1[i + 3]); } \
            rm = xhalf_max(max2f(rm, rm2)); \
            if (first_ || __any(rm > THR)) { \
                const float dl = first_ ? (rm > -1e29f ? rm : 0.f) : max2f(rm, 0.f); first_ = false; \
                mrun += dl; const float f = __builtin_amdgcn_exp2f(-dl); lrun *= f; \
_Pragma("unroll") \
                for (int i = 0; i < 16; ++i) { s0[i] -= dl; s1[i] -= dl; negm[i] = -mrun; } \
                if (h == 0) scr[r] = f; \
_Pragma("unroll") \
                for (int i = 0; i < 16; ++i) { const float fi = scr[crow(i, h)]; o0[i] *= fi; o1[i] *= fi; } \
            } \
            float ls = 0.f; \
_Pragma("unroll") \
            for (int i = 0; i < 16; ++i) { s0[i] = __builtin_amdgcn_exp2f(s0[i]); s1[i] = __builtin_amdgcn_exp2f(s1[i]); ls += s0[i] + s1[i]; } \
            lrun += ls; \
            const bf16x8 p0 = pack8(s0, 0), p1 = pack8(s0, 1), p2 = pack8(s1, 0), p3 = pack8(s1, 1); \
            __builtin_amdgcn_sched_barrier(0); \
            AT_PVF(p0, 0); AT_PVF(p1, 1); AT_PVF(p2, 2); AT_PVF(p3, 3); \
        } \
        if (t + 1 < NT) AT_LSTORE(buf ^ 1, SS); \
        __syncthreads(); \
    } while (0)
    {
        int t = t0;
        for (; t + 1 < NT; t += 2) { AT_STEP(t, B, A); const int t1 = t + 1; AT_STEP(t1, A, B); }
        if (t < NT) AT_STEP(t, B, A);
    }
#undef AT_STEP
#undef AT_PV
#undef AT_GLOAD
#undef AT_LSTORE
    __builtin_amdgcn_s_setprio(0);
    if (wave_valid) {
        const float lt = lrun + __shfl_xor(lrun, 32);
        if (h == 0) scr[32 + r] = lt;
        ALAS bf16_t* stg = (ALAS bf16_t*)(lds + wid * 4096);
#pragma unroll
        for (int i = 0; i < 16; ++i) {
            const float li = scr[32 + crow(i, h)], inv = li > 0.f ? 1.0f / li : 0.f;
            const int orow = crow(i, h);
            stg[orow * 64 + r] = f2bf(o0[i] * inv); stg[orow * 64 + 32 + r] = f2bf(o1[i] * inv);
        }
#pragma unroll
        for (int i = 0; i < 4; ++i) {
            const int lrow = i * 8 + (lane >> 3), ch = lane & 7; const u32x4 v = *(const ALAS u32x4*)(stg + lrow * 64 + ch * 8);
            const size_t row = rowbase + q0w + lrow;
            *(AGAS u32x4*)(Op + row * 1024 + ch * 8) = v;
            float ss = 0.f;
#pragma unroll
            for (int j = 0; j < 4; ++j) { const unsigned w = v[j]; const float lo = __builtin_bit_cast(float, w << 16), hi = __builtin_bit_cast(float, w & 0xffff0000u); ss += lo * lo + hi * hi; }
            ss += __shfl_xor(ss, 1); ss += __shfl_xor(ss, 2); ss += __shfl_xor(ss, 4);
            if (ch == 0) ((AGAS float*)ssq)[row * 16] = ss;
        }
    }
    __syncthreads();
}
}
typedef unsigned short bf16;
#define LAS __attribute__((address_space(3)))
#define GAS __attribute__((address_space(1)))
constexpr size_t MiB = 1u << 20;
constexpr int NWAVES = 8, NTHREADS = 512;
constexpr int LDS_BYTES = 147456;
static_assert(att::LDS_BYTES <= 131072, "attention LDS");
constexpr size_t WS_CTL = 0, CTL_BYTES = 65536;
constexpr size_t WS_H = 1 * MiB;
constexpr size_t WS_HB = WS_H + (size_t)MROWS * DM * 4;
constexpr size_t WS_W = WS_HB + (size_t)MROWS * DM * 2;
constexpr size_t WL_IN = 0, WL_Q = WL_IN + (size_t)INP * DM * 2, WL_KV = WL_Q + (size_t)768 * 256 * 2, WL_O = WL_KV + (size_t)1024 * 128 * 2,
                 WL_GU = WL_O + (size_t)DM * DM * 2, WL_D = WL_GU + (size_t)GUP * DM * 2, WL_END = WL_D + (size_t)DM * DFF * 2;
constexpr size_t WBUF = 22 * MiB;
static_assert(WL_END <= WBUF, "weight buffer");
constexpr size_t WS_PART = WS_W + 2 * WBUF;
constexpr size_t P_HSSA = 0, P_HSSB = P_HSSA + (size_t)MROWS * 64, P_SSQO = P_HSSB + (size_t)MROWS * 64, P_SSQQ = P_SSQO + (size_t)MROWS * 64, P_SSQKV = P_SSQQ + (size_t)MROWS * 16, P_END = P_SSQKV + (size_t)MROWS * 16;
constexpr size_t PM_H = (P_END + 255) & ~(size_t)255, PM_HB = PM_H + 16 * DM * 4, PM_HSSA = PM_HB + 16 * DM * 2, PM_HSSB = PM_HSSA + 1024, PM_SSQQ = PM_HSSB + 1024, PM_SSQKV = PM_SSQQ + 256,
                 PM_QLAT = PM_SSQKV + 256, PM_KVLAT = PM_QLAT + 16 * 256 * 2, PM_ACT = PM_KVLAT + 16 * 128 * 2, PM_END = PM_ACT + 16 * DFF * 2;
static_assert(PM_END <= 8 * MiB, "partials");
constexpr int MC = BATCH * SEQ;
constexpr size_t WS_R = WS_PART + 8 * MiB;
constexpr size_t R_QA = 0, R_KA = R_QA + (size_t)MROWS * 512 * 2, R_VA = R_KA + (size_t)MROWS * 128 * 2, R_QLAT = R_VA + (size_t)MROWS * 128 * 2, R_KVLAT = R_QLAT + (size_t)MROWS * 256 * 2,
                 R_KR = R_KVLAT + (size_t)MROWS * 128 * 2, R_QM = R_KR + (size_t)MROWS * 32 * 2, R_KN = R_QM + (size_t)MROWS * 768 * 2, R_VB = R_KN + (size_t)MROWS * 512 * 2,
                 R_O = R_VB + (size_t)MROWS * 512 * 2, R_END = R_O + (size_t)MROWS * 1024 * 2;
constexpr size_t R_ACT = 0;
static_assert((size_t)MROWS * DFF * 2 <= R_END, "act overlay");
constexpr size_t WS_END = WS_R + R_END;
static_assert(WS_END <= 512 * MiB, "workspace must fit 512 MiB");

struct Args {
    const float *x, *meta, *attn_norm, *w_in, *q_norm, *w_q_up, *kv_norm, *w_kv_up, *sinks, *out_norm_swa, *out_norm_mla, *w_o, *ffn_norm, *w_gate, *w_up, *w_down, *final_norm;
    float* out; unsigned char* ws; int ph_lo, ph_hi;
};

__device__ __forceinline__ unsigned f2bf_u(float f) { unsigned u = __builtin_bit_cast(unsigned, f); return (u + 0x7fffu + ((u >> 16) & 1u)) >> 16; }
__device__ __forceinline__ unsigned pk2(float lo, float hi) { return f2bf_u(lo) | (f2bf_u(hi) << 16); }
__device__ __forceinline__ float wave_sum(float v) {
#pragma unroll
    for (int o = 1; o < 64; o <<= 1) v += __shfl_xor(v, o);
    return v;
}

__device__ __forceinline__ int src_in(int np) { const int pn = np >> 8, bj = (np >> 7) & 1, o = np & 127;
    if (pn < 2) return (4 * pn + (o >> 5)) * 64 + (o & 31) + 32 * bj;
    if (pn == 2) { if (o < 64) return 512 + (o >> 5) * 64 + (o & 31) + 32 * bj; if (o < 80) return 1152 + (o - 64) + 16 * bj; return -1; }
    if (pn == 3) return bj ? 1024 + o : 640 + o;
    return 768 + 128 * bj + o; }
__device__ __forceinline__ int src_qup(int np) { const int pn = np >> 8, op = np & 255;
    if (pn < 2) return (4 * pn + (op >> 6)) * 96 + (op & 63);
    const int bj = op >> 7, o = op & 127; return (o >> 4) * 96 + 64 + (o & 15) + 16 * bj; }
__device__ __forceinline__ int src_kvup(int np) { const int pn = np >> 8, op = np & 255; return (4 * (pn & 1) + (op >> 6)) * 128 + (pn >= 2 ? 64 : 0) + (op & 63); }

template <int MODE>
__device__ __forceinline__ void conv_item(const float* W, const float* W2, const float* gain, const float* gain2, int K, int Nsrc, bf16* WT, LAS float* scr, int item, int nblk, int lane) {
    const int kb = item / nblk, nb = item % nblk, k0 = 64 * kb, n0 = 32 * nb;
    const int nn = 4 * (lane & 7), np = n0 + nn;
    int src; float cs = 1.0f; const float* Wp = W;
    if (MODE == 0) { src = src_in(np); if (np < 512) cs = 0.125f * LOG2E; }
    else if (MODE == 1) { src = src_qup(np); cs = 0.10206207261596577f * LOG2E; }
    else if (MODE == 2) src = src_kvup(np);
    else if (MODE == 4) { src = 128 * (np >> 8) + (np & 127); if ((np >> 7) & 1) Wp = W2; }
    else src = np;
#pragma unroll
    for (int i = 0; i < 8; ++i) { const int kk = 8 * i + (lane >> 3), k = k0 + kk;
        float g = 1.0f; if (MODE == 3) g = (k < 512) ? ((const GAS float*)gain)[k] : ((const GAS float*)gain2)[k - 512]; else if (MODE != 5) g = ((const GAS float*)gain)[k];
        pg8::f32x4 v = {0.f, 0.f, 0.f, 0.f}; if (src >= 0) v = *(const GAS pg8::f32x4*)(Wp + (size_t)k * Nsrc + src);
        g *= cs; scr[kk * 33 + nn] = v[0] * g; scr[kk * 33 + nn + 1] = v[1] * g; scr[kk * 33 + nn + 2] = v[2] * g; scr[kk * 33 + nn + 3] = v[3] * g; }
    asm volatile("s_waitcnt lgkmcnt(0)" ::: "memory");
    const int c = lane & 7;
#pragma unroll
    for (int j = 0; j < 4; ++j) { const int n = (lane >> 3) + 8 * j; const LAS float* s = scr + (8 * c) * 33 + n;
        pg8::u32x4 o; o.x = pk2(s[0 * 33], s[1 * 33]); o.y = pk2(s[2 * 33], s[3 * 33]); o.z = pk2(s[4 * 33], s[5 * 33]); o.w = pk2(s[6 * 33], s[7 * 33]);
        *(GAS pg8::u32x4*)(WT + (size_t)(n0 + n) * K + k0 + 8 * c) = o; }
    asm volatile("s_waitcnt lgkmcnt(0)" ::: "memory");
}
__device__ __forceinline__ void conv_layer(const Args& a, int l, unsigned char* wbuf, LAS unsigned char* lds) {
    int tid_ = threadIdx.x; asm volatile("" : "+v"(tid_));
    const int lane = tid_ & 63, wave = tid_ >> 6;
    LAS float* scr = (LAS float*)(lds + wave * 16384);
    const int gw = blockIdx.x * NWAVES + wave, NGW = gridDim.x * NWAVES;
    constexpr int I0 = (DM / 64) * (INP / 32), I1 = (256 / 64) * (768 / 32), I2 = (128 / 64) * (1024 / 32), I3 = (DM / 64) * (DM / 32), I4 = (DM / 64) * (GUP / 32), I5 = (DFF / 64) * (DM / 32);
    constexpr int NIT = I0 + I1 + I2 + I3 + I4 + I5;
    for (int it = gw; it < NIT; it += NGW) {
        int r = it;
        if (r < I0) { conv_item<0>(a.w_in + (size_t)l * DM * INW, nullptr, a.attn_norm + l * DM, nullptr, DM, INW, (bf16*)(wbuf + WL_IN), scr, r, INP / 32, lane); continue; } r -= I0;
        if (r < I1) { conv_item<1>(a.w_q_up + (size_t)l * 256 * 768, nullptr, a.q_norm + l * 256, nullptr, 256, 768, (bf16*)(wbuf + WL_Q), scr, r, 768 / 32, lane); continue; } r -= I1;
        if (r < I2) { conv_item<2>(a.w_kv_up + (size_t)l * 128 * 1024, nullptr, a.kv_norm + l * 128, nullptr, 128, 1024, (bf16*)(wbuf + WL_KV), scr, r, 1024 / 32, lane); continue; } r -= I2;
        if (r < I3) { conv_item<3>(a.w_o + (size_t)l * DM * DM, nullptr, a.out_norm_swa + l * 512, a.out_norm_mla + l * 512, DM, DM, (bf16*)(wbuf + WL_O), scr, r, DM / 32, lane); continue; } r -= I3;
        if (r < I4) { conv_item<4>(a.w_gate + (size_t)l * DM * DFF, a.w_up + (size_t)l * DM * DFF, a.ffn_norm + l * DM, nullptr, DM, DFF, (bf16*)(wbuf + WL_GU), scr, r, GUP / 32, lane); continue; } r -= I4;
        conv_item<5>(a.w_down + (size_t)l * DFF * DM, nullptr, nullptr, nullptr, DFF, DM, (bf16*)(wbuf + WL_D), scr, r, DM / 32, lane);
    }
}

__device__ __forceinline__ void init_rows(const Args& a, unsigned char* ws) {
    const int lane = threadIdx.x & 63, wave = threadIdx.x >> 6; const int gw = blockIdx.x * NWAVES + wave, NGW = gridDim.x * NWAVES;
    for (int row = gw; row < MC + NMETA; row += NGW) {
        const bool meta = row >= MC; const int r = meta ? row - MC : row;
        const float* src = meta ? a.meta + (size_t)r * DM : a.x + (size_t)r * DM;
        float* H = (float*)(ws + (meta ? WS_PART + PM_H : WS_H)); bf16* HB = (bf16*)(ws + (meta ? WS_PART + PM_HB : WS_HB)); float* hss = (float*)(ws + WS_PART + (meta ? PM_HSSA : P_HSSA));
        pg8::f32x4 v[4]; float s = 0.f;
#pragma unroll
        for (int j = 0; j < 4; ++j) { v[j] = *((const GAS pg8::f32x4*)src + lane + 64 * j); s += pg8::sq4(v[j]); }
        s = wave_sum(s);
#pragma unroll
        for (int j = 0; j < 4; ++j) { pg8::st_bf16x4(HB + (size_t)r * DM + 4 * (lane + 64 * j), v[j]); }
        if (lane < 16) ((GAS float*)hss)[(size_t)r * 16 + lane] = (lane == 0) ? s : 0.f;
    }
}
__device__ __forceinline__ void final_rows(const Args& a, const bf16* HBf, const float* hss) {
    const int lane = threadIdx.x & 63, wave = threadIdx.x >> 6; const int gw = blockIdx.x * NWAVES + wave, NGW = gridDim.x * NWAVES;
    for (int o = gw; o < BATCH * SEQ; o += NGW) {
        const int row = o;
        const float rs = pg8::rsq(pg8::sum16(hss, row) * (1.0f / DM) + RMS_EPS);
#pragma unroll
        for (int j = 0; j < 4; ++j) { const pg8::u32x2 hw = *((const GAS pg8::u32x2*)(HBf + (size_t)row * DM) + lane + 64 * j); pg8::f32x4 v; v[0] = __builtin_bit_cast(float, hw.x << 16); v[1] = __builtin_bit_cast(float, hw.x & 0xffff0000u); v[2] = __builtin_bit_cast(float, hw.y << 16); v[3] = __builtin_bit_cast(float, hw.y & 0xffff0000u);
            const pg8::f32x4 g = *((const GAS pg8::f32x4*)a.final_norm + lane + 64 * j);
            *((GAS pg8::f32x4*)(a.out + (size_t)o * DM) + lane + 64 * j) = v * rs * g; }
    }
}

constexpr int N_ATT_UNITS = 2 * 17 * 64;
__device__ __forceinline__ void attn_phase(const Args& a, int l, unsigned char* ws, LAS unsigned char* lds, int mode = 0) {
    const int lq = l; l &= 3;
    unsigned char* R = ws + WS_R;
    const bf16 *QA = (const bf16*)(R + R_QA), *KA = (const bf16*)(R + R_KA), *VA = (const bf16*)(R + R_VA), *KR = (const bf16*)(R + R_KR), *QM = (const bf16*)(R + R_QM), *KN = (const bf16*)(R + R_KN), *VB = (const bf16*)(R + R_VB);
    bf16* O = (bf16*)(R + R_O); float* ssqO = (float*)(ws + WS_PART + P_SSQO);
    LAS int* qslot = (LAS int*)(lds + att::OFF_Q);
    const unsigned xcc = ((unsigned)__builtin_amdgcn_s_getreg((3 << 11) | 20) & 0xFu) & 7u;
    unsigned* ctr = (unsigned*)(ws + WS_CTL) + 64 * lq + 8 * 64 * (int)xcc;
    constexpr int PER_X = N_ATT_UNITS / 8;
    for (int pass = 0; pass < 8; ++pass) {
        const unsigned x = (xcc + (unsigned)pass) & 7u; unsigned* c = (unsigned*)(ws + WS_CTL) + 64 * lq + 8 * 64 * (int)x;
        for (;;) {
            if (threadIdx.x == 0) *qslot = (int)atomicAdd(c, 1u);
            __syncthreads();
            const int u = *qslot;
            __syncthreads();
            if (u >= (mode == 1 ? PER_X / 2 : PER_X)) break;
            if (u < PER_X / 2) {
                const int bh = 8 * (u / 17) + (int)x, qb = 16 - u % 17, b = bh >> 3, hd = bh & 7;
                att::attn_unit<96, false>(lds, QM + hd * 96, 768, KN + hd * 64, 512, KR, VB + hd * 64, 512, O + 512 + hd * 64, ssqO + 8 + hd, 0.f, b, qb);
            } else {
                const int v = u - PER_X / 2; const int bh = 8 * (v / 17) + (int)x, qb = 16 - v % 17, b = bh >> 3, hq = bh & 7, kv = hq >> 2;
                att::attn_unit<64, true>(lds, QA + hq * 64, 512, KA + kv * 64, 128, nullptr, VA + kv * 64, 128, O + hq * 64, ssqO + hq, a.sinks[l * 8 + hq] * LOG2E, b, qb);
            }
        }
    }
    (void)ctr;
}

#define XB_TMO      128
#define XB_XCNT(j)  (256  + 64 * (j))
#define XB_XSUB(j)  (1280 + 64 * (j))
#define XB_XGEN(j)  (2304 + 64 * (j))
#define XB_TOP      3328
#define XB_TOPGEN   3392
#define XCD_BAR_WORDS 3456
#define XB_SPIN_CAP (1u << 18)

__device__ __forceinline__ unsigned xb_ld(unsigned* p)              { return __hip_atomic_load(p, __ATOMIC_RELAXED, __HIP_MEMORY_SCOPE_AGENT); }
__device__ __forceinline__ unsigned xb_add(unsigned* p, unsigned v) { return __hip_atomic_fetch_add(p, v, __ATOMIC_RELAXED, __HIP_MEMORY_SCOPE_AGENT); }
__device__ __forceinline__ unsigned xb_xcc_id() { return (unsigned)__builtin_amdgcn_s_getreg((3 << 11) | 20) & 0xFu; }
#define XB_SPIN(cond, bar) do { unsigned _sp = 0; while (cond) { __builtin_amdgcn_s_sleep(1); \
    if ((++_sp & 255u) == 0u) { if (xb_ld(&(bar)[XB_TMO])) break; if (_sp > XB_SPIN_CAP) { atomicAdd(&(bar)[XB_TMO], 1u); break; } } } } while (0)

struct XcdBarrier {
    unsigned* bar; unsigned x;
    volatile LAS unsigned* st;
};

__device__ __forceinline__ XcdBarrier xcd_barrier_post(unsigned* bar, volatile LAS unsigned* st) {
    XcdBarrier b; b.bar = bar; b.x = xb_xcc_id(); b.st = st;
    if (threadIdx.x == 0) (void)xb_add(&bar[XB_XCNT(b.x)], 1u);
    return b;
}
__device__ __forceinline__ void xcd_barrier_complete(unsigned* bar, unsigned x, unsigned& nloc, unsigned& nx) {
    const unsigned G = gridDim.x * gridDim.y * gridDim.z;
    unsigned sum, cnt, mine, sp = 0u;
    for (;;) {
        sum = 0u; cnt = 0u; mine = 0u;
#pragma unroll
        for (unsigned j = 0; j < 16; ++j) { const unsigned c = xb_ld(&bar[XB_XCNT(j)]); sum += c; cnt += (c > 0u) ? 1u : 0u; mine = (j == x) ? c : mine; }
        if (sum == G) break;
        __builtin_amdgcn_s_sleep(1);
        if ((++sp & 255u) == 0u) { if (xb_ld(&bar[XB_TMO])) break; if (sp > XB_SPIN_CAP) { atomicAdd(&bar[XB_TMO], 1u); break; } }
    }
    nloc = mine > 0u ? mine : 1u; nx = cnt > 0u ? cnt : 1u;
}

__device__ __forceinline__ void xcd_barrier(const XcdBarrier& b) {
    asm volatile("s_waitcnt vmcnt(0)" ::: "memory");
    __syncthreads();
    if (threadIdx.x == 0) {
        unsigned* bar = b.bar;
        __builtin_amdgcn_s_waitcnt(0);
        unsigned nloc = b.st[0], nx = b.st[1];
        if (nloc == 0u) { xcd_barrier_complete(bar, b.x, nloc, nx); b.st[0] = nloc; b.st[1] = nx; }
        const unsigned old = xb_add(&bar[XB_XSUB(b.x)], 1u);
        const unsigned gen = old / nloc;
        if (old + 1u == (gen + 1u) * nloc) {
            __builtin_amdgcn_fence(__ATOMIC_RELEASE, "agent");
            asm volatile("s_waitcnt vmcnt(0)" ::: "memory");
            const unsigned og = xb_add(&bar[XB_TOP], 1u);
            const unsigned tg = og / nx;
            if (og + 1u == (tg + 1u) * nx) xb_add(&bar[XB_TOPGEN], 1u);
            else XB_SPIN(xb_ld(&bar[XB_TOPGEN]) == tg, bar);
            __builtin_amdgcn_fence(__ATOMIC_ACQUIRE, "agent");
            xb_add(&bar[XB_XGEN(b.x)], 1u);
            asm volatile("s_waitcnt vmcnt(0)" ::: "memory");
        } else {
            XB_SPIN(xb_ld(&bar[XB_XGEN(b.x)]) == gen, bar);
            __builtin_amdgcn_fence(__ATOMIC_ACQUIRE, "agent");
            asm volatile("s_waitcnt vmcnt(0)" ::: "memory");
        }
    }
    __syncthreads();
}

constexpr int CW_BAR = 4096;
constexpr int XB_LDS_OFF = 131072 + 8192;
#ifndef PHM
#define PHM 255
#endif
#ifndef PROBE_DUP
#define PROBE_DUP 0
#endif
#ifndef PROBE_SYNC
#define PROBE_SYNC 0
#endif
__global__ void __launch_bounds__(NTHREADS, 2) fwd_megakernel(Args a) {
    extern __shared__ __attribute__((aligned(16))) unsigned char lds_raw[];
    LAS unsigned char* lds = (LAS unsigned char*)lds_raw;
    cg::grid_group grid = cg::this_grid();
    const int lo = a.ph_lo, hi = a.ph_hi;
    if (threadIdx.x < 2) ((LAS unsigned*)(lds + XB_LDS_OFF))[threadIdx.x] = 0u;
    __syncthreads();
    if (a.ph_hi < 0) grid.sync();
    const XcdBarrier xbar = xcd_barrier_post((unsigned*)(a.ws + WS_CTL) + CW_BAR, (volatile LAS unsigned*)(lds + XB_LDS_OFF));
#define IN_PH(k) (lo <= (k) && (k) < hi)
#define SEAM(k) do { if (IN_PH(k) && IN_PH((k) + 1)) { xcd_barrier(xbar); if (PROBE_SYNC) xcd_barrier(xbar); } } while (0)
#define WSL(w) unsigned char* w = a.ws; asm volatile("" : "+s"(w))
    if (IN_PH(0) && (PHM & 1)) { WSL(ws); init_rows(a, ws); conv_layer(a, 0, ws + WS_W, lds); __syncthreads(); }
    SEAM(0);
#pragma unroll 1
    for (int l = 0; l < DEPTH; ++l) {
        const int p = 1 + 6 * l;
        if (IN_PH(p) && (PHM & 2)) {
            { WSL(ws); unsigned char* R = ws + WS_R; unsigned char* wb = ws + WS_W + (size_t)(l & 1) * WBUF; unsigned char* pm_ = ws + WS_PART;
              pg8::EpiIn<true> E{(const float*)(pm_ + PM_HSSA), (bf16*)(R + R_QA), (bf16*)(R + R_KA), (bf16*)(R + R_VA), (bf16*)(pm_ + PM_QLAT), (bf16*)(pm_ + PM_KVLAT), (bf16*)(R + R_KR), (float*)(pm_ + PM_SSQQ), (float*)(pm_ + PM_SSQKV)};
              pg8::skinny_phase<DM>(lds, (const bf16*)(pm_ + PM_HB), (const bf16*)(wb + WL_IN), INP / 256, E, 128); }
            WSL(ws); unsigned char* R = ws + WS_R; unsigned char* wb = ws + WS_W + (size_t)(l & 1) * WBUF;
            pg8::Gemm g{(const bf16*)(ws + WS_HB), (const bf16*)(wb + WL_IN), MC, INP, DM, 0}; pg8::OrderCT<MC / 256, INP / 256> S; S.init((int)gridDim.x, (int)blockIdx.x);
            pg8::EpiIn<false> E{(const float*)(ws + WS_PART + P_HSSA), (bf16*)(R + R_QA), (bf16*)(R + R_KA), (bf16*)(R + R_VA), (bf16*)(R + R_QLAT), (bf16*)(R + R_KVLAT), (bf16*)(R + R_KR),
                         (float*)(ws + WS_PART + P_SSQQ), (float*)(ws + WS_PART + P_SSQKV)};
            pg8::gemm_phase<pg8::EpiIn<false>, pg8::OrderCT<MC / 256, INP / 256>, true, true>(lds, g, S, E);
            if (PROBE_DUP & 2) pg8::gemm_phase<pg8::EpiIn<false>, pg8::OrderCT<MC / 256, INP / 256>, true, true>(lds, g, S, E);
        }
        SEAM(p);
        if (IN_PH(p + 1) && (PHM & 4)) {
            { WSL(ws); unsigned char* R = ws + WS_R; unsigned char* wb = ws + WS_W + (size_t)(l & 1) * WBUF; unsigned char* pm_ = ws + WS_PART;
              pg8::EpiQup<true> E{(const float*)(pm_ + PM_SSQQ), (bf16*)(R + R_QM)}; pg8::skinny_phase<256>(lds, (const bf16*)(pm_ + PM_QLAT), (const bf16*)(wb + WL_Q), 3, E, 128); }
            { WSL(ws); unsigned char* R = ws + WS_R; unsigned char* wb = ws + WS_W + (size_t)(l & 1) * WBUF;
              pg8::Gemm g{(const bf16*)(R + R_QLAT), (const bf16*)(wb + WL_Q), MC, 768, 256, 0}; pg8::OrderCT<MC / 256, 3> S; S.init((int)gridDim.x, (int)blockIdx.x);
              pg8::EpiQup<false> E{(const float*)(ws + WS_PART + P_SSQQ), (bf16*)(R + R_QM)}; pg8::gemm_phase<pg8::EpiQup<false>, pg8::OrderCT<MC / 256, 3>, true, true>(lds, g, S, E); if (PROBE_DUP & 4) pg8::gemm_phase<pg8::EpiQup<false>, pg8::OrderCT<MC / 256, 3>, true, true>(lds, g, S, E); }
            { WSL(ws); unsigned char* R = ws + WS_R; unsigned char* wb = ws + WS_W + (size_t)(l & 1) * WBUF; unsigned char* pm_ = ws + WS_PART;
              pg8::EpiKvup<true> E{(const float*)(pm_ + PM_SSQKV), (bf16*)(R + R_KN), (bf16*)(R + R_VB)}; pg8::skinny_phase<128>(lds, (const bf16*)(pm_ + PM_KVLAT), (const bf16*)(wb + WL_KV), 4, E, 0); }
            { WSL(ws); unsigned char* R = ws + WS_R; unsigned char* wb = ws + WS_W + (size_t)(l & 1) * WBUF;
              pg8::Gemm g{(const bf16*)(R + R_KVLAT), (const bf16*)(wb + WL_KV), MC, 1024, 128, 0}; pg8::OrderCT<MC / 256, 4> S; S.init((int)gridDim.x, (int)blockIdx.x);
              pg8::EpiKvup<false> E{(const float*)(ws + WS_PART + P_SSQKV), (bf16*)(R + R_KN), (bf16*)(R + R_VB)}; pg8::gemm_phase<pg8::EpiKvup<false>, pg8::OrderCT<MC / 256, 4>, true, true>(lds, g, S, E); if (PROBE_DUP & 4) pg8::gemm_phase<pg8::EpiKvup<false>, pg8::OrderCT<MC / 256, 4>, true, true>(lds, g, S, E); }
        }
        SEAM(p + 1);
        if (IN_PH(p + 2) && (PHM & 8)) { WSL(ws); if (l + 1 < DEPTH) { conv_layer(a, l + 1, ws + WS_W + (size_t)((l + 1) & 1) * WBUF, lds); __syncthreads(); if (PROBE_DUP & 256) { conv_layer(a, l + 1, ws + WS_W + (size_t)((l + 1) & 1) * WBUF, lds); __syncthreads(); } } attn_phase(a, l, ws, lds); if (PROBE_DUP & 8) attn_phase(a, l + 4, ws, lds); if (PROBE_DUP & 1024) attn_phase(a, l + 4, ws, lds, 1); }
        SEAM(p + 2);
        if (IN_PH(p + 3) && (PHM & 16)) {
            { WSL(ws); unsigned char* R = ws + WS_R; unsigned char* wb = ws + WS_W + (size_t)(l & 1) * WBUF; unsigned char* pm_ = ws + WS_PART;
              pg8::EpiOut<true> E; E.H = (float*)(pm_ + PM_H); E.HB = (bf16*)(pm_ + PM_HB); E.hss_out = (float*)(pm_ + PM_HSSB); E.ssq_o = (const float*)(pm_ + P_SSQO); E.xlds = lds;
              pg8::skinny_phase<DM>(lds, (const bf16*)(R + R_O) + (size_t)FRONT * 1024, (const bf16*)(wb + WL_O), 4, E, 0); }
            WSL(ws); unsigned char* R = ws + WS_R; unsigned char* wb = ws + WS_W + (size_t)(l & 1) * WBUF;
            pg8::Gemm g{(const bf16*)(R + R_O), (const bf16*)(wb + WL_O), MC, DM, DM, 1}; pg8::OrderCT<MC / 256, 4> S; S.init((int)gridDim.x, (int)blockIdx.x);
            pg8::EpiOut<false> E; E.H = (float*)(ws + WS_H); E.HB = (bf16*)(ws + WS_HB); E.hss_out = (float*)(ws + WS_PART + P_HSSB); E.ssq_o = (const float*)(ws + WS_PART + P_SSQO); E.xlds = lds + pg8::STAGE_BYTES;
            pg8::gemm_phase<pg8::EpiOut<false>, pg8::OrderCT<MC / 256, 4>, true, true>(lds, g, S, E);
        }
        SEAM(p + 3);
        if (IN_PH(p + 4) && (PHM & 32)) {
            { WSL(ws); unsigned char* wb = ws + WS_W + (size_t)(l & 1) * WBUF; unsigned char* pm_ = ws + WS_PART;
              pg8::EpiGU<true> E{(const float*)(pm_ + PM_HSSB), (bf16*)(pm_ + PM_ACT)}; pg8::skinny_phase<DM>(lds, (const bf16*)(pm_ + PM_HB), (const bf16*)(wb + WL_GU), GUP / 256, E, 0); }
            WSL(ws); unsigned char* R = ws + WS_R; unsigned char* wb = ws + WS_W + (size_t)(l & 1) * WBUF;
            pg8::Gemm g{(const bf16*)(ws + WS_HB), (const bf16*)(wb + WL_GU), MC, GUP, DM, 0}; pg8::OrderCT<MC / 256, GUP / 256> S; S.init((int)gridDim.x, (int)blockIdx.x);
            pg8::EpiGU<false> E{(const float*)(ws + WS_PART + P_HSSB), (bf16*)(R + R_ACT)};
            pg8::gemm_phase<pg8::EpiGU<false>, pg8::OrderCT<MC / 256, GUP / 256>, true, true>(lds, g, S, E);
        }
        SEAM(p + 4);
        if (IN_PH(p + 5) && (PHM & 64)) {
            { WSL(ws); unsigned char* wb = ws + WS_W + (size_t)(l & 1) * WBUF; unsigned char* pm_ = ws + WS_PART;
              pg8::EpiDown<true> E; E.H = (float*)(pm_ + PM_H); E.HB = (bf16*)(pm_ + PM_HB); E.hss_out = (float*)(pm_ + PM_HSSA); E.ssq_o = nullptr;
              pg8::skinny_phase<DFF>(lds, (const bf16*)(pm_ + PM_ACT), (const bf16*)(wb + WL_D), 4, E, 0); }
            WSL(ws); unsigned char* R = ws + WS_R; unsigned char* wb = ws + WS_W + (size_t)(l & 1) * WBUF;
            pg8::Gemm g{(const bf16*)(R + R_ACT), (const bf16*)(wb + WL_D), MC, DM, DFF, 0}; pg8::OrderCT<MC / 256, 4> S; S.init((int)gridDim.x, (int)blockIdx.x);
            pg8::EpiDown<false> E; E.H = (float*)(ws + WS_H); E.HB = (bf16*)(ws + WS_HB); E.hss_out = (float*)(ws + WS_PART + P_HSSA); E.ssq_o = nullptr;
            pg8::gemm_phase<pg8::EpiDown<false>, pg8::OrderCT<MC / 256, 4>, true, true>(lds, g, S, E);
        }
        SEAM(p + 5);
    }
    if (IN_PH(1 + 6 * DEPTH) && (PHM & 128)) { WSL(ws); final_rows(a, (const bf16*)(ws + WS_HB), (const float*)(ws + WS_PART + P_HSSA)); }
#undef IN_PH
#undef SEAM
#undef WSL
}
constexpr int N_PHASES = 2 + 6 * DEPTH;

#ifndef MK_SPLIT
#define MK_SPLIT 0
#endif
extern "C" void kernel_launch(void* const* d_in, const int* in_sizes, int n_in, void* d_out, int out_size, void* d_ws, size_t ws_size, hipStream_t stream) {
    static int grid = 0;
    if (grid == 0) {
        if (n_in != 17 || ws_size < WS_END) { fprintf(stderr, "kernel_launch: need 17 inputs and >= %zu bytes of workspace; got n_in %d, ws %zu\n", (size_t)WS_END, n_in, ws_size); grid = -1; return; }
        int dev = 0, cus = 0, per_cu = 0;
        hipGetDevice(&dev); hipDeviceGetAttribute(&cus, hipDeviceAttributeMultiprocessorCount, dev);
        if (hipFuncSetAttribute((const void*)fwd_megakernel, hipFuncAttributeMaxDynamicSharedMemorySize, LDS_BYTES) != hipSuccess) { fprintf(stderr, "kernel_launch: hipFuncSetAttribute failed\n"); grid = -1; return; }
        if (hipOccupancyMaxActiveBlocksPerMultiprocessor(&per_cu, (const void*)fwd_megakernel, NTHREADS, LDS_BYTES) != hipSuccess || per_cu < 1) { fprintf(stderr, "kernel_launch: occupancy query says %d\n", per_cu); per_cu = 1; }
        (void)hipGetLastError();
        grid = cus * 1;
    }
    if (grid < 0) return;
    hipMemsetAsync((char*)d_ws + WS_CTL, 0, CTL_BYTES, stream);
    Args a{};
    const float** f = (const float**)&a;
    for (int i = 0; i < 17; ++i) f[i] = (const float*)d_in[i];
    a.out = (float*)d_out; a.ws = (unsigned char*)d_ws;
#if MK_SPLIT
    for (int ph = 0; ph < N_PHASES; ++ph) { a.ph_lo = ph; a.ph_hi = ph + 1; hipLaunchKernelGGL(fwd_megakernel, dim3(grid), dim3(NTHREADS), LDS_BYTES, stream, a); }
#else
    a.ph_lo = 0; a.ph_hi = N_PHASES;
    void* args[] = {&a};
    hipError_t e = hipLaunchCooperativeKernel((const void*)fwd_megakernel, dim3(grid), dim3(NTHREADS), args, LDS_BYTES, stream);
    if (e != hipSuccess) fprintf(stderr, "cooperative launch failed: %s (grid %d)\n", hipGetErrorString(e), grid);
#endif
}
```

```cpp
#include <hip/hip_runtime.h>
#include <hip/hip_cooperative_groups.h>
#include <cstdio>
#include <cstdint>
namespace cg = cooperative_groups;

constexpr int BATCH = 8, SEQ = 4096, DM = 1024, DEPTH = 4, NMETA = 16, FRONT = 112, TT = 4224;
constexpr int MROWS = BATCH * TT;
constexpr int INW = 1184, INP = 1280, DFF = 2816, GUP = 2 * DFF;
constexpr float RMS_EPS = 1e-6f;
constexpr float LOG2E = 1.4426950408889634f;
constexpr float LOG2_THETA = 13.287712379549449f;
constexpr float INV_2PI = 0.15915494309189535f;

namespace pg8 {
#define PG8_LAS __attribute__((address_space(3)))
typedef unsigned short bf16_t;
typedef short bf16x8 __attribute__((ext_vector_type(8)));
typedef float f32x4 __attribute__((ext_vector_type(4)));
typedef unsigned u32x4 __attribute__((ext_vector_type(4)));
constexpr int BM = 256, BK = 64, HALF = 128, HTB = HALF * BK * 2  , STAGE_BYTES = 8 * HTB, NXCD = 8, WGM = 8;

__host__ __device__ __forceinline__ int lds_byte(int r, int c) { const int st = (r >> 4) * 2 + (c >> 5), rr = r & 15, cc = c & 31, ob = rr * 64 + cc * 2; return st * 1024 + (ob ^ (((ob >> 9) & 1) << 5)); }
__host__ __device__ __forceinline__ void stage_rc(int b, int& R, int& C) { const int st = b / 1024, sb = b % 1024, swz = sb ^ (((sb >> 9) & 1) << 5); R = (st >> 1) * 16 + swz / 64; C = (st & 1) * 32 + (swz % 64) / 2; }
__host__ __device__ __forceinline__ int perm32(int rho) { const int n = rho >> 4, i = rho & 15; return 8 * (i >> 2) + 4 * n + (i & 3); }

struct Unit { int pm, pn; };
struct Gemm { const bf16_t* A; const bf16_t* Bt; int M, N, K; int apad; };

struct StaticOrder {
    int nM, nN, nwg, G, c;
    __host__ __device__ void init(int M, int N, int G_, int c_) { nM = M / BM; nN = N / BM; nwg = nM * nN; G = G_; c = c_; }
    __host__ __device__ bool next(int i, Unit& u) const {
        const long L = (long)i * G + c; if (L >= nwg) return false;
        int wgid = (int)L; { const int q = nwg / NXCD, r = nwg % NXCD, xcd = wgid % NXCD, off = wgid / NXCD; wgid = (xcd < r ? xcd * (q + 1) : r * (q + 1) + (xcd - r) * q) + off; }
        const int nig = WGM * nN, gid = wgid / nig, fm = gid * WGM, gsz = (nM - fm) < WGM ? (nM - fm) : WGM;
        u.pm = fm + ((wgid % nig) % gsz); u.pn = (wgid % nig) / gsz; return true;
    }
    __device__ __forceinline__ void a_ready(const Unit&) const {}
    __device__ __forceinline__ void done(const Unit&) const {}
};

__device__ __forceinline__ unsigned cvt_pk_bf16(float lo, float hi) { unsigned r; asm volatile("v_cvt_pk_bf16_f32 %0, %1, %2" : "=v"(r) : "v"(lo), "v"(hi)); return r; }

template <int NM, int NN> struct OrderCT {
    static_assert(NM % 8 == 0 || NM % 8 == 4, "last M group must be 8 or 4 tiles");
    int G, c;
    __device__ __forceinline__ void init(int G_, int c_) { G = G_; c = c_; }
    __device__ __forceinline__ bool next(int i, Unit& u) const {
        constexpr int nwg = NM * NN, q = nwg / NXCD, r = nwg % NXCD, nig = WGM * NN;
        const int L = i * G + c; if (L >= nwg) return false;
        const int xcd = L & (NXCD - 1), off = L >> 3;
        const int wgid = (xcd < r ? xcd * (q + 1) : r * (q + 1) + (xcd - r) * q) + off;
        const int gid = wgid / nig, rem = wgid - gid * nig, fm = gid * WGM;
        const int sh = (NM - fm) < WGM ? 2 : 3;
        u.pm = fm + (rem & ((1 << sh) - 1)); u.pn = rem >> sh; return true;
    }
    __device__ __forceinline__ void a_ready(const Unit&) const {}
    __device__ __forceinline__ void done(const Unit&) const {}
};
typedef unsigned u32x2 __attribute__((ext_vector_type(2)));
#define PG8_GAS __attribute__((address_space(1)))
__device__ __forceinline__ void st_bf16x4(bf16_t* p, f32x4 v) { u32x2 w; w.x = cvt_pk_bf16(v[0], v[1]); w.y = cvt_pk_bf16(v[2], v[3]); *(PG8_GAS u32x2*)p = w; }
__device__ __forceinline__ void st_bf16x8(bf16_t* p, f32x4 v0, f32x4 v1) { u32x4 w; w.x = cvt_pk_bf16(v0[0], v0[1]); w.y = cvt_pk_bf16(v0[2], v0[3]); w.z = cvt_pk_bf16(v1[0], v1[1]); w.w = cvt_pk_bf16(v1[2], v1[3]); *(PG8_GAS u32x4*)p = w; }
__device__ __forceinline__ float sum16(const float* part, int row) {
    const PG8_GAS f32x4* p = (const PG8_GAS f32x4*)(part + (size_t)row * 16); const f32x4 a = p[0], b = p[1], c = p[2], d = p[3];
    return (((a.x + a.y) + (a.z + a.w)) + ((b.x + b.y) + (b.z + b.w))) + (((c.x + c.y) + (c.z + c.w)) + ((d.x + d.y) + (d.z + d.w)));
}
__device__ __forceinline__ float sum16q(const float* part, int row, int fq) {
    const f32x4 a = *((const PG8_GAS f32x4*)(part + (size_t)row * 16) + fq); float s = (a.x + a.y) + (a.z + a.w);
    s += __shfl_xor(s, 16); s += __shfl_xor(s, 32); return s;
}
__device__ __forceinline__ float sum4(const float* part, int row) { const f32x4 a = *(const PG8_GAS f32x4*)(part + (size_t)row * 4); return (a.x + a.y) + (a.z + a.w); }
__device__ __forceinline__ float rsq(float x) { return 1.0f / sqrtf(x); }
__device__ __forceinline__ float sq4(f32x4 v) { return (v[0] * v[0] + v[1] * v[1]) + (v[2] * v[2] + v[3] * v[3]); }
#define EPI_ROWS(ai, m) for (int ai = 0; ai < 2; ++ai) for (int m = 0; m < 4; ++m)
#define EPI_ROW(u, ai, m) ((u).pm * BM + (ai) * HALF + wr * 64 + (m) * 16 + fr)

__device__ __forceinline__ int prow_of(int m) { return m + (m >> 12) * 128 + 128; }
#define EPI_NB (META ? BATCH : 1)
#define EPI_PROW(row, b) (META ? (size_t)((b) * TT + FRONT + (row)) : (size_t)prow_of(row))
#define EPI_MAIN_LOOP(CALL) _Pragma("unroll") for (int ai = 0; ai < 2; ++ai) _Pragma("unroll") for (int m = 0; m < 4; ++m) { asm volatile("" ::: "memory"); const int row = EPI_ROW(u, ai, m); \
        const f32x4 a_[2][2] = {{acc[ai][0][m][0], acc[ai][0][m][1]}, {acc[ai][1][m][0], acc[ai][1][m][1]}}; CALL; }

template <bool META> struct EpiIn {
    static constexpr bool PERM = true, AFTER_DRAIN = false, MIDSCALE = false;
    const float* hss; bf16_t *qa, *ka, *va, *qlat, *kvlat, *kr; float *ssq_q, *ssq_kv;
    __device__ __forceinline__ void mid(f32x4 (&)[2][2][4][2], const Unit&, int, int, int, int) const {}
    __device__ __forceinline__ void row_epi(const f32x4 (&a)[2][2], int row, int pn, int wc, int fr, int fq) const {
        const float rs = rsq(sum16q(hss, row, fq) * (1.0f / DM) + RMS_EPS);
        if (pn <= 2) {
            const bool is_kr = (pn == 2 && wc == 2);
            if (pn == 2 && wc == 3) return;
            const float pos = META ? (float)row : (float)((row & 4095) + NMETA);
            f32x4 o1[2], o2[2];
#pragma unroll
            for (int n = 0; n < 2; ++n) {
                const f32x4 x1 = a[0][n] * rs, x2 = a[1][n] * rs;
#pragma unroll
                for (int e = 0; e < 4; ++e) { const float d1 = (float)(8 * fq + 4 * n + e); const float inv = __builtin_amdgcn_exp2f(-d1 * (is_kr ? (LOG2_THETA / 16.0f) : (LOG2_THETA / 32.0f)));
                    const float ang = pos * inv; float rev = ang * INV_2PI; rev = rev - floorf(rev);
                    const float sn = __builtin_amdgcn_sinf(rev), cs = __builtin_amdgcn_cosf(rev); o1[n][e] = x1[e] * cs - x2[e] * sn; o2[n][e] = x2[e] * cs + x1[e] * sn; }
            }
            if (is_kr && fq >= 2) return;
#pragma unroll
            for (int b = 0; b < EPI_NB; ++b) { const size_t pr = EPI_PROW(row, b); bf16_t* d; int half;
                if (pn < 2) { d = qa + pr * 512 + (4 * pn + wc) * 64 + 8 * fq; half = 32; }
                else if (!is_kr) { d = ka + pr * 128 + wc * 64 + 8 * fq; half = 32; }
                else { d = kr + pr * 32 + 8 * fq; half = 16; }
                st_bf16x8(d, o1[0], o1[1]); st_bf16x8(d + half, o2[0], o2[1]); }
        } else if (pn == 3) {
            const int c = 32 * wc + 8 * fq; const f32x4 v0 = a[0][0] * rs, v1 = a[0][1] * rs, w0 = a[1][0] * rs, w1 = a[1][1] * rs;
#pragma unroll
            for (int b = 0; b < EPI_NB; ++b) st_bf16x8(va + EPI_PROW(row, b) * 128 + c, v0, v1);
            st_bf16x8(kvlat + (size_t)row * 128 + c, w0, w1);
            float ss = sq4(w0) + sq4(w1);
            ss += __shfl_xor(ss, 16); ss += __shfl_xor(ss, 32);
            if (fq == 0) ((PG8_GAS float*)ssq_kv)[(size_t)row * 4 + wc] = ss;
        } else {
            float ss = 0.f;
#pragma unroll
            for (int bj = 0; bj < 2; ++bj) { const int c = 128 * bj + 32 * wc + 8 * fq; const f32x4 v0 = a[bj][0] * rs, v1 = a[bj][1] * rs; st_bf16x8(qlat + (size_t)row * 256 + c, v0, v1); ss += sq4(v0) + sq4(v1); }
            ss += __shfl_xor(ss, 16); ss += __shfl_xor(ss, 32);
            if (fq == 0) ((PG8_GAS float*)ssq_q)[(size_t)row * 4 + wc] = ss;
        }
    }
    __device__ __forceinline__ void operator()(const f32x4 (&acc)[2][2][4][2], const Unit& u, int wr, int wc, int fr, int fq) const { EPI_MAIN_LOOP(row_epi(a_, row, u.pn, wc, fr, fq)) }
};

template <bool META> struct EpiQup {
    static constexpr bool PERM = true, AFTER_DRAIN = false, MIDSCALE = false;
    const float* ssq_q; bf16_t* qm;
    __device__ __forceinline__ void mid(f32x4 (&)[2][2][4][2], const Unit&, int, int, int, int) const {}
    __device__ __forceinline__ void row_epi(const f32x4 (&a)[2][2], int row, int pn, int wc, int fr, int fq) const {
        const float rs = rsq(sum4(ssq_q, row) * (1.0f / 256.0f) + RMS_EPS);
        if (pn < 2) {
#pragma unroll
            for (int bj = 0; bj < 2; ++bj) { const int head = 4 * pn + 2 * bj + (wc >> 1), d = 32 * (wc & 1) + 8 * fq; const f32x4 v0 = a[bj][0] * rs, v1 = a[bj][1] * rs;
#pragma unroll
                for (int b = 0; b < EPI_NB; ++b) st_bf16x8(qm + EPI_PROW(row, b) * 768 + head * 96 + d, v0, v1); }
        } else {
            const float pos = META ? (float)row : (float)((row & 4095) + NMETA);
            const int head = 2 * wc + (fq >> 1), i0 = 8 * (fq & 1); f32x4 o1[2], o2[2];
#pragma unroll
            for (int n = 0; n < 2; ++n) { const f32x4 x1 = a[0][n] * rs, x2 = a[1][n] * rs;
#pragma unroll
                for (int e = 0; e < 4; ++e) { const float inv = __builtin_amdgcn_exp2f(-(float)(i0 + 4 * n + e) * (LOG2_THETA / 16.0f)); const float ang = pos * inv; float rev = ang * INV_2PI; rev = rev - floorf(rev);
                    const float sn = __builtin_amdgcn_sinf(rev), cs = __builtin_amdgcn_cosf(rev); o1[n][e] = x1[e] * cs - x2[e] * sn; o2[n][e] = x2[e] * cs + x1[e] * sn; } }
#pragma unroll
            for (int b = 0; b < EPI_NB; ++b) { bf16_t* qrow = qm + EPI_PROW(row, b) * 768 + head * 96; st_bf16x8(qrow + 64 + i0, o1[0], o1[1]); st_bf16x8(qrow + 80 + i0, o2[0], o2[1]); }
        }
    }
    __device__ __forceinline__ void operator()(const f32x4 (&acc)[2][2][4][2], const Unit& u, int wr, int wc, int fr, int fq) const { EPI_MAIN_LOOP(row_epi(a_, row, u.pn, wc, fr, fq)) }
};

template <bool META> struct EpiKvup {
    static constexpr bool PERM = true, AFTER_DRAIN = false, MIDSCALE = false;
    const float* ssq_kv; bf16_t *kn, *vb;
    __device__ __forceinline__ void mid(f32x4 (&)[2][2][4][2], const Unit&, int, int, int, int) const {}
    __device__ __forceinline__ void row_epi(const f32x4 (&a)[2][2], int row, int pn, int wc, int fr, int fq) const {
        bf16_t* dst = (pn < 2 ? kn : vb) + (pn & 1) * 256;
        const float rs = rsq(sum4(ssq_kv, row) * (1.0f / 128.0f) + RMS_EPS);
#pragma unroll
        for (int bj = 0; bj < 2; ++bj) { const f32x4 v0 = a[bj][0] * rs, v1 = a[bj][1] * rs;
#pragma unroll
            for (int b = 0; b < EPI_NB; ++b) st_bf16x8(dst + EPI_PROW(row, b) * 512 + 128 * bj + 32 * wc + 8 * fq, v0, v1); }
    }
    __device__ __forceinline__ void operator()(const f32x4 (&acc)[2][2][4][2], const Unit& u, int wr, int wc, int fr, int fq) const { EPI_MAIN_LOOP(row_epi(a_, row, u.pn, wc, fr, fq)) }
};

struct EpiResid {
    static constexpr bool PERM = true, AFTER_DRAIN = false;
    float* H; bf16_t* HB; float* hss_out; const float* ssq_o;
    __device__ __forceinline__ void resid_row(const f32x4 (&a)[2][2], int row, float rs, int pn, int wc, int fr, int fq) const {
        float ss = 0.f;
#pragma unroll
        for (int bj = 0; bj < 2; ++bj) { const size_t off = (size_t)row * DM + pn * BM + 128 * bj + 32 * wc + 8 * fq;
            const u32x4 hw = *(const PG8_GAS u32x4*)(HB + off); f32x4 h0, h1;
            h0[0] = __builtin_bit_cast(float, hw.x << 16); h0[1] = __builtin_bit_cast(float, hw.x & 0xffff0000u); h0[2] = __builtin_bit_cast(float, hw.y << 16); h0[3] = __builtin_bit_cast(float, hw.y & 0xffff0000u);
            h1[0] = __builtin_bit_cast(float, hw.z << 16); h1[1] = __builtin_bit_cast(float, hw.z & 0xffff0000u); h1[2] = __builtin_bit_cast(float, hw.w << 16); h1[3] = __builtin_bit_cast(float, hw.w & 0xffff0000u);
            h0 = h0 + a[bj][0] * rs; h1 = h1 + a[bj][1] * rs; st_bf16x8(HB + off, h0, h1); ss += sq4(h0) + sq4(h1); }
        ss += __shfl_xor(ss, 16); ss += __shfl_xor(ss, 32);
        if (fq == 0) ((PG8_GAS float*)hss_out)[(size_t)row * 16 + 4 * pn + wc] = ss;
    }
    __device__ __forceinline__ void two_scales(size_t prow, float& f, float& rb) const {
        const PG8_GAS f32x4* p = (const PG8_GAS f32x4*)(ssq_o + prow * 16); const f32x4 a = p[0], b = p[1], c = p[2], d = p[3];
        const float sa = ((a.x + a.y) + (a.z + a.w)) + ((b.x + b.y) + (b.z + b.w)), sb = ((c.x + c.y) + (c.z + c.w)) + ((d.x + d.y) + (d.z + d.w));
        const float va = sa * (1.0f / 512.0f) + RMS_EPS, vb = sb * (1.0f / 512.0f) + RMS_EPS; f = sqrtf(vb / va); rb = rsq(vb);
    }
};
template <bool META> struct EpiOut : EpiResid {
    static constexpr bool MIDSCALE = true;
    PG8_LAS unsigned char* xlds;
    __device__ __forceinline__ void prep(const Unit& u, int wid, int wr, int lane) const {
        PG8_LAS float* tab = (PG8_LAS float*)(xlds + wid * 1024);
#pragma unroll
        for (int j = 0; j < 2; ++j) { const int idx = lane + 64 * j; const int row = u.pm * BM + (idx >> 6) * HALF + wr * 64 + (idx & 63);
            float f, rb; two_scales((size_t)prow_of(row), f, rb); tab[2 * idx] = f; tab[2 * idx + 1] = rb; }
    }
    __device__ __forceinline__ void mid(f32x4 (&acc)[2][2][4][2], const Unit& u, int wr, int wc, int fr, int fq) const {
        const int wid = wr * 4 + wc; const PG8_LAS float* tab = (const PG8_LAS float*)(xlds + wid * 1024);
#pragma unroll
        for (int ai = 0; ai < 2; ++ai)
#pragma unroll
            for (int m = 0; m < 4; ++m) {
                const float f = tab[2 * (ai * 64 + m * 16 + fr)];
#pragma unroll
                for (int bj = 0; bj < 2; ++bj)
#pragma unroll
                    for (int n = 0; n < 2; ++n) acc[ai][bj][m][n] *= f;
            }
    }
    __device__ __forceinline__ void operator()(const f32x4 (&acc)[2][2][4][2], const Unit& u, int wr, int wc, int fr, int fq) const {
        const PG8_LAS float* tab = (const PG8_LAS float*)(xlds + (wr * 4 + wc) * 1024);
        EPI_MAIN_LOOP(resid_row(a_, row, tab[2 * (ai * 64 + m * 16 + fr) + 1], u.pn, wc, fr, fq))
    }
    __device__ __forceinline__ void mid_row(f32x4 (&a)[2][2], int row) const { float f, rb; two_scales((size_t)(FRONT + row), f, rb);
#pragma unroll
        for (int bj = 0; bj < 2; ++bj)
#pragma unroll
            for (int n = 0; n < 2; ++n) a[bj][n] *= f; }
    __device__ __forceinline__ void row_epi(const f32x4 (&a)[2][2], int row, int pn, int wc, int fr, int fq) const { float f, rb; two_scales((size_t)(FRONT + row), f, rb); resid_row(a, row, rb, pn, wc, fr, fq); }
};
template <bool META> struct EpiDown : EpiResid {
    static constexpr bool MIDSCALE = false;
    __device__ __forceinline__ void mid(f32x4 (&)[2][2][4][2], const Unit&, int, int, int, int) const {}
    __device__ __forceinline__ void row_epi(const f32x4 (&a)[2][2], int row, int pn, int wc, int fr, int fq) const { resid_row(a, row, 1.0f, pn, wc, fr, fq); }
    __device__ __forceinline__ void operator()(const f32x4 (&acc)[2][2][4][2], const Unit& u, int wr, int wc, int fr, int fq) const { EPI_MAIN_LOOP(resid_row(a_, row, 1.0f, u.pn, wc, fr, fq)) }
};

template <bool META> struct EpiGU {
    static constexpr bool PERM = true, AFTER_DRAIN = false, MIDSCALE = false;
    const float* hss; bf16_t* act;
    __device__ __forceinline__ void mid(f32x4 (&)[2][2][4][2], const Unit&, int, int, int, int) const {}
    __device__ __forceinline__ void row_epi(const f32x4 (&a)[2][2], int row, int pn, int wc, int fr, int fq) const {
        const float rs = rsq(sum16q(hss, row, fq) * (1.0f / DM) + RMS_EPS); f32x4 o[2];
#pragma unroll
        for (int n = 0; n < 2; ++n) { const f32x4 g = a[0][n] * rs, up = a[1][n] * rs;
#pragma unroll
            for (int e = 0; e < 4; ++e) o[n][e] = g[e] * up[e] * __builtin_amdgcn_rcpf(1.0f + __builtin_amdgcn_exp2f(-g[e] * LOG2E)); }
        st_bf16x8(act + (size_t)row * DFF + 128 * pn + 32 * wc + 8 * fq, o[0], o[1]);
    }
    __device__ __forceinline__ void operator()(const f32x4 (&acc)[2][2][4][2], const Unit& u, int wr, int wc, int fr, int fq) const { EPI_MAIN_LOOP(row_epi(a_, row, u.pn, wc, fr, fq)) }
};

template <int K, class Epi>
__device__ __forceinline__ void skinny_phase(PG8_LAS unsigned char* lds, const bf16_t* A16, const bf16_t* Bt, int NN, const Epi& E, int wg0) {
    int tid_ = threadIdx.x; asm volatile("" : "+v"(tid_));
    const int tid = tid_, lane = tid & 63, wid = __builtin_amdgcn_readfirstlane(tid >> 6), fr = lane & 15, fq = lane >> 4;
    constexpr int nk = K / 32, NJ = (nk + 7) / 8;
    const int G = (int)gridDim.x; int first = (int)blockIdx.x - wg0; if (first < 0) first += G;
    for (int task = first; task < 4 * NN; task += G) {
        const int pn = task >> 2, wc = task & 3;
        f32x4 a[2][2];
#pragma unroll
        for (int bj = 0; bj < 2; ++bj)
#pragma unroll
            for (int n = 0; n < 2; ++n) a[bj][n] = (f32x4){0.f, 0.f, 0.f, 0.f};
        bool scaled = false;
        const bf16_t* ap = A16 + (size_t)fr * K + 8 * fq;
        const bf16_t* bp = Bt + (size_t)(256 * pn + 32 * wc + 8 * (fr >> 2) + (fr & 3)) * K + 8 * fq;
#pragma unroll 4
        for (int j = 0; j < NJ; ++j) {
            const int it = wid + 8 * j; if (it >= nk) break;
            const int k0 = 32 * it;
            if constexpr (Epi::MIDSCALE) { if (!scaled && k0 >= (K >> 1)) { E.mid_row(a, fr); scaled = true; } }
            const bf16x8 av = *(const PG8_GAS bf16x8*)(ap + k0);
#pragma unroll
            for (int bj = 0; bj < 2; ++bj)
#pragma unroll
                for (int n = 0; n < 2; ++n) { const bf16x8 bv = *(const PG8_GAS bf16x8*)(bp + (size_t)(128 * bj + 4 * n) * K + k0);
                    a[bj][n] = __builtin_amdgcn_mfma_f32_16x16x32_bf16(bv, av, a[bj][n], 0, 0, 0); }
        }
        if constexpr (Epi::MIDSCALE) { if (!scaled) E.mid_row(a, fr); }
        PG8_LAS f32x4* red = (PG8_LAS f32x4*)lds;
#pragma unroll
        for (int bj = 0; bj < 2; ++bj)
#pragma unroll
            for (int n = 0; n < 2; ++n) red[(wid * 64 + lane) * 4 + bj * 2 + n] = a[bj][n];
        __syncthreads();
        if (wid == 0) {
#pragma unroll
            for (int w = 1; w < 8; ++w)
#pragma unroll
                for (int bj = 0; bj < 2; ++bj)
#pragma unroll
                    for (int n = 0; n < 2; ++n) a[bj][n] += red[(w * 64 + lane) * 4 + bj * 2 + n];
            E.row_epi(a, fr, pn, wc, fr, fq);
        }
        __syncthreads();
    }
}
template <class Epi, class Sched, bool ALIGN_EPI = false, bool SP2 = false>
__device__ __forceinline__ void gemm_phase(PG8_LAS unsigned char* lds, const Gemm g, const Sched& S, const Epi& E) {
    int tid_ = threadIdx.x; asm volatile("" : "+v"(tid_));
    const int tid = tid_, wid = __builtin_amdgcn_readfirstlane(tid >> 6), lane = tid & 63, wr = wid >> 2, wc = wid & 3, fr = lane & 15, fq = lane >> 4;
    int K_ = g.K; asm volatile("" : "+s"(K_)); const int K = K_, nt = K / BK;
    unsigned voffA[2], voffB[2];
#pragma unroll
    for (int i = 0; i < 2; ++i) { int R, C; stage_rc(tid * 16 + i * 8192, R, C); const int Rb = Epi::PERM ? ((R & ~31) + perm32(R & 31)) : R;
        voffA[i] = (unsigned)(R * K + C) * 2u; voffB[i] = (unsigned)(Rb * K + C) * 2u; }
    const size_t kstep = (size_t)(BK * 2);
    const size_t hstep = (size_t)HALF * K * 2;
    const size_t tstep = 2 * hstep;
    const unsigned ldsw = (unsigned)wid * 1024u;
    const int aoff = lds_byte(wr * 64 + fr, fq * 8), boff = lds_byte(wc * 32 + fr, fq * 8);
#define PG8_SA(b, h) (((b) * 2 + (h)) * HTB)
#define PG8_SB(b, h) ((4 + (b) * 2 + (h)) * HTB)
#define PG8_STAGE(bufoff, gbase, voff) do { _Pragma("unroll") for (int _i = 0; _i < 2; ++_i) \
        __builtin_amdgcn_global_load_lds((const unsigned*)((const char*)(gbase) + (voff)[_i]), (PG8_LAS unsigned*)(lds + (bufoff) + ldsw + _i * 8192), 16, 0, 0); } while (0)
#define PG8_LDA(dst, b, h) do { _Pragma("unroll") for (int m = 0; m < 4; ++m) _Pragma("unroll") for (int k = 0; k < 2; ++k) dst[m][k] = *(const PG8_LAS bf16x8*)(lds + PG8_SA(b, h) + aoff + m * 2048 + k * 1024); } while (0)
#define PG8_LDB(dst, b, h) do { _Pragma("unroll") for (int n = 0; n < 2; ++n) _Pragma("unroll") for (int k = 0; k < 2; ++k) dst[n][k] = *(const PG8_LAS bf16x8*)(lds + PG8_SB(b, h) + boff + n * 2048 + k * 1024); } while (0)
#define PG8_MMA(ai, bj, At, Bt) do { __builtin_amdgcn_s_setprio(1); _Pragma("unroll") for (int m = 0; m < 4; ++m) _Pragma("unroll") for (int n = 0; n < 2; ++n) _Pragma("unroll") for (int k = 0; k < 2; ++k) \
        acc[ai][bj][m][n] = __builtin_amdgcn_mfma_f32_16x16x32_bf16(Bt[n][k], At[m][k], acc[ai][bj][m][n], 0, 0, 0); __builtin_amdgcn_s_setprio(0); } while (0)
#define PG8_WAIT_V(n) asm volatile("s_waitcnt vmcnt(" #n ")" ::: "memory")
#define PG8_WAIT_L(n) asm volatile("s_waitcnt lgkmcnt(" #n ")" ::: "memory")
#define PG8_BAR __builtin_amdgcn_s_barrier()
#define PG8_SCHED __builtin_amdgcn_sched_barrier(0)
    Unit cur, nxt; int ui = 0;
    if (!S.next(0, cur)) return;
    f32x4 acc[2][2][4][2];
#pragma unroll
    for (int a = 0; a < 2; ++a)
#pragma unroll
        for (int b = 0; b < 2; ++b)
#pragma unroll
            for (int m = 0; m < 4; ++m)
#pragma unroll
                for (int n = 0; n < 2; ++n) acc[a][b][m][n] = (f32x4){0.f, 0.f, 0.f, 0.f};
    bf16x8 At[4][2], B0[2][2], B1[2][2];
    const char* cA = (const char*)g.A + (size_t)cur.pm * tstep + (g.apad ? (size_t)((cur.pm >> 4) * 128 + 128) * (size_t)K * 2 : (size_t)0); const char* cB = (const char*)g.Bt + (size_t)cur.pn * tstep;
    S.a_ready(cur);
    if constexpr (SP2) {
        PG8_STAGE(PG8_SB(0, 0), cB, voffB); PG8_STAGE(PG8_SB(0, 1), cB + hstep, voffB); PG8_STAGE(PG8_SA(0, 0), cA, voffA); PG8_STAGE(PG8_SA(0, 1), cA + hstep, voffA);
        if (wr == 1) PG8_BAR;
        PG8_WAIT_V(2); PG8_BAR;
        PG8_STAGE(PG8_SB(1, 0), cB + kstep, voffB); PG8_STAGE(PG8_SA(1, 0), cA + kstep, voffA); PG8_STAGE(PG8_SB(1, 1), cB + hstep + kstep, voffB);
        PG8_WAIT_V(6); PG8_BAR;
    } else {
        PG8_STAGE(PG8_SB(0, 0), cB, voffB); PG8_STAGE(PG8_SA(0, 0), cA, voffA); PG8_STAGE(PG8_SB(0, 1), cB + hstep, voffB); PG8_STAGE(PG8_SA(0, 1), cA + hstep, voffA);
        if (wr == 1) PG8_BAR;
        PG8_WAIT_V(4); PG8_BAR;
        PG8_STAGE(PG8_SB(1, 0), cB + kstep, voffB); PG8_STAGE(PG8_SA(1, 0), cA + kstep, voffA); PG8_STAGE(PG8_SB(1, 1), cB + hstep + kstep, voffB);
        PG8_WAIT_V(6); PG8_BAR;
    }
    for (;;) {
        const bool has_next = S.next(ui + 1, nxt);
        if constexpr (Epi::MIDSCALE) E.prep(cur, wid, wr, lane);
        const char* nA = has_next ? (const char*)g.A + (size_t)nxt.pm * tstep + (g.apad ? (size_t)((nxt.pm >> 4) * 128 + 128) * (size_t)K * 2 : (size_t)0) : cA; const char* nB = has_next ? (const char*)g.Bt + (size_t)nxt.pn * tstep : cB;
        for (int t = 0; t < nt; t += 2) {
            const bool last = (t == nt - 2);
            if constexpr (Epi::MIDSCALE) { if (t == (nt >> 1)) E.mid(acc, cur, wr, wc, fr, fq); }
            const char* a1 = cA + (size_t)(t + 1) * kstep;
            const char* a2 = last ? nA : cA + (size_t)(t + 2) * kstep; const char* b2 = last ? nB : cB + (size_t)(t + 2) * kstep;
            const char* a3 = a2 + kstep; const char* b3 = b2 + kstep;
            if (last && has_next) S.a_ready(nxt);
            if constexpr (SP2) {
            PG8_LDB(B0, 0, 0); PG8_LDB(B1, 0, 1); PG8_SCHED; PG8_LDA(At, 0, 0); PG8_STAGE(PG8_SA(1, 1), a1 + hstep, voffA);
            PG8_WAIT_V(8); PG8_WAIT_L(0); PG8_BAR; PG8_MMA(0, 0, At, B0); PG8_MMA(0, 1, At, B1); PG8_BAR; PG8_SCHED;
            PG8_LDA(At, 0, 1); PG8_STAGE(PG8_SB(0, 0), b2, voffB); PG8_STAGE(PG8_SB(0, 1), b2 + hstep, voffB); PG8_STAGE(PG8_SA(0, 0), a2, voffA);
            PG8_WAIT_V(8); PG8_WAIT_L(0); PG8_BAR; PG8_MMA(1, 0, At, B0); PG8_MMA(1, 1, At, B1); PG8_BAR; PG8_SCHED;
            PG8_LDB(B0, 1, 0); PG8_LDB(B1, 1, 1); PG8_SCHED; PG8_LDA(At, 1, 0); PG8_STAGE(PG8_SA(0, 1), a2 + hstep, voffA);
            PG8_WAIT_V(8); PG8_WAIT_L(0); PG8_BAR; PG8_MMA(0, 0, At, B0); PG8_MMA(0, 1, At, B1); PG8_BAR; PG8_SCHED;
            PG8_LDA(At, 1, 1); PG8_STAGE(PG8_SB(1, 0), b3, voffB); PG8_STAGE(PG8_SB(1, 1), b3 + hstep, voffB); PG8_STAGE(PG8_SA(1, 0), a3, voffA);
            PG8_WAIT_V(8); PG8_WAIT_L(0); PG8_BAR; PG8_MMA(1, 0, At, B0); PG8_MMA(1, 1, At, B1); PG8_BAR; PG8_SCHED;
            } else {
            PG8_LDB(B0, 0, 0); PG8_SCHED; PG8_LDA(At, 0, 0); PG8_STAGE(PG8_SA(1, 1), a1 + hstep, voffA);
            PG8_WAIT_L(8); PG8_BAR; PG8_WAIT_L(0); PG8_MMA(0, 0, At, B0); PG8_BAR; PG8_SCHED;
            PG8_LDB(B1, 0, 1); PG8_STAGE(PG8_SB(0, 0), b2, voffB);
            PG8_BAR; PG8_WAIT_L(0); PG8_MMA(0, 1, At, B1); PG8_BAR;
            PG8_LDA(At, 0, 1); PG8_STAGE(PG8_SA(0, 0), a2, voffA);
            PG8_BAR; PG8_WAIT_L(0); PG8_MMA(1, 0, At, B0); PG8_BAR; PG8_SCHED;
            PG8_STAGE(PG8_SB(0, 1), b2 + hstep, voffB);
            PG8_WAIT_V(6); PG8_BAR; PG8_MMA(1, 1, At, B1); PG8_BAR;
            PG8_LDB(B0, 1, 0); PG8_SCHED; PG8_LDA(At, 1, 0); PG8_STAGE(PG8_SA(0, 1), a2 + hstep, voffA);
            PG8_WAIT_L(8); PG8_BAR; PG8_WAIT_L(0); PG8_MMA(0, 0, At, B0); PG8_BAR; PG8_SCHED;
            PG8_LDB(B1, 1, 1); PG8_STAGE(PG8_SB(1, 0), b3, voffB);
            PG8_BAR; PG8_WAIT_L(0); PG8_MMA(0, 1, At, B1); PG8_BAR;
            PG8_LDA(At, 1, 1); PG8_STAGE(PG8_SA(1, 0), a3, voffA);
            PG8_BAR; PG8_WAIT_L(0); PG8_MMA(1, 0, At, B0); PG8_BAR; PG8_SCHED;
            PG8_STAGE(PG8_SB(1, 1), b3 + hstep, voffB);
            PG8_WAIT_V(6); PG8_BAR; PG8_MMA(1, 1, At, B1); PG8_BAR;
            }
        }
        if constexpr (ALIGN_EPI) { if (wr == 0) PG8_BAR; }
        if constexpr (!Epi::AFTER_DRAIN) { E(acc, cur, wr, wc, fr, fq); S.done(cur); }
        if (!has_next) break;
#pragma unroll
        for (int a = 0; a < 2; ++a)
#pragma unroll
            for (int b = 0; b < 2; ++b)
#pragma unroll
                for (int m = 0; m < 4; ++m)
#pragma unroll
                    for (int n = 0; n < 2; ++n) acc[a][b][m][n] = (f32x4){0.f, 0.f, 0.f, 0.f};
        cur = nxt; cA = nA; cB = nB; ++ui;
        if constexpr (ALIGN_EPI) { if (wr == 1) PG8_BAR; }
    }
    PG8_WAIT_V(0);
    if constexpr (!ALIGN_EPI) { if (wr == 0) PG8_BAR; }
    PG8_BAR;
    if constexpr (Epi::AFTER_DRAIN) { E.fused(acc, cur, wr, wc, fr, fq, lds, wid, lane); S.done(cur); }
#undef PG8_SA
#undef PG8_SB
#undef PG8_STAGE
#undef PG8_LDA
#undef PG8_LDB
#undef PG8_MMA
#undef PG8_WAIT_V
#undef PG8_WAIT_L
#undef PG8_BAR
#undef PG8_SCHED
}
}
namespace att {
#define ALAS __attribute__((address_space(3)))
#define AGAS __attribute__((address_space(1)))
typedef unsigned short bf16_t;
typedef short bf16x8 __attribute__((ext_vector_type(8)));
typedef short s16x4 __attribute__((ext_vector_type(4)));
typedef float f32x16 __attribute__((ext_vector_type(16)));
typedef unsigned u32x4 __attribute__((ext_vector_type(4)));
typedef float f32x2_t __attribute__((ext_vector_type(2))); typedef __bf16 bf16x2_t __attribute__((ext_vector_type(2)));
constexpr int KPMAX = 208, VP = 192, KSZ = 64 * KPMAX, VSZ = 64 * VP;
constexpr int OFF_V = 2 * KSZ, OFF_SCR = OFF_V + 2 * VSZ, OFF_Q = OFF_SCR + 8 * 256, LDS_BYTES = OFF_Q + 64;
constexpr float NEGF = -1e30f, THR = 6.0f;
__device__ __forceinline__ int crow(int r, int hi) { return (r & 3) + 8 * (r >> 2) + 4 * hi; }
__device__ __forceinline__ unsigned cvtpk(float lo, float hi) { f32x2_t v = {lo, hi}; bf16x2_t b = __builtin_convertvector(v, bf16x2_t); return __builtin_bit_cast(unsigned, b); }
__device__ __forceinline__ bf16x8 pack8(const f32x16& p, int s) { u32x4 w; w.x = cvtpk(p[8 * s], p[8 * s + 1]); w.y = cvtpk(p[8 * s + 2], p[8 * s + 3]); w.z = cvtpk(p[8 * s + 4], p[8 * s + 5]); w.w = cvtpk(p[8 * s + 6], p[8 * s + 7]); return __builtin_bit_cast(bf16x8, w); }
typedef short v4i16_t __attribute__((ext_vector_type(4)));
__device__ __forceinline__ float max3f(float a, float b, float c) { float r; asm("v_max3_f32 %0, %1, %2, %3" : "=v"(r) : "v"(a), "v"(b), "v"(c)); return r; }
__device__ __forceinline__ float max2f(float a, float b) { float r; asm("v_max_f32_e32 %0, %1, %2" : "=v"(r) : "v"(a), "v"(b)); return r; }
__device__ __forceinline__ float xhalf_max(float m) { auto rr = __builtin_amdgcn_permlane32_swap(__float_as_uint(m), __float_as_uint(m), false, false); return max2f(__uint_as_float(rr[0]), __uint_as_float(rr[1])); }
__device__ __forceinline__ s16x4 vtr(const ALAS unsigned char* p) { return __builtin_bit_cast(s16x4, __builtin_amdgcn_ds_read_tr16_b64_v4i16((ALAS v4i16_t*)p)); }
__device__ __forceinline__ unsigned short f2bf(float f) { unsigned u = __builtin_bit_cast(unsigned, f); return (unsigned short)((u + 0x7fffu + ((u >> 16) & 1u)) >> 16); }

template <int DQK, bool SWA>
__device__ __forceinline__ void attn_unit(ALAS unsigned char* lds, const bf16_t* Qp, int qpitch, const bf16_t* Kp, int kpitch, const bf16_t* Krp, const bf16_t* Vp, int vpitch,
                                          bf16_t* Op, float* ssq, float sink2, int b, int qb) {
    constexpr int KP = DQK * 2 + 16, NS = DQK / 16;
    int tid_ = threadIdx.x; asm volatile("" : "+v"(tid_));
    const int tid = tid_, lane = tid & 63, wid = __builtin_amdgcn_readfirstlane(tid >> 6), r = lane & 31, h = lane >> 5;
    const size_t rowbase = (size_t)b * TT;
    const int q0 = qb * 256, q0w = q0 + wid * 32;
    const bool wave_valid = q0w < TT;
    const int NT = (q0 + 256) / 64 < TT / 64 ? (q0 + 256) / 64 : TT / 64;
    int t0 = 1; if (SWA) { t0 = (q0 - 128) / 64; if (t0 < 1) t0 = 1; }
    ALAS float* scr = (ALAS float*)(lds + OFF_SCR + wid * 256);
    bf16x8 qf[NS];
    { const int qr = (q0w + r) < TT ? (q0w + r) : TT - 1; const bf16_t* qrow = Qp + (rowbase + qr) * (size_t)qpitch;
#pragma unroll
      for (int s = 0; s < NS; ++s) qf[s] = *(const AGAS bf16x8*)(qrow + 16 * s + 8 * h); }
    const int srow = tid >> 3, sch = tid & 7, rrow = (tid >> 2) & 63, rch = tid & 3;
    u32x4 kregA, vregA, rregA = {0u, 0u, 0u, 0u}, kregB, vregB, rregB = {0u, 0u, 0u, 0u};
#define AT_GLOAD(t, S) do { const size_t kr_ = rowbase + 64 * (t) + srow; kreg##S = *(const AGAS u32x4*)(Kp + kr_ * (size_t)kpitch + sch * 8); vreg##S = *(const AGAS u32x4*)(Vp + kr_ * (size_t)vpitch + sch * 8); \
        if (DQK == 96) { if (tid < 256) rreg##S = *(const AGAS u32x4*)(Krp + (rowbase + 64 * (t) + rrow) * 32 + rch * 8); } } while (0)
#define AT_LSTORE(buf, S) do { *(ALAS u32x4*)(lds + (buf) * KSZ + srow * KP + sch * 16) = kreg##S; *(ALAS u32x4*)(lds + OFF_V + (buf) * VSZ + srow * VP + sch * 16) = vreg##S; \
        if (DQK == 96) { if (tid < 256) *(ALAS u32x4*)(lds + (buf) * KSZ + rrow * KP + 128 + rch * 16) = rreg##S; } } while (0)
    AT_GLOAD(t0, A); AT_LSTORE(0, A);
    if (t0 + 1 < NT) AT_GLOAD(t0 + 1, A);
    __syncthreads();
    if (wid >= 4) __builtin_amdgcn_s_setprio(1);
    float mrun = SWA ? sink2 : 0.0f, lrun = (SWA && h == 0) ? 1.0f : 0.0f;
    bool first_ = !SWA;
    f32x16 negm;
#pragma unroll
    for (int i = 0; i < 16; ++i) negm[i] = -mrun;
    f32x16 o0, o1;
#pragma unroll
    for (int i = 0; i < 16; ++i) { o0[i] = 0.f; o1[i] = 0.f; }
    const int q = q0w + r;
#define AT_PVF(P, j) do { o0 = __builtin_amdgcn_mfma_f32_32x32x16_bf16(P, __builtin_shufflevector(vlo[2 * (j)], vhi[2 * (j)], 0, 1, 2, 3, 4, 5, 6, 7), o0, 0, 0, 0); o1 = __builtin_amdgcn_mfma_f32_32x32x16_bf16(P, __builtin_shufflevector(vlo[2 * (j) + 1], vhi[2 * (j) + 1], 0, 1, 2, 3, 4, 5, 6, 7), o1, 0, 0, 0); } while (0)
#define AT_PV(P, rowoff) do { \
                { const s16x4 lo = vtr(vb_ + (rowoff) * VP), hi = vtr(vb_ + ((rowoff) + 8) * VP); const bf16x8 vf = __builtin_shufflevector(lo, hi, 0, 1, 2, 3, 4, 5, 6, 7); o0 = __builtin_amdgcn_mfma_f32_32x32x16_bf16(P, vf, o0, 0, 0, 0); } \
                { const s16x4 lo = vtr(vb_ + (rowoff) * VP + 64), hi = vtr(vb_ + ((rowoff) + 8) * VP + 64); const bf16x8 vf = __builtin_shufflevector(lo, hi, 0, 1, 2, 3, 4, 5, 6, 7); o1 = __builtin_amdgcn_mfma_f32_32x32x16_bf16(P, vf, o1, 0, 0, 0); } } while (0)
#define AT_STEP(t, LS, SS) do { \
        const int buf = (t - t0) & 1; \
        if (t + 2 < NT) AT_GLOAD(t + 2, LS); \
        const int kfirst = 64 * t; \
        bool active = wave_valid && (kfirst <= q0w + 31); \
        if (SWA) active = active && (kfirst + 63 >= q0w - 127); \
        if (active) { \
            f32x16 s0, s1; \
            const ALAS unsigned char* kb = lds + buf * KSZ + r * KP + h * 16; \
            bf16x8 kf[2 * NS]; \
_Pragma("unroll") \
            for (int s = 0; s < NS; ++s) { kf[2 * s] = *(const ALAS bf16x8*)(kb + s * 32); kf[2 * s + 1] = *(const ALAS bf16x8*)(kb + 32 * KP + s * 32); } \
            __builtin_amdgcn_sched_barrier(0); \
_Pragma("unroll") \
            for (int s = 0; s < NS; ++s) { if (s == 0) { s0 = __builtin_amdgcn_mfma_f32_32x32x16_bf16(kf[0], qf[0], negm, 0, 0, 0); s1 = __builtin_amdgcn_mfma_f32_32x32x16_bf16(kf[1], qf[0], negm, 0, 0, 0); } else { s0 = __builtin_amdgcn_mfma_f32_32x32x16_bf16(kf[2 * s], qf[s], s0, 0, 0, 0); s1 = __builtin_amdgcn_mfma_f32_32x32x16_bf16(kf[2 * s + 1], qf[s], s1, 0, 0, 0); } } \
            __builtin_amdgcn_sched_barrier(0); \
            const ALAS unsigned char* vb_ = lds + OFF_V + buf * VSZ + (4 * h + ((lane & 15) >> 2)) * VP + ((lane >> 4) & 1) * 32 + (lane & 3) * 8; \
            s16x4 vlo[8], vhi[8]; \
_Pragma("unroll") \
            for (int j = 0; j < 4; ++j) { vlo[2 * j] = vtr(vb_ + (16 * j) * VP); vhi[2 * j] = vtr(vb_ + (16 * j + 8) * VP); vlo[2 * j + 1] = vtr(vb_ + (16 * j) * VP + 64); vhi[2 * j + 1] = vtr(vb_ + (16 * j + 8) * VP + 64); } \
            __builtin_amdgcn_sched_barrier(0); \
            const bool need_mask = SWA || (t == 1) || (kfirst + 63 > q0w); \
            if (need_mask) { \
_Pragma("unroll") \
                for (int i = 0; i < 16; ++i) { const int key = kfirst + crow(i, h), key1 = key + 32; \
                    bool ok0 = (key <= q) && (key >= FRONT), ok1 = (key1 <= q) && (key1 >= FRONT); \
                    if (SWA) { ok0 = ok0 && (q - key < 128); ok1 = ok1 && (q - key1 < 128); } \
                    s0[i] = ok0 ? s0[i] : NEGF; s1[i] = ok1 ? s1[i] : NEGF; } \
            } \
            float rm = max3f(s0[0], s0[1], s1[0]), rm2 = max3f(s0[2], s0[3], s1[1]); rm = max3f(rm, s1[2], s1[3]); \
_Pragma("unroll") \
            for (int i = 4; i < 16; i += 4) { rm = max3f(rm, s0[i], s0[i + 1]); rm2 = max3f(rm2, s0[i + 2], s0[i + 3]); rm = max3f(rm, s1[i], s1[i + 1]); rm2 = max3f(rm2, s1[i + 2], s1[i + 3]); } \
            rm = xhalf_max(max2f(rm, rm2)); \
            if (first_ || __any(rm > THR)) { \
                const float dl = first_ ? (rm > -1e29f ? rm : 0.f) : max2f(rm, 0.f); first_ = false; \
                mrun += dl; const float f = __builtin_amdgcn_exp2f(-dl); lrun *= f; \
_Pragma("unroll") \
                for (int i = 0; i < 16; ++i) { s0[i] -= dl; s1[i] -= dl; negm[i] = -mrun; } \
                if (h == 0) scr[r] = f; \
_Pragma("unroll") \
                for (int i = 0; i < 16; ++i) { const float fi = scr[crow(i, h)]; o0[i] *= fi; o1[i] *= fi; } \
            } \
            float ls = 0.f; \
_Pragma("unroll") \
            for (int i = 0; i < 16; ++i) { s0[i] = __builtin_amdgcn_exp2f(s0[i]); s1[i] = __builtin_amdgcn_exp2f(s1[i]); ls += s0[i] + s1[i]; } \
            lrun += ls; \
            const bf16x8 p0 = pack8(s0, 0), p1 = pack8(s0, 1), p2 = pack8(s1, 0), p3 = pack8(s1, 1); \
            __builtin_amdgcn_sched_barrier(0); \
            AT_PVF(p0, 0); AT_PVF(p1, 1); AT_PVF(p2, 2); AT_PVF(p3, 3); \
        } \
        if (t + 1 < NT) AT_LSTORE(buf ^ 1, SS); \
        __syncthreads(); \
    } while (0)
    {
        int t = t0;
        for (; t + 1 < NT; t += 2) { AT_STEP(t, B, A); const int t1 = t + 1; AT_STEP(t1, A, B); }
        if (t < NT) AT_STEP(t, B, A);
    }
#undef AT_STEP
#undef AT_PV
#undef AT_GLOAD
#undef AT_LSTORE
    __builtin_amdgcn_s_setprio(0);
    if (wave_valid) {
        const float lt = lrun + __shfl_xor(lrun, 32);
        if (h == 0) scr[32 + r] = lt;
        ALAS bf16_t* stg = (ALAS bf16_t*)(lds + wid * 4096);
#pragma unroll
        for (int i = 0; i < 16; ++i) {
            const float li = scr[32 + crow(i, h)], inv = li > 0.f ? 1.0f / li : 0.f;
            const int orow = crow(i, h);
            stg[orow * 64 + r] = f2bf(o0[i] * inv); stg[orow * 64 + 32 + r] = f2bf(o1[i] * inv);
        }
#pragma unroll
        for (int i = 0; i < 4; ++i) {
            const int lrow = i * 8 + (lane >> 3), ch = lane & 7; const u32x4 v = *(const ALAS u32x4*)(stg + lrow * 64 + ch * 8);
            const size_t row = rowbase + q0w + lrow;
            *(AGAS u32x4*)(Op + row * 1024 + ch * 8) = v;
            float ss = 0.f;
#pragma unroll
            for (int j = 0; j < 4; ++j) { const unsigned w = v[j]; const float lo = __builtin_bit_cast(float, w << 16), hi = __builtin_bit_cast(float, w & 0xffff0000u); ss += lo * lo + hi * hi; }
            ss += __shfl_xor(ss, 1); ss += __shfl_xor(ss, 2); ss += __shfl_xor(ss, 4);
            if (ch == 0) ((AGAS float*)ssq)[row * 16] = ss;
        }
    }
    __syncthreads();
}
}
typedef unsigned short bf16;
#define LAS __attribute__((address_space(3)))
#define GAS __attribute__((address_space(1)))
constexpr size_t MiB = 1u << 20;
constexpr int NWAVES = 8, NTHREADS = 512;
constexpr int LDS_BYTES = 147456;
static_assert(att::LDS_BYTES <= 131072, "attention LDS");
constexpr size_t WS_CTL = 0, CTL_BYTES = 65536;
constexpr size_t WS_H = 1 * MiB;
constexpr size_t WS_HB = WS_H + (size_t)MROWS * DM * 4;
constexpr size_t WS_W = WS_HB + (size_t)MROWS * DM * 2;
constexpr size_t WL_IN = 0, WL_Q = WL_IN + (size_t)INP * DM * 2, WL_KV = WL_Q + (size_t)768 * 256 * 2, WL_O = WL_KV + (size_t)1024 * 128 * 2,
                 WL_GU = WL_O + (size_t)DM * DM * 2, WL_D = WL_GU + (size_t)GUP * DM * 2, WL_END = WL_D + (size_t)DM * DFF * 2;
constexpr size_t WBUF = 22 * MiB;
static_assert(WL_END <= WBUF, "weight buffer");
constexpr size_t WS_PART = WS_W + 2 * WBUF;
constexpr size_t P_HSSA = 0, P_HSSB = P_HSSA + (size_t)MROWS * 64, P_SSQO = P_HSSB + (size_t)MROWS * 64, P_SSQQ = P_SSQO + (size_t)MROWS * 64, P_SSQKV = P_SSQQ + (size_t)MROWS * 16, P_END = P_SSQKV + (size_t)MROWS * 16;
constexpr size_t PM_H = (P_END + 255) & ~(size_t)255, PM_HB = PM_H + 16 * DM * 4, PM_HSSA = PM_HB + 16 * DM * 2, PM_HSSB = PM_HSSA + 1024, PM_SSQQ = PM_HSSB + 1024, PM_SSQKV = PM_SSQQ + 256,
                 PM_QLAT = PM_SSQKV + 256, PM_KVLAT = PM_QLAT + 16 * 256 * 2, PM_ACT = PM_KVLAT + 16 * 128 * 2, PM_END = PM_ACT + 16 * DFF * 2;
static_assert(PM_END <= 8 * MiB, "partials");
constexpr int MC = BATCH * SEQ;
constexpr size_t WS_R = WS_PART + 8 * MiB;
constexpr size_t R_QA = 0, R_KA = R_QA + (size_t)MROWS * 512 * 2, R_VA = R_KA + (size_t)MROWS * 128 * 2, R_QLAT = R_VA + (size_t)MROWS * 128 * 2, R_KVLAT = R_QLAT + (size_t)MROWS * 256 * 2,
                 R_KR = R_KVLAT + (size_t)MROWS * 128 * 2, R_QM = R_KR + (size_t)MROWS * 32 * 2, R_KN = R_QM + (size_t)MROWS * 768 * 2, R_VB = R_KN + (size_t)MROWS * 512 * 2,
                 R_O = R_VB + (size_t)MROWS * 512 * 2, R_END = R_O + (size_t)MROWS * 1024 * 2;
constexpr size_t R_ACT = 0;
static_assert((size_t)MROWS * DFF * 2 <= R_END, "act overlay");
constexpr size_t WS_END = WS_R + R_END;
static_assert(WS_END <= 512 * MiB, "workspace must fit 512 MiB");

struct Args {
    const float *x, *meta, *attn_norm, *w_in, *q_norm, *w_q_up, *kv_norm, *w_kv_up, *sinks, *out_norm_swa, *out_norm_mla, *w_o, *ffn_norm, *w_gate, *w_up, *w_down, *final_norm;
    float* out; unsigned char* ws; int ph_lo, ph_hi;
};

__device__ __forceinline__ unsigned f2bf_u(float f) { unsigned u = __builtin_bit_cast(unsigned, f); return (u + 0x7fffu + ((u >> 16) & 1u)) >> 16; }
__device__ __forceinline__ unsigned pk2(float lo, float hi) { return f2bf_u(lo) | (f2bf_u(hi) << 16); }
__device__ __forceinline__ float wave_sum(float v) {
#pragma unroll
    for (int o = 1; o < 64; o <<= 1) v += __shfl_xor(v, o);
    return v;
}

__device__ __forceinline__ int src_in(int np) { const int pn = np >> 8, bj = (np >> 7) & 1, o = np & 127;
    if (pn < 2) return (4 * pn + (o >> 5)) * 64 + (o & 31) + 32 * bj;
    if (pn == 2) { if (o < 64) return 512 + (o >> 5) * 64 + (o & 31) + 32 * bj; if (o < 80) return 1152 + (o - 64) + 16 * bj; return -1; }
    if (pn == 3) return bj ? 1024 + o : 640 + o;
    return 768 + 128 * bj + o; }
__device__ __forceinline__ int src_qup(int np) { const int pn = np >> 8, op = np & 255;
    if (pn < 2) return (4 * pn + (op >> 6)) * 96 + (op & 63);
    const int bj = op >> 7, o = op & 127; return (o >> 4) * 96 + 64 + (o & 15) + 16 * bj; }
__device__ __forceinline__ int src_kvup(int np) { const int pn = np >> 8, op = np & 255; return (4 * (pn & 1) + (op >> 6)) * 128 + (pn >= 2 ? 64 : 0) + (op & 63); }

template <int MODE>
__device__ __forceinline__ void conv_item(const float* W, const float* W2, const float* gain, const float* gain2, int K, int Nsrc, bf16* WT, LAS float* scr, int item, int nblk, int lane) {
    const int kb = item / nblk, nb = item % nblk, k0 = 64 * kb, n0 = 32 * nb;
    const int nn = 4 * (lane & 7), np = n0 + nn;
    int src; float cs = 1.0f; const float* Wp = W;
    if (MODE == 0) { src = src_in(np); if (np < 512) cs = 0.125f * LOG2E; }
    else if (MODE == 1) { src = src_qup(np); cs = 0.10206207261596577f * LOG2E; }
    else if (MODE == 2) src = src_kvup(np);
    else if (MODE == 4) { src = 128 * (np >> 8) + (np & 127); if ((np >> 7) & 1) Wp = W2; }
    else src = np;
#pragma unroll
    for (int i = 0; i < 8; ++i) { const int kk = 8 * i + (lane >> 3), k = k0 + kk;
        float g = 1.0f; if (MODE == 3) g = (k < 512) ? ((const GAS float*)gain)[k] : ((const GAS float*)gain2)[k - 512]; else if (MODE != 5) g = ((const GAS float*)gain)[k];
        pg8::f32x4 v = {0.f, 0.f, 0.f, 0.f}; if (src >= 0) v = *(const GAS pg8::f32x4*)(Wp + (size_t)k * Nsrc + src);
        g *= cs; scr[kk * 33 + nn] = v[0] * g; scr[kk * 33 + nn + 1] = v[1] * g; scr[kk * 33 + nn + 2] = v[2] * g; scr[kk * 33 + nn + 3] = v[3] * g; }
    asm volatile("s_waitcnt lgkmcnt(0)" ::: "memory");
    const int c = lane & 7;
#pragma unroll
    for (int j = 0; j < 4; ++j) { const int n = (lane >> 3) + 8 * j; const LAS float* s = scr + (8 * c) * 33 + n;
        pg8::u32x4 o; o.x = pk2(s[0 * 33], s[1 * 33]); o.y = pk2(s[2 * 33], s[3 * 33]); o.z = pk2(s[4 * 33], s[5 * 33]); o.w = pk2(s[6 * 33], s[7 * 33]);
        *(GAS pg8::u32x4*)(WT + (size_t)(n0 + n) * K + k0 + 8 * c) = o; }
    asm volatile("s_waitcnt lgkmcnt(0)" ::: "memory");
}
__device__ __forceinline__ void conv_layer(const Args& a, int l, unsigned char* wbuf, LAS unsigned char* lds) {
    int tid_ = threadIdx.x; asm volatile("" : "+v"(tid_));
    const int lane = tid_ & 63, wave = tid_ >> 6;
    LAS float* scr = (LAS float*)(lds + wave * 16384);
    const int gw = blockIdx.x * NWAVES + wave, NGW = gridDim.x * NWAVES;
    constexpr int I0 = (DM / 64) * (INP / 32), I1 = (256 / 64) * (768 / 32), I2 = (128 / 64) * (1024 / 32), I3 = (DM / 64) * (DM / 32), I4 = (DM / 64) * (GUP / 32), I5 = (DFF / 64) * (DM / 32);
    constexpr int NIT = I0 + I1 + I2 + I3 + I4 + I5;
    for (int it = gw; it < NIT; it += NGW) {
        int r = it;
        if (r < I0) { conv_item<0>(a.w_in + (size_t)l * DM * INW, nullptr, a.attn_norm + l * DM, nullptr, DM, INW, (bf16*)(wbuf + WL_IN), scr, r, INP / 32, lane); continue; } r -= I0;
        if (r < I1) { conv_item<1>(a.w_q_up + (size_t)l * 256 * 768, nullptr, a.q_norm + l * 256, nullptr, 256, 768, (bf16*)(wbuf + WL_Q), scr, r, 768 / 32, lane); continue; } r -= I1;
        if (r < I2) { conv_item<2>(a.w_kv_up + (size_t)l * 128 * 1024, nullptr, a.kv_norm + l * 128, nullptr, 128, 1024, (bf16*)(wbuf + WL_KV), scr, r, 1024 / 32, lane); continue; } r -= I2;
        if (r < I3) { conv_item<3>(a.w_o + (size_t)l * DM * DM, nullptr, a.out_norm_swa + l * 512, a.out_norm_mla + l * 512, DM, DM, (bf16*)(wbuf + WL_O), scr, r, DM / 32, lane); continue; } r -= I3;
        if (r < I4) { conv_item<4>(a.w_gate + (size_t)l * DM * DFF, a.w_up + (size_t)l * DM * DFF, a.ffn_norm + l * DM, nullptr, DM, DFF, (bf16*)(wbuf + WL_GU), scr, r, GUP / 32, lane); continue; } r -= I4;
        conv_item<5>(a.w_down + (size_t)l * DFF * DM, nullptr, nullptr, nullptr, DFF, DM, (bf16*)(wbuf + WL_D), scr, r, DM / 32, lane);
    }
}

__device__ __forceinline__ void init_rows(const Args& a, unsigned char* ws) {
    const int lane = threadIdx.x & 63, wave = threadIdx.x >> 6; const int gw = blockIdx.x * NWAVES + wave, NGW = gridDim.x * NWAVES;
    for (int row = gw; row < MC + NMETA; row += NGW) {
        const bool meta = row >= MC; const int r = meta ? row - MC : row;
        const float* src = meta ? a.meta + (size_t)r * DM : a.x + (size_t)r * DM;
        float* H = (float*)(ws + (meta ? WS_PART + PM_H : WS_H)); bf16* HB = (bf16*)(ws + (meta ? WS_PART + PM_HB : WS_HB)); float* hss = (float*)(ws + WS_PART + (meta ? PM_HSSA : P_HSSA));
        pg8::f32x4 v[4]; float s = 0.f;
#pragma unroll
        for (int j = 0; j < 2; ++j) { v[2 * j] = *((const GAS pg8::f32x4*)src + 2 * (lane + 64 * j)); v[2 * j + 1] = *((const GAS pg8::f32x4*)src + 2 * (lane + 64 * j) + 1); s += pg8::sq4(v[2 * j]) + pg8::sq4(v[2 * j + 1]); }
        s = wave_sum(s);
#pragma unroll
        for (int j = 0; j < 2; ++j) pg8::st_bf16x8(HB + (size_t)r * DM + 8 * (lane + 64 * j), v[2 * j], v[2 * j + 1]);
        if (lane < 16) ((GAS float*)hss)[(size_t)r * 16 + lane] = (lane == 0) ? s : 0.f;
    }
}
__device__ __forceinline__ void final_rows(const Args& a, const bf16* HBf, const float* hss) {
    const int lane = threadIdx.x & 63, wave = threadIdx.x >> 6; const int gw = blockIdx.x * NWAVES + wave, NGW = gridDim.x * NWAVES;
    for (int o = gw; o < BATCH * SEQ; o += NGW) {
        const int row = o;
        const float rs = pg8::rsq(pg8::sum16(hss, row) * (1.0f / DM) + RMS_EPS);
#pragma unroll
        for (int j = 0; j < 2; ++j) { const pg8::u32x4 hw = *((const GAS pg8::u32x4*)(HBf + (size_t)row * DM) + lane + 64 * j); pg8::f32x4 v0, v1;
            v0[0] = __builtin_bit_cast(float, hw.x << 16); v0[1] = __builtin_bit_cast(float, hw.x & 0xffff0000u); v0[2] = __builtin_bit_cast(float, hw.y << 16); v0[3] = __builtin_bit_cast(float, hw.y & 0xffff0000u);
            v1[0] = __builtin_bit_cast(float, hw.z << 16); v1[1] = __builtin_bit_cast(float, hw.z & 0xffff0000u); v1[2] = __builtin_bit_cast(float, hw.w << 16); v1[3] = __builtin_bit_cast(float, hw.w & 0xffff0000u);
            const pg8::f32x4 g0 = *((const GAS pg8::f32x4*)a.final_norm + 2 * (lane + 64 * j)), g1 = *((const GAS pg8::f32x4*)a.final_norm + 2 * (lane + 64 * j) + 1);
            *((GAS pg8::f32x4*)(a.out + (size_t)o * DM) + 2 * (lane + 64 * j)) = v0 * rs * g0; *((GAS pg8::f32x4*)(a.out + (size_t)o * DM) + 2 * (lane + 64 * j) + 1) = v1 * rs * g1; }
    }
}

constexpr int N_ATT_UNITS = 2 * 17 * 64;
__device__ __forceinline__ void attn_phase(const Args& a, int l, unsigned char* ws, LAS unsigned char* lds, int mode = 0) {
    const int lq = l; l &= 3;
    unsigned char* R = ws + WS_R;
    const bf16 *QA = (const bf16*)(R + R_QA), *KA = (const bf16*)(R + R_KA), *VA = (const bf16*)(R + R_VA), *KR = (const bf16*)(R + R_KR), *QM = (const bf16*)(R + R_QM), *KN = (const bf16*)(R + R_KN), *VB = (const bf16*)(R + R_VB);
    bf16* O = (bf16*)(R + R_O); float* ssqO = (float*)(ws + WS_PART + P_SSQO);
    LAS int* qslot = (LAS int*)(lds + att::OFF_Q);
    const unsigned xcc = ((unsigned)__builtin_amdgcn_s_getreg((3 << 11) | 20) & 0xFu) & 7u;
    unsigned* ctr = (unsigned*)(ws + WS_CTL) + 64 * lq + 8 * 64 * (int)xcc;
    constexpr int PER_X = N_ATT_UNITS / 8;
    for (int pass = 0; pass < 8; ++pass) {
        const unsigned x = (xcc + (unsigned)pass) & 7u; unsigned* c = (unsigned*)(ws + WS_CTL) + 64 * lq + 8 * 64 * (int)x;
        for (;;) {
            if (threadIdx.x == 0) *qslot = (int)atomicAdd(c, 1u);
            __syncthreads();
            const int u = *qslot;
            __syncthreads();
            if (u >= (mode == 1 ? PER_X / 2 : PER_X)) break;
            if (u < PER_X / 2) {
                const int bh = 8 * (u / 17) + (int)x, qb = 16 - u % 17, b = bh >> 3, hd = bh & 7;
                att::attn_unit<96, false>(lds, QM + hd * 96, 768, KN + hd * 64, 512, KR, VB + hd * 64, 512, O + 512 + hd * 64, ssqO + 8 + hd, 0.f, b, qb);
            } else {
                const int v = u - PER_X / 2; const int bh = 8 * (v / 17) + (int)x, qb = 16 - v % 17, b = bh >> 3, hq = bh & 7, kv = hq >> 2;
                att::attn_unit<64, true>(lds, QA + hq * 64, 512, KA + kv * 64, 128, nullptr, VA + kv * 64, 128, O + hq * 64, ssqO + hq, a.sinks[l * 8 + hq] * LOG2E, b, qb);
            }
        }
    }
    (void)ctr;
}

#define XB_TMO      128
#define XB_XCNT(j)  (256  + 64 * (j))
#define XB_XSUB(j)  (1280 + 64 * (j))
#define XB_XGEN(j)  (2304 + 64 * (j))
#define XB_TOP      3328
#define XB_TOPGEN   3392
#define XCD_BAR_WORDS 3456
#define XB_SPIN_CAP (1u << 18)

__device__ __forceinline__ unsigned xb_ld(unsigned* p)              { return __hip_atomic_load(p, __ATOMIC_RELAXED, __HIP_MEMORY_SCOPE_AGENT); }
__device__ __forceinline__ unsigned xb_add(unsigned* p, unsigned v) { return __hip_atomic_fetch_add(p, v, __ATOMIC_RELAXED, __HIP_MEMORY_SCOPE_AGENT); }
__device__ __forceinline__ unsigned xb_xcc_id() { return (unsigned)__builtin_amdgcn_s_getreg((3 << 11) | 20) & 0xFu; }
#define XB_SPIN(cond, bar) do { unsigned _sp = 0; while (cond) { __builtin_amdgcn_s_sleep(1); \
    if ((++_sp & 255u) == 0u) { if (xb_ld(&(bar)[XB_TMO])) break; if (_sp > XB_SPIN_CAP) { atomicAdd(&(bar)[XB_TMO], 1u); break; } } } } while (0)

struct XcdBarrier {
    unsigned* bar; unsigned x;
    volatile LAS unsigned* st;
};

__device__ __forceinline__ XcdBarrier xcd_barrier_post(unsigned* bar, volatile LAS unsigned* st) {
    XcdBarrier b; b.bar = bar; b.x = xb_xcc_id(); b.st = st;
    if (threadIdx.x == 0) (void)xb_add(&bar[XB_XCNT(b.x)], 1u);
    return b;
}
__device__ __forceinline__ void xcd_barrier_complete(unsigned* bar, unsigned x, unsigned& nloc, unsigned& nx) {
    const unsigned G = gridDim.x * gridDim.y * gridDim.z;
    unsigned sum, cnt, mine, sp = 0u;
    for (;;) {
        sum = 0u; cnt = 0u; mine = 0u;
#pragma unroll
        for (unsigned j = 0; j < 16; ++j) { const unsigned c = xb_ld(&bar[XB_XCNT(j)]); sum += c; cnt += (c > 0u) ? 1u : 0u; mine = (j == x) ? c : mine; }
        if (sum == G) break;
        __builtin_amdgcn_s_sleep(1);
        if ((++sp & 255u) == 0u) { if (xb_ld(&bar[XB_TMO])) break; if (sp > XB_SPIN_CAP) { atomicAdd(&bar[XB_TMO], 1u); break; } }
    }
    nloc = mine > 0u ? mine : 1u; nx = cnt > 0u ? cnt : 1u;
}

__device__ __forceinline__ void xcd_barrier(const XcdBarrier& b) {
    asm volatile("s_waitcnt vmcnt(0)" ::: "memory");
    __syncthreads();
    if (threadIdx.x == 0) {
        unsigned* bar = b.bar;
        __builtin_amdgcn_s_waitcnt(0);
        unsigned nloc = b.st[0], nx = b.st[1];
        if (nloc == 0u) { xcd_barrier_complete(bar, b.x, nloc, nx); b.st[0] = nloc; b.st[1] = nx; }
        const unsigned old = xb_add(&bar[XB_XSUB(b.x)], 1u);
        const unsigned gen = old / nloc;
        if (old + 1u == (gen + 1u) * nloc) {
            __builtin_amdgcn_fence(__ATOMIC_RELEASE, "agent");
            asm volatile("s_waitcnt vmcnt(0)" ::: "memory");
            const unsigned og = xb_add(&bar[XB_TOP], 1u);
            const unsigned tg = og / nx;
            if (og + 1u == (tg + 1u) * nx) xb_add(&bar[XB_TOPGEN], 1u);
            else XB_SPIN(xb_ld(&bar[XB_TOPGEN]) == tg, bar);
            __builtin_amdgcn_fence(__ATOMIC_ACQUIRE, "agent");
            xb_add(&bar[XB_XGEN(b.x)], 1u);
            asm volatile("s_waitcnt vmcnt(0)" ::: "memory");
        } else {
            XB_SPIN(xb_ld(&bar[XB_XGEN(b.x)]) == gen, bar);
            __builtin_amdgcn_fence(__ATOMIC_ACQUIRE, "agent");
            asm volatile("s_waitcnt vmcnt(0)" ::: "memory");
        }
    }
    __syncthreads();
}

constexpr int CW_BAR = 4096;
constexpr int XB_LDS_OFF = 131072 + 8192;
#ifndef PHM
#define PHM 255
#endif
#ifndef PROBE_DUP
#define PROBE_DUP 0
#endif
#ifndef PROBE_SYNC
#define PROBE_SYNC 0
#endif
__global__ void __launch_bounds__(NTHREADS, 2) fwd_megakernel(Args a) {
    extern __shared__ __attribute__((aligned(16))) unsigned char lds_raw[];
    LAS unsigned char* lds = (LAS unsigned char*)lds_raw;
    cg::grid_group grid = cg::this_grid();
    const int lo = a.ph_lo, hi = a.ph_hi;
    if (threadIdx.x < 2) ((LAS unsigned*)(lds + XB_LDS_OFF))[threadIdx.x] = 0u;
    __syncthreads();
    if (a.ph_hi < 0) grid.sync();
    const XcdBarrier xbar = xcd_barrier_post((unsigned*)(a.ws + WS_CTL) + CW_BAR, (volatile LAS unsigned*)(lds + XB_LDS_OFF));
#define IN_PH(k) (lo <= (k) && (k) < hi)
#define SEAM(k) do { if (IN_PH(k) && IN_PH((k) + 1)) { xcd_barrier(xbar); if (PROBE_SYNC) xcd_barrier(xbar); } } while (0)
#define WSL(w) unsigned char* w = a.ws; asm volatile("" : "+s"(w))
    if (IN_PH(0) && (PHM & 1)) { WSL(ws); init_rows(a, ws); conv_layer(a, 0, ws + WS_W, lds); __syncthreads(); }
    SEAM(0);
#pragma unroll 1
    for (int l = 0; l < DEPTH; ++l) {
        const int p = 1 + 6 * l;
        if (IN_PH(p) && (PHM & 2)) {
            { WSL(ws); unsigned char* R = ws + WS_R; unsigned char* wb = ws + WS_W + (size_t)(l & 1) * WBUF; unsigned char* pm_ = ws + WS_PART;
              pg8::EpiIn<true> E{(const float*)(pm_ + PM_HSSA), (bf16*)(R + R_QA), (bf16*)(R + R_KA), (bf16*)(R + R_VA), (bf16*)(pm_ + PM_QLAT), (bf16*)(pm_ + PM_KVLAT), (bf16*)(R + R_KR), (float*)(pm_ + PM_SSQQ), (float*)(pm_ + PM_SSQKV)};
              pg8::skinny_phase<DM>(lds, (const bf16*)(pm_ + PM_HB), (const bf16*)(wb + WL_IN), INP / 256, E, 128); }
            WSL(ws); unsigned char* R = ws + WS_R; unsigned char* wb = ws + WS_W + (size_t)(l & 1) * WBUF;
            pg8::Gemm g{(const bf16*)(ws + WS_HB), (const bf16*)(wb + WL_IN), MC, INP, DM, 0}; pg8::OrderCT<MC / 256, INP / 256> S; S.init((int)gridDim.x, (int)blockIdx.x);
            pg8::EpiIn<false> E{(const float*)(ws + WS_PART + P_HSSA), (bf16*)(R + R_QA), (bf16*)(R + R_KA), (bf16*)(R + R_VA), (bf16*)(R + R_QLAT), (bf16*)(R + R_KVLAT), (bf16*)(R + R_KR),
                         (float*)(ws + WS_PART + P_SSQQ), (float*)(ws + WS_PART + P_SSQKV)};
            pg8::gemm_phase<pg8::EpiIn<false>, pg8::OrderCT<MC / 256, INP / 256>, true, true>(lds, g, S, E);
            if (PROBE_DUP & 2) pg8::gemm_phase<pg8::EpiIn<false>, pg8::OrderCT<MC / 256, INP / 256>, true, true>(lds, g, S, E);
        }
        SEAM(p);
        if (IN_PH(p + 1) && (PHM & 4)) {
            { WSL(ws); unsigned char* R = ws + WS_R; unsigned char* wb = ws + WS_W + (size_t)(l & 1) * WBUF; unsigned char* pm_ = ws + WS_PART;
              pg8::EpiQup<true> E{(const float*)(pm_ + PM_SSQQ), (bf16*)(R + R_QM)}; pg8::skinny_phase<256>(lds, (const bf16*)(pm_ + PM_QLAT), (const bf16*)(wb + WL_Q), 3, E, 128); }
            { WSL(ws); unsigned char* R = ws + WS_R; unsigned char* wb = ws + WS_W + (size_t)(l & 1) * WBUF;
              pg8::Gemm g{(const bf16*)(R + R_QLAT), (const bf16*)(wb + WL_Q), MC, 768, 256, 0}; pg8::OrderCT<MC / 256, 3> S; S.init((int)gridDim.x, (int)blockIdx.x);
              pg8::EpiQup<false> E{(const float*)(ws + WS_PART + P_SSQQ), (bf16*)(R + R_QM)}; pg8::gemm_phase<pg8::EpiQup<false>, pg8::OrderCT<MC / 256, 3>, true, true>(lds, g, S, E); if (PROBE_DUP & 4) pg8::gemm_phase<pg8::EpiQup<false>, pg8::OrderCT<MC / 256, 3>, true, true>(lds, g, S, E); }
            { WSL(ws); unsigned char* R = ws + WS_R; unsigned char* wb = ws + WS_W + (size_t)(l & 1) * WBUF; unsigned char* pm_ = ws + WS_PART;
              pg8::EpiKvup<true> E{(const float*)(pm_ + PM_SSQKV), (bf16*)(R + R_KN), (bf16*)(R + R_VB)}; pg8::skinny_phase<128>(lds, (const bf16*)(pm_ + PM_KVLAT), (const bf16*)(wb + WL_KV), 4, E, 0); }
            { WSL(ws); unsigned char* R = ws + WS_R; unsigned char* wb = ws + WS_W + (size_t)(l & 1) * WBUF;
              pg8::Gemm g{(const bf16*)(R + R_KVLAT), (const bf16*)(wb + WL_KV), MC, 1024, 128, 0}; pg8::OrderCT<MC / 256, 4> S; S.init((int)gridDim.x, (int)blockIdx.x);
              pg8::EpiKvup<false> E{(const float*)(ws + WS_PART + P_SSQKV), (bf16*)(R + R_KN), (bf16*)(R + R_VB)}; pg8::gemm_phase<pg8::EpiKvup<false>, pg8::OrderCT<MC / 256, 4>, true, true>(lds, g, S, E); if (PROBE_DUP & 4) pg8::gemm_phase<pg8::EpiKvup<false>, pg8::OrderCT<MC / 256, 4>, true, true>(lds, g, S, E); }
        }
        SEAM(p + 1);
        if (IN_PH(p + 2) && (PHM & 8)) { WSL(ws); if (l + 1 < DEPTH) { conv_layer(a, l + 1, ws + WS_W + (size_t)((l + 1) & 1) * WBUF, lds); __syncthreads(); if (PROBE_DUP & 256) { conv_layer(a, l + 1, ws + WS_W + (size_t)((l + 1) & 1) * WBUF, lds); __syncthreads(); } } attn_phase(a, l, ws, lds); if (PROBE_DUP & 8) attn_phase(a, l + 4, ws, lds); if (PROBE_DUP & 1024) attn_phase(a, l + 4, ws, lds, 1); }
        SEAM(p + 2);
        if (IN_PH(p + 3) && (PHM & 16)) {
            { WSL(ws); unsigned char* R = ws + WS_R; unsigned char* wb = ws + WS_W + (size_t)(l & 1) * WBUF; unsigned char* pm_ = ws + WS_PART;
              pg8::EpiOut<true> E; E.H = (float*)(pm_ + PM_H); E.HB = (bf16*)(pm_ + PM_HB); E.hss_out = (float*)(pm_ + PM_HSSB); E.ssq_o = (const float*)(pm_ + P_SSQO); E.xlds = lds;
              pg8::skinny_phase<DM>(lds, (const bf16*)(R + R_O) + (size_t)FRONT * 1024, (const bf16*)(wb + WL_O), 4, E, 0); }
            WSL(ws); unsigned char* R = ws + WS_R; unsigned char* wb = ws + WS_W + (size_t)(l & 1) * WBUF;
            pg8::Gemm g{(const bf16*)(R + R_O), (const bf16*)(wb + WL_O), MC, DM, DM, 1}; pg8::OrderCT<MC / 256, 4> S; S.init((int)gridDim.x, (int)blockIdx.x);
            pg8::EpiOut<false> E; E.H = (float*)(ws + WS_H); E.HB = (bf16*)(ws + WS_HB); E.hss_out = (float*)(ws + WS_PART + P_HSSB); E.ssq_o = (const float*)(ws + WS_PART + P_SSQO); E.xlds = lds + pg8::STAGE_BYTES;
            pg8::gemm_phase<pg8::EpiOut<false>, pg8::OrderCT<MC / 256, 4>, true, true>(lds, g, S, E);
        }
        SEAM(p + 3);
        if (IN_PH(p + 4) && (PHM & 32)) {
            { WSL(ws); unsigned char* wb = ws + WS_W + (size_t)(l & 1) * WBUF; unsigned char* pm_ = ws + WS_PART;
              pg8::EpiGU<true> E{(const float*)(pm_ + PM_HSSB), (bf16*)(pm_ + PM_ACT)}; pg8::skinny_phase<DM>(lds, (const bf16*)(pm_ + PM_HB), (const bf16*)(wb + WL_GU), GUP / 256, E, 0); }
            WSL(ws); unsigned char* R = ws + WS_R; unsigned char* wb = ws + WS_W + (size_t)(l & 1) * WBUF;
            pg8::Gemm g{(const bf16*)(ws + WS_HB), (const bf16*)(wb + WL_GU), MC, GUP, DM, 0}; pg8::OrderCT<MC / 256, GUP / 256> S; S.init((int)gridDim.x, (int)blockIdx.x);
            pg8::EpiGU<false> E{(const float*)(ws + WS_PART + P_HSSB), (bf16*)(R + R_ACT)};
            pg8::gemm_phase<pg8::EpiGU<false>, pg8::OrderCT<MC / 256, GUP / 256>, true, true>(lds, g, S, E);
        }
        SEAM(p + 4);
        if (IN_PH(p + 5) && (PHM & 64)) {
            { WSL(ws); unsigned char* wb = ws + WS_W + (size_t)(l & 1) * WBUF; unsigned char* pm_ = ws + WS_PART;
              pg8::EpiDown<true> E; E.H = (float*)(pm_ + PM_H); E.HB = (bf16*)(pm_ + PM_HB); E.hss_out = (float*)(pm_ + PM_HSSA); E.ssq_o = nullptr;
              pg8::skinny_phase<DFF>(lds, (const bf16*)(pm_ + PM_ACT), (const bf16*)(wb + WL_D), 4, E, 0); }
            WSL(ws); unsigned char* R = ws + WS_R; unsigned char* wb = ws + WS_W + (size_t)(l & 1) * WBUF;
            pg8::Gemm g{(const bf16*)(R + R_ACT), (const bf16*)(wb + WL_D), MC, DM, DFF, 0}; pg8::OrderCT<MC / 256, 4> S; S.init((int)gridDim.x, (int)blockIdx.x);
            pg8::EpiDown<false> E; E.H = (float*)(ws + WS_H); E.HB = (bf16*)(ws + WS_HB); E.hss_out = (float*)(ws + WS_PART + P_HSSA); E.ssq_o = nullptr;
            pg8::gemm_phase<pg8::EpiDown<false>, pg8::OrderCT<MC / 256, 4>, true, true>(lds, g, S, E);
        }
        SEAM(p + 5);
    }
    if (IN_PH(1 + 6 * DEPTH) && (PHM & 128)) { WSL(ws); final_rows(a, (const bf16*)(ws + WS_HB), (const float*)(ws + WS_PART + P_HSSA)); }
#undef IN_PH
#undef SEAM
#undef WSL
}
constexpr int N_PHASES = 2 + 6 * DEPTH;

#ifndef MK_SPLIT
#define MK_SPLIT 0
#endif
extern "C" void kernel_launch(void* const* d_in, const int* in_sizes, int n_in, void* d_out, int out_size, void* d_ws, size_t ws_size, hipStream_t stream) {
    static int grid = 0;
    if (grid == 0) {
        if (n_in != 17 || ws_size < WS_END) { fprintf(stderr, "kernel_launch: need 17 inputs and >= %zu bytes of workspace; got n_in %d, ws %zu\n", (size_t)WS_END, n_in, ws_size); grid = -1; return; }
        int dev = 0, cus = 0, per_cu = 0;
        hipGetDevice(&dev); hipDeviceGetAttribute(&cus, hipDeviceAttributeMultiprocessorCount, dev);
        if (hipFuncSetAttribute((const void*)fwd_megakernel, hipFuncAttributeMaxDynamicSharedMemorySize, LDS_BYTES) != hipSuccess) { fprintf(stderr, "kernel_launch: hipFuncSetAttribute failed\n"); grid = -1; return; }
        if (hipOccupancyMaxActiveBlocksPerMultiprocessor(&per_cu, (const void*)fwd_megakernel, NTHREADS, LDS_BYTES) != hipSuccess || per_cu < 1) { fprintf(stderr, "kernel_launch: occupancy query says %d\n", per_cu); per_cu = 1; }
        (void)hipGetLastError();
        grid = cus * 1;
    }
    if (grid < 0) return;
    hipMemsetAsync((char*)d_ws + WS_CTL, 0, CTL_BYTES, stream);
    Args a{};
    const float** f = (const float**)&a;
    for (int i = 0; i < 17; ++i) f[i] = (const float*)d_in[i];
    a.out = (float*)d_out; a.ws = (unsigned char*)d_ws;
#if MK_SPLIT
    for (int ph = 0; ph < N_PHASES; ++ph) { a.ph_lo = ph; a.ph_hi = ph + 1; hipLaunchKernelGGL(fwd_megakernel, dim3(grid), dim3(NTHREADS), LDS_BYTES, stream, a); }
#else
    a.ph_lo = 0; a.ph_hi = N_PHASES;
    void* args[] = {&a};
    hipError_t e = hipLaunchCooperativeKernel((const void*)fwd_megakernel, dim3(grid), dim3(NTHREADS), args, LDS_BYTES, stream);
    if (e != hipSuccess) fprintf(stderr, "cooperative launch failed: %s (grid %d)\n", hipGetErrorString(e), grid);
#endif
}
```

```cpp
#include <hip/hip_runtime.h>
#include <hip/hip_cooperative_groups.h>
#include <cstdio>
#include <cstdint>
namespace cg = cooperative_groups;

constexpr int BATCH = 8, SEQ = 4096, DM = 1024, DEPTH = 4, NMETA = 16, FRONT = 112, TT = 4224;
constexpr int MROWS = BATCH * TT;
constexpr int INW = 1184, INP = 1280, DFF = 2816, GUP = 2 * DFF;
constexpr float RMS_EPS = 1e-6f;
constexpr float LOG2E = 1.4426950408889634f;
constexpr float LOG2_THETA = 13.287712379549449f;
constexpr float INV_2PI = 0.15915494309189535f;

namespace pg8 {
#define PG8_LAS __attribute__((address_space(3)))
typedef unsigned short bf16_t;
typedef short bf16x8 __attribute__((ext_vector_type(8)));
typedef float f32x4 __attribute__((ext_vector_type(4)));
typedef unsigned u32x4 __attribute__((ext_vector_type(4)));
constexpr int BM = 256, BK = 64, HALF = 128, HTB = HALF * BK * 2  , STAGE_BYTES = 8 * HTB, NXCD = 8, WGM = 8;

__host__ __device__ __forceinline__ int lds_byte(int r, int c) { const int st = (r >> 4) * 2 + (c >> 5), rr = r & 15, cc = c & 31, ob = rr * 64 + cc * 2; return st * 1024 + (ob ^ (((ob >> 9) & 1) << 5)); }
__host__ __device__ __forceinline__ void stage_rc(int b, int& R, int& C) { const int st = b / 1024, sb = b % 1024, swz = sb ^ (((sb >> 9) & 1) << 5); R = (st >> 1) * 16 + swz / 64; C = (st & 1) * 32 + (swz % 64) / 2; }
__host__ __device__ __forceinline__ int perm32(int rho) { const int n = rho >> 4, i = rho & 15; return 8 * (i >> 2) + 4 * n + (i & 3); }

struct Unit { int pm, pn; };
struct Gemm { const bf16_t* A; const bf16_t* Bt; int M, N, K; int apad; };

struct StaticOrder {
    int nM, nN, nwg, G, c;
    __host__ __device__ void init(int M, int N, int G_, int c_) { nM = M / BM; nN = N / BM; nwg = nM * nN; G = G_; c = c_; }
    __host__ __device__ bool next(int i, Unit& u) const {
        const long L = (long)i * G + c; if (L >= nwg) return false;
        int wgid = (int)L; { const int q = nwg / NXCD, r = nwg % NXCD, xcd = wgid % NXCD, off = wgid / NXCD; wgid = (xcd < r ? xcd * (q + 1) : r * (q + 1) + (xcd - r) * q) + off; }
        const int nig = WGM * nN, gid = wgid / nig, fm = gid * WGM, gsz = (nM - fm) < WGM ? (nM - fm) : WGM;
        u.pm = fm + ((wgid % nig) % gsz); u.pn = (wgid % nig) / gsz; return true;
    }
    __device__ __forceinline__ void a_ready(const Unit&) const {}
    __device__ __forceinline__ void done(const Unit&) const {}
};

__device__ __forceinline__ unsigned cvt_pk_bf16(float lo, float hi) { unsigned r; asm volatile("v_cvt_pk_bf16_f32 %0, %1, %2" : "=v"(r) : "v"(lo), "v"(hi)); return r; }

template <int NM, int NN> struct OrderCT {
    static_assert(NM % 8 == 0 || NM % 8 == 4, "last M group must be 8 or 4 tiles");
    int G, c;
    __device__ __forceinline__ void init(int G_, int c_) { G = G_; c = c_; }
    __device__ __forceinline__ bool next(int i, Unit& u) const {
        constexpr int nwg = NM * NN, q = nwg / NXCD, r = nwg % NXCD, nig = WGM * NN;
        const int L = i * G + c; if (L >= nwg) return false;
        const int xcd = L & (NXCD - 1), off = L >> 3;
        const int wgid = (xcd < r ? xcd * (q + 1) : r * (q + 1) + (xcd - r) * q) + off;
        const int gid = wgid / nig, rem = wgid - gid * nig, fm = gid * WGM;
        const int sh = (NM - fm) < WGM ? 2 : 3;
        u.pm = fm + (rem & ((1 << sh) - 1)); u.pn = rem >> sh; return true;
    }
    __device__ __forceinline__ void a_ready(const Unit&) const {}
    __device__ __forceinline__ void done(const Unit&) const {}
};
typedef unsigned u32x2 __attribute__((ext_vector_type(2)));
#define PG8_GAS __attribute__((address_space(1)))
__device__ __forceinline__ void st_bf16x4(bf16_t* p, f32x4 v) { u32x2 w; w.x = cvt_pk_bf16(v[0], v[1]); w.y = cvt_pk_bf16(v[2], v[3]); *(PG8_GAS u32x2*)p = w; }
__device__ __forceinline__ void st_bf16x8(bf16_t* p, f32x4 v0, f32x4 v1) { u32x4 w; w.x = cvt_pk_bf16(v0[0], v0[1]); w.y = cvt_pk_bf16(v0[2], v0[3]); w.z = cvt_pk_bf16(v1[0], v1[1]); w.w = cvt_pk_bf16(v1[2], v1[3]); *(PG8_GAS u32x4*)p = w; }
__device__ __forceinline__ float sum16(const float* part, int row) {
    const PG8_GAS f32x4* p = (const PG8_GAS f32x4*)(part + (size_t)row * 16); const f32x4 a = p[0], b = p[1], c = p[2], d = p[3];
    return (((a.x + a.y) + (a.z + a.w)) + ((b.x + b.y) + (b.z + b.w))) + (((c.x + c.y) + (c.z + c.w)) + ((d.x + d.y) + (d.z + d.w)));
}
__device__ __forceinline__ float sum16q(const float* part, int row, int fq) {
    const f32x4 a = *((const PG8_GAS f32x4*)(part + (size_t)row * 16) + fq); float s = (a.x + a.y) + (a.z + a.w);
    s += __shfl_xor(s, 16); s += __shfl_xor(s, 32); return s;
}
__device__ __forceinline__ float sum4(const float* part, int row) { const f32x4 a = *(const PG8_GAS f32x4*)(part + (size_t)row * 4); return (a.x + a.y) + (a.z + a.w); }
__device__ __forceinline__ float rsq(float x) { return 1.0f / sqrtf(x); }
__device__ __forceinline__ float sq4(f32x4 v) { return (v[0] * v[0] + v[1] * v[1]) + (v[2] * v[2] + v[3] * v[3]); }
#define EPI_ROWS(ai, m) for (int ai = 0; ai < 2; ++ai) for (int m = 0; m < 4; ++m)
#define EPI_ROW(u, ai, m) ((u).pm * BM + (ai) * HALF + wr * 64 + (m) * 16 + fr)

__device__ __forceinline__ int prow_of(int m) { return m + (m >> 12) * 128 + 128; }
#define EPI_NB (META ? BATCH : 1)
#define EPI_PROW(row, b) (META ? (size_t)((b) * TT + FRONT + (row)) : (size_t)prow_of(row))
#define EPI_MAIN_LOOP(CALL) _Pragma("unroll") for (int ai = 0; ai < 2; ++ai) _Pragma("unroll") for (int m = 0; m < 4; ++m) { asm volatile("" ::: "memory"); const int row = EPI_ROW(u, ai, m); \
        const f32x4 a_[2][2] = {{acc[ai][0][m][0], acc[ai][0][m][1]}, {acc[ai][1][m][0], acc[ai][1][m][1]}}; CALL; }

template <bool META> struct EpiIn {
    static constexpr bool PERM = true, AFTER_DRAIN = false, MIDSCALE = false;
    const float* hss; bf16_t *qa, *ka, *va, *qlat, *kvlat, *kr; float *ssq_q, *ssq_kv;
    __device__ __forceinline__ void mid(f32x4 (&)[2][2][4][2], const Unit&, int, int, int, int) const {}
    __device__ __forceinline__ void row_epi(const f32x4 (&a)[2][2], int row, int pn, int wc, int fr, int fq) const {
        const float rs = rsq(sum16q(hss, row, fq) * (1.0f / DM) + RMS_EPS);
        if (pn <= 2) {
            const bool is_kr = (pn == 2 && wc == 2);
            if (pn == 2 && wc == 3) return;
            const float pos = META ? (float)row : (float)((row & 4095) + NMETA);
            f32x4 o1[2], o2[2];
#pragma unroll
            for (int n = 0; n < 2; ++n) {
                const f32x4 x1 = a[0][n] * rs, x2 = a[1][n] * rs;
#pragma unroll
                for (int e = 0; e < 4; ++e) { const float d1 = (float)(8 * fq + 4 * n + e); const float inv = __builtin_amdgcn_exp2f(-d1 * (is_kr ? (LOG2_THETA / 16.0f) : (LOG2_THETA / 32.0f)));
                    const float ang = pos * inv; float rev = ang * INV_2PI; rev = rev - floorf(rev);
                    const float sn = __builtin_amdgcn_sinf(rev), cs = __builtin_amdgcn_cosf(rev); o1[n][e] = x1[e] * cs - x2[e] * sn; o2[n][e] = x2[e] * cs + x1[e] * sn; }
            }
            if (is_kr && fq >= 2) return;
#pragma unroll
            for (int b = 0; b < EPI_NB; ++b) { const size_t pr = EPI_PROW(row, b); bf16_t* d; int half;
                if (pn < 2) { d = qa + pr * 512 + (4 * pn + wc) * 64 + 8 * fq; half = 32; }
                else if (!is_kr) { d = ka + pr * 128 + wc * 64 + 8 * fq; half = 32; }
                else { d = kr + pr * 32 + 8 * fq; half = 16; }
                st_bf16x8(d, o1[0], o1[1]); st_bf16x8(d + half, o2[0], o2[1]); }
        } else if (pn == 3) {
            const int c = 32 * wc + 8 * fq; const f32x4 v0 = a[0][0] * rs, v1 = a[0][1] * rs, w0 = a[1][0] * rs, w1 = a[1][1] * rs;
#pragma unroll
            for (int b = 0; b < EPI_NB; ++b) st_bf16x8(va + EPI_PROW(row, b) * 128 + c, v0, v1);
            st_bf16x8(kvlat + (size_t)row * 128 + c, w0, w1);
            float ss = sq4(w0) + sq4(w1);
            ss += __shfl_xor(ss, 16); ss += __shfl_xor(ss, 32);
            if (fq == 0) ((PG8_GAS float*)ssq_kv)[(size_t)row * 4 + wc] = ss;
        } else {
            float ss = 0.f;
#pragma unroll
            for (int bj = 0; bj < 2; ++bj) { const int c = 128 * bj + 32 * wc + 8 * fq; const f32x4 v0 = a[bj][0] * rs, v1 = a[bj][1] * rs; st_bf16x8(qlat + (size_t)row * 256 + c, v0, v1); ss += sq4(v0) + sq4(v1); }
            ss += __shfl_xor(ss, 16); ss += __shfl_xor(ss, 32);
            if (fq == 0) ((PG8_GAS float*)ssq_q)[(size_t)row * 4 + wc] = ss;
        }
    }
    __device__ __forceinline__ void operator()(const f32x4 (&acc)[2][2][4][2], const Unit& u, int wr, int wc, int fr, int fq) const { EPI_MAIN_LOOP(row_epi(a_, row, u.pn, wc, fr, fq)) }
};

template <bool META> struct EpiQup {
    static constexpr bool PERM = true, AFTER_DRAIN = false, MIDSCALE = false;
    const float* ssq_q; bf16_t* qm;
    __device__ __forceinline__ void mid(f32x4 (&)[2][2][4][2], const Unit&, int, int, int, int) const {}
    __device__ __forceinline__ void row_epi(const f32x4 (&a)[2][2], int row, int pn, int wc, int fr, int fq) const {
        const float rs = rsq(sum4(ssq_q, row) * (1.0f / 256.0f) + RMS_EPS);
        if (pn < 2) {
#pragma unroll
            for (int bj = 0; bj < 2; ++bj) { const int head = 4 * pn + 2 * bj + (wc >> 1), d = 32 * (wc & 1) + 8 * fq; const f32x4 v0 = a[bj][0] * rs, v1 = a[bj][1] * rs;
#pragma unroll
                for (int b = 0; b < EPI_NB; ++b) st_bf16x8(qm + EPI_PROW(row, b) * 768 + head * 96 + d, v0, v1); }
        } else {
            const float pos = META ? (float)row : (float)((row & 4095) + NMETA);
            const int head = 2 * wc + (fq >> 1), i0 = 8 * (fq & 1); f32x4 o1[2], o2[2];
#pragma unroll
            for (int n = 0; n < 2; ++n) { const f32x4 x1 = a[0][n] * rs, x2 = a[1][n] * rs;
#pragma unroll
                for (int e = 0; e < 4; ++e) { const float inv = __builtin_amdgcn_exp2f(-(float)(i0 + 4 * n + e) * (LOG2_THETA / 16.0f)); const float ang = pos * inv; float rev = ang * INV_2PI; rev = rev - floorf(rev);
                    const float sn = __builtin_amdgcn_sinf(rev), cs = __builtin_amdgcn_cosf(rev); o1[n][e] = x1[e] * cs - x2[e] * sn; o2[n][e] = x2[e] * cs + x1[e] * sn; } }
#pragma unroll
            for (int b = 0; b < EPI_NB; ++b) { bf16_t* qrow = qm + EPI_PROW(row, b) * 768 + head * 96; st_bf16x8(qrow + 64 + i0, o1[0], o1[1]); st_bf16x8(qrow + 80 + i0, o2[0], o2[1]); }
        }
    }
    __device__ __forceinline__ void operator()(const f32x4 (&acc)[2][2][4][2], const Unit& u, int wr, int wc, int fr, int fq) const { EPI_MAIN_LOOP(row_epi(a_, row, u.pn, wc, fr, fq)) }
};

template <bool META> struct EpiKvup {
    static constexpr bool PERM = true, AFTER_DRAIN = false, MIDSCALE = false;
    const float* ssq_kv; bf16_t *kn, *vb;
    __device__ __forceinline__ void mid(f32x4 (&)[2][2][4][2], const Unit&, int, int, int, int) const {}
    __device__ __forceinline__ void row_epi(const f32x4 (&a)[2][2], int row, int pn, int wc, int fr, int fq) const {
        bf16_t* dst = (pn < 2 ? kn : vb) + (pn & 1) * 256;
        const float rs = rsq(sum4(ssq_kv, row) * (1.0f / 128.0f) + RMS_EPS);
#pragma unroll
        for (int bj = 0; bj < 2; ++bj) { const f32x4 v0 = a[bj][0] * rs, v1 = a[bj][1] * rs;
#pragma unroll
            for (int b = 0; b < EPI_NB; ++b) st_bf16x8(dst + EPI_PROW(row, b) * 512 + 128 * bj + 32 * wc + 8 * fq, v0, v1); }
    }
    __device__ __forceinline__ void operator()(const f32x4 (&acc)[2][2][4][2], const Unit& u, int wr, int wc, int fr, int fq) const { EPI_MAIN_LOOP(row_epi(a_, row, u.pn, wc, fr, fq)) }
};

struct EpiResid {
    static constexpr bool PERM = true, AFTER_DRAIN = false;
    float* H; bf16_t* HB; float* hss_out; const float* ssq_o;
    __device__ __forceinline__ void resid_row(const f32x4 (&a)[2][2], int row, float rs, int pn, int wc, int fr, int fq) const {
        float ss = 0.f;
#pragma unroll
        for (int bj = 0; bj < 2; ++bj) { const size_t off = (size_t)row * DM + pn * BM + 128 * bj + 32 * wc + 8 * fq;
            const u32x4 hw = *(const PG8_GAS u32x4*)(HB + off); f32x4 h0, h1;
            h0[0] = __builtin_bit_cast(float, hw.x << 16); h0[1] = __builtin_bit_cast(float, hw.x & 0xffff0000u); h0[2] = __builtin_bit_cast(float, hw.y << 16); h0[3] = __builtin_bit_cast(float, hw.y & 0xffff0000u);
            h1[0] = __builtin_bit_cast(float, hw.z << 16); h1[1] = __builtin_bit_cast(float, hw.z & 0xffff0000u); h1[2] = __builtin_bit_cast(float, hw.w << 16); h1[3] = __builtin_bit_cast(float, hw.w & 0xffff0000u);
            h0 = h0 + a[bj][0] * rs; h1 = h1 + a[bj][1] * rs; st_bf16x8(HB + off, h0, h1); ss += sq4(h0) + sq4(h1); }
        ss += __shfl_xor(ss, 16); ss += __shfl_xor(ss, 32);
        if (fq == 0) ((PG8_GAS float*)hss_out)[(size_t)row * 16 + 4 * pn + wc] = ss;
    }
    __device__ __forceinline__ void two_scales(size_t prow, float& f, float& rb) const {
        const PG8_GAS f32x4* p = (const PG8_GAS f32x4*)(ssq_o + prow * 16); const f32x4 a = p[0], b = p[1], c = p[2], d = p[3];
        const float sa = ((a.x + a.y) + (a.z + a.w)) + ((b.x + b.y) + (b.z + b.w)), sb = ((c.x + c.y) + (c.z + c.w)) + ((d.x + d.y) + (d.z + d.w));
        const float va = sa * (1.0f / 512.0f) + RMS_EPS, vb = sb * (1.0f / 512.0f) + RMS_EPS; f = sqrtf(vb / va); rb = rsq(vb);
    }
};
template <bool META> struct EpiOut : EpiResid {
    static constexpr bool MIDSCALE = true;
    PG8_LAS unsigned char* xlds;
    __device__ __forceinline__ void prep(const Unit& u, int wid, int wr, int lane) const {
        PG8_LAS float* tab = (PG8_LAS float*)(xlds + wid * 1024);
#pragma unroll
        for (int j = 0; j < 2; ++j) { const int idx = lane + 64 * j; const int row = u.pm * BM + (idx >> 6) * HALF + wr * 64 + (idx & 63);
            float f, rb; two_scales((size_t)prow_of(row), f, rb); tab[2 * idx] = f; tab[2 * idx + 1] = rb; }
    }
    __device__ __forceinline__ void mid(f32x4 (&acc)[2][2][4][2], const Unit& u, int wr, int wc, int fr, int fq) const {
        const int wid = wr * 4 + wc; const PG8_LAS float* tab = (const PG8_LAS float*)(xlds + wid * 1024);
#pragma unroll
        for (int ai = 0; ai < 2; ++ai)
#pragma unroll
            for (int m = 0; m < 4; ++m) {
                const float f = tab[2 * (ai * 64 + m * 16 + fr)];
#pragma unroll
                for (int bj = 0; bj < 2; ++bj)
#pragma unroll
                    for (int n = 0; n < 2; ++n) acc[ai][bj][m][n] *= f;
            }
    }
    __device__ __forceinline__ void operator()(const f32x4 (&acc)[2][2][4][2], const Unit& u, int wr, int wc, int fr, int fq) const {
        const PG8_LAS float* tab = (const PG8_LAS float*)(xlds + (wr * 4 + wc) * 1024);
        EPI_MAIN_LOOP(resid_row(a_, row, tab[2 * (ai * 64 + m * 16 + fr) + 1], u.pn, wc, fr, fq))
    }
    __device__ __forceinline__ void mid_row(f32x4 (&a)[2][2], int row) const { float f, rb; two_scales((size_t)(FRONT + row), f, rb);
#pragma unroll
        for (int bj = 0; bj < 2; ++bj)
#pragma unroll
            for (int n = 0; n < 2; ++n) a[bj][n] *= f; }
    __device__ __forceinline__ void row_epi(const f32x4 (&a)[2][2], int row, int pn, int wc, int fr, int fq) const { float f, rb; two_scales((size_t)(FRONT + row), f, rb); resid_row(a, row, rb, pn, wc, fr, fq); }
};
template <bool META> struct EpiDown : EpiResid {
    static constexpr bool MIDSCALE = false;
    __device__ __forceinline__ void mid(f32x4 (&)[2][2][4][2], const Unit&, int, int, int, int) const {}
    __device__ __forceinline__ void row_epi(const f32x4 (&a)[2][2], int row, int pn, int wc, int fr, int fq) const { resid_row(a, row, 1.0f, pn, wc, fr, fq); }
    __device__ __forceinline__ void operator()(const f32x4 (&acc)[2][2][4][2], const Unit& u, int wr, int wc, int fr, int fq) const { EPI_MAIN_LOOP(resid_row(a_, row, 1.0f, u.pn, wc, fr, fq)) }
};

template <bool META> struct EpiGU {
    static constexpr bool PERM = true, AFTER_DRAIN = false, MIDSCALE = false;
    const float* hss; bf16_t* act;
    __device__ __forceinline__ void mid(f32x4 (&)[2][2][4][2], const Unit&, int, int, int, int) const {}
    __device__ __forceinline__ void row_epi(const f32x4 (&a)[2][2], int row, int pn, int wc, int fr, int fq) const {
        const float rs = rsq(sum16q(hss, row, fq) * (1.0f / DM) + RMS_EPS); f32x4 o[2];
#pragma unroll
        for (int n = 0; n < 2; ++n) { const f32x4 g = a[0][n] * rs, up = a[1][n] * rs;
#pragma unroll
            for (int e = 0; e < 4; ++e) o[n][e] = g[e] * up[e] * __builtin_amdgcn_rcpf(1.0f + __builtin_amdgcn_exp2f(-g[e] * LOG2E)); }
        st_bf16x8(act + (size_t)row * DFF + 128 * pn + 32 * wc + 8 * fq, o[0], o[1]);
    }
    __device__ __forceinline__ void operator()(const f32x4 (&acc)[2][2][4][2], const Unit& u, int wr, int wc, int fr, int fq) const { EPI_MAIN_LOOP(row_epi(a_, row, u.pn, wc, fr, fq)) }
};

template <int K, class Epi>
__device__ __forceinline__ void skinny_phase(PG8_LAS unsigned char* lds, const bf16_t* A16, const bf16_t* Bt, int NN, const Epi& E, int wg0) {
    int tid_ = threadIdx.x; asm volatile("" : "+v"(tid_));
    const int tid = tid_, lane = tid & 63, wid = __builtin_amdgcn_readfirstlane(tid >> 6), fr = lane & 15, fq = lane >> 4;
    constexpr int nk = K / 32, NJ = (nk + 7) / 8;
    const int G = (int)gridDim.x; int first = (int)blockIdx.x - wg0; if (first < 0) first += G;
    for (int task = first; task < 4 * NN; task += G) {
        const int pn = task >> 2, wc = task & 3;
        f32x4 a[2][2];
#pragma unroll
        for (int bj = 0; bj < 2; ++bj)
#pragma unroll
            for (int n = 0; n < 2; ++n) a[bj][n] = (f32x4){0.f, 0.f, 0.f, 0.f};
        bool scaled = false;
        const bf16_t* ap = A16 + (size_t)fr * K + 8 * fq;
        const bf16_t* bp = Bt + (size_t)(256 * pn + 32 * wc + 8 * (fr >> 2) + (fr & 3)) * K + 8 * fq;
#pragma unroll 4
        for (int j = 0; j < NJ; ++j) {
            const int it = wid + 8 * j; if (it >= nk) break;
            const int k0 = 32 * it;
            if constexpr (Epi::MIDSCALE) { if (!scaled && k0 >= (K >> 1)) { E.mid_row(a, fr); scaled = true; } }
            const bf16x8 av = *(const PG8_GAS bf16x8*)(ap + k0);
#pragma unroll
            for (int bj = 0; bj < 2; ++bj)
#pragma unroll
                for (int n = 0; n < 2; ++n) { const bf16x8 bv = *(const PG8_GAS bf16x8*)(bp + (size_t)(128 * bj + 4 * n) * K + k0);
                    a[bj][n] = __builtin_amdgcn_mfma_f32_16x16x32_bf16(bv, av, a[bj][n], 0, 0, 0); }
        }
        if constexpr (Epi::MIDSCALE) { if (!scaled) E.mid_row(a, fr); }
        PG8_LAS f32x4* red = (PG8_LAS f32x4*)lds;
#pragma unroll
        for (int bj = 0; bj < 2; ++bj)
#pragma unroll
            for (int n = 0; n < 2; ++n) red[(wid * 64 + lane) * 4 + bj * 2 + n] = a[bj][n];
        __syncthreads();
        if (wid == 0) {
#pragma unroll
            for (int w = 1; w < 8; ++w)
#pragma unroll
                for (int bj = 0; bj < 2; ++bj)
#pragma unroll
                    for (int n = 0; n < 2; ++n) a[bj][n] += red[(w * 64 + lane) * 4 + bj * 2 + n];
            E.row_epi(a, fr, pn, wc, fr, fq);
        }
        __syncthreads();
    }
}
template <class Epi, class Sched, bool ALIGN_EPI = false, bool SP2 = false>
__device__ __forceinline__ void gemm_phase(PG8_LAS unsigned char* lds, const Gemm g, const Sched& S, const Epi& E) {
    int tid_ = threadIdx.x; asm volatile("" : "+v"(tid_));
    const int tid = tid_, wid = __builtin_amdgcn_readfirstlane(tid >> 6), lane = tid & 63, wr = wid >> 2, wc = wid & 3, fr = lane & 15, fq = lane >> 4;
    int K_ = g.K; asm volatile("" : "+s"(K_)); const int K = K_, nt = K / BK;
    unsigned voffA[2], voffB[2];
#pragma unroll
    for (int i = 0; i < 2; ++i) { int R, C; stage_rc(tid * 16 + i * 8192, R, C); const int Rb = Epi::PERM ? ((R & ~31) + perm32(R & 31)) : R;
        voffA[i] = (unsigned)(R * K + C) * 2u; voffB[i] = (unsigned)(Rb * K + C) * 2u; }
    const size_t kstep = (size_t)(BK * 2);
    const size_t hstep = (size_t)HALF * K * 2;
    const size_t tstep = 2 * hstep;
    const unsigned ldsw = (unsigned)wid * 1024u;
    const int aoff = lds_byte(wr * 64 + fr, fq * 8), boff = lds_byte(wc * 32 + fr, fq * 8);
#define PG8_SA(b, h) (((b) * 2 + (h)) * HTB)
#define PG8_SB(b, h) ((4 + (b) * 2 + (h)) * HTB)
#define PG8_STAGE(bufoff, gbase, voff) do { _Pragma("unroll") for (int _i = 0; _i < 2; ++_i) \
        __builtin_amdgcn_global_load_lds((const unsigned*)((const char*)(gbase) + (voff)[_i]), (PG8_LAS unsigned*)(lds + (bufoff) + ldsw + _i * 8192), 16, 0, 0); } while (0)
#define PG8_LDA(dst, b, h) do { _Pragma("unroll") for (int m = 0; m < 4; ++m) _Pragma("unroll") for (int k = 0; k < 2; ++k) dst[m][k] = *(const PG8_LAS bf16x8*)(lds + PG8_SA(b, h) + aoff + m * 2048 + k * 1024); } while (0)
#define PG8_LDB(dst, b, h) do { _Pragma("unroll") for (int n = 0; n < 2; ++n) _Pragma("unroll") for (int k = 0; k < 2; ++k) dst[n][k] = *(const PG8_LAS bf16x8*)(lds + PG8_SB(b, h) + boff + n * 2048 + k * 1024); } while (0)
#define PG8_MMA(ai, bj, At, Bt) do { __builtin_amdgcn_s_setprio(1); _Pragma("unroll") for (int m = 0; m < 4; ++m) _Pragma("unroll") for (int n = 0; n < 2; ++n) _Pragma("unroll") for (int k = 0; k < 2; ++k) \
        acc[ai][bj][m][n] = __builtin_amdgcn_mfma_f32_16x16x32_bf16(Bt[n][k], At[m][k], acc[ai][bj][m][n], 0, 0, 0); __builtin_amdgcn_s_setprio(0); } while (0)
#define PG8_WAIT_V(n) asm volatile("s_waitcnt vmcnt(" #n ")" ::: "memory")
#define PG8_WAIT_L(n) asm volatile("s_waitcnt lgkmcnt(" #n ")" ::: "memory")
#define PG8_BAR __builtin_amdgcn_s_barrier()
#define PG8_SCHED __builtin_amdgcn_sched_barrier(0)
    Unit cur, nxt; int ui = 0;
    if (!S.next(0, cur)) return;
    f32x4 acc[2][2][4][2];
#pragma unroll
    for (int a = 0; a < 2; ++a)
#pragma unroll
        for (int b = 0; b < 2; ++b)
#pragma unroll
            for (int m = 0; m < 4; ++m)
#pragma unroll
                for (int n = 0; n < 2; ++n) acc[a][b][m][n] = (f32x4){0.f, 0.f, 0.f, 0.f};
    bf16x8 At[4][2], B0[2][2], B1[2][2];
    const char* cA = (const char*)g.A + (size_t)cur.pm * tstep + (g.apad ? (size_t)((cur.pm >> 4) * 128 + 128) * (size_t)K * 2 : (size_t)0); const char* cB = (const char*)g.Bt + (size_t)cur.pn * tstep;
    S.a_ready(cur);
    if constexpr (SP2) {
        PG8_STAGE(PG8_SB(0, 0), cB, voffB); PG8_STAGE(PG8_SB(0, 1), cB + hstep, voffB); PG8_STAGE(PG8_SA(0, 0), cA, voffA); PG8_STAGE(PG8_SA(0, 1), cA + hstep, voffA);
        if (wr == 1) PG8_BAR;
        PG8_WAIT_V(2); PG8_BAR;
        PG8_STAGE(PG8_SB(1, 0), cB + kstep, voffB); PG8_STAGE(PG8_SA(1, 0), cA + kstep, voffA); PG8_STAGE(PG8_SB(1, 1), cB + hstep + kstep, voffB);
        PG8_WAIT_V(6); PG8_BAR;
    } else {
        PG8_STAGE(PG8_SB(0, 0), cB, voffB); PG8_STAGE(PG8_SA(0, 0), cA, voffA); PG8_STAGE(PG8_SB(0, 1), cB + hstep, voffB); PG8_STAGE(PG8_SA(0, 1), cA + hstep, voffA);
        if (wr == 1) PG8_BAR;
        PG8_WAIT_V(4); PG8_BAR;
        PG8_STAGE(PG8_SB(1, 0), cB + kstep, voffB); PG8_STAGE(PG8_SA(1, 0), cA + kstep, voffA); PG8_STAGE(PG8_SB(1, 1), cB + hstep + kstep, voffB);
        PG8_WAIT_V(6); PG8_BAR;
    }
    for (;;) {
        const bool has_next = S.next(ui + 1, nxt);
        if constexpr (Epi::MIDSCALE) E.prep(cur, wid, wr, lane);
        const char* nA = has_next ? (const char*)g.A + (size_t)nxt.pm * tstep + (g.apad ? (size_t)((nxt.pm >> 4) * 128 + 128) * (size_t)K * 2 : (size_t)0) : cA; const char* nB = has_next ? (const char*)g.Bt + (size_t)nxt.pn * tstep : cB;
        for (int t = 0; t < nt; t += 2) {
            const bool last = (t == nt - 2);
            if constexpr (Epi::MIDSCALE) { if (t == (nt >> 1)) E.mid(acc, cur, wr, wc, fr, fq); }
            const char* a1 = cA + (size_t)(t + 1) * kstep;
            const char* a2 = last ? nA : cA + (size_t)(t + 2) * kstep; const char* b2 = last ? nB : cB + (size_t)(t + 2) * kstep;
            const char* a3 = a2 + kstep; const char* b3 = b2 + kstep;
            if (last && has_next) S.a_ready(nxt);
            if constexpr (SP2) {
            PG8_LDB(B0, 0, 0); PG8_LDB(B1, 0, 1); PG8_SCHED; PG8_LDA(At, 0, 0); PG8_STAGE(PG8_SA(1, 1), a1 + hstep, voffA);
            PG8_WAIT_V(8); PG8_WAIT_L(0); PG8_BAR; PG8_MMA(0, 0, At, B0); PG8_MMA(0, 1, At, B1); PG8_BAR; PG8_SCHED;
            PG8_LDA(At, 0, 1); PG8_STAGE(PG8_SB(0, 0), b2, voffB); PG8_STAGE(PG8_SB(0, 1), b2 + hstep, voffB); PG8_STAGE(PG8_SA(0, 0), a2, voffA);
            PG8_WAIT_V(8); PG8_WAIT_L(0); PG8_BAR; PG8_MMA(1, 0, At, B0); PG8_MMA(1, 1, At, B1); PG8_BAR; PG8_SCHED;
            PG8_LDB(B0, 1, 0); PG8_LDB(B1, 1, 1); PG8_SCHED; PG8_LDA(At, 1, 0); PG8_STAGE(PG8_SA(0, 1), a2 + hstep, voffA);
            PG8_WAIT_V(8); PG8_WAIT_L(0); PG8_BAR; PG8_MMA(0, 0, At, B0); PG8_MMA(0, 1, At, B1); PG8_BAR; PG8_SCHED;
            PG8_LDA(At, 1, 1); PG8_STAGE(PG8_SB(1, 0), b3, voffB); PG8_STAGE(PG8_SB(1, 1), b3 + hstep, voffB); PG8_STAGE(PG8_SA(1, 0), a3, voffA);
            PG8_WAIT_V(8); PG8_WAIT_L(0); PG8_BAR; PG8_MMA(1, 0, At, B0); PG8_MMA(1, 1, At, B1); PG8_BAR; PG8_SCHED;
            } else {
            PG8_LDB(B0, 0, 0); PG8_SCHED; PG8_LDA(At, 0, 0); PG8_STAGE(PG8_SA(1, 1), a1 + hstep, voffA);
            PG8_WAIT_L(8); PG8_BAR; PG8_WAIT_L(0); PG8_MMA(0, 0, At, B0); PG8_BAR; PG8_SCHED;
            PG8_LDB(B1, 0, 1); PG8_STAGE(PG8_SB(0, 0), b2, voffB);
            PG8_BAR; PG8_WAIT_L(0); PG8_MMA(0, 1, At, B1); PG8_BAR;
            PG8_LDA(At, 0, 1); PG8_STAGE(PG8_SA(0, 0), a2, voffA);
            PG8_BAR; PG8_WAIT_L(0); PG8_MMA(1, 0, At, B0); PG8_BAR; PG8_SCHED;
            PG8_STAGE(PG8_SB(0, 1), b2 + hstep, voffB);
            PG8_WAIT_V(6); PG8_BAR; PG8_MMA(1, 1, At, B1); PG8_BAR;
            PG8_LDB(B0, 1, 0); PG8_SCHED; PG8_LDA(At, 1, 0); PG8_STAGE(PG8_SA(0, 1), a2 + hstep, voffA);
            PG8_WAIT_L(8); PG8_BAR; PG8_WAIT_L(0); PG8_MMA(0, 0, At, B0); PG8_BAR; PG8_SCHED;
            PG8_LDB(B1, 1, 1); PG8_STAGE(PG8_SB(1, 0), b3, voffB);
            PG8_BAR; PG8_WAIT_L(0); PG8_MMA(0, 1, At, B1); PG8_BAR;
            PG8_LDA(At, 1, 1); PG8_STAGE(PG8_SA(1, 0), a3, voffA);
            PG8_BAR; PG8_WAIT_L(0); PG8_MMA(1, 0, At, B0); PG8_BAR; PG8_SCHED;
            PG8_STAGE(PG8_SB(1, 1), b3 + hstep, voffB);
            PG8_WAIT_V(6); PG8_BAR; PG8_MMA(1, 1, At, B1); PG8_BAR;
            }
        }
        if constexpr (ALIGN_EPI) { if (wr == 0) PG8_BAR; }
        if constexpr (!Epi::AFTER_DRAIN) { E(acc, cur, wr, wc, fr, fq); S.done(cur); }
        if (!has_next) break;
#pragma unroll
        for (int a = 0; a < 2; ++a)
#pragma unroll
            for (int b = 0; b < 2; ++b)
#pragma unroll
                for (int m = 0; m < 4; ++m)
#pragma unroll
                    for (int n = 0; n < 2; ++n) acc[a][b][m][n] = (f32x4){0.f, 0.f, 0.f, 0.f};
        cur = nxt; cA = nA; cB = nB; ++ui;
        if constexpr (ALIGN_EPI) { if (wr == 1) PG8_BAR; }
    }
    PG8_WAIT_V(0);
    if constexpr (!ALIGN_EPI) { if (wr == 0) PG8_BAR; }
    PG8_BAR;
    if constexpr (Epi::AFTER_DRAIN) { E.fused(acc, cur, wr, wc, fr, fq, lds, wid, lane); S.done(cur); }
#undef PG8_SA
#undef PG8_SB
#undef PG8_STAGE
#undef PG8_LDA
#undef PG8_LDB
#undef PG8_MMA
#undef PG8_WAIT_V
#undef PG8_WAIT_L
#undef PG8_BAR
#undef PG8_SCHED
}
}
namespace att {
#define ALAS __attribute__((address_space(3)))
#define AGAS __attribute__((address_space(1)))
typedef unsigned short bf16_t;
typedef short bf16x8 __attribute__((ext_vector_type(8)));
typedef short s16x4 __attribute__((ext_vector_type(4)));
typedef float f32x16 __attribute__((ext_vector_type(16)));
typedef unsigned u32x4 __attribute__((ext_vector_type(4)));
typedef float f32x2_t __attribute__((ext_vector_type(2))); typedef __bf16 bf16x2_t __attribute__((ext_vector_type(2)));
constexpr int KPMAX = 208, VP = 192, KSZ = 64 * KPMAX, VSZ = 64 * VP;
constexpr int OFF_V = 2 * KSZ, OFF_SCR = OFF_V + 2 * VSZ, OFF_Q = OFF_SCR + 8 * 256, LDS_BYTES = OFF_Q + 64;
constexpr float NEGF = -1e30f, THR = 6.0f;
__device__ __forceinline__ int crow(int r, int hi) { return (r & 3) + 8 * (r >> 2) + 4 * hi; }
__device__ __forceinline__ unsigned cvtpk(float lo, float hi) { f32x2_t v = {lo, hi}; bf16x2_t b = __builtin_convertvector(v, bf16x2_t); return __builtin_bit_cast(unsigned, b); }
__device__ __forceinline__ bf16x8 pack8(const f32x16& p, int s) { u32x4 w; w.x = cvtpk(p[8 * s], p[8 * s + 1]); w.y = cvtpk(p[8 * s + 2], p[8 * s + 3]); w.z = cvtpk(p[8 * s + 4], p[8 * s + 5]); w.w = cvtpk(p[8 * s + 6], p[8 * s + 7]); return __builtin_bit_cast(bf16x8, w); }
typedef short v4i16_t __attribute__((ext_vector_type(4)));
__device__ __forceinline__ float max3f(float a, float b, float c) { float r; asm("v_max3_f32 %0, %1, %2, %3" : "=v"(r) : "v"(a), "v"(b), "v"(c)); return r; }
__device__ __forceinline__ float max2f(float a, float b) { float r; asm("v_max_f32_e32 %0, %1, %2" : "=v"(r) : "v"(a), "v"(b)); return r; }
__device__ __forceinline__ float xhalf_max(float m) { auto rr = __builtin_amdgcn_permlane32_swap(__float_as_uint(m), __float_as_uint(m), false, false); return max2f(__uint_as_float(rr[0]), __uint_as_float(rr[1])); }
__device__ __forceinline__ s16x4 vtr(const ALAS unsigned char* p) { return __builtin_bit_cast(s16x4, __builtin_amdgcn_ds_read_tr16_b64_v4i16((ALAS v4i16_t*)p)); }
__device__ __forceinline__ unsigned short f2bf(float f) { unsigned u = __builtin_bit_cast(unsigned, f); return (unsigned short)((u + 0x7fffu + ((u >> 16) & 1u)) >> 16); }

template <int DQK, bool SWA>
__device__ __forceinline__ void attn_unit(ALAS unsigned char* lds, const bf16_t* Qp, int qpitch, const bf16_t* Kp, int kpitch, const bf16_t* Krp, const bf16_t* Vp, int vpitch,
                                          bf16_t* Op, float* ssq, float sink2, int b, int qb) {
    constexpr int KP = DQK * 2 + 16, NS = DQK / 16;
    int tid_ = threadIdx.x; asm volatile("" : "+v"(tid_));
    const int tid = tid_, lane = tid & 63, wid = __builtin_amdgcn_readfirstlane(tid >> 6), r = lane & 31, h = lane >> 5;
    const size_t rowbase = (size_t)b * TT;
    const int q0 = qb * 256, q0w = q0 + wid * 32;
    const bool wave_valid = q0w < TT;
    const int NT = (q0 + 256) / 64 < TT / 64 ? (q0 + 256) / 64 : TT / 64;
    int t0 = 1; if (SWA) { t0 = (q0 - 128) / 64; if (t0 < 1) t0 = 1; }
    ALAS float* scr = (ALAS float*)(lds + OFF_SCR + wid * 256);
    bf16x8 qf[NS];
    { const int qr = (q0w + r) < TT ? (q0w + r) : TT - 1; const bf16_t* qrow = Qp + (rowbase + qr) * (size_t)qpitch;
#pragma unroll
      for (int s = 0; s < NS; ++s) qf[s] = *(const AGAS bf16x8*)(qrow + 16 * s + 8 * h); }
    const int srow = tid >> 3, sch = tid & 7, rrow = (tid >> 2) & 63, rch = tid & 3;
    u32x4 kregA, vregA, rregA = {0u, 0u, 0u, 0u}, kregB, vregB, rregB = {0u, 0u, 0u, 0u};
#define AT_GLOAD(t, S) do { const size_t kr_ = rowbase + 64 * (t) + srow; kreg##S = *(const AGAS u32x4*)(Kp + kr_ * (size_t)kpitch + sch * 8); vreg##S = *(const AGAS u32x4*)(Vp + kr_ * (size_t)vpitch + sch * 8); \
        if (DQK == 96) { if (tid < 256) rreg##S = *(const AGAS u32x4*)(Krp + (rowbase + 64 * (t) + rrow) * 32 + rch * 8); } } while (0)
#define AT_LSTORE(buf, S) do { *(ALAS u32x4*)(lds + (buf) * KSZ + srow * KP + sch * 16) = kreg##S; *(ALAS u32x4*)(lds + OFF_V + (buf) * VSZ + srow * VP + sch * 16) = vreg##S; \
        if (DQK == 96) { if (tid < 256) *(ALAS u32x4*)(lds + (buf) * KSZ + rrow * KP + 128 + rch * 16) = rreg##S; } } while (0)
    AT_GLOAD(t0, A); AT_LSTORE(0, A);
    if (t0 + 1 < NT) AT_GLOAD(t0 + 1, A);
    if (t0 + 2 < NT) AT_GLOAD(t0 + 2, B);
    __syncthreads();
    if (wid >= 4) __builtin_amdgcn_s_setprio(1);
    float mrun = SWA ? sink2 : 0.0f, lrun = (SWA && h == 0) ? 1.0f : 0.0f;
    bool first_ = !SWA;
    f32x16 negm;
#pragma unroll
    for (int i = 0; i < 16; ++i) negm[i] = -mrun;
    f32x16 o0, o1;
#pragma unroll
    for (int i = 0; i < 16; ++i) { o0[i] = 0.f; o1[i] = 0.f; }
    const int q = q0w + r;
#define AT_PVF(P, j) do { o0 = __builtin_amdgcn_mfma_f32_32x32x16_bf16(P, __builtin_shufflevector(vlo[2 * (j)], vhi[2 * (j)], 0, 1, 2, 3, 4, 5, 6, 7), o0, 0, 0, 0); o1 = __builtin_amdgcn_mfma_f32_32x32x16_bf16(P, __builtin_shufflevector(vlo[2 * (j) + 1], vhi[2 * (j) + 1], 0, 1, 2, 3, 4, 5, 6, 7), o1, 0, 0, 0); } while (0)
#define AT_PV(P, rowoff) do { \
                { const s16x4 lo = vtr(vb_ + (rowoff) * VP), hi = vtr(vb_ + ((rowoff) + 8) * VP); const bf16x8 vf = __builtin_shufflevector(lo, hi, 0, 1, 2, 3, 4, 5, 6, 7); o0 = __builtin_amdgcn_mfma_f32_32x32x16_bf16(P, vf, o0, 0, 0, 0); } \
                { const s16x4 lo = vtr(vb_ + (rowoff) * VP + 64), hi = vtr(vb_ + ((rowoff) + 8) * VP + 64); const bf16x8 vf = __builtin_shufflevector(lo, hi, 0, 1, 2, 3, 4, 5, 6, 7); o1 = __builtin_amdgcn_mfma_f32_32x32x16_bf16(P, vf, o1, 0, 0, 0); } } while (0)
#define AT_STEP(t, LS, SS) do { \
        const int buf = (t - t0) & 1; \
          \
        if (t + 1 < NT) AT_LSTORE(buf ^ 1, SS); \
        if (t + 3 < NT) AT_GLOAD(t + 3, SS); \
        const int kfirst = 64 * t; \
        bool active = wave_valid && (kfirst <= q0w + 31); \
        if (SWA) active = active && (kfirst + 63 >= q0w - 127); \
        if (active) { \
            f32x16 s0, s1; \
            const ALAS unsigned char* kb = lds + buf * KSZ + r * KP + h * 16; \
            bf16x8 kf[2 * NS]; \
_Pragma("unroll") \
            for (int s = 0; s < NS; ++s) { kf[2 * s] = *(const ALAS bf16x8*)(kb + s * 32); kf[2 * s + 1] = *(const ALAS bf16x8*)(kb + 32 * KP + s * 32); } \
            __builtin_amdgcn_sched_barrier(0); \
_Pragma("unroll") \
            for (int s = 0; s < NS; ++s) { if (s == 0) { s0 = __builtin_amdgcn_mfma_f32_32x32x16_bf16(kf[0], qf[0], negm, 0, 0, 0); s1 = __builtin_amdgcn_mfma_f32_32x32x16_bf16(kf[1], qf[0], negm, 0, 0, 0); } else { s0 = __builtin_amdgcn_mfma_f32_32x32x16_bf16(kf[2 * s], qf[s], s0, 0, 0, 0); s1 = __builtin_amdgcn_mfma_f32_32x32x16_bf16(kf[2 * s + 1], qf[s], s1, 0, 0, 0); } } \
            __builtin_amdgcn_sched_barrier(0); \
            const ALAS unsigned char* vb_ = lds + OFF_V + buf * VSZ + (4 * h + ((lane & 15) >> 2)) * VP + ((lane >> 4) & 1) * 32 + (lane & 3) * 8; \
            s16x4 vlo[8], vhi[8]; \
_Pragma("unroll") \
            for (int j = 0; j < 4; ++j) { vlo[2 * j] = vtr(vb_ + (16 * j) * VP); vhi[2 * j] = vtr(vb_ + (16 * j + 8) * VP); vlo[2 * j + 1] = vtr(vb_ + (16 * j) * VP + 64); vhi[2 * j + 1] = vtr(vb_ + (16 * j + 8) * VP + 64); } \
            __builtin_amdgcn_sched_barrier(0); \
            const bool need_mask = SWA || (t == 1) || (kfirst + 63 > q0w); \
            if (need_mask) { \
_Pragma("unroll") \
                for (int i = 0; i < 16; ++i) { const int key = kfirst + crow(i, h), key1 = key + 32; \
                    bool ok0 = (key <= q) && (key >= FRONT), ok1 = (key1 <= q) && (key1 >= FRONT); \
                    if (SWA) { ok0 = ok0 && (q - key < 128); ok1 = ok1 && (q - key1 < 128); } \
                    s0[i] = ok0 ? s0[i] : NEGF; s1[i] = ok1 ? s1[i] : NEGF; } \
            } \
            float rm = max3f(s0[0], s0[1], s1[0]), rm2 = max3f(s0[2], s0[3], s1[1]); rm = max3f(rm, s1[2], s1[3]); \
_Pragma("unroll") \
            for (int i = 4; i < 16; i += 4) { rm = max3f(rm, s0[i], s0[i + 1]); rm2 = max3f(rm2, s0[i + 2], s0[i + 3]); rm = max3f(rm, s1[i], s1[i + 1]); rm2 = max3f(rm2, s1[i + 2], s1[i + 3]); } \
            rm = xhalf_max(max2f(rm, rm2)); \
            if (first_ || __any(rm > THR)) { \
                const float dl = first_ ? (rm > -1e29f ? rm : 0.f) : max2f(rm, 0.f); first_ = false; \
                mrun += dl; const float f = __builtin_amdgcn_exp2f(-dl); lrun *= f; \
_Pragma("unroll") \
                for (int i = 0; i < 16; ++i) { s0[i] -= dl; s1[i] -= dl; negm[i] = -mrun; } \
                if (h == 0) scr[r] = f; \
_Pragma("unroll") \
                for (int i = 0; i < 16; ++i) { const float fi = scr[crow(i, h)]; o0[i] *= fi; o1[i] *= fi; } \
            } \
            float ls = 0.f; \
_Pragma("unroll") \
            for (int i = 0; i < 16; ++i) { s0[i] = __builtin_amdgcn_exp2f(s0[i]); s1[i] = __builtin_amdgcn_exp2f(s1[i]); ls += s0[i] + s1[i]; } \
            lrun += ls; \
            const bf16x8 p0 = pack8(s0, 0), p1 = pack8(s0, 1), p2 = pack8(s1, 0), p3 = pack8(s1, 1); \
            __builtin_amdgcn_sched_barrier(0); \
            AT_PVF(p0, 0); AT_PVF(p1, 1); AT_PVF(p2, 2); AT_PVF(p3, 3); \
        } \
        __syncthreads(); \
    } while (0)
    {
        int t = t0;
        for (; t + 1 < NT; t += 2) { AT_STEP(t, B, A); const int t1 = t + 1; AT_STEP(t1, A, B); }
        if (t < NT) AT_STEP(t, B, A);
    }
#undef AT_STEP
#undef AT_PV
#undef AT_GLOAD
#undef AT_LSTORE
    __builtin_amdgcn_s_setprio(0);
    if (wave_valid) {
        const float lt = lrun + __shfl_xor(lrun, 32);
        if (h == 0) scr[32 + r] = lt;
        ALAS bf16_t* stg = (ALAS bf16_t*)(lds + wid * 4096);
#pragma unroll
        for (int i = 0; i < 16; ++i) {
            const float li = scr[32 + crow(i, h)], inv = li > 0.f ? 1.0f / li : 0.f;
            const int orow = crow(i, h);
            stg[orow * 64 + r] = f2bf(o0[i] * inv); stg[orow * 64 + 32 + r] = f2bf(o1[i] * inv);
        }
#pragma unroll
        for (int i = 0; i < 4; ++i) {
            const int lrow = i * 8 + (lane >> 3), ch = lane & 7; const u32x4 v = *(const ALAS u32x4*)(stg + lrow * 64 + ch * 8);
            const size_t row = rowbase + q0w + lrow;
            *(AGAS u32x4*)(Op + row * 1024 + ch * 8) = v;
            float ss = 0.f;
#pragma unroll
            for (int j = 0; j < 4; ++j) { const unsigned w = v[j]; const float lo = __builtin_bit_cast(float, w << 16), hi = __builtin_bit_cast(float, w & 0xffff0000u); ss += lo * lo + hi * hi; }
            ss += __shfl_xor(ss, 1); ss += __shfl_xor(ss, 2); ss += __shfl_xor(ss, 4);
            if (ch == 0) ((AGAS float*)ssq)[row * 16] = ss;
        }
    }
    __syncthreads();
}
}
typedef unsigned short bf16;
#define LAS __attribute__((address_space(3)))
#define GAS __attribute__((address_space(1)))
constexpr size_t MiB = 1u << 20;
constexpr int NWAVES = 8, NTHREADS = 512;
constexpr int LDS_BYTES = 147456;
static_assert(att::LDS_BYTES <= 131072, "attention LDS");
constexpr size_t WS_CTL = 0, CTL_BYTES = 65536;
constexpr size_t WS_H = 1 * MiB;
constexpr size_t WS_HB = WS_H + (size_t)MROWS * DM * 4;
constexpr size_t WS_W = WS_HB + (size_t)MROWS * DM * 2;
constexpr size_t WL_IN = 0, WL_Q = WL_IN + (size_t)INP * DM * 2, WL_KV = WL_Q + (size_t)768 * 256 * 2, WL_O = WL_KV + (size_t)1024 * 128 * 2,
                 WL_GU = WL_O + (size_t)DM * DM * 2, WL_D = WL_GU + (size_t)GUP * DM * 2, WL_END = WL_D + (size_t)DM * DFF * 2;
constexpr size_t WBUF = 22 * MiB;
static_assert(WL_END <= WBUF, "weight buffer");
constexpr size_t WS_PART = WS_W + 2 * WBUF;
constexpr size_t P_HSSA = 0, P_HSSB = P_HSSA + (size_t)MROWS * 64, P_SSQO = P_HSSB + (size_t)MROWS * 64, P_SSQQ = P_SSQO + (size_t)MROWS * 64, P_SSQKV = P_SSQQ + (size_t)MROWS * 16, P_END = P_SSQKV + (size_t)MROWS * 16;
constexpr size_t PM_H = (P_END + 255) & ~(size_t)255, PM_HB = PM_H + 16 * DM * 4, PM_HSSA = PM_HB + 16 * DM * 2, PM_HSSB = PM_HSSA + 1024, PM_SSQQ = PM_HSSB + 1024, PM_SSQKV = PM_SSQQ + 256,
                 PM_QLAT = PM_SSQKV + 256, PM_KVLAT = PM_QLAT + 16 * 256 * 2, PM_ACT = PM_KVLAT + 16 * 128 * 2, PM_END = PM_ACT + 16 * DFF * 2;
static_assert(PM_END <= 8 * MiB, "partials");
constexpr int MC = BATCH * SEQ;
constexpr size_t WS_R = WS_PART + 8 * MiB;
constexpr size_t R_QA = 0, R_KA = R_QA + (size_t)MROWS * 512 * 2, R_VA = R_KA + (size_t)MROWS * 128 * 2, R_QLAT = R_VA + (size_t)MROWS * 128 * 2, R_KVLAT = R_QLAT + (size_t)MROWS * 256 * 2,
                 R_KR = R_KVLAT + (size_t)MROWS * 128 * 2, R_QM = R_KR + (size_t)MROWS * 32 * 2, R_KN = R_QM + (size_t)MROWS * 768 * 2, R_VB = R_KN + (size_t)MROWS * 512 * 2,
                 R_O = R_VB + (size_t)MROWS * 512 * 2, R_END = R_O + (size_t)MROWS * 1024 * 2;
constexpr size_t R_ACT = 0;
static_assert((size_t)MROWS * DFF * 2 <= R_END, "act overlay");
constexpr size_t WS_END = WS_R + R_END;
static_assert(WS_END <= 512 * MiB, "workspace must fit 512 MiB");

struct Args {
    const float *x, *meta, *attn_norm, *w_in, *q_norm, *w_q_up, *kv_norm, *w_kv_up, *sinks, *out_norm_swa, *out_norm_mla, *w_o, *ffn_norm, *w_gate, *w_up, *w_down, *final_norm;
    float* out; unsigned char* ws; int ph_lo, ph_hi;
};

__device__ __forceinline__ unsigned f2bf_u(float f) { unsigned u = __builtin_bit_cast(unsigned, f); return (u + 0x7fffu + ((u >> 16) & 1u)) >> 16; }
__device__ __forceinline__ unsigned pk2(float lo, float hi) { return f2bf_u(lo) | (f2bf_u(hi) << 16); }
__device__ __forceinline__ float wave_sum(float v) {
#pragma unroll
    for (int o = 1; o < 64; o <<= 1) v += __shfl_xor(v, o);
    return v;
}

__device__ __forceinline__ int src_in(int np) { const int pn = np >> 8, bj = (np >> 7) & 1, o = np & 127;
    if (pn < 2) return (4 * pn + (o >> 5)) * 64 + (o & 31) + 32 * bj;
    if (pn == 2) { if (o < 64) return 512 + (o >> 5) * 64 + (o & 31) + 32 * bj; if (o < 80) return 1152 + (o - 64) + 16 * bj; return -1; }
    if (pn == 3) return bj ? 1024 + o : 640 + o;
    return 768 + 128 * bj + o; }
__device__ __forceinline__ int src_qup(int np) { const int pn = np >> 8, op = np & 255;
    if (pn < 2) return (4 * pn + (op >> 6)) * 96 + (op & 63);
    const int bj = op >> 7, o = op & 127; return (o >> 4) * 96 + 64 + (o & 15) + 16 * bj; }
__device__ __forceinline__ int src_kvup(int np) { const int pn = np >> 8, op = np & 255; return (4 * (pn & 1) + (op >> 6)) * 128 + (pn >= 2 ? 64 : 0) + (op & 63); }

template <int MODE>
__device__ __forceinline__ void conv_item(const float* W, const float* W2, const float* gain, const float* gain2, int K, int Nsrc, bf16* WT, LAS float* scr, int item, int nblk, int lane) {
    const int kb = item / nblk, nb = item % nblk, k0 = 64 * kb, n0 = 32 * nb;
    const int nn = 4 * (lane & 7), np = n0 + nn;
    int src; float cs = 1.0f; const float* Wp = W;
    if (MODE == 0) { src = src_in(np); if (np < 512) cs = 0.125f * LOG2E; }
    else if (MODE == 1) { src = src_qup(np); cs = 0.10206207261596577f * LOG2E; }
    else if (MODE == 2) src = src_kvup(np);
    else if (MODE == 4) { src = 128 * (np >> 8) + (np & 127); if ((np >> 7) & 1) Wp = W2; }
    else src = np;
#pragma unroll
    for (int i = 0; i < 8; ++i) { const int kk = 8 * i + (lane >> 3), k = k0 + kk;
        float g = 1.0f; if (MODE == 3) g = (k < 512) ? ((const GAS float*)gain)[k] : ((const GAS float*)gain2)[k - 512]; else if (MODE != 5) g = ((const GAS float*)gain)[k];
        pg8::f32x4 v = {0.f, 0.f, 0.f, 0.f}; if (src >= 0) v = *(const GAS pg8::f32x4*)(Wp + (size_t)k * Nsrc + src);
        g *= cs; scr[kk * 33 + nn] = v[0] * g; scr[kk * 33 + nn + 1] = v[1] * g; scr[kk * 33 + nn + 2] = v[2] * g; scr[kk * 33 + nn + 3] = v[3] * g; }
    asm volatile("s_waitcnt lgkmcnt(0)" ::: "memory");
    const int c = lane & 7;
#pragma unroll
    for (int j = 0; j < 4; ++j) { const int n = (lane >> 3) + 8 * j; const LAS float* s = scr + (8 * c) * 33 + n;
        pg8::u32x4 o; o.x = pk2(s[0 * 33], s[1 * 33]); o.y = pk2(s[2 * 33], s[3 * 33]); o.z = pk2(s[4 * 33], s[5 * 33]); o.w = pk2(s[6 * 33], s[7 * 33]);
        *(GAS pg8::u32x4*)(WT + (size_t)(n0 + n) * K + k0 + 8 * c) = o; }
    asm volatile("s_waitcnt lgkmcnt(0)" ::: "memory");
}
__device__ __forceinline__ void conv_layer(const Args& a, int l, unsigned char* wbuf, LAS unsigned char* lds) {
    int tid_ = threadIdx.x; asm volatile("" : "+v"(tid_));
    const int lane = tid_ & 63, wave = tid_ >> 6;
    LAS float* scr = (LAS float*)(lds + wave * 16384);
    const int gw = blockIdx.x * NWAVES + wave, NGW = gridDim.x * NWAVES;
    constexpr int I0 = (DM / 64) * (INP / 32), I1 = (256 / 64) * (768 / 32), I2 = (128 / 64) * (1024 / 32), I3 = (DM / 64) * (DM / 32), I4 = (DM / 64) * (GUP / 32), I5 = (DFF / 64) * (DM / 32);
    constexpr int NIT = I0 + I1 + I2 + I3 + I4 + I5;
    for (int it = gw; it < NIT; it += NGW) {
        int r = it;
        if (r < I0) { conv_item<0>(a.w_in + (size_t)l * DM * INW, nullptr, a.attn_norm + l * DM, nullptr, DM, INW, (bf16*)(wbuf + WL_IN), scr, r, INP / 32, lane); continue; } r -= I0;
        if (r < I1) { conv_item<1>(a.w_q_up + (size_t)l * 256 * 768, nullptr, a.q_norm + l * 256, nullptr, 256, 768, (bf16*)(wbuf + WL_Q), scr, r, 768 / 32, lane); continue; } r -= I1;
        if (r < I2) { conv_item<2>(a.w_kv_up + (size_t)l * 128 * 1024, nullptr, a.kv_norm + l * 128, nullptr, 128, 1024, (bf16*)(wbuf + WL_KV), scr, r, 1024 / 32, lane); continue; } r -= I2;
        if (r < I3) { conv_item<3>(a.w_o + (size_t)l * DM * DM, nullptr, a.out_norm_swa + l * 512, a.out_norm_mla + l * 512, DM, DM, (bf16*)(wbuf + WL_O), scr, r, DM / 32, lane); continue; } r -= I3;
        if (r < I4) { conv_item<4>(a.w_gate + (size_t)l * DM * DFF, a.w_up + (size_t)l * DM * DFF, a.ffn_norm + l * DM, nullptr, DM, DFF, (bf16*)(wbuf + WL_GU), scr, r, GUP / 32, lane); continue; } r -= I4;
        conv_item<5>(a.w_down + (size_t)l * DFF * DM, nullptr, nullptr, nullptr, DFF, DM, (bf16*)(wbuf + WL_D), scr, r, DM / 32, lane);
    }
}

__device__ __forceinline__ void init_rows(const Args& a, unsigned char* ws) {
    const int lane = threadIdx.x & 63, wave = threadIdx.x >> 6; const int gw = blockIdx.x * NWAVES + wave, NGW = gridDim.x * NWAVES;
    for (int row = gw; row < MC + NMETA; row += NGW) {
        const bool meta = row >= MC; const int r = meta ? row - MC : row;
        const float* src = meta ? a.meta + (size_t)r * DM : a.x + (size_t)r * DM;
        float* H = (float*)(ws + (meta ? WS_PART + PM_H : WS_H)); bf16* HB = (bf16*)(ws + (meta ? WS_PART + PM_HB : WS_HB)); float* hss = (float*)(ws + WS_PART + (meta ? PM_HSSA : P_HSSA));
        pg8::f32x4 v[4]; float s = 0.f;
#pragma unroll
        for (int j = 0; j < 2; ++j) { v[2 * j] = *((const GAS pg8::f32x4*)src + 2 * (lane + 64 * j)); v[2 * j + 1] = *((const GAS pg8::f32x4*)src + 2 * (lane + 64 * j) + 1); s += pg8::sq4(v[2 * j]) + pg8::sq4(v[2 * j + 1]); }
        s = wave_sum(s);
#pragma unroll
        for (int j = 0; j < 2; ++j) pg8::st_bf16x8(HB + (size_t)r * DM + 8 * (lane + 64 * j), v[2 * j], v[2 * j + 1]);
        if (lane < 16) ((GAS float*)hss)[(size_t)r * 16 + lane] = (lane == 0) ? s : 0.f;
    }
}
__device__ __forceinline__ void final_rows(const Args& a, const bf16* HBf, const float* hss) {
    const int lane = threadIdx.x & 63, wave = threadIdx.x >> 6; const int gw = blockIdx.x * NWAVES + wave, NGW = gridDim.x * NWAVES;
    for (int o = gw; o < BATCH * SEQ; o += NGW) {
        const int row = o;
        const float rs = pg8::rsq(pg8::sum16(hss, row) * (1.0f / DM) + RMS_EPS);
#pragma unroll
        for (int j = 0; j < 2; ++j) { const pg8::u32x4 hw = *((const GAS pg8::u32x4*)(HBf + (size_t)row * DM) + lane + 64 * j); pg8::f32x4 v0, v1;
            v0[0] = __builtin_bit_cast(float, hw.x << 16); v0[1] = __builtin_bit_cast(float, hw.x & 0xffff0000u); v0[2] = __builtin_bit_cast(float, hw.y << 16); v0[3] = __builtin_bit_cast(float, hw.y & 0xffff0000u);
            v1[0] = __builtin_bit_cast(float, hw.z << 16); v1[1] = __builtin_bit_cast(float, hw.z & 0xffff0000u); v1[2] = __builtin_bit_cast(float, hw.w << 16); v1[3] = __builtin_bit_cast(float, hw.w & 0xffff0000u);
            const pg8::f32x4 g0 = *((const GAS pg8::f32x4*)a.final_norm + 2 * (lane + 64 * j)), g1 = *((const GAS pg8::f32x4*)a.final_norm + 2 * (lane + 64 * j) + 1);
            *((GAS pg8::f32x4*)(a.out + (size_t)o * DM) + 2 * (lane + 64 * j)) = v0 * rs * g0; *((GAS pg8::f32x4*)(a.out + (size_t)o * DM) + 2 * (lane + 64 * j) + 1) = v1 * rs * g1; }
    }
}

constexpr int N_ATT_UNITS = 2 * 17 * 64;
__device__ __forceinline__ void attn_phase(const Args& a, int l, unsigned char* ws, LAS unsigned char* lds, int mode = 0) {
    const int lq = l; l &= 3;
    unsigned char* R = ws + WS_R;
    const bf16 *QA = (const bf16*)(R + R_QA), *KA = (const bf16*)(R + R_KA), *VA = (const bf16*)(R + R_VA), *KR = (const bf16*)(R + R_KR), *QM = (const bf16*)(R + R_QM), *KN = (const bf16*)(R + R_KN), *VB = (const bf16*)(R + R_VB);
    bf16* O = (bf16*)(R + R_O); float* ssqO = (float*)(ws + WS_PART + P_SSQO);
    LAS int* qslot = (LAS int*)(lds + att::OFF_Q);
    const unsigned xcc = ((unsigned)__builtin_amdgcn_s_getreg((3 << 11) | 20) & 0xFu) & 7u;
    unsigned* ctr = (unsigned*)(ws + WS_CTL) + 64 * lq + 8 * 64 * (int)xcc;
    constexpr int PER_X = N_ATT_UNITS / 8;
    for (int pass = 0; pass < 8; ++pass) {
        const unsigned x = (xcc + (unsigned)pass) & 7u; unsigned* c = (unsigned*)(ws + WS_CTL) + 64 * lq + 8 * 64 * (int)x;
        for (;;) {
            if (threadIdx.x == 0) *qslot = (int)atomicAdd(c, 1u);
            __syncthreads();
            const int u = *qslot;
            __syncthreads();
            if (u >= (mode == 1 ? PER_X / 2 : PER_X)) break;
            if (u < PER_X / 2) {
                const int bh = 8 * (u / 17) + (int)x, qb = 16 - u % 17, b = bh >> 3, hd = bh & 7;
                att::attn_unit<96, false>(lds, QM + hd * 96, 768, KN + hd * 64, 512, KR, VB + hd * 64, 512, O + 512 + hd * 64, ssqO + 8 + hd, 0.f, b, qb);
            } else {
                const int v = u - PER_X / 2; const int bh = 8 * (v / 17) + (int)x, qb = 16 - v % 17, b = bh >> 3, hq = bh & 7, kv = hq >> 2;
                att::attn_unit<64, true>(lds, QA + hq * 64, 512, KA + kv * 64, 128, nullptr, VA + kv * 64, 128, O + hq * 64, ssqO + hq, a.sinks[l * 8 + hq] * LOG2E, b, qb);
            }
        }
    }
    (void)ctr;
}

#define XB_TMO      128
#define XB_XCNT(j)  (256  + 64 * (j))
#define XB_XSUB(j)  (1280 + 64 * (j))
#define XB_XGEN(j)  (2304 + 64 * (j))
#define XB_TOP      3328
#define XB_TOPGEN   3392
#define XCD_BAR_WORDS 3456
#define XB_SPIN_CAP (1u << 18)

__device__ __forceinline__ unsigned xb_ld(unsigned* p)              { return __hip_atomic_load(p, __ATOMIC_RELAXED, __HIP_MEMORY_SCOPE_AGENT); }
__device__ __forceinline__ unsigned xb_add(unsigned* p, unsigned v) { return __hip_atomic_fetch_add(p, v, __ATOMIC_RELAXED, __HIP_MEMORY_SCOPE_AGENT); }
__device__ __forceinline__ unsigned xb_xcc_id() { return (unsigned)__builtin_amdgcn_s_getreg((3 << 11) | 20) & 0xFu; }
#define XB_SPIN(cond, bar) do { unsigned _sp = 0; while (cond) { __builtin_amdgcn_s_sleep(1); \
    if ((++_sp & 255u) == 0u) { if (xb_ld(&(bar)[XB_TMO])) break; if (_sp > XB_SPIN_CAP) { atomicAdd(&(bar)[XB_TMO], 1u); break; } } } } while (0)

struct XcdBarrier {
    unsigned* bar; unsigned x;
    volatile LAS unsigned* st;
};

__device__ __forceinline__ XcdBarrier xcd_barrier_post(unsigned* bar, volatile LAS unsigned* st) {
    XcdBarrier b; b.bar = bar; b.x = xb_xcc_id(); b.st = st;
    if (threadIdx.x == 0) (void)xb_add(&bar[XB_XCNT(b.x)], 1u);
    return b;
}
__device__ __forceinline__ void xcd_barrier_complete(unsigned* bar, unsigned x, unsigned& nloc, unsigned& nx) {
    const unsigned G = gridDim.x * gridDim.y * gridDim.z;
    unsigned sum, cnt, mine, sp = 0u;
    for (;;) {
        sum = 0u; cnt = 0u; mine = 0u;
#pragma unroll
        for (unsigned j = 0; j < 16; ++j) { const unsigned c = xb_ld(&bar[XB_XCNT(j)]); sum += c; cnt += (c > 0u) ? 1u : 0u; mine = (j == x) ? c : mine; }
        if (sum == G) break;
        __builtin_amdgcn_s_sleep(1);
        if ((++sp & 255u) == 0u) { if (xb_ld(&bar[XB_TMO])) break; if (sp > XB_SPIN_CAP) { atomicAdd(&bar[XB_TMO], 1u); break; } }
    }
    nloc = mine > 0u ? mine : 1u; nx = cnt > 0u ? cnt : 1u;
}

__device__ __forceinline__ void xcd_barrier(const XcdBarrier& b) {
    asm volatile("s_waitcnt vmcnt(0)" ::: "memory");
    __syncthreads();
    if (threadIdx.x == 0) {
        unsigned* bar = b.bar;
        __builtin_amdgcn_s_waitcnt(0);
        unsigned nloc = b.st[0], nx = b.st[1];
        if (nloc == 0u) { xcd_barrier_complete(bar, b.x, nloc, nx); b.st[0] = nloc; b.st[1] = nx; }
        const unsigned old = xb_add(&bar[XB_XSUB(b.x)], 1u);
        const unsigned gen = old / nloc;
        if (old + 1u == (gen + 1u) * nloc) {
            __builtin_amdgcn_fence(__ATOMIC_RELEASE, "agent");
            asm volatile("s_waitcnt vmcnt(0)" ::: "memory");
            const unsigned og = xb_add(&bar[XB_TOP], 1u);
            const unsigned tg = og / nx;
            if (og + 1u == (tg + 1u) * nx) xb_add(&bar[XB_TOPGEN], 1u);
            else XB_SPIN(xb_ld(&bar[XB_TOPGEN]) == tg, bar);
            __builtin_amdgcn_fence(__ATOMIC_ACQUIRE, "agent");
            xb_add(&bar[XB_XGEN(b.x)], 1u);
            asm volatile("s_waitcnt vmcnt(0)" ::: "memory");
        } else {
            XB_SPIN(xb_ld(&bar[XB_XGEN(b.x)]) == gen, bar);
            __builtin_amdgcn_fence(__ATOMIC_ACQUIRE, "agent");
            asm volatile("s_waitcnt vmcnt(0)" ::: "memory");
        }
    }
    __syncthreads();
}

constexpr int CW_BAR = 4096;
constexpr int XB_LDS_OFF = 131072 + 8192;
#ifndef PHM
#define PHM 255
#endif
#ifndef PROBE_DUP
#define PROBE_DUP 0
#endif
#ifndef PROBE_SYNC
#define PROBE_SYNC 0
#endif
__global__ void __launch_bounds__(NTHREADS, 2) fwd_megakernel(Args a) {
    extern __shared__ __attribute__((aligned(16))) unsigned char lds_raw[];
    LAS unsigned char* lds = (LAS unsigned char*)lds_raw;
    cg::grid_group grid = cg::this_grid();
    const int lo = a.ph_lo, hi = a.ph_hi;
    if (threadIdx.x < 2) ((LAS unsigned*)(lds + XB_LDS_OFF))[threadIdx.x] = 0u;
    __syncthreads();
    if (a.ph_hi < 0) grid.sync();
    const XcdBarrier xbar = xcd_barrier_post((unsigned*)(a.ws + WS_CTL) + CW_BAR, (volatile LAS unsigned*)(lds + XB_LDS_OFF));
#define IN_PH(k) (lo <= (k) && (k) < hi)
#define SEAM(k) do { if (IN_PH(k) && IN_PH((k) + 1)) { xcd_barrier(xbar); if (PROBE_SYNC) xcd_barrier(xbar); } } while (0)
#define WSL(w) unsigned char* w = a.ws; asm volatile("" : "+s"(w))
    if (IN_PH(0) && (PHM & 1)) { WSL(ws); init_rows(a, ws); conv_layer(a, 0, ws + WS_W, lds); __syncthreads(); }
    SEAM(0);
#pragma unroll 1
    for (int l = 0; l < DEPTH; ++l) {
        const int p = 1 + 6 * l;
        if (IN_PH(p) && (PHM & 2)) {
            { WSL(ws); unsigned char* R = ws + WS_R; unsigned char* wb = ws + WS_W + (size_t)(l & 1) * WBUF; unsigned char* pm_ = ws + WS_PART;
              pg8::EpiIn<true> E{(const float*)(pm_ + PM_HSSA), (bf16*)(R + R_QA), (bf16*)(R + R_KA), (bf16*)(R + R_VA), (bf16*)(pm_ + PM_QLAT), (bf16*)(pm_ + PM_KVLAT), (bf16*)(R + R_KR), (float*)(pm_ + PM_SSQQ), (float*)(pm_ + PM_SSQKV)};
              pg8::skinny_phase<DM>(lds, (const bf16*)(pm_ + PM_HB), (const bf16*)(wb + WL_IN), INP / 256, E, 128); }
            WSL(ws); unsigned char* R = ws + WS_R; unsigned char* wb = ws + WS_W + (size_t)(l & 1) * WBUF;
            pg8::Gemm g{(const bf16*)(ws + WS_HB), (const bf16*)(wb + WL_IN), MC, INP, DM, 0}; pg8::OrderCT<MC / 256, INP / 256> S; S.init((int)gridDim.x, (int)blockIdx.x);
            pg8::EpiIn<false> E{(const float*)(ws + WS_PART + P_HSSA), (bf16*)(R + R_QA), (bf16*)(R + R_KA), (bf16*)(R + R_VA), (bf16*)(R + R_QLAT), (bf16*)(R + R_KVLAT), (bf16*)(R + R_KR),
                         (float*)(ws + WS_PART + P_SSQQ), (float*)(ws + WS_PART + P_SSQKV)};
            pg8::gemm_phase<pg8::EpiIn<false>, pg8::OrderCT<MC / 256, INP / 256>, true, true>(lds, g, S, E);
            if (PROBE_DUP & 2) pg8::gemm_phase<pg8::EpiIn<false>, pg8::OrderCT<MC / 256, INP / 256>, true, true>(lds, g, S, E);
        }
        SEAM(p);
        if (IN_PH(p + 1) && (PHM & 4)) {
            { WSL(ws); unsigned char* R = ws + WS_R; unsigned char* wb = ws + WS_W + (size_t)(l & 1) * WBUF; unsigned char* pm_ = ws + WS_PART;
              pg8::EpiQup<true> E{(const float*)(pm_ + PM_SSQQ), (bf16*)(R + R_QM)}; pg8::skinny_phase<256>(lds, (const bf16*)(pm_ + PM_QLAT), (const bf16*)(wb + WL_Q), 3, E, 128); }
            { WSL(ws); unsigned char* R = ws + WS_R; unsigned char* wb = ws + WS_W + (size_t)(l & 1) * WBUF;
              pg8::Gemm g{(const bf16*)(R + R_QLAT), (const bf16*)(wb + WL_Q), MC, 768, 256, 0}; pg8::OrderCT<MC / 256, 3> S; S.init((int)gridDim.x, (int)blockIdx.x);
              pg8::EpiQup<false> E{(const float*)(ws + WS_PART + P_SSQQ), (bf16*)(R + R_QM)}; pg8::gemm_phase<pg8::EpiQup<false>, pg8::OrderCT<MC / 256, 3>, true, true>(lds, g, S, E); if (PROBE_DUP & 4) pg8::gemm_phase<pg8::EpiQup<false>, pg8::OrderCT<MC / 256, 3>, true, true>(lds, g, S, E); }
            { WSL(ws); unsigned char* R = ws + WS_R; unsigned char* wb = ws + WS_W + (size_t)(l & 1) * WBUF; unsigned char* pm_ = ws + WS_PART;
              pg8::EpiKvup<true> E{(const float*)(pm_ + PM_SSQKV), (bf16*)(R + R_KN), (bf16*)(R + R_VB)}; pg8::skinny_phase<128>(lds, (const bf16*)(pm_ + PM_KVLAT), (const bf16*)(wb + WL_KV), 4, E, 0); }
            { WSL(ws); unsigned char* R = ws + WS_R; unsigned char* wb = ws + WS_W + (size_t)(l & 1) * WBUF;
              pg8::Gemm g{(const bf16*)(R + R_KVLAT), (const bf16*)(wb + WL_KV), MC, 1024, 128, 0}; pg8::OrderCT<MC / 256, 4> S; S.init((int)gridDim.x, (int)blockIdx.x);
              pg8::EpiKvup<false> E{(const float*)(ws + WS_PART + P_SSQKV), (bf16*)(R + R_KN), (bf16*)(R + R_VB)}; pg8::gemm_phase<pg8::EpiKvup<false>, pg8::OrderCT<MC / 256, 4>, true, true>(lds, g, S, E); if (PROBE_DUP & 4) pg8::gemm_phase<pg8::EpiKvup<false>, pg8::OrderCT<MC / 256, 4>, true, true>(lds, g, S, E); }
        }
        SEAM(p + 1);
        if (IN_PH(p + 2) && (PHM & 8)) { WSL(ws); if (l + 1 < DEPTH) { conv_layer(a, l + 1, ws + WS_W + (size_t)((l + 1) & 1) * WBUF, lds); __syncthreads(); if (PROBE_DUP & 256) { conv_layer(a, l + 1, ws + WS_W + (size_t)((l + 1) & 1) * WBUF, lds); __syncthreads(); } } attn_phase(a, l, ws, lds); if (PROBE_DUP & 8) attn_phase(a, l + 4, ws, lds); if (PROBE_DUP & 1024) attn_phase(a, l + 4, ws, lds, 1); }
        SEAM(p + 2);
        if (IN_PH(p + 3) && (PHM & 16)) {
            { WSL(ws); unsigned char* R = ws + WS_R; unsigned char* wb = ws + WS_W + (size_t)(l & 1) * WBUF; unsigned char* pm_ = ws + WS_PART;
              pg8::EpiOut<true> E; E.H = (float*)(pm_ + PM_H); E.HB = (bf16*)(pm_ + PM_HB); E.hss_out = (float*)(pm_ + PM_HSSB); E.ssq_o = (const float*)(pm_ + P_SSQO); E.xlds = lds;
              pg8::skinny_phase<DM>(lds, (const bf16*)(R + R_O) + (size_t)FRONT * 1024, (const bf16*)(wb + WL_O), 4, E, 0); }
            WSL(ws); unsigned char* R = ws + WS_R; unsigned char* wb = ws + WS_W + (size_t)(l & 1) * WBUF;
            pg8::Gemm g{(const bf16*)(R + R_O), (const bf16*)(wb + WL_O), MC, DM, DM, 1}; pg8::OrderCT<MC / 256, 4> S; S.init((int)gridDim.x, (int)blockIdx.x);
            pg8::EpiOut<false> E; E.H = (float*)(ws + WS_H); E.HB = (bf16*)(ws + WS_HB); E.hss_out = (float*)(ws + WS_PART + P_HSSB); E.ssq_o = (const float*)(ws + WS_PART + P_SSQO); E.xlds = lds + pg8::STAGE_BYTES;
            pg8::gemm_phase<pg8::EpiOut<false>, pg8::OrderCT<MC / 256, 4>, true, true>(lds, g, S, E);
        }
        SEAM(p + 3);
        if (IN_PH(p + 4) && (PHM & 32)) {
            { WSL(ws); unsigned char* wb = ws + WS_W + (size_t)(l & 1) * WBUF; unsigned char* pm_ = ws + WS_PART;
              pg8::EpiGU<true> E{(const float*)(pm_ + PM_HSSB), (bf16*)(pm_ + PM_ACT)}; pg8::skinny_phase<DM>(lds, (const bf16*)(pm_ + PM_HB), (const bf16*)(wb + WL_GU), GUP / 256, E, 0); }
            WSL(ws); unsigned char* R = ws + WS_R; unsigned char* wb = ws + WS_W + (size_t)(l & 1) * WBUF;
            pg8::Gemm g{(const bf16*)(ws + WS_HB), (const bf16*)(wb + WL_GU), MC, GUP, DM, 0}; pg8::OrderCT<MC / 256, GUP / 256> S; S.init((int)gridDim.x, (int)blockIdx.x);
            pg8::EpiGU<false> E{(const float*)(ws + WS_PART + P_HSSB), (bf16*)(R + R_ACT)};
            pg8::gemm_phase<pg8::EpiGU<false>, pg8::OrderCT<MC / 256, GUP / 256>, true, true>(lds, g, S, E);
        }
        SEAM(p + 4);
        if (IN_PH(p + 5) && (PHM & 64)) {
            { WSL(ws); unsigned char* wb = ws + WS_W + (size_t)(l & 1) * WBUF; unsigned char* pm_ = ws + WS_PART;
              pg8::EpiDown<true> E; E.H = (float*)(pm_ + PM_H); E.HB = (bf16*)(pm_ + PM_HB); E.hss_out = (float*)(pm_ + PM_HSSA); E.ssq_o = nullptr;
              pg8::skinny_phase<DFF>(lds, (const bf16*)(pm_ + PM_ACT), (const bf16*)(wb + WL_D), 4, E, 0); }
            WSL(ws); unsigned char* R = ws + WS_R; unsigned char* wb = ws + WS_W + (size_t)(l & 1) * WBUF;
            pg8::Gemm g{(const bf16*)(R + R_ACT), (const bf16*)(wb + WL_D), MC, DM, DFF, 0}; pg8::OrderCT<MC / 256, 4> S; S.init((int)gridDim.x, (int)blockIdx.x);
            pg8::EpiDown<false> E; E.H = (float*)(ws + WS_H); E.HB = (bf16*)(ws + WS_HB); E.hss_out = (float*)(ws + WS_PART + P_HSSA); E.ssq_o = nullptr;
            pg8::gemm_phase<pg8::EpiDown<false>, pg8::OrderCT<MC / 256, 4>, true, true>(lds, g, S, E);
        }
        SEAM(p + 5);
    }
    if (IN_PH(1 + 6 * DEPTH) && (PHM & 128)) { WSL(ws); final_rows(a, (const bf16*)(ws + WS_HB), (const float*)(ws + WS_PART + P_HSSA)); }
#undef IN_PH
#undef SEAM
#undef WSL
}
constexpr int N_PHASES = 2 + 6 * DEPTH;

#ifndef MK_SPLIT
#define MK_SPLIT 0
#endif
extern "C" void kernel_launch(void* const* d_in, const int* in_sizes, int n_in, void* d_out, int out_size, void* d_ws, size_t ws_size, hipStream_t stream) {
    static int grid = 0;
    if (grid == 0) {
        if (n_in != 17 || ws_size < WS_END) { fprintf(stderr, "kernel_launch: need 17 inputs and >= %zu bytes of workspace; got n_in %d, ws %zu\n", (size_t)WS_END, n_in, ws_size); grid = -1; return; }
        int dev = 0, cus = 0, per_cu = 0;
        hipGetDevice(&dev); hipDeviceGetAttribute(&cus, hipDeviceAttributeMultiprocessorCount, dev);
        if (hipFuncSetAttribute((const void*)fwd_megakernel, hipFuncAttributeMaxDynamicSharedMemorySize, LDS_BYTES) != hipSuccess) { fprintf(stderr, "kernel_launch: hipFuncSetAttribute failed\n"); grid = -1; return; }
        if (hipOccupancyMaxActiveBlocksPerMultiprocessor(&per_cu, (const void*)fwd_megakernel, NTHREADS, LDS_BYTES) != hipSuccess || per_cu < 1) { fprintf(stderr, "kernel_launch: occupancy query says %d\n", per_cu); per_cu = 1; }
        (void)hipGetLastError();
        grid = cus * 1;
    }
    if (grid < 0) return;
    hipMemsetAsync((char*)d_ws + WS_CTL, 0, CTL_BYTES, stream);
    Args a{};
    const float** f = (const float**)&a;
    for (int i = 0; i < 17; ++i) f[i] = (const float*)d_in[i];
    a.out = (float*)d_out; a.ws = (unsigned char*)d_ws;
#if MK_SPLIT
    for (int ph = 0; ph < N_PHASES; ++ph) { a.ph_lo = ph; a.ph_hi = ph + 1; hipLaunchKernelGGL(fwd_megakernel, dim3(grid), dim3(NTHREADS), LDS_BYTES, stream, a); }
#else
    a.ph_lo = 0; a.ph_hi = N_PHASES;
    void* args[] = {&a};
    hipError_t e = hipLaunchCooperativeKernel((const void*)fwd_megakernel, dim3(grid), dim3(NTHREADS), args, LDS_BYTES, stream);
    if (e != hipSuccess) fprintf(stderr, "cooperative launch failed: %s (grid %d)\n", hipGetErrorString(e), grid);
#endif
}
```
